# Optimizing an MI355X kernel written in HIP

```python
import math
import jax
import jax.numpy as jnp
from jax import lax
import numpy as np

D_MODEL = 1024
BATCH = 8
SEQ = 4096
DEPTH = 4

HEAD_DIM = 64
N_MIXERS = 4
MIX_W = D_MODEL // 2
Q_BLOCK = 128
EPS = 1e-6
NEG_INF = -1e30
CONV_K = 3
NSA_HEADS = MIX_W // HEAD_DIM
NSA_KV_HEADS = 2
CMP_BLOCK = 32
CMP_STRIDE = 16
CMP_HIDDEN = 256
SEL_BLOCK = 64
SEL_TOPN = 8
WINDOW = 512
FORCED_SCORE = 1e4
SGU_CHUNK = 128
SGU_GROUPS = 8
DSA_HEADS = MIX_W // HEAD_DIM
IDX_HEADS = 8
IDX_DIM = 64
DSA_TOPK_MAX = 256
N_BUCKETS = 32
MAX_DISTANCE = 1024
REL_HEADS = NSA_HEADS + DSA_HEADS
PEER_HEADS = 8
PEER_KEYS = 128
PEER_QDIM = 128
PEER_TOPK = 16
N_EXPERTS = PEER_KEYS * PEER_KEYS
PEER_CHUNK = 128
PLE_DIM = 256

SPLIT_WIDTHS = (
    MIX_W, MIX_W, MIX_W,
    NSA_HEADS * HEAD_DIM,
    6 * NSA_KV_HEADS * HEAD_DIM,
    3 * NSA_HEADS,
    2 * MIX_W,
    DSA_HEADS * HEAD_DIM, HEAD_DIM, HEAD_DIM,
    IDX_HEADS * IDX_DIM, IDX_DIM, IDX_HEADS,
)
IN_WIDTH = sum(SPLIT_WIDTHS)

kernel_name = "hybrid_gated_nsa_dsa_sgu_conv_peer"


def rmsnorm(x, g):
    xf = x.astype(jnp.float32)
    xf = xf * lax.rsqrt(jnp.mean(xf * xf, axis=-1, keepdims=True) + EPS)
    return (xf * g.astype(jnp.float32)).astype(x.dtype)


def layernorm(x, g):
    xf = x.astype(jnp.float32)
    xf = xf - jnp.mean(xf, axis=-1, keepdims=True)
    xf = xf * lax.rsqrt(jnp.mean(xf * xf, axis=-1, keepdims=True) + EPS)
    return (xf * g.astype(jnp.float32)).astype(x.dtype)


def rel_bucket(dist):
    n = jnp.maximum(dist, 0)
    max_exact = N_BUCKETS // 2
    nf = jnp.maximum(n, 1).astype(jnp.float32)
    large = max_exact + (jnp.log(nf / max_exact) / math.log(MAX_DISTANCE / max_exact)
                         * (N_BUCKETS - max_exact)).astype(jnp.int32)
    return jnp.where(n < max_exact, n, jnp.minimum(large, N_BUCKETS - 1))


def masked_softmax(logits, mask, axis):
    lf = jnp.where(mask, logits.astype(jnp.float32), NEG_INF)
    m = jnp.max(lf, axis=axis, keepdims=True)
    e = jnp.where(mask, jnp.exp(lf - m), 0.0)
    return e / jnp.maximum(jnp.sum(e, axis=axis, keepdims=True), 1e-30)


def short_conv_mixer(b_gate, c_gate, xv, conv_w):
    S = xv.shape[1]
    bx = c_gate * xv
    xp = jnp.pad(bx, ((0, 0), (CONV_K - 1, 0), (0, 0)))
    conv = sum(conv_w[k] * xp[:, k:k + S] for k in range(CONV_K))
    return b_gate * conv


def nsa_mixer(q, kv, gate_logits, cmp_pe, cmp_w1, cmp_w2, q_gain, k_gain, rel_tbl):
    B, S = q.shape[:2]
    H, Hkv, dh = NSA_HEADS, NSA_KV_HEADS, HEAD_DIM
    G = H // Hkv
    q = rmsnorm(q, q_gain) * (dh ** -0.5)
    k_c, v_c, k_s, v_s, k_w, v_w = (kv[:, :, i] for i in range(6))
    k_s = rmsnorm(k_s, k_gain[1])
    k_w = rmsnorm(k_w, k_gain[2])

    n_cmp = (S - CMP_BLOCK) // CMP_STRIDE + 1
    cmp_idx = np.arange(n_cmp)[:, None] * CMP_STRIDE + np.arange(CMP_BLOCK)[None, :]

    def compress(t, j):
        blk = t[:, cmp_idx] + cmp_pe[j][None, None, :, None, :]
        blk = blk.transpose(0, 1, 3, 2, 4).reshape(B, n_cmp, Hkv, CMP_BLOCK * dh)
        return jax.nn.gelu(blk @ cmp_w1[j]) @ cmp_w2[j]

    k_c = rmsnorm(compress(k_c, 0), k_gain[0])
    v_c = compress(v_c, 1)
    cmp_end = jnp.asarray(cmp_idx[:, -1], jnp.int32)

    n_sel = S // SEL_BLOCK
    sel_start = np.arange(n_sel) * SEL_BLOCK
    cmp_start = cmp_idx[:, 0]
    overlap = jnp.asarray((cmp_start[:, None] < sel_start[None, :] + SEL_BLOCK)
                          & (cmp_start[:, None] + CMP_BLOCK > sel_start[None, :]), jnp.float32)
    ks_blk = k_s.reshape(B, n_sel, SEL_BLOCK, Hkv, dh).transpose(0, 3, 1, 2, 4)
    vs_blk = v_s.reshape(B, n_sel, SEL_BLOCK, Hkv, dh).transpose(0, 3, 1, 2, 4)
    top_n = min(SEL_TOPN, n_sel)

    kw_p = jnp.pad(k_w, ((0, 0), (WINDOW, 0), (0, 0), (0, 0)))
    vw_p = jnp.pad(v_w, ((0, 0), (WINDOW, 0), (0, 0), (0, 0)))

    tbl = rel_tbl[:, :NSA_HEADS].reshape(N_BUCKETS, Hkv, G)
    b_idx = jnp.arange(B)[:, None, None]
    g_idx = jnp.arange(Hkv)[None, :, None]

    def block(i):
        q0 = i * Q_BLOCK
        t = q0 + jnp.arange(Q_BLOCK)
        qb = lax.dynamic_slice_in_dim(q, q0, Q_BLOCK, axis=1).reshape(B, Q_BLOCK, Hkv, G, dh)
        gb = lax.dynamic_slice_in_dim(gate_logits, q0, Q_BLOCK, axis=1)

        dist_c = t[:, None] - cmp_end[None, :]
        lc = jnp.einsum('btgrd,bngd->bgrtn', qb, k_c)
        lc = lc + tbl[rel_bucket(dist_c)].transpose(2, 3, 0, 1)[None]
        pc = masked_softmax(lc, dist_c >= 0, -1)
        o_c = jnp.einsum('bgrtn,bngd->btgrd', pc, v_c)

        imp = jnp.einsum('bgrtn,nj->bgtj', pc, overlap)
        cur = t // SEL_BLOCK
        j = jnp.arange(n_sel)
        forced = (j[None, :] == 0) | (j[None, :] == cur[:, None])
        imp = jnp.where(forced, FORCED_SCORE, imp)
        imp = jnp.where(j[None, :] <= cur[:, None], imp, NEG_INF)
        _, sel = lax.top_k(imp, top_n)
        sel_f = sel.reshape(B, Hkv, Q_BLOCK * top_n)
        k_sel = ks_blk[b_idx, g_idx, sel_f].reshape(B, Hkv, Q_BLOCK, top_n, SEL_BLOCK, dh)
        v_sel = vs_blk[b_idx, g_idx, sel_f].reshape(B, Hkv, Q_BLOCK, top_n, SEL_BLOCK, dh)
        pos_s = sel[..., None] * SEL_BLOCK + jnp.arange(SEL_BLOCK)
        dist_s = t[None, None, :, None, None] - pos_s
        ls = jnp.einsum('btgrd,bgtnkd->bgrtnk', qb, k_sel)
        bias_s = tbl[rel_bucket(dist_s), jnp.arange(Hkv)[None, :, None, None, None]]
        ls = ls + jnp.moveaxis(bias_s, -1, 2)
        ps = masked_softmax(ls, (dist_s >= 0)[:, :, None], (-2, -1))
        o_s = jnp.einsum('bgrtnk,bgtnkd->btgrd', ps, v_sel)

        kwb = lax.dynamic_slice_in_dim(kw_p, q0, Q_BLOCK + WINDOW, axis=1)
        vwb = lax.dynamic_slice_in_dim(vw_p, q0, Q_BLOCK + WINDOW, axis=1)
        pos_w = q0 - WINDOW + jnp.arange(Q_BLOCK + WINDOW)
        dist_w = t[:, None] - pos_w[None, :]
        mask_w = (dist_w >= 0) & (dist_w < WINDOW) & (pos_w[None, :] >= 0)
        lw = jnp.einsum('btgrd,bsgd->bgrts', qb, kwb)
        lw = lw + tbl[rel_bucket(dist_w)].transpose(2, 3, 0, 1)[None]
        pw = masked_softmax(lw, mask_w, -1)
        o_w = jnp.einsum('bgrts,bsgd->btgrd', pw, vwb)

        g = jax.nn.sigmoid(gb.astype(jnp.float32)).reshape(B, Q_BLOCK, 3, Hkv, G)[..., None]
        o = g[:, :, 0] * o_c + g[:, :, 1] * o_s + g[:, :, 2] * o_w
        return o.reshape(B, Q_BLOCK, H * dh).astype(q.dtype)

    out = lax.map(block, jnp.arange(S // Q_BLOCK))
    return out.transpose(1, 0, 2, 3).reshape(B, S, H * dh)


def sgu_mixer(uv, ln_gain, w_s, b_s):
    B, S, _ = uv.shape
    uv = jax.nn.gelu(uv)
    u, v = jnp.split(uv, 2, axis=-1)
    v = layernorm(v, ln_gain).reshape(B, S // SGU_CHUNK, SGU_CHUNK, SGU_GROUPS, MIX_W // SGU_GROUPS)
    tri = jnp.tril(jnp.ones((SGU_CHUNK, SGU_CHUNK), dtype=bool))
    w = jnp.where(tri[None], w_s, 0)
    s = jnp.einsum('gts,bcsgd->bctgd', w, v) + b_s.T[:, :, None]
    return u * s.reshape(B, S, MIX_W)


def dsa_mixer(q, k, v, q_idx, k_idx, w_idx, q_gain, k_gain, rel_tbl):
    B, S = q.shape[:2]
    H, dh = DSA_HEADS, HEAD_DIM
    q = rmsnorm(q, q_gain) * (dh ** -0.5)
    k = rmsnorm(k, k_gain)
    w_idx = w_idx * (IDX_HEADS ** -0.5)
    top_k = min(DSA_TOPK_MAX, S // 4)
    tbl = rel_tbl[:, NSA_HEADS:]
    b_idx = jnp.arange(B)[:, None, None]
    key_pos = jnp.arange(S)

    def block(i):
        q0 = i * Q_BLOCK
        t = q0 + jnp.arange(Q_BLOCK)
        qb = lax.dynamic_slice_in_dim(q, q0, Q_BLOCK, axis=1)
        qib = lax.dynamic_slice_in_dim(q_idx, q0, Q_BLOCK, axis=1)
        wib = lax.dynamic_slice_in_dim(w_idx, q0, Q_BLOCK, axis=1)
        score = jnp.einsum('bth,bths->bts', wib,
                           jax.nn.relu(jnp.einsum('bthd,bsd->bths', qib, k_idx)))
        score = jnp.where(key_pos[None, None, :] <= t[None, :, None],
                          score.astype(jnp.float32), NEG_INF)
        _, sel = lax.top_k(score, top_k)
        k_sel = k[b_idx, sel]
        v_sel = v[b_idx, sel]
        dist = t[None, :, None] - sel
        logits = jnp.einsum('bthd,btkd->bhtk', qb, k_sel)
        logits = logits + jnp.moveaxis(tbl[rel_bucket(dist)], -1, 1)
        p = masked_softmax(logits, (dist >= 0)[:, None], -1)
        o = jnp.einsum('bhtk,btkd->bthd', p, v_sel)
        return o.reshape(B, Q_BLOCK, H * dh).astype(q.dtype)

    out = lax.map(block, jnp.arange(S // Q_BLOCK))
    return out.transpose(1, 0, 2, 3).reshape(B, S, H * dh)


def peer_ffn(h, wq, subkeys, u_tab, v_tab):
    B, S, D = h.shape
    T = B * S

    def chunk(hc):
        C = hc.shape[0]
        q = (hc @ wq).reshape(C, PEER_HEADS, 2, PEER_QDIM // 2)
        s = jnp.einsum('chpd,hpkd->chpk', q, subkeys).astype(jnp.float32)
        s_top, i_top = lax.top_k(s, PEER_TOPK)
        cand = s_top[:, :, 0, :, None] + s_top[:, :, 1, None, :]
        cand_idx = i_top[:, :, 0, :, None] * PEER_KEYS + i_top[:, :, 1, None, :]
        c_s, c_i = lax.top_k(cand.reshape(C, PEER_HEADS, PEER_TOPK * PEER_TOPK), PEER_TOPK)
        experts = jnp.take_along_axis(cand_idx.reshape(C, PEER_HEADS, -1), c_i, axis=-1)
        g = jax.nn.softmax(c_s, axis=-1)
        u = u_tab[experts]
        v = v_tab[experts]
        a = jax.nn.gelu(jnp.einsum('ched,cd->che', u, hc))
        return jnp.einsum('che,ched->cd', (g * a).astype(v.dtype), v)

    out = lax.map(chunk, h.reshape(T // PEER_CHUNK, PEER_CHUNK, D))
    return out.reshape(B, S, D)


def setup_inputs(seed: int = 0) -> dict:
    key = jax.random.key(seed)
    ks = jax.random.split(key, 32)
    L = DEPTH

    def nrm(k, shape, scale):
        return jax.random.normal(k, shape, jnp.float32) * scale

    def gain(k, shape):
        return 1.0 + 0.05 * jax.random.normal(k, shape, jnp.float32)

    return {
        "x": nrm(ks[0], (BATCH, SEQ, D_MODEL), 1.0),
        "p": nrm(ks[1], (DEPTH, BATCH, SEQ, PLE_DIM), 1.0),
        "rel_bias": nrm(ks[2], (N_BUCKETS, REL_HEADS), 0.5),
        "g_mix": gain(ks[3], (L, D_MODEL)),
        "w_in": nrm(ks[4], (L, D_MODEL, IN_WIDTH), D_MODEL ** -0.5),
        "conv_w": nrm(ks[5], (L, CONV_K, MIX_W), 0.5),
        "nsa_cmp_pe": nrm(ks[6], (L, 2, CMP_BLOCK, HEAD_DIM), 0.1),
        "nsa_cmp_w1": nrm(ks[7], (L, 2, CMP_BLOCK * HEAD_DIM, CMP_HIDDEN), (CMP_BLOCK * HEAD_DIM) ** -0.5),
        "nsa_cmp_w2": nrm(ks[8], (L, 2, CMP_HIDDEN, HEAD_DIM), CMP_HIDDEN ** -0.5),
        "nsa_q_gain": gain(ks[9], (L, HEAD_DIM)),
        "nsa_k_gain": gain(ks[10], (L, 3, HEAD_DIM)),
        "sgu_ln_gain": gain(ks[11], (L, MIX_W)),
        "sgu_w": nrm(ks[12], (L, SGU_GROUPS, SGU_CHUNK, SGU_CHUNK), 0.5 * SGU_CHUNK ** -0.5),
        "sgu_b": 1.0 + nrm(ks[13], (L, SGU_GROUPS, SGU_CHUNK), 0.02),
        "dsa_q_gain": gain(ks[14], (L, HEAD_DIM)),
        "dsa_k_gain": gain(ks[15], (L, HEAD_DIM)),
        "w_gate": nrm(ks[16], (L, D_MODEL, N_MIXERS * D_MODEL), D_MODEL ** -0.5),
        "w_branch": nrm(ks[17], (L, N_MIXERS * MIX_W, D_MODEL), MIX_W ** -0.5),
        "w_out": nrm(ks[18], (L, D_MODEL, D_MODEL), 0.5 * D_MODEL ** -0.5),
        "g_ffn": gain(ks[19], (L, D_MODEL)),
        "peer_wq": nrm(ks[20], (L, D_MODEL, PEER_HEADS * PEER_QDIM), D_MODEL ** -0.5),
        "peer_subkeys": nrm(ks[21], (L, PEER_HEADS, 2, PEER_KEYS, PEER_QDIM // 2), (PEER_QDIM // 2) ** -0.5),
        "peer_u": nrm(ks[22], (L, N_EXPERTS, D_MODEL), D_MODEL ** -0.5),
        "peer_v": nrm(ks[23], (L, N_EXPERTS, D_MODEL), 0.25),
        "g_ple": gain(ks[24], (L, D_MODEL)),
        "w_ple_gate": nrm(ks[25], (L, D_MODEL, D_MODEL), D_MODEL ** -0.5),
        "w_ple_proj": nrm(ks[26], (L, PLE_DIM, D_MODEL), PLE_DIM ** -0.5),
    }


def reference(x, p, rel_bias, g_mix, w_in, conv_w, nsa_cmp_pe, nsa_cmp_w1, nsa_cmp_w2,
              nsa_q_gain, nsa_k_gain, sgu_ln_gain, sgu_w, sgu_b, dsa_q_gain, dsa_k_gain,
              w_gate, w_branch, w_out, g_ffn, peer_wq, peer_subkeys, peer_u, peer_v,
              g_ple, w_ple_gate, w_ple_proj):
    B, S, D = x.shape
    split_points = [int(c) for c in np.cumsum(SPLIT_WIDTHS)[:-1]]
    for l in range(DEPTH):
        h = rmsnorm(x, g_mix[l])
        proj = h @ w_in[l]
        (a_b, a_c, a_x, n_q, n_kv, n_g, c_uv,
         d_q, d_k, d_v, d_qi, d_ki, d_wi) = jnp.split(proj, split_points, axis=-1)

        y_a = short_conv_mixer(a_b, a_c, a_x, conv_w[l])
        y_b = nsa_mixer(n_q.reshape(B, S, NSA_HEADS, HEAD_DIM),
                        n_kv.reshape(B, S, 6, NSA_KV_HEADS, HEAD_DIM),
                        n_g.reshape(B, S, 3, NSA_HEADS),
                        nsa_cmp_pe[l], nsa_cmp_w1[l], nsa_cmp_w2[l],
                        nsa_q_gain[l], nsa_k_gain[l], rel_bias)
        y_c = sgu_mixer(c_uv, sgu_ln_gain[l], sgu_w[l], sgu_b[l])
        y_d = dsa_mixer(d_q.reshape(B, S, DSA_HEADS, HEAD_DIM), d_k, d_v,
                        d_qi.reshape(B, S, IDX_HEADS, IDX_DIM), d_ki, d_wi,
                        dsa_q_gain[l], dsa_k_gain[l], rel_bias)

        z = jnp.concatenate([y_a, y_b, y_c, y_d], axis=-1).reshape(B, S, N_MIXERS, MIX_W)
        z = jnp.einsum('bsmc,mcd->bsmd', z, w_branch[l].reshape(N_MIXERS, MIX_W, D))
        gates = jax.nn.sigmoid(h @ w_gate[l]).reshape(B, S, N_MIXERS, D)
        merged = jnp.einsum('bsmd,bsmd->bsd', gates, z)
        x = x + merged @ w_out[l]

        x = x + peer_ffn(rmsnorm(x, g_ffn[l]), peer_wq[l], peer_subkeys[l], peer_u[l], peer_v[l])

        x = x + jax.nn.sigmoid(rmsnorm(x, g_ple[l]) @ w_ple_gate[l]) * (p[l] @ w_ple_proj[l])
    return x
```

```cpp
#include <hip/hip_runtime.h>
#include <stdio.h>
#include <stdint.h>
namespace pg8 {
#define PG8_LAS __attribute__((address_space(3)))
typedef unsigned short bf16_t;
typedef short bf16x8 __attribute__((ext_vector_type(8)));
typedef float f32x4 __attribute__((ext_vector_type(4)));
typedef unsigned u32x4 __attribute__((ext_vector_type(4)));
constexpr int BM = 256, BK = 64, HALF = 128, HTB = HALF * BK * 2  , STAGE_BYTES = 8 * HTB, NXCD = 8, WGM = 8;

__host__ __device__ __forceinline__ int lds_byte(int r, int c) { const int st = (r >> 4) * 2 + (c >> 5), rr = r & 15, cc = c & 31, ob = rr * 64 + cc * 2; return st * 1024 + (ob ^ (((ob >> 9) & 1) << 5)); }
__host__ __device__ __forceinline__ void stage_rc(int b, int& R, int& C) { const int st = b / 1024, sb = b % 1024, swz = sb ^ (((sb >> 9) & 1) << 5); R = (st >> 1) * 16 + swz / 64; C = (st & 1) * 32 + (swz % 64) / 2; }
__host__ __device__ __forceinline__ int perm32(int rho) { const int n = rho >> 4, i = rho & 15; return 8 * (i >> 2) + 4 * n + (i & 3); }

struct Unit { int pm, pn; };
struct Gemm { const bf16_t* A; const bf16_t* Bt; int M, N, K; };

struct StaticOrder {
    int nM, nN, nwg, G, c;
    __host__ __device__ void init(int M, int N, int G_, int c_) { nM = M / BM; nN = N / BM; nwg = nM * nN; G = G_; c = c_; }
    __host__ __device__ bool next(int i, Unit& u) const {
        const long L = (long)i * G + c; if (L >= nwg) return false;
        int wgid = (int)L; { const int q = nwg / NXCD, r = nwg % NXCD, xcd = wgid % NXCD, off = wgid / NXCD; wgid = (xcd < r ? xcd * (q + 1) : r * (q + 1) + (xcd - r) * q) + off; }
        const int nig = WGM * nN, gid = wgid / nig, fm = gid * WGM, gsz = (nM - fm) < WGM ? (nM - fm) : WGM;
        u.pm = fm + ((wgid % nig) % gsz); u.pn = (wgid % nig) / gsz; return true;
    }
    __device__ __forceinline__ void a_ready(const Unit&) const {}
    __device__ __forceinline__ void done(const Unit&) const {}
};
__device__ __forceinline__ unsigned cvt_pk_bf16(float lo, float hi) { unsigned r; asm volatile("v_cvt_pk_bf16_f32 %0, %1, %2" : "=v"(r) : "v"(lo), "v"(hi)); return r; }
template <class Epi, class Sched, bool STAMP = false>
__device__ __forceinline__ void gemm_phase(PG8_LAS unsigned char* lds, const Gemm g, const Sched& S, const Epi& E, unsigned long long* stamps) {
    int tid_l = threadIdx.x; asm volatile("" : "+v"(tid_l));
    const int tid = tid_l, wid = __builtin_amdgcn_readfirstlane(tid >> 6), lane = tid & 63, wr = wid >> 2, wc = wid & 3, fr = lane & 15, fq = lane >> 4;
    const int K = g.K, nt = K / BK;
    int ts_lo = 0, ts_hi = 0, nts = 0; const unsigned long long rt_entry = STAMP ? (unsigned long long)wall_clock64() : 0ull;
#define PG8_STAMP() do { if (STAMP && wid == 0 && nts < 64) { const unsigned long long _c = (unsigned long long)clock64(); \
        ts_lo = (lane == nts) ? (int)(unsigned)_c : ts_lo; ts_hi = (lane == nts) ? (int)(unsigned)(_c >> 32) : ts_hi; ++nts; } } while (0)
    PG8_STAMP();
    unsigned voffA[2], voffB[2];
#pragma unroll
    for (int i = 0; i < 2; ++i) { int R, C; stage_rc(tid * 16 + i * 8192, R, C); const int Rb = Epi::PERM ? ((R & ~31) + perm32(R & 31)) : R;
        voffA[i] = (unsigned)(R * K + C) * 2u; voffB[i] = (unsigned)(Rb * K + C) * 2u; }
    const size_t kstep = (size_t)(BK * 2);
    const size_t hstep = (size_t)HALF * K * 2;
    const size_t tstep = 2 * hstep;
    const unsigned ldsw = (unsigned)wid * 1024u;
    const int aoff = lds_byte(wr * 64 + fr, fq * 8), boff = lds_byte(wc * 32 + fr, fq * 8);
#define PG8_SA(b, h) (((b) * 2 + (h)) * HTB)
#define PG8_SB(b, h) ((4 + (b) * 2 + (h)) * HTB)
#define PG8_STAGE(bufoff, gbase, voff) do { _Pragma("unroll") for (int _i = 0; _i < 2; ++_i) \
        __builtin_amdgcn_global_load_lds((const unsigned*)((const char*)(gbase) + (voff)[_i]), (PG8_LAS unsigned*)(lds + (bufoff) + ldsw + _i * 8192), 16, 0, 0); } while (0)
#define PG8_LDA(dst, b, h) do { _Pragma("unroll") for (int m = 0; m < 4; ++m) _Pragma("unroll") for (int k = 0; k < 2; ++k) dst[m][k] = *(const PG8_LAS bf16x8*)(lds + PG8_SA(b, h) + aoff + m * 2048 + k * 1024); } while (0)
#define PG8_LDB(dst, b, h) do { _Pragma("unroll") for (int n = 0; n < 2; ++n) _Pragma("unroll") for (int k = 0; k < 2; ++k) dst[n][k] = *(const PG8_LAS bf16x8*)(lds + PG8_SB(b, h) + boff + n * 2048 + k * 1024); } while (0)
#define PG8_MMA(ai, bj, At, Bt) do { __builtin_amdgcn_s_setprio(1); _Pragma("unroll") for (int m = 0; m < 4; ++m) _Pragma("unroll") for (int n = 0; n < 2; ++n) _Pragma("unroll") for (int k = 0; k < 2; ++k) \
        acc[ai][bj][m][n] = __builtin_amdgcn_mfma_f32_16x16x32_bf16(Bt[n][k], At[m][k], acc[ai][bj][m][n], 0, 0, 0); __builtin_amdgcn_s_setprio(0); } while (0)
#define PG8_WAIT_V(n) asm volatile("s_waitcnt vmcnt(" #n ")" ::: "memory")
#define PG8_WAIT_L(n) asm volatile("s_waitcnt lgkmcnt(" #n ")" ::: "memory")
#define PG8_BAR __builtin_amdgcn_s_barrier()
#define PG8_SCHED __builtin_amdgcn_sched_barrier(0)
    Unit cur, nxt; int ui = 0;
    if (!S.next(0, cur)) return;
    f32x4 acc[2][2][4][2];
#pragma unroll
    for (int a = 0; a < 2; ++a)
#pragma unroll
        for (int b = 0; b < 2; ++b)
#pragma unroll
            for (int m = 0; m < 4; ++m)
#pragma unroll
                for (int n = 0; n < 2; ++n) acc[a][b][m][n] = (f32x4){0.f, 0.f, 0.f, 0.f};
    bf16x8 At[4][2], B0[2][2], B1[2][2];
    const char* cA = (const char*)g.A + (size_t)cur.pm * tstep; const char* cB = (const char*)g.Bt + (size_t)cur.pn * tstep;
    S.a_ready(cur);
    PG8_STAGE(PG8_SB(0, 0), cB, voffB); PG8_STAGE(PG8_SA(0, 0), cA, voffA); PG8_STAGE(PG8_SB(0, 1), cB + hstep, voffB); PG8_STAGE(PG8_SA(0, 1), cA + hstep, voffA);
    if (wr == 1) PG8_BAR;
    PG8_WAIT_V(4); PG8_BAR;
    PG8_STAGE(PG8_SB(1, 0), cB + kstep, voffB); PG8_STAGE(PG8_SA(1, 0), cA + kstep, voffA); PG8_STAGE(PG8_SB(1, 1), cB + hstep + kstep, voffB);
    PG8_WAIT_V(6); PG8_BAR;
    PG8_STAMP();
    for (;;) {
        const bool has_next = S.next(ui + 1, nxt);
        const char* nA = has_next ? (const char*)g.A + (size_t)nxt.pm * tstep : cA; const char* nB = has_next ? (const char*)g.Bt + (size_t)nxt.pn * tstep : cB;
        for (int t = 0; t < nt; t += 2) {
            const bool last = (t == nt - 2);
            const char* a1 = cA + (size_t)(t + 1) * kstep;
            const char* a2 = last ? nA : cA + (size_t)(t + 2) * kstep; const char* b2 = last ? nB : cB + (size_t)(t + 2) * kstep;
            const char* a3 = a2 + kstep; const char* b3 = b2 + kstep;
            if (last && has_next) S.a_ready(nxt);
            PG8_LDB(B0, 0, 0); PG8_SCHED; PG8_LDA(At, 0, 0); PG8_STAGE(PG8_SA(1, 1), a1 + hstep, voffA);
            PG8_WAIT_L(8); PG8_BAR; PG8_WAIT_L(0); PG8_MMA(0, 0, At, B0); PG8_BAR; PG8_SCHED;
            PG8_LDB(B1, 0, 1); PG8_STAGE(PG8_SB(0, 0), b2, voffB);
            PG8_BAR; PG8_WAIT_L(0); PG8_MMA(0, 1, At, B1); PG8_BAR;
            PG8_LDA(At, 0, 1); PG8_STAGE(PG8_SA(0, 0), a2, voffA);
            PG8_BAR; PG8_WAIT_L(0); PG8_MMA(1, 0, At, B0); PG8_BAR; PG8_SCHED;
            PG8_STAGE(PG8_SB(0, 1), b2 + hstep, voffB);
            PG8_WAIT_V(6); PG8_BAR; PG8_MMA(1, 1, At, B1); PG8_BAR;
            PG8_LDB(B0, 1, 0); PG8_SCHED; PG8_LDA(At, 1, 0); PG8_STAGE(PG8_SA(0, 1), a2 + hstep, voffA);
            PG8_WAIT_L(8); PG8_BAR; PG8_WAIT_L(0); PG8_MMA(0, 0, At, B0); PG8_BAR; PG8_SCHED;
            PG8_LDB(B1, 1, 1); PG8_STAGE(PG8_SB(1, 0), b3, voffB);
            PG8_BAR; PG8_WAIT_L(0); PG8_MMA(0, 1, At, B1); PG8_BAR;
            PG8_LDA(At, 1, 1); PG8_STAGE(PG8_SA(1, 0), a3, voffA);
            PG8_BAR; PG8_WAIT_L(0); PG8_MMA(1, 0, At, B0); PG8_BAR; PG8_SCHED;
            PG8_STAGE(PG8_SB(1, 1), b3 + hstep, voffB);
            PG8_WAIT_V(6); PG8_BAR; PG8_MMA(1, 1, At, B1); PG8_BAR;
        }
        PG8_STAMP();
        if constexpr (!Epi::AFTER_DRAIN) { E(acc, cur, wr, wc, fr, fq); S.done(cur); }
        PG8_STAMP();
        if (!has_next) break;
#pragma unroll
        for (int a = 0; a < 2; ++a)
#pragma unroll
            for (int b = 0; b < 2; ++b)
#pragma unroll
                for (int m = 0; m < 4; ++m)
#pragma unroll
                    for (int n = 0; n < 2; ++n) acc[a][b][m][n] = (f32x4){0.f, 0.f, 0.f, 0.f};
        cur = nxt; cA = nA; cB = nB; ++ui;
    }
    PG8_WAIT_V(0);
    if (wr == 0) PG8_BAR;
    PG8_BAR;
    if constexpr (Epi::AFTER_DRAIN) { E.fused(acc, cur, wr, wc, fr, fq, lds, wid, lane); S.done(cur); }
    PG8_STAMP();
    if (STAMP && wid == 0) { stamps[lane] = lane < nts ? (((unsigned long long)(unsigned)ts_hi << 32) | (unsigned)ts_lo) : 0ull;
        if (lane == 62) stamps[62] = rt_entry; if (lane == 63) stamps[63] = (unsigned long long)wall_clock64(); }
#undef PG8_STAMP
#undef PG8_SA
#undef PG8_SB
#undef PG8_STAGE
#undef PG8_LDA
#undef PG8_LDB
#undef PG8_MMA
#undef PG8_WAIT_V
#undef PG8_WAIT_L
#undef PG8_BAR
#undef PG8_SCHED
}
}
#define XB_TMO      128
#define XB_XCNT(j)  (256  + 64 * (j))
#define XB_XSUB(j)  (1280 + 64 * (j))
#define XB_XGEN(j)  (2304 + 64 * (j))
#define XB_TOP      3328
#define XB_TOPGEN   3392
#define XCD_BAR_WORDS 3456
#define XB_SPIN_CAP (1u << 18)
#define LAS __attribute__((address_space(3)))

__device__ __forceinline__ unsigned xb_ld(unsigned* p)              { return __hip_atomic_load(p, __ATOMIC_RELAXED, __HIP_MEMORY_SCOPE_AGENT); }
__device__ __forceinline__ unsigned xb_add(unsigned* p, unsigned v) { return __hip_atomic_fetch_add(p, v, __ATOMIC_RELAXED, __HIP_MEMORY_SCOPE_AGENT); }
__device__ __forceinline__ unsigned xb_xcc_id() { return (unsigned)__builtin_amdgcn_s_getreg((3 << 11) | 20) & 0xFu; }
#define XB_SPIN(cond, bar) do { unsigned _sp = 0; while (cond) { __builtin_amdgcn_s_sleep(1); \
    if ((++_sp & 255u) == 0u) { if (xb_ld(&(bar)[XB_TMO])) break; if (_sp > XB_SPIN_CAP) { atomicAdd(&(bar)[XB_TMO], 1u); break; } } } } while (0)

struct XcdBarrier {
    unsigned* bar; unsigned x;
    volatile LAS unsigned* st;
};

__device__ __forceinline__ XcdBarrier xcd_barrier_post(unsigned* bar, volatile LAS unsigned* st) {
    XcdBarrier b; b.bar = bar; b.x = xb_xcc_id(); b.st = st;
    if (threadIdx.x == 0) (void)xb_add(&bar[XB_XCNT(b.x)], 1u);
    return b;
}
__device__ __forceinline__ void xcd_barrier_complete(unsigned* bar, unsigned x, unsigned& nloc, unsigned& nx) {
    const unsigned G = gridDim.x * gridDim.y * gridDim.z;
    unsigned sum, cnt, mine, sp = 0u;
    for (;;) {
        sum = 0u; cnt = 0u; mine = 0u;
#pragma unroll
        for (unsigned j = 0; j < 16; ++j) { const unsigned c = xb_ld(&bar[XB_XCNT(j)]); sum += c; cnt += (c > 0u) ? 1u : 0u; mine = (j == x) ? c : mine; }
        if (sum == G) break;
        __builtin_amdgcn_s_sleep(1);
        if ((++sp & 255u) == 0u) { if (xb_ld(&bar[XB_TMO])) break; if (sp > XB_SPIN_CAP) { atomicAdd(&bar[XB_TMO], 1u); break; } }
    }
    nloc = mine > 0u ? mine : 1u; nx = cnt > 0u ? cnt : 1u;
}

__device__ __forceinline__ void xcd_barrier(const XcdBarrier& b) {
    asm volatile("s_waitcnt vmcnt(0)" ::: "memory");
    __syncthreads();
    if (threadIdx.x == 0) {
        unsigned* bar = b.bar;
        __builtin_amdgcn_s_waitcnt(0);
        unsigned nloc = b.st[0], nx = b.st[1];
        if (nloc == 0u) { xcd_barrier_complete(bar, b.x, nloc, nx); b.st[0] = nloc; b.st[1] = nx; }
        const unsigned old = xb_add(&bar[XB_XSUB(b.x)], 1u);
        const unsigned gen = old / nloc;
        if (old + 1u == (gen + 1u) * nloc) {
            __builtin_amdgcn_fence(__ATOMIC_RELEASE, "agent");
            asm volatile("s_waitcnt vmcnt(0)" ::: "memory");
            const unsigned og = xb_add(&bar[XB_TOP], 1u);
            const unsigned tg = og / nx;
            if (og + 1u == (tg + 1u) * nx) xb_add(&bar[XB_TOPGEN], 1u);
            else XB_SPIN(xb_ld(&bar[XB_TOPGEN]) == tg, bar);
            __builtin_amdgcn_fence(__ATOMIC_ACQUIRE, "agent");
            xb_add(&bar[XB_XGEN(b.x)], 1u);
            asm volatile("s_waitcnt vmcnt(0)" ::: "memory");
        } else {
            XB_SPIN(xb_ld(&bar[XB_XGEN(b.x)]) == gen, bar);
            __builtin_amdgcn_fence(__ATOMIC_ACQUIRE, "agent");
            asm volatile("s_waitcnt vmcnt(0)" ::: "memory");
        }
    }
    __syncthreads();
}

namespace mk {
using pg8::bf16_t; using pg8::bf16x8; using pg8::f32x4; using pg8::u32x4;
typedef unsigned u32x2 __attribute__((ext_vector_type(2)));
typedef short s16x4 __attribute__((ext_vector_type(4)));
#define DI __device__ __forceinline__
#define LDS_WAIT() asm volatile("s_waitcnt lgkmcnt(0)" ::: "memory")
#define MFMA16(a, b, c) __builtin_amdgcn_mfma_f32_16x16x32_bf16((a), (b), (c), 0, 0, 0)

constexpr int T = 32768, SEQ = 4096, NLAYER = 4, NPH = 13;
constexpr int PW = 5120;
constexpr int C_AB = 0, C_AC = 512, C_AX = 1024, C_NQ = 1536, C_NKV = 2048, C_UV = 2816, C_DQ = 3840, C_DK = 4352, C_DV = 4416,
              C_DQI = 4480, C_DKI = 4992, C_NG = 5056, C_DWI = 5080;
constexpr size_t MiB = 1u << 20;
constexpr size_t WS_CTL = 0, WS_PEB = 1 * MiB, WS_CMPK = 2 * MiB, WS_CMPV = 3 * MiB, WS_SK = 4 * MiB, WS_SGUW = 5 * MiB, WS_CMPA = 8 * MiB,
                 WS_CMPP = 24 * MiB, WS_WCAT = 40 * MiB, WS_WBR = 58 * MiB, WS_WOUT4 = 62 * MiB, WS_WQ = 70 * MiB, WS_WPG = 72 * MiB,
                 WS_WPP = 74 * MiB, WS_W1C = 75 * MiB, WS_PB = 78 * MiB, WS_PTU = 96 * MiB, WS_PTV = 128 * MiB, WS_H = 160 * MiB,
                 WS_Y = 224 * MiB, WS_PROJ = 352 * MiB, WS_GATES = 672 * MiB, WS_END = 928 * MiB;
constexpr size_t WS_GZ = WS_PROJ, WS_QP = WS_PROJ, WS_PP = WS_PROJ + 64 * MiB, WS_EIDX = WS_PROJ + 128 * MiB, WS_EW = WS_PROJ + 144 * MiB;
constexpr int LDS_BYTES = 163840, LDS_PERWAVE = 17920, LDS_BUCK = 8 * LDS_PERWAVE, LDS_TBL = LDS_BUCK + 4096, LDS_XB = LDS_BYTES - 64;

struct Params { const float* in[27]; float* out; unsigned char* ws; int ph_lo, ph_hi; };
enum { I_X = 0, I_P, I_REL, I_GMIX, I_WIN, I_CONVW, I_PE, I_CW1, I_CW2, I_NQG, I_NKG, I_LNG, I_SGUW, I_SGUB, I_DQG, I_DKG, I_WGATE, I_WBR, I_WOUT,
       I_GFFN, I_WQ, I_SUBK, I_PU, I_PV, I_GPLE, I_WPG, I_WPP };

struct Frame { LAS unsigned char* lds; int tid, lane, wave, vb, G; };

DI float bf2f(unsigned short b) { return __uint_as_float(((unsigned)b) << 16); }
DI unsigned f2bf(float f) { unsigned u = __float_as_uint(f); return (u + 0x7fffu + ((u >> 16) & 1u)) >> 16; }
DI unsigned pk2(float lo, float hi) { return f2bf(lo) | (f2bf(hi) << 16); }
DI float lo16(unsigned w) { return __uint_as_float(w << 16); }
DI float hi16(unsigned w) { return __uint_as_float(w & 0xffff0000u); }
DI float sigm(float x) { return 1.f / (1.f + __expf(-x)); }
DI float gelu_t(float x) { const float y = 0.7978845608f * (x + 0.044715f * x * x * x); return x / (1.f + __expf(-2.f * y)); }
DI float wave_sum(float v) {
#pragma unroll
    for (int o = 1; o < 64; o <<= 1) v += __shfl_xor(v, o);
    return v; }
DI float wave_max(float v) {
#pragma unroll
    for (int o = 1; o < 64; o <<= 1) v = fmaxf(v, __shfl_xor(v, o));
    return v; }
DI unsigned ordf(float f) { const unsigned u = __float_as_uint(f); return (u & 0x80000000u) ? ~u : (u | 0x80000000u); }
DI float unordf(unsigned x) { return __uint_as_float((x & 0x80000000u) ? (x & 0x7fffffffu) : ~x); }
DI int bucket_of(int n) {
    if (n < 16) return n;
    int b = 16;
    b += (n >= 21); b += (n >= 27); b += (n >= 35); b += (n >= 46); b += (n >= 59); b += (n >= 77); b += (n >= 99); b += (n >= 128);
    b += (n >= 166); b += (n >= 216); b += (n >= 280); b += (n >= 363); b += (n >= 470); b += (n >= 609); b += (n >= 790);
    return b; }

DI int srccol(int n) { return n < 2816 ? n : (n < 5056 ? n + 24 : (n < 5080 ? n - 2240 : (n < 5088 ? n : -1))); }
DI void tr_item(const float* W, int ldw, bf16_t* WT, int ldwt, int k0, int n0, LAS float* scr, int lane, bool remap, int ncopy, int cstride) {
#pragma unroll 8
    for (int i = 0; i < 32; ++i) { const int kk = 2 * i + (lane >> 5), nl = lane & 31; const int n = n0 + nl; const int src = remap ? srccol(n) : n;
        scr[kk * 33 + nl] = src >= 0 ? W[(size_t)(k0 + kk) * ldw + src] : 0.f; }
    LDS_WAIT();
    const int c = lane & 7;
#pragma unroll
    for (int j = 0; j < 4; ++j) { const int n = (lane >> 3) + 8 * j; const LAS float* s = scr + (8 * c) * 33 + n;
        u32x4 o; o.x = pk2(s[0], s[33]); o.y = pk2(s[66], s[99]); o.z = pk2(s[132], s[165]); o.w = pk2(s[198], s[231]);
        for (int cp = 0; cp < ncopy; ++cp) *(u32x4*)(WT + (size_t)(n0 + n) * ldwt + (size_t)cp * cstride + k0 + 8 * c) = o; }
    LDS_WAIT();
}
DI void cvt_rows(const float* src, bf16_t* dst, size_t ngroups8, int gw, int NGW, int lane) {
    for (size_t i = (size_t)gw * 64 + lane; i < ngroups8; i += (size_t)NGW * 64) {
        const f32x4 a = ((const f32x4*)src)[2 * i], b = ((const f32x4*)src)[2 * i + 1];
        u32x4 o; o.x = pk2(a.x, a.y); o.y = pk2(a.z, a.w); o.z = pk2(b.x, b.y); o.w = pk2(b.z, b.w);
        ((u32x4*)dst)[i] = o; }
}
DI void rmsnorm_rows(const float* x, const float* g, bf16_t* H, int gw, int NGW, int lane) {
    const f32x4 g0 = *(const f32x4*)(g + lane * 8), g1 = *(const f32x4*)(g + lane * 8 + 4), g2 = *(const f32x4*)(g + 512 + lane * 8), g3 = *(const f32x4*)(g + 512 + lane * 8 + 4);
    for (int m = gw; m < T; m += NGW) {
        const float* xr = x + (size_t)m * 1024 + lane * 8;
        const f32x4 a = *(const f32x4*)xr, b = *(const f32x4*)(xr + 4), c = *(const f32x4*)(xr + 512), d = *(const f32x4*)(xr + 516);
        float ss = a.x * a.x + a.y * a.y + a.z * a.z + a.w * a.w + b.x * b.x + b.y * b.y + b.z * b.z + b.w * b.w
                 + c.x * c.x + c.y * c.y + c.z * c.z + c.w * c.w + d.x * d.x + d.y * d.y + d.z * d.z + d.w * d.w;
        ss = wave_sum(ss);
        const float r = rsqrtf(ss * (1.f / 1024.f) + 1e-6f);
        u32x4 o0, o1;
        o0.x = pk2(a.x * r * g0.x, a.y * r * g0.y); o0.y = pk2(a.z * r * g0.z, a.w * r * g0.w); o0.z = pk2(b.x * r * g1.x, b.y * r * g1.y); o0.w = pk2(b.z * r * g1.z, b.w * r * g1.w);
        o1.x = pk2(c.x * r * g2.x, c.y * r * g2.y); o1.y = pk2(c.z * r * g2.z, c.w * r * g2.w); o1.z = pk2(d.x * r * g3.x, d.y * r * g3.y); o1.w = pk2(d.z * r * g3.z, d.w * r * g3.w);
        bf16_t* hr = H + (size_t)m * 1024 + lane * 8;
        *(u32x4*)hr = o0; *(u32x4*)(hr + 512) = o1;
    }
}
DI void phase_prep_w(const Params& p, int l, const Frame& F) {
    LAS float* scr = (LAS float*)(F.lds + F.wave * 8448);
    const int gw = F.vb * 8 + F.wave, NGW = F.G * 8, lane = F.lane;
    unsigned char* ws = p.ws;
    bf16_t* WCAT = (bf16_t*)(ws + WS_WCAT); bf16_t* WBR = (bf16_t*)(ws + WS_WBR); bf16_t* WOUT4 = (bf16_t*)(ws + WS_WOUT4); bf16_t* WQ = (bf16_t*)(ws + WS_WQ);
    bf16_t* WPG = (bf16_t*)(ws + WS_WPG); bf16_t* WPP = (bf16_t*)(ws + WS_WPP); bf16_t* W1C = (bf16_t*)(ws + WS_W1C);
    constexpr int I0 = 2560, I1 = 2048, I2 = 1024, I3 = 512, I4 = 512, I5 = 512, I6 = 128, I7 = 512, NIT = I0 + I1 + I2 + I3 + I4 + I5 + I6 + I7;
    for (int it = gw; it < NIT; it += NGW) {
        int r = it;
        if (r < I0) { tr_item(p.in[I_WIN] + (size_t)l * 1024 * 5088, 5088, WCAT, 1024, (r / 160) * 64, (r % 160) * 32, scr, lane, true, 1, 0); continue; } r -= I0;
        if (r < I1) { tr_item(p.in[I_WGATE] + (size_t)l * 1024 * 4096, 4096, WCAT + (size_t)5120 * 1024, 1024, (r / 128) * 64, (r % 128) * 32, scr, lane, false, 1, 0); continue; } r -= I1;
        if (r < I2) { const int m = r >> 8, rr = r & 255; tr_item(p.in[I_WBR] + ((size_t)l * 2048 + m * 512) * 1024, 1024, WBR + (size_t)m * 1024 * 512, 512, (rr / 32) * 64, (rr % 32) * 32, scr, lane, false, 1, 0); continue; } r -= I2;
        if (r < I3) { tr_item(p.in[I_WOUT] + (size_t)l * 1024 * 1024, 1024, WOUT4, 4096, (r / 32) * 64, (r % 32) * 32, scr, lane, false, 4, 1024); continue; } r -= I3;
        if (r < I4) { tr_item(p.in[I_WQ] + (size_t)l * 1024 * 1024, 1024, WQ, 1024, (r / 32) * 64, (r % 32) * 32, scr, lane, false, 1, 0); continue; } r -= I4;
        if (r < I5) { tr_item(p.in[I_WPG] + (size_t)l * 1024 * 1024, 1024, WPG, 1024, (r / 32) * 64, (r % 32) * 32, scr, lane, false, 1, 0); continue; } r -= I5;
        if (r < I6) { tr_item(p.in[I_WPP] + (size_t)l * 256 * 1024, 1024, WPP, 256, (r / 32) * 64, (r % 32) * 32, scr, lane, false, 1, 0); continue; } r -= I6;
        { const int jh = r >> 7, rr = r & 127, j = jh >> 1, half = jh & 1;
          tr_item(p.in[I_CW1] + (((size_t)l * 2 + j) * 2048 + half * 1024) * 256, 256, W1C + ((size_t)j * 512 + half * 256) * 1024, 1024, (rr / 8) * 64, (rr % 8) * 32, scr, lane, false, 1, 0); }
    }
    cvt_rows(p.in[I_PU] + (size_t)l * 16384 * 1024, (bf16_t*)(ws + WS_PTU), (size_t)16384 * 1024 / 8, gw, NGW, lane);
    cvt_rows(p.in[I_PV] + (size_t)l * 16384 * 1024, (bf16_t*)(ws + WS_PTV), (size_t)16384 * 1024 / 8, gw, NGW, lane);
    cvt_rows(p.in[I_SUBK] + (size_t)l * 131072, (bf16_t*)(ws + WS_SK), 131072 / 8, gw, NGW, lane);
    cvt_rows(p.in[I_P] + (size_t)l * T * 256, (bf16_t*)(ws + WS_PB), (size_t)T * 256 / 8, gw, NGW, lane);
    { const float* sw = p.in[I_SGUW] + (size_t)l * 131072; bf16_t* dst = (bf16_t*)(ws + WS_SGUW);
      for (int i = gw * 64 + lane; i < 131072 / 8; i += NGW * 64) { const int e = i * 8, t = (e >> 7) & 127, s0 = e & 127; float v[8];
#pragma unroll
          for (int k = 0; k < 8; ++k) v[k] = (s0 + k <= t) ? sw[e + k] : 0.f;
          u32x4 o; o.x = pk2(v[0], v[1]); o.y = pk2(v[2], v[3]); o.z = pk2(v[4], v[5]); o.w = pk2(v[6], v[7]); ((u32x4*)dst)[i] = o; } }
    { float* peb = (float*)(ws + WS_PEB);
      for (int o = gw; o < 512; o += NGW) { const int j = o >> 8, n = o & 255; const float* pe = p.in[I_PE] + ((size_t)l * 2 + j) * 2048; const float* w1 = p.in[I_CW1] + ((size_t)l * 2 + j) * 2048 * 256;
          float s = 0.f; for (int k = lane; k < 2048; k += 64) s += pe[k] * w1[(size_t)k * 256 + n];
          s = wave_sum(s); if (lane == 0) peb[o] = s; } }
    rmsnorm_rows(l == 0 ? p.in[I_X] : p.out, p.in[I_GMIX] + l * 1024, (bf16_t*)(ws + WS_H), gw, NGW, lane);
}

struct Epi1 {
    static constexpr bool PERM = true, AFTER_DRAIN = false;
    bf16_t* proj; bf16_t* gates;
    DI void operator()(const f32x4 (&acc)[2][2][4][2], const pg8::Unit& u, int wr, int wc, int fr, int fq) const {
        const int row0 = u.pm * 256 + wr * 64 + fr; const bool isg = u.pn >= 20;
        const int col0 = (isg ? (u.pn - 20) * 256 : u.pn * 256) + wc * 32 + 8 * fq; bf16_t* base = isg ? gates : proj; const int ldc = isg ? 4096 : PW;
#pragma unroll
        for (int ai = 0; ai < 2; ++ai)
#pragma unroll
            for (int m = 0; m < 4; ++m) { bf16_t* rowp = base + (size_t)(row0 + ai * 128 + m * 16) * ldc + col0;
#pragma unroll
                for (int bj = 0; bj < 2; ++bj) { f32x4 v0 = acc[ai][bj][m][0], v1 = acc[ai][bj][m][1];
                    if (isg) { v0.x = sigm(v0.x); v0.y = sigm(v0.y); v0.z = sigm(v0.z); v0.w = sigm(v0.w); v1.x = sigm(v1.x); v1.y = sigm(v1.y); v1.z = sigm(v1.z); v1.w = sigm(v1.w); }
                    u32x4 w; w.x = pk2(v0.x, v0.y); w.y = pk2(v0.z, v0.w); w.z = pk2(v1.x, v1.y); w.w = pk2(v1.z, v1.w);
                    *(u32x4*)(rowp + bj * 128) = w; } }
    }
};
struct EpiBf {
    static constexpr bool PERM = true, AFTER_DRAIN = false;
    bf16_t* O; int ldc;
    DI void operator()(const f32x4 (&acc)[2][2][4][2], const pg8::Unit& u, int wr, int wc, int fr, int fq) const {
        const int row0 = u.pm * 256 + wr * 64 + fr, col0 = u.pn * 256 + wc * 32 + 8 * fq;
#pragma unroll
        for (int ai = 0; ai < 2; ++ai)
#pragma unroll
            for (int m = 0; m < 4; ++m) { bf16_t* rowp = O + (size_t)(row0 + ai * 128 + m * 16) * ldc + col0;
#pragma unroll
                for (int bj = 0; bj < 2; ++bj) { const f32x4 v0 = acc[ai][bj][m][0], v1 = acc[ai][bj][m][1];
                    u32x4 w; w.x = pk2(v0.x, v0.y); w.y = pk2(v0.z, v0.w); w.z = pk2(v1.x, v1.y); w.w = pk2(v1.z, v1.w);
                    *(u32x4*)(rowp + bj * 128) = w; } }
    }
};
struct EpiF32P {
    static constexpr bool PERM = true, AFTER_DRAIN = false;
    float* C; int ldc;
    DI void operator()(const f32x4 (&acc)[2][2][4][2], const pg8::Unit& u, int wr, int wc, int fr, int fq) const {
        const int row0 = u.pm * 256 + wr * 64 + fr, col0 = u.pn * 256 + wc * 32 + 8 * fq;
#pragma unroll
        for (int ai = 0; ai < 2; ++ai)
#pragma unroll
            for (int m = 0; m < 4; ++m) { float* rowp = C + (size_t)(row0 + ai * 128 + m * 16) * ldc + col0;
#pragma unroll
                for (int bj = 0; bj < 2; ++bj) { *(f32x4*)(rowp + bj * 128) = acc[ai][bj][m][0]; *(f32x4*)(rowp + bj * 128 + 4) = acc[ai][bj][m][1]; } }
    }
};
struct BranchOrder {
    int G, c;
    DI bool next(int i, pg8::Unit& u) const { const int Lx = i * G + c; if (Lx >= 2048) return false; const int m = Lx >> 9, r = Lx & 511; u.pm = m * 128 + (r >> 2); u.pn = m * 4 + (r & 3); return true; }
    DI void a_ready(const pg8::Unit&) const {}
    DI void done(const pg8::Unit&) const {}
};
struct EpiBranch {
    static constexpr bool PERM = true, AFTER_DRAIN = false;
    const bf16_t* gates; bf16_t* gz;
    DI void operator()(const f32x4 (&acc)[2][2][4][2], const pg8::Unit& u, int wr, int wc, int fr, int fq) const {
        const int row0 = (u.pm & 127) * 256 + wr * 64 + fr, col0 = u.pn * 256 + wc * 32 + 8 * fq;
#pragma unroll
        for (int ai = 0; ai < 2; ++ai)
#pragma unroll
            for (int m = 0; m < 4; ++m) { const size_t off = (size_t)(row0 + ai * 128 + m * 16) * 4096 + col0;
#pragma unroll
                for (int bj = 0; bj < 2; ++bj) { const f32x4 v0 = acc[ai][bj][m][0], v1 = acc[ai][bj][m][1]; const u32x4 g = *(const u32x4*)(gates + off + bj * 128);
                    u32x4 w; w.x = pk2(v0.x * lo16(g.x), v0.y * hi16(g.x)); w.y = pk2(v0.z * lo16(g.y), v0.w * hi16(g.y)); w.z = pk2(v1.x * lo16(g.z), v1.y * hi16(g.z)); w.w = pk2(v1.z * lo16(g.w), v1.w * hi16(g.w));
                    *(u32x4*)(gz + off + bj * 128) = w; } }
    }
};
struct EpiRes {
    static constexpr bool PERM = true, AFTER_DRAIN = false;
    const float* xin; float* out;
    DI void operator()(const f32x4 (&acc)[2][2][4][2], const pg8::Unit& u, int wr, int wc, int fr, int fq) const {
        const int row0 = u.pm * 256 + wr * 64 + fr, col0 = u.pn * 256 + wc * 32 + 8 * fq;
#pragma unroll
        for (int ai = 0; ai < 2; ++ai)
#pragma unroll
            for (int m = 0; m < 4; ++m) { const size_t off = (size_t)(row0 + ai * 128 + m * 16) * 1024 + col0;
#pragma unroll
                for (int bj = 0; bj < 2; ++bj) { const f32x4 x0 = *(const f32x4*)(xin + off + bj * 128), x1 = *(const f32x4*)(xin + off + bj * 128 + 4);
                    *(f32x4*)(out + off + bj * 128) = x0 + acc[ai][bj][m][0]; *(f32x4*)(out + off + bj * 128 + 4) = x1 + acc[ai][bj][m][1]; } }
    }
};
struct EpiPle {
    static constexpr bool PERM = true, AFTER_DRAIN = false;
    float* x; const bf16_t* pp;
    DI void operator()(const f32x4 (&acc)[2][2][4][2], const pg8::Unit& u, int wr, int wc, int fr, int fq) const {
        const int row0 = u.pm * 256 + wr * 64 + fr, col0 = u.pn * 256 + wc * 32 + 8 * fq;
#pragma unroll
        for (int ai = 0; ai < 2; ++ai)
#pragma unroll
            for (int m = 0; m < 4; ++m) { const size_t off = (size_t)(row0 + ai * 128 + m * 16) * 1024 + col0;
#pragma unroll
                for (int bj = 0; bj < 2; ++bj) { const f32x4 v0 = acc[ai][bj][m][0], v1 = acc[ai][bj][m][1]; const u32x4 g = *(const u32x4*)(pp + off + bj * 128);
                    f32x4 x0 = *(const f32x4*)(x + off + bj * 128), x1 = *(const f32x4*)(x + off + bj * 128 + 4);
                    x0.x += sigm(v0.x) * lo16(g.x); x0.y += sigm(v0.y) * hi16(g.x); x0.z += sigm(v0.z) * lo16(g.y); x0.w += sigm(v0.w) * hi16(g.y);
                    x1.x += sigm(v1.x) * lo16(g.z); x1.y += sigm(v1.y) * hi16(g.z); x1.z += sigm(v1.z) * lo16(g.w); x1.w += sigm(v1.w) * hi16(g.w);
                    *(f32x4*)(x + off + bj * 128) = x0; *(f32x4*)(x + off + bj * 128 + 4) = x1; } }
    }
};

DI void unpack8(const u32x4 w, float (&f)[8]) { f[0] = lo16(w.x); f[1] = hi16(w.x); f[2] = lo16(w.y); f[3] = hi16(w.y); f[4] = lo16(w.z); f[5] = hi16(w.z); f[6] = lo16(w.w); f[7] = hi16(w.w); }
DI u32x4 pack8(const float (&f)[8]) { u32x4 o; o.x = pk2(f[0], f[1]); o.y = pk2(f[2], f[3]); o.z = pk2(f[4], f[5]); o.w = pk2(f[6], f[7]); return o; }
DI void load8f(const float* p, float (&f)[8]) { const f32x4 a = *(const f32x4*)p, b = *(const f32x4*)(p + 4); f[0] = a.x; f[1] = a.y; f[2] = a.z; f[3] = a.w; f[4] = b.x; f[5] = b.y; f[6] = b.z; f[7] = b.w; }

DI void phase_chunk(const Params& p, int l, const Frame& F) {
    unsigned char* ws = p.ws; const int lane = F.lane, wave = F.wave;
    bf16_t* PROJ = (bf16_t*)(ws + WS_PROJ); bf16_t* YA = (bf16_t*)(ws + WS_Y); bf16_t* YC = YA + (size_t)2 * T * 512; bf16_t* CMPA = (bf16_t*)(ws + WS_CMPA);
    const bf16_t* SGUW = (const bf16_t*)(ws + WS_SGUW);
    LAS unsigned char* vnT = F.lds;
    const float* convw = p.in[I_CONVW] + (size_t)l * 3 * 512; const float* lng = p.in[I_LNG] + (size_t)l * 512; const float* sgub = p.in[I_SGUB] + (size_t)l * 8 * 128;
    for (int chunk = F.vb; chunk < T / 128; chunk += F.G) {
        const int t0 = chunk * 128;
        for (int tt = wave; tt < 128; tt += 8) {
            const int t = t0 + tt, s = t & (SEQ - 1), b = t >> 12;
            bf16_t* row = PROJ + (size_t)t * PW;
            {
                const int c0 = lane * 8; float ab[8], c0v[8], x0v[8], c1v[8], x1v[8], c2v[8], x2v[8], w0[8], w1[8], w2[8], y[8];
                unpack8(*(const u32x4*)(row + C_AB + c0), ab); unpack8(*(const u32x4*)(row + C_AC + c0), c0v); unpack8(*(const u32x4*)(row + C_AX + c0), x0v);
                u32x4 z; z.x = 0; z.y = 0; z.z = 0; z.w = 0; u32x4 r1c = z, r1x = z, r2c = z, r2x = z;
                if (s >= 1) { r1c = *(const u32x4*)(row - PW + C_AC + c0); r1x = *(const u32x4*)(row - PW + C_AX + c0); }
                if (s >= 2) { r2c = *(const u32x4*)(row - 2 * PW + C_AC + c0); r2x = *(const u32x4*)(row - 2 * PW + C_AX + c0); }
                unpack8(r1c, c1v); unpack8(r1x, x1v); unpack8(r2c, c2v); unpack8(r2x, x2v);
                load8f(convw + c0, w0); load8f(convw + 512 + c0, w1); load8f(convw + 1024 + c0, w2);
#pragma unroll
                for (int e = 0; e < 8; ++e) y[e] = ab[e] * (w2[e] * c0v[e] * x0v[e] + w1[e] * c1v[e] * x1v[e] + w0[e] * c2v[e] * x2v[e]);
                *(u32x4*)(YA + (size_t)t * 512 + c0) = pack8(y);
            }
#pragma unroll
            for (int pass = 0; pass < 3; ++pass) {
                const int seg = pass * 8 + (lane >> 3), part = lane & 7, sg = seg < 20 ? seg : 20;
                int col; const float* gp; float sc = 1.f;
                if (sg < 8) { col = C_NQ + 64 * sg; gp = p.in[I_NQG] + l * 64; sc = 0.125f; }
                else if (sg < 10) { col = C_NKV + 2 * 128 + (sg - 8) * 64; gp = p.in[I_NKG] + (l * 3 + 1) * 64; }
                else if (sg < 12) { col = C_NKV + 4 * 128 + (sg - 10) * 64; gp = p.in[I_NKG] + (l * 3 + 2) * 64; }
                else if (sg < 20) { col = C_DQ + 64 * (sg - 12); gp = p.in[I_DQG] + l * 64; sc = 0.125f; }
                else { col = C_DK; gp = p.in[I_DKG] + l * 64; }
                float v[8], g[8]; unpack8(*(const u32x4*)(row + col + part * 8), v); load8f(gp + part * 8, g);
                float ss = 0.f;
#pragma unroll
                for (int e = 0; e < 8; ++e) ss += v[e] * v[e];
                ss += __shfl_xor(ss, 1); ss += __shfl_xor(ss, 2); ss += __shfl_xor(ss, 4);
                const float r = rsqrtf(ss * (1.f / 64.f) + 1e-6f) * sc;
#pragma unroll
                for (int e = 0; e < 8; ++e) v[e] = v[e] * r * g[e];
                if (seg < 21) *(u32x4*)(row + col + part * 8) = pack8(v);
            }
            if (lane < 32) { const int jg = lane >> 3, j = jg >> 1, g = jg & 1, part = lane & 7;
                *(u32x4*)(CMPA + ((size_t)j * 4096 + ((size_t)(b * 256 + (s >> 4)) * 2 + g)) * 1024 + (s & 15) * 64 + part * 8) = *(const u32x4*)(row + C_NKV + j * 128 + g * 64 + part * 8); }
            {
                float v[8], g[8]; unpack8(*(const u32x4*)(row + C_UV + 512 + lane * 8), v); load8f(lng + lane * 8, g);
                float sm = 0.f;
#pragma unroll
                for (int e = 0; e < 8; ++e) { v[e] = gelu_t(v[e]); sm += v[e]; }
                const float mean = wave_sum(sm) * (1.f / 512.f); float sq = 0.f;
#pragma unroll
                for (int e = 0; e < 8; ++e) { v[e] -= mean; sq += v[e] * v[e]; }
                const float r = rsqrtf(wave_sum(sq) * (1.f / 512.f) + 1e-6f);
#pragma unroll
                for (int e = 0; e < 8; ++e) *(LAS unsigned short*)(vnT + (lane * 8 + e) * 272 + tt * 2) = (unsigned short)f2bf(v[e] * r * g[e]);
            }
        }
        __syncthreads();
        {
            const int g = wave, c = lane & 15, q = lane >> 4; const bf16_t* Wg = SGUW + (size_t)g * 128 * 128;
            for (int tt16 = 0; tt16 < 8; ++tt16) {
                const int nk = (tt16 >> 1) + 1;
                bf16x8 bw[4];
#pragma unroll
                for (int kk = 0; kk < 4; ++kk) bw[kk] = *(const bf16x8*)(Wg + (size_t)(16 * tt16 + c) * 128 + 32 * (kk < nk ? kk : 0) + 8 * q);
                const int t = t0 + 16 * tt16 + c; const float bias = sgub[g * 128 + 16 * tt16 + c];
#pragma unroll
                for (int dt = 0; dt < 4; ++dt) {
                    f32x4 acc = {0.f, 0.f, 0.f, 0.f};
#pragma unroll
                    for (int kk = 0; kk < 4; ++kk) if (kk < nk) { const bf16x8 a = *(const LAS bf16x8*)(vnT + (g * 64 + 16 * dt + c) * 272 + (32 * kk + 8 * q) * 2); acc = MFMA16(a, bw[kk], acc); }
                    const int ch = g * 64 + 16 * dt + 4 * q;
                    const u32x2 uu = *(const u32x2*)(PROJ + (size_t)t * PW + C_UV + ch);
                    u32x2 o; o.x = pk2(gelu_t(lo16(uu.x)) * (acc[0] + bias), gelu_t(hi16(uu.x)) * (acc[1] + bias)); o.y = pk2(gelu_t(lo16(uu.y)) * (acc[2] + bias), gelu_t(hi16(uu.y)) * (acc[3] + bias));
                    *(u32x2*)(YC + (size_t)t * 512 + ch) = o;
                }
            }
        }
        __syncthreads();
    }
}

DI void phase_cmp2(const Params& p, int l, const Frame& F) {
    unsigned char* ws = p.ws; const int lane = F.lane; const int gw = F.vb * 8 + F.wave, NGW = F.G * 8;
    LAS float* hid = (LAS float*)(F.lds + F.wave * 1024);
    const float* CMPP = (const float*)(ws + WS_CMPP); const float* peb = (const float*)(ws + WS_PEB);
    bf16_t* CMPK = (bf16_t*)(ws + WS_CMPK); bf16_t* CMPV = (bf16_t*)(ws + WS_CMPV);
    const float* kg = p.in[I_NKG] + (l * 3 + 0) * 64;
    for (int it = gw; it < 8 * 256 * 2 * 2; it += NGW) {
        const int j = it & 1, g = (it >> 1) & 1, n = (it >> 2) & 255, b = it >> 10;
        bf16_t* dst = (j ? CMPV : CMPK) + ((size_t)(b * 2 + g) * 256 + n) * 64;
        if (n == 255) { dst[lane] = 0; continue; }
        const float* Pa = CMPP + ((size_t)j * 4096 + (size_t)(b * 256 + n) * 2 + g) * 512; const float* Pb = CMPP + ((size_t)j * 4096 + (size_t)(b * 256 + n + 1) * 2 + g) * 512 + 256;
        const f32x4 a = *(const f32x4*)(Pa + lane * 4), bq = *(const f32x4*)(Pb + lane * 4), pe = *(const f32x4*)(peb + j * 256 + lane * 4);
        f32x4 h; h.x = gelu_t(a.x + bq.x + pe.x); h.y = gelu_t(a.y + bq.y + pe.y); h.z = gelu_t(a.z + bq.z + pe.z); h.w = gelu_t(a.w + bq.w + pe.w);
        *(LAS f32x4*)(hid + lane * 4) = h;
        LDS_WAIT();
        const float* w2 = p.in[I_CW2] + ((size_t)l * 2 + j) * 256 * 64;
        float o = 0.f;
#pragma unroll 8
        for (int k = 0; k < 256; ++k) o += hid[k] * w2[k * 64 + lane];
        if (j == 0) { const float ss = wave_sum(o * o); o = o * rsqrtf(ss * (1.f / 64.f) + 1e-6f) * kg[lane]; }
        dst[lane] = (bf16_t)f2bf(o);
        LDS_WAIT();
    }
}

struct KsCmp { const bf16_t* kb; const bf16_t* vb; int t0, hb;
    DI const bf16_t* krow(int idx) const { return kb + (size_t)(idx < 255 ? idx : 255) * 64; }
    DI const bf16_t* vrow(int idx) const { return vb + (size_t)(idx < 255 ? idx : 255) * 64; }
    DI float adjust(int idx, int c, float s, bool& ok, const LAS unsigned char* buck, const LAS float* tbl) const {
        const int dist = t0 + (c >> 2) - (16 * idx + 31); ok = dist >= 0; const int dc = ok ? dist : 0; return s + tbl[buck[dc] * 16 + hb + (c & 3)]; } };
struct KsSel { const bf16_t* kb; const bf16_t* vb; const LAS int* selb; int t, hb;
    DI int pos(int idx) const { const int blk = selb[idx >> 6]; return blk < 0 ? -1 : blk * 64 + (idx & 63); }
    DI const bf16_t* krow(int idx) const { const int ps = pos(idx); return kb + (size_t)(ps < 0 ? 0 : ps) * PW; }
    DI const bf16_t* vrow(int idx) const { const int ps = pos(idx); return vb + (size_t)(ps < 0 ? 0 : ps) * PW; }
    DI float adjust(int idx, int c, float s, bool& ok, const LAS unsigned char* buck, const LAS float* tbl) const {
        const int ps = pos(idx); ok = ps >= 0 && ps <= t; const int dc = ok ? t - ps : 0; return s + tbl[buck[dc] * 16 + hb + (c & 3)]; } };
struct KsWin { const bf16_t* kb; const bf16_t* vb; int pstart, t0, hb;
    DI const bf16_t* krow(int idx) const { const int ps = pstart + idx; return kb + (size_t)(ps < SEQ ? ps : SEQ - 1) * PW; }
    DI const bf16_t* vrow(int idx) const { const int ps = pstart + idx; return vb + (size_t)(ps < SEQ ? ps : SEQ - 1) * PW; }
    DI float adjust(int idx, int c, float s, bool& ok, const LAS unsigned char* buck, const LAS float* tbl) const {
        const int dist = t0 + (c >> 2) - (pstart + idx); ok = dist >= 0 && dist < 512; const int dc = ok ? dist : 0; return s + tbl[buck[dc] * 16 + hb + (c & 3)]; } };
struct KsDsa { const bf16_t* kb; const bf16_t* vb; const LAS int* list; int n, t;
    DI int pos(int idx) const { return idx < n ? list[idx] : -1; }
    DI const bf16_t* krow(int idx) const { const int ps = pos(idx); return kb + (size_t)(ps < 0 ? 0 : ps) * PW; }
    DI const bf16_t* vrow(int idx) const { const int ps = pos(idx); return vb + (size_t)(ps < 0 ? 0 : ps) * PW; }
    DI float adjust(int idx, int c, float s, bool& ok, const LAS unsigned char* buck, const LAS float* tbl) const {
        const int ps = pos(idx); ok = ps >= 0 && ps <= t; const int dc = ok ? t - ps : 0; return s + tbl[buck[dc] * 16 + 8 + (c & 7)]; } };

template <int MODE, class KS>
DI void flash_run(const KS& ks, int nkeys, const bf16x8 (&qb)[2], f32x4 (&o)[4], float& m_run, float& l_run, LAS unsigned char* vt, LAS float* al, LAS float* pn,
                  const LAS unsigned char* buck, const LAS float* tbl, int lane) {
    const int c = lane & 15, q = lane >> 4;
    for (int k0 = 0; k0 < nkeys; k0 += 32) {
        const bf16_t* kr0 = ks.krow(k0 + c); const bf16_t* kr1 = ks.krow(k0 + 16 + c);
        const bf16x8 ka00 = *(const bf16x8*)(kr0 + 8 * q), ka01 = *(const bf16x8*)(kr0 + 32 + 8 * q), ka10 = *(const bf16x8*)(kr1 + 8 * q), ka11 = *(const bf16x8*)(kr1 + 32 + 8 * q);
        u32x4 vv[4];
        if (MODE != 1) {
#pragma unroll
            for (int m = 0; m < 4; ++m) vv[m] = *(const u32x4*)(ks.vrow(k0 + (lane >> 3) + 8 * m) + (lane & 7) * 8);
        }
        f32x4 s0 = {0.f, 0.f, 0.f, 0.f}, s1 = {0.f, 0.f, 0.f, 0.f};
        s0 = MFMA16(ka00, qb[0], s0); s0 = MFMA16(ka01, qb[1], s0); s1 = MFMA16(ka10, qb[0], s1); s1 = MFMA16(ka11, qb[1], s1);
        float sv[8], pv[8]; bool ok[8];
#pragma unroll
        for (int i = 0; i < 4; ++i) { sv[i] = ks.adjust(k0 + 4 * q + i, c, s0[i], ok[i], buck, tbl); sv[4 + i] = ks.adjust(k0 + 16 + 4 * q + i, c, s1[i], ok[4 + i], buck, tbl); }
        if (MODE == 2) {
#pragma unroll
            for (int e = 0; e < 8; ++e) { pv[e] = ok[e] ? __expf(sv[e] - m_run) * l_run : 0.f;
                float x = pv[e]; x += __shfl_xor(x, 1); x += __shfl_xor(x, 2);
                if ((c & 3) == 0) pn[(c >> 2) * 256 + k0 + (e < 4 ? 4 * q + e : 16 + 4 * q + (e - 4))] = x; }
        } else {
            float mloc = -1e30f;
#pragma unroll
            for (int e = 0; e < 8; ++e) mloc = ok[e] ? fmaxf(mloc, sv[e]) : mloc;
            mloc = fmaxf(mloc, __shfl_xor(mloc, 16)); mloc = fmaxf(mloc, __shfl_xor(mloc, 32));
            const float m_new = fmaxf(m_run, mloc), alpha = __expf(m_run - m_new);
            float ps = 0.f;
#pragma unroll
            for (int e = 0; e < 8; ++e) { pv[e] = ok[e] ? __expf(sv[e] - m_new) : 0.f; ps += pv[e]; }
            l_run = l_run * alpha + ps; m_run = m_new;
            if (MODE == 0) {
                if (__any(alpha != 1.f)) {
                    if (q == 0) al[c] = alpha;
                    LDS_WAIT();
                    const f32x4 a4 = *(const LAS f32x4*)(al + 4 * q);
#pragma unroll
                    for (int dt = 0; dt < 4; ++dt) o[dt] = o[dt] * a4;
                    LDS_WAIT();
                }
            }
        }
        if (MODE != 1) {
#pragma unroll
            for (int m = 0; m < 4; ++m) *(LAS u32x4*)(vt + ((lane >> 3) + 8 * m) * 144 + (lane & 7) * 16) = vv[m];
            LDS_WAIT();
            const bf16x8 pa = __builtin_bit_cast(bf16x8, pack8(pv));
#pragma unroll
            for (int dt = 0; dt < 4; ++dt) {
                const s16x4 lo = __builtin_amdgcn_ds_read_tr16_b64_v4i16((LAS s16x4*)(vt + (4 * q + (c >> 2)) * 144 + (16 * dt + 4 * (c & 3)) * 2));
                const s16x4 hi = __builtin_amdgcn_ds_read_tr16_b64_v4i16((LAS s16x4*)(vt + (16 + 4 * q + (c >> 2)) * 144 + (16 * dt + 4 * (c & 3)) * 2));
                const bf16x8 vb8 = __builtin_shufflevector(lo, hi, 0, 1, 2, 3, 4, 5, 6, 7);
                o[dt] = MFMA16(pa, vb8, o[dt]);
            }
            LDS_WAIT();
        }
    }
    if (MODE == 0) {
        float lt = l_run; lt += __shfl_xor(lt, 16); lt += __shfl_xor(lt, 32);
        const float inv = lt > 0.f ? 1.f / lt : 0.f;
        if (q == 0) al[c] = inv;
        LDS_WAIT();
        const f32x4 a4 = *(const LAS f32x4*)(al + 4 * q);
#pragma unroll
        for (int dt = 0; dt < 4; ++dt) o[dt] = o[dt] * a4;
        LDS_WAIT();
    }
}

DI void nsa_item(const Params& p, int b, int g, int t0, LAS unsigned char* wl, const LAS unsigned char* buck, const LAS float* tbl, int lane) {
    unsigned char* ws = p.ws; const int c = lane & 15, q = lane >> 4;
    LAS unsigned char* vt = wl; LAS float* al = (LAS float*)(wl + 4608); LAS float* pn = (LAS float*)(wl + 4736); LAS float* outb = (LAS float*)(wl + 8832); LAS int* selb = (LAS int*)(wl + 12928);
    const bf16_t* prow0 = (const bf16_t*)(ws + WS_PROJ) + (size_t)(b * SEQ) * PW;
    bf16_t* YB = (bf16_t*)(ws + WS_Y) + (size_t)T * 512;
    const f32x4 z4 = {0.f, 0.f, 0.f, 0.f};
#pragma unroll
    for (int k = 0; k < 4; ++k) { *(LAS f32x4*)(outb + lane * 4 + 256 * k) = z4; *(LAS f32x4*)(pn + lane * 4 + 256 * k) = z4; }
    bf16x8 qb[2];
    { const bf16_t* qp = prow0 + (size_t)(t0 + (c >> 2)) * PW + C_NQ + (g * 4 + (c & 3)) * 64 + 8 * q; qb[0] = *(const bf16x8*)qp; qb[1] = *(const bf16x8*)(qp + 32); }
    float gt[3][4];
#pragma unroll
    for (int br = 0; br < 3; ++br) { const u32x2 gg = *(const u32x2*)(prow0 + (size_t)(t0 + q) * PW + C_NG + br * 8 + g * 4);
        gt[br][0] = sigm(lo16(gg.x)); gt[br][1] = sigm(hi16(gg.x)); gt[br][2] = sigm(lo16(gg.y)); gt[br][3] = sigm(hi16(gg.y)); }
    LDS_WAIT();
    const int tl = t0 + 3, nv = tl >= 31 ? ((tl - 31) >> 4) + 1 : 0;
    if (nv > 0) {
        const int nk = (nv + 31) & ~31;
        KsCmp ks{(const bf16_t*)(ws + WS_CMPK) + (size_t)(b * 2 + g) * 256 * 64, (const bf16_t*)(ws + WS_CMPV) + (size_t)(b * 2 + g) * 256 * 64, t0, g * 4};
        float m = -1e30f, lr = 0.f; f32x4 o[4] = {z4, z4, z4, z4};
        flash_run<1>(ks, nk, qb, o, m, lr, vt, al, pn, buck, tbl, lane);
        lr += __shfl_xor(lr, 16); lr += __shfl_xor(lr, 32); lr = lr > 0.f ? 1.f / lr : 0.f;
        flash_run<2>(ks, nk, qb, o, m, lr, vt, al, pn, buck, tbl, lane);
#pragma unroll
        for (int dt = 0; dt < 4; ++dt)
#pragma unroll
            for (int i = 0; i < 4; ++i) outb[(q * 4 + i) * 64 + 16 * dt + c] += gt[0][i] * o[dt][i];
    }
    LDS_WAIT();
    for (int qi = 0; qi < 4; ++qi) {
        const int t = t0 + qi, cur = t >> 6, j = lane; float val;
        if (j == 0 || j == cur) val = 1e4f;
        else if (j < cur) { const LAS float* pq = pn + qi * 256 + 4 * j; val = pq[-1] + pq[0] + pq[1] + pq[2] + pq[3]; }
        else val = -1e30f;
        for (int k = 0; k < 8; ++k) {
            const float mx = wave_max(val); const unsigned long long who = __ballot(val == mx); const int w = __builtin_ctzll(who);
            if (lane == 0) selb[qi * 8 + k] = mx > -1e29f ? w : -1;
            if (lane == w) val = -3e38f;
        }
    }
    LDS_WAIT();
    for (int qi = 0; qi < 4; ++qi) {
        const int t = t0 + qi;
        bf16x8 qs[2] = {(bf16x8){0, 0, 0, 0, 0, 0, 0, 0}, (bf16x8){0, 0, 0, 0, 0, 0, 0, 0}};
        if (c < 4) { const bf16_t* qp = prow0 + (size_t)t * PW + C_NQ + (g * 4 + c) * 64 + 8 * q; qs[0] = *(const bf16x8*)qp; qs[1] = *(const bf16x8*)(qp + 32); }
        const int sv = lane < 8 ? selb[qi * 8 + lane] : -1; const int nvb = __popcll(__ballot(sv >= 0));
        KsSel ks{prow0 + C_NKV + 2 * 128 + g * 64, prow0 + C_NKV + 3 * 128 + g * 64, selb + qi * 8, t, g * 4};
        float m = -1e30f, lr = 0.f; f32x4 o[4] = {z4, z4, z4, z4};
        flash_run<0>(ks, nvb * 64, qs, o, m, lr, vt, al, pn, buck, tbl, lane);
        const u32x2 gg = *(const u32x2*)(prow0 + (size_t)t * PW + C_NG + 8 + g * 4);
        const float g1[4] = {sigm(lo16(gg.x)), sigm(hi16(gg.x)), sigm(lo16(gg.y)), sigm(hi16(gg.y))};
        if (q == 0) {
#pragma unroll
            for (int dt = 0; dt < 4; ++dt)
#pragma unroll
                for (int i = 0; i < 4; ++i) outb[(qi * 4 + i) * 64 + 16 * dt + c] += g1[i] * o[dt][i];
        }
    }
    {
        const int pstart = t0 >= 511 ? t0 - 511 : 0, nk = (t0 + 3 - pstart + 1 + 31) & ~31;
        KsWin ks{prow0 + C_NKV + 4 * 128 + g * 64, prow0 + C_NKV + 5 * 128 + g * 64, pstart, t0, g * 4};
        float m = -1e30f, lr = 0.f; f32x4 o[4] = {z4, z4, z4, z4};
        flash_run<0>(ks, nk, qb, o, m, lr, vt, al, pn, buck, tbl, lane);
#pragma unroll
        for (int dt = 0; dt < 4; ++dt)
#pragma unroll
            for (int i = 0; i < 4; ++i) outb[(q * 4 + i) * 64 + 16 * dt + c] += gt[2][i] * o[dt][i];
    }
    LDS_WAIT();
    {
        const int qi = lane >> 4, h = (lane >> 2) & 3, d0 = (lane & 3) * 16; float f[8], f2[8];
        const f32x4 a = *(const LAS f32x4*)(outb + lane * 16), bq = *(const LAS f32x4*)(outb + lane * 16 + 4), cq = *(const LAS f32x4*)(outb + lane * 16 + 8), dq = *(const LAS f32x4*)(outb + lane * 16 + 12);
        f[0] = a.x; f[1] = a.y; f[2] = a.z; f[3] = a.w; f[4] = bq.x; f[5] = bq.y; f[6] = bq.z; f[7] = bq.w; f2[0] = cq.x; f2[1] = cq.y; f2[2] = cq.z; f2[3] = cq.w; f2[4] = dq.x; f2[5] = dq.y; f2[6] = dq.z; f2[7] = dq.w;
        bf16_t* dst = YB + (size_t)(b * SEQ + t0 + qi) * 512 + (g * 4 + h) * 64 + d0;
        *(u32x4*)dst = pack8(f); *(u32x4*)(dst + 8) = pack8(f2);
    }
    LDS_WAIT();
}

DI void dsa_item(const Params& p, int b, int t, LAS unsigned char* wl, const LAS unsigned char* buck, const LAS float* tbl, int lane) {
    unsigned char* ws = p.ws; const int c = lane & 15, q = lane >> 4;
    LAS unsigned* sc = (LAS unsigned*)wl; LAS int* list = (LAS int*)(wl + 16384); LAS float* al = (LAS float*)(wl + 17408);
    const bf16_t* prow0 = (const bf16_t*)(ws + WS_PROJ) + (size_t)(b * SEQ) * PW; const bf16_t* qrow = prow0 + (size_t)t * PW;
    bf16_t* YD = (bf16_t*)(ws + WS_Y) + (size_t)3 * T * 512;
    const bf16x8 zf = {0, 0, 0, 0, 0, 0, 0, 0};
    int n;
    if (t < 256) { n = t + 1; for (int i = lane; i < 256; i += 64) list[i] = i <= t ? i : -1; }
    else {
        n = 256;
        bf16x8 qa[2] = {zf, zf};
        if (c < 8) { qa[0] = *(const bf16x8*)(qrow + C_DQI + c * 64 + 8 * q); qa[1] = *(const bf16x8*)(qrow + C_DQI + c * 64 + 32 + 8 * q); }
        float wv[4];
#pragma unroll
        for (int i = 0; i < 4; ++i) { const int r = 4 * q + i; wv[i] = r < 8 ? bf2f(qrow[C_DWI + (r & 7)]) * 0.35355339f : 0.f; }
        const int ntile = (t >> 4) + 1, nk64 = (t >> 6) + 1;
        for (int tau = 0; tau < ntile; ++tau) {
            const bf16_t* kp = prow0 + (size_t)(16 * tau + c) * PW + C_DKI + 8 * q;
            const bf16x8 kb0 = *(const bf16x8*)kp, kb1 = *(const bf16x8*)(kp + 32);
            f32x4 acc = {0.f, 0.f, 0.f, 0.f};
            acc = MFMA16(qa[0], kb0, acc); acc = MFMA16(qa[1], kb1, acc);
            float s = wv[0] * fmaxf(acc[0], 0.f) + wv[1] * fmaxf(acc[1], 0.f) + wv[2] * fmaxf(acc[2], 0.f) + wv[3] * fmaxf(acc[3], 0.f);
            s += __shfl_xor(s, 16); s += __shfl_xor(s, 32);
            const int key = 16 * tau + c; const unsigned u = key <= t ? ordf(s) : 0u;
            if (q == 0) sc[key] = u;
        }
        for (int key = ntile * 16 + lane; key < nk64 * 64; key += 64) sc[key] = 0u;
        LDS_WAIT();
        unsigned prefix = 0u;
        for (int bit = 31; bit >= 0; --bit) {
            const unsigned cand = prefix | (1u << bit); int cnt = 0;
            for (int k = 0; k < nk64; ++k) cnt += __popcll(__ballot(sc[k * 64 + lane] >= cand));
            if (cnt >= 256) { prefix = cand; if (cnt == 256) break; }
        }
        int cgt = 0;
        for (int k = 0; k < nk64; ++k) cgt += __popcll(__ballot(sc[k * 64 + lane] > prefix));
        const int need_eq = 256 - cgt; int base = 0, eqbase = 0;
        for (int k = 0; k < nk64; ++k) {
            const unsigned u = sc[k * 64 + lane]; const bool gtp = u > prefix, eq = u == prefix;
            const unsigned long long meq = __ballot(eq);
            const int eqrank = eqbase + (int)__builtin_amdgcn_mbcnt_hi((unsigned)(meq >> 32), __builtin_amdgcn_mbcnt_lo((unsigned)meq, 0u));
            const bool take = gtp || (eq && eqrank < need_eq);
            const unsigned long long mt = __ballot(take);
            const int slot = base + (int)__builtin_amdgcn_mbcnt_hi((unsigned)(mt >> 32), __builtin_amdgcn_mbcnt_lo((unsigned)mt, 0u));
            if (take && slot < 256) list[slot] = k * 64 + lane;
            base += __popcll(mt); eqbase += __popcll(meq);
        }
    }
    LDS_WAIT();
    bf16x8 qd[2] = {zf, zf};
    if (c < 8) { qd[0] = *(const bf16x8*)(qrow + C_DQ + c * 64 + 8 * q); qd[1] = *(const bf16x8*)(qrow + C_DQ + c * 64 + 32 + 8 * q); }
    KsDsa ks{prow0 + C_DK, prow0 + C_DV, list, n, t};
    const f32x4 z4 = {0.f, 0.f, 0.f, 0.f};
    float m = -1e30f, lr = 0.f; f32x4 o[4] = {z4, z4, z4, z4};
    flash_run<0>(ks, (n + 31) & ~31, qd, o, m, lr, wl, al, (LAS float*)wl, buck, tbl, lane);
    if (q < 2) {
#pragma unroll
        for (int dt = 0; dt < 4; ++dt)
#pragma unroll
            for (int i = 0; i < 4; ++i) YD[(size_t)(b * SEQ + t) * 512 + (4 * q + i) * 64 + 16 * dt + c] = (bf16_t)f2bf(o[dt][i]);
    }
    LDS_WAIT();
}

DI void phase_attn(const Params& p, int l, const Frame& F) {
    LAS unsigned char* buck = F.lds + LDS_BUCK; LAS float* tbl = (LAS float*)(F.lds + LDS_TBL);
    for (int i = F.tid; i < 4096; i += 512) buck[i] = (unsigned char)bucket_of(i);
    { const float* rel = p.in[I_REL]; tbl[F.tid] = rel[F.tid]; }
    __syncthreads();
    LAS unsigned char* wl = F.lds + F.wave * LDS_PERWAVE; const int gw = F.vb * 8 + F.wave, NGW = F.G * 8;
    for (int it = gw; it < 8 * 2 * 1024; it += NGW) { const int b = it >> 11, g = (it >> 10) & 1; int tq = it & 1023; if (b & 1) tq = 1023 - tq; nsa_item(p, b, g, tq * 4, wl, buck, tbl, F.lane); }
    for (int it = gw; it < 8 * 4096; it += NGW) { const int b = it >> 12; int t = it & 4095; if (b & 1) t = 4095 - t; dsa_item(p, b, t, wl, buck, tbl, F.lane); }
}

DI unsigned row16_maxu(unsigned m) { unsigned o;
    o = (unsigned)__shfl_xor((int)m, 1); m = m > o ? m : o; o = (unsigned)__shfl_xor((int)m, 2); m = m > o ? m : o;
    o = (unsigned)__shfl_xor((int)m, 4); m = m > o ? m : o; o = (unsigned)__shfl_xor((int)m, 8); m = m > o ? m : o; return m; }
DI void peer_route_tile(const Params& p, int t0, int lane) {
    unsigned char* ws = p.ws; const int c = lane & 15, q = lane >> 4;
    const bf16_t* QP = (const bf16_t*)(ws + WS_QP); const bf16_t* SK = (const bf16_t*)(ws + WS_SK); int* EIDX = (int*)(ws + WS_EIDX); float* EW = (float*)(ws + WS_EW);
    for (int h = 0; h < 8; ++h) {
        unsigned top[2][4];
#pragma unroll
        for (int pp = 0; pp < 2; ++pp) {
            const int hp = h * 2 + pp;
            const bf16_t* ap = QP + (size_t)(t0 + c) * 1024 + hp * 64 + 8 * q;
            const bf16x8 a0 = *(const bf16x8*)ap, a1 = *(const bf16x8*)(ap + 32);
            unsigned v[4][8];
#pragma unroll
            for (int kt = 0; kt < 8; ++kt) { const bf16_t* bp = SK + ((size_t)hp * 128 + 16 * kt + c) * 64 + 8 * q;
                const bf16x8 b0 = *(const bf16x8*)bp, b1 = *(const bf16x8*)(bp + 32);
                f32x4 acc = {0.f, 0.f, 0.f, 0.f}; acc = MFMA16(a0, b0, acc); acc = MFMA16(a1, b1, acc);
#pragma unroll
                for (int i = 0; i < 4; ++i) v[i][kt] = (ordf(acc[i]) & 0xFFFFFF80u) | (unsigned)(127 - (16 * kt + c)); }
#pragma unroll
            for (int i = 0; i < 4; ++i) { unsigned mine = 0u;
                for (int r = 0; r < 16; ++r) { unsigned m = v[i][0];
#pragma unroll
                    for (int kt = 1; kt < 8; ++kt) m = m > v[i][kt] ? m : v[i][kt];
                    m = row16_maxu(m); mine = (c == r) ? m : mine;
#pragma unroll
                    for (int kt = 0; kt < 8; ++kt) v[i][kt] = (v[i][kt] == m) ? 0u : v[i][kt]; }
                top[pp][i] = mine; }
        }
#pragma unroll
        for (int i = 0; i < 4; ++i) {
            const float s0 = unordf(top[0][i] & 0xFFFFFF80u), s1 = unordf(top[1][i] & 0xFFFFFF80u);
            const int i0 = 127 - (int)(top[0][i] & 127u), i1 = 127 - (int)(top[1][i] & 127u);
            unsigned cd[16];
#pragma unroll
            for (int k = 0; k < 16; ++k) { const int bb = (c - k) & 15; const float s1b = __shfl(s1, (lane & 48) | bb); cd[k] = (ordf(s0 + s1b) & 0xFFFFFF00u) | (unsigned)(255 - (c * 16 + bb)); }
            unsigned mine = 0u;
            for (int r = 0; r < 16; ++r) { unsigned m = cd[0];
#pragma unroll
                for (int k = 1; k < 16; ++k) m = m > cd[k] ? m : cd[k];
                m = row16_maxu(m); mine = (c == r) ? m : mine;
#pragma unroll
                for (int k = 0; k < 16; ++k) cd[k] = (cd[k] == m) ? 0u : cd[k]; }
            const int pr = 255 - (int)(mine & 255u); const int ea = __shfl(i0, (lane & 48) | (pr >> 4)), eb = __shfl(i1, (lane & 48) | (pr & 15));
            const float scv = unordf(mine & 0xFFFFFF00u);
            float mx = scv; mx = fmaxf(mx, __shfl_xor(mx, 1)); mx = fmaxf(mx, __shfl_xor(mx, 2)); mx = fmaxf(mx, __shfl_xor(mx, 4)); mx = fmaxf(mx, __shfl_xor(mx, 8));
            const float e = __expf(scv - mx); float sm = e; sm += __shfl_xor(sm, 1); sm += __shfl_xor(sm, 2); sm += __shfl_xor(sm, 4); sm += __shfl_xor(sm, 8);
            const size_t o = (size_t)(t0 + 4 * q + i) * 128 + h * 16 + c;
            EIDX[o] = ea * 128 + eb; EW[o] = e / sm;
        }
    }
}
DI void peer_gather_token(const Params& p, int l, int t, const float* xin, float* xout, LAS unsigned char* wl, int lane) {
    unsigned char* ws = p.ws;
    LAS bf16_t* h2 = (LAS bf16_t*)wl; LAS int* el = (LAS int*)(wl + 2048); LAS float* wlw = (LAS float*)(wl + 2560); LAS float* cl = (LAS float*)(wl + 3072);
    const bf16_t* PTU = (const bf16_t*)(ws + WS_PTU); const bf16_t* PTV = (const bf16_t*)(ws + WS_PTV); const int* EIDX = (const int*)(ws + WS_EIDX); const float* EW = (const float*)(ws + WS_EW);
    const int e0 = lane * 8; const float* xr = xin + (size_t)t * 1024; const float* gf = p.in[I_GFFN] + l * 1024;
    float xa[8], xb[8], ga[8], gb[8];
    load8f(xr + e0, xa); load8f(xr + 512 + e0, xb); load8f(gf + e0, ga); load8f(gf + 512 + e0, gb);
    float ss = 0.f;
#pragma unroll
    for (int e = 0; e < 8; ++e) ss += xa[e] * xa[e] + xb[e] * xb[e];
    const float r = rsqrtf(wave_sum(ss) * (1.f / 1024.f) + 1e-6f);
    { float hv[8];
#pragma unroll
      for (int e = 0; e < 8; ++e) hv[e] = xa[e] * r * ga[e];
      *(LAS u32x4*)(h2 + e0) = pack8(hv);
#pragma unroll
      for (int e = 0; e < 8; ++e) hv[e] = xb[e] * r * gb[e];
      *(LAS u32x4*)(h2 + 512 + e0) = pack8(hv); }
    el[lane] = EIDX[(size_t)t * 128 + lane]; el[64 + lane] = EIDX[(size_t)t * 128 + 64 + lane];
    wlw[lane] = EW[(size_t)t * 128 + lane]; wlw[64 + lane] = EW[(size_t)t * 128 + 64 + lane];
    LDS_WAIT();
    const int c = lane & 15, q = lane >> 4;
    for (int eg = 0; eg < 8; ++eg) {
        const int e = el[16 * eg + c]; const bf16_t* ur = PTU + (size_t)e * 1024 + 8 * q;
        f32x4 acc = {0.f, 0.f, 0.f, 0.f};
#pragma unroll 8
        for (int kk = 0; kk < 32; ++kk) { const bf16x8 a = *(const bf16x8*)(ur + 32 * kk); const bf16x8 bq = *(const LAS bf16x8*)(h2 + 32 * kk + 8 * q); acc = MFMA16(a, bq, acc); }
        if (c == 0) { f32x4 cf; cf.x = wlw[16 * eg + 4 * q + 0] * gelu_t(acc[0]); cf.y = wlw[16 * eg + 4 * q + 1] * gelu_t(acc[1]); cf.z = wlw[16 * eg + 4 * q + 2] * gelu_t(acc[2]); cf.w = wlw[16 * eg + 4 * q + 3] * gelu_t(acc[3]);
            *(LAS f32x4*)(cl + 16 * eg + 4 * q) = cf; }
    }
    LDS_WAIT();
    float out[16];
#pragma unroll
    for (int e = 0; e < 16; ++e) out[e] = 0.f;
    for (int e = 0; e < 128; e += 4) {
        u32x4 w0[4], w1[4]; float cf[4];
#pragma unroll
        for (int j = 0; j < 4; ++j) { const int eid = el[e + j]; cf[j] = cl[e + j]; const bf16_t* vr = PTV + (size_t)eid * 1024; w0[j] = *(const u32x4*)(vr + e0); w1[j] = *(const u32x4*)(vr + 512 + e0); }
#pragma unroll
        for (int j = 0; j < 4; ++j) { float a[8], bq[8]; unpack8(w0[j], a); unpack8(w1[j], bq);
#pragma unroll
            for (int k = 0; k < 8; ++k) { out[k] += cf[j] * a[k]; out[8 + k] += cf[j] * bq[k]; } }
    }
    float* xo = xout + (size_t)t * 1024;
    { f32x4 o0 = {xa[0] + out[0], xa[1] + out[1], xa[2] + out[2], xa[3] + out[3]}, o1 = {xa[4] + out[4], xa[5] + out[5], xa[6] + out[6], xa[7] + out[7]};
      f32x4 o2 = {xb[0] + out[8], xb[1] + out[9], xb[2] + out[10], xb[3] + out[11]}, o3 = {xb[4] + out[12], xb[5] + out[13], xb[6] + out[14], xb[7] + out[15]};
      *(f32x4*)(xo + e0) = o0; *(f32x4*)(xo + e0 + 4) = o1; *(f32x4*)(xo + 512 + e0) = o2; *(f32x4*)(xo + 512 + e0 + 4) = o3; }
    LDS_WAIT();
}
DI void phase_peer(const Params& p, int l, const Frame& F) {
    LAS unsigned char* wl = F.lds + F.wave * LDS_PERWAVE; const int gw = F.vb * 8 + F.wave, NGW = F.G * 8;
    for (int tile = gw; tile < T / 16; tile += NGW) {
        peer_route_tile(p, tile * 16, F.lane);
        __threadfence_block();
        for (int k = 0; k < 16; ++k) peer_gather_token(p, l, tile * 16 + k, p.out, p.out, wl, F.lane);
    }
}

#ifndef MK_MASK
#define MK_MASK 0x1fff
#endif
__global__ void __launch_bounds__(512, 2) mega(Params p) {
    extern __shared__ __attribute__((aligned(16))) unsigned char lds_raw[];
#define MKFRAME() Frame F; { int t_ = threadIdx.x; asm volatile("" : "+v"(t_)); F.lds = (LAS unsigned char*)lds_raw; F.tid = t_; F.lane = t_ & 63; F.wave = __builtin_amdgcn_readfirstlane(t_ >> 6); \
        F.G = gridDim.x; const int bx = blockIdx.x; F.vb = (F.G % 8 == 0) ? (bx % 8) * (F.G / 8) + bx / 8 : bx; }
    if (threadIdx.x < 16) ((LAS unsigned*)((LAS unsigned char*)lds_raw + LDS_XB))[threadIdx.x] = 0u;
    __syncthreads();
    const int lo = p.ph_lo, hi = p.ph_hi;
    XcdBarrier bar; bar.bar = (unsigned*)(p.ws + WS_CTL) + 4096; bar.x = 0; bar.st = (volatile LAS unsigned*)((LAS unsigned char*)lds_raw + LDS_XB);
    if (hi - lo > 1) bar = xcd_barrier_post((unsigned*)(p.ws + WS_CTL) + 4096, (volatile LAS unsigned*)((LAS unsigned char*)lds_raw + LDS_XB));
#define WSP(ws) unsigned char* ws = p.ws; asm volatile("" : "+s"(ws))
    for (int l = 0; l < NLAYER; ++l) {
        const int pb = l * NPH;
#define IN(k) (((MK_MASK >> (k)) & 1) && lo <= pb + (k) && pb + (k) < hi)
#define SEAM(k) do { if (((MK_MASK >> (k)) & 1) && lo <= pb + (k) && pb + (k) + 1 < hi) xcd_barrier(bar); } while (0)
        if (IN(0)) { MKFRAME(); phase_prep_w(p, l, F); }
        SEAM(0);
        if (IN(1)) { MKFRAME(); WSP(ws); pg8::Gemm g{(const bf16_t*)(ws + WS_H), (const bf16_t*)(ws + WS_WCAT), T, 9216, 1024}; pg8::StaticOrder S; S.init(T, 9216, F.G, (int)blockIdx.x);
            Epi1 E{(bf16_t*)(ws + WS_PROJ), (bf16_t*)(ws + WS_GATES)};
            pg8::gemm_phase<Epi1, pg8::StaticOrder, false>(F.lds, g, S, E, nullptr); }
        SEAM(1);
        if (IN(2)) { MKFRAME(); phase_chunk(p, l, F); }
        SEAM(2);
        if (IN(3)) { MKFRAME(); WSP(ws);
            { pg8::Gemm g{(const bf16_t*)(ws + WS_CMPA), (const bf16_t*)(ws + WS_W1C), 4096, 512, 1024}; pg8::StaticOrder S; S.init(4096, 512, F.G, (int)blockIdx.x); EpiF32P E{(float*)(ws + WS_CMPP), 512};
              pg8::gemm_phase<EpiF32P, pg8::StaticOrder, false>(F.lds, g, S, E, nullptr); }
        }
        if (IN(3)) { MKFRAME(); WSP(ws);
            { pg8::Gemm g{(const bf16_t*)(ws + WS_CMPA) + (size_t)4096 * 1024, (const bf16_t*)(ws + WS_W1C) + (size_t)512 * 1024, 4096, 512, 1024}; pg8::StaticOrder S; S.init(4096, 512, F.G, (int)((blockIdx.x + F.G / 2) % F.G));
              EpiF32P E{(float*)(ws + WS_CMPP) + (size_t)4096 * 512, 512};
              pg8::gemm_phase<EpiF32P, pg8::StaticOrder, false>(F.lds, g, S, E, nullptr); }
        }
        SEAM(3);
        if (IN(4)) { MKFRAME(); phase_cmp2(p, l, F); }
        SEAM(4);
        if (IN(5)) { MKFRAME(); phase_attn(p, l, F); }
        SEAM(5);
        if (IN(6)) { MKFRAME(); WSP(ws); pg8::Gemm g{(const bf16_t*)(ws + WS_Y), (const bf16_t*)(ws + WS_WBR), 4 * T, 4096, 512}; BranchOrder S{F.G, (int)blockIdx.x};
            EpiBranch E{(const bf16_t*)(ws + WS_GATES), (bf16_t*)(ws + WS_GZ)};
            pg8::gemm_phase<EpiBranch, BranchOrder, false>(F.lds, g, S, E, nullptr); }
        SEAM(6);
        if (IN(7)) { MKFRAME(); WSP(ws); pg8::Gemm g{(const bf16_t*)(ws + WS_GZ), (const bf16_t*)(ws + WS_WOUT4), T, 1024, 4096}; pg8::StaticOrder S; S.init(T, 1024, F.G, (int)blockIdx.x);
            EpiRes E{l == 0 ? p.in[I_X] : p.out, p.out};
            pg8::gemm_phase<EpiRes, pg8::StaticOrder, false>(F.lds, g, S, E, nullptr); }
        SEAM(7);
        if (IN(8)) { MKFRAME(); WSP(ws); rmsnorm_rows(p.out, p.in[I_GFFN] + l * 1024, (bf16_t*)(ws + WS_H), F.vb * 8 + F.wave, F.G * 8, F.lane); }
        SEAM(8);
        if (IN(9)) { MKFRAME(); WSP(ws);
            { pg8::Gemm g{(const bf16_t*)(ws + WS_H), (const bf16_t*)(ws + WS_WQ), T, 1024, 1024}; pg8::StaticOrder S; S.init(T, 1024, F.G, (int)blockIdx.x); EpiBf E{(bf16_t*)(ws + WS_QP), 1024};
              pg8::gemm_phase<EpiBf, pg8::StaticOrder, false>(F.lds, g, S, E, nullptr); }
        }
        if (IN(9)) { MKFRAME(); WSP(ws);
            { pg8::Gemm g{(const bf16_t*)(ws + WS_PB), (const bf16_t*)(ws + WS_WPP), T, 1024, 256}; pg8::StaticOrder S; S.init(T, 1024, F.G, (int)blockIdx.x); EpiBf E{(bf16_t*)(ws + WS_PP), 1024};
              pg8::gemm_phase<EpiBf, pg8::StaticOrder, false>(F.lds, g, S, E, nullptr); }
        }
        SEAM(9);
        if (IN(10)) { MKFRAME(); phase_peer(p, l, F); }
        SEAM(10);
        if (IN(11)) { MKFRAME(); WSP(ws); rmsnorm_rows(p.out, p.in[I_GPLE] + l * 1024, (bf16_t*)(ws + WS_H), F.vb * 8 + F.wave, F.G * 8, F.lane); }
        SEAM(11);
        if (IN(12)) { MKFRAME(); WSP(ws); pg8::Gemm g{(const bf16_t*)(ws + WS_H), (const bf16_t*)(ws + WS_WPG), T, 1024, 1024}; pg8::StaticOrder S; S.init(T, 1024, F.G, (int)blockIdx.x);
            EpiPle E{p.out, (const bf16_t*)(ws + WS_PP)};
            pg8::gemm_phase<EpiPle, pg8::StaticOrder, false>(F.lds, g, S, E, nullptr); }
        SEAM(12);
#undef IN
#undef SEAM
    }
}
}

#ifndef MK_LAUNCH_PER_PHASE
#define MK_LAUNCH_PER_PHASE 1
#endif
extern "C" void kernel_launch(void* const* d_in, const int* in_sizes, int n_in, void* d_out, int out_size, void* d_ws, size_t ws_size, hipStream_t stream) {
    static int grid = 0;
    if (grid == 0) {
        if (n_in != 27 || ws_size < mk::WS_END) { fprintf(stderr, "kernel_launch: need 27 inputs and >= %zu bytes of workspace (got %d, %zu)\n", (size_t)mk::WS_END, n_in, ws_size); grid = -1; return; }
        int dev = 0, cus = 0;
        if (hipGetDevice(&dev) != hipSuccess || hipDeviceGetAttribute(&cus, hipDeviceAttributeMultiprocessorCount, dev) != hipSuccess) { grid = -1; return; }
        if (hipFuncSetAttribute((const void*)mk::mega, hipFuncAttributeMaxDynamicSharedMemorySize, mk::LDS_BYTES) != hipSuccess) { fprintf(stderr, "kernel_launch: hipFuncSetAttribute failed\n"); grid = -1; return; }
        int per_cu = 0;
        if (hipOccupancyMaxActiveBlocksPerMultiprocessor(&per_cu, (const void*)mk::mega, 512, mk::LDS_BYTES) != hipSuccess || per_cu < 1) fprintf(stderr, "kernel_launch: occupancy query says %d\n", per_cu);
        (void)hipGetLastError();
        grid = cus;
    }
    if (grid < 0) return;
    (void)in_sizes; (void)out_size;
    hipMemsetAsync((char*)d_ws + mk::WS_CTL, 0, 1u << 20, stream);
    mk::Params prm{};
    for (int i = 0; i < 27; ++i) prm.in[i] = (const float*)d_in[i];
    prm.out = (float*)d_out; prm.ws = (unsigned char*)d_ws;
#if MK_LAUNCH_PER_PHASE
    for (int ph = 0; ph < mk::NLAYER * mk::NPH; ++ph) { prm.ph_lo = ph; prm.ph_hi = ph + 1; hipLaunchKernelGGL(mk::mega, dim3(grid), dim3(512), mk::LDS_BYTES, stream, prm); }
#else
    prm.ph_lo = 0; prm.ph_hi = mk::NLAYER * mk::NPH; hipLaunchKernelGGL(mk::mega, dim3(grid), dim3(512), mk::LDS_BYTES, stream, prm);
#endif
}
```

```cpp
#include <hip/hip_runtime.h>
#include <stdio.h>
#include <stdint.h>
namespace pg8 {
#define PG8_LAS __attribute__((address_space(3)))
typedef unsigned short bf16_t;
typedef short bf16x8 __attribute__((ext_vector_type(8)));
typedef float f32x4 __attribute__((ext_vector_type(4)));
typedef unsigned u32x4 __attribute__((ext_vector_type(4)));
constexpr int BM = 256, BK = 64, HALF = 128, HTB = HALF * BK * 2  , STAGE_BYTES = 8 * HTB, NXCD = 8, WGM = 8;

__host__ __device__ __forceinline__ int lds_byte(int r, int c) { const int st = (r >> 4) * 2 + (c >> 5), rr = r & 15, cc = c & 31, ob = rr * 64 + cc * 2; return st * 1024 + (ob ^ (((ob >> 9) & 1) << 5)); }
__host__ __device__ __forceinline__ void stage_rc(int b, int& R, int& C) { const int st = b / 1024, sb = b % 1024, swz = sb ^ (((sb >> 9) & 1) << 5); R = (st >> 1) * 16 + swz / 64; C = (st & 1) * 32 + (swz % 64) / 2; }
__host__ __device__ __forceinline__ int perm32(int rho) { const int n = rho >> 4, i = rho & 15; return 8 * (i >> 2) + 4 * n + (i & 3); }

struct Unit { int pm, pn; };
struct Gemm { const bf16_t* A; const bf16_t* Bt; int M, N, K; };

struct StaticOrder {
    int nM, nN, nwg, G, c;
    __host__ __device__ void init(int M, int N, int G_, int c_) { nM = M / BM; nN = N / BM; nwg = nM * nN; G = G_; c = c_; }
    __host__ __device__ bool next(int i, Unit& u) const {
        const long L = (long)i * G + c; if (L >= nwg) return false;
        int wgid = (int)L; { const int q = nwg / NXCD, r = nwg % NXCD, xcd = wgid % NXCD, off = wgid / NXCD; wgid = (xcd < r ? xcd * (q + 1) : r * (q + 1) + (xcd - r) * q) + off; }
        const int nig = WGM * nN, gid = wgid / nig, fm = gid * WGM, gsz = (nM - fm) < WGM ? (nM - fm) : WGM;
        u.pm = fm + ((wgid % nig) % gsz); u.pn = (wgid % nig) / gsz; return true;
    }
    __device__ __forceinline__ void a_ready(const Unit&) const {}
    __device__ __forceinline__ void done(const Unit&) const {}
};
__device__ __forceinline__ unsigned cvt_pk_bf16(float lo, float hi) { unsigned r; asm volatile("v_cvt_pk_bf16_f32 %0, %1, %2" : "=v"(r) : "v"(lo), "v"(hi)); return r; }
template <class Epi, class Sched, bool STAMP = false>
__device__ __forceinline__ void gemm_phase(PG8_LAS unsigned char* lds, const Gemm g, const Sched& S, const Epi& E, unsigned long long* stamps) {
    int tid_l = threadIdx.x; asm volatile("" : "+v"(tid_l));
    const int tid = tid_l, wid = __builtin_amdgcn_readfirstlane(tid >> 6), lane = tid & 63, wr = wid >> 2, wc = wid & 3, fr = lane & 15, fq = lane >> 4;
    const int K = g.K, nt = K / BK;
    int ts_lo = 0, ts_hi = 0, nts = 0; const unsigned long long rt_entry = STAMP ? (unsigned long long)wall_clock64() : 0ull;
#define PG8_STAMP() do { if (STAMP && wid == 0 && nts < 64) { const unsigned long long _c = (unsigned long long)clock64(); \
        ts_lo = (lane == nts) ? (int)(unsigned)_c : ts_lo; ts_hi = (lane == nts) ? (int)(unsigned)(_c >> 32) : ts_hi; ++nts; } } while (0)
    PG8_STAMP();
    unsigned voffA[2], voffB[2];
#pragma unroll
    for (int i = 0; i < 2; ++i) { int R, C; stage_rc(tid * 16 + i * 8192, R, C); const int Rb = Epi::PERM ? ((R & ~31) + perm32(R & 31)) : R;
        voffA[i] = (unsigned)(R * K + C) * 2u; voffB[i] = (unsigned)(Rb * K + C) * 2u; }
    const size_t kstep = (size_t)(BK * 2);
    const size_t hstep = (size_t)HALF * K * 2;
    const size_t tstep = 2 * hstep;
    const unsigned ldsw = (unsigned)wid * 1024u;
    const int aoff = lds_byte(wr * 64 + fr, fq * 8), boff = lds_byte(wc * 32 + fr, fq * 8);
#define PG8_SA(b, h) (((b) * 2 + (h)) * HTB)
#define PG8_SB(b, h) ((4 + (b) * 2 + (h)) * HTB)
#define PG8_STAGE(bufoff, gbase, voff) do { _Pragma("unroll") for (int _i = 0; _i < 2; ++_i) \
        __builtin_amdgcn_global_load_lds((const unsigned*)((const char*)(gbase) + (voff)[_i]), (PG8_LAS unsigned*)(lds + (bufoff) + ldsw + _i * 8192), 16, 0, 0); } while (0)
#define PG8_LDA(dst, b, h) do { _Pragma("unroll") for (int m = 0; m < 4; ++m) _Pragma("unroll") for (int k = 0; k < 2; ++k) dst[m][k] = *(const PG8_LAS bf16x8*)(lds + PG8_SA(b, h) + aoff + m * 2048 + k * 1024); } while (0)
#define PG8_LDB(dst, b, h) do { _Pragma("unroll") for (int n = 0; n < 2; ++n) _Pragma("unroll") for (int k = 0; k < 2; ++k) dst[n][k] = *(const PG8_LAS bf16x8*)(lds + PG8_SB(b, h) + boff + n * 2048 + k * 1024); } while (0)
#define PG8_MMA(ai, bj, At, Bt) do { __builtin_amdgcn_s_setprio(1); _Pragma("unroll") for (int m = 0; m < 4; ++m) _Pragma("unroll") for (int n = 0; n < 2; ++n) _Pragma("unroll") for (int k = 0; k < 2; ++k) \
        acc[ai][bj][m][n] = __builtin_amdgcn_mfma_f32_16x16x32_bf16(Bt[n][k], At[m][k], acc[ai][bj][m][n], 0, 0, 0); __builtin_amdgcn_s_setprio(0); } while (0)
#define PG8_WAIT_V(n) asm volatile("s_waitcnt vmcnt(" #n ")" ::: "memory")
#define PG8_WAIT_L(n) asm volatile("s_waitcnt lgkmcnt(" #n ")" ::: "memory")
#define PG8_BAR __builtin_amdgcn_s_barrier()
#define PG8_SCHED __builtin_amdgcn_sched_barrier(0)
    Unit cur, nxt; int ui = 0;
    if (!S.next(0, cur)) return;
    f32x4 acc[2][2][4][2];
#pragma unroll
    for (int a = 0; a < 2; ++a)
#pragma unroll
        for (int b = 0; b < 2; ++b)
#pragma unroll
            for (int m = 0; m < 4; ++m)
#pragma unroll
                for (int n = 0; n < 2; ++n) acc[a][b][m][n] = (f32x4){0.f, 0.f, 0.f, 0.f};
    bf16x8 At[4][2], B0[2][2], B1[2][2];
    const char* cA = (const char*)g.A + (size_t)cur.pm * tstep; const char* cB = (const char*)g.Bt + (size_t)cur.pn * tstep;
    S.a_ready(cur);
    PG8_STAGE(PG8_SB(0, 0), cB, voffB); PG8_STAGE(PG8_SA(0, 0), cA, voffA); PG8_STAGE(PG8_SB(0, 1), cB + hstep, voffB); PG8_STAGE(PG8_SA(0, 1), cA + hstep, voffA);
    if (wr == 1) PG8_BAR;
    PG8_WAIT_V(4); PG8_BAR;
    PG8_STAGE(PG8_SB(1, 0), cB + kstep, voffB); PG8_STAGE(PG8_SA(1, 0), cA + kstep, voffA); PG8_STAGE(PG8_SB(1, 1), cB + hstep + kstep, voffB);
    PG8_WAIT_V(6); PG8_BAR;
    PG8_STAMP();
    for (;;) {
        const bool has_next = S.next(ui + 1, nxt);
        const char* nA = has_next ? (const char*)g.A + (size_t)nxt.pm * tstep : cA; const char* nB = has_next ? (const char*)g.Bt + (size_t)nxt.pn * tstep : cB;
        for (int t = 0; t < nt; t += 2) {
            const bool last = (t == nt - 2);
            const char* a1 = cA + (size_t)(t + 1) * kstep;
            const char* a2 = last ? nA : cA + (size_t)(t + 2) * kstep; const char* b2 = last ? nB : cB + (size_t)(t + 2) * kstep;
            const char* a3 = a2 + kstep; const char* b3 = b2 + kstep;
            if (last && has_next) S.a_ready(nxt);
            PG8_LDB(B0, 0, 0); PG8_SCHED; PG8_LDA(At, 0, 0); PG8_STAGE(PG8_SA(1, 1), a1 + hstep, voffA);
            PG8_WAIT_L(8); PG8_BAR; PG8_WAIT_L(0); PG8_MMA(0, 0, At, B0); PG8_BAR; PG8_SCHED;
            PG8_LDB(B1, 0, 1); PG8_STAGE(PG8_SB(0, 0), b2, voffB);
            PG8_BAR; PG8_WAIT_L(0); PG8_MMA(0, 1, At, B1); PG8_BAR;
            PG8_LDA(At, 0, 1); PG8_STAGE(PG8_SA(0, 0), a2, voffA);
            PG8_BAR; PG8_WAIT_L(0); PG8_MMA(1, 0, At, B0); PG8_BAR; PG8_SCHED;
            PG8_STAGE(PG8_SB(0, 1), b2 + hstep, voffB);
            PG8_WAIT_V(6); PG8_BAR; PG8_MMA(1, 1, At, B1); PG8_BAR;
            PG8_LDB(B0, 1, 0); PG8_SCHED; PG8_LDA(At, 1, 0); PG8_STAGE(PG8_SA(0, 1), a2 + hstep, voffA);
            PG8_WAIT_L(8); PG8_BAR; PG8_WAIT_L(0); PG8_MMA(0, 0, At, B0); PG8_BAR; PG8_SCHED;
            PG8_LDB(B1, 1, 1); PG8_STAGE(PG8_SB(1, 0), b3, voffB);
            PG8_BAR; PG8_WAIT_L(0); PG8_MMA(0, 1, At, B1); PG8_BAR;
            PG8_LDA(At, 1, 1); PG8_STAGE(PG8_SA(1, 0), a3, voffA);
            PG8_BAR; PG8_WAIT_L(0); PG8_MMA(1, 0, At, B0); PG8_BAR; PG8_SCHED;
            PG8_STAGE(PG8_SB(1, 1), b3 + hstep, voffB);
            PG8_WAIT_V(6); PG8_BAR; PG8_MMA(1, 1, At, B1); PG8_BAR;
        }
        PG8_STAMP();
        if constexpr (!Epi::AFTER_DRAIN) { E(acc, cur, wr, wc, fr, fq); S.done(cur); }
        PG8_STAMP();
        if (!has_next) break;
#pragma unroll
        for (int a = 0; a < 2; ++a)
#pragma unroll
            for (int b = 0; b < 2; ++b)
#pragma unroll
                for (int m = 0; m < 4; ++m)
#pragma unroll
                    for (int n = 0; n < 2; ++n) acc[a][b][m][n] = (f32x4){0.f, 0.f, 0.f, 0.f};
        cur = nxt; cA = nA; cB = nB; ++ui;
    }
    PG8_WAIT_V(0);
    if (wr == 0) PG8_BAR;
    PG8_BAR;
    if constexpr (Epi::AFTER_DRAIN) { E.fused(acc, cur, wr, wc, fr, fq, lds, wid, lane); S.done(cur); }
    PG8_STAMP();
    if (STAMP && wid == 0) { stamps[lane] = lane < nts ? (((unsigned long long)(unsigned)ts_hi << 32) | (unsigned)ts_lo) : 0ull;
        if (lane == 62) stamps[62] = rt_entry; if (lane == 63) stamps[63] = (unsigned long long)wall_clock64(); }
#undef PG8_STAMP
#undef PG8_SA
#undef PG8_SB
#undef PG8_STAGE
#undef PG8_LDA
#undef PG8_LDB
#undef PG8_MMA
#undef PG8_WAIT_V
#undef PG8_WAIT_L
#undef PG8_BAR
#undef PG8_SCHED
}
}
#define XB_TMO      128
#define XB_XCNT(j)  (256  + 64 * (j))
#define XB_XSUB(j)  (1280 + 64 * (j))
#define XB_XGEN(j)  (2304 + 64 * (j))
#define XB_TOP      3328
#define XB_TOPGEN   3392
#define XCD_BAR_WORDS 3456
#define XB_SPIN_CAP (1u << 18)
#define LAS __attribute__((address_space(3)))

__device__ __forceinline__ unsigned xb_ld(unsigned* p)              { return __hip_atomic_load(p, __ATOMIC_RELAXED, __HIP_MEMORY_SCOPE_AGENT); }
__device__ __forceinline__ unsigned xb_add(unsigned* p, unsigned v) { return __hip_atomic_fetch_add(p, v, __ATOMIC_RELAXED, __HIP_MEMORY_SCOPE_AGENT); }
__device__ __forceinline__ unsigned xb_xcc_id() { return (unsigned)__builtin_amdgcn_s_getreg((3 << 11) | 20) & 0xFu; }
#define XB_SPIN(cond, bar) do { unsigned _sp = 0; while (cond) { __builtin_amdgcn_s_sleep(1); \
    if ((++_sp & 255u) == 0u) { if (xb_ld(&(bar)[XB_TMO])) break; if (_sp > XB_SPIN_CAP) { atomicAdd(&(bar)[XB_TMO], 1u); break; } } } } while (0)

struct XcdBarrier {
    unsigned* bar; unsigned x;
    volatile LAS unsigned* st;
};

__device__ __forceinline__ XcdBarrier xcd_barrier_post(unsigned* bar, volatile LAS unsigned* st) {
    XcdBarrier b; b.bar = bar; b.x = xb_xcc_id(); b.st = st;
    if (threadIdx.x == 0) (void)xb_add(&bar[XB_XCNT(b.x)], 1u);
    return b;
}
__device__ __forceinline__ void xcd_barrier_complete(unsigned* bar, unsigned x, unsigned& nloc, unsigned& nx) {
    const unsigned G = gridDim.x * gridDim.y * gridDim.z;
    unsigned sum, cnt, mine, sp = 0u;
    for (;;) {
        sum = 0u; cnt = 0u; mine = 0u;
#pragma unroll
        for (unsigned j = 0; j < 16; ++j) { const unsigned c = xb_ld(&bar[XB_XCNT(j)]); sum += c; cnt += (c > 0u) ? 1u : 0u; mine = (j == x) ? c : mine; }
        if (sum == G) break;
        __builtin_amdgcn_s_sleep(1);
        if ((++sp & 255u) == 0u) { if (xb_ld(&bar[XB_TMO])) break; if (sp > XB_SPIN_CAP) { atomicAdd(&bar[XB_TMO], 1u); break; } }
    }
    nloc = mine > 0u ? mine : 1u; nx = cnt > 0u ? cnt : 1u;
}

__device__ __forceinline__ void xcd_barrier(const XcdBarrier& b) {
    asm volatile("s_waitcnt vmcnt(0)" ::: "memory");
    __syncthreads();
    if (threadIdx.x == 0) {
        unsigned* bar = b.bar;
        __builtin_amdgcn_s_waitcnt(0);
        unsigned nloc = b.st[0], nx = b.st[1];
        if (nloc == 0u) { xcd_barrier_complete(bar, b.x, nloc, nx); b.st[0] = nloc; b.st[1] = nx; }
        const unsigned old = xb_add(&bar[XB_XSUB(b.x)], 1u);
        const unsigned gen = old / nloc;
        if (old + 1u == (gen + 1u) * nloc) {
            __builtin_amdgcn_fence(__ATOMIC_RELEASE, "agent");
            asm volatile("s_waitcnt vmcnt(0)" ::: "memory");
            const unsigned og = xb_add(&bar[XB_TOP], 1u);
            const unsigned tg = og / nx;
            if (og + 1u == (tg + 1u) * nx) xb_add(&bar[XB_TOPGEN], 1u);
            else XB_SPIN(xb_ld(&bar[XB_TOPGEN]) == tg, bar);
            __builtin_amdgcn_fence(__ATOMIC_ACQUIRE, "agent");
            xb_add(&bar[XB_XGEN(b.x)], 1u);
            asm volatile("s_waitcnt vmcnt(0)" ::: "memory");
        } else {
            XB_SPIN(xb_ld(&bar[XB_XGEN(b.x)]) == gen, bar);
            __builtin_amdgcn_fence(__ATOMIC_ACQUIRE, "agent");
            asm volatile("s_waitcnt vmcnt(0)" ::: "memory");
        }
    }
    __syncthreads();
}

namespace mk {
using pg8::bf16_t; using pg8::bf16x8; using pg8::f32x4; using pg8::u32x4;
typedef unsigned u32x2 __attribute__((ext_vector_type(2)));
typedef short s16x4 __attribute__((ext_vector_type(4)));
#define DI __device__ __forceinline__
#define LDS_WAIT() asm volatile("s_waitcnt lgkmcnt(0)" ::: "memory")
#define LDS_FENCE() asm volatile("" ::: "memory")
#define MFMA16(a, b, c) __builtin_amdgcn_mfma_f32_16x16x32_bf16((a), (b), (c), 0, 0, 0)

constexpr int T = 32768, SEQ = 4096, NLAYER = 4, NPH = 13;
constexpr int PW = 5120;
constexpr int C_AB = 0, C_AC = 512, C_AX = 1024, C_NQ = 1536, C_NKV = 2048, C_UV = 2816, C_DQ = 3840, C_DK = 4352, C_DV = 4416,
              C_DQI = 4480, C_DKI = 4992, C_NG = 5056, C_DWI = 5080;
constexpr size_t MiB = 1u << 20;
constexpr size_t WS_CTL = 0, WS_PEB = 1 * MiB, WS_CMPK = 2 * MiB, WS_CMPV = 3 * MiB, WS_SK = 4 * MiB, WS_SGUW = 5 * MiB, WS_CMPA = 8 * MiB,
                 WS_CMPP = 24 * MiB, WS_WCAT = 40 * MiB, WS_WBR = 58 * MiB, WS_WOUT4 = 62 * MiB, WS_WQ = 70 * MiB, WS_WPG = 72 * MiB,
                 WS_WPP = 74 * MiB, WS_W1C = 75 * MiB, WS_PB = 78 * MiB, WS_PTU = 96 * MiB, WS_PTV = 128 * MiB, WS_H = 160 * MiB,
                 WS_Y = 224 * MiB, WS_PROJ = 352 * MiB, WS_GATES = 672 * MiB,
                 WS_KS = 928 * MiB, WS_VS = 936 * MiB, WS_KW = 944 * MiB, WS_VW = 952 * MiB, WS_DK = 960 * MiB, WS_DV = 964 * MiB, WS_DKI = 968 * MiB, WS_END = 972 * MiB;
constexpr size_t WS_ACCF = WS_PROJ, WS_MERGED = WS_PROJ + 128 * MiB, WS_QP = WS_PROJ, WS_PP = WS_PROJ + 64 * MiB, WS_EIDX = WS_PROJ + 128 * MiB, WS_EW = WS_PROJ + 144 * MiB, WS_EU = WS_PROJ + 160 * MiB;
constexpr int LDS_BYTES = 163840, LDS_PERWAVE = 19456, LDS_BUCK = 8 * LDS_PERWAVE, LDS_TBL = LDS_BUCK + 4096, LDS_XB = LDS_BYTES - 64;

struct Params { const float* in[27]; float* out; unsigned char* ws; int ph_lo, ph_hi; };
enum { I_X = 0, I_P, I_REL, I_GMIX, I_WIN, I_CONVW, I_PE, I_CW1, I_CW2, I_NQG, I_NKG, I_LNG, I_SGUW, I_SGUB, I_DQG, I_DKG, I_WGATE, I_WBR, I_WOUT,
       I_GFFN, I_WQ, I_SUBK, I_PU, I_PV, I_GPLE, I_WPG, I_WPP };

struct Frame { LAS unsigned char* lds; int tid, lane, wave, vb, G; };

DI float bf2f(unsigned short b) { return __uint_as_float(((unsigned)b) << 16); }
DI unsigned f2bf(float f) { unsigned u = __float_as_uint(f); return (u + 0x7fffu + ((u >> 16) & 1u)) >> 16; }
DI unsigned pk2(float lo, float hi) { return pg8::cvt_pk_bf16(lo, hi); }
DI float lo16(unsigned w) { return __uint_as_float(w << 16); }
DI float hi16(unsigned w) { return __uint_as_float(w & 0xffff0000u); }
DI float sigm(float x) { return __builtin_amdgcn_rcpf(1.f + __builtin_amdgcn_exp2f(-1.44269504f * x)); }
DI float gelu_t(float x) { const float y = (-2.f * 0.7978845608f * 1.44269504f) * (x + 0.044715f * x * x * x); return x * __builtin_amdgcn_rcpf(1.f + __builtin_amdgcn_exp2f(y)); }
#define DPP_I(x, ctrl) __builtin_amdgcn_update_dpp(0, (x), (ctrl), 0xF, 0xF, false)
DI float dppf(float x, int) { return x; }
DI float row16_sumf(float v) { v += __builtin_bit_cast(float, DPP_I(__builtin_bit_cast(int, v), 0xB1)); v += __builtin_bit_cast(float, DPP_I(__builtin_bit_cast(int, v), 0x4E));
    v += __builtin_bit_cast(float, DPP_I(__builtin_bit_cast(int, v), 0x141)); v += __builtin_bit_cast(float, DPP_I(__builtin_bit_cast(int, v), 0x140)); return v; }
DI float row16_maxf(float v) { v = fmaxf(v, __builtin_bit_cast(float, DPP_I(__builtin_bit_cast(int, v), 0xB1))); v = fmaxf(v, __builtin_bit_cast(float, DPP_I(__builtin_bit_cast(int, v), 0x4E)));
    v = fmaxf(v, __builtin_bit_cast(float, DPP_I(__builtin_bit_cast(int, v), 0x141))); v = fmaxf(v, __builtin_bit_cast(float, DPP_I(__builtin_bit_cast(int, v), 0x140))); return v; }
DI float quad_sumf(float v) { v += __builtin_bit_cast(float, DPP_I(__builtin_bit_cast(int, v), 0xB1)); v += __builtin_bit_cast(float, DPP_I(__builtin_bit_cast(int, v), 0x4E)); return v; }
DI float oct_sumf(float v) { v = quad_sumf(v); v += __builtin_bit_cast(float, DPP_I(__builtin_bit_cast(int, v), 0x141)); return v; }
DI float wave_sum(float v) { v = row16_sumf(v); v += __shfl_xor(v, 16); v += __shfl_xor(v, 32); return v; }
DI float wave_max(float v) { v = row16_maxf(v); v = fmaxf(v, __shfl_xor(v, 16)); v = fmaxf(v, __shfl_xor(v, 32)); return v; }
DI unsigned ordf(float f) { const unsigned u = __float_as_uint(f); return (u & 0x80000000u) ? ~u : (u | 0x80000000u); }
DI float unordf(unsigned x) { return __uint_as_float((x & 0x80000000u) ? (x & 0x7fffffffu) : ~x); }
DI int bucket_of(int n) {
    if (n < 16) return n;
    int b = 16;
    b += (n >= 21); b += (n >= 27); b += (n >= 35); b += (n >= 46); b += (n >= 59); b += (n >= 77); b += (n >= 99); b += (n >= 128);
    b += (n >= 166); b += (n >= 216); b += (n >= 280); b += (n >= 363); b += (n >= 470); b += (n >= 609); b += (n >= 790);
    return b; }

DI int srccol(int n) { return n < 2816 ? n : (n < 5056 ? n + 24 : (n < 5080 ? n - 2240 : (n < 5088 ? n : -1))); }
DI void tr_item(const float* W, int ldw, bf16_t* WT, int ldwt, int k0, int n0, LAS float* scr, int lane, bool remap, int ncopy, int cstride) {
    float tv[32];
#pragma unroll
    for (int i = 0; i < 32; ++i) { const int kk = 2 * i + (lane >> 5), nl = lane & 31; const int n = n0 + nl; const int src = remap ? srccol(n) : n; tv[i] = src >= 0 ? W[(size_t)(k0 + kk) * ldw + src] : 0.f; }
#pragma unroll
    for (int i = 0; i < 32; ++i) { const int kk = 2 * i + (lane >> 5), nl = lane & 31; scr[kk * 33 + nl] = tv[i]; }
    LDS_WAIT();
    const int c = lane & 7;
#pragma unroll
    for (int j = 0; j < 4; ++j) { const int n = (lane >> 3) + 8 * j; const LAS float* s = scr + (8 * c) * 33 + n;
        u32x4 o; o.x = pk2(s[0], s[33]); o.y = pk2(s[66], s[99]); o.z = pk2(s[132], s[165]); o.w = pk2(s[198], s[231]);
        for (int cp = 0; cp < ncopy; ++cp) *(u32x4*)(WT + (size_t)(n0 + n) * ldwt + (size_t)cp * cstride + k0 + 8 * c) = o; }
    LDS_WAIT();
}
DI void cvt_rows(const float* src, bf16_t* dst, size_t ngroups8, int gw, int NGW, int lane) {
    const size_t st = (size_t)NGW * 64;
    for (size_t i0 = (size_t)gw * 64 + lane; i0 < ngroups8; i0 += 4 * st) {
        f32x4 a[4], b[4];
#pragma unroll
        for (int r = 0; r < 4; ++r) { const size_t i = i0 + r * st < ngroups8 ? i0 + r * st : i0; a[r] = ((const f32x4*)src)[2 * i]; b[r] = ((const f32x4*)src)[2 * i + 1]; }
#pragma unroll
        for (int r = 0; r < 4; ++r) { const size_t i = i0 + r * st; if (i >= ngroups8) break;
            u32x4 o; o.x = pk2(a[r].x, a[r].y); o.y = pk2(a[r].z, a[r].w); o.z = pk2(b[r].x, b[r].y); o.w = pk2(b[r].z, b[r].w); ((u32x4*)dst)[i] = o; }
    }
}
DI int pk4_fp8(float a, float b, float c, float d) { int w = 0; w = __builtin_amdgcn_cvt_pk_fp8_f32(a, b, w, false); w = __builtin_amdgcn_cvt_pk_fp8_f32(c, d, w, true); return w; }
DI void cvt_rows_fp8(const float* src, unsigned char* dst, float* scl, int nrows, int gw, int NGW, int lane) {
    for (int r0 = gw; r0 < nrows; r0 += 4 * NGW) {
        f32x4 a[4], b[4], c[4], d[4];
#pragma unroll
        for (int k = 0; k < 4; ++k) { const int r = r0 + k * NGW < nrows ? r0 + k * NGW : r0; const float* s = src + (size_t)r * 1024 + lane * 16;
            a[k] = *(const f32x4*)s; b[k] = *(const f32x4*)(s + 4); c[k] = *(const f32x4*)(s + 8); d[k] = *(const f32x4*)(s + 12); }
#pragma unroll
        for (int k = 0; k < 4; ++k) { const int r = r0 + k * NGW; if (r >= nrows) break;
            float mx = fmaxf(fmaxf(fmaxf(fabsf(a[k].x), fabsf(a[k].y)), fmaxf(fabsf(a[k].z), fabsf(a[k].w))), fmaxf(fmaxf(fabsf(b[k].x), fabsf(b[k].y)), fmaxf(fabsf(b[k].z), fabsf(b[k].w))));
            mx = fmaxf(mx, fmaxf(fmaxf(fmaxf(fabsf(c[k].x), fabsf(c[k].y)), fmaxf(fabsf(c[k].z), fabsf(c[k].w))), fmaxf(fmaxf(fabsf(d[k].x), fabsf(d[k].y)), fmaxf(fabsf(d[k].z), fabsf(d[k].w)))));
            mx = wave_max(mx);
            const float sc = mx > 0.f ? mx * (1.f / 448.f) : 1.f, inv = 1.f / sc;
            u32x4 o; o.x = (unsigned)pk4_fp8(a[k].x * inv, a[k].y * inv, a[k].z * inv, a[k].w * inv); o.y = (unsigned)pk4_fp8(b[k].x * inv, b[k].y * inv, b[k].z * inv, b[k].w * inv);
            o.z = (unsigned)pk4_fp8(c[k].x * inv, c[k].y * inv, c[k].z * inv, c[k].w * inv); o.w = (unsigned)pk4_fp8(d[k].x * inv, d[k].y * inv, d[k].z * inv, d[k].w * inv);
            *(u32x4*)(dst + (size_t)r * 1024 + lane * 16) = o;
            if (lane == 0) scl[r] = sc; }
    }
}
DI void rmsnorm_rows(const float* x, const float* g, bf16_t* H, int gw, int NGW, int lane) {
    const f32x4 g0 = *(const f32x4*)(g + lane * 8), g1 = *(const f32x4*)(g + lane * 8 + 4), g2 = *(const f32x4*)(g + 512 + lane * 8), g3 = *(const f32x4*)(g + 512 + lane * 8 + 4);
    for (int m0 = gw; m0 < T; m0 += 4 * NGW) {
        f32x4 a[4], b[4], c[4], d[4];
#pragma unroll
        for (int r = 0; r < 4; ++r) { const int m = m0 + r * NGW < T ? m0 + r * NGW : m0; const float* xr = x + (size_t)m * 1024 + lane * 8;
            a[r] = *(const f32x4*)xr; b[r] = *(const f32x4*)(xr + 4); c[r] = *(const f32x4*)(xr + 512); d[r] = *(const f32x4*)(xr + 516); }
#pragma unroll
        for (int r = 0; r < 4; ++r) { const int m = m0 + r * NGW; if (m >= T) break;
            float ss = a[r].x * a[r].x + a[r].y * a[r].y + a[r].z * a[r].z + a[r].w * a[r].w + b[r].x * b[r].x + b[r].y * b[r].y + b[r].z * b[r].z + b[r].w * b[r].w
                     + c[r].x * c[r].x + c[r].y * c[r].y + c[r].z * c[r].z + c[r].w * c[r].w + d[r].x * d[r].x + d[r].y * d[r].y + d[r].z * d[r].z + d[r].w * d[r].w;
            ss = wave_sum(ss);
            const float rr = rsqrtf(ss * (1.f / 1024.f) + 1e-6f);
            u32x4 o0, o1;
            o0.x = pk2(a[r].x * rr * g0.x, a[r].y * rr * g0.y); o0.y = pk2(a[r].z * rr * g0.z, a[r].w * rr * g0.w); o0.z = pk2(b[r].x * rr * g1.x, b[r].y * rr * g1.y); o0.w = pk2(b[r].z * rr * g1.z, b[r].w * rr * g1.w);
            o1.x = pk2(c[r].x * rr * g2.x, c[r].y * rr * g2.y); o1.y = pk2(c[r].z * rr * g2.z, c[r].w * rr * g2.w); o1.z = pk2(d[r].x * rr * g3.x, d[r].y * rr * g3.y); o1.w = pk2(d[r].z * rr * g3.z, d[r].w * rr * g3.w);
            bf16_t* hr = H + (size_t)m * 1024 + lane * 8; *(u32x4*)hr = o0; *(u32x4*)(hr + 512) = o1; }
    }
}
DI void phase_prep_w(const Params& p, int l, const Frame& F) {
    LAS float* scr = (LAS float*)(F.lds + F.wave * 8448);
    const int gw = F.vb * 8 + F.wave, NGW = F.G * 8, lane = F.lane;
    unsigned char* ws = p.ws;
    bf16_t* WCAT = (bf16_t*)(ws + WS_WCAT); bf16_t* WBR = (bf16_t*)(ws + WS_WBR); bf16_t* WOUT4 = (bf16_t*)(ws + WS_WOUT4); bf16_t* WQ = (bf16_t*)(ws + WS_WQ);
    bf16_t* WPG = (bf16_t*)(ws + WS_WPG); bf16_t* WPP = (bf16_t*)(ws + WS_WPP); bf16_t* W1C = (bf16_t*)(ws + WS_W1C);
    constexpr int I0 = 2560, I1 = 2048, I2 = 1024, I3 = 512, I4 = 512, I5 = 512, I6 = 128, I7 = 512, NIT = I0 + I1 + I2 + I3 + I4 + I5 + I6 + I7;
    for (int it = gw; it < NIT; it += NGW) {
        int r = it;
        if (r < I0) { tr_item(p.in[I_WIN] + (size_t)l * 1024 * 5088, 5088, WCAT, 1024, (r / 160) * 64, (r % 160) * 32, scr, lane, true, 1, 0); continue; } r -= I0;
        if (r < I1) { tr_item(p.in[I_WGATE] + (size_t)l * 1024 * 4096, 4096, WCAT + (size_t)5120 * 1024, 1024, (r / 128) * 64, (r % 128) * 32, scr, lane, false, 1, 0); continue; } r -= I1;
        if (r < I2) { const int m = r >> 8, rr = r & 255; tr_item(p.in[I_WBR] + ((size_t)l * 2048 + m * 512) * 1024, 1024, WBR + (size_t)m * 1024 * 512, 512, (rr / 32) * 64, (rr % 32) * 32, scr, lane, false, 1, 0); continue; } r -= I2;
        if (r < I3) { tr_item(p.in[I_WOUT] + (size_t)l * 1024 * 1024, 1024, WOUT4, 1024, (r / 32) * 64, (r % 32) * 32, scr, lane, false, 1, 0); continue; } r -= I3;
        if (r < I4) { tr_item(p.in[I_WQ] + (size_t)l * 1024 * 1024, 1024, WQ, 1024, (r / 32) * 64, (r % 32) * 32, scr, lane, false, 1, 0); continue; } r -= I4;
        if (r < I5) { tr_item(p.in[I_WPG] + (size_t)l * 1024 * 1024, 1024, WPG, 1024, (r / 32) * 64, (r % 32) * 32, scr, lane, false, 1, 0); continue; } r -= I5;
        if (r < I6) { tr_item(p.in[I_WPP] + (size_t)l * 256 * 1024, 1024, WPP, 256, (r / 32) * 64, (r % 32) * 32, scr, lane, false, 1, 0); continue; } r -= I6;
        { const int jh = r >> 7, rr = r & 127, j = jh >> 1, half = jh & 1;
          tr_item(p.in[I_CW1] + (((size_t)l * 2 + j) * 2048 + half * 1024) * 256, 256, W1C + ((size_t)j * 512 + half * 256) * 1024, 1024, (rr / 8) * 64, (rr % 8) * 32, scr, lane, false, 1, 0); }
    }
    cvt_rows_fp8(p.in[I_PU] + (size_t)l * 16384 * 1024, ws + WS_PTU, (float*)(ws + WS_PTV), 16384, gw, NGW, lane);
    cvt_rows_fp8(p.in[I_PV] + (size_t)l * 16384 * 1024, ws + WS_PTU + 16 * MiB, (float*)(ws + WS_PTV) + 16384, 16384, gw, NGW, lane);
    cvt_rows(p.in[I_SUBK] + (size_t)l * 131072, (bf16_t*)(ws + WS_SK), 131072 / 8, gw, NGW, lane);
    cvt_rows(p.in[I_P] + (size_t)l * T * 256, (bf16_t*)(ws + WS_PB), (size_t)T * 256 / 8, gw, NGW, lane);
    { const float* sw = p.in[I_SGUW] + (size_t)l * 131072; bf16_t* dst = (bf16_t*)(ws + WS_SGUW);
      for (int i = gw * 64 + lane; i < 131072 / 8; i += NGW * 64) { const int e = i * 8, t = (e >> 7) & 127, s0 = e & 127; float v[8];
#pragma unroll
          for (int k = 0; k < 8; ++k) v[k] = (s0 + k <= t) ? sw[e + k] : 0.f;
          u32x4 o; o.x = pk2(v[0], v[1]); o.y = pk2(v[2], v[3]); o.z = pk2(v[4], v[5]); o.w = pk2(v[6], v[7]); ((u32x4*)dst)[i] = o; } }
    { float* peb = (float*)(ws + WS_PEB);
      for (int o = gw; o < 512; o += NGW) { const int j = o >> 8, n = o & 255; const float* pe = p.in[I_PE] + ((size_t)l * 2 + j) * 2048; const float* w1 = p.in[I_CW1] + ((size_t)l * 2 + j) * 2048 * 256;
          float s = 0.f; for (int k = lane; k < 2048; k += 64) s += pe[k] * w1[(size_t)k * 256 + n];
          s = wave_sum(s); if (lane == 0) peb[o] = s; } }
    rmsnorm_rows(l == 0 ? p.in[I_X] : p.out, p.in[I_GMIX] + l * 1024, (bf16_t*)(ws + WS_H), gw, NGW, lane);
}

struct Epi1 {
    static constexpr bool PERM = true, AFTER_DRAIN = false;
    bf16_t* proj; bf16_t* gates;
    DI void operator()(const f32x4 (&acc)[2][2][4][2], const pg8::Unit& u, int wr, int wc, int fr, int fq) const {
        const int row0 = u.pm * 256 + wr * 64 + fr; const bool isg = u.pn >= 20;
        const int col0 = (isg ? (u.pn - 20) * 256 : u.pn * 256) + wc * 32 + 8 * fq; bf16_t* base = isg ? gates : proj; const int ldc = isg ? 4096 : PW;
#pragma unroll
        for (int ai = 0; ai < 2; ++ai)
#pragma unroll
            for (int m = 0; m < 4; ++m) { bf16_t* rowp = base + (size_t)(row0 + ai * 128 + m * 16) * ldc + col0;
#pragma unroll
                for (int bj = 0; bj < 2; ++bj) { f32x4 v0 = acc[ai][bj][m][0], v1 = acc[ai][bj][m][1];
                    if (isg) { v0.x = sigm(v0.x); v0.y = sigm(v0.y); v0.z = sigm(v0.z); v0.w = sigm(v0.w); v1.x = sigm(v1.x); v1.y = sigm(v1.y); v1.z = sigm(v1.z); v1.w = sigm(v1.w); }
                    u32x4 w; w.x = pk2(v0.x, v0.y); w.y = pk2(v0.z, v0.w); w.z = pk2(v1.x, v1.y); w.w = pk2(v1.z, v1.w);
                    __builtin_nontemporal_store(w, (u32x4*)(rowp + bj * 128)); } }
    }
};
struct EpiBf {
    static constexpr bool PERM = true, AFTER_DRAIN = false;
    bf16_t* O; int ldc;
    DI void operator()(const f32x4 (&acc)[2][2][4][2], const pg8::Unit& u, int wr, int wc, int fr, int fq) const {
        const int row0 = u.pm * 256 + wr * 64 + fr, col0 = u.pn * 256 + wc * 32 + 8 * fq;
#pragma unroll
        for (int ai = 0; ai < 2; ++ai)
#pragma unroll
            for (int m = 0; m < 4; ++m) { bf16_t* rowp = O + (size_t)(row0 + ai * 128 + m * 16) * ldc + col0;
#pragma unroll
                for (int bj = 0; bj < 2; ++bj) { const f32x4 v0 = acc[ai][bj][m][0], v1 = acc[ai][bj][m][1];
                    u32x4 w; w.x = pk2(v0.x, v0.y); w.y = pk2(v0.z, v0.w); w.z = pk2(v1.x, v1.y); w.w = pk2(v1.z, v1.w);
                    *(u32x4*)(rowp + bj * 128) = w; } }
    }
};
struct EpiF32P {
    static constexpr bool PERM = true, AFTER_DRAIN = false;
    float* C; int ldc;
    DI void operator()(const f32x4 (&acc)[2][2][4][2], const pg8::Unit& u, int wr, int wc, int fr, int fq) const {
        const int row0 = u.pm * 256 + wr * 64 + fr, col0 = u.pn * 256 + wc * 32 + 8 * fq;
#pragma unroll
        for (int ai = 0; ai < 2; ++ai)
#pragma unroll
            for (int m = 0; m < 4; ++m) { float* rowp = C + (size_t)(row0 + ai * 128 + m * 16) * ldc + col0;
#pragma unroll
                for (int bj = 0; bj < 2; ++bj) { *(f32x4*)(rowp + bj * 128) = acc[ai][bj][m][0]; *(f32x4*)(rowp + bj * 128 + 4) = acc[ai][bj][m][1]; } }
    }
};
struct XcdColOrder {
    int G, c;
    DI bool next(int i, pg8::Unit& u) const {
        if (G != 256) { const int Lx = i * G + c; if (Lx >= 128 * 36) return false; u.pm = Lx / 36; u.pn = Lx % 36; return true; }
        if (i >= 18) return false;
        const int x = c & 7, w = c >> 3;
        if (i < 16) { u.pm = 8 * i + (w & 7); u.pn = 4 * x + (w >> 3); }
        else { u.pm = 16 * x + 8 * (i - 16) + (w & 7); u.pn = 32 + (w >> 3); }
        return true; }
    DI void a_ready(const pg8::Unit&) const {}
    DI void done(const pg8::Unit&) const {}
};
struct RoundOrder {
    pg8::StaticOrder base; int r;
    DI bool next(int i, pg8::Unit& u) const { return i == 0 && base.next(r, u); }
    DI void a_ready(const pg8::Unit&) const {}
    DI void done(const pg8::Unit&) const {}
};
struct ColRangeOrder {
    int G, c, c0, c1;
    DI bool next(int i, pg8::Unit& u) const { const int nc = c1 - c0; const int Lx = i * G + c; if (Lx >= 128 * nc) return false; u.pm = Lx / nc; u.pn = c0 + Lx % nc; return true; }
    DI void a_ready(const pg8::Unit&) const {}
    DI void done(const pg8::Unit&) const {}
};
struct BranchOrder {
    int G, c;
    DI bool next(int i, pg8::Unit& u) const { const int tile = c + G * (i >> 2), m = i & 3; if (tile >= 512) return false; u.pm = m * 128 + (tile >> 2); u.pn = m * 4 + (tile & 3); return true; }
    DI void a_ready(const pg8::Unit&) const {}
    DI void done(const pg8::Unit&) const {}
};
struct EpiBranch {
    static constexpr bool PERM = true, AFTER_DRAIN = false;
    const bf16_t* gates; bf16_t* merged;
    DI void operator()(const f32x4 (&acc)[2][2][4][2], const pg8::Unit& u, int wr, int wc, int fr, int fq) const {
        const int m4 = u.pn >> 2; const int row0 = (u.pm & 127) * 256 + wr * 64 + fr, gcol0 = u.pn * 256 + wc * 32 + 8 * fq, dcol0 = (u.pn & 3) * 256 + wc * 32 + 8 * fq;
#pragma unroll
        for (int ai = 0; ai < 2; ++ai) {
            u32x4 g[4][2], pr[4][2];
#pragma unroll
            for (int m = 0; m < 4; ++m)
#pragma unroll
                for (int bj = 0; bj < 2; ++bj) { g[m][bj] = *(const u32x4*)(gates + (size_t)(row0 + ai * 128 + m * 16) * 4096 + gcol0 + bj * 128);
                    if (m4 > 0) pr[m][bj] = *(const u32x4*)(merged + (size_t)(row0 + ai * 128 + m * 16) * 1024 + dcol0 + bj * 128); }
#pragma unroll
            for (int m = 0; m < 4; ++m)
#pragma unroll
                for (int bj = 0; bj < 2; ++bj) { const f32x4 v0 = acc[ai][bj][m][0], v1 = acc[ai][bj][m][1]; const u32x4 gg = g[m][bj];
                    f32x4 r0 = {v0.x * lo16(gg.x), v0.y * hi16(gg.x), v0.z * lo16(gg.y), v0.w * hi16(gg.y)}, r1 = {v1.x * lo16(gg.z), v1.y * hi16(gg.z), v1.z * lo16(gg.w), v1.w * hi16(gg.w)};
                    if (m4 > 0) { const u32x4 pp_ = pr[m][bj];
                        r0.x += lo16(pp_.x); r0.y += hi16(pp_.x); r0.z += lo16(pp_.y); r0.w += hi16(pp_.y); r1.x += lo16(pp_.z); r1.y += hi16(pp_.z); r1.z += lo16(pp_.w); r1.w += hi16(pp_.w); }
                    u32x4 w; w.x = pk2(r0.x, r0.y); w.y = pk2(r0.z, r0.w); w.z = pk2(r1.x, r1.y); w.w = pk2(r1.z, r1.w);
                    *(u32x4*)(merged + (size_t)(row0 + ai * 128 + m * 16) * 1024 + dcol0 + bj * 128) = w; }
        }
    }
};
struct EpiRes {
    static constexpr bool PERM = true, AFTER_DRAIN = false;
    const float* xin; float* out;
    DI void operator()(const f32x4 (&acc)[2][2][4][2], const pg8::Unit& u, int wr, int wc, int fr, int fq) const {
        const int row0 = u.pm * 256 + wr * 64 + fr, col0 = u.pn * 256 + wc * 32 + 8 * fq;
#pragma unroll
        for (int ai = 0; ai < 2; ++ai)
#pragma unroll
            for (int mh = 0; mh < 2; ++mh) {
                f32x4 xa[2][2][2];
#pragma unroll
                for (int m2 = 0; m2 < 2; ++m2)
#pragma unroll
                    for (int bj = 0; bj < 2; ++bj) { const size_t off = (size_t)(row0 + ai * 128 + (mh * 2 + m2) * 16) * 1024 + col0 + bj * 128; xa[m2][bj][0] = *(const f32x4*)(xin + off); xa[m2][bj][1] = *(const f32x4*)(xin + off + 4); }
#pragma unroll
                for (int m2 = 0; m2 < 2; ++m2)
#pragma unroll
                    for (int bj = 0; bj < 2; ++bj) { const size_t off = (size_t)(row0 + ai * 128 + (mh * 2 + m2) * 16) * 1024 + col0 + bj * 128;
                        *(f32x4*)(out + off) = xa[m2][bj][0] + acc[ai][bj][mh * 2 + m2][0]; *(f32x4*)(out + off + 4) = xa[m2][bj][1] + acc[ai][bj][mh * 2 + m2][1]; }
            }
    }
};
struct EpiPle {
    static constexpr bool PERM = true, AFTER_DRAIN = false;
    float* x; const bf16_t* pp;
    DI void operator()(const f32x4 (&acc)[2][2][4][2], const pg8::Unit& u, int wr, int wc, int fr, int fq) const {
        const int row0 = u.pm * 256 + wr * 64 + fr, col0 = u.pn * 256 + wc * 32 + 8 * fq;
#pragma unroll
        for (int ai = 0; ai < 2; ++ai)
#pragma unroll
            for (int mh = 0; mh < 2; ++mh) {
                f32x4 xa[2][2][2]; u32x4 ga[2][2];
#pragma unroll
                for (int m2 = 0; m2 < 2; ++m2)
#pragma unroll
                    for (int bj = 0; bj < 2; ++bj) { const size_t off = (size_t)(row0 + ai * 128 + (mh * 2 + m2) * 16) * 1024 + col0 + bj * 128;
                        xa[m2][bj][0] = *(const f32x4*)(x + off); xa[m2][bj][1] = *(const f32x4*)(x + off + 4); ga[m2][bj] = *(const u32x4*)(pp + off); }
#pragma unroll
                for (int m2 = 0; m2 < 2; ++m2)
#pragma unroll
                    for (int bj = 0; bj < 2; ++bj) { const size_t off = (size_t)(row0 + ai * 128 + (mh * 2 + m2) * 16) * 1024 + col0 + bj * 128;
                        const f32x4 v0 = acc[ai][bj][mh * 2 + m2][0], v1 = acc[ai][bj][mh * 2 + m2][1]; const u32x4 g = ga[m2][bj]; f32x4 x0 = xa[m2][bj][0], x1 = xa[m2][bj][1];
                        x0.x += sigm(v0.x) * lo16(g.x); x0.y += sigm(v0.y) * hi16(g.x); x0.z += sigm(v0.z) * lo16(g.y); x0.w += sigm(v0.w) * hi16(g.y);
                        x1.x += sigm(v1.x) * lo16(g.z); x1.y += sigm(v1.y) * hi16(g.z); x1.z += sigm(v1.z) * lo16(g.w); x1.w += sigm(v1.w) * hi16(g.w);
                        *(f32x4*)(x + off) = x0; *(f32x4*)(x + off + 4) = x1; }
            }
    }
};


DI void unpack8(const u32x4 w, float (&f)[8]) { f[0] = lo16(w.x); f[1] = hi16(w.x); f[2] = lo16(w.y); f[3] = hi16(w.y); f[4] = lo16(w.z); f[5] = hi16(w.z); f[6] = lo16(w.w); f[7] = hi16(w.w); }
DI u32x4 pack8(const float (&f)[8]) { u32x4 o; o.x = pk2(f[0], f[1]); o.y = pk2(f[2], f[3]); o.z = pk2(f[4], f[5]); o.w = pk2(f[6], f[7]); return o; }
DI void load8f(const float* p, float (&f)[8]) { const f32x4 a = *(const f32x4*)p, b = *(const f32x4*)(p + 4); f[0] = a.x; f[1] = a.y; f[2] = a.z; f[3] = a.w; f[4] = b.x; f[5] = b.y; f[6] = b.z; f[7] = b.w; }

DI void phase_chunk(const Params& p, int l, const Frame& F) {
    unsigned char* ws = p.ws; const int lane = F.lane, wave = F.wave;
    bf16_t* PROJ = (bf16_t*)(ws + WS_PROJ); bf16_t* YA = (bf16_t*)(ws + WS_Y); bf16_t* YC = YA + (size_t)2 * T * 512; bf16_t* CMPA = (bf16_t*)(ws + WS_CMPA);
    const bf16_t* SGUW = (const bf16_t*)(ws + WS_SGUW);
    LAS unsigned char* vnT = F.lds;
    const float* convw = p.in[I_CONVW] + (size_t)l * 3 * 512; const float* lng = p.in[I_LNG] + (size_t)l * 512; const float* sgub = p.in[I_SGUB] + (size_t)l * 8 * 128;
    float cw0[8], cw1[8], cw2[8], lgn[8];
    load8f(convw + lane * 8, cw0); load8f(convw + 512 + lane * 8, cw1); load8f(convw + 1024 + lane * 8, cw2); load8f(lng + lane * 8, lgn);
    for (int chunk = F.vb; chunk < T / 128; chunk += F.G) {
        const int t0 = chunk * 128;
        for (int tt = wave; tt < 128; tt += 8) {
            const int t = t0 + tt, s = t & (SEQ - 1), b = t >> 12;
            bf16_t* row = PROJ + (size_t)t * PW;
            const int c0 = lane * 8;
            const u32x4 z = {0u, 0u, 0u, 0u};
            const u32x4 rab = *(const u32x4*)(row + C_AB + c0), rc0 = *(const u32x4*)(row + C_AC + c0), rx0 = *(const u32x4*)(row + C_AX + c0);
            u32x4 r1c = z, r1x = z, r2c = z, r2x = z;
            if (s >= 1) { r1c = *(const u32x4*)(row - PW + C_AC + c0); r1x = *(const u32x4*)(row - PW + C_AX + c0); }
            if (s >= 2) { r2c = *(const u32x4*)(row - 2 * PW + C_AC + c0); r2x = *(const u32x4*)(row - 2 * PW + C_AX + c0); }
            u32x4 segv[3]; int segcol[3]; const float* seggp[3]; float segsc[3];
#pragma unroll
            for (int pass = 0; pass < 3; ++pass) {
                const int seg = pass * 8 + (lane >> 3), sg = seg < 20 ? seg : 20; int col; const float* gp; float sc = 1.f;
                if (sg < 8) { col = C_NQ + 64 * sg; gp = p.in[I_NQG] + l * 64; sc = 0.125f * 1.44269504f; }
                else if (sg < 10) { col = C_NKV + 2 * 128 + (sg - 8) * 64; gp = p.in[I_NKG] + (l * 3 + 1) * 64; }
                else if (sg < 12) { col = C_NKV + 4 * 128 + (sg - 10) * 64; gp = p.in[I_NKG] + (l * 3 + 2) * 64; }
                else if (sg < 20) { col = C_DQ + 64 * (sg - 12); gp = p.in[I_DQG] + l * 64; sc = 0.125f * 1.44269504f; }
                else { col = C_DK; gp = p.in[I_DKG] + l * 64; }
                segcol[pass] = col; seggp[pass] = gp; segsc[pass] = sc; segv[pass] = *(const u32x4*)(row + col + (lane & 7) * 8);
            }
            u32x4 rawc = z; const bf16_t* rawsrc = row; bf16_t* rawdst = nullptr;
            if (lane < 48) { const int sgc = lane >> 3;
                if (sgc < 2) { rawsrc = row + C_NKV + 3 * 128 + sgc * 64; rawdst = (bf16_t*)(ws + WS_VS) + ((size_t)((b * 2 + sgc) * SEQ + s)) * 64; }
                else if (sgc < 4) { rawsrc = row + C_NKV + 5 * 128 + (sgc - 2) * 64; rawdst = (bf16_t*)(ws + WS_VW) + ((size_t)((b * 2 + (sgc - 2)) * SEQ + s)) * 64; }
                else if (sgc == 4) { rawsrc = row + C_DV; rawdst = (bf16_t*)(ws + WS_DV) + (size_t)t * 64; }
                else { rawsrc = row + C_DKI; rawdst = (bf16_t*)(ws + WS_DKI) + (size_t)t * 64; }
                rawc = *(const u32x4*)(rawsrc + (lane & 7) * 8); }
            u32x4 cmpc = z;
            if (lane < 32) { const int jg = lane >> 3; cmpc = *(const u32x4*)(row + C_NKV + (jg >> 1) * 128 + (jg & 1) * 64 + (lane & 7) * 8); }
            const u32x4 ruv = *(const u32x4*)(row + C_UV + 512 + lane * 8);
            {
                float ab[8], c0v[8], x0v[8], c1v[8], x1v[8], c2v[8], x2v[8], y[8];
                unpack8(rab, ab); unpack8(rc0, c0v); unpack8(rx0, x0v); unpack8(r1c, c1v); unpack8(r1x, x1v); unpack8(r2c, c2v); unpack8(r2x, x2v);
#pragma unroll
                for (int e = 0; e < 8; ++e) y[e] = ab[e] * (cw2[e] * c0v[e] * x0v[e] + cw1[e] * c1v[e] * x1v[e] + cw0[e] * c2v[e] * x2v[e]);
                *(u32x4*)(YA + (size_t)t * 512 + c0) = pack8(y);
            }
#pragma unroll
            for (int pass = 0; pass < 3; ++pass) {
                const int seg = pass * 8 + (lane >> 3), part = lane & 7, sg = seg < 20 ? seg : 20;
                float v[8], g[8]; unpack8(segv[pass], v); load8f(seggp[pass] + part * 8, g);
                float ss = 0.f;
#pragma unroll
                for (int e = 0; e < 8; ++e) ss += v[e] * v[e];
                ss = oct_sumf(ss);
                const float r = rsqrtf(ss * (1.f / 64.f) + 1e-6f) * segsc[pass];
#pragma unroll
                for (int e = 0; e < 8; ++e) v[e] = v[e] * r * g[e];
                bf16_t* dstp = row + segcol[pass] + part * 8;
                if (sg >= 8 && sg < 10) dstp = (bf16_t*)(ws + WS_KS) + ((size_t)((b * 2 + (sg - 8)) * SEQ + s)) * 64 + part * 8;
                else if (sg >= 10 && sg < 12) dstp = (bf16_t*)(ws + WS_KW) + ((size_t)((b * 2 + (sg - 10)) * SEQ + s)) * 64 + part * 8;
                else if (sg == 20) dstp = (bf16_t*)(ws + WS_DK) + (size_t)t * 64 + part * 8;
                if (seg < 21) *(u32x4*)dstp = pack8(v);
            }
            if (lane < 48) *(u32x4*)(rawdst + (lane & 7) * 8) = rawc;
            if (lane < 32) { const int jg = lane >> 3, j = jg >> 1, g = jg & 1, part = lane & 7;
                *(u32x4*)(CMPA + ((size_t)j * 4096 + ((size_t)(b * 256 + (s >> 4)) * 2 + g)) * 1024 + (s & 15) * 64 + part * 8) = cmpc; }
            {
                float v[8]; unpack8(ruv, v);
                float sm = 0.f;
#pragma unroll
                for (int e = 0; e < 8; ++e) { v[e] = gelu_t(v[e]); sm += v[e]; }
                const float mean = wave_sum(sm) * (1.f / 512.f); float sq = 0.f;
#pragma unroll
                for (int e = 0; e < 8; ++e) { v[e] -= mean; sq += v[e] * v[e]; }
                const float r = rsqrtf(wave_sum(sq) * (1.f / 512.f) + 1e-6f);
#pragma unroll
                for (int e = 0; e < 8; ++e) *(LAS unsigned short*)(vnT + (lane * 8 + e) * 272 + tt * 2) = (unsigned short)f2bf(v[e] * r * lgn[e]);
            }
        }
        __syncthreads();
        {
            const int g = wave, c = lane & 15, q = lane >> 4; const bf16_t* Wg = SGUW + (size_t)g * 128 * 128;
            for (int tt16 = 0; tt16 < 8; ++tt16) {
                const int nk = (tt16 >> 1) + 1;
                bf16x8 bw[4];
#pragma unroll
                for (int kk = 0; kk < 4; ++kk) bw[kk] = *(const bf16x8*)(Wg + (size_t)(16 * tt16 + c) * 128 + 32 * (kk < nk ? kk : 0) + 8 * q);
                const int t = t0 + 16 * tt16 + c; const float bias = sgub[g * 128 + 16 * tt16 + c];
#pragma unroll
                for (int dt = 0; dt < 4; ++dt) {
                    f32x4 acc = {0.f, 0.f, 0.f, 0.f};
#pragma unroll
                    for (int kk = 0; kk < 4; ++kk) if (kk < nk) { const bf16x8 a = *(const LAS bf16x8*)(vnT + (g * 64 + 16 * dt + c) * 272 + (32 * kk + 8 * q) * 2); acc = MFMA16(a, bw[kk], acc); }
                    const int ch = g * 64 + 16 * dt + 4 * q;
                    const u32x2 uu = *(const u32x2*)(PROJ + (size_t)t * PW + C_UV + ch);
                    u32x2 o; o.x = pk2(gelu_t(lo16(uu.x)) * (acc[0] + bias), gelu_t(hi16(uu.x)) * (acc[1] + bias)); o.y = pk2(gelu_t(lo16(uu.y)) * (acc[2] + bias), gelu_t(hi16(uu.y)) * (acc[3] + bias));
                    *(u32x2*)(YC + (size_t)t * 512 + ch) = o;
                }
            }
        }
        __syncthreads();
    }
}

DI void phase_cmp2(const Params& p, int l, const Frame& F) {
    unsigned char* ws = p.ws; const int lane = F.lane; const int gw = F.vb * 8 + F.wave, NGW = F.G * 8;
    LAS float* hid = (LAS float*)(F.lds + 131072 + F.wave * 1024);
    LAS float* w2s = (LAS float*)F.lds;
    { const float* w2g = p.in[I_CW2] + (size_t)l * 2 * 256 * 64;
      for (int i = F.tid; i < 2 * 256 * 64 / 4; i += 512) *(LAS f32x4*)(w2s + i * 4) = *(const f32x4*)(w2g + i * 4); }
    __syncthreads();
    const float* CMPP = (const float*)(ws + WS_CMPP); const float* peb = (const float*)(ws + WS_PEB);
    bf16_t* CMPK = (bf16_t*)(ws + WS_CMPK); bf16_t* CMPV = (bf16_t*)(ws + WS_CMPV);
    const float* kg = p.in[I_NKG] + (l * 3 + 0) * 64;
    for (int it = gw; it < 8 * 256 * 2 * 2; it += NGW) {
        const int j = it & 1, g = (it >> 1) & 1, n = (it >> 2) & 255, b = it >> 10;
        bf16_t* dst = (j ? CMPV : CMPK) + ((size_t)(b * 2 + g) * 256 + n) * 64;
        if (n == 255) { dst[lane] = 0; continue; }
        const float* Pa = CMPP + ((size_t)j * 4096 + (size_t)(b * 256 + n) * 2 + g) * 512; const float* Pb = CMPP + ((size_t)j * 4096 + (size_t)(b * 256 + n + 1) * 2 + g) * 512 + 256;
        const f32x4 a = *(const f32x4*)(Pa + lane * 4), bq = *(const f32x4*)(Pb + lane * 4), pe = *(const f32x4*)(peb + j * 256 + lane * 4);
        f32x4 h; h.x = gelu_t(a.x + bq.x + pe.x); h.y = gelu_t(a.y + bq.y + pe.y); h.z = gelu_t(a.z + bq.z + pe.z); h.w = gelu_t(a.w + bq.w + pe.w);
        *(LAS f32x4*)(hid + lane * 4) = h;
        LDS_WAIT();
        const LAS float* w2 = w2s + j * 256 * 64;
        float o = 0.f;
#pragma unroll 16
        for (int k = 0; k < 256; ++k) o += hid[k] * w2[k * 64 + lane];
        if (j == 0) { const float ss = wave_sum(o * o); o = o * rsqrtf(ss * (1.f / 64.f) + 1e-6f) * kg[lane]; }
        dst[lane] = (bf16_t)f2bf(o);
        LDS_WAIT();
    }
}

DI int bucket_fast(int n) { const int big = 16 + (int)((__log2f((float)n) - 4.f) * 2.6666667f + 2e-4f); return n < 16 ? n : (big < 31 ? big : 31); }
struct KsCmp { static constexpr bool CONTIG = true; static constexpr int DSTEP = 16, DMAX = 1 << 30; const bf16_t* kb; const bf16_t* vb; int t0, hb;
    DI void base(int k0, const bf16_t*& k, const bf16_t*& v) const { k = kb + (size_t)k0 * 64; v = vb + (size_t)k0 * 64; }
    DI int dist0(int k0, int c) const { return t0 + (c >> 2) - (16 * k0 + 31); } };
struct KsSel { static constexpr bool CONTIG = true; static constexpr int DSTEP = 1, DMAX = 1 << 30; const bf16_t* kb; const bf16_t* vb; const LAS int* selb; int t, hb;
    DI int p0(int k0) const { return __builtin_amdgcn_readfirstlane(selb[k0 >> 6]) * 64 + (k0 & 63); }
    DI void base(int k0, const bf16_t*& k, const bf16_t*& v) const { const int ps = p0(k0); k = kb + (size_t)ps * 64; v = vb + (size_t)ps * 64; }
    DI int dist0(int k0, int c) const { return t - p0(k0); } };
struct KsWin { static constexpr bool CONTIG = true; static constexpr int DSTEP = 1, DMAX = 512; const bf16_t* kb; const bf16_t* vb; int pstart, t0, hb;
    DI void base(int k0, const bf16_t*& k, const bf16_t*& v) const { k = kb + (size_t)(pstart + k0) * 64; v = vb + (size_t)(pstart + k0) * 64; }
    DI int dist0(int k0, int c) const { return t0 + (c >> 2) - (pstart + k0); } };
struct KsDsa { static constexpr bool CONTIG = false; static constexpr int DSTEP = 1, DMAX = 1 << 30; const bf16_t* kb; const bf16_t* vb; const LAS int* list; int n, t;
    DI int pos(int idx) const { return idx < n ? list[idx] : -1; }
    DI const bf16_t* krow(int idx) const { const int ps = pos(idx); return kb + (size_t)(ps < 0 ? 0 : ps) * 64; }
    DI const bf16_t* vrow(int idx) const { const int ps = pos(idx); return vb + (size_t)(ps < 0 ? 0 : ps) * 64; }
    DI float adjust(int idx, int c, float s, bool& ok, const LAS unsigned char* buck, const LAS float* tbl) const {
        const int ps = pos(idx); ok = ps >= 0 && ps <= t; const int dd = t - ps; const int dc = ok ? (dd < 1023 ? dd : 1023) : 0; return s + tbl[buck[dc] * 16 + 8 + (c & 7)]; } };

template <int MODE, class KS>
DI void flash_run(const KS& ks, int nkeys, const bf16x8 (&qb)[2], f32x4 (&o)[4], float& m_run, float& l_run, LAS unsigned char* vt, LAS float* al, LAS float* pn,
                  const LAS unsigned char* buck, const LAS float* tbl, int lane) {
    const int c = lane & 15, q = lane >> 4;
    bf16x8 A00, A01, A10, A11, B00, B01, B10, B11; u32x4 Av[4], Bv[4];
#define FL_LOAD(B_, kk0) do { if constexpr (KS::CONTIG) { const bf16_t* kbp_; const bf16_t* vbp_; ks.base((kk0), kbp_, vbp_); const bf16_t* kr0 = kbp_ + c * 64 + 8 * q; \
            B_##00 = *(const bf16x8*)kr0; B_##01 = *(const bf16x8*)(kr0 + 32); B_##10 = *(const bf16x8*)(kr0 + 1024); B_##11 = *(const bf16x8*)(kr0 + 1056); \
            if (MODE != 1) { const bf16_t* vr0 = vbp_ + (lane >> 3) * 64 + (lane & 7) * 8; _Pragma("unroll") for (int m = 0; m < 4; ++m) B_##v[m] = *(const u32x4*)(vr0 + m * 512); } } \
        else { const bf16_t* kr0 = ks.krow((kk0) + c); const bf16_t* kr1 = ks.krow((kk0) + 16 + c); \
            B_##00 = *(const bf16x8*)(kr0 + 8 * q); B_##01 = *(const bf16x8*)(kr0 + 32 + 8 * q); B_##10 = *(const bf16x8*)(kr1 + 8 * q); B_##11 = *(const bf16x8*)(kr1 + 32 + 8 * q); \
            if (MODE != 1) { _Pragma("unroll") for (int m = 0; m < 4; ++m) B_##v[m] = *(const u32x4*)(ks.vrow((kk0) + (lane >> 3) + 8 * m) + (lane & 7) * 8); } } } while (0)
#define FL_STEP(B_, K0_) do { \
        f32x4 s0 = {0.f, 0.f, 0.f, 0.f}, s1 = {0.f, 0.f, 0.f, 0.f}; \
        s0 = MFMA16(B_##00, qb[0], s0); s0 = MFMA16(B_##01, qb[1], s0); s1 = MFMA16(B_##10, qb[0], s1); s1 = MFMA16(B_##11, qb[1], s1); \
        float sv[8], pv[8]; bool ok[8]; \
        if constexpr (KS::CONTIG) { \
            const LAS float* trow = tbl + (c & 3) * 1024; const int d0 = ks.dist0((K0_), c) - KS::DSTEP * 4 * q; \
        _Pragma("unroll") \
            for (int i = 0; i < 4; ++i) { const int da = d0 - KS::DSTEP * i, db = da - KS::DSTEP * 16; \
                ok[i] = (unsigned)da < (unsigned)KS::DMAX; ok[4 + i] = (unsigned)db < (unsigned)KS::DMAX; \
                sv[i] = s0[i] + trow[da < 0 ? 0 : (da < 1023 ? da : 1023)]; sv[4 + i] = s1[i] + trow[db < 0 ? 0 : (db < 1023 ? db : 1023)]; } \
        } else { \
        _Pragma("unroll") \
            for (int i = 0; i < 4; ++i) { sv[i] = ks.adjust((K0_) + 4 * q + i, c, s0[i], ok[i], buck, tbl); sv[4 + i] = ks.adjust((K0_) + 16 + 4 * q + i, c, s1[i], ok[4 + i], buck, tbl); } \
        } \
        if (MODE == 2) { \
        _Pragma("unroll") \
            for (int e = 0; e < 8; ++e) { pv[e] = ok[e] ? __builtin_amdgcn_exp2f(sv[e]) * l_run : 0.f; \
                const float x = quad_sumf(pv[e]); \
                if ((c & 3) == 0) pn[(c >> 2) * 256 + (K0_) + (e < 4 ? 4 * q + e : 16 + 4 * q + (e - 4))] = x; } \
        } else { \
            float ps = 0.f; \
        _Pragma("unroll") \
            for (int e = 0; e < 8; ++e) { pv[e] = ok[e] ? __builtin_amdgcn_exp2f(sv[e]) : 0.f; ps += pv[e]; } \
            l_run += ps; \
        } \
        if (MODE != 1) { \
        _Pragma("unroll") \
            for (int m = 0; m < 4; ++m) *(LAS u32x4*)(vt + ((lane >> 3) + 8 * m) * 144 + (lane & 7) * 16) = B_##v[m]; \
            LDS_FENCE(); \
            const bf16x8 pa = __builtin_bit_cast(bf16x8, pack8(pv)); \
        _Pragma("unroll") \
            for (int dt = 0; dt < 4; ++dt) { \
                const s16x4 lo = __builtin_amdgcn_ds_read_tr16_b64_v4i16((LAS s16x4*)(vt + (4 * q + (c >> 2)) * 144 + (16 * dt + 4 * (c & 3)) * 2)); \
                const s16x4 hi = __builtin_amdgcn_ds_read_tr16_b64_v4i16((LAS s16x4*)(vt + (16 + 4 * q + (c >> 2)) * 144 + (16 * dt + 4 * (c & 3)) * 2)); \
                const bf16x8 vb8 = __builtin_shufflevector(lo, hi, 0, 1, 2, 3, 4, 5, 6, 7); \
                o[dt] = MFMA16(pa, vb8, o[dt]); \
            } \
            LDS_FENCE(); \
        } \
    } while (0)
    if (nkeys > 0) FL_LOAD(A, 0);
    for (int k0 = 0; k0 < nkeys; k0 += 64) {
        if (k0 + 32 < nkeys) FL_LOAD(B, k0 + 32);
        FL_STEP(A, k0);
        if (k0 + 32 >= nkeys) break;
        if (k0 + 64 < nkeys) FL_LOAD(A, k0 + 64);
        FL_STEP(B, k0 + 32);
    }
#undef FL_STEP
#undef FL_LOAD
    if (MODE == 0) {
        float lt = l_run; lt += __shfl_xor(lt, 16); lt += __shfl_xor(lt, 32);
        const float inv = lt > 0.f ? __builtin_amdgcn_rcpf(lt) : 0.f;
        if (q == 0) al[c] = inv;
        LDS_WAIT();
        const f32x4 a4 = *(const LAS f32x4*)(al + 4 * q);
#pragma unroll
        for (int dt = 0; dt < 4; ++dt) o[dt] = o[dt] * a4;
        LDS_WAIT();
    }
}

DI void nsa_tile(const Params& p, int b, int g, int tb, const Frame& F, const LAS float* lut, int vm = 0) {
    unsigned char* ws = p.ws; const int lane = F.lane, wave = F.wave, c = lane & 15, q = lane >> 4;
    const LAS float* tbl = lut + g * 4096;
    LAS unsigned char* wl = F.lds + wave * 9216; LAS unsigned char* vt = wl; LAS float* al = (LAS float*)(wl + 4608); LAS float* pn = (LAS float*)(wl + 4736);
    LAS float* OS = (LAS float*)F.lds; LAS float* LS = (LAS float*)(F.lds + 65536);
    LAS int* SELB = (LAS int*)(F.lds + 73728); LAS int* CNT = (LAS int*)(F.lds + 75776); LAS unsigned short* UNIT = (LAS unsigned short*)(F.lds + 76032); LAS int* NUNIT = (LAS int*)(F.lds + 76416);
    volatile LAS int* TURN = (volatile LAS int*)(F.lds + 76544); LAS unsigned short* LIST = (LAS unsigned short*)(F.lds + 76800);
    LAS unsigned char* vt2 = F.lds + 84992 + wave * 4608;
    const bf16_t* prow0 = (const bf16_t*)(ws + WS_PROJ) + (size_t)(b * SEQ) * PW;
    bf16_t* YB = (bf16_t*)(ws + WS_Y) + (size_t)T * 512;
    const f32x4 z4 = {0.f, 0.f, 0.f, 0.f};
    for (int ii = 0; ii < 2; ++ii) {
        f32x4 accw[4];
        const int item = wave * 2 + ii, t0 = 64 * tb + 4 * item;
#pragma unroll
        for (int k = 0; k < 4; ++k) *(LAS f32x4*)(pn + lane * 4 + 256 * k) = z4;
        bf16x8 qb[2];
        { const bf16_t* qp = prow0 + (size_t)(t0 + (c >> 2)) * PW + C_NQ + (g * 4 + (c & 3)) * 64 + 8 * q; qb[0] = *(const bf16x8*)qp; qb[1] = *(const bf16x8*)(qp + 32); }
        float g0[4], g2[4];
        { const u32x2 ga = *(const u32x2*)(prow0 + (size_t)(t0 + q) * PW + C_NG + 0 * 8 + g * 4), gc = *(const u32x2*)(prow0 + (size_t)(t0 + q) * PW + C_NG + 2 * 8 + g * 4);
          g0[0] = sigm(lo16(ga.x)); g0[1] = sigm(hi16(ga.x)); g0[2] = sigm(lo16(ga.y)); g0[3] = sigm(hi16(ga.y));
          g2[0] = sigm(lo16(gc.x)); g2[1] = sigm(hi16(gc.x)); g2[2] = sigm(lo16(gc.y)); g2[3] = sigm(hi16(gc.y)); }
#pragma unroll
        for (int dt = 0; dt < 4; ++dt) accw[dt] = z4;
        LDS_WAIT();
        const int tl = t0 + 3, nv = tl >= 31 ? ((tl - 31) >> 4) + 1 : 0;
        if (nv > 0 && (vm == 0 || (vm & 1))) {
            const int nk = (nv + 31) & ~31;
            KsCmp ks{(const bf16_t*)(ws + WS_CMPK) + (size_t)(b * 2 + g) * 256 * 64, (const bf16_t*)(ws + WS_CMPV) + (size_t)(b * 2 + g) * 256 * 64, t0, g * 4};
            float m = 0.f, lr = 0.f; f32x4 o[4] = {z4, z4, z4, z4};
            flash_run<1>(ks, nk, qb, o, m, lr, vt, al, pn, (const LAS unsigned char*)vt, tbl, lane);
            lr += __shfl_xor(lr, 16); lr += __shfl_xor(lr, 32); lr = lr > 0.f ? __builtin_amdgcn_rcpf(lr) : 0.f;
            flash_run<2>(ks, nk, qb, o, m, lr, vt, al, pn, (const LAS unsigned char*)vt, tbl, lane);
#pragma unroll
            for (int dt = 0; dt < 4; ++dt) { accw[dt][0] = g0[0] * o[dt][0]; accw[dt][1] = g0[1] * o[dt][1]; accw[dt][2] = g0[2] * o[dt][2]; accw[dt][3] = g0[3] * o[dt][3]; }
        }
        LDS_WAIT();
        {
            const int j = lane; float val[4];
#pragma unroll
            for (int qi = 0; qi < 4; ++qi) {
                if (j == 0 || j == tb) val[qi] = 1e4f;
                else if (j < tb) { const LAS float* pq = pn + qi * 256 + 4 * j; val[qi] = pq[-1] + pq[0] + pq[1] + pq[2] + pq[3]; }
                else val[qi] = -1e30f;
            }
            for (int k = 0; k < 8; ++k) {
#pragma unroll
                for (int qi = 0; qi < 4; ++qi) {
                    const float mx = wave_max(val[qi]); const unsigned long long who = __ballot(val[qi] == mx); const int w = __builtin_ctzll(who);
                    if (lane == 0) SELB[(item * 4 + qi) * 8 + k] = mx > -1e29f ? w : -1;
                    if (lane == w) val[qi] = -3e38f;
                }
            }
        }
        {
            const int pstart = t0 >= 511 ? t0 - 511 : 0, nk = (t0 + 3 - pstart + 1 + 31) & ~31;
            KsWin ks{(const bf16_t*)(ws + WS_KW) + (size_t)(b * 2 + g) * SEQ * 64, (const bf16_t*)(ws + WS_VW) + (size_t)(b * 2 + g) * SEQ * 64, pstart, t0, g * 4};
            float m = 0.f, lr = 0.f; f32x4 o[4] = {z4, z4, z4, z4};
            if (vm == 0 || (vm & 2)) flash_run<0>(ks, nk, qb, o, m, lr, vt, al, pn, (const LAS unsigned char*)vt, tbl, lane);
            if (vm & 4) { flash_run<1>(ks, nk, qb, o, m, lr, vt, al, pn, (const LAS unsigned char*)vt, tbl, lane); o[0][0] += lr; }
#pragma unroll
            for (int dt = 0; dt < 4; ++dt) { accw[dt][0] += g2[0] * o[dt][0]; accw[dt][1] += g2[1] * o[dt][1]; accw[dt][2] += g2[2] * o[dt][2]; accw[dt][3] += g2[3] * o[dt][3]; }
        }
        if (vm == 0) {
            bf16_t* dst = YB + (size_t)(b * SEQ + t0 + q) * 512 + (g * 4) * 64 + c;
#pragma unroll
            for (int dt = 0; dt < 4; ++dt)
#pragma unroll
                for (int i = 0; i < 4; ++i) dst[i * 64 + 16 * dt] = (bf16_t)f2bf(accw[dt][i]);
        }
        else { asm volatile("" :: "v"(accw[0]), "v"(accw[1]), "v"(accw[2]), "v"(accw[3])); }
        LDS_WAIT();
    }
    __syncthreads();
    if (vm != 0) return;
    for (int i = F.tid; i < 66560 / 16; i += 512) *(LAS f32x4*)(F.lds + i * 16) = z4;
    if (F.tid < 64) { CNT[F.tid] = 0; TURN[F.tid] = 0; }
    __syncthreads();
    { const int blk = SELB[F.tid];
      if (blk >= 0) { int rank = 0;
#pragma unroll
          for (int k = 0; k < 8; ++k) { const int ob = SELB[(F.tid & ~7) + k]; rank += (ob >= 0 && ob < blk) ? 1 : 0; }
          const int pos = __hip_atomic_fetch_add(CNT + blk, 1, __ATOMIC_RELAXED, __HIP_MEMORY_SCOPE_WORKGROUP); LIST[blk * 64 + pos] = (unsigned short)((F.tid >> 3) | (rank << 8)); } }
    __syncthreads();
    if (wave == 0) {
        const int uj = (CNT[lane] + 3) >> 2; int inc = uj;
#pragma unroll
        for (int o_ = 1; o_ < 64; o_ <<= 1) { const int v = __shfl_up(inc, o_); if (lane >= o_) inc += v; }
        const int offs = inc - uj;
        for (int u = 0; u < uj; ++u) UNIT[offs + u] = (unsigned short)(lane | (u << 8));
        if (lane == 63) NUNIT[0] = inc;
    }
    __syncthreads();
    {
        const int nu = NUNIT[0];
        const LAS float* trow = tbl + (c & 3) * 1024;
        const bf16_t* KSb = (const bf16_t*)(ws + WS_KS) + (size_t)(b * 2 + g) * SEQ * 64; const bf16_t* VSb = (const bf16_t*)(ws + WS_VS) + (size_t)(b * 2 + g) * SEQ * 64;
        for (int ui = wave; ui < nu; ui += 8) {
            const int uu = UNIT[ui], j = uu & 255, u = uu >> 8, nj = CNT[j];
            const int slot = 4 * u + (c >> 2); const int qrow = slot < nj ? (int)(LIST[j * 64 + slot] & 255) : -1;
            const int slotq = 4 * u + q; const int qo = slotq < nj ? (int)(LIST[j * 64 + slotq] & 255) : -1;
            bf16x8 qs[2] = {(bf16x8){0, 0, 0, 0, 0, 0, 0, 0}, (bf16x8){0, 0, 0, 0, 0, 0, 0, 0}};
            if (qrow >= 0) { const bf16_t* qp = prow0 + (size_t)(64 * tb + qrow) * PW + C_NQ + (g * 4 + (c & 3)) * 64 + 8 * q; qs[0] = *(const bf16x8*)qp; qs[1] = *(const bf16x8*)(qp + 32); }
            const bf16_t* kb0 = KSb + (size_t)(64 * j) * 64; const bf16_t* vb0 = VSb + (size_t)(64 * j) * 64;
            bf16x8 ka[4]; u32x4 vv[4];
#define SEL_LOADK(st) do { const bf16_t* kr0 = kb0 + (32 * (st) + c) * 64 + 8 * q; ka[0] = *(const bf16x8*)kr0; ka[1] = *(const bf16x8*)(kr0 + 32); ka[2] = *(const bf16x8*)(kr0 + 1024); ka[3] = *(const bf16x8*)(kr0 + 1056); } while (0)
#define SEL_LOADV(st) do { const bf16_t* vr0 = vb0 + (32 * (st) + (lane >> 3)) * 64 + (lane & 7) * 8; _Pragma("unroll") for (int m = 0; m < 4; ++m) vv[m] = *(const u32x4*)(vr0 + m * 512); } while (0)
            SEL_LOADK(0); SEL_LOADV(0);
            f32x4 o[4] = {z4, z4, z4, z4}; float lsum = 0.f;
#pragma unroll
            for (int st = 0; st < 2; ++st) {
                f32x4 s0 = z4, s1 = z4;
                s0 = MFMA16(ka[0], qs[0], s0); s0 = MFMA16(ka[1], qs[1], s0); s1 = MFMA16(ka[2], qs[0], s1); s1 = MFMA16(ka[3], qs[1], s1);
                if (st == 0) SEL_LOADK(1);
                const int d0 = 64 * (tb - j) + (qrow < 0 ? 0 : qrow) - 32 * st - 4 * q; float pv[8];
#pragma unroll
                for (int i = 0; i < 4; ++i) { const int da = d0 - i, db = da - 16;
                    const float ea = __builtin_amdgcn_exp2f(s0[i] + trow[da < 0 ? 0 : (da < 1023 ? da : 1023)]), eb = __builtin_amdgcn_exp2f(s1[i] + trow[db < 0 ? 0 : (db < 1023 ? db : 1023)]);
                    pv[i] = (qrow >= 0 && da >= 0) ? ea : 0.f; pv[4 + i] = (qrow >= 0 && db >= 0) ? eb : 0.f; lsum += pv[i] + pv[4 + i]; }
#pragma unroll
                for (int m = 0; m < 4; ++m) *(LAS u32x4*)(vt2 + ((lane >> 3) + 8 * m) * 144 + (lane & 7) * 16) = vv[m];
                if (st == 0) SEL_LOADV(1);
                LDS_FENCE();
                const bf16x8 pa = __builtin_bit_cast(bf16x8, pack8(pv));
#pragma unroll
                for (int dt = 0; dt < 4; ++dt) {
                    const s16x4 lo = __builtin_amdgcn_ds_read_tr16_b64_v4i16((LAS s16x4*)(vt2 + (4 * q + (c >> 2)) * 144 + (16 * dt + 4 * (c & 3)) * 2));
                    const s16x4 hi = __builtin_amdgcn_ds_read_tr16_b64_v4i16((LAS s16x4*)(vt2 + (16 + 4 * q + (c >> 2)) * 144 + (16 * dt + 4 * (c & 3)) * 2));
                    o[dt] = MFMA16(pa, __builtin_shufflevector(lo, hi, 0, 1, 2, 3, 4, 5, 6, 7), o[dt]);
                }
                LDS_FENCE();
            }
#undef SEL_LOADK
#undef SEL_LOADV
            lsum += __shfl_xor(lsum, 16); lsum += __shfl_xor(lsum, 32);
#pragma unroll 1
            for (int s = 0; s < 4; ++s) {
                if (4 * u + s >= nj) break;
                const int ent = LIST[j * 64 + 4 * u + s], qs_ = ent & 255, rk = ent >> 8;
                unsigned spins = 0;
                while (TURN[qs_] != rk) { __builtin_amdgcn_s_sleep(1); if (++spins > (1u << 22)) break; }
                if (q == s) {
#pragma unroll
                    for (int dt = 0; dt < 4; ++dt)
#pragma unroll
                        for (int i = 0; i < 4; ++i) OS[(qs_ * 4 + i) * 64 + 16 * dt + c] += o[dt][i];
                }
                if ((c >> 2) == s && q == 0) LS[qs_ * 4 + (c & 3)] += lsum;
                LDS_WAIT();
                if (lane == 0) TURN[qs_] = rk + 1;
                LDS_WAIT();
            }
        }
    }
    __syncthreads();
    for (int ii = 0; ii < 2; ++ii) {
        const int item = wave * 2 + ii, qq = item * 4 + q, t = 64 * tb + qq;
        const u32x2 gg = *(const u32x2*)(prow0 + (size_t)t * PW + C_NG + 8 + g * 4);
        const float g1[4] = {sigm(lo16(gg.x)), sigm(hi16(gg.x)), sigm(lo16(gg.y)), sigm(hi16(gg.y))};
        const f32x4 l4 = *(const LAS f32x4*)(LS + qq * 4);
        const float inv[4] = {l4.x > 0.f ? g1[0] / l4.x : 0.f, l4.y > 0.f ? g1[1] / l4.y : 0.f, l4.z > 0.f ? g1[2] / l4.z : 0.f, l4.w > 0.f ? g1[3] / l4.w : 0.f};
        bf16_t* dst = YB + (size_t)(b * SEQ + t) * 512 + (g * 4) * 64 + c;
#pragma unroll
        for (int dt = 0; dt < 4; ++dt)
#pragma unroll
            for (int i = 0; i < 4; ++i) dst[i * 64 + 16 * dt] = (bf16_t)f2bf(bf2f(dst[i * 64 + 16 * dt]) + inv[i] * OS[(qq * 4 + i) * 64 + 16 * dt + c]);
    }
    __syncthreads();
}

DI void dsa_group(const Params& p, int b, int t0, const Frame& F, const LAS unsigned char* buck, const LAS float* tbl, int parts = 7) {
    unsigned char* ws = p.ws; const int lane = F.lane, wave = F.wave, c = lane & 15, q = lane >> 4;
    LAS unsigned* SC = (LAS unsigned*)F.lds;
    LAS int* list = (LAS int*)(F.lds + 131072 + wave * 1024); LAS float* al = (LAS float*)(F.lds + 139264 + wave * 64);
    const bf16_t* prow0 = (const bf16_t*)(ws + WS_PROJ) + (size_t)(b * SEQ) * PW;
    bf16_t* YD = (bf16_t*)(ws + WS_Y) + (size_t)3 * T * 512;
    const bf16x8 zf = {0, 0, 0, 0, 0, 0, 0, 0};
    const int t = t0 + wave; const bf16_t* qrow = prow0 + (size_t)t * PW;
    const bf16_t* dki = (const bf16_t*)(ws + WS_DKI) + (size_t)(b * SEQ) * 64;
    const bool full = t0 >= 256;
    if (full && (parts & 1)) {
        bf16x8 qa[4][2]; float wv[4][4];
#pragma unroll
        for (int rt = 0; rt < 4; ++rt) { const bf16_t* qp = prow0 + (size_t)(t0 + 2 * rt + (c >> 3)) * PW + C_DQI + (c & 7) * 64 + 8 * q; qa[rt][0] = *(const bf16x8*)qp; qa[rt][1] = *(const bf16x8*)(qp + 32);
            const u32x2 w4 = *(const u32x2*)(prow0 + (size_t)(t0 + 2 * rt + (q >> 1)) * PW + C_DWI + (q & 1) * 4);
            wv[rt][0] = lo16(w4.x) * 0.35355339f; wv[rt][1] = hi16(w4.x) * 0.35355339f; wv[rt][2] = lo16(w4.y) * 0.35355339f; wv[rt][3] = hi16(w4.y) * 0.35355339f; }
        const int ntile = ((t0 + 7) >> 4) + 1, nk64 = ((t0 + 7) >> 6) + 1;
        bf16x8 kx0, kx1, ky0, ky1;
        { const int ta = wave < ntile ? wave : ntile - 1, tb2 = wave + 8 < ntile ? wave + 8 : ntile - 1;
          const bf16_t* kp = dki + (size_t)(16 * ta + c) * 64 + 8 * q; kx0 = *(const bf16x8*)kp; kx1 = *(const bf16x8*)(kp + 32);
          const bf16_t* kq = dki + (size_t)(16 * tb2 + c) * 64 + 8 * q; ky0 = *(const bf16x8*)kq; ky1 = *(const bf16x8*)(kq + 32); }
        for (int tau = wave; tau < ntile; tau += 8) {
            const bf16x8 kb0 = kx0, kb1 = kx1;
            kx0 = ky0; kx1 = ky1;
            if (tau + 16 < ntile) { const bf16_t* kp = dki + (size_t)(16 * (tau + 16) + c) * 64 + 8 * q; ky0 = *(const bf16x8*)kp; ky1 = *(const bf16x8*)(kp + 32); }
            const int key = 16 * tau + c;
#pragma unroll
            for (int rt = 0; rt < 4; ++rt) {
                f32x4 acc = {0.f, 0.f, 0.f, 0.f};
                acc = MFMA16(qa[rt][0], kb0, acc); acc = MFMA16(qa[rt][1], kb1, acc);
                float s = wv[rt][0] * fmaxf(acc[0], 0.f) + wv[rt][1] * fmaxf(acc[1], 0.f) + wv[rt][2] * fmaxf(acc[2], 0.f) + wv[rt][3] * fmaxf(acc[3], 0.f);
                s += __shfl_xor(s, 16);
                const int qq = 2 * rt + (q >> 1);
                if ((q & 1) == 0) SC[qq * 4096 + key] = key <= t0 + qq ? ordf(s) : 0u;
            }
        }
        for (int i = F.tid; i < 8 * 64; i += 512) { const int key = ntile * 16 + (i & 63); if (key < nk64 * 64) SC[(i >> 6) * 4096 + key] = 0u; }
    }
    __syncthreads();
    int n;
    if (!full) { n = t + 1; for (int i = lane; i < 256; i += 64) list[i] = i <= t ? i : -1; }
    else if (parts & 2) {
        n = 256;
        const LAS unsigned* sc = SC + wave * 4096; const int nk64 = (t >> 6) + 1;
        unsigned u[64];
#pragma unroll
        for (int k = 0; k < 64; ++k) u[k] = k < nk64 ? sc[k * 64 + lane] : 0u;
#define WAVE_TOTAL(cl, tot) do { tot = 0; _Pragma("unroll") for (int b_ = 0; b_ < 7; ++b_) tot += __popcll(__ballot(((cl) >> b_) & 1u)) << b_; } while (0)
        unsigned prefix = 0u;
        for (int bit = 31; bit >= 0; --bit) {
            const unsigned cand = prefix | (1u << bit); unsigned cl = 0u; int cnt;
#pragma unroll
            for (int k = 0; k < 64; ++k) cl += (u[k] >= cand) ? 1u : 0u;
            WAVE_TOTAL(cl, cnt);
            if (cnt >= 256) { prefix = cand; if (cnt == 256) break; }
        }
        int cgt; { unsigned cl = 0u;
#pragma unroll
            for (int k = 0; k < 64; ++k) cl += (u[k] > prefix) ? 1u : 0u;
            WAVE_TOTAL(cl, cgt); }
#undef WAVE_TOTAL
        const int need_eq = 256 - cgt; int base = 0, eqbase = 0;
#pragma unroll
        for (int k = 0; k < 64; ++k) {
            if (k < nk64) {
                const bool gtp = u[k] > prefix, eq = u[k] == prefix;
                const unsigned long long meq = __ballot(eq);
                const int eqrank = eqbase + (int)__builtin_amdgcn_mbcnt_hi((unsigned)(meq >> 32), __builtin_amdgcn_mbcnt_lo((unsigned)meq, 0u));
                const bool take = gtp || (eq && eqrank < need_eq);
                const unsigned long long mt = __ballot(take);
                const int slot = base + (int)__builtin_amdgcn_mbcnt_hi((unsigned)(mt >> 32), __builtin_amdgcn_mbcnt_lo((unsigned)mt, 0u));
                if (take && slot < 256) list[slot] = k * 64 + lane;
                base += __popcll(mt); eqbase += __popcll(meq);
            }
        }
    }
    else n = 256;
    LDS_WAIT();
    if (!(parts & 4)) { __syncthreads(); return; }
    LAS unsigned char* vt = F.lds + wave * 16384;
    bf16x8 qd[2] = {zf, zf};
    if (c < 8) { qd[0] = *(const bf16x8*)(qrow + C_DQ + c * 64 + 8 * q); qd[1] = *(const bf16x8*)(qrow + C_DQ + c * 64 + 32 + 8 * q); }
    KsDsa ks{(const bf16_t*)(ws + WS_DK) + (size_t)(b * SEQ) * 64, (const bf16_t*)(ws + WS_DV) + (size_t)(b * SEQ) * 64, list, n, t};
    const f32x4 z4 = {0.f, 0.f, 0.f, 0.f};
    float m = -1e30f, lr = 0.f; f32x4 o[4] = {z4, z4, z4, z4};
    flash_run<0>(ks, (n + 31) & ~31, qd, o, m, lr, vt, al, (LAS float*)vt, buck, tbl, lane);
    if (q < 2) {
#pragma unroll
        for (int dt = 0; dt < 4; ++dt)
#pragma unroll
            for (int i = 0; i < 4; ++i) YD[(size_t)(b * SEQ + t) * 512 + (4 * q + i) * 64 + 16 * dt + c] = (bf16_t)f2bf(o[dt][i]);
    }
    __syncthreads();
}

DI void phase_attn(const Params& p, int l, const Frame& F, int mask = 3, int parts = 15) {
    const int gw = F.vb * 8 + F.wave, NGW = F.G * 8; const float* rel = p.in[I_REL];
#ifndef MK_ATTN
#define MK_ATTN 3
#endif
    if ((MK_ATTN & 1) && (mask & 1)) {
        LAS float* lut = (LAS float*)(F.lds + 130048);
        for (int i = F.tid; i < 8 * 1024; i += 512) { const int h = i >> 10, d = i & 1023; lut[i] = rel[bucket_of(d) * 16 + h] * 1.44269504f; }
        __syncthreads();
        for (int it = F.vb; it < 8 * 2 * 64; it += F.G) { const int b = it >> 7, g = (it >> 6) & 1; int tb = it & 63; if (b & 1) tb = 63 - tb; nsa_tile(p, b, g, tb, F, lut, (parts >> 8) & 15); }
    }
    __syncthreads();
    LAS unsigned char* buck = F.lds + 139776; LAS float* tbl = (LAS float*)(F.lds + 140800);
    for (int i = F.tid; i < 1024; i += 512) buck[i] = (unsigned char)bucket_of(i);
    tbl[F.tid] = rel[F.tid] * 1.44269504f;
    __syncthreads();
    if ((MK_ATTN & 2) && (mask & 2)) for (int it = F.vb; it < 8 * 512; it += F.G) { const int b = it >> 9; int tg = it & 511; if (b & 1) tg = 511 - tg; dsa_group(p, b, tg * 8, F, buck, tbl, parts); }
}


#ifndef MK_PROBE
#define MK_PROBE 0
#endif

DI unsigned row16_maxu(unsigned m) { unsigned o;
    o = (unsigned)DPP_I((int)m, 0xB1); m = m > o ? m : o; o = (unsigned)DPP_I((int)m, 0x4E); m = m > o ? m : o;
    o = (unsigned)DPP_I((int)m, 0x141); m = m > o ? m : o; o = (unsigned)DPP_I((int)m, 0x140); m = m > o ? m : o; return m; }
DI void peer_route_tile(const Params& p, int t0, int lane) {
    unsigned char* ws = p.ws; const int c = lane & 15, q = lane >> 4;
    const bf16_t* QP = (const bf16_t*)(ws + WS_QP); const bf16_t* SK = (const bf16_t*)(ws + WS_SK); int* EIDX = (int*)(ws + WS_EIDX); float* EW = (float*)(ws + WS_EW);
    float* EU = (float*)(ws + WS_EU); const float* USr = (const float*)(ws + WS_PTV); const float* VSr = USr + 16384;
    int ca[4], cb[4]; bool cv[4];
    ca[0] = 0; cb[0] = c; cv[0] = true;
    ca[1] = c < 8 ? 1 : (c < 13 ? 2 : 3); cb[1] = c < 8 ? c : (c < 13 ? c - 8 : c - 13); cv[1] = true;
    { const int ci = 32 + c; int a_, b_;
      if (ci == 32) { a_ = 3; b_ = 3; } else if (ci < 36) { a_ = 4; b_ = ci - 33; } else if (ci < 42) { a_ = 5 + ((ci - 36) >> 1); b_ = (ci - 36) & 1; } else { a_ = 8 + (ci - 42); b_ = 0; }
      ca[2] = a_; cb[2] = b_; cv[2] = true; }
    ca[3] = c < 2 ? 14 + c : 0; cb[3] = 0; cv[3] = c < 2;
    for (int h = 0; h < 8; ++h) {
        unsigned top[2][4];
#pragma unroll
        for (int pp = 0; pp < 2; ++pp) {
            const int hp = h * 2 + pp;
            const bf16_t* ap = QP + (size_t)(t0 + c) * 1024 + hp * 64 + 8 * q;
            const bf16x8 a0 = *(const bf16x8*)ap, a1 = *(const bf16x8*)(ap + 32);
            unsigned v[4][8];
#pragma unroll
            for (int kt = 0; kt < 8; ++kt) { const bf16_t* bp = SK + ((size_t)hp * 128 + 16 * kt + c) * 64 + 8 * q;
                const bf16x8 b0 = *(const bf16x8*)bp, b1 = *(const bf16x8*)(bp + 32);
                f32x4 acc = {0.f, 0.f, 0.f, 0.f}; acc = MFMA16(a0, b0, acc); acc = MFMA16(a1, b1, acc);
#pragma unroll
                for (int i = 0; i < 4; ++i) v[i][kt] = (ordf(acc[i]) & 0xFFFFFF80u) | (unsigned)(127 - (16 * kt + c)); }
            { unsigned mine[4] = {0u, 0u, 0u, 0u};
              for (int r = 0; r < 16; ++r) {
#pragma unroll
                  for (int i = 0; i < 4; ++i) { unsigned m = v[i][0];
#pragma unroll
                      for (int kt = 1; kt < 8; ++kt) m = m > v[i][kt] ? m : v[i][kt];
                      m = row16_maxu(m); mine[i] = (c == r) ? m : mine[i];
#pragma unroll
                      for (int kt = 0; kt < 8; ++kt) v[i][kt] = (v[i][kt] == m) ? 0u : v[i][kt]; } }
#pragma unroll
              for (int i = 0; i < 4; ++i) top[pp][i] = mine[i]; }
        }
        unsigned cd[4][4], mine2[4] = {0u, 0u, 0u, 0u}; int i0v[4], i1v[4];
#pragma unroll
        for (int i = 0; i < 4; ++i) {
            const float s0 = unordf(top[0][i] & 0xFFFFFF80u), s1 = unordf(top[1][i] & 0xFFFFFF80u);
            i0v[i] = 127 - (int)(top[0][i] & 127u); i1v[i] = 127 - (int)(top[1][i] & 127u);
#pragma unroll
            for (int k = 0; k < 4; ++k) { const float s0a = __shfl(s0, (lane & 48) | ca[k]), s1b = __shfl(s1, (lane & 48) | cb[k]);
                cd[i][k] = cv[k] ? ((ordf(s0a + s1b) & 0xFFFFFF00u) | (unsigned)(255 - (ca[k] * 16 + cb[k]))) : 0u; }
        }
        for (int r = 0; r < 16; ++r) {
#pragma unroll
            for (int i = 0; i < 4; ++i) { unsigned m = cd[i][0];
#pragma unroll
                for (int k = 1; k < 4; ++k) m = m > cd[i][k] ? m : cd[i][k];
                m = row16_maxu(m); mine2[i] = (c == r) ? m : mine2[i];
#pragma unroll
                for (int k = 0; k < 4; ++k) cd[i][k] = (cd[i][k] == m) ? 0u : cd[i][k]; }
        }
#pragma unroll
        for (int i = 0; i < 4; ++i) {
            const unsigned mine = mine2[i];
            const int pr = 255 - (int)(mine & 255u); const int ea = __shfl(i0v[i], (lane & 48) | (pr >> 4)), eb = __shfl(i1v[i], (lane & 48) | (pr & 15));
            const float scv = unordf(mine & 0xFFFFFF00u);
            const float mx = row16_maxf(scv);
            const float e = __expf(scv - mx); const float sm = row16_sumf(e);
            const size_t o = (size_t)(t0 + 4 * q + i) * 128 + h * 16 + c;
            const int eid = ea * 128 + eb; EIDX[o] = eid; EW[o] = (e / sm) * VSr[eid]; EU[o] = USr[eid];
        }
    }
}
#define MFMA8(a, b, c) __builtin_amdgcn_mfma_f32_16x16x32_fp8_fp8((a), (b), (c), 0, 0, 0)
DI long lo64(const u32x4 v) { return (long)(((unsigned long long)v.y << 32) | v.x); }
DI long hi64(const u32x4 v) { return (long)(((unsigned long long)v.w << 32) | v.z); }
template <int OFF> DI void peer_dma_o(const unsigned char* src, LAS unsigned char* dst) { __builtin_amdgcn_global_load_lds((const unsigned*)src, (LAS unsigned*)(dst - OFF), 16, OFF, 0); }
template <int K> DI void peer_dma_u(const unsigned char* ub, LAS unsigned char* ring) { peer_dma_o<512 * ((K >> 3) & 1) + 64 * (K & 7)>(ub, ring + 1024 * K); }
DI void peer_gather_token(const Params& p, int l, int t, const float* xin, float* xout, LAS unsigned char* wl, int lane) {
    unsigned char* ws = p.ws;
    LAS unsigned char* h8 = wl; LAS int* el = (LAS int*)(wl + 1024); LAS float* wlw = (LAS float*)(wl + 1536); LAS float* cl = (LAS float*)(wl + 2048); LAS float* eul = (LAS float*)(wl + 2560);
    LAS unsigned char* ring = wl + 3072;
    const unsigned char* PTU = ws + WS_PTU; const unsigned char* PTV = ws + WS_PTU + 16 * MiB;
    const int* EIDX = (const int*)(ws + WS_EIDX); const float* EW = (const float*)(ws + WS_EW); const float* EU = (const float*)(ws + WS_EU);
    const int e0 = lane * 16; const float* xr = xin + (size_t)t * 1024 + e0; const float* gf = p.in[I_GFFN] + l * 1024 + e0;
    float hs_inv; f32x4 xk0, xk1, xk2, xk3;
    {
        float xa[8], xb[8], ga[8], gb[8];
        xk0 = *(const f32x4*)xr; xk1 = *(const f32x4*)(xr + 4); xk2 = *(const f32x4*)(xr + 8); xk3 = *(const f32x4*)(xr + 12);
        xa[0] = xk0.x; xa[1] = xk0.y; xa[2] = xk0.z; xa[3] = xk0.w; xa[4] = xk1.x; xa[5] = xk1.y; xa[6] = xk1.z; xa[7] = xk1.w;
        xb[0] = xk2.x; xb[1] = xk2.y; xb[2] = xk2.z; xb[3] = xk2.w; xb[4] = xk3.x; xb[5] = xk3.y; xb[6] = xk3.z; xb[7] = xk3.w;
        load8f(gf, ga); load8f(gf + 8, gb);
        const int ei0 = EIDX[(size_t)t * 128 + lane], ei1 = EIDX[(size_t)t * 128 + 64 + lane];
        const float ew0 = EW[(size_t)t * 128 + lane], ew1 = EW[(size_t)t * 128 + 64 + lane], eu0 = EU[(size_t)t * 128 + lane], eu1 = EU[(size_t)t * 128 + 64 + lane];
        float ss = 0.f;
#pragma unroll
        for (int e = 0; e < 8; ++e) ss += xa[e] * xa[e] + xb[e] * xb[e];
        const float r = rsqrtf(wave_sum(ss) * (1.f / 1024.f) + 1e-6f);
        float am = 0.f;
#pragma unroll
        for (int e = 0; e < 8; ++e) { xa[e] = xa[e] * r * ga[e]; xb[e] = xb[e] * r * gb[e]; am = fmaxf(am, fmaxf(fabsf(xa[e]), fabsf(xb[e]))); }
        am = wave_max(am);
        const float hs = am > 0.f ? 224.f / am : 1.f; hs_inv = 1.f / hs;
        u32x4 o; o.x = (unsigned)pk4_fp8(xa[0] * hs, xa[1] * hs, xa[2] * hs, xa[3] * hs); o.y = (unsigned)pk4_fp8(xa[4] * hs, xa[5] * hs, xa[6] * hs, xa[7] * hs);
        o.z = (unsigned)pk4_fp8(xb[0] * hs, xb[1] * hs, xb[2] * hs, xb[3] * hs); o.w = (unsigned)pk4_fp8(xb[4] * hs, xb[5] * hs, xb[6] * hs, xb[7] * hs);
        *(LAS u32x4*)(h8 + e0) = o;
        el[lane] = ei0; el[64 + lane] = ei1; wlw[lane] = ew0; wlw[64 + lane] = ew1; eul[lane] = eu0; eul[64 + lane] = eu1;
#if MK_PROBE == 12
        if (xout != p.out) { el[lane] = ei0 & 63; el[64 + lane] = ei1 & 63; }
#endif
    }
    asm volatile("s_waitcnt vmcnt(0) lgkmcnt(0)" ::: "memory");
    const int c = lane & 15, q = lane >> 4;
    u32x4 hb[16];
#pragma unroll
    for (int j = 0; j < 16; ++j) hb[j] = *(const LAS u32x4*)(h8 + 64 * j + 16 * q);
#define PEER_DMA(src_, slot_) __builtin_amdgcn_global_load_lds((const unsigned*)(src_), (LAS unsigned*)(ring + 1024 * (slot_)), 16, 0, 0)
#define PEER_RD(slot_) (*(const LAS u32x4*)(ring + 1024 * (slot_) + 16 * lane))
#define PEER_EL16(dst, base_) do { const int b4_ = (base_) < 112 ? (base_) : 112; _Pragma("unroll") for (int v_ = 0; v_ < 4; ++v_) { const u32x4 t4_ = *(const LAS u32x4*)(el + b4_ + 4 * v_); dst[4 * v_] = (int)t4_.x; dst[4 * v_ + 1] = (int)t4_.y; dst[4 * v_ + 2] = (int)t4_.z; dst[4 * v_ + 3] = (int)t4_.w; } } while (0)
    { const unsigned char* ub0 = PTU + (size_t)el[c] * 1024 + 16 * q;
      peer_dma_u<0>(ub0, ring); peer_dma_u<1>(ub0, ring); peer_dma_u<2>(ub0, ring); peer_dma_u<3>(ub0, ring); peer_dma_u<4>(ub0, ring); peer_dma_u<5>(ub0, ring); peer_dma_u<6>(ub0, ring); peer_dma_u<7>(ub0, ring);
      peer_dma_u<8>(ub0, ring); peer_dma_u<9>(ub0, ring); peer_dma_u<10>(ub0, ring); peer_dma_u<11>(ub0, ring); peer_dma_u<12>(ub0, ring); peer_dma_u<13>(ub0, ring); peer_dma_u<14>(ub0, ring); peer_dma_u<15>(ub0, ring); }
    asm volatile("s_waitcnt vmcnt(12)" ::: "memory");
    u32x4 rr[4];
#pragma unroll
    for (int i = 0; i < 4; ++i) rr[i] = PEER_RD(i);
    for (int eg = 0; eg < 8; ++eg) {
        f32x4 acc = {0.f, 0.f, 0.f, 0.f};
        const unsigned char* ubn = PTU + (size_t)el[16 * (eg < 7 ? eg + 1 : 7) + c] * 1024 + 16 * q;
        int ev[16]; PEER_EL16(ev, 0);
#define PEER_USTEP(k) do { asm volatile("s_waitcnt vmcnt(11)" ::: "memory"); const u32x4 nw = PEER_RD(((k) + 4) & 15); \
            acc = MFMA8(lo64(rr[(k) & 3]), lo64(hb[k]), acc); acc = MFMA8(hi64(rr[(k) & 3]), hi64(hb[k]), acc); asm volatile("" :: "v"(rr[(k) & 3])); \
            if (eg < 7) peer_dma_u<k>(ubn, ring); else PEER_DMA(PTV + (size_t)ev[k] * 1024 + e0, k); rr[(k) & 3] = nw; } while (0)
        PEER_USTEP(0); PEER_USTEP(1); PEER_USTEP(2); PEER_USTEP(3); PEER_USTEP(4); PEER_USTEP(5); PEER_USTEP(6); PEER_USTEP(7);
        PEER_USTEP(8); PEER_USTEP(9); PEER_USTEP(10); PEER_USTEP(11); PEER_USTEP(12); PEER_USTEP(13); PEER_USTEP(14); PEER_USTEP(15);
#undef PEER_USTEP
        if (c == 0) { f32x4 cf;
#pragma unroll
            for (int i = 0; i < 4; ++i) cf[i] = wlw[16 * eg + 4 * q + i] * gelu_t(acc[i] * eul[16 * eg + 4 * q + i] * hs_inv);
            *(LAS f32x4*)(cl + 16 * eg + 4 * q) = cf; }
    }
    typedef float f32x2_t __attribute__((ext_vector_type(2)));
    f32x2_t out[8];
#pragma unroll
    for (int e = 0; e < 8; ++e) out[e] = (f32x2_t){0.f, 0.f};
    for (int eb = 0; eb < 128; eb += 16) {
        int ev[16]; PEER_EL16(ev, eb + 16);
        float cv[16];
#pragma unroll
        for (int v_ = 0; v_ < 4; ++v_) { const f32x4 t4 = *(const LAS f32x4*)(cl + eb + 4 * v_); cv[4 * v_] = t4.x; cv[4 * v_ + 1] = t4.y; cv[4 * v_ + 2] = t4.z; cv[4 * v_ + 3] = t4.w; }
#pragma unroll
        for (int k = 0; k < 16; ++k) {
            asm volatile("s_waitcnt vmcnt(11)" ::: "memory");
            const u32x4 nw = PEER_RD((k + 4) & 15);
            const u32x4 pv_ = rr[k & 3]; const f32x2_t cc = {cv[k], cv[k]};
            out[0] += cc * __builtin_amdgcn_cvt_pk_f32_fp8((int)pv_.x, false); out[1] += cc * __builtin_amdgcn_cvt_pk_f32_fp8((int)pv_.x, true);
            out[2] += cc * __builtin_amdgcn_cvt_pk_f32_fp8((int)pv_.y, false); out[3] += cc * __builtin_amdgcn_cvt_pk_f32_fp8((int)pv_.y, true);
            out[4] += cc * __builtin_amdgcn_cvt_pk_f32_fp8((int)pv_.z, false); out[5] += cc * __builtin_amdgcn_cvt_pk_f32_fp8((int)pv_.z, true);
            out[6] += cc * __builtin_amdgcn_cvt_pk_f32_fp8((int)pv_.w, false); out[7] += cc * __builtin_amdgcn_cvt_pk_f32_fp8((int)pv_.w, true);
            asm volatile("" :: "v"(rr[k & 3]));
            PEER_DMA(PTV + (size_t)ev[k] * 1024 + e0, k);
            rr[k & 3] = nw;
        }
    }
    asm volatile("s_waitcnt vmcnt(0) lgkmcnt(0)" ::: "memory");
#undef PEER_DMA
#undef PEER_RD
#undef PEER_EL16
    float* xo = xout + (size_t)t * 1024 + e0;
    { const f32x4 o0 = {xk0.x + out[0].x, xk0.y + out[0].y, xk0.z + out[1].x, xk0.w + out[1].y}, o1 = {xk1.x + out[2].x, xk1.y + out[2].y, xk1.z + out[3].x, xk1.w + out[3].y};
      const f32x4 o2 = {xk2.x + out[4].x, xk2.y + out[4].y, xk2.z + out[5].x, xk2.w + out[5].y}, o3 = {xk3.x + out[6].x, xk3.y + out[6].y, xk3.z + out[7].x, xk3.w + out[7].y};
      *(f32x4*)xo = o0; *(f32x4*)(xo + 4) = o1; *(f32x4*)(xo + 8) = o2; *(f32x4*)(xo + 12) = o3;
      if (xout == p.out) {
          float ss = (o0.x * o0.x + o0.y * o0.y + o0.z * o0.z + o0.w * o0.w) + (o1.x * o1.x + o1.y * o1.y + o1.z * o1.z + o1.w * o1.w) + (o2.x * o2.x + o2.y * o2.y + o2.z * o2.z + o2.w * o2.w) + (o3.x * o3.x + o3.y * o3.y + o3.z * o3.z + o3.w * o3.w);
          const float rq = rsqrtf(wave_sum(ss) * (1.f / 1024.f) + 1e-6f);
          const float* gp = p.in[I_GPLE] + l * 1024 + e0; const f32x4 g0 = *(const f32x4*)gp, g1 = *(const f32x4*)(gp + 4), g2 = *(const f32x4*)(gp + 8), g3 = *(const f32x4*)(gp + 12);
          u32x4 w0, w1; w0.x = pk2(o0.x * rq * g0.x, o0.y * rq * g0.y); w0.y = pk2(o0.z * rq * g0.z, o0.w * rq * g0.w); w0.z = pk2(o1.x * rq * g1.x, o1.y * rq * g1.y); w0.w = pk2(o1.z * rq * g1.z, o1.w * rq * g1.w);
          w1.x = pk2(o2.x * rq * g2.x, o2.y * rq * g2.y); w1.y = pk2(o2.z * rq * g2.z, o2.w * rq * g2.w); w1.z = pk2(o3.x * rq * g3.x, o3.y * rq * g3.y); w1.w = pk2(o3.z * rq * g3.z, o3.w * rq * g3.w);
          bf16_t* hr = (bf16_t*)(ws + WS_H) + (size_t)t * 1024 + e0; *(u32x4*)hr = w0; *(u32x4*)(hr + 8) = w1; } }
    LDS_WAIT();
}
DI void phase_peer(const Params& p, int l, const Frame& F, float* xout) {
    LAS unsigned char* wl = F.lds + F.wave * LDS_PERWAVE; const int gw = F.vb * 8 + F.wave, NGW = F.G * 8;
    for (int tile = gw; tile < T / 16; tile += NGW) {
        peer_route_tile(p, tile * 16, F.lane);
        __threadfence_block();
        for (int k = 0; k < 16; ++k) peer_gather_token(p, l, tile * 16 + k, p.out, xout, wl, F.lane);
    }
}

#ifndef MK_MASK
#define MK_MASK 0x1fff
#endif
__global__ void __launch_bounds__(512, 2) mega(Params p) {
    extern __shared__ __attribute__((aligned(16))) unsigned char lds_raw[];
#define MKFRAME() Frame F; { int t_ = threadIdx.x; asm volatile("" : "+v"(t_)); F.lds = (LAS unsigned char*)lds_raw; F.tid = t_; F.lane = t_ & 63; F.wave = __builtin_amdgcn_readfirstlane(t_ >> 6); \
        F.G = gridDim.x; const int bx = blockIdx.x; F.vb = (F.G % 8 == 0) ? (bx % 8) * (F.G / 8) + bx / 8 : bx; }
    if (threadIdx.x < 16) ((LAS unsigned*)((LAS unsigned char*)lds_raw + LDS_XB))[threadIdx.x] = 0u;
    __syncthreads();
    const int lo = p.ph_lo, hi = p.ph_hi;
    XcdBarrier bar; bar.bar = (unsigned*)(p.ws + WS_CTL) + 4096; bar.x = 0; bar.st = (volatile LAS unsigned*)((LAS unsigned char*)lds_raw + LDS_XB);
    if (hi - lo > 1) bar = xcd_barrier_post((unsigned*)(p.ws + WS_CTL) + 4096, (volatile LAS unsigned*)((LAS unsigned char*)lds_raw + LDS_XB));
#define WSP(ws) unsigned char* ws = p.ws; asm volatile("" : "+s"(ws))
    for (int l = 0; l < NLAYER; ++l) {
        const int pb = l * NPH;
#define IN(k) (((MK_MASK >> (k)) & 1) && lo <= pb + (k) && pb + (k) < hi)
#if MK_PROBE == 120
#define SEAM(k) do { if (((MK_MASK >> (k)) & 1) && lo <= pb + (k) && pb + (k) + 1 < hi) { xcd_barrier(bar); xcd_barrier(bar); xcd_barrier(bar); } } while (0)
#else
#define SEAM(k) do { if (((MK_MASK >> (k)) & 1) && lo <= pb + (k) && pb + (k) + 1 < hi) xcd_barrier(bar); } while (0)
#endif
        if (IN(0)) { MKFRAME(); phase_prep_w(p, l, F); }
        SEAM(0);
#if MK_PROBE == 100
        if (IN(0)) { MKFRAME(); phase_prep_w(p, l, F); } xcd_barrier(bar);
#endif
        if (IN(1)) { MKFRAME(); WSP(ws); pg8::Gemm g{(const bf16_t*)(ws + WS_H), (const bf16_t*)(ws + WS_WCAT), T, 9216, 1024}; XcdColOrder S{F.G, (int)blockIdx.x};
            Epi1 E{(bf16_t*)(ws + WS_PROJ), (bf16_t*)(ws + WS_GATES)};
            pg8::gemm_phase<Epi1, XcdColOrder, false>(F.lds, g, S, E, nullptr); }
        SEAM(1);
#if MK_PROBE == 104
        if (IN(1)) { for (int rr = 0; rr < 18; ++rr) { MKFRAME(); WSP(ws); pg8::Gemm g{(const bf16_t*)(ws + WS_H), (const bf16_t*)(ws + WS_WCAT), T, 9216, 1024}; RoundOrder S; S.base.init(T, 9216, F.G, (int)blockIdx.x); S.r = rr;
            Epi1 E{(bf16_t*)(ws + WS_PROJ), (bf16_t*)(ws + WS_GATES)};
            pg8::gemm_phase<Epi1, RoundOrder, false>(F.lds, g, S, E, nullptr); xcd_barrier(bar); } }
#endif
#if MK_PROBE == 101 || MK_PROBE == 102 || MK_PROBE == 103
        if (IN(1)) { MKFRAME(); WSP(ws); pg8::Gemm g{(const bf16_t*)(ws + WS_H), (const bf16_t*)(ws + WS_WCAT), T, 9216, 1024}; ColRangeOrder S{F.G, (int)blockIdx.x, MK_PROBE == 103 ? 20 : 0, MK_PROBE == 102 ? 20 : 36};
            Epi1 E{(bf16_t*)(ws + WS_PROJ), (bf16_t*)(ws + WS_GATES)};
            pg8::gemm_phase<Epi1, ColRangeOrder, false>(F.lds, g, S, E, nullptr); } xcd_barrier(bar);
#endif
        if (IN(2)) { MKFRAME(); phase_chunk(p, l, F); }
        SEAM(2);
        if (IN(3)) { MKFRAME(); WSP(ws);
            { pg8::Gemm g{(const bf16_t*)(ws + WS_CMPA), (const bf16_t*)(ws + WS_W1C), 4096, 512, 1024}; pg8::StaticOrder S; S.init(4096, 512, F.G, (int)blockIdx.x); EpiF32P E{(float*)(ws + WS_CMPP), 512};
              pg8::gemm_phase<EpiF32P, pg8::StaticOrder, false>(F.lds, g, S, E, nullptr); }
        }
        if (IN(3)) { MKFRAME(); WSP(ws);
            { pg8::Gemm g{(const bf16_t*)(ws + WS_CMPA) + (size_t)4096 * 1024, (const bf16_t*)(ws + WS_W1C) + (size_t)512 * 1024, 4096, 512, 1024}; pg8::StaticOrder S; S.init(4096, 512, F.G, (int)((blockIdx.x + F.G / 2) % F.G));
              EpiF32P E{(float*)(ws + WS_CMPP) + (size_t)4096 * 512, 512};
              pg8::gemm_phase<EpiF32P, pg8::StaticOrder, false>(F.lds, g, S, E, nullptr); }
        }
        SEAM(3);
        if (IN(4)) { MKFRAME(); phase_cmp2(p, l, F); }
        SEAM(4);
        if (IN(5)) { MKFRAME(); phase_attn(p, l, F, 3, 15); }
        SEAM(5);
#if MK_PROBE == 5 || MK_PROBE == 50 || MK_PROBE == 51 || MK_PROBE == 52 || MK_PROBE == 53
        if (IN(5)) { MKFRAME(); phase_attn(p, l, F, MK_PROBE == 5 ? 3 : (MK_PROBE == 50 ? 1 : 2), MK_PROBE == 52 ? 1 : (MK_PROBE == 53 ? 3 : 15)); xcd_barrier(bar); }
#endif
#if MK_PROBE >= 60 && MK_PROBE < 76
        if (IN(5)) { MKFRAME(); phase_attn(p, l, F, 1, (MK_PROBE - 60) << 8); xcd_barrier(bar); }
#endif
        if (IN(6)) { MKFRAME(); WSP(ws); pg8::Gemm g{(const bf16_t*)(ws + WS_Y), (const bf16_t*)(ws + WS_WBR), 4 * T, 4096, 512}; BranchOrder S{F.G, (int)blockIdx.x};
            EpiBranch E{(const bf16_t*)(ws + WS_GATES), (bf16_t*)(ws + WS_MERGED)};
            pg8::gemm_phase<EpiBranch, BranchOrder, false>(F.lds, g, S, E, nullptr); }
        SEAM(6);
#if MK_PROBE == 106
        if (IN(6)) { MKFRAME(); WSP(ws); pg8::Gemm g{(const bf16_t*)(ws + WS_Y), (const bf16_t*)(ws + WS_WBR), 4 * T, 4096, 512}; BranchOrder S{F.G, (int)blockIdx.x};
            EpiBranch E{(const bf16_t*)(ws + WS_GATES), (bf16_t*)(ws + WS_MERGED)};
            pg8::gemm_phase<EpiBranch, BranchOrder, false>(F.lds, g, S, E, nullptr); } xcd_barrier(bar);
#endif
        if (IN(7)) { MKFRAME(); WSP(ws); pg8::Gemm g{(const bf16_t*)(ws + WS_MERGED), (const bf16_t*)(ws + WS_WOUT4), T, 1024, 1024}; pg8::StaticOrder S; S.init(T, 1024, F.G, (int)blockIdx.x);
            EpiRes E{l == 0 ? p.in[I_X] : p.out, p.out};
            pg8::gemm_phase<EpiRes, pg8::StaticOrder, false>(F.lds, g, S, E, nullptr); }
        SEAM(7);
        if (IN(8)) { MKFRAME(); WSP(ws); rmsnorm_rows(p.out, p.in[I_GFFN] + l * 1024, (bf16_t*)(ws + WS_H), F.vb * 8 + F.wave, F.G * 8, F.lane); }
        SEAM(8);
#if MK_PROBE == 108
        if (IN(8)) { MKFRAME(); WSP(ws); rmsnorm_rows(p.out, p.in[I_GFFN] + l * 1024, (bf16_t*)(ws + WS_H), F.vb * 8 + F.wave, F.G * 8, F.lane); } xcd_barrier(bar);
#endif
        if (IN(9)) { MKFRAME(); WSP(ws);
            { pg8::Gemm g{(const bf16_t*)(ws + WS_H), (const bf16_t*)(ws + WS_WQ), T, 1024, 1024}; pg8::StaticOrder S; S.init(T, 1024, F.G, (int)blockIdx.x); EpiBf E{(bf16_t*)(ws + WS_QP), 1024};
              pg8::gemm_phase<EpiBf, pg8::StaticOrder, false>(F.lds, g, S, E, nullptr); }
        }
        if (IN(9)) { MKFRAME(); WSP(ws);
            { pg8::Gemm g{(const bf16_t*)(ws + WS_PB), (const bf16_t*)(ws + WS_WPP), T, 1024, 256}; pg8::StaticOrder S; S.init(T, 1024, F.G, (int)blockIdx.x); EpiBf E{(bf16_t*)(ws + WS_PP), 1024};
              pg8::gemm_phase<EpiBf, pg8::StaticOrder, false>(F.lds, g, S, E, nullptr); }
        }
        SEAM(9);
#if MK_PROBE == 110
        if (IN(9)) { for (int rep = 0; rep < 9; ++rep) { MKFRAME(); WSP(ws);
            { pg8::Gemm g{(const bf16_t*)(ws + WS_H), (const bf16_t*)(ws + WS_WQ), T, 1024, 1024}; pg8::StaticOrder S; S.init(T, 1024, F.G, (int)blockIdx.x); EpiBf E{(bf16_t*)(ws + WS_QP), 1024};
              pg8::gemm_phase<EpiBf, pg8::StaticOrder, false>(F.lds, g, S, E, nullptr); } } xcd_barrier(bar); }
#endif
#if MK_PROBE == 109
        if (IN(9)) { MKFRAME(); WSP(ws);
            { pg8::Gemm g{(const bf16_t*)(ws + WS_H), (const bf16_t*)(ws + WS_WQ), T, 1024, 1024}; pg8::StaticOrder S; S.init(T, 1024, F.G, (int)blockIdx.x); EpiBf E{(bf16_t*)(ws + WS_QP), 1024};
              pg8::gemm_phase<EpiBf, pg8::StaticOrder, false>(F.lds, g, S, E, nullptr); } }
        if (IN(9)) { MKFRAME(); WSP(ws);
            { pg8::Gemm g{(const bf16_t*)(ws + WS_PB), (const bf16_t*)(ws + WS_WPP), T, 1024, 256}; pg8::StaticOrder S; S.init(T, 1024, F.G, (int)blockIdx.x); EpiBf E{(bf16_t*)(ws + WS_PP), 1024};
              pg8::gemm_phase<EpiBf, pg8::StaticOrder, false>(F.lds, g, S, E, nullptr); } }
        xcd_barrier(bar);
#endif
#if MK_PROBE == 10 || MK_PROBE == 12
        if (IN(10)) { MKFRAME(); phase_peer(p, l, F, (float*)(p.ws + WS_GATES)); xcd_barrier(bar); }
#endif
#if MK_PROBE == 11
        if (IN(10)) { MKFRAME(); for (int tile = F.vb * 8 + F.wave; tile < T / 16; tile += F.G * 8) peer_route_tile(p, tile * 16, F.lane); xcd_barrier(bar); }
#endif
        if (IN(10)) { MKFRAME(); phase_peer(p, l, F, p.out); }
        SEAM(10);
        if (IN(12)) { MKFRAME(); WSP(ws); pg8::Gemm g{(const bf16_t*)(ws + WS_H), (const bf16_t*)(ws + WS_WPG), T, 1024, 1024}; pg8::StaticOrder S; S.init(T, 1024, F.G, (int)blockIdx.x);
            EpiPle E{p.out, (const bf16_t*)(ws + WS_PP)};
            pg8::gemm_phase<EpiPle, pg8::StaticOrder, false>(F.lds, g, S, E, nullptr); }
        SEAM(12);
#undef IN
#undef SEAM
    }
}
}

#ifndef MK_LAUNCH_PER_PHASE
#define MK_LAUNCH_PER_PHASE 0
#endif
extern "C" void kernel_launch(void* const* d_in, const int* in_sizes, int n_in, void* d_out, int out_size, void* d_ws, size_t ws_size, hipStream_t stream) {
    static int grid = 0;
    if (grid == 0) {
        if (n_in != 27 || ws_size < mk::WS_END) { fprintf(stderr, "kernel_launch: need 27 inputs and >= %zu bytes of workspace (got %d, %zu)\n", (size_t)mk::WS_END, n_in, ws_size); grid = -1; return; }
        int dev = 0, cus = 0;
        if (hipGetDevice(&dev) != hipSuccess || hipDeviceGetAttribute(&cus, hipDeviceAttributeMultiprocessorCount, dev) != hipSuccess) { grid = -1; return; }
        if (hipFuncSetAttribute((const void*)mk::mega, hipFuncAttributeMaxDynamicSharedMemorySize, mk::LDS_BYTES) != hipSuccess) { fprintf(stderr, "kernel_launch: hipFuncSetAttribute failed\n"); grid = -1; return; }
        int per_cu = 0;
        if (hipOccupancyMaxActiveBlocksPerMultiprocessor(&per_cu, (const void*)mk::mega, 512, mk::LDS_BYTES) != hipSuccess || per_cu < 1) fprintf(stderr, "kernel_launch: occupancy query says %d\n", per_cu);
        (void)hipGetLastError();
        grid = cus;
    }
    if (grid < 0) return;
    (void)in_sizes; (void)out_size;
    hipMemsetAsync((char*)d_ws + mk::WS_CTL, 0, 1u << 20, stream);
    mk::Params prm{};
    for (int i = 0; i < 27; ++i) prm.in[i] = (const float*)d_in[i];
    prm.out = (float*)d_out; prm.ws = (unsigned char*)d_ws;
#if MK_LAUNCH_PER_PHASE
    for (int ph = 0; ph < mk::NLAYER * mk::NPH; ++ph) { prm.ph_lo = ph; prm.ph_hi = ph + 1; hipLaunchKernelGGL(mk::mega, dim3(grid), dim3(512), mk::LDS_BYTES, stream, prm); }
#else
    prm.ph_lo = 0; prm.ph_hi = mk::NLAYER * mk::NPH; hipLaunchKernelGGL(mk::mega, dim3(grid), dim3(512), mk::LDS_BYTES, stream, prm);
#endif
}
```

```cpp
#include <hip/hip_runtime.h>
#include <stdio.h>
#include <stdint.h>
namespace pg8 {
#define PG8_LAS __attribute__((address_space(3)))
typedef unsigned short bf16_t;
typedef short bf16x8 __attribute__((ext_vector_type(8)));
typedef float f32x4 __attribute__((ext_vector_type(4)));
typedef unsigned u32x4 __attribute__((ext_vector_type(4)));
constexpr int BM = 256, BK = 64, HALF = 128, HTB = HALF * BK * 2  , STAGE_BYTES = 8 * HTB, NXCD = 8, WGM = 8;

__host__ __device__ __forceinline__ int lds_byte(int r, int c) { const int st = (r >> 4) * 2 + (c >> 5), rr = r & 15, cc = c & 31, ob = rr * 64 + cc * 2; return st * 1024 + (ob ^ (((ob >> 9) & 1) << 5)); }
__host__ __device__ __forceinline__ void stage_rc(int b, int& R, int& C) { const int st = b / 1024, sb = b % 1024, swz = sb ^ (((sb >> 9) & 1) << 5); R = (st >> 1) * 16 + swz / 64; C = (st & 1) * 32 + (swz % 64) / 2; }
__host__ __device__ __forceinline__ int perm32(int rho) { const int n = rho >> 4, i = rho & 15; return 8 * (i >> 2) + 4 * n + (i & 3); }

struct Unit { int pm, pn; };
struct Gemm { const bf16_t* A; const bf16_t* Bt; int M, N, K; };

struct StaticOrder {
    int nM, nN, nwg, G, c;
    __host__ __device__ void init(int M, int N, int G_, int c_) { nM = M / BM; nN = N / BM; nwg = nM * nN; G = G_; c = c_; }
    __host__ __device__ bool next(int i, Unit& u) const {
        const long L = (long)i * G + c; if (L >= nwg) return false;
        int wgid = (int)L; { const int q = nwg / NXCD, r = nwg % NXCD, xcd = wgid % NXCD, off = wgid / NXCD; wgid = (xcd < r ? xcd * (q + 1) : r * (q + 1) + (xcd - r) * q) + off; }
        const int nig = WGM * nN, gid = wgid / nig, fm = gid * WGM, gsz = (nM - fm) < WGM ? (nM - fm) : WGM;
        u.pm = fm + ((wgid % nig) % gsz); u.pn = (wgid % nig) / gsz; return true;
    }
    __device__ __forceinline__ void a_ready(const Unit&) const {}
    __device__ __forceinline__ void done(const Unit&) const {}
};
__device__ __forceinline__ unsigned cvt_pk_bf16(float lo, float hi) { unsigned r; asm volatile("v_cvt_pk_bf16_f32 %0, %1, %2" : "=v"(r) : "v"(lo), "v"(hi)); return r; }
template <class Epi, class Sched, bool STAMP = false>
__device__ __forceinline__ void gemm_phase(PG8_LAS unsigned char* lds, const Gemm g, const Sched& S, const Epi& E, unsigned long long* stamps) {
    int tid_l = threadIdx.x; asm volatile("" : "+v"(tid_l));
    const int tid = tid_l, wid = __builtin_amdgcn_readfirstlane(tid >> 6), lane = tid & 63, wr = wid >> 2, wc = wid & 3, fr = lane & 15, fq = lane >> 4;
    const int K = g.K, nt = K / BK;
    int ts_lo = 0, ts_hi = 0, nts = 0; const unsigned long long rt_entry = STAMP ? (unsigned long long)wall_clock64() : 0ull;
#define PG8_STAMP() do { if (STAMP && wid == 0 && nts < 64) { const unsigned long long _c = (unsigned long long)clock64(); \
        ts_lo = (lane == nts) ? (int)(unsigned)_c : ts_lo; ts_hi = (lane == nts) ? (int)(unsigned)(_c >> 32) : ts_hi; ++nts; } } while (0)
    PG8_STAMP();
    unsigned voffA[2], voffB[2];
#pragma unroll
    for (int i = 0; i < 2; ++i) { int R, C; stage_rc(tid * 16 + i * 8192, R, C); const int Rb = Epi::PERM ? ((R & ~31) + perm32(R & 31)) : R;
        voffA[i] = (unsigned)(R * K + C) * 2u; voffB[i] = (unsigned)(Rb * K + C) * 2u; }
    const size_t kstep = (size_t)(BK * 2);
    const size_t hstep = (size_t)HALF * K * 2;
    const size_t tstep = 2 * hstep;
    const unsigned ldsw = (unsigned)wid * 1024u;
    const int aoff = lds_byte(wr * 64 + fr, fq * 8), boff = lds_byte(wc * 32 + fr, fq * 8);
#define PG8_SA(b, h) (((b) * 2 + (h)) * HTB)
#define PG8_SB(b, h) ((4 + (b) * 2 + (h)) * HTB)
#define PG8_STAGE(bufoff, gbase, voff) do { _Pragma("unroll") for (int _i = 0; _i < 2; ++_i) \
        __builtin_amdgcn_global_load_lds((const unsigned*)((const char*)(gbase) + (voff)[_i]), (PG8_LAS unsigned*)(lds + (bufoff) + ldsw + _i * 8192), 16, 0, 0); } while (0)
#define PG8_LDA(dst, b, h) do { _Pragma("unroll") for (int m = 0; m < 4; ++m) _Pragma("unroll") for (int k = 0; k < 2; ++k) dst[m][k] = *(const PG8_LAS bf16x8*)(lds + PG8_SA(b, h) + aoff + m * 2048 + k * 1024); } while (0)
#define PG8_LDB(dst, b, h) do { _Pragma("unroll") for (int n = 0; n < 2; ++n) _Pragma("unroll") for (int k = 0; k < 2; ++k) dst[n][k] = *(const PG8_LAS bf16x8*)(lds + PG8_SB(b, h) + boff + n * 2048 + k * 1024); } while (0)
#define PG8_MMA(ai, bj, At, Bt) do { __builtin_amdgcn_s_setprio(1); _Pragma("unroll") for (int m = 0; m < 4; ++m) _Pragma("unroll") for (int n = 0; n < 2; ++n) _Pragma("unroll") for (int k = 0; k < 2; ++k) \
        acc[ai][bj][m][n] = __builtin_amdgcn_mfma_f32_16x16x32_bf16(Bt[n][k], At[m][k], acc[ai][bj][m][n], 0, 0, 0); __builtin_amdgcn_s_setprio(0); } while (0)
#define PG8_WAIT_V(n) asm volatile("s_waitcnt vmcnt(" #n ")" ::: "memory")
#define PG8_WAIT_L(n) asm volatile("s_waitcnt lgkmcnt(" #n ")" ::: "memory")
#define PG8_BAR __builtin_amdgcn_s_barrier()
#define PG8_SCHED __builtin_amdgcn_sched_barrier(0)
    Unit cur, nxt; int ui = 0;
    if (!S.next(0, cur)) return;
    f32x4 acc[2][2][4][2];
#pragma unroll
    for (int a = 0; a < 2; ++a)
#pragma unroll
        for (int b = 0; b < 2; ++b)
#pragma unroll
            for (int m = 0; m < 4; ++m)
#pragma unroll
                for (int n = 0; n < 2; ++n) acc[a][b][m][n] = (f32x4){0.f, 0.f, 0.f, 0.f};
    bf16x8 At[4][2], B0[2][2], B1[2][2];
    const char* cA = (const char*)g.A + (size_t)cur.pm * tstep; const char* cB = (const char*)g.Bt + (size_t)cur.pn * tstep;
    S.a_ready(cur);
    PG8_STAGE(PG8_SB(0, 0), cB, voffB); PG8_STAGE(PG8_SA(0, 0), cA, voffA); PG8_STAGE(PG8_SB(0, 1), cB + hstep, voffB); PG8_STAGE(PG8_SA(0, 1), cA + hstep, voffA);
    if (wr == 1) PG8_BAR;
    PG8_WAIT_V(4); PG8_BAR;
    PG8_STAGE(PG8_SB(1, 0), cB + kstep, voffB); PG8_STAGE(PG8_SA(1, 0), cA + kstep, voffA); PG8_STAGE(PG8_SB(1, 1), cB + hstep + kstep, voffB);
    PG8_WAIT_V(6); PG8_BAR;
    PG8_STAMP();
    for (;;) {
        const bool has_next = S.next(ui + 1, nxt);
        const char* nA = has_next ? (const char*)g.A + (size_t)nxt.pm * tstep : cA; const char* nB = has_next ? (const char*)g.Bt + (size_t)nxt.pn * tstep : cB;
        for (int t = 0; t < nt; t += 2) {
            const bool last = (t == nt - 2);
            const char* a1 = cA + (size_t)(t + 1) * kstep;
            const char* a2 = last ? nA : cA + (size_t)(t + 2) * kstep; const char* b2 = last ? nB : cB + (size_t)(t + 2) * kstep;
            const char* a3 = a2 + kstep; const char* b3 = b2 + kstep;
            if (last && has_next) S.a_ready(nxt);
            PG8_LDB(B0, 0, 0); PG8_SCHED; PG8_LDA(At, 0, 0); PG8_STAGE(PG8_SA(1, 1), a1 + hstep, voffA);
            PG8_WAIT_L(8); PG8_BAR; PG8_WAIT_L(0); PG8_MMA(0, 0, At, B0); PG8_BAR; PG8_SCHED;
            PG8_LDB(B1, 0, 1); PG8_STAGE(PG8_SB(0, 0), b2, voffB);
            PG8_BAR; PG8_WAIT_L(0); PG8_MMA(0, 1, At, B1); PG8_BAR;
            PG8_LDA(At, 0, 1); PG8_STAGE(PG8_SA(0, 0), a2, voffA);
            PG8_BAR; PG8_WAIT_L(0); PG8_MMA(1, 0, At, B0); PG8_BAR; PG8_SCHED;
            PG8_STAGE(PG8_SB(0, 1), b2 + hstep, voffB);
            PG8_WAIT_V(6); PG8_BAR; PG8_MMA(1, 1, At, B1); PG8_BAR;
            PG8_LDB(B0, 1, 0); PG8_SCHED; PG8_LDA(At, 1, 0); PG8_STAGE(PG8_SA(0, 1), a2 + hstep, voffA);
            PG8_WAIT_L(8); PG8_BAR; PG8_WAIT_L(0); PG8_MMA(0, 0, At, B0); PG8_BAR; PG8_SCHED;
            PG8_LDB(B1, 1, 1); PG8_STAGE(PG8_SB(1, 0), b3, voffB);
            PG8_BAR; PG8_WAIT_L(0); PG8_MMA(0, 1, At, B1); PG8_BAR;
            PG8_LDA(At, 1, 1); PG8_STAGE(PG8_SA(1, 0), a3, voffA);
            PG8_BAR; PG8_WAIT_L(0); PG8_MMA(1, 0, At, B0); PG8_BAR; PG8_SCHED;
            PG8_STAGE(PG8_SB(1, 1), b3 + hstep, voffB);
            PG8_WAIT_V(6); PG8_BAR; PG8_MMA(1, 1, At, B1); PG8_BAR;
        }
        PG8_STAMP();
        if constexpr (!Epi::AFTER_DRAIN) { E(acc, cur, wr, wc, fr, fq); S.done(cur); }
        PG8_STAMP();
        if (!has_next) break;
#pragma unroll
        for (int a = 0; a < 2; ++a)
#pragma unroll
            for (int b = 0; b < 2; ++b)
#pragma unroll
                for (int m = 0; m < 4; ++m)
#pragma unroll
                    for (int n = 0; n < 2; ++n) acc[a][b][m][n] = (f32x4){0.f, 0.f, 0.f, 0.f};
        cur = nxt; cA = nA; cB = nB; ++ui;
    }
    PG8_WAIT_V(0);
    if (wr == 0) PG8_BAR;
    PG8_BAR;
    if constexpr (Epi::AFTER_DRAIN) { E.fused(acc, cur, wr, wc, fr, fq, lds, wid, lane); S.done(cur); }
    PG8_STAMP();
    if (STAMP && wid == 0) { stamps[lane] = lane < nts ? (((unsigned long long)(unsigned)ts_hi << 32) | (unsigned)ts_lo) : 0ull;
        if (lane == 62) stamps[62] = rt_entry; if (lane == 63) stamps[63] = (unsigned long long)wall_clock64(); }
#undef PG8_STAMP
#undef PG8_SA
#undef PG8_SB
#undef PG8_STAGE
#undef PG8_LDA
#undef PG8_LDB
#undef PG8_MMA
#undef PG8_WAIT_V
#undef PG8_WAIT_L
#undef PG8_BAR
#undef PG8_SCHED
}
}
#define XB_TMO      128
#define XB_XCNT(j)  (256  + 64 * (j))
#define XB_XSUB(j)  (1280 + 64 * (j))
#define XB_XGEN(j)  (2304 + 64 * (j))
#define XB_TOP      3328
#define XB_TOPGEN   3392
#define XCD_BAR_WORDS 3456
#define XB_SPIN_CAP (1u << 18)
#define LAS __attribute__((address_space(3)))

__device__ __forceinline__ unsigned xb_ld(unsigned* p)              { return __hip_atomic_load(p, __ATOMIC_RELAXED, __HIP_MEMORY_SCOPE_AGENT); }
__device__ __forceinline__ unsigned xb_add(unsigned* p, unsigned v) { return __hip_atomic_fetch_add(p, v, __ATOMIC_RELAXED, __HIP_MEMORY_SCOPE_AGENT); }
__device__ __forceinline__ unsigned xb_xcc_id() { return (unsigned)__builtin_amdgcn_s_getreg((3 << 11) | 20) & 0xFu; }
#define XB_SPIN(cond, bar) do { unsigned _sp = 0; while (cond) { __builtin_amdgcn_s_sleep(1); \
    if ((++_sp & 255u) == 0u) { if (xb_ld(&(bar)[XB_TMO])) break; if (_sp > XB_SPIN_CAP) { atomicAdd(&(bar)[XB_TMO], 1u); break; } } } } while (0)

struct XcdBarrier {
    unsigned* bar; unsigned x;
    volatile LAS unsigned* st;
};

__device__ __forceinline__ XcdBarrier xcd_barrier_post(unsigned* bar, volatile LAS unsigned* st) {
    XcdBarrier b; b.bar = bar; b.x = xb_xcc_id(); b.st = st;
    if (threadIdx.x == 0) (void)xb_add(&bar[XB_XCNT(b.x)], 1u);
    return b;
}
__device__ __forceinline__ void xcd_barrier_complete(unsigned* bar, unsigned x, unsigned& nloc, unsigned& nx) {
    const unsigned G = gridDim.x * gridDim.y * gridDim.z;
    unsigned sum, cnt, mine, sp = 0u;
    for (;;) {
        sum = 0u; cnt = 0u; mine = 0u;
#pragma unroll
        for (unsigned j = 0; j < 16; ++j) { const unsigned c = xb_ld(&bar[XB_XCNT(j)]); sum += c; cnt += (c > 0u) ? 1u : 0u; mine = (j == x) ? c : mine; }
        if (sum == G) break;
        __builtin_amdgcn_s_sleep(1);
        if ((++sp & 255u) == 0u) { if (xb_ld(&bar[XB_TMO])) break; if (sp > XB_SPIN_CAP) { atomicAdd(&bar[XB_TMO], 1u); break; } }
    }
    nloc = mine > 0u ? mine : 1u; nx = cnt > 0u ? cnt : 1u;
}

__device__ __forceinline__ void xcd_barrier(const XcdBarrier& b) {
    asm volatile("s_waitcnt vmcnt(0)" ::: "memory");
    __syncthreads();
    if (threadIdx.x == 0) {
        unsigned* bar = b.bar;
        __builtin_amdgcn_s_waitcnt(0);
        unsigned nloc = b.st[0], nx = b.st[1];
        if (nloc == 0u) { xcd_barrier_complete(bar, b.x, nloc, nx); b.st[0] = nloc; b.st[1] = nx; }
        const unsigned old = xb_add(&bar[XB_XSUB(b.x)], 1u);
        const unsigned gen = old / nloc;
        if (old + 1u == (gen + 1u) * nloc) {
            __builtin_amdgcn_fence(__ATOMIC_RELEASE, "agent");
            asm volatile("s_waitcnt vmcnt(0)" ::: "memory");
            const unsigned og = xb_add(&bar[XB_TOP], 1u);
            const unsigned tg = og / nx;
            if (og + 1u == (tg + 1u) * nx) xb_add(&bar[XB_TOPGEN], 1u);
            else XB_SPIN(xb_ld(&bar[XB_TOPGEN]) == tg, bar);
            __builtin_amdgcn_fence(__ATOMIC_ACQUIRE, "agent");
            xb_add(&bar[XB_XGEN(b.x)], 1u);
            asm volatile("s_waitcnt vmcnt(0)" ::: "memory");
        } else {
            XB_SPIN(xb_ld(&bar[XB_XGEN(b.x)]) == gen, bar);
            __builtin_amdgcn_fence(__ATOMIC_ACQUIRE, "agent");
            asm volatile("s_waitcnt vmcnt(0)" ::: "memory");
        }
    }
    __syncthreads();
}

namespace mk {
using pg8::bf16_t; using pg8::bf16x8; using pg8::f32x4; using pg8::u32x4;
typedef unsigned u32x2 __attribute__((ext_vector_type(2)));
typedef short s16x4 __attribute__((ext_vector_type(4)));
#define DI __device__ __forceinline__
#define LDS_WAIT() asm volatile("s_waitcnt lgkmcnt(0)" ::: "memory")
#define LDS_FENCE() asm volatile("" ::: "memory")
#define MFMA16(a, b, c) __builtin_amdgcn_mfma_f32_16x16x32_bf16((a), (b), (c), 0, 0, 0)

constexpr int T = 32768, SEQ = 4096, NLAYER = 4, NPH = 13;
constexpr int PW = 5120;
constexpr int C_AB = 0, C_AC = 512, C_AX = 1024, C_NQ = 1536, C_NKV = 2048, C_UV = 2816, C_DQ = 3840, C_DK = 4352, C_DV = 4416,
              C_DQI = 4480, C_DKI = 4992, C_NG = 5056, C_DWI = 5080;
constexpr size_t MiB = 1u << 20;
constexpr size_t WS_CTL = 0, WS_PEB = 1 * MiB, WS_CMPK = 2 * MiB, WS_CMPV = 3 * MiB, WS_SK = 4 * MiB, WS_SGUW = 5 * MiB, WS_CMPA = 8 * MiB,
                 WS_CMPP = 24 * MiB, WS_WCAT = 40 * MiB, WS_WBR = 58 * MiB, WS_WOUT4 = 62 * MiB, WS_WQ = 70 * MiB, WS_WPG = 72 * MiB,
                 WS_WPP = 74 * MiB, WS_W1C = 75 * MiB, WS_PB = 78 * MiB, WS_PTU = 96 * MiB, WS_PTV = 128 * MiB, WS_H = 160 * MiB,
                 WS_Y = 224 * MiB, WS_PROJ = 352 * MiB, WS_GATES = 672 * MiB,
                 WS_KS = 928 * MiB, WS_VS = 936 * MiB, WS_KW = 944 * MiB, WS_VW = 952 * MiB, WS_DK = 960 * MiB, WS_DV = 964 * MiB, WS_DKI = 968 * MiB, WS_END = 972 * MiB;
constexpr size_t WS_ACCF = WS_PROJ, WS_MERGED = WS_PROJ + 128 * MiB, WS_QP = WS_PROJ, WS_PP = WS_PROJ + 64 * MiB, WS_EIDX = WS_PROJ + 128 * MiB, WS_EW = WS_PROJ + 144 * MiB, WS_EU = WS_PROJ + 160 * MiB;
constexpr int LDS_BYTES = 163840, LDS_PERWAVE = 19456, LDS_BUCK = 8 * LDS_PERWAVE, LDS_TBL = LDS_BUCK + 4096, LDS_XB = LDS_BYTES - 64;

struct Params { const float* in[27]; float* out; unsigned char* ws; int ph_lo, ph_hi; };
enum { I_X = 0, I_P, I_REL, I_GMIX, I_WIN, I_CONVW, I_PE, I_CW1, I_CW2, I_NQG, I_NKG, I_LNG, I_SGUW, I_SGUB, I_DQG, I_DKG, I_WGATE, I_WBR, I_WOUT,
       I_GFFN, I_WQ, I_SUBK, I_PU, I_PV, I_GPLE, I_WPG, I_WPP };

struct Frame { LAS unsigned char* lds; int tid, lane, wave, vb, G; };

DI float bf2f(unsigned short b) { return __uint_as_float(((unsigned)b) << 16); }
DI unsigned f2bf(float f) { unsigned u = __float_as_uint(f); return (u + 0x7fffu + ((u >> 16) & 1u)) >> 16; }
DI unsigned pk2(float lo, float hi) { return pg8::cvt_pk_bf16(lo, hi); }
DI float lo16(unsigned w) { return __uint_as_float(w << 16); }
DI float hi16(unsigned w) { return __uint_as_float(w & 0xffff0000u); }
DI float sigm(float x) { return __builtin_amdgcn_rcpf(1.f + __builtin_amdgcn_exp2f(-1.44269504f * x)); }
DI float gelu_t(float x) { const float y = (-2.f * 0.7978845608f * 1.44269504f) * (x + 0.044715f * x * x * x); return x * __builtin_amdgcn_rcpf(1.f + __builtin_amdgcn_exp2f(y)); }
#define DPP_I(x, ctrl) __builtin_amdgcn_update_dpp(0, (x), (ctrl), 0xF, 0xF, false)
DI float dppf(float x, int) { return x; }
DI float row16_sumf(float v) { v += __builtin_bit_cast(float, DPP_I(__builtin_bit_cast(int, v), 0xB1)); v += __builtin_bit_cast(float, DPP_I(__builtin_bit_cast(int, v), 0x4E));
    v += __builtin_bit_cast(float, DPP_I(__builtin_bit_cast(int, v), 0x141)); v += __builtin_bit_cast(float, DPP_I(__builtin_bit_cast(int, v), 0x140)); return v; }
DI float row16_maxf(float v) { v = fmaxf(v, __builtin_bit_cast(float, DPP_I(__builtin_bit_cast(int, v), 0xB1))); v = fmaxf(v, __builtin_bit_cast(float, DPP_I(__builtin_bit_cast(int, v), 0x4E)));
    v = fmaxf(v, __builtin_bit_cast(float, DPP_I(__builtin_bit_cast(int, v), 0x141))); v = fmaxf(v, __builtin_bit_cast(float, DPP_I(__builtin_bit_cast(int, v), 0x140))); return v; }
DI float quad_sumf(float v) { v += __builtin_bit_cast(float, DPP_I(__builtin_bit_cast(int, v), 0xB1)); v += __builtin_bit_cast(float, DPP_I(__builtin_bit_cast(int, v), 0x4E)); return v; }
DI float oct_sumf(float v) { v = quad_sumf(v); v += __builtin_bit_cast(float, DPP_I(__builtin_bit_cast(int, v), 0x141)); return v; }
DI float x16_sum(float v) { const unsigned u = __float_as_uint(v); const auto r = __builtin_amdgcn_permlane16_swap(u, u, false, false); return __uint_as_float(r[0]) + __uint_as_float(r[1]); }
DI float x32_sum(float v) { const unsigned u = __float_as_uint(v); const auto r = __builtin_amdgcn_permlane32_swap(u, u, false, false); return __uint_as_float(r[0]) + __uint_as_float(r[1]); }
DI float x16_max(float v) { const unsigned u = __float_as_uint(v); const auto r = __builtin_amdgcn_permlane16_swap(u, u, false, false); return fmaxf(__uint_as_float(r[0]), __uint_as_float(r[1])); }
DI float x32_max(float v) { const unsigned u = __float_as_uint(v); const auto r = __builtin_amdgcn_permlane32_swap(u, u, false, false); return fmaxf(__uint_as_float(r[0]), __uint_as_float(r[1])); }
DI float wave_sum(float v) { return x32_sum(x16_sum(row16_sumf(v))); }
DI float wave_max(float v) { return x32_max(x16_max(row16_maxf(v))); }
DI unsigned ordf(float f) { const unsigned u = __float_as_uint(f); return (u & 0x80000000u) ? ~u : (u | 0x80000000u); }
DI float unordf(unsigned x) { return __uint_as_float((x & 0x80000000u) ? (x & 0x7fffffffu) : ~x); }
DI int bucket_of(int n) {
    if (n < 16) return n;
    int b = 16;
    b += (n >= 21); b += (n >= 27); b += (n >= 35); b += (n >= 46); b += (n >= 59); b += (n >= 77); b += (n >= 99); b += (n >= 128);
    b += (n >= 166); b += (n >= 216); b += (n >= 280); b += (n >= 363); b += (n >= 470); b += (n >= 609); b += (n >= 790);
    return b; }

DI int srccol(int n) { return n < 2816 ? n : (n < 5056 ? n + 24 : (n < 5080 ? n - 2240 : (n < 5088 ? n : -1))); }
DI void tr_item(const float* W, int ldw, bf16_t* WT, int ldwt, int k0, int n0, LAS float* scr, int lane, bool remap, int ncopy, int cstride) {
    float tv[32];
#pragma unroll
    for (int i = 0; i < 32; ++i) { const int kk = 2 * i + (lane >> 5), nl = lane & 31; const int n = n0 + nl; const int src = remap ? srccol(n) : n; tv[i] = src >= 0 ? W[(size_t)(k0 + kk) * ldw + src] : 0.f; }
#pragma unroll
    for (int i = 0; i < 32; ++i) { const int kk = 2 * i + (lane >> 5), nl = lane & 31; scr[kk * 33 + nl] = tv[i]; }
    LDS_WAIT();
    const int c = lane & 7;
#pragma unroll
    for (int j = 0; j < 4; ++j) { const int n = (lane >> 3) + 8 * j; const LAS float* s = scr + (8 * c) * 33 + n;
        u32x4 o; o.x = pk2(s[0], s[33]); o.y = pk2(s[66], s[99]); o.z = pk2(s[132], s[165]); o.w = pk2(s[198], s[231]);
        for (int cp = 0; cp < ncopy; ++cp) *(u32x4*)(WT + (size_t)(n0 + n) * ldwt + (size_t)cp * cstride + k0 + 8 * c) = o; }
    LDS_WAIT();
}
DI void cvt_rows(const float* src, bf16_t* dst, size_t ngroups8, int gw, int NGW, int lane) {
    const size_t st = (size_t)NGW * 64;
    for (size_t i0 = (size_t)gw * 64 + lane; i0 < ngroups8; i0 += 4 * st) {
        f32x4 a[4], b[4];
#pragma unroll
        for (int r = 0; r < 4; ++r) { const size_t i = i0 + r * st < ngroups8 ? i0 + r * st : i0; a[r] = ((const f32x4*)src)[2 * i]; b[r] = ((const f32x4*)src)[2 * i + 1]; }
#pragma unroll
        for (int r = 0; r < 4; ++r) { const size_t i = i0 + r * st; if (i >= ngroups8) break;
            u32x4 o; o.x = pk2(a[r].x, a[r].y); o.y = pk2(a[r].z, a[r].w); o.z = pk2(b[r].x, b[r].y); o.w = pk2(b[r].z, b[r].w); ((u32x4*)dst)[i] = o; }
    }
}
DI int pk4_fp8(float a, float b, float c, float d) { int w = 0; w = __builtin_amdgcn_cvt_pk_fp8_f32(a, b, w, false); w = __builtin_amdgcn_cvt_pk_fp8_f32(c, d, w, true); return w; }
DI void cvt_rows_fp8(const float* src, unsigned char* dst, float* scl, int nrows, int gw, int NGW, int lane) {
    for (int r0 = gw; r0 < nrows; r0 += 4 * NGW) {
        f32x4 a[4], b[4], c[4], d[4];
#pragma unroll
        for (int k = 0; k < 4; ++k) { const int r = r0 + k * NGW < nrows ? r0 + k * NGW : r0; const float* s = src + (size_t)r * 1024 + lane * 16;
            a[k] = *(const f32x4*)s; b[k] = *(const f32x4*)(s + 4); c[k] = *(const f32x4*)(s + 8); d[k] = *(const f32x4*)(s + 12); }
#pragma unroll
        for (int k = 0; k < 4; ++k) { const int r = r0 + k * NGW; if (r >= nrows) break;
            float mx = fmaxf(fmaxf(fmaxf(fabsf(a[k].x), fabsf(a[k].y)), fmaxf(fabsf(a[k].z), fabsf(a[k].w))), fmaxf(fmaxf(fabsf(b[k].x), fabsf(b[k].y)), fmaxf(fabsf(b[k].z), fabsf(b[k].w))));
            mx = fmaxf(mx, fmaxf(fmaxf(fmaxf(fabsf(c[k].x), fabsf(c[k].y)), fmaxf(fabsf(c[k].z), fabsf(c[k].w))), fmaxf(fmaxf(fabsf(d[k].x), fabsf(d[k].y)), fmaxf(fabsf(d[k].z), fabsf(d[k].w)))));
            mx = wave_max(mx);
            const float sc = mx > 0.f ? mx * (1.f / 448.f) : 1.f, inv = 1.f / sc;
            u32x4 o; o.x = (unsigned)pk4_fp8(a[k].x * inv, a[k].y * inv, a[k].z * inv, a[k].w * inv); o.y = (unsigned)pk4_fp8(b[k].x * inv, b[k].y * inv, b[k].z * inv, b[k].w * inv);
            o.z = (unsigned)pk4_fp8(c[k].x * inv, c[k].y * inv, c[k].z * inv, c[k].w * inv); o.w = (unsigned)pk4_fp8(d[k].x * inv, d[k].y * inv, d[k].z * inv, d[k].w * inv);
            *(u32x4*)(dst + (size_t)r * 1024 + lane * 16) = o;
            if (lane == 0) scl[r] = sc; }
    }
}
DI void rmsnorm_rows(const float* x, const float* g, bf16_t* H, int gw, int NGW, int lane) {
    const f32x4 g0 = *(const f32x4*)(g + lane * 8), g1 = *(const f32x4*)(g + lane * 8 + 4), g2 = *(const f32x4*)(g + 512 + lane * 8), g3 = *(const f32x4*)(g + 512 + lane * 8 + 4);
    for (int m0 = gw; m0 < T; m0 += 4 * NGW) {
        f32x4 a[4], b[4], c[4], d[4];
#pragma unroll
        for (int r = 0; r < 4; ++r) { const int m = m0 + r * NGW < T ? m0 + r * NGW : m0; const float* xr = x + (size_t)m * 1024 + lane * 8;
            a[r] = *(const f32x4*)xr; b[r] = *(const f32x4*)(xr + 4); c[r] = *(const f32x4*)(xr + 512); d[r] = *(const f32x4*)(xr + 516); }
#pragma unroll
        for (int r = 0; r < 4; ++r) { const int m = m0 + r * NGW; if (m >= T) break;
            float ss = a[r].x * a[r].x + a[r].y * a[r].y + a[r].z * a[r].z + a[r].w * a[r].w + b[r].x * b[r].x + b[r].y * b[r].y + b[r].z * b[r].z + b[r].w * b[r].w
                     + c[r].x * c[r].x + c[r].y * c[r].y + c[r].z * c[r].z + c[r].w * c[r].w + d[r].x * d[r].x + d[r].y * d[r].y + d[r].z * d[r].z + d[r].w * d[r].w;
            ss = wave_sum(ss);
            const float rr = rsqrtf(ss * (1.f / 1024.f) + 1e-6f);
            u32x4 o0, o1;
            o0.x = pk2(a[r].x * rr * g0.x, a[r].y * rr * g0.y); o0.y = pk2(a[r].z * rr * g0.z, a[r].w * rr * g0.w); o0.z = pk2(b[r].x * rr * g1.x, b[r].y * rr * g1.y); o0.w = pk2(b[r].z * rr * g1.z, b[r].w * rr * g1.w);
            o1.x = pk2(c[r].x * rr * g2.x, c[r].y * rr * g2.y); o1.y = pk2(c[r].z * rr * g2.z, c[r].w * rr * g2.w); o1.z = pk2(d[r].x * rr * g3.x, d[r].y * rr * g3.y); o1.w = pk2(d[r].z * rr * g3.z, d[r].w * rr * g3.w);
            bf16_t* hr = H + (size_t)m * 1024 + lane * 8; *(u32x4*)hr = o0; *(u32x4*)(hr + 512) = o1; }
    }
}
DI void phase_prep_w(const Params& p, int l, const Frame& F) {
    LAS float* scr = (LAS float*)(F.lds + F.wave * 8448);
    const int gw = F.vb * 8 + F.wave, NGW = F.G * 8, lane = F.lane;
    unsigned char* ws = p.ws;
    bf16_t* WCAT = (bf16_t*)(ws + WS_WCAT); bf16_t* WBR = (bf16_t*)(ws + WS_WBR); bf16_t* WOUT4 = (bf16_t*)(ws + WS_WOUT4); bf16_t* WQ = (bf16_t*)(ws + WS_WQ);
    bf16_t* WPG = (bf16_t*)(ws + WS_WPG); bf16_t* WPP = (bf16_t*)(ws + WS_WPP); bf16_t* W1C = (bf16_t*)(ws + WS_W1C);
    constexpr int I0 = 2560, I1 = 2048, I2 = 1024, I3 = 512, I4 = 512, I5 = 512, I6 = 128, I7 = 512, NIT = I0 + I1 + I2 + I3 + I4 + I5 + I6 + I7;
    for (int it = gw; it < NIT; it += NGW) {
        int r = it;
        if (r < I0) { tr_item(p.in[I_WIN] + (size_t)l * 1024 * 5088, 5088, WCAT, 1024, (r / 160) * 64, (r % 160) * 32, scr, lane, true, 1, 0); continue; } r -= I0;
        if (r < I1) { tr_item(p.in[I_WGATE] + (size_t)l * 1024 * 4096, 4096, WCAT + (size_t)5120 * 1024, 1024, (r / 128) * 64, (r % 128) * 32, scr, lane, false, 1, 0); continue; } r -= I1;
        if (r < I2) { const int m = r >> 8, rr = r & 255; tr_item(p.in[I_WBR] + ((size_t)l * 2048 + m * 512) * 1024, 1024, WBR + (size_t)m * 1024 * 512, 512, (rr / 32) * 64, (rr % 32) * 32, scr, lane, false, 1, 0); continue; } r -= I2;
        if (r < I3) { tr_item(p.in[I_WOUT] + (size_t)l * 1024 * 1024, 1024, WOUT4, 1024, (r / 32) * 64, (r % 32) * 32, scr, lane, false, 1, 0); continue; } r -= I3;
        if (r < I4) { tr_item(p.in[I_WQ] + (size_t)l * 1024 * 1024, 1024, WQ, 1024, (r / 32) * 64, (r % 32) * 32, scr, lane, false, 1, 0); continue; } r -= I4;
        if (r < I5) { tr_item(p.in[I_WPG] + (size_t)l * 1024 * 1024, 1024, WPG, 1024, (r / 32) * 64, (r % 32) * 32, scr, lane, false, 1, 0); continue; } r -= I5;
        if (r < I6) { tr_item(p.in[I_WPP] + (size_t)l * 256 * 1024, 1024, WPP, 256, (r / 32) * 64, (r % 32) * 32, scr, lane, false, 1, 0); continue; } r -= I6;
        { const int jh = r >> 7, rr = r & 127, j = jh >> 1, half = jh & 1;
          tr_item(p.in[I_CW1] + (((size_t)l * 2 + j) * 2048 + half * 1024) * 256, 256, W1C + ((size_t)j * 512 + half * 256) * 1024, 1024, (rr / 8) * 64, (rr % 8) * 32, scr, lane, false, 1, 0); }
    }
    cvt_rows_fp8(p.in[I_PU] + (size_t)l * 16384 * 1024, ws + WS_PTU, (float*)(ws + WS_PTV), 16384, gw, NGW, lane);
    cvt_rows_fp8(p.in[I_PV] + (size_t)l * 16384 * 1024, ws + WS_PTU + 16 * MiB, (float*)(ws + WS_PTV) + 16384, 16384, gw, NGW, lane);
    cvt_rows(p.in[I_SUBK] + (size_t)l * 131072, (bf16_t*)(ws + WS_SK), 131072 / 8, gw, NGW, lane);
    cvt_rows(p.in[I_P] + (size_t)l * T * 256, (bf16_t*)(ws + WS_PB), (size_t)T * 256 / 8, gw, NGW, lane);
    { const float* sw = p.in[I_SGUW] + (size_t)l * 131072; bf16_t* dst = (bf16_t*)(ws + WS_SGUW);
      for (int i = gw * 64 + lane; i < 131072 / 8; i += NGW * 64) { const int e = i * 8, t = (e >> 7) & 127, s0 = e & 127; float v[8];
#pragma unroll
          for (int k = 0; k < 8; ++k) v[k] = (s0 + k <= t) ? sw[e + k] : 0.f;
          u32x4 o; o.x = pk2(v[0], v[1]); o.y = pk2(v[2], v[3]); o.z = pk2(v[4], v[5]); o.w = pk2(v[6], v[7]); ((u32x4*)dst)[i] = o; } }
    { float* peb = (float*)(ws + WS_PEB);
      for (int o = gw; o < 512; o += NGW) { const int j = o >> 8, n = o & 255; const float* pe = p.in[I_PE] + ((size_t)l * 2 + j) * 2048; const float* w1 = p.in[I_CW1] + ((size_t)l * 2 + j) * 2048 * 256;
          float s = 0.f; for (int k = lane; k < 2048; k += 64) s += pe[k] * w1[(size_t)k * 256 + n];
          s = wave_sum(s); if (lane == 0) peb[o] = s; } }
    rmsnorm_rows(l == 0 ? p.in[I_X] : p.out, p.in[I_GMIX] + l * 1024, (bf16_t*)(ws + WS_H), gw, NGW, lane);
}

struct Epi1 {
    static constexpr bool PERM = true, AFTER_DRAIN = false;
    bf16_t* proj; bf16_t* gates;
    DI void operator()(const f32x4 (&acc)[2][2][4][2], const pg8::Unit& u, int wr, int wc, int fr, int fq) const {
        const int row0 = u.pm * 256 + wr * 64 + fr; const bool isg = u.pn >= 20;
        const int col0 = (isg ? (u.pn - 20) * 256 : u.pn * 256) + wc * 32 + 8 * fq; bf16_t* base = isg ? gates : proj; const int ldc = isg ? 4096 : PW;
#pragma unroll
        for (int ai = 0; ai < 2; ++ai)
#pragma unroll
            for (int m = 0; m < 4; ++m) { bf16_t* rowp = base + (size_t)(row0 + ai * 128 + m * 16) * ldc + col0;
#pragma unroll
                for (int bj = 0; bj < 2; ++bj) { f32x4 v0 = acc[ai][bj][m][0], v1 = acc[ai][bj][m][1];
                    if (isg) { v0.x = sigm(v0.x); v0.y = sigm(v0.y); v0.z = sigm(v0.z); v0.w = sigm(v0.w); v1.x = sigm(v1.x); v1.y = sigm(v1.y); v1.z = sigm(v1.z); v1.w = sigm(v1.w); }
                    u32x4 w; w.x = pk2(v0.x, v0.y); w.y = pk2(v0.z, v0.w); w.z = pk2(v1.x, v1.y); w.w = pk2(v1.z, v1.w);
                    __builtin_nontemporal_store(w, (u32x4*)(rowp + bj * 128)); } }
    }
};
struct EpiBf {
    static constexpr bool PERM = true, AFTER_DRAIN = false;
    bf16_t* O; int ldc;
    DI void operator()(const f32x4 (&acc)[2][2][4][2], const pg8::Unit& u, int wr, int wc, int fr, int fq) const {
        const int row0 = u.pm * 256 + wr * 64 + fr, col0 = u.pn * 256 + wc * 32 + 8 * fq;
#pragma unroll
        for (int ai = 0; ai < 2; ++ai)
#pragma unroll
            for (int m = 0; m < 4; ++m) { bf16_t* rowp = O + (size_t)(row0 + ai * 128 + m * 16) * ldc + col0;
#pragma unroll
                for (int bj = 0; bj < 2; ++bj) { const f32x4 v0 = acc[ai][bj][m][0], v1 = acc[ai][bj][m][1];
                    u32x4 w; w.x = pk2(v0.x, v0.y); w.y = pk2(v0.z, v0.w); w.z = pk2(v1.x, v1.y); w.w = pk2(v1.z, v1.w);
                    *(u32x4*)(rowp + bj * 128) = w; } }
    }
};
struct EpiF32P {
    static constexpr bool PERM = true, AFTER_DRAIN = false;
    float* C; int ldc;
    DI void operator()(const f32x4 (&acc)[2][2][4][2], const pg8::Unit& u, int wr, int wc, int fr, int fq) const {
        const int row0 = u.pm * 256 + wr * 64 + fr, col0 = u.pn * 256 + wc * 32 + 8 * fq;
#pragma unroll
        for (int ai = 0; ai < 2; ++ai)
#pragma unroll
            for (int m = 0; m < 4; ++m) { float* rowp = C + (size_t)(row0 + ai * 128 + m * 16) * ldc + col0;
#pragma unroll
                for (int bj = 0; bj < 2; ++bj) { *(f32x4*)(rowp + bj * 128) = acc[ai][bj][m][0]; *(f32x4*)(rowp + bj * 128 + 4) = acc[ai][bj][m][1]; } }
    }
};
struct XcdColOrder {
    int G, c;
    DI bool next(int i, pg8::Unit& u) const {
        if (G != 256) { const int Lx = i * G + c; if (Lx >= 128 * 36) return false; u.pm = Lx / 36; u.pn = Lx % 36; return true; }
        if (i >= 18) return false;
        const int x = c & 7, w = c >> 3;
        if (i < 16) { u.pm = 8 * i + (w & 7); u.pn = 4 * x + (w >> 3); }
        else { u.pm = 16 * x + 8 * (i - 16) + (w & 7); u.pn = 32 + (w >> 3); }
        return true; }
    DI void a_ready(const pg8::Unit&) const {}
    DI void done(const pg8::Unit&) const {}
};
struct RoundOrder {
    pg8::StaticOrder base; int r;
    DI bool next(int i, pg8::Unit& u) const { return i == 0 && base.next(r, u); }
    DI void a_ready(const pg8::Unit&) const {}
    DI void done(const pg8::Unit&) const {}
};
struct ColRangeOrder {
    int G, c, c0, c1;
    DI bool next(int i, pg8::Unit& u) const { const int nc = c1 - c0; const int Lx = i * G + c; if (Lx >= 128 * nc) return false; u.pm = Lx / nc; u.pn = c0 + Lx % nc; return true; }
    DI void a_ready(const pg8::Unit&) const {}
    DI void done(const pg8::Unit&) const {}
};
struct BranchOrder {
    int G, c;
    DI bool next(int i, pg8::Unit& u) const { const int tile = c + G * (i >> 2), m = i & 3; if (tile >= 512) return false; u.pm = m * 128 + (tile >> 2); u.pn = m * 4 + (tile & 3); return true; }
    DI void a_ready(const pg8::Unit&) const {}
    DI void done(const pg8::Unit&) const {}
};
struct EpiBranch {
    static constexpr bool PERM = true, AFTER_DRAIN = false;
    const bf16_t* gates; bf16_t* merged;
    DI void operator()(const f32x4 (&acc)[2][2][4][2], const pg8::Unit& u, int wr, int wc, int fr, int fq) const {
        const int m4 = u.pn >> 2; const int row0 = (u.pm & 127) * 256 + wr * 64 + fr, gcol0 = u.pn * 256 + wc * 32 + 8 * fq, dcol0 = (u.pn & 3) * 256 + wc * 32 + 8 * fq;
#pragma unroll
        for (int ai = 0; ai < 2; ++ai) {
            u32x4 g[4][2], pr[4][2];
#pragma unroll
            for (int m = 0; m < 4; ++m)
#pragma unroll
                for (int bj = 0; bj < 2; ++bj) { g[m][bj] = *(const u32x4*)(gates + (size_t)(row0 + ai * 128 + m * 16) * 4096 + gcol0 + bj * 128);
                    if (m4 > 0) pr[m][bj] = *(const u32x4*)(merged + (size_t)(row0 + ai * 128 + m * 16) * 1024 + dcol0 + bj * 128); }
#pragma unroll
            for (int m = 0; m < 4; ++m)
#pragma unroll
                for (int bj = 0; bj < 2; ++bj) { const f32x4 v0 = acc[ai][bj][m][0], v1 = acc[ai][bj][m][1]; const u32x4 gg = g[m][bj];
                    f32x4 r0 = {v0.x * lo16(gg.x), v0.y * hi16(gg.x), v0.z * lo16(gg.y), v0.w * hi16(gg.y)}, r1 = {v1.x * lo16(gg.z), v1.y * hi16(gg.z), v1.z * lo16(gg.w), v1.w * hi16(gg.w)};
                    if (m4 > 0) { const u32x4 pp_ = pr[m][bj];
                        r0.x += lo16(pp_.x); r0.y += hi16(pp_.x); r0.z += lo16(pp_.y); r0.w += hi16(pp_.y); r1.x += lo16(pp_.z); r1.y += hi16(pp_.z); r1.z += lo16(pp_.w); r1.w += hi16(pp_.w); }
                    u32x4 w; w.x = pk2(r0.x, r0.y); w.y = pk2(r0.z, r0.w); w.z = pk2(r1.x, r1.y); w.w = pk2(r1.z, r1.w);
                    *(u32x4*)(merged + (size_t)(row0 + ai * 128 + m * 16) * 1024 + dcol0 + bj * 128) = w; }
        }
    }
};
struct EpiRes {
    static constexpr bool PERM = true, AFTER_DRAIN = false;
    const float* xin; float* out;
    DI void operator()(const f32x4 (&acc)[2][2][4][2], const pg8::Unit& u, int wr, int wc, int fr, int fq) const {
        const int row0 = u.pm * 256 + wr * 64 + fr, col0 = u.pn * 256 + wc * 32 + 8 * fq;
#pragma unroll
        for (int ai = 0; ai < 2; ++ai)
#pragma unroll
            for (int mh = 0; mh < 2; ++mh) {
                f32x4 xa[2][2][2];
#pragma unroll
                for (int m2 = 0; m2 < 2; ++m2)
#pragma unroll
                    for (int bj = 0; bj < 2; ++bj) { const size_t off = (size_t)(row0 + ai * 128 + (mh * 2 + m2) * 16) * 1024 + col0 + bj * 128; xa[m2][bj][0] = *(const f32x4*)(xin + off); xa[m2][bj][1] = *(const f32x4*)(xin + off + 4); }
#pragma unroll
                for (int m2 = 0; m2 < 2; ++m2)
#pragma unroll
                    for (int bj = 0; bj < 2; ++bj) { const size_t off = (size_t)(row0 + ai * 128 + (mh * 2 + m2) * 16) * 1024 + col0 + bj * 128;
                        *(f32x4*)(out + off) = xa[m2][bj][0] + acc[ai][bj][mh * 2 + m2][0]; *(f32x4*)(out + off + 4) = xa[m2][bj][1] + acc[ai][bj][mh * 2 + m2][1]; }
            }
    }
};
struct EpiPle {
    static constexpr bool PERM = true, AFTER_DRAIN = false;
    float* x; const bf16_t* pp;
    DI void operator()(const f32x4 (&acc)[2][2][4][2], const pg8::Unit& u, int wr, int wc, int fr, int fq) const {
        const int row0 = u.pm * 256 + wr * 64 + fr, col0 = u.pn * 256 + wc * 32 + 8 * fq;
#pragma unroll
        for (int ai = 0; ai < 2; ++ai)
#pragma unroll
            for (int mh = 0; mh < 2; ++mh) {
                f32x4 xa[2][2][2]; u32x4 ga[2][2];
#pragma unroll
                for (int m2 = 0; m2 < 2; ++m2)
#pragma unroll
                    for (int bj = 0; bj < 2; ++bj) { const size_t off = (size_t)(row0 + ai * 128 + (mh * 2 + m2) * 16) * 1024 + col0 + bj * 128;
                        xa[m2][bj][0] = *(const f32x4*)(x + off); xa[m2][bj][1] = *(const f32x4*)(x + off + 4); ga[m2][bj] = *(const u32x4*)(pp + off); }
#pragma unroll
                for (int m2 = 0; m2 < 2; ++m2)
#pragma unroll
                    for (int bj = 0; bj < 2; ++bj) { const size_t off = (size_t)(row0 + ai * 128 + (mh * 2 + m2) * 16) * 1024 + col0 + bj * 128;
                        const f32x4 v0 = acc[ai][bj][mh * 2 + m2][0], v1 = acc[ai][bj][mh * 2 + m2][1]; const u32x4 g = ga[m2][bj]; f32x4 x0 = xa[m2][bj][0], x1 = xa[m2][bj][1];
                        x0.x += sigm(v0.x) * lo16(g.x); x0.y += sigm(v0.y) * hi16(g.x); x0.z += sigm(v0.z) * lo16(g.y); x0.w += sigm(v0.w) * hi16(g.y);
                        x1.x += sigm(v1.x) * lo16(g.z); x1.y += sigm(v1.y) * hi16(g.z); x1.z += sigm(v1.z) * lo16(g.w); x1.w += sigm(v1.w) * hi16(g.w);
                        *(f32x4*)(x + off) = x0; *(f32x4*)(x + off + 4) = x1; }
            }
    }
};


DI void unpack8(const u32x4 w, float (&f)[8]) { f[0] = lo16(w.x); f[1] = hi16(w.x); f[2] = lo16(w.y); f[3] = hi16(w.y); f[4] = lo16(w.z); f[5] = hi16(w.z); f[6] = lo16(w.w); f[7] = hi16(w.w); }
DI u32x4 pack8(const float (&f)[8]) { u32x4 o; o.x = pk2(f[0], f[1]); o.y = pk2(f[2], f[3]); o.z = pk2(f[4], f[5]); o.w = pk2(f[6], f[7]); return o; }
DI void load8f(const float* p, float (&f)[8]) { const f32x4 a = *(const f32x4*)p, b = *(const f32x4*)(p + 4); f[0] = a.x; f[1] = a.y; f[2] = a.z; f[3] = a.w; f[4] = b.x; f[5] = b.y; f[6] = b.z; f[7] = b.w; }

DI void phase_chunk(const Params& p, int l, const Frame& F) {
    unsigned char* ws = p.ws; const int lane = F.lane, wave = F.wave;
    bf16_t* PROJ = (bf16_t*)(ws + WS_PROJ); bf16_t* YA = (bf16_t*)(ws + WS_Y); bf16_t* YC = YA + (size_t)2 * T * 512; bf16_t* CMPA = (bf16_t*)(ws + WS_CMPA);
    const bf16_t* SGUW = (const bf16_t*)(ws + WS_SGUW);
    LAS unsigned char* vnT = F.lds;
    const float* convw = p.in[I_CONVW] + (size_t)l * 3 * 512; const float* lng = p.in[I_LNG] + (size_t)l * 512; const float* sgub = p.in[I_SGUB] + (size_t)l * 8 * 128;
    float cw0[8], cw1[8], cw2[8], lgn[8];
    load8f(convw + lane * 8, cw0); load8f(convw + 512 + lane * 8, cw1); load8f(convw + 1024 + lane * 8, cw2); load8f(lng + lane * 8, lgn);
    for (int chunk = F.vb; chunk < T / 128; chunk += F.G) {
        const int t0 = chunk * 128;
        for (int tt = wave; tt < 128; tt += 8) {
            const int t = t0 + tt, s = t & (SEQ - 1), b = t >> 12;
            bf16_t* row = PROJ + (size_t)t * PW;
            const int c0 = lane * 8;
            const u32x4 z = {0u, 0u, 0u, 0u};
            const u32x4 rab = *(const u32x4*)(row + C_AB + c0), rc0 = *(const u32x4*)(row + C_AC + c0), rx0 = *(const u32x4*)(row + C_AX + c0);
            u32x4 r1c = z, r1x = z, r2c = z, r2x = z;
            if (s >= 1) { r1c = *(const u32x4*)(row - PW + C_AC + c0); r1x = *(const u32x4*)(row - PW + C_AX + c0); }
            if (s >= 2) { r2c = *(const u32x4*)(row - 2 * PW + C_AC + c0); r2x = *(const u32x4*)(row - 2 * PW + C_AX + c0); }
            u32x4 segv[3]; int segcol[3]; const float* seggp[3]; float segsc[3];
#pragma unroll
            for (int pass = 0; pass < 3; ++pass) {
                const int seg = pass * 8 + (lane >> 3), sg = seg < 20 ? seg : 20; int col; const float* gp; float sc = 1.f;
                if (sg < 8) { col = C_NQ + 64 * sg; gp = p.in[I_NQG] + l * 64; sc = 0.125f * 1.44269504f; }
                else if (sg < 10) { col = C_NKV + 2 * 128 + (sg - 8) * 64; gp = p.in[I_NKG] + (l * 3 + 1) * 64; }
                else if (sg < 12) { col = C_NKV + 4 * 128 + (sg - 10) * 64; gp = p.in[I_NKG] + (l * 3 + 2) * 64; }
                else if (sg < 20) { col = C_DQ + 64 * (sg - 12); gp = p.in[I_DQG] + l * 64; sc = 0.125f * 1.44269504f; }
                else { col = C_DK; gp = p.in[I_DKG] + l * 64; }
                segcol[pass] = col; seggp[pass] = gp; segsc[pass] = sc; segv[pass] = *(const u32x4*)(row + col + (lane & 7) * 8);
            }
            u32x4 rawc = z; const bf16_t* rawsrc = row; bf16_t* rawdst = nullptr;
            if (lane < 48) { const int sgc = lane >> 3;
                if (sgc < 2) { rawsrc = row + C_NKV + 3 * 128 + sgc * 64; rawdst = (bf16_t*)(ws + WS_VS) + ((size_t)((b * 2 + sgc) * SEQ + s)) * 64; }
                else if (sgc < 4) { rawsrc = row + C_NKV + 5 * 128 + (sgc - 2) * 64; rawdst = (bf16_t*)(ws + WS_VW) + ((size_t)((b * 2 + (sgc - 2)) * SEQ + s)) * 64; }
                else if (sgc == 4) { rawsrc = row + C_DV; rawdst = (bf16_t*)(ws + WS_DV) + (size_t)t * 64; }
                else { rawsrc = row + C_DKI; rawdst = (bf16_t*)(ws + WS_DKI) + (size_t)t * 64; }
                rawc = *(const u32x4*)(rawsrc + (lane & 7) * 8); }
            u32x4 cmpc = z;
            if (lane < 32) { const int jg = lane >> 3; cmpc = *(const u32x4*)(row + C_NKV + (jg >> 1) * 128 + (jg & 1) * 64 + (lane & 7) * 8); }
            const u32x4 ruv = *(const u32x4*)(row + C_UV + 512 + lane * 8);
            {
                float ab[8], c0v[8], x0v[8], c1v[8], x1v[8], c2v[8], x2v[8], y[8];
                unpack8(rab, ab); unpack8(rc0, c0v); unpack8(rx0, x0v); unpack8(r1c, c1v); unpack8(r1x, x1v); unpack8(r2c, c2v); unpack8(r2x, x2v);
#pragma unroll
                for (int e = 0; e < 8; ++e) y[e] = ab[e] * (cw2[e] * c0v[e] * x0v[e] + cw1[e] * c1v[e] * x1v[e] + cw0[e] * c2v[e] * x2v[e]);
                *(u32x4*)(YA + (size_t)t * 512 + c0) = pack8(y);
            }
#pragma unroll
            for (int pass = 0; pass < 3; ++pass) {
                const int seg = pass * 8 + (lane >> 3), part = lane & 7, sg = seg < 20 ? seg : 20;
                float v[8], g[8]; unpack8(segv[pass], v); load8f(seggp[pass] + part * 8, g);
                float ss = 0.f;
#pragma unroll
                for (int e = 0; e < 8; ++e) ss += v[e] * v[e];
                ss = oct_sumf(ss);
                const float r = rsqrtf(ss * (1.f / 64.f) + 1e-6f) * segsc[pass];
#pragma unroll
                for (int e = 0; e < 8; ++e) v[e] = v[e] * r * g[e];
                bf16_t* dstp = row + segcol[pass] + part * 8;
                if (sg >= 8 && sg < 10) dstp = (bf16_t*)(ws + WS_KS) + ((size_t)((b * 2 + (sg - 8)) * SEQ + s)) * 64 + part * 8;
                else if (sg >= 10 && sg < 12) dstp = (bf16_t*)(ws + WS_KW) + ((size_t)((b * 2 + (sg - 10)) * SEQ + s)) * 64 + part * 8;
                else if (sg == 20) dstp = (bf16_t*)(ws + WS_DK) + (size_t)t * 64 + part * 8;
                if (seg < 21) *(u32x4*)dstp = pack8(v);
            }
            if (lane < 48) *(u32x4*)(rawdst + (lane & 7) * 8) = rawc;
            if (lane < 32) { const int jg = lane >> 3, j = jg >> 1, g = jg & 1, part = lane & 7;
                *(u32x4*)(CMPA + ((size_t)j * 4096 + ((size_t)(b * 256 + (s >> 4)) * 2 + g)) * 1024 + (s & 15) * 64 + part * 8) = cmpc; }
            {
                float v[8]; unpack8(ruv, v);
                float sm = 0.f;
#pragma unroll
                for (int e = 0; e < 8; ++e) { v[e] = gelu_t(v[e]); sm += v[e]; }
                const float mean = wave_sum(sm) * (1.f / 512.f); float sq = 0.f;
#pragma unroll
                for (int e = 0; e < 8; ++e) { v[e] -= mean; sq += v[e] * v[e]; }
                const float r = rsqrtf(wave_sum(sq) * (1.f / 512.f) + 1e-6f);
#pragma unroll
                for (int e = 0; e < 8; ++e) *(LAS unsigned short*)(vnT + (lane * 8 + e) * 272 + tt * 2) = (unsigned short)f2bf(v[e] * r * lgn[e]);
            }
        }
        __syncthreads();
        {
            const int g = wave, c = lane & 15, q = lane >> 4; const bf16_t* Wg = SGUW + (size_t)g * 128 * 128;
            for (int tt16 = 0; tt16 < 8; ++tt16) {
                const int nk = (tt16 >> 1) + 1;
                bf16x8 bw[4];
#pragma unroll
                for (int kk = 0; kk < 4; ++kk) bw[kk] = *(const bf16x8*)(Wg + (size_t)(16 * tt16 + c) * 128 + 32 * (kk < nk ? kk : 0) + 8 * q);
                const int t = t0 + 16 * tt16 + c; const float bias = sgub[g * 128 + 16 * tt16 + c];
#pragma unroll
                for (int dt = 0; dt < 4; ++dt) {
                    f32x4 acc = {0.f, 0.f, 0.f, 0.f};
#pragma unroll
                    for (int kk = 0; kk < 4; ++kk) if (kk < nk) { const bf16x8 a = *(const LAS bf16x8*)(vnT + (g * 64 + 16 * dt + c) * 272 + (32 * kk + 8 * q) * 2); acc = MFMA16(a, bw[kk], acc); }
                    const int ch = g * 64 + 16 * dt + 4 * q;
                    const u32x2 uu = *(const u32x2*)(PROJ + (size_t)t * PW + C_UV + ch);
                    u32x2 o; o.x = pk2(gelu_t(lo16(uu.x)) * (acc[0] + bias), gelu_t(hi16(uu.x)) * (acc[1] + bias)); o.y = pk2(gelu_t(lo16(uu.y)) * (acc[2] + bias), gelu_t(hi16(uu.y)) * (acc[3] + bias));
                    *(u32x2*)(YC + (size_t)t * 512 + ch) = o;
                }
            }
        }
        __syncthreads();
    }
}

DI void phase_cmp2(const Params& p, int l, const Frame& F) {
    unsigned char* ws = p.ws; const int lane = F.lane; const int gw = F.vb * 8 + F.wave, NGW = F.G * 8;
    LAS float* hid = (LAS float*)(F.lds + 131072 + F.wave * 1024);
    LAS float* w2s = (LAS float*)F.lds;
    { const float* w2g = p.in[I_CW2] + (size_t)l * 2 * 256 * 64;
      for (int i = F.tid; i < 2 * 256 * 64 / 4; i += 512) *(LAS f32x4*)(w2s + i * 4) = *(const f32x4*)(w2g + i * 4); }
    __syncthreads();
    const float* CMPP = (const float*)(ws + WS_CMPP); const float* peb = (const float*)(ws + WS_PEB);
    bf16_t* CMPK = (bf16_t*)(ws + WS_CMPK); bf16_t* CMPV = (bf16_t*)(ws + WS_CMPV);
    const float* kg = p.in[I_NKG] + (l * 3 + 0) * 64;
    for (int it = gw; it < 8 * 256 * 2 * 2; it += NGW) {
        const int j = it & 1, g = (it >> 1) & 1, n = (it >> 2) & 255, b = it >> 10;
        bf16_t* dst = (j ? CMPV : CMPK) + ((size_t)(b * 2 + g) * 256 + n) * 64;
        if (n == 255) { dst[lane] = 0; continue; }
        const float* Pa = CMPP + ((size_t)j * 4096 + (size_t)(b * 256 + n) * 2 + g) * 512; const float* Pb = CMPP + ((size_t)j * 4096 + (size_t)(b * 256 + n + 1) * 2 + g) * 512 + 256;
        const f32x4 a = *(const f32x4*)(Pa + lane * 4), bq = *(const f32x4*)(Pb + lane * 4), pe = *(const f32x4*)(peb + j * 256 + lane * 4);
        f32x4 h; h.x = gelu_t(a.x + bq.x + pe.x); h.y = gelu_t(a.y + bq.y + pe.y); h.z = gelu_t(a.z + bq.z + pe.z); h.w = gelu_t(a.w + bq.w + pe.w);
        *(LAS f32x4*)(hid + lane * 4) = h;
        LDS_WAIT();
        const LAS float* w2 = w2s + j * 256 * 64;
        float o = 0.f;
#pragma unroll 16
        for (int k = 0; k < 256; ++k) o += hid[k] * w2[k * 64 + lane];
        if (j == 0) { const float ss = wave_sum(o * o); o = o * rsqrtf(ss * (1.f / 64.f) + 1e-6f) * kg[lane]; }
        dst[lane] = (bf16_t)f2bf(o);
        LDS_WAIT();
    }
}

DI int bucket_fast(int n) { const int big = 16 + (int)((__log2f((float)n) - 4.f) * 2.6666667f + 2e-4f); return n < 16 ? n : (big < 31 ? big : 31); }
struct KsCmp { static constexpr bool CONTIG = true; static constexpr int DSTEP = 16, DMAX = 1 << 30; const bf16_t* kb; const bf16_t* vb; int t0, hb;
    DI void base(int k0, const bf16_t*& k, const bf16_t*& v) const { k = kb + (size_t)k0 * 64; v = vb + (size_t)k0 * 64; }
    DI int dist0(int k0, int c) const { return t0 + (c >> 2) - (16 * k0 + 31); } };
struct KsSel { static constexpr bool CONTIG = true; static constexpr int DSTEP = 1, DMAX = 1 << 30; const bf16_t* kb; const bf16_t* vb; const LAS int* selb; int t, hb;
    DI int p0(int k0) const { return __builtin_amdgcn_readfirstlane(selb[k0 >> 6]) * 64 + (k0 & 63); }
    DI void base(int k0, const bf16_t*& k, const bf16_t*& v) const { const int ps = p0(k0); k = kb + (size_t)ps * 64; v = vb + (size_t)ps * 64; }
    DI int dist0(int k0, int c) const { return t - p0(k0); } };
struct KsWin { static constexpr bool CONTIG = true; static constexpr int DSTEP = 1, DMAX = 512; const bf16_t* kb; const bf16_t* vb; int pstart, t0, hb;
    DI void base(int k0, const bf16_t*& k, const bf16_t*& v) const { k = kb + (size_t)(pstart + k0) * 64; v = vb + (size_t)(pstart + k0) * 64; }
    DI int dist0(int k0, int c) const { return t0 + (c >> 2) - (pstart + k0); } };
struct KsDsa { static constexpr bool CONTIG = false; static constexpr int DSTEP = 1, DMAX = 1 << 30; const bf16_t* kb; const bf16_t* vb; const LAS int* list; int n, t;
    DI int pos(int idx) const { return idx < n ? list[idx] : -1; }
    DI const bf16_t* krow(int idx) const { const int ps = pos(idx); return kb + (size_t)(ps < 0 ? 0 : ps) * 64; }
    DI const bf16_t* vrow(int idx) const { const int ps = pos(idx); return vb + (size_t)(ps < 0 ? 0 : ps) * 64; }
    DI float adjust(int idx, int c, float s, bool& ok, const LAS unsigned char* buck, const LAS float* tbl) const {
        const int ps = pos(idx); ok = ps >= 0 && ps <= t; const int dd = t - ps; const int dc = ok ? (dd < 1023 ? dd : 1023) : 0; return s + tbl[buck[dc] * 16 + 8 + (c & 7)]; } };

template <int MODE, class KS>
DI void flash_run(const KS& ks, int nkeys, const bf16x8 (&qb)[2], f32x4 (&o)[4], float& m_run, float& l_run, LAS unsigned char* vt, LAS float* al, LAS float* pn,
                  const LAS unsigned char* buck, const LAS float* tbl, int lane) {
    const int c = lane & 15, q = lane >> 4;
    bf16x8 A00, A01, A10, A11, B00, B01, B10, B11; u32x4 Av[4], Bv[4];
#define FL_LOAD(B_, kk0) do { if constexpr (KS::CONTIG) { const bf16_t* kbp_; const bf16_t* vbp_; ks.base((kk0), kbp_, vbp_); const bf16_t* kr0 = kbp_ + c * 64 + 8 * q; \
            B_##00 = *(const bf16x8*)kr0; B_##01 = *(const bf16x8*)(kr0 + 32); B_##10 = *(const bf16x8*)(kr0 + 1024); B_##11 = *(const bf16x8*)(kr0 + 1056); \
            if (MODE != 1) { const bf16_t* vr0 = vbp_ + (lane >> 3) * 64 + (lane & 7) * 8; _Pragma("unroll") for (int m = 0; m < 4; ++m) B_##v[m] = *(const u32x4*)(vr0 + m * 512); } } \
        else { const bf16_t* kr0 = ks.krow((kk0) + c); const bf16_t* kr1 = ks.krow((kk0) + 16 + c); \
            B_##00 = *(const bf16x8*)(kr0 + 8 * q); B_##01 = *(const bf16x8*)(kr0 + 32 + 8 * q); B_##10 = *(const bf16x8*)(kr1 + 8 * q); B_##11 = *(const bf16x8*)(kr1 + 32 + 8 * q); \
            if (MODE != 1) { _Pragma("unroll") for (int m = 0; m < 4; ++m) B_##v[m] = *(const u32x4*)(ks.vrow((kk0) + (lane >> 3) + 8 * m) + (lane & 7) * 8); } } } while (0)
#define FL_STEP(B_, K0_) do { \
        f32x4 s0 = {0.f, 0.f, 0.f, 0.f}, s1 = {0.f, 0.f, 0.f, 0.f}; \
        s0 = MFMA16(B_##00, qb[0], s0); s0 = MFMA16(B_##01, qb[1], s0); s1 = MFMA16(B_##10, qb[0], s1); s1 = MFMA16(B_##11, qb[1], s1); \
        float sv[8], pv[8]; bool ok[8]; \
        if constexpr (KS::CONTIG) { \
            const LAS float* trow = tbl + (c & 3) * 1024; const int d0 = ks.dist0((K0_), c) - KS::DSTEP * 4 * q; \
        _Pragma("unroll") \
            for (int i = 0; i < 4; ++i) { const int da = d0 - KS::DSTEP * i, db = da - KS::DSTEP * 16; \
                ok[i] = da >= 0 && da < KS::DMAX; ok[4 + i] = db >= 0 && db < KS::DMAX; \
                sv[i] = s0[i] + trow[da < 0 ? 0 : (da < 1023 ? da : 1023)]; sv[4 + i] = s1[i] + trow[db < 0 ? 0 : (db < 1023 ? db : 1023)]; } \
        } else { \
        _Pragma("unroll") \
            for (int i = 0; i < 4; ++i) { sv[i] = ks.adjust((K0_) + 4 * q + i, c, s0[i], ok[i], buck, tbl); sv[4 + i] = ks.adjust((K0_) + 16 + 4 * q + i, c, s1[i], ok[4 + i], buck, tbl); } \
        } \
        if (MODE == 2) { \
        _Pragma("unroll") \
            for (int e = 0; e < 8; ++e) { pv[e] = ok[e] ? __builtin_amdgcn_exp2f(sv[e]) * l_run : 0.f; \
                const float x = quad_sumf(pv[e]); \
                if ((c & 3) == 0) pn[(c >> 2) * 256 + (K0_) + (e < 4 ? 4 * q + e : 16 + 4 * q + (e - 4))] = x; } \
        } else { \
            float ps = 0.f; \
        _Pragma("unroll") \
            for (int e = 0; e < 8; ++e) { pv[e] = ok[e] ? __builtin_amdgcn_exp2f(sv[e]) : 0.f; ps += pv[e]; } \
            l_run += ps; \
        } \
        if (MODE != 1) { \
        _Pragma("unroll") \
            for (int m = 0; m < 4; ++m) *(LAS u32x4*)(vt + ((lane >> 3) + 8 * m) * 144 + (lane & 7) * 16) = B_##v[m]; \
            LDS_FENCE(); \
            const bf16x8 pa = __builtin_bit_cast(bf16x8, pack8(pv)); \
        _Pragma("unroll") \
            for (int dt = 0; dt < 4; ++dt) { \
                const s16x4 lo = __builtin_amdgcn_ds_read_tr16_b64_v4i16((LAS s16x4*)(vt + (4 * q + (c >> 2)) * 144 + (16 * dt + 4 * (c & 3)) * 2)); \
                const s16x4 hi = __builtin_amdgcn_ds_read_tr16_b64_v4i16((LAS s16x4*)(vt + (16 + 4 * q + (c >> 2)) * 144 + (16 * dt + 4 * (c & 3)) * 2)); \
                const bf16x8 vb8 = __builtin_shufflevector(lo, hi, 0, 1, 2, 3, 4, 5, 6, 7); \
                o[dt] = MFMA16(pa, vb8, o[dt]); \
            } \
            LDS_FENCE(); \
        } \
    } while (0)
    if (nkeys > 0) FL_LOAD(A, 0);
    for (int k0 = 0; k0 < nkeys; k0 += 64) {
        if (k0 + 32 < nkeys) FL_LOAD(B, k0 + 32);
        FL_STEP(A, k0);
        if (k0 + 32 >= nkeys) break;
        if (k0 + 64 < nkeys) FL_LOAD(A, k0 + 64);
        FL_STEP(B, k0 + 32);
    }
#undef FL_STEP
#undef FL_LOAD
    if (MODE == 0) {
        float lt = x32_sum(x16_sum(l_run));
        const float inv = lt > 0.f ? __builtin_amdgcn_rcpf(lt) : 0.f;
        if (q == 0) al[c] = inv;
        LDS_WAIT();
        const f32x4 a4 = *(const LAS f32x4*)(al + 4 * q);
#pragma unroll
        for (int dt = 0; dt < 4; ++dt) o[dt] = o[dt] * a4;
        LDS_WAIT();
    }
}

DI void nsa_tile(const Params& p, int b, int g, int tb, const Frame& F, const LAS float* lut, int vm = 0) {
    unsigned char* ws = p.ws; const int lane = F.lane, wave = F.wave, c = lane & 15, q = lane >> 4;
    const LAS float* tbl = lut + g * 4096;
    LAS unsigned char* wl = F.lds + wave * 9216; LAS unsigned char* vt = wl; LAS float* al = (LAS float*)(wl + 4608); LAS float* pn = (LAS float*)(wl + 4736);
    LAS float* OS = (LAS float*)F.lds; LAS float* LS = (LAS float*)(F.lds + 65536);
    LAS int* SELB = (LAS int*)(F.lds + 73728); LAS int* CNT = (LAS int*)(F.lds + 75776); LAS unsigned short* UNIT = (LAS unsigned short*)(F.lds + 76032); LAS int* NUNIT = (LAS int*)(F.lds + 76416);
    volatile LAS int* TURN = (volatile LAS int*)(F.lds + 76544); LAS unsigned short* LIST = (LAS unsigned short*)(F.lds + 76800);
    LAS unsigned char* vt2 = F.lds + 84992 + wave * 4608;
    const bf16_t* prow0 = (const bf16_t*)(ws + WS_PROJ) + (size_t)(b * SEQ) * PW;
    bf16_t* YB = (bf16_t*)(ws + WS_Y) + (size_t)T * 512;
    const f32x4 z4 = {0.f, 0.f, 0.f, 0.f};
    for (int ii = 0; ii < 2; ++ii) {
        f32x4 accw[4];
        const int item = wave * 2 + ii, t0 = 64 * tb + 4 * item;
#pragma unroll
        for (int k = 0; k < 4; ++k) *(LAS f32x4*)(pn + lane * 4 + 256 * k) = z4;
        bf16x8 qb[2];
        { const bf16_t* qp = prow0 + (size_t)(t0 + (c >> 2)) * PW + C_NQ + (g * 4 + (c & 3)) * 64 + 8 * q; qb[0] = *(const bf16x8*)qp; qb[1] = *(const bf16x8*)(qp + 32); }
        float g0[4], g2[4];
        { const u32x2 ga = *(const u32x2*)(prow0 + (size_t)(t0 + q) * PW + C_NG + 0 * 8 + g * 4), gc = *(const u32x2*)(prow0 + (size_t)(t0 + q) * PW + C_NG + 2 * 8 + g * 4);
          g0[0] = sigm(lo16(ga.x)); g0[1] = sigm(hi16(ga.x)); g0[2] = sigm(lo16(ga.y)); g0[3] = sigm(hi16(ga.y));
          g2[0] = sigm(lo16(gc.x)); g2[1] = sigm(hi16(gc.x)); g2[2] = sigm(lo16(gc.y)); g2[3] = sigm(hi16(gc.y)); }
#pragma unroll
        for (int dt = 0; dt < 4; ++dt) accw[dt] = z4;
        LDS_WAIT();
        const int tl = t0 + 3, nv = tl >= 31 ? ((tl - 31) >> 4) + 1 : 0;
        if (nv > 0 && (vm == 0 || (vm & 1))) {
            const int nk = (nv + 31) & ~31;
            KsCmp ks{(const bf16_t*)(ws + WS_CMPK) + (size_t)(b * 2 + g) * 256 * 64, (const bf16_t*)(ws + WS_CMPV) + (size_t)(b * 2 + g) * 256 * 64, t0, g * 4};
            float m = 0.f, lr = 0.f; f32x4 o[4] = {z4, z4, z4, z4};
            flash_run<1>(ks, nk, qb, o, m, lr, vt, al, pn, (const LAS unsigned char*)vt, tbl, lane);
            lr = x32_sum(x16_sum(lr)); lr = lr > 0.f ? __builtin_amdgcn_rcpf(lr) : 0.f;
            flash_run<2>(ks, nk, qb, o, m, lr, vt, al, pn, (const LAS unsigned char*)vt, tbl, lane);
#pragma unroll
            for (int dt = 0; dt < 4; ++dt) { accw[dt][0] = g0[0] * o[dt][0]; accw[dt][1] = g0[1] * o[dt][1]; accw[dt][2] = g0[2] * o[dt][2]; accw[dt][3] = g0[3] * o[dt][3]; }
        }
        LDS_WAIT();
        {
            const int j = lane; float val[4];
#pragma unroll
            for (int qi = 0; qi < 4; ++qi) {
                if (j == 0 || j == tb) val[qi] = 1e4f;
                else if (j < tb) { const LAS float* pq = pn + qi * 256 + 4 * j; val[qi] = pq[-1] + pq[0] + pq[1] + pq[2] + pq[3]; }
                else val[qi] = -1e30f;
            }
            for (int k = 0; k < 8; ++k) {
#pragma unroll
                for (int qi = 0; qi < 4; ++qi) {
                    const float mx = wave_max(val[qi]); const unsigned long long who = __ballot(val[qi] == mx); const int w = __builtin_ctzll(who);
                    if (lane == 0) SELB[(item * 4 + qi) * 8 + k] = mx > -1e29f ? w : -1;
                    if (lane == w) val[qi] = -3e38f;
                }
            }
        }
        {
            const int pstart = t0 >= 511 ? t0 - 511 : 0, nk = (t0 + 3 - pstart + 1 + 31) & ~31;
            KsWin ks{(const bf16_t*)(ws + WS_KW) + (size_t)(b * 2 + g) * SEQ * 64, (const bf16_t*)(ws + WS_VW) + (size_t)(b * 2 + g) * SEQ * 64, pstart, t0, g * 4};
            float m = 0.f, lr = 0.f; f32x4 o[4] = {z4, z4, z4, z4};
            if (vm == 0 || (vm & 2)) flash_run<0>(ks, nk, qb, o, m, lr, vt, al, pn, (const LAS unsigned char*)vt, tbl, lane);
            if (vm & 4) { flash_run<1>(ks, nk, qb, o, m, lr, vt, al, pn, (const LAS unsigned char*)vt, tbl, lane); o[0][0] += lr; }
#pragma unroll
            for (int dt = 0; dt < 4; ++dt) { accw[dt][0] += g2[0] * o[dt][0]; accw[dt][1] += g2[1] * o[dt][1]; accw[dt][2] += g2[2] * o[dt][2]; accw[dt][3] += g2[3] * o[dt][3]; }
        }
        if (vm == 0) {
            bf16_t* dst = YB + (size_t)(b * SEQ + t0 + q) * 512 + (g * 4) * 64 + c;
#pragma unroll
            for (int dt = 0; dt < 4; ++dt)
#pragma unroll
                for (int i = 0; i < 4; ++i) dst[i * 64 + 16 * dt] = (bf16_t)f2bf(accw[dt][i]);
        }
        else { asm volatile("" :: "v"(accw[0]), "v"(accw[1]), "v"(accw[2]), "v"(accw[3])); }
        LDS_WAIT();
    }
    __syncthreads();
    if (vm != 0) return;
    for (int i = F.tid; i < 66560 / 16; i += 512) *(LAS f32x4*)(F.lds + i * 16) = z4;
    if (F.tid < 64) { CNT[F.tid] = 0; TURN[F.tid] = 0; }
    __syncthreads();
    { const int blk = SELB[F.tid];
      if (blk >= 0) { int rank = 0;
#pragma unroll
          for (int k = 0; k < 8; ++k) { const int ob = SELB[(F.tid & ~7) + k]; rank += (ob >= 0 && ob < blk) ? 1 : 0; }
          const int pos = __hip_atomic_fetch_add(CNT + blk, 1, __ATOMIC_RELAXED, __HIP_MEMORY_SCOPE_WORKGROUP); LIST[blk * 64 + pos] = (unsigned short)((F.tid >> 3) | (rank << 8)); } }
    __syncthreads();
    if (wave == 0) {
        const int uj = (CNT[lane] + 3) >> 2; int inc = uj;
#pragma unroll
        for (int o_ = 1; o_ < 64; o_ <<= 1) { const int v = __shfl_up(inc, o_); if (lane >= o_) inc += v; }
        const int offs = inc - uj;
        for (int u = 0; u < uj; ++u) UNIT[offs + u] = (unsigned short)(lane | (u << 8));
        if (lane == 63) NUNIT[0] = inc;
    }
    __syncthreads();
    {
        const int nu = NUNIT[0];
        const LAS float* trow = tbl + (c & 3) * 1024;
        const bf16_t* KSb = (const bf16_t*)(ws + WS_KS) + (size_t)(b * 2 + g) * SEQ * 64; const bf16_t* VSb = (const bf16_t*)(ws + WS_VS) + (size_t)(b * 2 + g) * SEQ * 64;
        for (int ui = wave; ui < nu; ui += 8) {
            const int uu = UNIT[ui], j = uu & 255, u = uu >> 8, nj = CNT[j];
            const int slot = 4 * u + (c >> 2); const int qrow = slot < nj ? (int)(LIST[j * 64 + slot] & 255) : -1;
            const int slotq = 4 * u + q; const int qo = slotq < nj ? (int)(LIST[j * 64 + slotq] & 255) : -1;
            bf16x8 qs[2] = {(bf16x8){0, 0, 0, 0, 0, 0, 0, 0}, (bf16x8){0, 0, 0, 0, 0, 0, 0, 0}};
            if (qrow >= 0) { const bf16_t* qp = prow0 + (size_t)(64 * tb + qrow) * PW + C_NQ + (g * 4 + (c & 3)) * 64 + 8 * q; qs[0] = *(const bf16x8*)qp; qs[1] = *(const bf16x8*)(qp + 32); }
            const bf16_t* kb0 = KSb + (size_t)(64 * j) * 64; const bf16_t* vb0 = VSb + (size_t)(64 * j) * 64;
            bf16x8 ka[4]; u32x4 vv[4];
#define SEL_LOADK(st) do { const bf16_t* kr0 = kb0 + (32 * (st) + c) * 64 + 8 * q; ka[0] = *(const bf16x8*)kr0; ka[1] = *(const bf16x8*)(kr0 + 32); ka[2] = *(const bf16x8*)(kr0 + 1024); ka[3] = *(const bf16x8*)(kr0 + 1056); } while (0)
#define SEL_LOADV(st) do { const bf16_t* vr0 = vb0 + (32 * (st) + (lane >> 3)) * 64 + (lane & 7) * 8; _Pragma("unroll") for (int m = 0; m < 4; ++m) vv[m] = *(const u32x4*)(vr0 + m * 512); } while (0)
            SEL_LOADK(0); SEL_LOADV(0);
            f32x4 o[4] = {z4, z4, z4, z4}; float lsum = 0.f;
#pragma unroll
            for (int st = 0; st < 2; ++st) {
                f32x4 s0 = z4, s1 = z4;
                s0 = MFMA16(ka[0], qs[0], s0); s0 = MFMA16(ka[1], qs[1], s0); s1 = MFMA16(ka[2], qs[0], s1); s1 = MFMA16(ka[3], qs[1], s1);
                if (st == 0) SEL_LOADK(1);
                const int d0 = 64 * (tb - j) + (qrow < 0 ? 0 : qrow) - 32 * st - 4 * q; float pv[8];
#pragma unroll
                for (int i = 0; i < 4; ++i) { const int da = d0 - i, db = da - 16;
                    const float ea = __builtin_amdgcn_exp2f(s0[i] + trow[da < 0 ? 0 : (da < 1023 ? da : 1023)]), eb = __builtin_amdgcn_exp2f(s1[i] + trow[db < 0 ? 0 : (db < 1023 ? db : 1023)]);
                    pv[i] = (qrow >= 0 && da >= 0) ? ea : 0.f; pv[4 + i] = (qrow >= 0 && db >= 0) ? eb : 0.f; lsum += pv[i] + pv[4 + i]; }
#pragma unroll
                for (int m = 0; m < 4; ++m) *(LAS u32x4*)(vt2 + ((lane >> 3) + 8 * m) * 144 + (lane & 7) * 16) = vv[m];
                if (st == 0) SEL_LOADV(1);
                LDS_FENCE();
                const bf16x8 pa = __builtin_bit_cast(bf16x8, pack8(pv));
#pragma unroll
                for (int dt = 0; dt < 4; ++dt) {
                    const s16x4 lo = __builtin_amdgcn_ds_read_tr16_b64_v4i16((LAS s16x4*)(vt2 + (4 * q + (c >> 2)) * 144 + (16 * dt + 4 * (c & 3)) * 2));
                    const s16x4 hi = __builtin_amdgcn_ds_read_tr16_b64_v4i16((LAS s16x4*)(vt2 + (16 + 4 * q + (c >> 2)) * 144 + (16 * dt + 4 * (c & 3)) * 2));
                    o[dt] = MFMA16(pa, __builtin_shufflevector(lo, hi, 0, 1, 2, 3, 4, 5, 6, 7), o[dt]);
                }
                LDS_FENCE();
            }
#undef SEL_LOADK
#undef SEL_LOADV
            lsum = x32_sum(x16_sum(lsum));
#pragma unroll 1
            for (int s = 0; s < 4; ++s) {
                if (4 * u + s >= nj) break;
                const int ent = LIST[j * 64 + 4 * u + s], qs_ = ent & 255, rk = ent >> 8;
                unsigned spins = 0;
                while (TURN[qs_] != rk) { __builtin_amdgcn_s_sleep(1); if (++spins > (1u << 22)) break; }
                if (q == s) {
#pragma unroll
                    for (int dt = 0; dt < 4; ++dt)
#pragma unroll
                        for (int i = 0; i < 4; ++i) OS[(qs_ * 4 + i) * 64 + 16 * dt + c] += o[dt][i];
                }
                if ((c >> 2) == s && q == 0) LS[qs_ * 4 + (c & 3)] += lsum;
                LDS_WAIT();
                if (lane == 0) TURN[qs_] = rk + 1;
                LDS_WAIT();
            }
        }
    }
    __syncthreads();
    for (int ii = 0; ii < 2; ++ii) {
        const int item = wave * 2 + ii, qq = item * 4 + q, t = 64 * tb + qq;
        const u32x2 gg = *(const u32x2*)(prow0 + (size_t)t * PW + C_NG + 8 + g * 4);
        const float g1[4] = {sigm(lo16(gg.x)), sigm(hi16(gg.x)), sigm(lo16(gg.y)), sigm(hi16(gg.y))};
        const f32x4 l4 = *(const LAS f32x4*)(LS + qq * 4);
        const float inv[4] = {l4.x > 0.f ? g1[0] / l4.x : 0.f, l4.y > 0.f ? g1[1] / l4.y : 0.f, l4.z > 0.f ? g1[2] / l4.z : 0.f, l4.w > 0.f ? g1[3] / l4.w : 0.f};
        bf16_t* dst = YB + (size_t)(b * SEQ + t) * 512 + (g * 4) * 64 + c;
#pragma unroll
        for (int dt = 0; dt < 4; ++dt)
#pragma unroll
            for (int i = 0; i < 4; ++i) dst[i * 64 + 16 * dt] = (bf16_t)f2bf(bf2f(dst[i * 64 + 16 * dt]) + inv[i] * OS[(qq * 4 + i) * 64 + 16 * dt + c]);
    }
    __syncthreads();
}

DI void dsa_group(const Params& p, int b, int t0, const Frame& F, const LAS unsigned char* buck, const LAS float* tbl, int parts = 7) {
    unsigned char* ws = p.ws; const int lane = F.lane, wave = F.wave, c = lane & 15, q = lane >> 4;
    LAS unsigned* SC = (LAS unsigned*)F.lds;
    LAS int* list = (LAS int*)(F.lds + 131072 + wave * 1024); LAS float* al = (LAS float*)(F.lds + 139264 + wave * 64);
    const bf16_t* prow0 = (const bf16_t*)(ws + WS_PROJ) + (size_t)(b * SEQ) * PW;
    bf16_t* YD = (bf16_t*)(ws + WS_Y) + (size_t)3 * T * 512;
    const bf16x8 zf = {0, 0, 0, 0, 0, 0, 0, 0};
    const int t = t0 + wave; const bf16_t* qrow = prow0 + (size_t)t * PW;
    const bf16_t* dki = (const bf16_t*)(ws + WS_DKI) + (size_t)(b * SEQ) * 64;
    const bool full = t0 >= 256;
    if (full && (parts & 1)) {
        bf16x8 qa[4][2]; float wv[4][4];
#pragma unroll
        for (int rt = 0; rt < 4; ++rt) { const bf16_t* qp = prow0 + (size_t)(t0 + 2 * rt + (c >> 3)) * PW + C_DQI + (c & 7) * 64 + 8 * q; qa[rt][0] = *(const bf16x8*)qp; qa[rt][1] = *(const bf16x8*)(qp + 32);
            const u32x2 w4 = *(const u32x2*)(prow0 + (size_t)(t0 + 2 * rt + (q >> 1)) * PW + C_DWI + (q & 1) * 4);
            wv[rt][0] = lo16(w4.x) * 0.35355339f; wv[rt][1] = hi16(w4.x) * 0.35355339f; wv[rt][2] = lo16(w4.y) * 0.35355339f; wv[rt][3] = hi16(w4.y) * 0.35355339f; }
        const int ntile = ((t0 + 7) >> 4) + 1, nk64 = ((t0 + 7) >> 6) + 1;
        bf16x8 kx0, kx1;
        if (wave < ntile) { const bf16_t* kp = dki + (size_t)(16 * wave + c) * 64 + 8 * q; kx0 = *(const bf16x8*)kp; kx1 = *(const bf16x8*)(kp + 32); }
        for (int tau = wave; tau < ntile; tau += 8) {
            const bf16x8 kb0 = kx0, kb1 = kx1;
            if (tau + 8 < ntile) { const bf16_t* kp = dki + (size_t)(16 * (tau + 8) + c) * 64 + 8 * q; kx0 = *(const bf16x8*)kp; kx1 = *(const bf16x8*)(kp + 32); }
            const int key = 16 * tau + c;
#pragma unroll
            for (int rt = 0; rt < 4; ++rt) {
                f32x4 acc = {0.f, 0.f, 0.f, 0.f};
                acc = MFMA16(qa[rt][0], kb0, acc); acc = MFMA16(qa[rt][1], kb1, acc);
                float s = wv[rt][0] * fmaxf(acc[0], 0.f) + wv[rt][1] * fmaxf(acc[1], 0.f) + wv[rt][2] * fmaxf(acc[2], 0.f) + wv[rt][3] * fmaxf(acc[3], 0.f);
                s = x16_sum(s);
                const int qq = 2 * rt + (q >> 1);
                if ((q & 1) == 0) SC[qq * 4096 + key] = key <= t0 + qq ? ordf(s) : 0u;
            }
        }
        for (int i = F.tid; i < 8 * 64; i += 512) { const int key = ntile * 16 + (i & 63); if (key < nk64 * 64) SC[(i >> 6) * 4096 + key] = 0u; }
    }
    __syncthreads();
    int n;
    if (!full) { n = t + 1; for (int i = lane; i < 256; i += 64) list[i] = i <= t ? i : -1; }
    else if (parts & 2) {
        n = 256;
        const LAS unsigned* sc = SC + wave * 4096; const int nk64 = (t >> 6) + 1;
        unsigned u[64];
#pragma unroll
        for (int k = 0; k < 64; ++k) u[k] = k < nk64 ? sc[k * 64 + lane] : 0u;
#define WAVE_TOTAL(cl, tot) do { tot = 0; _Pragma("unroll") for (int b_ = 0; b_ < 7; ++b_) tot += __popcll(__ballot(((cl) >> b_) & 1u)) << b_; } while (0)
        unsigned prefix = 0u;
        const int nk8 = __builtin_amdgcn_readfirstlane((nk64 + 7) >> 3);
#define CNT_GE(NK) _Pragma("unroll") for (int k = 0; k < NK; ++k) cl += (u[k] >= cand) ? 1u : 0u;
        for (int bit = 31; bit >= 0; --bit) {
            const unsigned cand = prefix | (1u << bit); unsigned cl = 0u; int cnt;
            switch (nk8) { case 1: CNT_GE(8) break; case 2: CNT_GE(16) break; case 3: CNT_GE(24) break; case 4: CNT_GE(32) break;
                           case 5: CNT_GE(40) break; case 6: CNT_GE(48) break; case 7: CNT_GE(56) break; default: CNT_GE(64) break; }
            WAVE_TOTAL(cl, cnt);
            if (cnt >= 256) { prefix = cand; if (cnt == 256) break; }
        }
        int cgt; { unsigned cl = 0u;
#pragma unroll
            for (int k = 0; k < 64; ++k) cl += (u[k] > prefix) ? 1u : 0u;
            WAVE_TOTAL(cl, cgt); }
#undef WAVE_TOTAL
#undef CNT_GE
        const int need_eq = 256 - cgt; int base = 0, eqbase = 0;
#pragma unroll
        for (int k = 0; k < 64; ++k) {
            if (k < nk64) {
                const bool gtp = u[k] > prefix, eq = u[k] == prefix;
                const unsigned long long meq = __ballot(eq);
                const int eqrank = eqbase + (int)__builtin_amdgcn_mbcnt_hi((unsigned)(meq >> 32), __builtin_amdgcn_mbcnt_lo((unsigned)meq, 0u));
                const bool take = gtp || (eq && eqrank < need_eq);
                const unsigned long long mt = __ballot(take);
                const int slot = base + (int)__builtin_amdgcn_mbcnt_hi((unsigned)(mt >> 32), __builtin_amdgcn_mbcnt_lo((unsigned)mt, 0u));
                if (take && slot < 256) list[slot] = k * 64 + lane;
                base += __popcll(mt); eqbase += __popcll(meq);
            }
        }
    }
    else n = 256;
    LDS_WAIT();
    if (!(parts & 4)) { __syncthreads(); return; }
    LAS unsigned char* vt = F.lds + wave * 16384;
    bf16x8 qd[2] = {zf, zf};
    if (c < 8) { qd[0] = *(const bf16x8*)(qrow + C_DQ + c * 64 + 8 * q); qd[1] = *(const bf16x8*)(qrow + C_DQ + c * 64 + 32 + 8 * q); }
    KsDsa ks{(const bf16_t*)(ws + WS_DK) + (size_t)(b * SEQ) * 64, (const bf16_t*)(ws + WS_DV) + (size_t)(b * SEQ) * 64, list, n, t};
    const f32x4 z4 = {0.f, 0.f, 0.f, 0.f};
    float m = -1e30f, lr = 0.f; f32x4 o[4] = {z4, z4, z4, z4};
    flash_run<0>(ks, (n + 31) & ~31, qd, o, m, lr, vt, al, (LAS float*)vt, buck, tbl, lane);
    if (q < 2) {
#pragma unroll
        for (int dt = 0; dt < 4; ++dt)
#pragma unroll
            for (int i = 0; i < 4; ++i) YD[(size_t)(b * SEQ + t) * 512 + (4 * q + i) * 64 + 16 * dt + c] = (bf16_t)f2bf(o[dt][i]);
    }
    __syncthreads();
}

DI void phase_attn(const Params& p, int l, const Frame& F, int mask = 3, int parts = 15) {
    const int gw = F.vb * 8 + F.wave, NGW = F.G * 8; const float* rel = p.in[I_REL];
#ifndef MK_ATTN
#define MK_ATTN 3
#endif
    if ((MK_ATTN & 1) && (mask & 1)) {
        LAS float* lut = (LAS float*)(F.lds + 130048);
        for (int i = F.tid; i < 8 * 1024; i += 512) { const int h = i >> 10, d = i & 1023; lut[i] = rel[bucket_of(d) * 16 + h] * 1.44269504f; }
        __syncthreads();
        for (int it = F.vb; it < 8 * 2 * 64; it += F.G) { const int b = it >> 7, g = (it >> 6) & 1; int tb = it & 63; if (b & 1) tb = 63 - tb; nsa_tile(p, b, g, tb, F, lut, (parts >> 8) & 15); }
    }
    __syncthreads();
    LAS unsigned char* buck = F.lds + 139776; LAS float* tbl = (LAS float*)(F.lds + 140800);
    for (int i = F.tid; i < 1024; i += 512) buck[i] = (unsigned char)bucket_of(i);
    tbl[F.tid] = rel[F.tid] * 1.44269504f;
    __syncthreads();
    if ((MK_ATTN & 2) && (mask & 2)) for (int it = F.vb; it < 8 * 512; it += F.G) { const int b = it >> 9; int tg = it & 511; if (b & 1) tg = 511 - tg; dsa_group(p, b, tg * 8, F, buck, tbl, parts); }
}


#ifndef MK_PROBE
#define MK_PROBE 0
#endif

DI unsigned row16_maxu(unsigned m) { unsigned o;
    o = (unsigned)DPP_I((int)m, 0xB1); m = m > o ? m : o; o = (unsigned)DPP_I((int)m, 0x4E); m = m > o ? m : o;
    o = (unsigned)DPP_I((int)m, 0x141); m = m > o ? m : o; o = (unsigned)DPP_I((int)m, 0x140); m = m > o ? m : o; return m; }
DI void peer_route_tile(const Params& p, int t0, int lane) {
    unsigned char* ws = p.ws; const int c = lane & 15, q = lane >> 4;
    const bf16_t* QP = (const bf16_t*)(ws + WS_QP); const bf16_t* SK = (const bf16_t*)(ws + WS_SK); int* EIDX = (int*)(ws + WS_EIDX); float* EW = (float*)(ws + WS_EW);
    float* EU = (float*)(ws + WS_EU); const float* USr = (const float*)(ws + WS_PTV); const float* VSr = USr + 16384;
    int ca[4], cb[4]; bool cv[4];
    ca[0] = 0; cb[0] = c; cv[0] = true;
    ca[1] = c < 8 ? 1 : (c < 13 ? 2 : 3); cb[1] = c < 8 ? c : (c < 13 ? c - 8 : c - 13); cv[1] = true;
    { const int ci = 32 + c; int a_, b_;
      if (ci == 32) { a_ = 3; b_ = 3; } else if (ci < 36) { a_ = 4; b_ = ci - 33; } else if (ci < 42) { a_ = 5 + ((ci - 36) >> 1); b_ = (ci - 36) & 1; } else { a_ = 8 + (ci - 42); b_ = 0; }
      ca[2] = a_; cb[2] = b_; cv[2] = true; }
    ca[3] = c < 2 ? 14 + c : 0; cb[3] = 0; cv[3] = c < 2;
    for (int h = 0; h < 8; ++h) {
        unsigned top[2][4];
#pragma unroll
        for (int pp = 0; pp < 2; ++pp) {
            const int hp = h * 2 + pp;
            const bf16_t* ap = QP + (size_t)(t0 + c) * 1024 + hp * 64 + 8 * q;
            const bf16x8 a0 = *(const bf16x8*)ap, a1 = *(const bf16x8*)(ap + 32);
            unsigned v[4][8];
#pragma unroll
            for (int kt = 0; kt < 8; ++kt) { const bf16_t* bp = SK + ((size_t)hp * 128 + 16 * kt + c) * 64 + 8 * q;
                const bf16x8 b0 = *(const bf16x8*)bp, b1 = *(const bf16x8*)(bp + 32);
                f32x4 acc = {0.f, 0.f, 0.f, 0.f}; acc = MFMA16(a0, b0, acc); acc = MFMA16(a1, b1, acc);
#pragma unroll
                for (int i = 0; i < 4; ++i) v[i][kt] = (ordf(acc[i]) & 0xFFFFFF80u) | (unsigned)(127 - (16 * kt + c)); }
            { unsigned mine[4] = {0u, 0u, 0u, 0u};
              for (int r = 0; r < 16; ++r) {
#pragma unroll
                  for (int i = 0; i < 4; ++i) { unsigned m = v[i][0];
#pragma unroll
                      for (int kt = 1; kt < 8; ++kt) m = m > v[i][kt] ? m : v[i][kt];
                      m = row16_maxu(m); mine[i] = (c == r) ? m : mine[i];
#pragma unroll
                      for (int kt = 0; kt < 8; ++kt) v[i][kt] = (v[i][kt] == m) ? 0u : v[i][kt]; } }
#pragma unroll
              for (int i = 0; i < 4; ++i) top[pp][i] = mine[i]; }
        }
        unsigned cd[4][4], mine2[4] = {0u, 0u, 0u, 0u}; int i0v[4], i1v[4];
#pragma unroll
        for (int i = 0; i < 4; ++i) {
            const float s0 = unordf(top[0][i] & 0xFFFFFF80u), s1 = unordf(top[1][i] & 0xFFFFFF80u);
            i0v[i] = 127 - (int)(top[0][i] & 127u); i1v[i] = 127 - (int)(top[1][i] & 127u);
#pragma unroll
            for (int k = 0; k < 4; ++k) { const float s0a = __shfl(s0, (lane & 48) | ca[k]), s1b = __shfl(s1, (lane & 48) | cb[k]);
                cd[i][k] = cv[k] ? ((ordf(s0a + s1b) & 0xFFFFFF00u) | (unsigned)(255 - (ca[k] * 16 + cb[k]))) : 0u; }
        }
        for (int r = 0; r < 16; ++r) {
#pragma unroll
            for (int i = 0; i < 4; ++i) { unsigned m = cd[i][0];
#pragma unroll
                for (int k = 1; k < 4; ++k) m = m > cd[i][k] ? m : cd[i][k];
                m = row16_maxu(m); mine2[i] = (c == r) ? m : mine2[i];
#pragma unroll
                for (int k = 0; k < 4; ++k) cd[i][k] = (cd[i][k] == m) ? 0u : cd[i][k]; }
        }
#pragma unroll
        for (int i = 0; i < 4; ++i) {
            const unsigned mine = mine2[i];
            const int pr = 255 - (int)(mine & 255u); const int ea = __shfl(i0v[i], (lane & 48) | (pr >> 4)), eb = __shfl(i1v[i], (lane & 48) | (pr & 15));
            const float scv = unordf(mine & 0xFFFFFF00u);
            const float mx = row16_maxf(scv);
            const float e = __expf(scv - mx); const float sm = row16_sumf(e);
            const size_t o = (size_t)(t0 + 4 * q + i) * 128 + h * 16 + c;
            const int eid = ea * 128 + eb; EIDX[o] = eid; EW[o] = (e / sm) * VSr[eid]; EU[o] = USr[eid];
        }
    }
}
#define MFMA8(a, b, c) __builtin_amdgcn_mfma_f32_16x16x32_fp8_fp8((a), (b), (c), 0, 0, 0)
DI long lo64(const u32x4 v) { return (long)(((unsigned long long)v.y << 32) | v.x); }
DI long hi64(const u32x4 v) { return (long)(((unsigned long long)v.w << 32) | v.z); }
template <int OFF> DI void peer_dma_o(const unsigned char* src, LAS unsigned char* dst) { __builtin_amdgcn_global_load_lds((const unsigned*)src, (LAS unsigned*)(dst - OFF), 16, OFF, 0); }
template <int K> DI void peer_dma_u(const unsigned char* ub, LAS unsigned char* ring) { peer_dma_o<512 * ((K >> 3) & 1) + 64 * (K & 7)>(ub, ring + 1024 * K); }
DI void peer_gather_token(const Params& p, int l, int t, const float* xin, float* xout, LAS unsigned char* wl, int lane) {
    unsigned char* ws = p.ws;
    LAS unsigned char* h8 = wl; LAS int* el = (LAS int*)(wl + 1024); LAS float* wlw = (LAS float*)(wl + 1536); LAS float* cl = (LAS float*)(wl + 2048); LAS float* eul = (LAS float*)(wl + 2560);
    LAS unsigned char* ring = wl + 3072;
    const unsigned char* PTU = ws + WS_PTU; const unsigned char* PTV = ws + WS_PTU + 16 * MiB;
    const int* EIDX = (const int*)(ws + WS_EIDX); const float* EW = (const float*)(ws + WS_EW); const float* EU = (const float*)(ws + WS_EU);
    const int e0 = lane * 16; const float* xr = xin + (size_t)t * 1024 + e0; const float* gf = p.in[I_GFFN] + l * 1024 + e0;
    float hs_inv; f32x4 xk0, xk1, xk2, xk3;
    {
        float xa[8], xb[8], ga[8], gb[8];
        xk0 = *(const f32x4*)xr; xk1 = *(const f32x4*)(xr + 4); xk2 = *(const f32x4*)(xr + 8); xk3 = *(const f32x4*)(xr + 12);
        xa[0] = xk0.x; xa[1] = xk0.y; xa[2] = xk0.z; xa[3] = xk0.w; xa[4] = xk1.x; xa[5] = xk1.y; xa[6] = xk1.z; xa[7] = xk1.w;
        xb[0] = xk2.x; xb[1] = xk2.y; xb[2] = xk2.z; xb[3] = xk2.w; xb[4] = xk3.x; xb[5] = xk3.y; xb[6] = xk3.z; xb[7] = xk3.w;
        load8f(gf, ga); load8f(gf + 8, gb);
        const int ei0 = EIDX[(size_t)t * 128 + lane], ei1 = EIDX[(size_t)t * 128 + 64 + lane];
        const float ew0 = EW[(size_t)t * 128 + lane], ew1 = EW[(size_t)t * 128 + 64 + lane], eu0 = EU[(size_t)t * 128 + lane], eu1 = EU[(size_t)t * 128 + 64 + lane];
        float ss = 0.f;
#pragma unroll
        for (int e = 0; e < 8; ++e) ss += xa[e] * xa[e] + xb[e] * xb[e];
        const float r = rsqrtf(wave_sum(ss) * (1.f / 1024.f) + 1e-6f);
        float am = 0.f;
#pragma unroll
        for (int e = 0; e < 8; ++e) { xa[e] = xa[e] * r * ga[e]; xb[e] = xb[e] * r * gb[e]; am = fmaxf(am, fmaxf(fabsf(xa[e]), fabsf(xb[e]))); }
        am = wave_max(am);
        const float hs = am > 0.f ? 224.f / am : 1.f; hs_inv = 1.f / hs;
        u32x4 o; o.x = (unsigned)pk4_fp8(xa[0] * hs, xa[1] * hs, xa[2] * hs, xa[3] * hs); o.y = (unsigned)pk4_fp8(xa[4] * hs, xa[5] * hs, xa[6] * hs, xa[7] * hs);
        o.z = (unsigned)pk4_fp8(xb[0] * hs, xb[1] * hs, xb[2] * hs, xb[3] * hs); o.w = (unsigned)pk4_fp8(xb[4] * hs, xb[5] * hs, xb[6] * hs, xb[7] * hs);
        *(LAS u32x4*)(h8 + e0) = o;
        el[lane] = ei0; el[64 + lane] = ei1; wlw[lane] = ew0; wlw[64 + lane] = ew1; eul[lane] = eu0; eul[64 + lane] = eu1;
#if MK_PROBE == 12
        if (xout != p.out) { el[lane] = ei0 & 63; el[64 + lane] = ei1 & 63; }
#endif
    }
    asm volatile("s_waitcnt vmcnt(0) lgkmcnt(0)" ::: "memory");
    const int c = lane & 15, q = lane >> 4;
    u32x4 hb[16];
#pragma unroll
    for (int j = 0; j < 16; ++j) hb[j] = *(const LAS u32x4*)(h8 + 64 * j + 16 * q);
#define PEER_DMA(src_, slot_) __builtin_amdgcn_global_load_lds((const unsigned*)(src_), (LAS unsigned*)(ring + 1024 * (slot_)), 16, 0, 0)
#define PEER_RD(slot_) (*(const LAS u32x4*)(ring + 1024 * (slot_) + 16 * lane))
#define PEER_EL16(dst, base_) do { const int b4_ = (base_) < 112 ? (base_) : 112; _Pragma("unroll") for (int v_ = 0; v_ < 4; ++v_) { const u32x4 t4_ = *(const LAS u32x4*)(el + b4_ + 4 * v_); dst[4 * v_] = (int)t4_.x; dst[4 * v_ + 1] = (int)t4_.y; dst[4 * v_ + 2] = (int)t4_.z; dst[4 * v_ + 3] = (int)t4_.w; } } while (0)
    { const unsigned char* ub0 = PTU + (size_t)el[c] * 1024 + 16 * q;
      peer_dma_u<0>(ub0, ring); peer_dma_u<1>(ub0, ring); peer_dma_u<2>(ub0, ring); peer_dma_u<3>(ub0, ring); peer_dma_u<4>(ub0, ring); peer_dma_u<5>(ub0, ring); peer_dma_u<6>(ub0, ring); peer_dma_u<7>(ub0, ring);
      peer_dma_u<8>(ub0, ring); peer_dma_u<9>(ub0, ring); peer_dma_u<10>(ub0, ring); peer_dma_u<11>(ub0, ring); peer_dma_u<12>(ub0, ring); peer_dma_u<13>(ub0, ring); peer_dma_u<14>(ub0, ring); peer_dma_u<15>(ub0, ring); }
    asm volatile("s_waitcnt vmcnt(12)" ::: "memory");
    u32x4 rr[4];
#pragma unroll
    for (int i = 0; i < 4; ++i) rr[i] = PEER_RD(i);
    for (int eg = 0; eg < 8; ++eg) {
        f32x4 acc = {0.f, 0.f, 0.f, 0.f};
        const unsigned char* ubn = PTU + (size_t)el[16 * (eg < 7 ? eg + 1 : 7) + c] * 1024 + 16 * q;
        int ev[16]; PEER_EL16(ev, 0);
#define PEER_USTEP(k) do { asm volatile("s_waitcnt vmcnt(11)" ::: "memory"); const u32x4 nw = PEER_RD(((k) + 4) & 15); \
            acc = MFMA8(lo64(rr[(k) & 3]), lo64(hb[k]), acc); acc = MFMA8(hi64(rr[(k) & 3]), hi64(hb[k]), acc); asm volatile("" :: "v"(rr[(k) & 3])); \
            if (eg < 7) peer_dma_u<k>(ubn, ring); else PEER_DMA(PTV + (size_t)ev[k] * 1024 + e0, k); rr[(k) & 3] = nw; } while (0)
        PEER_USTEP(0); PEER_USTEP(1); PEER_USTEP(2); PEER_USTEP(3); PEER_USTEP(4); PEER_USTEP(5); PEER_USTEP(6); PEER_USTEP(7);
        PEER_USTEP(8); PEER_USTEP(9); PEER_USTEP(10); PEER_USTEP(11); PEER_USTEP(12); PEER_USTEP(13); PEER_USTEP(14); PEER_USTEP(15);
#undef PEER_USTEP
        if (c == 0) { f32x4 cf;
#pragma unroll
            for (int i = 0; i < 4; ++i) cf[i] = wlw[16 * eg + 4 * q + i] * gelu_t(acc[i] * eul[16 * eg + 4 * q + i] * hs_inv);
            *(LAS f32x4*)(cl + 16 * eg + 4 * q) = cf; }
    }
    typedef float f32x2_t __attribute__((ext_vector_type(2)));
    f32x2_t out[8];
#pragma unroll
    for (int e = 0; e < 8; ++e) out[e] = (f32x2_t){0.f, 0.f};
    for (int eb = 0; eb < 128; eb += 16) {
        int ev[16]; PEER_EL16(ev, eb + 16);
        float cv[16];
#pragma unroll
        for (int v_ = 0; v_ < 4; ++v_) { const f32x4 t4 = *(const LAS f32x4*)(cl + eb + 4 * v_); cv[4 * v_] = t4.x; cv[4 * v_ + 1] = t4.y; cv[4 * v_ + 2] = t4.z; cv[4 * v_ + 3] = t4.w; }
#pragma unroll
        for (int k = 0; k < 16; ++k) {
            asm volatile("s_waitcnt vmcnt(11)" ::: "memory");
            const u32x4 nw = PEER_RD((k + 4) & 15);
            const u32x4 pv_ = rr[k & 3]; const f32x2_t cc = {cv[k], cv[k]};
            out[0] += cc * __builtin_amdgcn_cvt_pk_f32_fp8((int)pv_.x, false); out[1] += cc * __builtin_amdgcn_cvt_pk_f32_fp8((int)pv_.x, true);
            out[2] += cc * __builtin_amdgcn_cvt_pk_f32_fp8((int)pv_.y, false); out[3] += cc * __builtin_amdgcn_cvt_pk_f32_fp8((int)pv_.y, true);
            out[4] += cc * __builtin_amdgcn_cvt_pk_f32_fp8((int)pv_.z, false); out[5] += cc * __builtin_amdgcn_cvt_pk_f32_fp8((int)pv_.z, true);
            out[6] += cc * __builtin_amdgcn_cvt_pk_f32_fp8((int)pv_.w, false); out[7] += cc * __builtin_amdgcn_cvt_pk_f32_fp8((int)pv_.w, true);
            asm volatile("" :: "v"(rr[k & 3]));
            PEER_DMA(PTV + (size_t)ev[k] * 1024 + e0, k);
            rr[k & 3] = nw;
        }
    }
    asm volatile("s_waitcnt vmcnt(0) lgkmcnt(0)" ::: "memory");
#undef PEER_DMA
#undef PEER_RD
#undef PEER_EL16
    float* xo = xout + (size_t)t * 1024 + e0;
    { const f32x4 o0 = {xk0.x + out[0].x, xk0.y + out[0].y, xk0.z + out[1].x, xk0.w + out[1].y}, o1 = {xk1.x + out[2].x, xk1.y + out[2].y, xk1.z + out[3].x, xk1.w + out[3].y};
      const f32x4 o2 = {xk2.x + out[4].x, xk2.y + out[4].y, xk2.z + out[5].x, xk2.w + out[5].y}, o3 = {xk3.x + out[6].x, xk3.y + out[6].y, xk3.z + out[7].x, xk3.w + out[7].y};
      *(f32x4*)xo = o0; *(f32x4*)(xo + 4) = o1; *(f32x4*)(xo + 8) = o2; *(f32x4*)(xo + 12) = o3;
      if (xout == p.out) {
          float ss = (o0.x * o0.x + o0.y * o0.y + o0.z * o0.z + o0.w * o0.w) + (o1.x * o1.x + o1.y * o1.y + o1.z * o1.z + o1.w * o1.w) + (o2.x * o2.x + o2.y * o2.y + o2.z * o2.z + o2.w * o2.w) + (o3.x * o3.x + o3.y * o3.y + o3.z * o3.z + o3.w * o3.w);
          const float rq = rsqrtf(wave_sum(ss) * (1.f / 1024.f) + 1e-6f);
          const float* gp = p.in[I_GPLE] + l * 1024 + e0; const f32x4 g0 = *(const f32x4*)gp, g1 = *(const f32x4*)(gp + 4), g2 = *(const f32x4*)(gp + 8), g3 = *(const f32x4*)(gp + 12);
          u32x4 w0, w1; w0.x = pk2(o0.x * rq * g0.x, o0.y * rq * g0.y); w0.y = pk2(o0.z * rq * g0.z, o0.w * rq * g0.w); w0.z = pk2(o1.x * rq * g1.x, o1.y * rq * g1.y); w0.w = pk2(o1.z * rq * g1.z, o1.w * rq * g1.w);
          w1.x = pk2(o2.x * rq * g2.x, o2.y * rq * g2.y); w1.y = pk2(o2.z * rq * g2.z, o2.w * rq * g2.w); w1.z = pk2(o3.x * rq * g3.x, o3.y * rq * g3.y); w1.w = pk2(o3.z * rq * g3.z, o3.w * rq * g3.w);
          bf16_t* hr = (bf16_t*)(ws + WS_H) + (size_t)t * 1024 + e0; *(u32x4*)hr = w0; *(u32x4*)(hr + 8) = w1; } }
    LDS_WAIT();
}
DI void phase_peer(const Params& p, int l, const Frame& F, float* xout) {
    LAS unsigned char* wl = F.lds + F.wave * LDS_PERWAVE; const int gw = F.vb * 8 + F.wave, NGW = F.G * 8;
    for (int tile = gw; tile < T / 16; tile += NGW) {
        peer_route_tile(p, tile * 16, F.lane);
        __threadfence_block();
        for (int k = 0; k < 16; ++k) peer_gather_token(p, l, tile * 16 + k, p.out, xout, wl, F.lane);
    }
}

#ifndef MK_MASK
#define MK_MASK 0x1fff
#endif
__global__ void __launch_bounds__(512, 2) mega(Params p) {
    extern __shared__ __attribute__((aligned(16))) unsigned char lds_raw[];
#define MKFRAME() Frame F; { int t_ = threadIdx.x; asm volatile("" : "+v"(t_)); F.lds = (LAS unsigned char*)lds_raw; F.tid = t_; F.lane = t_ & 63; F.wave = __builtin_amdgcn_readfirstlane(t_ >> 6); \
        F.G = gridDim.x; const int bx = blockIdx.x; F.vb = (F.G % 8 == 0) ? (bx % 8) * (F.G / 8) + bx / 8 : bx; }
    if (threadIdx.x < 16) ((LAS unsigned*)((LAS unsigned char*)lds_raw + LDS_XB))[threadIdx.x] = 0u;
    __syncthreads();
    const int lo = p.ph_lo, hi = p.ph_hi;
    XcdBarrier bar; bar.bar = (unsigned*)(p.ws + WS_CTL) + 4096; bar.x = 0; bar.st = (volatile LAS unsigned*)((LAS unsigned char*)lds_raw + LDS_XB);
    if (hi - lo > 1) bar = xcd_barrier_post((unsigned*)(p.ws + WS_CTL) + 4096, (volatile LAS unsigned*)((LAS unsigned char*)lds_raw + LDS_XB));
#define WSP(ws) unsigned char* ws = p.ws; asm volatile("" : "+s"(ws))
    for (int l = 0; l < NLAYER; ++l) {
        const int pb = l * NPH;
#define IN(k) (((MK_MASK >> (k)) & 1) && lo <= pb + (k) && pb + (k) < hi)
#if MK_PROBE == 120
#define SEAM(k) do { if (((MK_MASK >> (k)) & 1) && lo <= pb + (k) && pb + (k) + 1 < hi) { xcd_barrier(bar); xcd_barrier(bar); xcd_barrier(bar); } } while (0)
#else
#define SEAM(k) do { if (((MK_MASK >> (k)) & 1) && lo <= pb + (k) && pb + (k) + 1 < hi) xcd_barrier(bar); } while (0)
#endif
        if (IN(0)) { MKFRAME(); phase_prep_w(p, l, F); }
        SEAM(0);
#if MK_PROBE == 100
        if (IN(0)) { MKFRAME(); phase_prep_w(p, l, F); } xcd_barrier(bar);
#endif
        if (IN(1)) { MKFRAME(); WSP(ws); pg8::Gemm g{(const bf16_t*)(ws + WS_H), (const bf16_t*)(ws + WS_WCAT), T, 9216, 1024}; XcdColOrder S{F.G, (int)blockIdx.x};
            Epi1 E{(bf16_t*)(ws + WS_PROJ), (bf16_t*)(ws + WS_GATES)};
            pg8::gemm_phase<Epi1, XcdColOrder, false>(F.lds, g, S, E, nullptr); }
        SEAM(1);
#if MK_PROBE == 104
        if (IN(1)) { for (int rr = 0; rr < 18; ++rr) { MKFRAME(); WSP(ws); pg8::Gemm g{(const bf16_t*)(ws + WS_H), (const bf16_t*)(ws + WS_WCAT), T, 9216, 1024}; RoundOrder S; S.base.init(T, 9216, F.G, (int)blockIdx.x); S.r = rr;
            Epi1 E{(bf16_t*)(ws + WS_PROJ), (bf16_t*)(ws + WS_GATES)};
            pg8::gemm_phase<Epi1, RoundOrder, false>(F.lds, g, S, E, nullptr); xcd_barrier(bar); } }
#endif
#if MK_PROBE == 101 || MK_PROBE == 102 || MK_PROBE == 103
        if (IN(1)) { MKFRAME(); WSP(ws); pg8::Gemm g{(const bf16_t*)(ws + WS_H), (const bf16_t*)(ws + WS_WCAT), T, 9216, 1024}; ColRangeOrder S{F.G, (int)blockIdx.x, MK_PROBE == 103 ? 20 : 0, MK_PROBE == 102 ? 20 : 36};
            Epi1 E{(bf16_t*)(ws + WS_PROJ), (bf16_t*)(ws + WS_GATES)};
            pg8::gemm_phase<Epi1, ColRangeOrder, false>(F.lds, g, S, E, nullptr); } xcd_barrier(bar);
#endif
        if (IN(2)) { MKFRAME(); phase_chunk(p, l, F); }
        SEAM(2);
        if (IN(3)) { MKFRAME(); WSP(ws);
            { pg8::Gemm g{(const bf16_t*)(ws + WS_CMPA), (const bf16_t*)(ws + WS_W1C), 4096, 512, 1024}; pg8::StaticOrder S; S.init(4096, 512, F.G, (int)blockIdx.x); EpiF32P E{(float*)(ws + WS_CMPP), 512};
              pg8::gemm_phase<EpiF32P, pg8::StaticOrder, false>(F.lds, g, S, E, nullptr); }
        }
        if (IN(3)) { MKFRAME(); WSP(ws);
            { pg8::Gemm g{(const bf16_t*)(ws + WS_CMPA) + (size_t)4096 * 1024, (const bf16_t*)(ws + WS_W1C) + (size_t)512 * 1024, 4096, 512, 1024}; pg8::StaticOrder S; S.init(4096, 512, F.G, (int)((blockIdx.x + F.G / 2) % F.G));
              EpiF32P E{(float*)(ws + WS_CMPP) + (size_t)4096 * 512, 512};
              pg8::gemm_phase<EpiF32P, pg8::StaticOrder, false>(F.lds, g, S, E, nullptr); }
        }
        SEAM(3);
        if (IN(4)) { MKFRAME(); phase_cmp2(p, l, F); }
        SEAM(4);
        if (IN(5)) { MKFRAME(); phase_attn(p, l, F, 3, 15); }
        SEAM(5);
#if MK_PROBE == 5 || MK_PROBE == 50 || MK_PROBE == 51 || MK_PROBE == 52 || MK_PROBE == 53
        if (IN(5)) { MKFRAME(); phase_attn(p, l, F, MK_PROBE == 5 ? 3 : (MK_PROBE == 50 ? 1 : 2), MK_PROBE == 52 ? 1 : (MK_PROBE == 53 ? 3 : 15)); xcd_barrier(bar); }
#endif
#if MK_PROBE >= 60 && MK_PROBE < 76
        if (IN(5)) { MKFRAME(); phase_attn(p, l, F, 1, (MK_PROBE - 60) << 8); xcd_barrier(bar); }
#endif
        if (IN(6)) { MKFRAME(); WSP(ws); pg8::Gemm g{(const bf16_t*)(ws + WS_Y), (const bf16_t*)(ws + WS_WBR), 4 * T, 4096, 512}; BranchOrder S{F.G, (int)blockIdx.x};
            EpiBranch E{(const bf16_t*)(ws + WS_GATES), (bf16_t*)(ws + WS_MERGED)};
            pg8::gemm_phase<EpiBranch, BranchOrder, false>(F.lds, g, S, E, nullptr); }
        SEAM(6);
#if MK_PROBE == 106
        if (IN(6)) { MKFRAME(); WSP(ws); pg8::Gemm g{(const bf16_t*)(ws + WS_Y), (const bf16_t*)(ws + WS_WBR), 4 * T, 4096, 512}; BranchOrder S{F.G, (int)blockIdx.x};
            EpiBranch E{(const bf16_t*)(ws + WS_GATES), (bf16_t*)(ws + WS_MERGED)};
            pg8::gemm_phase<EpiBranch, BranchOrder, false>(F.lds, g, S, E, nullptr); } xcd_barrier(bar);
#endif
        if (IN(7)) { MKFRAME(); WSP(ws); pg8::Gemm g{(const bf16_t*)(ws + WS_MERGED), (const bf16_t*)(ws + WS_WOUT4), T, 1024, 1024}; pg8::StaticOrder S; S.init(T, 1024, F.G, (int)blockIdx.x);
            EpiRes E{l == 0 ? p.in[I_X] : p.out, p.out};
            pg8::gemm_phase<EpiRes, pg8::StaticOrder, false>(F.lds, g, S, E, nullptr); }
        SEAM(7);
        if (IN(8)) { MKFRAME(); WSP(ws); rmsnorm_rows(p.out, p.in[I_GFFN] + l * 1024, (bf16_t*)(ws + WS_H), F.vb * 8 + F.wave, F.G * 8, F.lane); }
        SEAM(8);
#if MK_PROBE == 108
        if (IN(8)) { MKFRAME(); WSP(ws); rmsnorm_rows(p.out, p.in[I_GFFN] + l * 1024, (bf16_t*)(ws + WS_H), F.vb * 8 + F.wave, F.G * 8, F.lane); } xcd_barrier(bar);
#endif
        if (IN(9)) { MKFRAME(); WSP(ws);
            { pg8::Gemm g{(const bf16_t*)(ws + WS_H), (const bf16_t*)(ws + WS_WQ), T, 1024, 1024}; pg8::StaticOrder S; S.init(T, 1024, F.G, (int)blockIdx.x); EpiBf E{(bf16_t*)(ws + WS_QP), 1024};
              pg8::gemm_phase<EpiBf, pg8::StaticOrder, false>(F.lds, g, S, E, nullptr); }
        }
        if (IN(9)) { MKFRAME(); WSP(ws);
            { pg8::Gemm g{(const bf16_t*)(ws + WS_PB), (const bf16_t*)(ws + WS_WPP), T, 1024, 256}; pg8::StaticOrder S; S.init(T, 1024, F.G, (int)blockIdx.x); EpiBf E{(bf16_t*)(ws + WS_PP), 1024};
              pg8::gemm_phase<EpiBf, pg8::StaticOrder, false>(F.lds, g, S, E, nullptr); }
        }
        SEAM(9);
#if MK_PROBE == 110
        if (IN(9)) { for (int rep = 0; rep < 9; ++rep) { MKFRAME(); WSP(ws);
            { pg8::Gemm g{(const bf16_t*)(ws + WS_H), (const bf16_t*)(ws + WS_WQ), T, 1024, 1024}; pg8::StaticOrder S; S.init(T, 1024, F.G, (int)blockIdx.x); EpiBf E{(bf16_t*)(ws + WS_QP), 1024};
              pg8::gemm_phase<EpiBf, pg8::StaticOrder, false>(F.lds, g, S, E, nullptr); } } xcd_barrier(bar); }
#endif
#if MK_PROBE == 109
        if (IN(9)) { MKFRAME(); WSP(ws);
            { pg8::Gemm g{(const bf16_t*)(ws + WS_H), (const bf16_t*)(ws + WS_WQ), T, 1024, 1024}; pg8::StaticOrder S; S.init(T, 1024, F.G, (int)blockIdx.x); EpiBf E{(bf16_t*)(ws + WS_QP), 1024};
              pg8::gemm_phase<EpiBf, pg8::StaticOrder, false>(F.lds, g, S, E, nullptr); } }
        if (IN(9)) { MKFRAME(); WSP(ws);
            { pg8::Gemm g{(const bf16_t*)(ws + WS_PB), (const bf16_t*)(ws + WS_WPP), T, 1024, 256}; pg8::StaticOrder S; S.init(T, 1024, F.G, (int)blockIdx.x); EpiBf E{(bf16_t*)(ws + WS_PP), 1024};
              pg8::gemm_phase<EpiBf, pg8::StaticOrder, false>(F.lds, g, S, E, nullptr); } }
        xcd_barrier(bar);
#endif
#if MK_PROBE == 10 || MK_PROBE == 12
        if (IN(10)) { MKFRAME(); phase_peer(p, l, F, (float*)(p.ws + WS_GATES)); xcd_barrier(bar); }
#endif
#if MK_PROBE == 11
        if (IN(10)) { MKFRAME(); for (int tile = F.vb * 8 + F.wave; tile < T / 16; tile += F.G * 8) peer_route_tile(p, tile * 16, F.lane); xcd_barrier(bar); }
#endif
        if (IN(10)) { MKFRAME(); phase_peer(p, l, F, p.out); }
        SEAM(10);
        if (IN(12)) { MKFRAME(); WSP(ws); pg8::Gemm g{(const bf16_t*)(ws + WS_H), (const bf16_t*)(ws + WS_WPG), T, 1024, 1024}; pg8::StaticOrder S; S.init(T, 1024, F.G, (int)blockIdx.x);
            EpiPle E{p.out, (const bf16_t*)(ws + WS_PP)};
            pg8::gemm_phase<EpiPle, pg8::StaticOrder, false>(F.lds, g, S, E, nullptr); }
        SEAM(12);
#undef IN
#undef SEAM
    }
}
}

#ifndef MK_LAUNCH_PER_PHASE
#define MK_LAUNCH_PER_PHASE 0
#endif
extern "C" void kernel_launch(void* const* d_in, const int* in_sizes, int n_in, void* d_out, int out_size, void* d_ws, size_t ws_size, hipStream_t stream) {
    static int grid = 0;
    if (grid == 0) {
        if (n_in != 27 || ws_size < mk::WS_END) { fprintf(stderr, "kernel_launch: need 27 inputs and >= %zu bytes of workspace (got %d, %zu)\n", (size_t)mk::WS_END, n_in, ws_size); grid = -1; return; }
        int dev = 0, cus = 0;
        if (hipGetDevice(&dev) != hipSuccess || hipDeviceGetAttribute(&cus, hipDeviceAttributeMultiprocessorCount, dev) != hipSuccess) { grid = -1; return; }
        if (hipFuncSetAttribute((const void*)mk::mega, hipFuncAttributeMaxDynamicSharedMemorySize, mk::LDS_BYTES) != hipSuccess) { fprintf(stderr, "kernel_launch: hipFuncSetAttribute failed\n"); grid = -1; return; }
        int per_cu = 0;
        if (hipOccupancyMaxActiveBlocksPerMultiprocessor(&per_cu, (const void*)mk::mega, 512, mk::LDS_BYTES) != hipSuccess || per_cu < 1) fprintf(stderr, "kernel_launch: occupancy query says %d\n", per_cu);
        (void)hipGetLastError();
        grid = cus;
    }
    if (grid < 0) return;
    (void)in_sizes; (void)out_size;
    hipMemsetAsync((char*)d_ws + mk::WS_CTL, 0, 1u << 20, stream);
    mk::Params prm{};
    for (int i = 0; i < 27; ++i) prm.in[i] = (const float*)d_in[i];
    prm.out = (float*)d_out; prm.ws = (unsigned char*)d_ws;
#if MK_LAUNCH_PER_PHASE
    for (int ph = 0; ph < mk::NLAYER * mk::NPH; ++ph) { prm.ph_lo = ph; prm.ph_hi = ph + 1; hipLaunchKernelGGL(mk::mega, dim3(grid), dim3(512), mk::LDS_BYTES, stream, prm); }
#else
    prm.ph_lo = 0; prm.ph_hi = mk::NLAYER * mk::NPH; hipLaunchKernelGGL(mk::mega, dim3(grid), dim3(512), mk::LDS_BYTES, stream, prm);
#endif
}
```

```cpp
#include <hip/hip_runtime.h>
#include <stdio.h>
#include <stdint.h>
namespace pg8 {
#define PG8_LAS __attribute__((address_space(3)))
typedef unsigned short bf16_t;
typedef short bf16x8 __attribute__((ext_vector_type(8)));
typedef float f32x4 __attribute__((ext_vector_type(4)));
typedef unsigned u32x4 __attribute__((ext_vector_type(4)));
constexpr int BM = 256, BK = 64, HALF = 128, HTB = HALF * BK * 2  , STAGE_BYTES = 8 * HTB, NXCD = 8, WGM = 8;

__host__ __device__ __forceinline__ int lds_byte(int r, int c) { const int st = (r >> 4) * 2 + (c >> 5), rr = r & 15, cc = c & 31, ob = rr * 64 + cc * 2; return st * 1024 + (ob ^ (((ob >> 9) & 1) << 5)); }
__host__ __device__ __forceinline__ void stage_rc(int b, int& R, int& C) { const int st = b / 1024, sb = b % 1024, swz = sb ^ (((sb >> 9) & 1) << 5); R = (st >> 1) * 16 + swz / 64; C = (st & 1) * 32 + (swz % 64) / 2; }
__host__ __device__ __forceinline__ int perm32(int rho) { const int n = rho >> 4, i = rho & 15; return 8 * (i >> 2) + 4 * n + (i & 3); }

struct Unit { int pm, pn; };
struct Gemm { const bf16_t* A; const bf16_t* Bt; int M, N, K; };

struct StaticOrder {
    int nM, nN, nwg, G, c;
    __host__ __device__ void init(int M, int N, int G_, int c_) { nM = M / BM; nN = N / BM; nwg = nM * nN; G = G_; c = c_; }
    __host__ __device__ bool next(int i, Unit& u) const {
        const long L = (long)i * G + c; if (L >= nwg) return false;
        int wgid = (int)L; { const int q = nwg / NXCD, r = nwg % NXCD, xcd = wgid % NXCD, off = wgid / NXCD; wgid = (xcd < r ? xcd * (q + 1) : r * (q + 1) + (xcd - r) * q) + off; }
        const int nig = WGM * nN, gid = wgid / nig, fm = gid * WGM, gsz = (nM - fm) < WGM ? (nM - fm) : WGM;
        u.pm = fm + ((wgid % nig) % gsz); u.pn = (wgid % nig) / gsz; return true;
    }
    __device__ __forceinline__ void a_ready(const Unit&) const {}
    __device__ __forceinline__ void done(const Unit&) const {}
};
__device__ __forceinline__ unsigned cvt_pk_bf16(float lo, float hi) { unsigned r; asm volatile("v_cvt_pk_bf16_f32 %0, %1, %2" : "=v"(r) : "v"(lo), "v"(hi)); return r; }
template <class Epi, class Sched, bool STAMP = false>
__device__ __forceinline__ void gemm_phase(PG8_LAS unsigned char* lds, const Gemm g, const Sched& S, const Epi& E, unsigned long long* stamps) {
    int tid_l = threadIdx.x; asm volatile("" : "+v"(tid_l));
    const int tid = tid_l, wid = __builtin_amdgcn_readfirstlane(tid >> 6), lane = tid & 63, wr = wid >> 2, wc = wid & 3, fr = lane & 15, fq = lane >> 4;
    const int K = g.K, nt = K / BK;
    int ts_lo = 0, ts_hi = 0, nts = 0; const unsigned long long rt_entry = STAMP ? (unsigned long long)wall_clock64() : 0ull;
#define PG8_STAMP() do { if (STAMP && wid == 0 && nts < 64) { const unsigned long long _c = (unsigned long long)clock64(); \
        ts_lo = (lane == nts) ? (int)(unsigned)_c : ts_lo; ts_hi = (lane == nts) ? (int)(unsigned)(_c >> 32) : ts_hi; ++nts; } } while (0)
    PG8_STAMP();
    unsigned voffA[2], voffB[2];
#pragma unroll
    for (int i = 0; i < 2; ++i) { int R, C; stage_rc(tid * 16 + i * 8192, R, C); const int Rb = Epi::PERM ? ((R & ~31) + perm32(R & 31)) : R;
        voffA[i] = (unsigned)(R * K + C) * 2u; voffB[i] = (unsigned)(Rb * K + C) * 2u; }
    const size_t kstep = (size_t)(BK * 2);
    const size_t hstep = (size_t)HALF * K * 2;
    const size_t tstep = 2 * hstep;
    const unsigned ldsw = (unsigned)wid * 1024u;
    const int aoff = lds_byte(wr * 64 + fr, fq * 8), boff = lds_byte(wc * 32 + fr, fq * 8);
#define PG8_SA(b, h) (((b) * 2 + (h)) * HTB)
#define PG8_SB(b, h) ((4 + (b) * 2 + (h)) * HTB)
#define PG8_STAGE(bufoff, gbase, voff) do { _Pragma("unroll") for (int _i = 0; _i < 2; ++_i) \
        __builtin_amdgcn_global_load_lds((const unsigned*)((const char*)(gbase) + (voff)[_i]), (PG8_LAS unsigned*)(lds + (bufoff) + ldsw + _i * 8192), 16, 0, 0); } while (0)
#define PG8_LDA(dst, b, h) do { _Pragma("unroll") for (int m = 0; m < 4; ++m) _Pragma("unroll") for (int k = 0; k < 2; ++k) dst[m][k] = *(const PG8_LAS bf16x8*)(lds + PG8_SA(b, h) + aoff + m * 2048 + k * 1024); } while (0)
#define PG8_LDB(dst, b, h) do { _Pragma("unroll") for (int n = 0; n < 2; ++n) _Pragma("unroll") for (int k = 0; k < 2; ++k) dst[n][k] = *(const PG8_LAS bf16x8*)(lds + PG8_SB(b, h) + boff + n * 2048 + k * 1024); } while (0)
#define PG8_MMA(ai, bj, At, Bt) do { __builtin_amdgcn_s_setprio(1); _Pragma("unroll") for (int m = 0; m < 4; ++m) _Pragma("unroll") for (int n = 0; n < 2; ++n) _Pragma("unroll") for (int k = 0; k < 2; ++k) \
        acc[ai][bj][m][n] = __builtin_amdgcn_mfma_f32_16x16x32_bf16(Bt[n][k], At[m][k], acc[ai][bj][m][n], 0, 0, 0); __builtin_amdgcn_s_setprio(0); } while (0)
#define PG8_WAIT_V(n) asm volatile("s_waitcnt vmcnt(" #n ")" ::: "memory")
#define PG8_WAIT_L(n) asm volatile("s_waitcnt lgkmcnt(" #n ")" ::: "memory")
#define PG8_BAR __builtin_amdgcn_s_barrier()
#define PG8_SCHED __builtin_amdgcn_sched_barrier(0)
    Unit cur, nxt; int ui = 0;
    if (!S.next(0, cur)) return;
    f32x4 acc[2][2][4][2];
#pragma unroll
    for (int a = 0; a < 2; ++a)
#pragma unroll
        for (int b = 0; b < 2; ++b)
#pragma unroll
            for (int m = 0; m < 4; ++m)
#pragma unroll
                for (int n = 0; n < 2; ++n) acc[a][b][m][n] = (f32x4){0.f, 0.f, 0.f, 0.f};
    bf16x8 At[4][2], B0[2][2], B1[2][2];
    const char* cA = (const char*)g.A + (size_t)cur.pm * tstep; const char* cB = (const char*)g.Bt + (size_t)cur.pn * tstep;
    S.a_ready(cur);
    PG8_STAGE(PG8_SB(0, 0), cB, voffB); PG8_STAGE(PG8_SA(0, 0), cA, voffA); PG8_STAGE(PG8_SB(0, 1), cB + hstep, voffB); PG8_STAGE(PG8_SA(0, 1), cA + hstep, voffA);
    if (wr == 1) PG8_BAR;
    PG8_WAIT_V(4); PG8_BAR;
    PG8_STAGE(PG8_SB(1, 0), cB + kstep, voffB); PG8_STAGE(PG8_SA(1, 0), cA + kstep, voffA); PG8_STAGE(PG8_SB(1, 1), cB + hstep + kstep, voffB);
    PG8_WAIT_V(6); PG8_BAR;
    PG8_STAMP();
    for (;;) {
        const bool has_next = S.next(ui + 1, nxt);
        const char* nA = has_next ? (const char*)g.A + (size_t)nxt.pm * tstep : cA; const char* nB = has_next ? (const char*)g.Bt + (size_t)nxt.pn * tstep : cB;
        for (int t = 0; t < nt; t += 2) {
            const bool last = (t == nt - 2);
            const char* a1 = cA + (size_t)(t + 1) * kstep;
            const char* a2 = last ? nA : cA + (size_t)(t + 2) * kstep; const char* b2 = last ? nB : cB + (size_t)(t + 2) * kstep;
            const char* a3 = a2 + kstep; const char* b3 = b2 + kstep;
            if (last && has_next) S.a_ready(nxt);
            PG8_LDB(B0, 0, 0); PG8_SCHED; PG8_LDA(At, 0, 0); PG8_STAGE(PG8_SA(1, 1), a1 + hstep, voffA);
            PG8_WAIT_L(8); PG8_BAR; PG8_WAIT_L(0); PG8_MMA(0, 0, At, B0); PG8_BAR; PG8_SCHED;
            PG8_LDB(B1, 0, 1); PG8_STAGE(PG8_SB(0, 0), b2, voffB);
            PG8_BAR; PG8_WAIT_L(0); PG8_MMA(0, 1, At, B1); PG8_BAR;
            PG8_LDA(At, 0, 1); PG8_STAGE(PG8_SA(0, 0), a2, voffA);
            PG8_BAR; PG8_WAIT_L(0); PG8_MMA(1, 0, At, B0); PG8_BAR; PG8_SCHED;
            PG8_STAGE(PG8_SB(0, 1), b2 + hstep, voffB);
            PG8_WAIT_V(6); PG8_BAR; PG8_MMA(1, 1, At, B1); PG8_BAR;
            PG8_LDB(B0, 1, 0); PG8_SCHED; PG8_LDA(At, 1, 0); PG8_STAGE(PG8_SA(0, 1), a2 + hstep, voffA);
            PG8_WAIT_L(8); PG8_BAR; PG8_WAIT_L(0); PG8_MMA(0, 0, At, B0); PG8_BAR; PG8_SCHED;
            PG8_LDB(B1, 1, 1); PG8_STAGE(PG8_SB(1, 0), b3, voffB);
            PG8_BAR; PG8_WAIT_L(0); PG8_MMA(0, 1, At, B1); PG8_BAR;
            PG8_LDA(At, 1, 1); PG8_STAGE(PG8_SA(1, 0), a3, voffA);
            PG8_BAR; PG8_WAIT_L(0); PG8_MMA(1, 0, At, B0); PG8_BAR; PG8_SCHED;
            PG8_STAGE(PG8_SB(1, 1), b3 + hstep, voffB);
            PG8_WAIT_V(6); PG8_BAR; PG8_MMA(1, 1, At, B1); PG8_BAR;
        }
        PG8_STAMP();
        if constexpr (!Epi::AFTER_DRAIN) { E(acc, cur, wr, wc, fr, fq); S.done(cur); }
        PG8_STAMP();
        if (!has_next) break;
#pragma unroll
        for (int a = 0; a < 2; ++a)
#pragma unroll
            for (int b = 0; b < 2; ++b)
#pragma unroll
                for (int m = 0; m < 4; ++m)
#pragma unroll
                    for (int n = 0; n < 2; ++n) acc[a][b][m][n] = (f32x4){0.f, 0.f, 0.f, 0.f};
        cur = nxt; cA = nA; cB = nB; ++ui;
    }
    PG8_WAIT_V(0);
    if (wr == 0) PG8_BAR;
    PG8_BAR;
    if constexpr (Epi::AFTER_DRAIN) { E.fused(acc, cur, wr, wc, fr, fq, lds, wid, lane); S.done(cur); }
    PG8_STAMP();
    if (STAMP && wid == 0) { stamps[lane] = lane < nts ? (((unsigned long long)(unsigned)ts_hi << 32) | (unsigned)ts_lo) : 0ull;
        if (lane == 62) stamps[62] = rt_entry; if (lane == 63) stamps[63] = (unsigned long long)wall_clock64(); }
#undef PG8_STAMP
#undef PG8_SA
#undef PG8_SB
#undef PG8_STAGE
#undef PG8_LDA
#undef PG8_LDB
#undef PG8_MMA
#undef PG8_WAIT_V
#undef PG8_WAIT_L
#undef PG8_BAR
#undef PG8_SCHED
}
}
#define XB_TMO      128
#define XB_XCNT(j)  (256  + 64 * (j))
#define XB_XSUB(j)  (1280 + 64 * (j))
#define XB_XGEN(j)  (2304 + 64 * (j))
#define XB_TOP      3328
#define XB_TOPGEN   3392
#define XCD_BAR_WORDS 3456
#define XB_SPIN_CAP (1u << 18)
#define LAS __attribute__((address_space(3)))

__device__ __forceinline__ unsigned xb_ld(unsigned* p)              { return __hip_atomic_load(p, __ATOMIC_RELAXED, __HIP_MEMORY_SCOPE_AGENT); }
__device__ __forceinline__ unsigned xb_add(unsigned* p, unsigned v) { return __hip_atomic_fetch_add(p, v, __ATOMIC_RELAXED, __HIP_MEMORY_SCOPE_AGENT); }
__device__ __forceinline__ unsigned xb_xcc_id() { return (unsigned)__builtin_amdgcn_s_getreg((3 << 11) | 20) & 0xFu; }
#define XB_SPIN(cond, bar) do { unsigned _sp = 0; while (cond) { __builtin_amdgcn_s_sleep(1); \
    if ((++_sp & 255u) == 0u) { if (xb_ld(&(bar)[XB_TMO])) break; if (_sp > XB_SPIN_CAP) { atomicAdd(&(bar)[XB_TMO], 1u); break; } } } } while (0)

struct XcdBarrier {
    unsigned* bar; unsigned x;
    volatile LAS unsigned* st;
};

__device__ __forceinline__ XcdBarrier xcd_barrier_post(unsigned* bar, volatile LAS unsigned* st) {
    XcdBarrier b; b.bar = bar; b.x = xb_xcc_id(); b.st = st;
    if (threadIdx.x == 0) (void)xb_add(&bar[XB_XCNT(b.x)], 1u);
    return b;
}
__device__ __forceinline__ void xcd_barrier_complete(unsigned* bar, unsigned x, unsigned& nloc, unsigned& nx) {
    const unsigned G = gridDim.x * gridDim.y * gridDim.z;
    unsigned sum, cnt, mine, sp = 0u;
    for (;;) {
        sum = 0u; cnt = 0u; mine = 0u;
#pragma unroll
        for (unsigned j = 0; j < 16; ++j) { const unsigned c = xb_ld(&bar[XB_XCNT(j)]); sum += c; cnt += (c > 0u) ? 1u : 0u; mine = (j == x) ? c : mine; }
        if (sum == G) break;
        __builtin_amdgcn_s_sleep(1);
        if ((++sp & 255u) == 0u) { if (xb_ld(&bar[XB_TMO])) break; if (sp > XB_SPIN_CAP) { atomicAdd(&bar[XB_TMO], 1u); break; } }
    }
    nloc = mine > 0u ? mine : 1u; nx = cnt > 0u ? cnt : 1u;
}

__device__ __forceinline__ void xcd_barrier(const XcdBarrier& b) {
    asm volatile("s_waitcnt vmcnt(0)" ::: "memory");
    __syncthreads();
    if (threadIdx.x == 0) {
        unsigned* bar = b.bar;
        __builtin_amdgcn_s_waitcnt(0);
        unsigned nloc = b.st[0], nx = b.st[1];
        if (nloc == 0u) { xcd_barrier_complete(bar, b.x, nloc, nx); b.st[0] = nloc; b.st[1] = nx; }
        const unsigned old = xb_add(&bar[XB_XSUB(b.x)], 1u);
        const unsigned gen = old / nloc;
        if (old + 1u == (gen + 1u) * nloc) {
            __builtin_amdgcn_fence(__ATOMIC_RELEASE, "agent");
            asm volatile("s_waitcnt vmcnt(0)" ::: "memory");
            const unsigned og = xb_add(&bar[XB_TOP], 1u);
            const unsigned tg = og / nx;
            if (og + 1u == (tg + 1u) * nx) xb_add(&bar[XB_TOPGEN], 1u);
            else XB_SPIN(xb_ld(&bar[XB_TOPGEN]) == tg, bar);
            __builtin_amdgcn_fence(__ATOMIC_ACQUIRE, "agent");
            xb_add(&bar[XB_XGEN(b.x)], 1u);
            asm volatile("s_waitcnt vmcnt(0)" ::: "memory");
        } else {
            XB_SPIN(xb_ld(&bar[XB_XGEN(b.x)]) == gen, bar);
            __builtin_amdgcn_fence(__ATOMIC_ACQUIRE, "agent");
            asm volatile("s_waitcnt vmcnt(0)" ::: "memory");
        }
    }
    __syncthreads();
}

namespace mk {
using pg8::bf16_t; using pg8::bf16x8; using pg8::f32x4; using pg8::u32x4;
typedef unsigned u32x2 __attribute__((ext_vector_type(2)));
typedef short s16x4 __attribute__((ext_vector_type(4)));
#define DI __device__ __forceinline__
#define LDS_WAIT() asm volatile("s_waitcnt lgkmcnt(0)" ::: "memory")
#define LDS_FENCE() asm volatile("" ::: "memory")
#define MFMA16(a, b, c) __builtin_amdgcn_mfma_f32_16x16x32_bf16((a), (b), (c), 0, 0, 0)

constexpr int T = 32768, SEQ = 4096, NLAYER = 4, NPH = 16;
constexpr int PW = 5120;
constexpr int C_AB = 0, C_AC = 512, C_AX = 1024, C_NQ = 1536, C_NKV = 2048, C_UV = 2816, C_DQ = 3840, C_DK = 4352, C_DV = 4416,
              C_DQI = 4480, C_DKI = 4992, C_NG = 5056, C_DWI = 5080;
constexpr size_t MiB = 1u << 20;
constexpr size_t WS_CTL = 0, WS_PEB = 1 * MiB, WS_CMPK = 2 * MiB, WS_CMPV = 3 * MiB, WS_SK = 4 * MiB, WS_SGUW = 5 * MiB, WS_CMPA = 8 * MiB,
                 WS_CMPP = 24 * MiB, WS_WCAT = 40 * MiB, WS_WBR = 58 * MiB, WS_WOUT4 = 62 * MiB, WS_WQ = 70 * MiB, WS_WPG = 72 * MiB,
                 WS_WPP = 74 * MiB, WS_W1C = 75 * MiB, WS_PB = 78 * MiB, WS_PTU = 96 * MiB, WS_PTV = 128 * MiB, WS_H = 160 * MiB,
                 WS_Y = 224 * MiB, WS_PROJ = 352 * MiB, WS_GATES = 672 * MiB,
                 WS_KS = 928 * MiB, WS_VS = 936 * MiB, WS_KW = 944 * MiB, WS_VW = 952 * MiB, WS_DK = 960 * MiB, WS_DV = 964 * MiB, WS_DKI = 968 * MiB, WS_END = 972 * MiB;
constexpr size_t WS_ACCF = WS_PROJ, WS_MERGED = WS_PROJ + 128 * MiB, WS_QP = WS_PROJ, WS_PP = WS_PROJ + 64 * MiB, WS_EIDX = WS_PROJ + 128 * MiB, WS_EW = WS_PROJ + 144 * MiB, WS_EU = WS_PROJ + 160 * MiB;
constexpr size_t WS_COEF = WS_PROJ + 176 * MiB, WS_H8 = WS_PROJ + 192 * MiB, WS_HSI = WS_PROJ + 224 * MiB, WS_PD = WS_GATES, PT_SLICE = 2 * MiB;
constexpr int LDS_BYTES = 163840, LDS_PERWAVE = 19456, LDS_BUCK = 8 * LDS_PERWAVE, LDS_TBL = LDS_BUCK + 4096, LDS_XB = LDS_BYTES - 64;

struct Params { const float* in[27]; float* out; unsigned char* ws; int ph_lo, ph_hi; };
enum { I_X = 0, I_P, I_REL, I_GMIX, I_WIN, I_CONVW, I_PE, I_CW1, I_CW2, I_NQG, I_NKG, I_LNG, I_SGUW, I_SGUB, I_DQG, I_DKG, I_WGATE, I_WBR, I_WOUT,
       I_GFFN, I_WQ, I_SUBK, I_PU, I_PV, I_GPLE, I_WPG, I_WPP };

struct Frame { LAS unsigned char* lds; int tid, lane, wave, vb, G; };

DI float bf2f(unsigned short b) { return __uint_as_float(((unsigned)b) << 16); }
DI unsigned f2bf(float f) { unsigned u = __float_as_uint(f); return (u + 0x7fffu + ((u >> 16) & 1u)) >> 16; }
DI unsigned pk2(float lo, float hi) { return pg8::cvt_pk_bf16(lo, hi); }
DI float lo16(unsigned w) { return __uint_as_float(w << 16); }
DI float hi16(unsigned w) { return __uint_as_float(w & 0xffff0000u); }
DI float sigm(float x) { return __builtin_amdgcn_rcpf(1.f + __builtin_amdgcn_exp2f(-1.44269504f * x)); }
DI float gelu_t(float x) { const float y = (-2.f * 0.7978845608f * 1.44269504f) * (x + 0.044715f * x * x * x); return x * __builtin_amdgcn_rcpf(1.f + __builtin_amdgcn_exp2f(y)); }
#define DPP_I(x, ctrl) __builtin_amdgcn_update_dpp(0, (x), (ctrl), 0xF, 0xF, false)
DI float dppf(float x, int) { return x; }
DI float row16_sumf(float v) { v += __builtin_bit_cast(float, DPP_I(__builtin_bit_cast(int, v), 0xB1)); v += __builtin_bit_cast(float, DPP_I(__builtin_bit_cast(int, v), 0x4E));
    v += __builtin_bit_cast(float, DPP_I(__builtin_bit_cast(int, v), 0x141)); v += __builtin_bit_cast(float, DPP_I(__builtin_bit_cast(int, v), 0x140)); return v; }
DI float row16_maxf(float v) { v = fmaxf(v, __builtin_bit_cast(float, DPP_I(__builtin_bit_cast(int, v), 0xB1))); v = fmaxf(v, __builtin_bit_cast(float, DPP_I(__builtin_bit_cast(int, v), 0x4E)));
    v = fmaxf(v, __builtin_bit_cast(float, DPP_I(__builtin_bit_cast(int, v), 0x141))); v = fmaxf(v, __builtin_bit_cast(float, DPP_I(__builtin_bit_cast(int, v), 0x140))); return v; }
DI float quad_sumf(float v) { v += __builtin_bit_cast(float, DPP_I(__builtin_bit_cast(int, v), 0xB1)); v += __builtin_bit_cast(float, DPP_I(__builtin_bit_cast(int, v), 0x4E)); return v; }
DI float oct_sumf(float v) { v = quad_sumf(v); v += __builtin_bit_cast(float, DPP_I(__builtin_bit_cast(int, v), 0x141)); return v; }
DI float x16_sum(float v) { const unsigned u = __float_as_uint(v); const auto r = __builtin_amdgcn_permlane16_swap(u, u, false, false); return __uint_as_float(r[0]) + __uint_as_float(r[1]); }
DI float x32_sum(float v) { const unsigned u = __float_as_uint(v); const auto r = __builtin_amdgcn_permlane32_swap(u, u, false, false); return __uint_as_float(r[0]) + __uint_as_float(r[1]); }
DI float x16_max(float v) { const unsigned u = __float_as_uint(v); const auto r = __builtin_amdgcn_permlane16_swap(u, u, false, false); return fmaxf(__uint_as_float(r[0]), __uint_as_float(r[1])); }
DI float x32_max(float v) { const unsigned u = __float_as_uint(v); const auto r = __builtin_amdgcn_permlane32_swap(u, u, false, false); return fmaxf(__uint_as_float(r[0]), __uint_as_float(r[1])); }
DI float wave_sum(float v) { return x32_sum(x16_sum(row16_sumf(v))); }
DI float wave_max(float v) { return x32_max(x16_max(row16_maxf(v))); }
DI unsigned ordf(float f) { const unsigned u = __float_as_uint(f); return (u & 0x80000000u) ? ~u : (u | 0x80000000u); }
DI float unordf(unsigned x) { return __uint_as_float((x & 0x80000000u) ? (x & 0x7fffffffu) : ~x); }
DI int bucket_of(int n) {
    if (n < 16) return n;
    int b = 16;
    b += (n >= 21); b += (n >= 27); b += (n >= 35); b += (n >= 46); b += (n >= 59); b += (n >= 77); b += (n >= 99); b += (n >= 128);
    b += (n >= 166); b += (n >= 216); b += (n >= 280); b += (n >= 363); b += (n >= 470); b += (n >= 609); b += (n >= 790);
    return b; }

DI int srccol(int n) { return n < 2816 ? n : (n < 5056 ? n + 24 : (n < 5080 ? n - 2240 : (n < 5088 ? n : -1))); }
DI void tr_item(const float* W, int ldw, bf16_t* WT, int ldwt, int k0, int n0, LAS float* scr, int lane, bool remap, int ncopy, int cstride) {
    float tv[32];
#pragma unroll
    for (int i = 0; i < 32; ++i) { const int kk = 2 * i + (lane >> 5), nl = lane & 31; const int n = n0 + nl; const int src = remap ? srccol(n) : n; tv[i] = src >= 0 ? W[(size_t)(k0 + kk) * ldw + src] : 0.f; }
#pragma unroll
    for (int i = 0; i < 32; ++i) { const int kk = 2 * i + (lane >> 5), nl = lane & 31; scr[kk * 33 + nl] = tv[i]; }
    LDS_WAIT();
    const int c = lane & 7;
#pragma unroll
    for (int j = 0; j < 4; ++j) { const int n = (lane >> 3) + 8 * j; const LAS float* s = scr + (8 * c) * 33 + n;
        u32x4 o; o.x = pk2(s[0], s[33]); o.y = pk2(s[66], s[99]); o.z = pk2(s[132], s[165]); o.w = pk2(s[198], s[231]);
        for (int cp = 0; cp < ncopy; ++cp) *(u32x4*)(WT + (size_t)(n0 + n) * ldwt + (size_t)cp * cstride + k0 + 8 * c) = o; }
    LDS_WAIT();
}
DI void cvt_rows(const float* src, bf16_t* dst, size_t ngroups8, int gw, int NGW, int lane) {
    const size_t st = (size_t)NGW * 64;
    for (size_t i0 = (size_t)gw * 64 + lane; i0 < ngroups8; i0 += 4 * st) {
        f32x4 a[4], b[4];
#pragma unroll
        for (int r = 0; r < 4; ++r) { const size_t i = i0 + r * st < ngroups8 ? i0 + r * st : i0; a[r] = ((const f32x4*)src)[2 * i]; b[r] = ((const f32x4*)src)[2 * i + 1]; }
#pragma unroll
        for (int r = 0; r < 4; ++r) { const size_t i = i0 + r * st; if (i >= ngroups8) break;
            u32x4 o; o.x = pk2(a[r].x, a[r].y); o.y = pk2(a[r].z, a[r].w); o.z = pk2(b[r].x, b[r].y); o.w = pk2(b[r].z, b[r].w); ((u32x4*)dst)[i] = o; }
    }
}
DI int pk4_fp8(float a, float b, float c, float d) { int w = 0; w = __builtin_amdgcn_cvt_pk_fp8_f32(a, b, w, false); w = __builtin_amdgcn_cvt_pk_fp8_f32(c, d, w, true); return w; }
DI void cvt_rows_fp8(const float* src, unsigned char* dst, float* scl, int nrows, int gw, int NGW, int lane) {
    for (int r0 = gw; r0 < nrows; r0 += 4 * NGW) {
        f32x4 a[4], b[4], c[4], d[4];
#pragma unroll
        for (int k = 0; k < 4; ++k) { const int r = r0 + k * NGW < nrows ? r0 + k * NGW : r0; const float* s = src + (size_t)r * 1024 + lane * 16;
            a[k] = *(const f32x4*)s; b[k] = *(const f32x4*)(s + 4); c[k] = *(const f32x4*)(s + 8); d[k] = *(const f32x4*)(s + 12); }
#pragma unroll
        for (int k = 0; k < 4; ++k) { const int r = r0 + k * NGW; if (r >= nrows) break;
            float mx = fmaxf(fmaxf(fmaxf(fabsf(a[k].x), fabsf(a[k].y)), fmaxf(fabsf(a[k].z), fabsf(a[k].w))), fmaxf(fmaxf(fabsf(b[k].x), fabsf(b[k].y)), fmaxf(fabsf(b[k].z), fabsf(b[k].w))));
            mx = fmaxf(mx, fmaxf(fmaxf(fmaxf(fabsf(c[k].x), fabsf(c[k].y)), fmaxf(fabsf(c[k].z), fabsf(c[k].w))), fmaxf(fmaxf(fabsf(d[k].x), fabsf(d[k].y)), fmaxf(fabsf(d[k].z), fabsf(d[k].w)))));
            mx = wave_max(mx);
            const float sc = mx > 0.f ? mx * (1.f / 448.f) : 1.f, inv = 1.f / sc;
            u32x4 o; o.x = (unsigned)pk4_fp8(a[k].x * inv, a[k].y * inv, a[k].z * inv, a[k].w * inv); o.y = (unsigned)pk4_fp8(b[k].x * inv, b[k].y * inv, b[k].z * inv, b[k].w * inv);
            o.z = (unsigned)pk4_fp8(c[k].x * inv, c[k].y * inv, c[k].z * inv, c[k].w * inv); o.w = (unsigned)pk4_fp8(d[k].x * inv, d[k].y * inv, d[k].z * inv, d[k].w * inv);
            *(u32x4*)(dst + (size_t)(lane >> 3) * PT_SLICE + (size_t)r * 128 + (lane & 7) * 16) = o;
            if (lane == 0) scl[r] = sc; }
    }
}
DI void rmsnorm_rows(const float* x, const float* g, bf16_t* H, int gw, int NGW, int lane, unsigned char* H8 = nullptr, float* HSI = nullptr) {
    const f32x4 g0 = *(const f32x4*)(g + lane * 8), g1 = *(const f32x4*)(g + lane * 8 + 4), g2 = *(const f32x4*)(g + 512 + lane * 8), g3 = *(const f32x4*)(g + 512 + lane * 8 + 4);
    for (int m0 = gw; m0 < T; m0 += 4 * NGW) {
        f32x4 a[4], b[4], c[4], d[4];
#pragma unroll
        for (int r = 0; r < 4; ++r) { const int m = m0 + r * NGW < T ? m0 + r * NGW : m0; const float* xr = x + (size_t)m * 1024 + lane * 8;
            a[r] = *(const f32x4*)xr; b[r] = *(const f32x4*)(xr + 4); c[r] = *(const f32x4*)(xr + 512); d[r] = *(const f32x4*)(xr + 516); }
#pragma unroll
        for (int r = 0; r < 4; ++r) { const int m = m0 + r * NGW; if (m >= T) break;
            float ss = a[r].x * a[r].x + a[r].y * a[r].y + a[r].z * a[r].z + a[r].w * a[r].w + b[r].x * b[r].x + b[r].y * b[r].y + b[r].z * b[r].z + b[r].w * b[r].w
                     + c[r].x * c[r].x + c[r].y * c[r].y + c[r].z * c[r].z + c[r].w * c[r].w + d[r].x * d[r].x + d[r].y * d[r].y + d[r].z * d[r].z + d[r].w * d[r].w;
            ss = wave_sum(ss);
            const float rr = rsqrtf(ss * (1.f / 1024.f) + 1e-6f);
            u32x4 o0, o1;
            o0.x = pk2(a[r].x * rr * g0.x, a[r].y * rr * g0.y); o0.y = pk2(a[r].z * rr * g0.z, a[r].w * rr * g0.w); o0.z = pk2(b[r].x * rr * g1.x, b[r].y * rr * g1.y); o0.w = pk2(b[r].z * rr * g1.z, b[r].w * rr * g1.w);
            o1.x = pk2(c[r].x * rr * g2.x, c[r].y * rr * g2.y); o1.y = pk2(c[r].z * rr * g2.z, c[r].w * rr * g2.w); o1.z = pk2(d[r].x * rr * g3.x, d[r].y * rr * g3.y); o1.w = pk2(d[r].z * rr * g3.z, d[r].w * rr * g3.w);
            bf16_t* hr = H + (size_t)m * 1024 + lane * 8; *(u32x4*)hr = o0; *(u32x4*)(hr + 512) = o1;
            if (H8) {
                float v[16] = {a[r].x * rr * g0.x, a[r].y * rr * g0.y, a[r].z * rr * g0.z, a[r].w * rr * g0.w, b[r].x * rr * g1.x, b[r].y * rr * g1.y, b[r].z * rr * g1.z, b[r].w * rr * g1.w,
                               c[r].x * rr * g2.x, c[r].y * rr * g2.y, c[r].z * rr * g2.z, c[r].w * rr * g2.w, d[r].x * rr * g3.x, d[r].y * rr * g3.y, d[r].z * rr * g3.z, d[r].w * rr * g3.w};
                float am = 0.f;
#pragma unroll
                for (int e = 0; e < 16; ++e) am = fmaxf(am, fabsf(v[e]));
                am = wave_max(am);
                const float hs = am > 0.f ? 224.f / am : 1.f;
                u32x2 q0, q1; q0.x = (unsigned)pk4_fp8(v[0] * hs, v[1] * hs, v[2] * hs, v[3] * hs); q0.y = (unsigned)pk4_fp8(v[4] * hs, v[5] * hs, v[6] * hs, v[7] * hs);
                q1.x = (unsigned)pk4_fp8(v[8] * hs, v[9] * hs, v[10] * hs, v[11] * hs); q1.y = (unsigned)pk4_fp8(v[12] * hs, v[13] * hs, v[14] * hs, v[15] * hs);
                unsigned char* h8 = H8 + (size_t)m * 1024 + lane * 8; *(u32x2*)h8 = q0; *(u32x2*)(h8 + 512) = q1;
                if (lane == 0) HSI[m] = 1.f / hs; } }
    }
}
DI void phase_prep_w(const Params& p, int l, const Frame& F) {
    LAS float* scr = (LAS float*)(F.lds + F.wave * 8448);
    const int gw = F.vb * 8 + F.wave, NGW = F.G * 8, lane = F.lane;
    unsigned char* ws = p.ws;
    bf16_t* WCAT = (bf16_t*)(ws + WS_WCAT); bf16_t* WBR = (bf16_t*)(ws + WS_WBR); bf16_t* WOUT4 = (bf16_t*)(ws + WS_WOUT4); bf16_t* WQ = (bf16_t*)(ws + WS_WQ);
    bf16_t* WPG = (bf16_t*)(ws + WS_WPG); bf16_t* WPP = (bf16_t*)(ws + WS_WPP); bf16_t* W1C = (bf16_t*)(ws + WS_W1C);
    constexpr int I0 = 2560, I1 = 2048, I2 = 1024, I3 = 512, I4 = 512, I5 = 512, I6 = 128, I7 = 512, NIT = I0 + I1 + I2 + I3 + I4 + I5 + I6 + I7;
    for (int it = gw; it < NIT; it += NGW) {
        int r = it;
        if (r < I0) { tr_item(p.in[I_WIN] + (size_t)l * 1024 * 5088, 5088, WCAT, 1024, (r / 160) * 64, (r % 160) * 32, scr, lane, true, 1, 0); continue; } r -= I0;
        if (r < I1) { tr_item(p.in[I_WGATE] + (size_t)l * 1024 * 4096, 4096, WCAT + (size_t)5120 * 1024, 1024, (r / 128) * 64, (r % 128) * 32, scr, lane, false, 1, 0); continue; } r -= I1;
        if (r < I2) { const int m = r >> 8, rr = r & 255; tr_item(p.in[I_WBR] + ((size_t)l * 2048 + m * 512) * 1024, 1024, WBR + (size_t)m * 1024 * 512, 512, (rr / 32) * 64, (rr % 32) * 32, scr, lane, false, 1, 0); continue; } r -= I2;
        if (r < I3) { tr_item(p.in[I_WOUT] + (size_t)l * 1024 * 1024, 1024, WOUT4, 1024, (r / 32) * 64, (r % 32) * 32, scr, lane, false, 1, 0); continue; } r -= I3;
        if (r < I4) { tr_item(p.in[I_WQ] + (size_t)l * 1024 * 1024, 1024, WQ, 1024, (r / 32) * 64, (r % 32) * 32, scr, lane, false, 1, 0); continue; } r -= I4;
        if (r < I5) { tr_item(p.in[I_WPG] + (size_t)l * 1024 * 1024, 1024, WPG, 1024, (r / 32) * 64, (r % 32) * 32, scr, lane, false, 1, 0); continue; } r -= I5;
        if (r < I6) { tr_item(p.in[I_WPP] + (size_t)l * 256 * 1024, 1024, WPP, 256, (r / 32) * 64, (r % 32) * 32, scr, lane, false, 1, 0); continue; } r -= I6;
        { const int jh = r >> 7, rr = r & 127, j = jh >> 1, half = jh & 1;
          tr_item(p.in[I_CW1] + (((size_t)l * 2 + j) * 2048 + half * 1024) * 256, 256, W1C + ((size_t)j * 512 + half * 256) * 1024, 1024, (rr / 8) * 64, (rr % 8) * 32, scr, lane, false, 1, 0); }
    }
    cvt_rows_fp8(p.in[I_PU] + (size_t)l * 16384 * 1024, ws + WS_PTU, (float*)(ws + WS_PTV), 16384, gw, NGW, lane);
    cvt_rows_fp8(p.in[I_PV] + (size_t)l * 16384 * 1024, ws + WS_PTU + 16 * MiB, (float*)(ws + WS_PTV) + 16384, 16384, gw, NGW, lane);
    cvt_rows(p.in[I_SUBK] + (size_t)l * 131072, (bf16_t*)(ws + WS_SK), 131072 / 8, gw, NGW, lane);
    cvt_rows(p.in[I_P] + (size_t)l * T * 256, (bf16_t*)(ws + WS_PB), (size_t)T * 256 / 8, gw, NGW, lane);
    { const float* sw = p.in[I_SGUW] + (size_t)l * 131072; bf16_t* dst = (bf16_t*)(ws + WS_SGUW);
      for (int i = gw * 64 + lane; i < 131072 / 8; i += NGW * 64) { const int e = i * 8, t = (e >> 7) & 127, s0 = e & 127; float v[8];
#pragma unroll
          for (int k = 0; k < 8; ++k) v[k] = (s0 + k <= t) ? sw[e + k] : 0.f;
          u32x4 o; o.x = pk2(v[0], v[1]); o.y = pk2(v[2], v[3]); o.z = pk2(v[4], v[5]); o.w = pk2(v[6], v[7]); ((u32x4*)dst)[i] = o; } }
    { float* peb = (float*)(ws + WS_PEB);
      for (int o = gw; o < 512; o += NGW) { const int j = o >> 8, n = o & 255; const float* pe = p.in[I_PE] + ((size_t)l * 2 + j) * 2048; const float* w1 = p.in[I_CW1] + ((size_t)l * 2 + j) * 2048 * 256;
          float s = 0.f; for (int k = lane; k < 2048; k += 64) s += pe[k] * w1[(size_t)k * 256 + n];
          s = wave_sum(s); if (lane == 0) peb[o] = s; } }
    rmsnorm_rows(l == 0 ? p.in[I_X] : p.out, p.in[I_GMIX] + l * 1024, (bf16_t*)(ws + WS_H), gw, NGW, lane);
}

struct Epi1 {
    static constexpr bool PERM = true, AFTER_DRAIN = false;
    bf16_t* proj; bf16_t* gates;
    DI void operator()(const f32x4 (&acc)[2][2][4][2], const pg8::Unit& u, int wr, int wc, int fr, int fq) const {
        const int row0 = u.pm * 256 + wr * 64 + fr; const bool isg = u.pn >= 20;
        const int col0 = (isg ? (u.pn - 20) * 256 : u.pn * 256) + wc * 32 + 8 * fq; bf16_t* base = isg ? gates : proj; const int ldc = isg ? 4096 : PW;
#pragma unroll
        for (int ai = 0; ai < 2; ++ai)
#pragma unroll
            for (int m = 0; m < 4; ++m) { bf16_t* rowp = base + (size_t)(row0 + ai * 128 + m * 16) * ldc + col0;
#pragma unroll
                for (int bj = 0; bj < 2; ++bj) { f32x4 v0 = acc[ai][bj][m][0], v1 = acc[ai][bj][m][1];
                    if (isg) { v0.x = sigm(v0.x); v0.y = sigm(v0.y); v0.z = sigm(v0.z); v0.w = sigm(v0.w); v1.x = sigm(v1.x); v1.y = sigm(v1.y); v1.z = sigm(v1.z); v1.w = sigm(v1.w); }
                    u32x4 w; w.x = pk2(v0.x, v0.y); w.y = pk2(v0.z, v0.w); w.z = pk2(v1.x, v1.y); w.w = pk2(v1.z, v1.w);
                    __builtin_nontemporal_store(w, (u32x4*)(rowp + bj * 128)); } }
    }
};
struct EpiBf {
    static constexpr bool PERM = true, AFTER_DRAIN = false;
    bf16_t* O; int ldc;
    DI void operator()(const f32x4 (&acc)[2][2][4][2], const pg8::Unit& u, int wr, int wc, int fr, int fq) const {
        const int row0 = u.pm * 256 + wr * 64 + fr, col0 = u.pn * 256 + wc * 32 + 8 * fq;
#pragma unroll
        for (int ai = 0; ai < 2; ++ai)
#pragma unroll
            for (int m = 0; m < 4; ++m) { bf16_t* rowp = O + (size_t)(row0 + ai * 128 + m * 16) * ldc + col0;
#pragma unroll
                for (int bj = 0; bj < 2; ++bj) { const f32x4 v0 = acc[ai][bj][m][0], v1 = acc[ai][bj][m][1];
                    u32x4 w; w.x = pk2(v0.x, v0.y); w.y = pk2(v0.z, v0.w); w.z = pk2(v1.x, v1.y); w.w = pk2(v1.z, v1.w);
                    *(u32x4*)(rowp + bj * 128) = w; } }
    }
};
struct EpiF32P {
    static constexpr bool PERM = true, AFTER_DRAIN = false;
    float* C; int ldc;
    DI void operator()(const f32x4 (&acc)[2][2][4][2], const pg8::Unit& u, int wr, int wc, int fr, int fq) const {
        const int row0 = u.pm * 256 + wr * 64 + fr, col0 = u.pn * 256 + wc * 32 + 8 * fq;
#pragma unroll
        for (int ai = 0; ai < 2; ++ai)
#pragma unroll
            for (int m = 0; m < 4; ++m) { float* rowp = C + (size_t)(row0 + ai * 128 + m * 16) * ldc + col0;
#pragma unroll
                for (int bj = 0; bj < 2; ++bj) { *(f32x4*)(rowp + bj * 128) = acc[ai][bj][m][0]; *(f32x4*)(rowp + bj * 128 + 4) = acc[ai][bj][m][1]; } }
    }
};
struct XcdColOrder {
    int G, c;
    DI bool next(int i, pg8::Unit& u) const {
        if (G != 256) { const int Lx = i * G + c; if (Lx >= 128 * 36) return false; u.pm = Lx / 36; u.pn = Lx % 36; return true; }
        if (i >= 18) return false;
        const int x = c & 7, w = c >> 3;
        if (i < 16) { u.pm = 8 * i + (w & 7); u.pn = 4 * x + (w >> 3); }
        else { u.pm = 16 * x + 8 * (i - 16) + (w & 7); u.pn = 32 + (w >> 3); }
        return true; }
    DI void a_ready(const pg8::Unit&) const {}
    DI void done(const pg8::Unit&) const {}
};
struct RoundOrder {
    pg8::StaticOrder base; int r;
    DI bool next(int i, pg8::Unit& u) const { return i == 0 && base.next(r, u); }
    DI void a_ready(const pg8::Unit&) const {}
    DI void done(const pg8::Unit&) const {}
};
struct ColRangeOrder {
    int G, c, c0, c1;
    DI bool next(int i, pg8::Unit& u) const { const int nc = c1 - c0; const int Lx = i * G + c; if (Lx >= 128 * nc) return false; u.pm = Lx / nc; u.pn = c0 + Lx % nc; return true; }
    DI void a_ready(const pg8::Unit&) const {}
    DI void done(const pg8::Unit&) const {}
};
struct BranchOrder {
    int G, c;
    DI bool next(int i, pg8::Unit& u) const { const int tile = c + G * (i >> 2), m = i & 3; if (tile >= 512) return false; u.pm = m * 128 + (tile >> 2); u.pn = m * 4 + (tile & 3); return true; }
    DI void a_ready(const pg8::Unit&) const {}
    DI void done(const pg8::Unit&) const {}
};
struct EpiBranch {
    static constexpr bool PERM = true, AFTER_DRAIN = false;
    const bf16_t* gates; bf16_t* merged;
    DI void operator()(const f32x4 (&acc)[2][2][4][2], const pg8::Unit& u, int wr, int wc, int fr, int fq) const {
        const int m4 = u.pn >> 2; const int row0 = (u.pm & 127) * 256 + wr * 64 + fr, gcol0 = u.pn * 256 + wc * 32 + 8 * fq, dcol0 = (u.pn & 3) * 256 + wc * 32 + 8 * fq;
#pragma unroll
        for (int ai = 0; ai < 2; ++ai) {
            u32x4 g[4][2], pr[4][2];
#pragma unroll
            for (int m = 0; m < 4; ++m)
#pragma unroll
                for (int bj = 0; bj < 2; ++bj) { g[m][bj] = *(const u32x4*)(gates + (size_t)(row0 + ai * 128 + m * 16) * 4096 + gcol0 + bj * 128);
                    if (m4 > 0) pr[m][bj] = *(const u32x4*)(merged + (size_t)(row0 + ai * 128 + m * 16) * 1024 + dcol0 + bj * 128); }
#pragma unroll
            for (int m = 0; m < 4; ++m)
#pragma unroll
                for (int bj = 0; bj < 2; ++bj) { const f32x4 v0 = acc[ai][bj][m][0], v1 = acc[ai][bj][m][1]; const u32x4 gg = g[m][bj];
                    f32x4 r0 = {v0.x * lo16(gg.x), v0.y * hi16(gg.x), v0.z * lo16(gg.y), v0.w * hi16(gg.y)}, r1 = {v1.x * lo16(gg.z), v1.y * hi16(gg.z), v1.z * lo16(gg.w), v1.w * hi16(gg.w)};
                    if (m4 > 0) { const u32x4 pp_ = pr[m][bj];
                        r0.x += lo16(pp_.x); r0.y += hi16(pp_.x); r0.z += lo16(pp_.y); r0.w += hi16(pp_.y); r1.x += lo16(pp_.z); r1.y += hi16(pp_.z); r1.z += lo16(pp_.w); r1.w += hi16(pp_.w); }
                    u32x4 w; w.x = pk2(r0.x, r0.y); w.y = pk2(r0.z, r0.w); w.z = pk2(r1.x, r1.y); w.w = pk2(r1.z, r1.w);
                    *(u32x4*)(merged + (size_t)(row0 + ai * 128 + m * 16) * 1024 + dcol0 + bj * 128) = w; }
        }
    }
};
struct EpiRes {
    static constexpr bool PERM = true, AFTER_DRAIN = false;
    const float* xin; float* out;
    DI void operator()(const f32x4 (&acc)[2][2][4][2], const pg8::Unit& u, int wr, int wc, int fr, int fq) const {
        const int row0 = u.pm * 256 + wr * 64 + fr, col0 = u.pn * 256 + wc * 32 + 8 * fq;
#pragma unroll
        for (int ai = 0; ai < 2; ++ai)
#pragma unroll
            for (int mh = 0; mh < 2; ++mh) {
                f32x4 xa[2][2][2];
#pragma unroll
                for (int m2 = 0; m2 < 2; ++m2)
#pragma unroll
                    for (int bj = 0; bj < 2; ++bj) { const size_t off = (size_t)(row0 + ai * 128 + (mh * 2 + m2) * 16) * 1024 + col0 + bj * 128; xa[m2][bj][0] = *(const f32x4*)(xin + off); xa[m2][bj][1] = *(const f32x4*)(xin + off + 4); }
#pragma unroll
                for (int m2 = 0; m2 < 2; ++m2)
#pragma unroll
                    for (int bj = 0; bj < 2; ++bj) { const size_t off = (size_t)(row0 + ai * 128 + (mh * 2 + m2) * 16) * 1024 + col0 + bj * 128;
                        *(f32x4*)(out + off) = xa[m2][bj][0] + acc[ai][bj][mh * 2 + m2][0]; *(f32x4*)(out + off + 4) = xa[m2][bj][1] + acc[ai][bj][mh * 2 + m2][1]; }
            }
    }
};
struct EpiPle {
    static constexpr bool PERM = true, AFTER_DRAIN = false;
    float* x; const bf16_t* pp;
    DI void operator()(const f32x4 (&acc)[2][2][4][2], const pg8::Unit& u, int wr, int wc, int fr, int fq) const {
        const int row0 = u.pm * 256 + wr * 64 + fr, col0 = u.pn * 256 + wc * 32 + 8 * fq;
#pragma unroll
        for (int ai = 0; ai < 2; ++ai)
#pragma unroll
            for (int mh = 0; mh < 2; ++mh) {
                f32x4 xa[2][2][2]; u32x4 ga[2][2];
#pragma unroll
                for (int m2 = 0; m2 < 2; ++m2)
#pragma unroll
                    for (int bj = 0; bj < 2; ++bj) { const size_t off = (size_t)(row0 + ai * 128 + (mh * 2 + m2) * 16) * 1024 + col0 + bj * 128;
                        xa[m2][bj][0] = *(const f32x4*)(x + off); xa[m2][bj][1] = *(const f32x4*)(x + off + 4); ga[m2][bj] = *(const u32x4*)(pp + off); }
#pragma unroll
                for (int m2 = 0; m2 < 2; ++m2)
#pragma unroll
                    for (int bj = 0; bj < 2; ++bj) { const size_t off = (size_t)(row0 + ai * 128 + (mh * 2 + m2) * 16) * 1024 + col0 + bj * 128;
                        const f32x4 v0 = acc[ai][bj][mh * 2 + m2][0], v1 = acc[ai][bj][mh * 2 + m2][1]; const u32x4 g = ga[m2][bj]; f32x4 x0 = xa[m2][bj][0], x1 = xa[m2][bj][1];
                        x0.x += sigm(v0.x) * lo16(g.x); x0.y += sigm(v0.y) * hi16(g.x); x0.z += sigm(v0.z) * lo16(g.y); x0.w += sigm(v0.w) * hi16(g.y);
                        x1.x += sigm(v1.x) * lo16(g.z); x1.y += sigm(v1.y) * hi16(g.z); x1.z += sigm(v1.z) * lo16(g.w); x1.w += sigm(v1.w) * hi16(g.w);
                        *(f32x4*)(x + off) = x0; *(f32x4*)(x + off + 4) = x1; }
            }
    }
};


DI void unpack8(const u32x4 w, float (&f)[8]) { f[0] = lo16(w.x); f[1] = hi16(w.x); f[2] = lo16(w.y); f[3] = hi16(w.y); f[4] = lo16(w.z); f[5] = hi16(w.z); f[6] = lo16(w.w); f[7] = hi16(w.w); }
DI u32x4 pack8(const float (&f)[8]) { u32x4 o; o.x = pk2(f[0], f[1]); o.y = pk2(f[2], f[3]); o.z = pk2(f[4], f[5]); o.w = pk2(f[6], f[7]); return o; }
DI void load8f(const float* p, float (&f)[8]) { const f32x4 a = *(const f32x4*)p, b = *(const f32x4*)(p + 4); f[0] = a.x; f[1] = a.y; f[2] = a.z; f[3] = a.w; f[4] = b.x; f[5] = b.y; f[6] = b.z; f[7] = b.w; }

DI void phase_chunk(const Params& p, int l, const Frame& F) {
    unsigned char* ws = p.ws; const int lane = F.lane, wave = F.wave;
    bf16_t* PROJ = (bf16_t*)(ws + WS_PROJ); bf16_t* YA = (bf16_t*)(ws + WS_Y); bf16_t* YC = YA + (size_t)2 * T * 512; bf16_t* CMPA = (bf16_t*)(ws + WS_CMPA);
    const bf16_t* SGUW = (const bf16_t*)(ws + WS_SGUW);
    LAS unsigned char* vnT = F.lds;
    const float* convw = p.in[I_CONVW] + (size_t)l * 3 * 512; const float* lng = p.in[I_LNG] + (size_t)l * 512; const float* sgub = p.in[I_SGUB] + (size_t)l * 8 * 128;
    float cw0[8], cw1[8], cw2[8], lgn[8];
    load8f(convw + lane * 8, cw0); load8f(convw + 512 + lane * 8, cw1); load8f(convw + 1024 + lane * 8, cw2); load8f(lng + lane * 8, lgn);
    for (int chunk = F.vb; chunk < T / 128; chunk += F.G) {
        const int t0 = chunk * 128;
        for (int tt = wave; tt < 128; tt += 8) {
            const int t = t0 + tt, s = t & (SEQ - 1), b = t >> 12;
            bf16_t* row = PROJ + (size_t)t * PW;
            const int c0 = lane * 8;
            const u32x4 z = {0u, 0u, 0u, 0u};
            const u32x4 rab = *(const u32x4*)(row + C_AB + c0), rc0 = *(const u32x4*)(row + C_AC + c0), rx0 = *(const u32x4*)(row + C_AX + c0);
            u32x4 r1c = z, r1x = z, r2c = z, r2x = z;
            if (s >= 1) { r1c = *(const u32x4*)(row - PW + C_AC + c0); r1x = *(const u32x4*)(row - PW + C_AX + c0); }
            if (s >= 2) { r2c = *(const u32x4*)(row - 2 * PW + C_AC + c0); r2x = *(const u32x4*)(row - 2 * PW + C_AX + c0); }
            u32x4 segv[3]; int segcol[3]; const float* seggp[3]; float segsc[3];
#pragma unroll
            for (int pass = 0; pass < 3; ++pass) {
                const int seg = pass * 8 + (lane >> 3), sg = seg < 20 ? seg : 20; int col; const float* gp; float sc = 1.f;
                if (sg < 8) { col = C_NQ + 64 * sg; gp = p.in[I_NQG] + l * 64; sc = 0.125f * 1.44269504f; }
                else if (sg < 10) { col = C_NKV + 2 * 128 + (sg - 8) * 64; gp = p.in[I_NKG] + (l * 3 + 1) * 64; }
                else if (sg < 12) { col = C_NKV + 4 * 128 + (sg - 10) * 64; gp = p.in[I_NKG] + (l * 3 + 2) * 64; }
                else if (sg < 20) { col = C_DQ + 64 * (sg - 12); gp = p.in[I_DQG] + l * 64; sc = 0.125f * 1.44269504f; }
                else { col = C_DK; gp = p.in[I_DKG] + l * 64; }
                segcol[pass] = col; seggp[pass] = gp; segsc[pass] = sc; segv[pass] = *(const u32x4*)(row + col + (lane & 7) * 8);
            }
            u32x4 rawc = z; const bf16_t* rawsrc = row; bf16_t* rawdst = nullptr;
            if (lane < 48) { const int sgc = lane >> 3;
                if (sgc < 2) { rawsrc = row + C_NKV + 3 * 128 + sgc * 64; rawdst = (bf16_t*)(ws + WS_VS) + ((size_t)((b * 2 + sgc) * SEQ + s)) * 64; }
                else if (sgc < 4) { rawsrc = row + C_NKV + 5 * 128 + (sgc - 2) * 64; rawdst = (bf16_t*)(ws + WS_VW) + ((size_t)((b * 2 + (sgc - 2)) * SEQ + s)) * 64; }
                else if (sgc == 4) { rawsrc = row + C_DV; rawdst = (bf16_t*)(ws + WS_DV) + (size_t)t * 64; }
                else { rawsrc = row + C_DKI; rawdst = (bf16_t*)(ws + WS_DKI) + (size_t)t * 64; }
                rawc = *(const u32x4*)(rawsrc + (lane & 7) * 8); }
            u32x4 cmpc = z;
            if (lane < 32) { const int jg = lane >> 3; cmpc = *(const u32x4*)(row + C_NKV + (jg >> 1) * 128 + (jg & 1) * 64 + (lane & 7) * 8); }
            const u32x4 ruv = *(const u32x4*)(row + C_UV + 512 + lane * 8);
            {
                float ab[8], c0v[8], x0v[8], c1v[8], x1v[8], c2v[8], x2v[8], y[8];
                unpack8(rab, ab); unpack8(rc0, c0v); unpack8(rx0, x0v); unpack8(r1c, c1v); unpack8(r1x, x1v); unpack8(r2c, c2v); unpack8(r2x, x2v);
#pragma unroll
                for (int e = 0; e < 8; ++e) y[e] = ab[e] * (cw2[e] * c0v[e] * x0v[e] + cw1[e] * c1v[e] * x1v[e] + cw0[e] * c2v[e] * x2v[e]);
                *(u32x4*)(YA + (size_t)t * 512 + c0) = pack8(y);
            }
#pragma unroll
            for (int pass = 0; pass < 3; ++pass) {
                const int seg = pass * 8 + (lane >> 3), part = lane & 7, sg = seg < 20 ? seg : 20;
                float v[8], g[8]; unpack8(segv[pass], v); load8f(seggp[pass] + part * 8, g);
                float ss = 0.f;
#pragma unroll
                for (int e = 0; e < 8; ++e) ss += v[e] * v[e];
                ss = oct_sumf(ss);
                const float r = rsqrtf(ss * (1.f / 64.f) + 1e-6f) * segsc[pass];
#pragma unroll
                for (int e = 0; e < 8; ++e) v[e] = v[e] * r * g[e];
                bf16_t* dstp = row + segcol[pass] + part * 8;
                if (sg >= 8 && sg < 10) dstp = (bf16_t*)(ws + WS_KS) + ((size_t)((b * 2 + (sg - 8)) * SEQ + s)) * 64 + part * 8;
                else if (sg >= 10 && sg < 12) dstp = (bf16_t*)(ws + WS_KW) + ((size_t)((b * 2 + (sg - 10)) * SEQ + s)) * 64 + part * 8;
                else if (sg == 20) dstp = (bf16_t*)(ws + WS_DK) + (size_t)t * 64 + part * 8;
                if (seg < 21) *(u32x4*)dstp = pack8(v);
            }
            if (lane < 48) *(u32x4*)(rawdst + (lane & 7) * 8) = rawc;
            if (lane < 32) { const int jg = lane >> 3, j = jg >> 1, g = jg & 1, part = lane & 7;
                *(u32x4*)(CMPA + ((size_t)j * 4096 + ((size_t)(b * 256 + (s >> 4)) * 2 + g)) * 1024 + (s & 15) * 64 + part * 8) = cmpc; }
            {
                float v[8]; unpack8(ruv, v);
                float sm = 0.f;
#pragma unroll
                for (int e = 0; e < 8; ++e) { v[e] = gelu_t(v[e]); sm += v[e]; }
                const float mean = wave_sum(sm) * (1.f / 512.f); float sq = 0.f;
#pragma unroll
                for (int e = 0; e < 8; ++e) { v[e] -= mean; sq += v[e] * v[e]; }
                const float r = rsqrtf(wave_sum(sq) * (1.f / 512.f) + 1e-6f);
#pragma unroll
                for (int e = 0; e < 8; ++e) *(LAS unsigned short*)(vnT + (lane * 8 + e) * 272 + tt * 2) = (unsigned short)f2bf(v[e] * r * lgn[e]);
            }
        }
        __syncthreads();
        {
            const int g = wave, c = lane & 15, q = lane >> 4; const bf16_t* Wg = SGUW + (size_t)g * 128 * 128;
            for (int tt16 = 0; tt16 < 8; ++tt16) {
                const int nk = (tt16 >> 1) + 1;
                bf16x8 bw[4];
#pragma unroll
                for (int kk = 0; kk < 4; ++kk) bw[kk] = *(const bf16x8*)(Wg + (size_t)(16 * tt16 + c) * 128 + 32 * (kk < nk ? kk : 0) + 8 * q);
                const int t = t0 + 16 * tt16 + c; const float bias = sgub[g * 128 + 16 * tt16 + c];
#pragma unroll
                for (int dt = 0; dt < 4; ++dt) {
                    f32x4 acc = {0.f, 0.f, 0.f, 0.f};
#pragma unroll
                    for (int kk = 0; kk < 4; ++kk) if (kk < nk) { const bf16x8 a = *(const LAS bf16x8*)(vnT + (g * 64 + 16 * dt + c) * 272 + (32 * kk + 8 * q) * 2); acc = MFMA16(a, bw[kk], acc); }
                    const int ch = g * 64 + 16 * dt + 4 * q;
                    const u32x2 uu = *(const u32x2*)(PROJ + (size_t)t * PW + C_UV + ch);
                    u32x2 o; o.x = pk2(gelu_t(lo16(uu.x)) * (acc[0] + bias), gelu_t(hi16(uu.x)) * (acc[1] + bias)); o.y = pk2(gelu_t(lo16(uu.y)) * (acc[2] + bias), gelu_t(hi16(uu.y)) * (acc[3] + bias));
                    *(u32x2*)(YC + (size_t)t * 512 + ch) = o;
                }
            }
        }
        __syncthreads();
    }
}

DI void phase_cmp2(const Params& p, int l, const Frame& F) {
    unsigned char* ws = p.ws; const int lane = F.lane; const int gw = F.vb * 8 + F.wave, NGW = F.G * 8;
    LAS float* hid = (LAS float*)(F.lds + 131072 + F.wave * 1024);
    LAS float* w2s = (LAS float*)F.lds;
    { const float* w2g = p.in[I_CW2] + (size_t)l * 2 * 256 * 64;
      for (int i = F.tid; i < 2 * 256 * 64 / 4; i += 512) *(LAS f32x4*)(w2s + i * 4) = *(const f32x4*)(w2g + i * 4); }
    __syncthreads();
    const float* CMPP = (const float*)(ws + WS_CMPP); const float* peb = (const float*)(ws + WS_PEB);
    bf16_t* CMPK = (bf16_t*)(ws + WS_CMPK); bf16_t* CMPV = (bf16_t*)(ws + WS_CMPV);
    const float* kg = p.in[I_NKG] + (l * 3 + 0) * 64;
    for (int it = gw; it < 8 * 256 * 2 * 2; it += NGW) {
        const int j = it & 1, g = (it >> 1) & 1, n = (it >> 2) & 255, b = it >> 10;
        bf16_t* dst = (j ? CMPV : CMPK) + ((size_t)(b * 2 + g) * 256 + n) * 64;
        if (n == 255) { dst[lane] = 0; continue; }
        const float* Pa = CMPP + ((size_t)j * 4096 + (size_t)(b * 256 + n) * 2 + g) * 512; const float* Pb = CMPP + ((size_t)j * 4096 + (size_t)(b * 256 + n + 1) * 2 + g) * 512 + 256;
        const f32x4 a = *(const f32x4*)(Pa + lane * 4), bq = *(const f32x4*)(Pb + lane * 4), pe = *(const f32x4*)(peb + j * 256 + lane * 4);
        f32x4 h; h.x = gelu_t(a.x + bq.x + pe.x); h.y = gelu_t(a.y + bq.y + pe.y); h.z = gelu_t(a.z + bq.z + pe.z); h.w = gelu_t(a.w + bq.w + pe.w);
        *(LAS f32x4*)(hid + lane * 4) = h;
        LDS_WAIT();
        const LAS float* w2 = w2s + j * 256 * 64;
        float o = 0.f;
#pragma unroll 16
        for (int k = 0; k < 256; ++k) o += hid[k] * w2[k * 64 + lane];
        if (j == 0) { const float ss = wave_sum(o * o); o = o * rsqrtf(ss * (1.f / 64.f) + 1e-6f) * kg[lane]; }
        dst[lane] = (bf16_t)f2bf(o);
        LDS_WAIT();
    }
}

DI int bucket_fast(int n) { const int big = 16 + (int)((__log2f((float)n) - 4.f) * 2.6666667f + 2e-4f); return n < 16 ? n : (big < 31 ? big : 31); }
struct KsCmp { static constexpr bool CONTIG = true; static constexpr int DSTEP = 16, DMAX = 1 << 30; const bf16_t* kb; const bf16_t* vb; int t0, hb;
    DI void base(int k0, const bf16_t*& k, const bf16_t*& v) const { k = kb + (size_t)k0 * 64; v = vb + (size_t)k0 * 64; }
    DI int dist0(int k0, int c) const { return t0 + (c >> 2) - (16 * k0 + 31); } };
struct KsSel { static constexpr bool CONTIG = true; static constexpr int DSTEP = 1, DMAX = 1 << 30; const bf16_t* kb; const bf16_t* vb; const LAS int* selb; int t, hb;
    DI int p0(int k0) const { return __builtin_amdgcn_readfirstlane(selb[k0 >> 6]) * 64 + (k0 & 63); }
    DI void base(int k0, const bf16_t*& k, const bf16_t*& v) const { const int ps = p0(k0); k = kb + (size_t)ps * 64; v = vb + (size_t)ps * 64; }
    DI int dist0(int k0, int c) const { return t - p0(k0); } };
struct KsWin { static constexpr bool CONTIG = true; static constexpr int DSTEP = 1, DMAX = 512; const bf16_t* kb; const bf16_t* vb; int pstart, t0, hb;
    DI void base(int k0, const bf16_t*& k, const bf16_t*& v) const { k = kb + (size_t)(pstart + k0) * 64; v = vb + (size_t)(pstart + k0) * 64; }
    DI int dist0(int k0, int c) const { return t0 + (c >> 2) - (pstart + k0); } };
struct KsDsa { static constexpr bool CONTIG = false; static constexpr int DSTEP = 1, DMAX = 1 << 30; const bf16_t* kb; const bf16_t* vb; const LAS int* list; int n, t;
    DI int pos(int idx) const { return idx < n ? list[idx] : -1; }
    DI const bf16_t* krow(int idx) const { const int ps = pos(idx); return kb + (size_t)(ps < 0 ? 0 : ps) * 64; }
    DI const bf16_t* vrow(int idx) const { const int ps = pos(idx); return vb + (size_t)(ps < 0 ? 0 : ps) * 64; }
    DI float adjust(int idx, int c, float s, bool& ok, const LAS unsigned char* buck, const LAS float* tbl) const {
        const int ps = pos(idx); ok = ps >= 0 && ps <= t; const int dd = t - ps; const int dc = ok ? (dd < 1023 ? dd : 1023) : 0; return s + tbl[buck[dc] * 16 + 8 + (c & 7)]; } };

template <int MODE, class KS>
DI void flash_run(const KS& ks, int nkeys, const bf16x8 (&qb)[2], f32x4 (&o)[4], float& m_run, float& l_run, LAS unsigned char* vt, LAS float* al, LAS float* pn,
                  const LAS unsigned char* buck, const LAS float* tbl, int lane) {
    const int c = lane & 15, q = lane >> 4;
    bf16x8 A00, A01, A10, A11, B00, B01, B10, B11; u32x4 Av[4], Bv[4];
#define FL_LOAD(B_, kk0) do { if constexpr (KS::CONTIG) { const bf16_t* kbp_; const bf16_t* vbp_; ks.base((kk0), kbp_, vbp_); const bf16_t* kr0 = kbp_ + c * 64 + 8 * q; \
            B_##00 = *(const bf16x8*)kr0; B_##01 = *(const bf16x8*)(kr0 + 32); B_##10 = *(const bf16x8*)(kr0 + 1024); B_##11 = *(const bf16x8*)(kr0 + 1056); \
            if (MODE != 1) { const bf16_t* vr0 = vbp_ + (lane >> 3) * 64 + (lane & 7) * 8; _Pragma("unroll") for (int m = 0; m < 4; ++m) B_##v[m] = *(const u32x4*)(vr0 + m * 512); } } \
        else { const bf16_t* kr0 = ks.krow((kk0) + c); const bf16_t* kr1 = ks.krow((kk0) + 16 + c); \
            B_##00 = *(const bf16x8*)(kr0 + 8 * q); B_##01 = *(const bf16x8*)(kr0 + 32 + 8 * q); B_##10 = *(const bf16x8*)(kr1 + 8 * q); B_##11 = *(const bf16x8*)(kr1 + 32 + 8 * q); \
            if (MODE != 1) { _Pragma("unroll") for (int m = 0; m < 4; ++m) B_##v[m] = *(const u32x4*)(ks.vrow((kk0) + (lane >> 3) + 8 * m) + (lane & 7) * 8); } } } while (0)
#define FL_STEP(B_, K0_) do { \
        f32x4 s0 = {0.f, 0.f, 0.f, 0.f}, s1 = {0.f, 0.f, 0.f, 0.f}; \
        s0 = MFMA16(B_##00, qb[0], s0); s0 = MFMA16(B_##01, qb[1], s0); s1 = MFMA16(B_##10, qb[0], s1); s1 = MFMA16(B_##11, qb[1], s1); \
        float sv[8], pv[8]; bool ok[8]; \
        if constexpr (KS::CONTIG) { \
            const LAS float* trow = tbl + (c & 3) * 1024; const int d0 = ks.dist0((K0_), c) - KS::DSTEP * 4 * q; \
        _Pragma("unroll") \
            for (int i = 0; i < 4; ++i) { const int da = d0 - KS::DSTEP * i, db = da - KS::DSTEP * 16; \
                ok[i] = da >= 0 && da < KS::DMAX; ok[4 + i] = db >= 0 && db < KS::DMAX; \
                sv[i] = s0[i] + trow[da < 0 ? 0 : (da < 1023 ? da : 1023)]; sv[4 + i] = s1[i] + trow[db < 0 ? 0 : (db < 1023 ? db : 1023)]; } \
        } else { \
        _Pragma("unroll") \
            for (int i = 0; i < 4; ++i) { sv[i] = ks.adjust((K0_) + 4 * q + i, c, s0[i], ok[i], buck, tbl); sv[4 + i] = ks.adjust((K0_) + 16 + 4 * q + i, c, s1[i], ok[4 + i], buck, tbl); } \
        } \
        if (MODE == 2) { \
        _Pragma("unroll") \
            for (int e = 0; e < 8; ++e) { pv[e] = ok[e] ? __builtin_amdgcn_exp2f(sv[e]) * l_run : 0.f; \
                const float x = quad_sumf(pv[e]); \
                if ((c & 3) == 0) pn[(c >> 2) * 256 + (K0_) + (e < 4 ? 4 * q + e : 16 + 4 * q + (e - 4))] = x; } \
        } else { \
            float ps = 0.f; \
        _Pragma("unroll") \
            for (int e = 0; e < 8; ++e) { pv[e] = ok[e] ? __builtin_amdgcn_exp2f(sv[e]) : 0.f; ps += pv[e]; } \
            l_run += ps; \
        } \
        if (MODE != 1) { \
        _Pragma("unroll") \
            for (int m = 0; m < 4; ++m) *(LAS u32x4*)(vt + ((lane >> 3) + 8 * m) * 144 + (lane & 7) * 16) = B_##v[m]; \
            LDS_FENCE(); \
            const bf16x8 pa = __builtin_bit_cast(bf16x8, pack8(pv)); \
        _Pragma("unroll") \
            for (int dt = 0; dt < 4; ++dt) { \
                const s16x4 lo = __builtin_amdgcn_ds_read_tr16_b64_v4i16((LAS s16x4*)(vt + (4 * q + (c >> 2)) * 144 + (16 * dt + 4 * (c & 3)) * 2)); \
                const s16x4 hi = __builtin_amdgcn_ds_read_tr16_b64_v4i16((LAS s16x4*)(vt + (16 + 4 * q + (c >> 2)) * 144 + (16 * dt + 4 * (c & 3)) * 2)); \
                const bf16x8 vb8 = __builtin_shufflevector(lo, hi, 0, 1, 2, 3, 4, 5, 6, 7); \
                o[dt] = MFMA16(pa, vb8, o[dt]); \
            } \
            LDS_FENCE(); \
        } \
    } while (0)
    if (nkeys > 0) FL_LOAD(A, 0);
    for (int k0 = 0; k0 < nkeys; k0 += 64) {
        if (k0 + 32 < nkeys) FL_LOAD(B, k0 + 32);
        FL_STEP(A, k0);
        if (k0 + 32 >= nkeys) break;
        if (k0 + 64 < nkeys) FL_LOAD(A, k0 + 64);
        FL_STEP(B, k0 + 32);
    }
#undef FL_STEP
#undef FL_LOAD
    if (MODE == 0) {
        float lt = x32_sum(x16_sum(l_run));
        const float inv = lt > 0.f ? __builtin_amdgcn_rcpf(lt) : 0.f;
        if (q == 0) al[c] = inv;
        LDS_WAIT();
        const f32x4 a4 = *(const LAS f32x4*)(al + 4 * q);
#pragma unroll
        for (int dt = 0; dt < 4; ++dt) o[dt] = o[dt] * a4;
        LDS_WAIT();
    }
}

DI void nsa_tile(const Params& p, int b, int g, int tb, const Frame& F, const LAS float* lut, int vm = 0) {
    unsigned char* ws = p.ws; const int lane = F.lane, wave = F.wave, c = lane & 15, q = lane >> 4;
    const LAS float* tbl = lut + g * 4096;
    LAS unsigned char* wl = F.lds + wave * 9216; LAS unsigned char* vt = wl; LAS float* al = (LAS float*)(wl + 4608); LAS float* pn = (LAS float*)(wl + 4736);
    LAS float* OS = (LAS float*)F.lds; LAS float* LS = (LAS float*)(F.lds + 65536);
    LAS int* SELB = (LAS int*)(F.lds + 73728); LAS int* CNT = (LAS int*)(F.lds + 75776); LAS unsigned short* UNIT = (LAS unsigned short*)(F.lds + 76032); LAS int* NUNIT = (LAS int*)(F.lds + 76416);
    volatile LAS int* TURN = (volatile LAS int*)(F.lds + 76544); LAS unsigned short* LIST = (LAS unsigned short*)(F.lds + 76800);
    LAS unsigned char* vt2 = F.lds + 84992 + wave * 4608;
    const bf16_t* prow0 = (const bf16_t*)(ws + WS_PROJ) + (size_t)(b * SEQ) * PW;
    bf16_t* YB = (bf16_t*)(ws + WS_Y) + (size_t)T * 512;
    const f32x4 z4 = {0.f, 0.f, 0.f, 0.f};
    for (int ii = 0; ii < 2; ++ii) {
        f32x4 accw[4];
        const int item = wave * 2 + ii, t0 = 64 * tb + 4 * item;
#pragma unroll
        for (int k = 0; k < 4; ++k) *(LAS f32x4*)(pn + lane * 4 + 256 * k) = z4;
        bf16x8 qb[2];
        { const bf16_t* qp = prow0 + (size_t)(t0 + (c >> 2)) * PW + C_NQ + (g * 4 + (c & 3)) * 64 + 8 * q; qb[0] = *(const bf16x8*)qp; qb[1] = *(const bf16x8*)(qp + 32); }
        float g0[4], g2[4];
        { const u32x2 ga = *(const u32x2*)(prow0 + (size_t)(t0 + q) * PW + C_NG + 0 * 8 + g * 4), gc = *(const u32x2*)(prow0 + (size_t)(t0 + q) * PW + C_NG + 2 * 8 + g * 4);
          g0[0] = sigm(lo16(ga.x)); g0[1] = sigm(hi16(ga.x)); g0[2] = sigm(lo16(ga.y)); g0[3] = sigm(hi16(ga.y));
          g2[0] = sigm(lo16(gc.x)); g2[1] = sigm(hi16(gc.x)); g2[2] = sigm(lo16(gc.y)); g2[3] = sigm(hi16(gc.y)); }
#pragma unroll
        for (int dt = 0; dt < 4; ++dt) accw[dt] = z4;
        LDS_WAIT();
        const int tl = t0 + 3, nv = tl >= 31 ? ((tl - 31) >> 4) + 1 : 0;
        if (nv > 0 && (vm == 0 || (vm & 1))) {
            const int nk = (nv + 31) & ~31;
            KsCmp ks{(const bf16_t*)(ws + WS_CMPK) + (size_t)(b * 2 + g) * 256 * 64, (const bf16_t*)(ws + WS_CMPV) + (size_t)(b * 2 + g) * 256 * 64, t0, g * 4};
            float m = 0.f, lr = 0.f; f32x4 o[4] = {z4, z4, z4, z4};
            flash_run<1>(ks, nk, qb, o, m, lr, vt, al, pn, (const LAS unsigned char*)vt, tbl, lane);
            lr = x32_sum(x16_sum(lr)); lr = lr > 0.f ? __builtin_amdgcn_rcpf(lr) : 0.f;
            flash_run<2>(ks, nk, qb, o, m, lr, vt, al, pn, (const LAS unsigned char*)vt, tbl, lane);
#pragma unroll
            for (int dt = 0; dt < 4; ++dt) { accw[dt][0] = g0[0] * o[dt][0]; accw[dt][1] = g0[1] * o[dt][1]; accw[dt][2] = g0[2] * o[dt][2]; accw[dt][3] = g0[3] * o[dt][3]; }
        }
        LDS_WAIT();
        {
            const int j = lane; float val[4];
#pragma unroll
            for (int qi = 0; qi < 4; ++qi) {
                if (j == 0 || j == tb) val[qi] = 1e4f;
                else if (j < tb) { const LAS float* pq = pn + qi * 256 + 4 * j; val[qi] = pq[-1] + pq[0] + pq[1] + pq[2] + pq[3]; }
                else val[qi] = -1e30f;
            }
            for (int k = 0; k < 8; ++k) {
#pragma unroll
                for (int qi = 0; qi < 4; ++qi) {
                    const float mx = wave_max(val[qi]); const unsigned long long who = __ballot(val[qi] == mx); const int w = __builtin_ctzll(who);
                    if (lane == 0) SELB[(item * 4 + qi) * 8 + k] = mx > -1e29f ? w : -1;
                    if (lane == w) val[qi] = -3e38f;
                }
            }
        }
        {
            const int pstart = t0 >= 511 ? t0 - 511 : 0, nk = (t0 + 3 - pstart + 1 + 31) & ~31;
            KsWin ks{(const bf16_t*)(ws + WS_KW) + (size_t)(b * 2 + g) * SEQ * 64, (const bf16_t*)(ws + WS_VW) + (size_t)(b * 2 + g) * SEQ * 64, pstart, t0, g * 4};
            float m = 0.f, lr = 0.f; f32x4 o[4] = {z4, z4, z4, z4};
            if (vm == 0 || (vm & 2)) flash_run<0>(ks, nk, qb, o, m, lr, vt, al, pn, (const LAS unsigned char*)vt, tbl, lane);
            if (vm & 4) { flash_run<1>(ks, nk, qb, o, m, lr, vt, al, pn, (const LAS unsigned char*)vt, tbl, lane); o[0][0] += lr; }
#pragma unroll
            for (int dt = 0; dt < 4; ++dt) { accw[dt][0] += g2[0] * o[dt][0]; accw[dt][1] += g2[1] * o[dt][1]; accw[dt][2] += g2[2] * o[dt][2]; accw[dt][3] += g2[3] * o[dt][3]; }
        }
        if (vm == 0) {
            bf16_t* dst = YB + (size_t)(b * SEQ + t0 + q) * 512 + (g * 4) * 64 + c;
#pragma unroll
            for (int dt = 0; dt < 4; ++dt)
#pragma unroll
                for (int i = 0; i < 4; ++i) dst[i * 64 + 16 * dt] = (bf16_t)f2bf(accw[dt][i]);
        }
        else { asm volatile("" :: "v"(accw[0]), "v"(accw[1]), "v"(accw[2]), "v"(accw[3])); }
        LDS_WAIT();
    }
    __syncthreads();
    if (vm != 0) return;
    for (int i = F.tid; i < 66560 / 16; i += 512) *(LAS f32x4*)(F.lds + i * 16) = z4;
    if (F.tid < 64) { CNT[F.tid] = 0; TURN[F.tid] = 0; }
    __syncthreads();
    { const int blk = SELB[F.tid];
      if (blk >= 0) { int rank = 0;
#pragma unroll
          for (int k = 0; k < 8; ++k) { const int ob = SELB[(F.tid & ~7) + k]; rank += (ob >= 0 && ob < blk) ? 1 : 0; }
          const int pos = __hip_atomic_fetch_add(CNT + blk, 1, __ATOMIC_RELAXED, __HIP_MEMORY_SCOPE_WORKGROUP); LIST[blk * 64 + pos] = (unsigned short)((F.tid >> 3) | (rank << 8)); } }
    __syncthreads();
    if (wave == 0) {
        const int uj = (CNT[lane] + 3) >> 2; int inc = uj;
#pragma unroll
        for (int o_ = 1; o_ < 64; o_ <<= 1) { const int v = __shfl_up(inc, o_); if (lane >= o_) inc += v; }
        const int offs = inc - uj;
        for (int u = 0; u < uj; ++u) UNIT[offs + u] = (unsigned short)(lane | (u << 8));
        if (lane == 63) NUNIT[0] = inc;
    }
    __syncthreads();
    {
        const int nu = NUNIT[0];
        const LAS float* trow = tbl + (c & 3) * 1024;
        const bf16_t* KSb = (const bf16_t*)(ws + WS_KS) + (size_t)(b * 2 + g) * SEQ * 64; const bf16_t* VSb = (const bf16_t*)(ws + WS_VS) + (size_t)(b * 2 + g) * SEQ * 64;
        for (int ui = wave; ui < nu; ui += 8) {
            const int uu = UNIT[ui], j = uu & 255, u = uu >> 8, nj = CNT[j];
            const int slot = 4 * u + (c >> 2); const int qrow = slot < nj ? (int)(LIST[j * 64 + slot] & 255) : -1;
            const int slotq = 4 * u + q; const int qo = slotq < nj ? (int)(LIST[j * 64 + slotq] & 255) : -1;
            bf16x8 qs[2] = {(bf16x8){0, 0, 0, 0, 0, 0, 0, 0}, (bf16x8){0, 0, 0, 0, 0, 0, 0, 0}};
            if (qrow >= 0) { const bf16_t* qp = prow0 + (size_t)(64 * tb + qrow) * PW + C_NQ + (g * 4 + (c & 3)) * 64 + 8 * q; qs[0] = *(const bf16x8*)qp; qs[1] = *(const bf16x8*)(qp + 32); }
            const bf16_t* kb0 = KSb + (size_t)(64 * j) * 64; const bf16_t* vb0 = VSb + (size_t)(64 * j) * 64;
            bf16x8 ka[4]; u32x4 vv[4];
#define SEL_LOADK(st) do { const bf16_t* kr0 = kb0 + (32 * (st) + c) * 64 + 8 * q; ka[0] = *(const bf16x8*)kr0; ka[1] = *(const bf16x8*)(kr0 + 32); ka[2] = *(const bf16x8*)(kr0 + 1024); ka[3] = *(const bf16x8*)(kr0 + 1056); } while (0)
#define SEL_LOADV(st) do { const bf16_t* vr0 = vb0 + (32 * (st) + (lane >> 3)) * 64 + (lane & 7) * 8; _Pragma("unroll") for (int m = 0; m < 4; ++m) vv[m] = *(const u32x4*)(vr0 + m * 512); } while (0)
            SEL_LOADK(0); SEL_LOADV(0);
            f32x4 o[4] = {z4, z4, z4, z4}; float lsum = 0.f;
#pragma unroll
            for (int st = 0; st < 2; ++st) {
                f32x4 s0 = z4, s1 = z4;
                s0 = MFMA16(ka[0], qs[0], s0); s0 = MFMA16(ka[1], qs[1], s0); s1 = MFMA16(ka[2], qs[0], s1); s1 = MFMA16(ka[3], qs[1], s1);
                if (st == 0) SEL_LOADK(1);
                const int d0 = 64 * (tb - j) + (qrow < 0 ? 0 : qrow) - 32 * st - 4 * q; float pv[8];
#pragma unroll
                for (int i = 0; i < 4; ++i) { const int da = d0 - i, db = da - 16;
                    const float ea = __builtin_amdgcn_exp2f(s0[i] + trow[da < 0 ? 0 : (da < 1023 ? da : 1023)]), eb = __builtin_amdgcn_exp2f(s1[i] + trow[db < 0 ? 0 : (db < 1023 ? db : 1023)]);
                    pv[i] = (qrow >= 0 && da >= 0) ? ea : 0.f; pv[4 + i] = (qrow >= 0 && db >= 0) ? eb : 0.f; lsum += pv[i] + pv[4 + i]; }
#pragma unroll
                for (int m = 0; m < 4; ++m) *(LAS u32x4*)(vt2 + ((lane >> 3) + 8 * m) * 144 + (lane & 7) * 16) = vv[m];
                if (st == 0) SEL_LOADV(1);
                LDS_FENCE();
                const bf16x8 pa = __builtin_bit_cast(bf16x8, pack8(pv));
#pragma unroll
                for (int dt = 0; dt < 4; ++dt) {
                    const s16x4 lo = __builtin_amdgcn_ds_read_tr16_b64_v4i16((LAS s16x4*)(vt2 + (4 * q + (c >> 2)) * 144 + (16 * dt + 4 * (c & 3)) * 2));
                    const s16x4 hi = __builtin_amdgcn_ds_read_tr16_b64_v4i16((LAS s16x4*)(vt2 + (16 + 4 * q + (c >> 2)) * 144 + (16 * dt + 4 * (c & 3)) * 2));
                    o[dt] = MFMA16(pa, __builtin_shufflevector(lo, hi, 0, 1, 2, 3, 4, 5, 6, 7), o[dt]);
                }
                LDS_FENCE();
            }
#undef SEL_LOADK
#undef SEL_LOADV
            lsum = x32_sum(x16_sum(lsum));
#pragma unroll 1
            for (int s = 0; s < 4; ++s) {
                if (4 * u + s >= nj) break;
                const int ent = LIST[j * 64 + 4 * u + s], qs_ = ent & 255, rk = ent >> 8;
                unsigned spins = 0;
                while (TURN[qs_] != rk) { __builtin_amdgcn_s_sleep(1); if (++spins > (1u << 22)) break; }
                if (q == s) {
#pragma unroll
                    for (int dt = 0; dt < 4; ++dt)
#pragma unroll
                        for (int i = 0; i < 4; ++i) OS[(qs_ * 4 + i) * 64 + 16 * dt + c] += o[dt][i];
                }
                if ((c >> 2) == s && q == 0) LS[qs_ * 4 + (c & 3)] += lsum;
                LDS_WAIT();
                if (lane == 0) TURN[qs_] = rk + 1;
                LDS_WAIT();
            }
        }
    }
    __syncthreads();
    for (int ii = 0; ii < 2; ++ii) {
        const int item = wave * 2 + ii, qq = item * 4 + q, t = 64 * tb + qq;
        const u32x2 gg = *(const u32x2*)(prow0 + (size_t)t * PW + C_NG + 8 + g * 4);
        const float g1[4] = {sigm(lo16(gg.x)), sigm(hi16(gg.x)), sigm(lo16(gg.y)), sigm(hi16(gg.y))};
        const f32x4 l4 = *(const LAS f32x4*)(LS + qq * 4);
        const float inv[4] = {l4.x > 0.f ? g1[0] / l4.x : 0.f, l4.y > 0.f ? g1[1] / l4.y : 0.f, l4.z > 0.f ? g1[2] / l4.z : 0.f, l4.w > 0.f ? g1[3] / l4.w : 0.f};
        bf16_t* dst = YB + (size_t)(b * SEQ + t) * 512 + (g * 4) * 64 + c;
#pragma unroll
        for (int dt = 0; dt < 4; ++dt)
#pragma unroll
            for (int i = 0; i < 4; ++i) dst[i * 64 + 16 * dt] = (bf16_t)f2bf(bf2f(dst[i * 64 + 16 * dt]) + inv[i] * OS[(qq * 4 + i) * 64 + 16 * dt + c]);
    }
    __syncthreads();
}

DI void dsa_group(const Params& p, int b, int t0, const Frame& F, const LAS unsigned char* buck, const LAS float* tbl, int parts = 7) {
    unsigned char* ws = p.ws; const int lane = F.lane, wave = F.wave, c = lane & 15, q = lane >> 4;
    LAS unsigned* SC = (LAS unsigned*)F.lds;
    LAS int* list = (LAS int*)(F.lds + 131072 + wave * 1024); LAS float* al = (LAS float*)(F.lds + 139264 + wave * 64);
    const bf16_t* prow0 = (const bf16_t*)(ws + WS_PROJ) + (size_t)(b * SEQ) * PW;
    bf16_t* YD = (bf16_t*)(ws + WS_Y) + (size_t)3 * T * 512;
    const bf16x8 zf = {0, 0, 0, 0, 0, 0, 0, 0};
    const int t = t0 + wave; const bf16_t* qrow = prow0 + (size_t)t * PW;
    const bf16_t* dki = (const bf16_t*)(ws + WS_DKI) + (size_t)(b * SEQ) * 64;
    const bool full = t0 >= 256;
    if (full && (parts & 1)) {
        bf16x8 qa[4][2]; float wv[4][4];
#pragma unroll
        for (int rt = 0; rt < 4; ++rt) { const bf16_t* qp = prow0 + (size_t)(t0 + 2 * rt + (c >> 3)) * PW + C_DQI + (c & 7) * 64 + 8 * q; qa[rt][0] = *(const bf16x8*)qp; qa[rt][1] = *(const bf16x8*)(qp + 32);
            const u32x2 w4 = *(const u32x2*)(prow0 + (size_t)(t0 + 2 * rt + (q >> 1)) * PW + C_DWI + (q & 1) * 4);
            wv[rt][0] = lo16(w4.x) * 0.35355339f; wv[rt][1] = hi16(w4.x) * 0.35355339f; wv[rt][2] = lo16(w4.y) * 0.35355339f; wv[rt][3] = hi16(w4.y) * 0.35355339f; }
        const int ntile = ((t0 + 7) >> 4) + 1, nk64 = ((t0 + 7) >> 6) + 1;
        bf16x8 kx0, kx1;
        if (wave < ntile) { const bf16_t* kp = dki + (size_t)(16 * wave + c) * 64 + 8 * q; kx0 = *(const bf16x8*)kp; kx1 = *(const bf16x8*)(kp + 32); }
        for (int tau = wave; tau < ntile; tau += 8) {
            const bf16x8 kb0 = kx0, kb1 = kx1;
            if (tau + 8 < ntile) { const bf16_t* kp = dki + (size_t)(16 * (tau + 8) + c) * 64 + 8 * q; kx0 = *(const bf16x8*)kp; kx1 = *(const bf16x8*)(kp + 32); }
            const int key = 16 * tau + c;
#pragma unroll
            for (int rt = 0; rt < 4; ++rt) {
                f32x4 acc = {0.f, 0.f, 0.f, 0.f};
                acc = MFMA16(qa[rt][0], kb0, acc); acc = MFMA16(qa[rt][1], kb1, acc);
                float s = wv[rt][0] * fmaxf(acc[0], 0.f) + wv[rt][1] * fmaxf(acc[1], 0.f) + wv[rt][2] * fmaxf(acc[2], 0.f) + wv[rt][3] * fmaxf(acc[3], 0.f);
                s = x16_sum(s);
                const int qq = 2 * rt + (q >> 1);
                if ((q & 1) == 0) SC[qq * 4096 + key] = key <= t0 + qq ? ordf(s) : 0u;
            }
        }
        for (int i = F.tid; i < 8 * 64; i += 512) { const int key = ntile * 16 + (i & 63); if (key < nk64 * 64) SC[(i >> 6) * 4096 + key] = 0u; }
    }
    __syncthreads();
    int n;
    if (!full) { n = t + 1; for (int i = lane; i < 256; i += 64) list[i] = i <= t ? i : -1; }
    else if (parts & 2) {
        n = 256;
        const LAS unsigned* sc = SC + wave * 4096; const int nk64 = (t >> 6) + 1;
        unsigned u[64];
#pragma unroll
        for (int k = 0; k < 64; ++k) u[k] = k < nk64 ? sc[k * 64 + lane] : 0u;
#define WAVE_TOTAL(cl, tot) do { tot = 0; _Pragma("unroll") for (int b_ = 0; b_ < 7; ++b_) tot += __popcll(__ballot(((cl) >> b_) & 1u)) << b_; } while (0)
        unsigned prefix = 0u;
        const int nk8 = __builtin_amdgcn_readfirstlane((nk64 + 7) >> 3);
#define CNT_GE(NK) _Pragma("unroll") for (int k = 0; k < NK; ++k) cl += (u[k] >= cand) ? 1u : 0u;
        for (int bit = 31; bit >= 0; --bit) {
            const unsigned cand = prefix | (1u << bit); unsigned cl = 0u; int cnt;
            switch (nk8) { case 1: CNT_GE(8) break; case 2: CNT_GE(16) break; case 3: CNT_GE(24) break; case 4: CNT_GE(32) break;
                           case 5: CNT_GE(40) break; case 6: CNT_GE(48) break; case 7: CNT_GE(56) break; default: CNT_GE(64) break; }
            WAVE_TOTAL(cl, cnt);
            if (cnt >= 256) { prefix = cand; if (cnt == 256) break; }
        }
        int cgt; { unsigned cl = 0u;
#pragma unroll
            for (int k = 0; k < 64; ++k) cl += (u[k] > prefix) ? 1u : 0u;
            WAVE_TOTAL(cl, cgt); }
#undef WAVE_TOTAL
#undef CNT_GE
        const int need_eq = 256 - cgt; int base = 0, eqbase = 0;
#pragma unroll
        for (int k = 0; k < 64; ++k) {
            if (k < nk64) {
                const bool gtp = u[k] > prefix, eq = u[k] == prefix;
                const unsigned long long meq = __ballot(eq);
                const int eqrank = eqbase + (int)__builtin_amdgcn_mbcnt_hi((unsigned)(meq >> 32), __builtin_amdgcn_mbcnt_lo((unsigned)meq, 0u));
                const bool take = gtp || (eq && eqrank < need_eq);
                const unsigned long long mt = __ballot(take);
                const int slot = base + (int)__builtin_amdgcn_mbcnt_hi((unsigned)(mt >> 32), __builtin_amdgcn_mbcnt_lo((unsigned)mt, 0u));
                if (take && slot < 256) list[slot] = k * 64 + lane;
                base += __popcll(mt); eqbase += __popcll(meq);
            }
        }
    }
    else n = 256;
    LDS_WAIT();
    if (!(parts & 4)) { __syncthreads(); return; }
    LAS unsigned char* vt = F.lds + wave * 16384;
    bf16x8 qd[2] = {zf, zf};
    if (c < 8) { qd[0] = *(const bf16x8*)(qrow + C_DQ + c * 64 + 8 * q); qd[1] = *(const bf16x8*)(qrow + C_DQ + c * 64 + 32 + 8 * q); }
    KsDsa ks{(const bf16_t*)(ws + WS_DK) + (size_t)(b * SEQ) * 64, (const bf16_t*)(ws + WS_DV) + (size_t)(b * SEQ) * 64, list, n, t};
    const f32x4 z4 = {0.f, 0.f, 0.f, 0.f};
    float m = -1e30f, lr = 0.f; f32x4 o[4] = {z4, z4, z4, z4};
    flash_run<0>(ks, (n + 31) & ~31, qd, o, m, lr, vt, al, (LAS float*)vt, buck, tbl, lane);
    if (q < 2) {
#pragma unroll
        for (int dt = 0; dt < 4; ++dt)
#pragma unroll
            for (int i = 0; i < 4; ++i) YD[(size_t)(b * SEQ + t) * 512 + (4 * q + i) * 64 + 16 * dt + c] = (bf16_t)f2bf(o[dt][i]);
    }
    __syncthreads();
}

DI void phase_attn(const Params& p, int l, const Frame& F, int mask = 3, int parts = 15) {
    const int gw = F.vb * 8 + F.wave, NGW = F.G * 8; const float* rel = p.in[I_REL];
#ifndef MK_ATTN
#define MK_ATTN 3
#endif
    if ((MK_ATTN & 1) && (mask & 1)) {
        LAS float* lut = (LAS float*)(F.lds + 130048);
        for (int i = F.tid; i < 8 * 1024; i += 512) { const int h = i >> 10, d = i & 1023; lut[i] = rel[bucket_of(d) * 16 + h] * 1.44269504f; }
        __syncthreads();
        for (int it = F.vb; it < 8 * 2 * 64; it += F.G) { const int b = it >> 7, g = (it >> 6) & 1; int tb = it & 63; if (b & 1) tb = 63 - tb; nsa_tile(p, b, g, tb, F, lut, (parts >> 8) & 15); }
    }
    __syncthreads();
    LAS unsigned char* buck = F.lds + 139776; LAS float* tbl = (LAS float*)(F.lds + 140800);
    for (int i = F.tid; i < 1024; i += 512) buck[i] = (unsigned char)bucket_of(i);
    tbl[F.tid] = rel[F.tid] * 1.44269504f;
    __syncthreads();
    if ((MK_ATTN & 2) && (mask & 2)) for (int it = F.vb; it < 8 * 512; it += F.G) { const int b = it >> 9; int tg = it & 511; if (b & 1) tg = 511 - tg; dsa_group(p, b, tg * 8, F, buck, tbl, parts); }
}


#ifndef MK_PROBE
#define MK_PROBE 0
#endif

DI unsigned row16_maxu(unsigned m) { unsigned o;
    o = (unsigned)DPP_I((int)m, 0xB1); m = m > o ? m : o; o = (unsigned)DPP_I((int)m, 0x4E); m = m > o ? m : o;
    o = (unsigned)DPP_I((int)m, 0x141); m = m > o ? m : o; o = (unsigned)DPP_I((int)m, 0x140); m = m > o ? m : o; return m; }
DI void peer_route_tile(const Params& p, int t0, int lane) {
    unsigned char* ws = p.ws; const int c = lane & 15, q = lane >> 4;
    const bf16_t* QP = (const bf16_t*)(ws + WS_QP); const bf16_t* SK = (const bf16_t*)(ws + WS_SK); int* EIDX = (int*)(ws + WS_EIDX); float* EW = (float*)(ws + WS_EW);
    float* EU = (float*)(ws + WS_EU); const float* USr = (const float*)(ws + WS_PTV); const float* VSr = USr + 16384;
    int ca[4], cb[4]; bool cv[4];
    ca[0] = 0; cb[0] = c; cv[0] = true;
    ca[1] = c < 8 ? 1 : (c < 13 ? 2 : 3); cb[1] = c < 8 ? c : (c < 13 ? c - 8 : c - 13); cv[1] = true;
    { const int ci = 32 + c; int a_, b_;
      if (ci == 32) { a_ = 3; b_ = 3; } else if (ci < 36) { a_ = 4; b_ = ci - 33; } else if (ci < 42) { a_ = 5 + ((ci - 36) >> 1); b_ = (ci - 36) & 1; } else { a_ = 8 + (ci - 42); b_ = 0; }
      ca[2] = a_; cb[2] = b_; cv[2] = true; }
    ca[3] = c < 2 ? 14 + c : 0; cb[3] = 0; cv[3] = c < 2;
    for (int h = 0; h < 8; ++h) {
        unsigned top[2][4];
#pragma unroll
        for (int pp = 0; pp < 2; ++pp) {
            const int hp = h * 2 + pp;
            const bf16_t* ap = QP + (size_t)(t0 + c) * 1024 + hp * 64 + 8 * q;
            const bf16x8 a0 = *(const bf16x8*)ap, a1 = *(const bf16x8*)(ap + 32);
            unsigned v[4][8];
#pragma unroll
            for (int kt = 0; kt < 8; ++kt) { const bf16_t* bp = SK + ((size_t)hp * 128 + 16 * kt + c) * 64 + 8 * q;
                const bf16x8 b0 = *(const bf16x8*)bp, b1 = *(const bf16x8*)(bp + 32);
                f32x4 acc = {0.f, 0.f, 0.f, 0.f}; acc = MFMA16(a0, b0, acc); acc = MFMA16(a1, b1, acc);
#pragma unroll
                for (int i = 0; i < 4; ++i) v[i][kt] = (ordf(acc[i]) & 0xFFFFFF80u) | (unsigned)(127 - (16 * kt + c)); }
            { unsigned mine[4] = {0u, 0u, 0u, 0u};
              for (int r = 0; r < 16; ++r) {
#pragma unroll
                  for (int i = 0; i < 4; ++i) { unsigned m = v[i][0];
#pragma unroll
                      for (int kt = 1; kt < 8; ++kt) m = m > v[i][kt] ? m : v[i][kt];
                      m = row16_maxu(m); mine[i] = (c == r) ? m : mine[i];
#pragma unroll
                      for (int kt = 0; kt < 8; ++kt) v[i][kt] = (v[i][kt] == m) ? 0u : v[i][kt]; } }
#pragma unroll
              for (int i = 0; i < 4; ++i) top[pp][i] = mine[i]; }
        }
        unsigned cd[4][4], mine2[4] = {0u, 0u, 0u, 0u}; int i0v[4], i1v[4];
#pragma unroll
        for (int i = 0; i < 4; ++i) {
            const float s0 = unordf(top[0][i] & 0xFFFFFF80u), s1 = unordf(top[1][i] & 0xFFFFFF80u);
            i0v[i] = 127 - (int)(top[0][i] & 127u); i1v[i] = 127 - (int)(top[1][i] & 127u);
#pragma unroll
            for (int k = 0; k < 4; ++k) { const float s0a = __shfl(s0, (lane & 48) | ca[k]), s1b = __shfl(s1, (lane & 48) | cb[k]);
                cd[i][k] = cv[k] ? ((ordf(s0a + s1b) & 0xFFFFFF00u) | (unsigned)(255 - (ca[k] * 16 + cb[k]))) : 0u; }
        }
        for (int r = 0; r < 16; ++r) {
#pragma unroll
            for (int i = 0; i < 4; ++i) { unsigned m = cd[i][0];
#pragma unroll
                for (int k = 1; k < 4; ++k) m = m > cd[i][k] ? m : cd[i][k];
                m = row16_maxu(m); mine2[i] = (c == r) ? m : mine2[i];
#pragma unroll
                for (int k = 0; k < 4; ++k) cd[i][k] = (cd[i][k] == m) ? 0u : cd[i][k]; }
        }
#pragma unroll
        for (int i = 0; i < 4; ++i) {
            const unsigned mine = mine2[i];
            const int pr = 255 - (int)(mine & 255u); const int ea = __shfl(i0v[i], (lane & 48) | (pr >> 4)), eb = __shfl(i1v[i], (lane & 48) | (pr & 15));
            const float scv = unordf(mine & 0xFFFFFF00u);
            const float mx = row16_maxf(scv);
            const float e = __expf(scv - mx); const float sm = row16_sumf(e);
            const size_t o = (size_t)(t0 + 4 * q + i) * 128 + h * 16 + c;
            const int eid = ea * 128 + eb; EIDX[o] = eid; EW[o] = (e / sm) * VSr[eid]; EU[o] = USr[eid];
        }
    }
}
#define MFMA8(a, b, c) __builtin_amdgcn_mfma_f32_16x16x32_fp8_fp8((a), (b), (c), 0, 0, 0)
DI long lo64(const u32x4 v) { return (long)(((unsigned long long)v.y << 32) | v.x); }
DI long hi64(const u32x4 v) { return (long)(((unsigned long long)v.w << 32) | v.z); }
template <int OFF> DI void peer_dma_o(const unsigned char* src, LAS unsigned char* dst) { __builtin_amdgcn_global_load_lds((const unsigned*)src, (LAS unsigned*)(dst - OFF), 16, OFF, 0); }
#define PEER_RD(slot_) (*(const LAS u32x4*)(ring + 1024 * (slot_) + 16 * lane))
#define PEER_VMW(n_) asm volatile("s_waitcnt vmcnt(" #n_ ")" ::: "memory")
struct PeerStream { int u0, ustep, n, xfix; bool al; };
DI PeerStream peer_stream(const Frame& F) { PeerStream s; const int bx = blockIdx.x; s.al = (F.G & 7) == 0; s.u0 = s.al ? (bx >> 3) * 8 + F.wave : bx * 8 + F.wave; s.ustep = s.al ? F.G : F.G * 8;
    const int nu = s.al ? T : T * 8; s.n = (nu - s.u0 + s.ustep - 1) / s.ustep; s.xfix = bx & 7; return s; }
DI void peer_unit(const PeerStream& s, int k, int& t, int& x) { const int u = s.u0 + (k < s.n ? k : s.n - 1) * s.ustep; t = s.al ? u : u >> 3; x = s.al ? s.xfix : u & 7; }

DI void phase_peer_u(const Params& p, const Frame& F) {
    unsigned char* ws = p.ws; const int lane = F.lane, c = lane & 15, q = lane >> 4;
    LAS unsigned char* wl = F.lds + F.wave * LDS_PERWAVE; LAS float* pdl = (LAS float*)wl; LAS unsigned char* ring = wl + 512; LAS unsigned char* meta = wl + 512 + 16384;
    const PeerStream S = peer_stream(F);
    const unsigned char* EIDX = ws + WS_EIDX; const unsigned char* H8 = ws + WS_H8; float* PD = (float*)(ws + WS_PD); const unsigned char* PTU = ws + WS_PTU;
    int t, x;
#define PU_META(k_, slot_) do { peer_unit(S, (k_), t, x); const unsigned char* s_ = lane < 32 ? EIDX + (size_t)t * 512 + 16 * lane : H8 + (size_t)t * 1024 + 128 * x + 16 * (lane & 7); peer_dma_o<0>(s_, meta + 1024 * (slot_)); } while (0)
    PU_META(0, 0); PU_META(1, 1);
    asm volatile("s_waitcnt vmcnt(0)" ::: "memory");
    u32x4 in0, in1, hc0, hc1, hn0, hn1;
    { const u32x4 i00 = *(const LAS u32x4*)(meta + 32 * c), i01 = *(const LAS u32x4*)(meta + 32 * c + 16); hn0 = *(const LAS u32x4*)(meta + 512 + 16 * q); hn1 = *(const LAS u32x4*)(meta + 512 + 64 + 16 * q);
      peer_unit(S, 0, t, x); const unsigned char* tb = PTU + (size_t)x * PT_SLICE + 16 * q;
#define PU_D0(g) peer_dma_o<0>(tb + (size_t)((g) < 4 ? i00[(g) & 3] : i01[(g) & 3]) * 128, ring + 2048 * (g)); peer_dma_o<64>(tb + (size_t)((g) < 4 ? i00[(g) & 3] : i01[(g) & 3]) * 128, ring + 2048 * (g) + 1024)
      PU_D0(0); PU_D0(1); PU_D0(2); PU_D0(3); PU_D0(4); PU_D0(5); PU_D0(6); PU_D0(7);
#undef PU_D0
    }
    PEER_VMW(12);
    u32x4 rr[4];
#pragma unroll
    for (int i = 0; i < 4; ++i) rr[i] = PEER_RD(i);
    const f32x4 z4 = {0.f, 0.f, 0.f, 0.f};
    for (int k = 0; k < S.n; ++k) {
        int tc, xc; peer_unit(S, k, tc, xc);
        hc0 = hn0; hc1 = hn1;
        { LAS unsigned char* m1 = meta + 1024 * ((k + 1) & 1);
          in0 = *(const LAS u32x4*)(m1 + 32 * c); in1 = *(const LAS u32x4*)(m1 + 32 * c + 16); hn0 = *(const LAS u32x4*)(m1 + 512 + 16 * q); hn1 = *(const LAS u32x4*)(m1 + 512 + 64 + 16 * q); }
        LDS_WAIT(); PU_META(k + 2, k & 1);
        peer_unit(S, k + 1, t, x);
        const unsigned char* tbn = PTU + (size_t)x * PT_SLICE + 16 * q;
        f32x4 acc = z4;
#define PU_STEP(j) do { if ((j) < 12) PEER_VMW(12); else PEER_VMW(11); const u32x4 nw = PEER_RD(((j) + 4) & 15); \
            { const u32x4 hh = ((j) & 1) ? hc1 : hc0; acc = MFMA8(lo64(rr[(j) & 3]), lo64(hh), acc); acc = MFMA8(hi64(rr[(j) & 3]), hi64(hh), acc); } asm volatile("" :: "v"(rr[(j) & 3])); \
            peer_dma_o<64 * ((j) & 1)>(tbn + (size_t)(((j) >> 1) < 4 ? in0[((j) >> 1) & 3] : in1[((j) >> 1) & 3]) * 128, ring + 1024 * (j)); rr[(j) & 3] = nw; \
            if ((j) & 1) { if (c == 0) *(LAS f32x4*)(pdl + 16 * ((j) >> 1) + 4 * q) = acc; acc = z4; } } while (0)
        PU_STEP(0); PU_STEP(1); PU_STEP(2); PU_STEP(3); PU_STEP(4); PU_STEP(5); PU_STEP(6); PU_STEP(7);
        PU_STEP(8); PU_STEP(9); PU_STEP(10); PU_STEP(11); PU_STEP(12); PU_STEP(13); PU_STEP(14); PU_STEP(15);
#undef PU_STEP
        { const u32x2 pv = *(const LAS u32x2*)(pdl + 2 * lane); *(u32x2*)(PD + ((size_t)xc * T + tc) * 128 + 2 * lane) = pv; }
    }
#undef PU_META
    asm volatile("s_waitcnt vmcnt(0) lgkmcnt(0)" ::: "memory");
}

DI void phase_peer_coef(const Params& p, const Frame& F) {
    unsigned char* ws = p.ws; const float* PD = (const float*)(ws + WS_PD); const float* EW = (const float*)(ws + WS_EW); const float* EU = (const float*)(ws + WS_EU);
    const float* HSI = (const float*)(ws + WS_HSI); float* COEF = (float*)(ws + WS_COEF);
    const size_t NT = (size_t)F.G * 512;
    for (size_t i0 = (size_t)F.vb * 512 + F.tid; i0 < (size_t)T * 128; i0 += 4 * NT) {
        float d[4][8], ew[4], eu[4], hs[4];
#pragma unroll
        for (int r = 0; r < 4; ++r) { size_t i = i0 + r * NT; if (i >= (size_t)T * 128) i = i0; const int t = (int)(i >> 7), s = (int)(i & 127), pp = (s & 7) * 16 + (s >> 3);
#pragma unroll
            for (int x = 0; x < 8; ++x) d[r][x] = PD[((size_t)x * T + t) * 128 + pp];
            ew[r] = EW[i]; eu[r] = EU[i]; hs[r] = HSI[t]; }
#pragma unroll
        for (int r = 0; r < 4; ++r) { const size_t i = i0 + r * NT; if (i >= (size_t)T * 128) break;
            const float dot = ((d[r][0] + d[r][1]) + (d[r][2] + d[r][3])) + ((d[r][4] + d[r][5]) + (d[r][6] + d[r][7]));
            COEF[i] = ew[r] * gelu_t(dot * eu[r] * hs[r]); }
    }
}

DI void phase_peer_v(const Params& p, const Frame& F, const float* xin, float* xout) {
    unsigned char* ws = p.ws; const int lane = F.lane, c8 = lane & 7, r8 = lane >> 3;
    LAS unsigned char* wl = F.lds + F.wave * LDS_PERWAVE; LAS unsigned char* ring = wl; LAS unsigned char* meta = wl + 16384; LAS unsigned char* xs = wl + 16384 + 2048;
    const PeerStream S = peer_stream(F);
    const unsigned char* EIDX = ws + WS_EIDX; const unsigned char* COEF = ws + WS_COEF; const unsigned char* PTV = ws + WS_PTU + 16 * MiB;
    typedef float f32x2_t __attribute__((ext_vector_type(2)));
    int colofs;
    { const auto ra = __builtin_amdgcn_permlane32_swap(0u, 8u, false, false); const unsigned ta = ra[0];
      const auto rb = __builtin_amdgcn_permlane16_swap(ta, ta + 4u, false, false); const unsigned tb = rb[0];
      colofs = (int)tb + ((lane & 8) ? 2 : 0); }
    int t, x;
#define PV_META(k_, slot_) do { peer_unit(S, (k_), t, x); const unsigned char* s_ = (lane < 32 ? EIDX : COEF) + (size_t)t * 512 + 16 * (lane & 31); peer_dma_o<0>(s_, meta + 1024 * (slot_)); } while (0)
#define PV_XS(k_, slot_) do { peer_unit(S, (k_), t, x); if (lane < 32) peer_dma_o<0>((const unsigned char*)(xin + (size_t)t * 1024 + 128 * x) + 16 * lane, xs + 512 * (slot_)); } while (0)
    PV_META(0, 0); PV_META(1, 1); PV_XS(0, 0);
    asm volatile("s_waitcnt vmcnt(0)" ::: "memory");
    u32x4 in_[4]; f32x4 cf[4], cn[4];
    { u32x4 i0_[4];
#pragma unroll
      for (int v_ = 0; v_ < 4; ++v_) { i0_[v_] = *(const LAS u32x4*)(meta + 64 * r8 + 16 * v_); cn[v_] = *(const LAS f32x4*)(meta + 512 + 64 * r8 + 16 * v_); }
      peer_unit(S, 0, t, x); const unsigned char* tb = PTV + (size_t)x * PT_SLICE + 16 * c8;
#define PV_D0(j) peer_dma_o<0>(tb + (size_t)i0_[(j) >> 2][(j) & 3] * 128, ring + 1024 * (j))
      PV_D0(0); PV_D0(1); PV_D0(2); PV_D0(3); PV_D0(4); PV_D0(5); PV_D0(6); PV_D0(7); PV_D0(8); PV_D0(9); PV_D0(10); PV_D0(11); PV_D0(12); PV_D0(13); PV_D0(14); PV_D0(15);
#undef PV_D0
    }
    PEER_VMW(12);
    u32x4 rr[4];
#pragma unroll
    for (int i = 0; i < 4; ++i) rr[i] = PEER_RD(i);
    for (int k = 0; k < S.n; ++k) {
        int tc, xc; peer_unit(S, k, tc, xc);
#pragma unroll
        for (int v_ = 0; v_ < 4; ++v_) cf[v_] = cn[v_];
        { LAS unsigned char* m1 = meta + 1024 * ((k + 1) & 1);
#pragma unroll
          for (int v_ = 0; v_ < 4; ++v_) { in_[v_] = *(const LAS u32x4*)(m1 + 64 * r8 + 16 * v_); cn[v_] = *(const LAS f32x4*)(m1 + 512 + 64 * r8 + 16 * v_); } }
        LDS_WAIT(); PV_META(k + 2, k & 1);
        PV_XS(k + 1, (k + 1) & 1);
        peer_unit(S, k + 1, t, x);
        const unsigned char* tbn = PTV + (size_t)x * PT_SLICE + 16 * c8;
        f32x2_t out[8];
#pragma unroll
        for (int e = 0; e < 8; ++e) out[e] = (f32x2_t){0.f, 0.f};
#define PV_STEP(j) do { if ((j) < 12) PEER_VMW(13); else PEER_VMW(11); const u32x4 nw = PEER_RD(((j) + 4) & 15); \
            const u32x4 pv_ = rr[(j) & 3]; const float c1_ = cf[(j) >> 2][(j) & 3]; const f32x2_t cc = {c1_, c1_}; \
            out[0] += cc * __builtin_amdgcn_cvt_pk_f32_fp8((int)pv_.x, false); out[1] += cc * __builtin_amdgcn_cvt_pk_f32_fp8((int)pv_.x, true); \
            out[2] += cc * __builtin_amdgcn_cvt_pk_f32_fp8((int)pv_.y, false); out[3] += cc * __builtin_amdgcn_cvt_pk_f32_fp8((int)pv_.y, true); \
            out[4] += cc * __builtin_amdgcn_cvt_pk_f32_fp8((int)pv_.z, false); out[5] += cc * __builtin_amdgcn_cvt_pk_f32_fp8((int)pv_.z, true); \
            out[6] += cc * __builtin_amdgcn_cvt_pk_f32_fp8((int)pv_.w, false); out[7] += cc * __builtin_amdgcn_cvt_pk_f32_fp8((int)pv_.w, true); \
            asm volatile("" :: "v"(rr[(j) & 3])); \
            peer_dma_o<0>(tbn + (size_t)in_[(j) >> 2][(j) & 3] * 128, ring + 1024 * (j)); rr[(j) & 3] = nw; } while (0)
        PV_STEP(0); PV_STEP(1); PV_STEP(2); PV_STEP(3); PV_STEP(4); PV_STEP(5); PV_STEP(6); PV_STEP(7);
        PV_STEP(8); PV_STEP(9); PV_STEP(10); PV_STEP(11); PV_STEP(12); PV_STEP(13); PV_STEP(14); PV_STEP(15);
#undef PV_STEP
        float n8[8], n4[4], f2[2];
#pragma unroll
        for (int i = 0; i < 8; ++i) { const float a_ = (i & 1) ? out[i >> 1].y : out[i >> 1].x, b_ = (i & 1) ? out[4 + (i >> 1)].y : out[4 + (i >> 1)].x;
            const auto r_ = __builtin_amdgcn_permlane32_swap(__float_as_uint(a_), __float_as_uint(b_), false, false); n8[i] = __uint_as_float(r_[0]) + __uint_as_float(r_[1]); }
#pragma unroll
        for (int i = 0; i < 4; ++i) { const auto r_ = __builtin_amdgcn_permlane16_swap(__float_as_uint(n8[i]), __float_as_uint(n8[4 + i]), false, false); n4[i] = __uint_as_float(r_[0]) + __uint_as_float(r_[1]); }
#pragma unroll
        for (int i = 0; i < 2; ++i) { const bool hi8 = (lane & 8) != 0; const float keep = hi8 ? n4[2 + i] : n4[i], send = hi8 ? n4[i] : n4[2 + i];
            f2[i] = keep + __builtin_bit_cast(float, DPP_I(__builtin_bit_cast(int, send), 0x128)); }
        { const f32x2_t xv = *(const LAS f32x2_t*)(xs + 512 * (k & 1) + 4 * (16 * c8 + colofs));
          const f32x2_t o = {xv.x + f2[0], xv.y + f2[1]}; *(f32x2_t*)(xout + (size_t)tc * 1024 + 128 * xc + 16 * c8 + colofs) = o; }
    }
#undef PV_META
#undef PV_XS
    asm volatile("s_waitcnt vmcnt(0) lgkmcnt(0)" ::: "memory");
}
#undef PEER_RD
#undef PEER_VMW

#ifndef MK_MASK
#define MK_MASK 0xffff
#endif
__global__ void __launch_bounds__(512, 2) mega(Params p) {
    extern __shared__ __attribute__((aligned(16))) unsigned char lds_raw[];
#define MKFRAME() Frame F; { int t_ = threadIdx.x; asm volatile("" : "+v"(t_)); F.lds = (LAS unsigned char*)lds_raw; F.tid = t_; F.lane = t_ & 63; F.wave = __builtin_amdgcn_readfirstlane(t_ >> 6); \
        F.G = gridDim.x; const int bx = blockIdx.x; F.vb = (F.G % 8 == 0) ? (bx % 8) * (F.G / 8) + bx / 8 : bx; }
    if (threadIdx.x < 16) ((LAS unsigned*)((LAS unsigned char*)lds_raw + LDS_XB))[threadIdx.x] = 0u;
    __syncthreads();
    const int lo = p.ph_lo, hi = p.ph_hi;
    XcdBarrier bar; bar.bar = (unsigned*)(p.ws + WS_CTL) + 4096; bar.x = 0; bar.st = (volatile LAS unsigned*)((LAS unsigned char*)lds_raw + LDS_XB);
    if (hi - lo > 1) bar = xcd_barrier_post((unsigned*)(p.ws + WS_CTL) + 4096, (volatile LAS unsigned*)((LAS unsigned char*)lds_raw + LDS_XB));
#define WSP(ws) unsigned char* ws = p.ws; asm volatile("" : "+s"(ws))
    for (int l = 0; l < NLAYER; ++l) {
        const int pb = l * NPH;
#define IN(k) (((MK_MASK >> (k)) & 1) && lo <= pb + (k) && pb + (k) < hi)
#if MK_PROBE == 120
#define SEAM(k) do { if (((MK_MASK >> (k)) & 1) && lo <= pb + (k) && pb + (k) + 1 < hi) { xcd_barrier(bar); xcd_barrier(bar); xcd_barrier(bar); } } while (0)
#else
#define SEAM(k) do { if (((MK_MASK >> (k)) & 1) && lo <= pb + (k) && pb + (k) + 1 < hi) xcd_barrier(bar); } while (0)
#endif
        if (IN(0)) { MKFRAME(); phase_prep_w(p, l, F); }
        SEAM(0);
#if MK_PROBE == 100
        if (IN(0)) { MKFRAME(); phase_prep_w(p, l, F); } xcd_barrier(bar);
#endif
        if (IN(1)) { MKFRAME(); WSP(ws); pg8::Gemm g{(const bf16_t*)(ws + WS_H), (const bf16_t*)(ws + WS_WCAT), T, 9216, 1024}; XcdColOrder S{F.G, (int)blockIdx.x};
            Epi1 E{(bf16_t*)(ws + WS_PROJ), (bf16_t*)(ws + WS_GATES)};
            pg8::gemm_phase<Epi1, XcdColOrder, false>(F.lds, g, S, E, nullptr); }
        SEAM(1);
#if MK_PROBE == 104
        if (IN(1)) { for (int rr = 0; rr < 18; ++rr) { MKFRAME(); WSP(ws); pg8::Gemm g{(const bf16_t*)(ws + WS_H), (const bf16_t*)(ws + WS_WCAT), T, 9216, 1024}; RoundOrder S; S.base.init(T, 9216, F.G, (int)blockIdx.x); S.r = rr;
            Epi1 E{(bf16_t*)(ws + WS_PROJ), (bf16_t*)(ws + WS_GATES)};
            pg8::gemm_phase<Epi1, RoundOrder, false>(F.lds, g, S, E, nullptr); xcd_barrier(bar); } }
#endif
#if MK_PROBE == 101 || MK_PROBE == 102 || MK_PROBE == 103
        if (IN(1)) { MKFRAME(); WSP(ws); pg8::Gemm g{(const bf16_t*)(ws + WS_H), (const bf16_t*)(ws + WS_WCAT), T, 9216, 1024}; ColRangeOrder S{F.G, (int)blockIdx.x, MK_PROBE == 103 ? 20 : 0, MK_PROBE == 102 ? 20 : 36};
            Epi1 E{(bf16_t*)(ws + WS_PROJ), (bf16_t*)(ws + WS_GATES)};
            pg8::gemm_phase<Epi1, ColRangeOrder, false>(F.lds, g, S, E, nullptr); } xcd_barrier(bar);
#endif
        if (IN(2)) { MKFRAME(); phase_chunk(p, l, F); }
        SEAM(2);
        if (IN(3)) { MKFRAME(); WSP(ws);
            { pg8::Gemm g{(const bf16_t*)(ws + WS_CMPA), (const bf16_t*)(ws + WS_W1C), 4096, 512, 1024}; pg8::StaticOrder S; S.init(4096, 512, F.G, (int)blockIdx.x); EpiF32P E{(float*)(ws + WS_CMPP), 512};
              pg8::gemm_phase<EpiF32P, pg8::StaticOrder, false>(F.lds, g, S, E, nullptr); }
        }
        if (IN(3)) { MKFRAME(); WSP(ws);
            { pg8::Gemm g{(const bf16_t*)(ws + WS_CMPA) + (size_t)4096 * 1024, (const bf16_t*)(ws + WS_W1C) + (size_t)512 * 1024, 4096, 512, 1024}; pg8::StaticOrder S; S.init(4096, 512, F.G, (int)((blockIdx.x + F.G / 2) % F.G));
              EpiF32P E{(float*)(ws + WS_CMPP) + (size_t)4096 * 512, 512};
              pg8::gemm_phase<EpiF32P, pg8::StaticOrder, false>(F.lds, g, S, E, nullptr); }
        }
        SEAM(3);
        if (IN(4)) { MKFRAME(); phase_cmp2(p, l, F); }
        SEAM(4);
        if (IN(5)) { MKFRAME(); phase_attn(p, l, F, 3, 15); }
        SEAM(5);
#if MK_PROBE == 5 || MK_PROBE == 50 || MK_PROBE == 51 || MK_PROBE == 52 || MK_PROBE == 53
        if (IN(5)) { MKFRAME(); phase_attn(p, l, F, MK_PROBE == 5 ? 3 : (MK_PROBE == 50 ? 1 : 2), MK_PROBE == 52 ? 1 : (MK_PROBE == 53 ? 3 : 15)); xcd_barrier(bar); }
#endif
#if MK_PROBE >= 60 && MK_PROBE < 76
        if (IN(5)) { MKFRAME(); phase_attn(p, l, F, 1, (MK_PROBE - 60) << 8); xcd_barrier(bar); }
#endif
        if (IN(6)) { MKFRAME(); WSP(ws); pg8::Gemm g{(const bf16_t*)(ws + WS_Y), (const bf16_t*)(ws + WS_WBR), 4 * T, 4096, 512}; BranchOrder S{F.G, (int)blockIdx.x};
            EpiBranch E{(const bf16_t*)(ws + WS_GATES), (bf16_t*)(ws + WS_MERGED)};
            pg8::gemm_phase<EpiBranch, BranchOrder, false>(F.lds, g, S, E, nullptr); }
        SEAM(6);
#if MK_PROBE == 106
        if (IN(6)) { MKFRAME(); WSP(ws); pg8::Gemm g{(const bf16_t*)(ws + WS_Y), (const bf16_t*)(ws + WS_WBR), 4 * T, 4096, 512}; BranchOrder S{F.G, (int)blockIdx.x};
            EpiBranch E{(const bf16_t*)(ws + WS_GATES), (bf16_t*)(ws + WS_MERGED)};
            pg8::gemm_phase<EpiBranch, BranchOrder, false>(F.lds, g, S, E, nullptr); } xcd_barrier(bar);
#endif
        if (IN(7)) { MKFRAME(); WSP(ws); pg8::Gemm g{(const bf16_t*)(ws + WS_MERGED), (const bf16_t*)(ws + WS_WOUT4), T, 1024, 1024}; pg8::StaticOrder S; S.init(T, 1024, F.G, (int)blockIdx.x);
            EpiRes E{l == 0 ? p.in[I_X] : p.out, p.out};
            pg8::gemm_phase<EpiRes, pg8::StaticOrder, false>(F.lds, g, S, E, nullptr); }
        SEAM(7);
        if (IN(8)) { MKFRAME(); WSP(ws); rmsnorm_rows(p.out, p.in[I_GFFN] + l * 1024, (bf16_t*)(ws + WS_H), F.vb * 8 + F.wave, F.G * 8, F.lane, ws + WS_H8, (float*)(ws + WS_HSI)); }
        SEAM(8);
#if MK_PROBE == 108
        if (IN(8)) { MKFRAME(); WSP(ws); rmsnorm_rows(p.out, p.in[I_GFFN] + l * 1024, (bf16_t*)(ws + WS_H), F.vb * 8 + F.wave, F.G * 8, F.lane); } xcd_barrier(bar);
#endif
        if (IN(9)) { MKFRAME(); WSP(ws);
            { pg8::Gemm g{(const bf16_t*)(ws + WS_H), (const bf16_t*)(ws + WS_WQ), T, 1024, 1024}; pg8::StaticOrder S; S.init(T, 1024, F.G, (int)blockIdx.x); EpiBf E{(bf16_t*)(ws + WS_QP), 1024};
              pg8::gemm_phase<EpiBf, pg8::StaticOrder, false>(F.lds, g, S, E, nullptr); }
        }
        if (IN(9)) { MKFRAME(); WSP(ws);
            { pg8::Gemm g{(const bf16_t*)(ws + WS_PB), (const bf16_t*)(ws + WS_WPP), T, 1024, 256}; pg8::StaticOrder S; S.init(T, 1024, F.G, (int)blockIdx.x); EpiBf E{(bf16_t*)(ws + WS_PP), 1024};
              pg8::gemm_phase<EpiBf, pg8::StaticOrder, false>(F.lds, g, S, E, nullptr); }
        }
        SEAM(9);
#if MK_PROBE == 110
        if (IN(9)) { for (int rep = 0; rep < 9; ++rep) { MKFRAME(); WSP(ws);
            { pg8::Gemm g{(const bf16_t*)(ws + WS_H), (const bf16_t*)(ws + WS_WQ), T, 1024, 1024}; pg8::StaticOrder S; S.init(T, 1024, F.G, (int)blockIdx.x); EpiBf E{(bf16_t*)(ws + WS_QP), 1024};
              pg8::gemm_phase<EpiBf, pg8::StaticOrder, false>(F.lds, g, S, E, nullptr); } } xcd_barrier(bar); }
#endif
#if MK_PROBE == 109
        if (IN(9)) { MKFRAME(); WSP(ws);
            { pg8::Gemm g{(const bf16_t*)(ws + WS_H), (const bf16_t*)(ws + WS_WQ), T, 1024, 1024}; pg8::StaticOrder S; S.init(T, 1024, F.G, (int)blockIdx.x); EpiBf E{(bf16_t*)(ws + WS_QP), 1024};
              pg8::gemm_phase<EpiBf, pg8::StaticOrder, false>(F.lds, g, S, E, nullptr); } }
        if (IN(9)) { MKFRAME(); WSP(ws);
            { pg8::Gemm g{(const bf16_t*)(ws + WS_PB), (const bf16_t*)(ws + WS_WPP), T, 1024, 256}; pg8::StaticOrder S; S.init(T, 1024, F.G, (int)blockIdx.x); EpiBf E{(bf16_t*)(ws + WS_PP), 1024};
              pg8::gemm_phase<EpiBf, pg8::StaticOrder, false>(F.lds, g, S, E, nullptr); } }
        xcd_barrier(bar);
#endif
        if (IN(10)) { MKFRAME(); for (int tile = F.vb * 8 + F.wave; tile < T / 16; tile += F.G * 8) peer_route_tile(p, tile * 16, F.lane); }
        SEAM(10);
        if (IN(11)) { MKFRAME(); phase_peer_u(p, F); }
        SEAM(11);
        if (IN(12)) { MKFRAME(); phase_peer_coef(p, F); }
        SEAM(12);
        if (IN(13)) { MKFRAME(); phase_peer_v(p, F, p.out, p.out); }
        SEAM(13);
        if (IN(14)) { MKFRAME(); WSP(ws); rmsnorm_rows(p.out, p.in[I_GPLE] + l * 1024, (bf16_t*)(ws + WS_H), F.vb * 8 + F.wave, F.G * 8, F.lane); }
        SEAM(14);
        if (IN(15)) { MKFRAME(); WSP(ws); pg8::Gemm g{(const bf16_t*)(ws + WS_H), (const bf16_t*)(ws + WS_WPG), T, 1024, 1024}; pg8::StaticOrder S; S.init(T, 1024, F.G, (int)blockIdx.x);
            EpiPle E{p.out, (const bf16_t*)(ws + WS_PP)};
            pg8::gemm_phase<EpiPle, pg8::StaticOrder, false>(F.lds, g, S, E, nullptr); }
        SEAM(15);
#undef IN
#undef SEAM
    }
}
}

#ifndef MK_LAUNCH_PER_PHASE
#define MK_LAUNCH_PER_PHASE 0
#endif
extern "C" void kernel_launch(void* const* d_in, const int* in_sizes, int n_in, void* d_out, int out_size, void* d_ws, size_t ws_size, hipStream_t stream) {
    static int grid = 0;
    if (grid == 0) {
        if (n_in != 27 || ws_size < mk::WS_END) { fprintf(stderr, "kernel_launch: need 27 inputs and >= %zu bytes of workspace (got %d, %zu)\n", (size_t)mk::WS_END, n_in, ws_size); grid = -1; return; }
        int dev = 0, cus = 0;
        if (hipGetDevice(&dev) != hipSuccess || hipDeviceGetAttribute(&cus, hipDeviceAttributeMultiprocessorCount, dev) != hipSuccess) { grid = -1; return; }
        if (hipFuncSetAttribute((const void*)mk::mega, hipFuncAttributeMaxDynamicSharedMemorySize, mk::LDS_BYTES) != hipSuccess) { fprintf(stderr, "kernel_launch: hipFuncSetAttribute failed\n"); grid = -1; return; }
        int per_cu = 0;
        if (hipOccupancyMaxActiveBlocksPerMultiprocessor(&per_cu, (const void*)mk::mega, 512, mk::LDS_BYTES) != hipSuccess || per_cu < 1) fprintf(stderr, "kernel_launch: occupancy query says %d\n", per_cu);
        (void)hipGetLastError();
        grid = cus;
    }
    if (grid < 0) return;
    (void)in_sizes; (void)out_size;
    hipMemsetAsync((char*)d_ws + mk::WS_CTL, 0, 1u << 20, stream);
    mk::Params prm{};
    for (int i = 0; i < 27; ++i) prm.in[i] = (const float*)d_in[i];
    prm.out = (float*)d_out; prm.ws = (unsigned char*)d_ws;
#if MK_LAUNCH_PER_PHASE
    for (int ph = 0; ph < mk::NLAYER * mk::NPH; ++ph) { prm.ph_lo = ph; prm.ph_hi = ph + 1; hipLaunchKernelGGL(mk::mega, dim3(grid), dim3(512), mk::LDS_BYTES, stream, prm); }
#else
    prm.ph_lo = 0; prm.ph_hi = mk::NLAYER * mk::NPH; hipLaunchKernelGGL(mk::mega, dim3(grid), dim3(512), mk::LDS_BYTES, stream, prm);
#endif
}
```

```cpp
#include <hip/hip_runtime.h>
#include <stdio.h>
#include <stdint.h>
namespace pg8 {
#define PG8_LAS __attribute__((address_space(3)))
typedef unsigned short bf16_t;
typedef short bf16x8 __attribute__((ext_vector_type(8)));
typedef float f32x4 __attribute__((ext_vector_type(4)));
typedef unsigned u32x4 __attribute__((ext_vector_type(4)));
constexpr int BM = 256, BK = 64, HALF = 128, HTB = HALF * BK * 2  , STAGE_BYTES = 8 * HTB, NXCD = 8, WGM = 8;

__host__ __device__ __forceinline__ int lds_byte(int r, int c) { const int st = (r >> 4) * 2 + (c >> 5), rr = r & 15, cc = c & 31, ob = rr * 64 + cc * 2; return st * 1024 + (ob ^ (((ob >> 9) & 1) << 5)); }
__host__ __device__ __forceinline__ void stage_rc(int b, int& R, int& C) { const int st = b / 1024, sb = b % 1024, swz = sb ^ (((sb >> 9) & 1) << 5); R = (st >> 1) * 16 + swz / 64; C = (st & 1) * 32 + (swz % 64) / 2; }
__host__ __device__ __forceinline__ int perm32(int rho) { const int n = rho >> 4, i = rho & 15; return 8 * (i >> 2) + 4 * n + (i & 3); }

struct Unit { int pm, pn; };
struct Gemm { const bf16_t* A; const bf16_t* Bt; int M, N, K; };

struct StaticOrder {
    int nM, nN, nwg, G, c;
    __host__ __device__ void init(int M, int N, int G_, int c_) { nM = M / BM; nN = N / BM; nwg = nM * nN; G = G_; c = c_; }
    __host__ __device__ bool next(int i, Unit& u) const {
        const long L = (long)i * G + c; if (L >= nwg) return false;
        int wgid = (int)L; { const int q = nwg / NXCD, r = nwg % NXCD, xcd = wgid % NXCD, off = wgid / NXCD; wgid = (xcd < r ? xcd * (q + 1) : r * (q + 1) + (xcd - r) * q) + off; }
        const int nig = WGM * nN, gid = wgid / nig, fm = gid * WGM, gsz = (nM - fm) < WGM ? (nM - fm) : WGM;
        u.pm = fm + ((wgid % nig) % gsz); u.pn = (wgid % nig) / gsz; return true;
    }
    __device__ __forceinline__ void a_ready(const Unit&) const {}
    __device__ __forceinline__ void done(const Unit&) const {}
};
__device__ __forceinline__ unsigned cvt_pk_bf16(float lo, float hi) { unsigned r; asm volatile("v_cvt_pk_bf16_f32 %0, %1, %2" : "=v"(r) : "v"(lo), "v"(hi)); return r; }
template <class Epi, class Sched, bool STAMP = false>
__device__ __forceinline__ void gemm_phase(PG8_LAS unsigned char* lds, const Gemm g, const Sched& S, const Epi& E, unsigned long long* stamps) {
    int tid_l = threadIdx.x; asm volatile("" : "+v"(tid_l));
    const int tid = tid_l, wid = __builtin_amdgcn_readfirstlane(tid >> 6), lane = tid & 63, wr = wid >> 2, wc = wid & 3, fr = lane & 15, fq = lane >> 4;
    const int K = g.K, nt = K / BK;
    int ts_lo = 0, ts_hi = 0, nts = 0; const unsigned long long rt_entry = STAMP ? (unsigned long long)wall_clock64() : 0ull;
#define PG8_STAMP() do { if (STAMP && wid == 0 && nts < 64) { const unsigned long long _c = (unsigned long long)clock64(); \
        ts_lo = (lane == nts) ? (int)(unsigned)_c : ts_lo; ts_hi = (lane == nts) ? (int)(unsigned)(_c >> 32) : ts_hi; ++nts; } } while (0)
    PG8_STAMP();
    unsigned voffA[2], voffB[2];
#pragma unroll
    for (int i = 0; i < 2; ++i) { int R, C; stage_rc(tid * 16 + i * 8192, R, C); const int Rb = Epi::PERM ? ((R & ~31) + perm32(R & 31)) : R;
        voffA[i] = (unsigned)(R * K + C) * 2u; voffB[i] = (unsigned)(Rb * K + C) * 2u; }
    const size_t kstep = (size_t)(BK * 2);
    const size_t hstep = (size_t)HALF * K * 2;
    const size_t tstep = 2 * hstep;
    const unsigned ldsw = (unsigned)wid * 1024u;
    const int aoff = lds_byte(wr * 64 + fr, fq * 8), boff = lds_byte(wc * 32 + fr, fq * 8);
#define PG8_SA(b, h) (((b) * 2 + (h)) * HTB)
#define PG8_SB(b, h) ((4 + (b) * 2 + (h)) * HTB)
#define PG8_STAGE(bufoff, gbase, voff) do { _Pragma("unroll") for (int _i = 0; _i < 2; ++_i) \
        __builtin_amdgcn_global_load_lds((const unsigned*)((const char*)(gbase) + (voff)[_i]), (PG8_LAS unsigned*)(lds + (bufoff) + ldsw + _i * 8192), 16, 0, 0); } while (0)
#define PG8_LDA(dst, b, h) do { _Pragma("unroll") for (int m = 0; m < 4; ++m) _Pragma("unroll") for (int k = 0; k < 2; ++k) dst[m][k] = *(const PG8_LAS bf16x8*)(lds + PG8_SA(b, h) + aoff + m * 2048 + k * 1024); } while (0)
#define PG8_LDB(dst, b, h) do { _Pragma("unroll") for (int n = 0; n < 2; ++n) _Pragma("unroll") for (int k = 0; k < 2; ++k) dst[n][k] = *(const PG8_LAS bf16x8*)(lds + PG8_SB(b, h) + boff + n * 2048 + k * 1024); } while (0)
#define PG8_MMA(ai, bj, At, Bt) do { __builtin_amdgcn_s_setprio(1); _Pragma("unroll") for (int m = 0; m < 4; ++m) _Pragma("unroll") for (int n = 0; n < 2; ++n) _Pragma("unroll") for (int k = 0; k < 2; ++k) \
        acc[ai][bj][m][n] = __builtin_amdgcn_mfma_f32_16x16x32_bf16(Bt[n][k], At[m][k], acc[ai][bj][m][n], 0, 0, 0); __builtin_amdgcn_s_setprio(0); } while (0)
#define PG8_WAIT_V(n) asm volatile("s_waitcnt vmcnt(" #n ")" ::: "memory")
#define PG8_WAIT_L(n) asm volatile("s_waitcnt lgkmcnt(" #n ")" ::: "memory")
#define PG8_BAR __builtin_amdgcn_s_barrier()
#define PG8_SCHED __builtin_amdgcn_sched_barrier(0)
    Unit cur, nxt; int ui = 0;
    if (!S.next(0, cur)) return;
    f32x4 acc[2][2][4][2];
#pragma unroll
    for (int a = 0; a < 2; ++a)
#pragma unroll
        for (int b = 0; b < 2; ++b)
#pragma unroll
            for (int m = 0; m < 4; ++m)
#pragma unroll
                for (int n = 0; n < 2; ++n) acc[a][b][m][n] = (f32x4){0.f, 0.f, 0.f, 0.f};
    bf16x8 At[4][2], B0[2][2], B1[2][2];
    const char* cA = (const char*)g.A + (size_t)cur.pm * tstep; const char* cB = (const char*)g.Bt + (size_t)cur.pn * tstep;
    S.a_ready(cur);
    PG8_STAGE(PG8_SB(0, 0), cB, voffB); PG8_STAGE(PG8_SA(0, 0), cA, voffA); PG8_STAGE(PG8_SB(0, 1), cB + hstep, voffB); PG8_STAGE(PG8_SA(0, 1), cA + hstep, voffA);
    if (wr == 1) PG8_BAR;
    PG8_WAIT_V(4); PG8_BAR;
    PG8_STAGE(PG8_SB(1, 0), cB + kstep, voffB); PG8_STAGE(PG8_SA(1, 0), cA + kstep, voffA); PG8_STAGE(PG8_SB(1, 1), cB + hstep + kstep, voffB);
    PG8_WAIT_V(6); PG8_BAR;
    PG8_STAMP();
    for (;;) {
        const bool has_next = S.next(ui + 1, nxt);
        const char* nA = has_next ? (const char*)g.A + (size_t)nxt.pm * tstep : cA; const char* nB = has_next ? (const char*)g.Bt + (size_t)nxt.pn * tstep : cB;
        for (int t = 0; t < nt; t += 2) {
            const bool last = (t == nt - 2);
            const char* a1 = cA + (size_t)(t + 1) * kstep;
            const char* a2 = last ? nA : cA + (size_t)(t + 2) * kstep; const char* b2 = last ? nB : cB + (size_t)(t + 2) * kstep;
            const char* a3 = a2 + kstep; const char* b3 = b2 + kstep;
            if (last && has_next) S.a_ready(nxt);
            PG8_LDB(B0, 0, 0); PG8_SCHED; PG8_LDA(At, 0, 0); PG8_STAGE(PG8_SA(1, 1), a1 + hstep, voffA);
            PG8_WAIT_L(8); PG8_BAR; PG8_WAIT_L(0); PG8_MMA(0, 0, At, B0); PG8_BAR; PG8_SCHED;
            PG8_LDB(B1, 0, 1); PG8_STAGE(PG8_SB(0, 0), b2, voffB);
            PG8_BAR; PG8_WAIT_L(0); PG8_MMA(0, 1, At, B1); PG8_BAR;
            PG8_LDA(At, 0, 1); PG8_STAGE(PG8_SA(0, 0), a2, voffA);
            PG8_BAR; PG8_WAIT_L(0); PG8_MMA(1, 0, At, B0); PG8_BAR; PG8_SCHED;
            PG8_STAGE(PG8_SB(0, 1), b2 + hstep, voffB);
            PG8_WAIT_V(6); PG8_BAR; PG8_MMA(1, 1, At, B1); PG8_BAR;
            PG8_LDB(B0, 1, 0); PG8_SCHED; PG8_LDA(At, 1, 0); PG8_STAGE(PG8_SA(0, 1), a2 + hstep, voffA);
            PG8_WAIT_L(8); PG8_BAR; PG8_WAIT_L(0); PG8_MMA(0, 0, At, B0); PG8_BAR; PG8_SCHED;
            PG8_LDB(B1, 1, 1); PG8_STAGE(PG8_SB(1, 0), b3, voffB);
            PG8_BAR; PG8_WAIT_L(0); PG8_MMA(0, 1, At, B1); PG8_BAR;
            PG8_LDA(At, 1, 1); PG8_STAGE(PG8_SA(1, 0), a3, voffA);
            PG8_BAR; PG8_WAIT_L(0); PG8_MMA(1, 0, At, B0); PG8_BAR; PG8_SCHED;
            PG8_STAGE(PG8_SB(1, 1), b3 + hstep, voffB);
            PG8_WAIT_V(6); PG8_BAR; PG8_MMA(1, 1, At, B1); PG8_BAR;
        }
        PG8_STAMP();
        if constexpr (!Epi::AFTER_DRAIN) { E(acc, cur, wr, wc, fr, fq); S.done(cur); }
        PG8_STAMP();
        if (!has_next) break;
#pragma unroll
        for (int a = 0; a < 2; ++a)
#pragma unroll
            for (int b = 0; b < 2; ++b)
#pragma unroll
                for (int m = 0; m < 4; ++m)
#pragma unroll
                    for (int n = 0; n < 2; ++n) acc[a][b][m][n] = (f32x4){0.f, 0.f, 0.f, 0.f};
        cur = nxt; cA = nA; cB = nB; ++ui;
    }
    PG8_WAIT_V(0);
    if (wr == 0) PG8_BAR;
    PG8_BAR;
    if constexpr (Epi::AFTER_DRAIN) { E.fused(acc, cur, wr, wc, fr, fq, lds, wid, lane); S.done(cur); }
    PG8_STAMP();
    if (STAMP && wid == 0) { stamps[lane] = lane < nts ? (((unsigned long long)(unsigned)ts_hi << 32) | (unsigned)ts_lo) : 0ull;
        if (lane == 62) stamps[62] = rt_entry; if (lane == 63) stamps[63] = (unsigned long long)wall_clock64(); }
#undef PG8_STAMP
#undef PG8_SA
#undef PG8_SB
#undef PG8_STAGE
#undef PG8_LDA
#undef PG8_LDB
#undef PG8_MMA
#undef PG8_WAIT_V
#undef PG8_WAIT_L
#undef PG8_BAR
#undef PG8_SCHED
}
}
#define XB_TMO      128
#define XB_XCNT(j)  (256  + 64 * (j))
#define XB_XSUB(j)  (1280 + 64 * (j))
#define XB_XGEN(j)  (2304 + 64 * (j))
#define XB_TOP      3328
#define XB_TOPGEN   3392
#define XCD_BAR_WORDS 3456
#define XB_SPIN_CAP (1u << 18)
#define LAS __attribute__((address_space(3)))

__device__ __forceinline__ unsigned xb_ld(unsigned* p)              { return __hip_atomic_load(p, __ATOMIC_RELAXED, __HIP_MEMORY_SCOPE_AGENT); }
__device__ __forceinline__ unsigned xb_add(unsigned* p, unsigned v) { return __hip_atomic_fetch_add(p, v, __ATOMIC_RELAXED, __HIP_MEMORY_SCOPE_AGENT); }
__device__ __forceinline__ unsigned xb_xcc_id() { return (unsigned)__builtin_amdgcn_s_getreg((3 << 11) | 20) & 0xFu; }
#define XB_SPIN(cond, bar) do { unsigned _sp = 0; while (cond) { __builtin_amdgcn_s_sleep(1); \
    if ((++_sp & 255u) == 0u) { if (xb_ld(&(bar)[XB_TMO])) break; if (_sp > XB_SPIN_CAP) { atomicAdd(&(bar)[XB_TMO], 1u); break; } } } } while (0)

struct XcdBarrier {
    unsigned* bar; unsigned x;
    volatile LAS unsigned* st;
};

__device__ __forceinline__ XcdBarrier xcd_barrier_post(unsigned* bar, volatile LAS unsigned* st) {
    XcdBarrier b; b.bar = bar; b.x = xb_xcc_id(); b.st = st;
    if (threadIdx.x == 0) (void)xb_add(&bar[XB_XCNT(b.x)], 1u);
    return b;
}
__device__ __forceinline__ void xcd_barrier_complete(unsigned* bar, unsigned x, unsigned& nloc, unsigned& nx) {
    const unsigned G = gridDim.x * gridDim.y * gridDim.z;
    unsigned sum, cnt, mine, sp = 0u;
    for (;;) {
        sum = 0u; cnt = 0u; mine = 0u;
#pragma unroll
        for (unsigned j = 0; j < 16; ++j) { const unsigned c = xb_ld(&bar[XB_XCNT(j)]); sum += c; cnt += (c > 0u) ? 1u : 0u; mine = (j == x) ? c : mine; }
        if (sum == G) break;
        __builtin_amdgcn_s_sleep(1);
        if ((++sp & 255u) == 0u) { if (xb_ld(&bar[XB_TMO])) break; if (sp > XB_SPIN_CAP) { atomicAdd(&bar[XB_TMO], 1u); break; } }
    }
    nloc = mine > 0u ? mine : 1u; nx = cnt > 0u ? cnt : 1u;
}

__device__ __forceinline__ void xcd_barrier(const XcdBarrier& b) {
    asm volatile("s_waitcnt vmcnt(0)" ::: "memory");
    __syncthreads();
    if (threadIdx.x == 0) {
        unsigned* bar = b.bar;
        __builtin_amdgcn_s_waitcnt(0);
        unsigned nloc = b.st[0], nx = b.st[1];
        if (nloc == 0u) { xcd_barrier_complete(bar, b.x, nloc, nx); b.st[0] = nloc; b.st[1] = nx; }
        const unsigned old = xb_add(&bar[XB_XSUB(b.x)], 1u);
        const unsigned gen = old / nloc;
        if (old + 1u == (gen + 1u) * nloc) {
            __builtin_amdgcn_fence(__ATOMIC_RELEASE, "agent");
            asm volatile("s_waitcnt vmcnt(0)" ::: "memory");
            const unsigned og = xb_add(&bar[XB_TOP], 1u);
            const unsigned tg = og / nx;
            if (og + 1u == (tg + 1u) * nx) xb_add(&bar[XB_TOPGEN], 1u);
            else XB_SPIN(xb_ld(&bar[XB_TOPGEN]) == tg, bar);
            __builtin_amdgcn_fence(__ATOMIC_ACQUIRE, "agent");
            xb_add(&bar[XB_XGEN(b.x)], 1u);
            asm volatile("s_waitcnt vmcnt(0)" ::: "memory");
        } else {
            XB_SPIN(xb_ld(&bar[XB_XGEN(b.x)]) == gen, bar);
            __builtin_amdgcn_fence(__ATOMIC_ACQUIRE, "agent");
            asm volatile("s_waitcnt vmcnt(0)" ::: "memory");
        }
    }
    __syncthreads();
}

namespace mk {
using pg8::bf16_t; using pg8::bf16x8; using pg8::f32x4; using pg8::u32x4;
typedef unsigned u32x2 __attribute__((ext_vector_type(2)));
typedef short s16x4 __attribute__((ext_vector_type(4)));
#define DI __device__ __forceinline__
#define LDS_WAIT() asm volatile("s_waitcnt lgkmcnt(0)" ::: "memory")
#define LDS_FENCE() asm volatile("" ::: "memory")
#define MFMA16(a, b, c) __builtin_amdgcn_mfma_f32_16x16x32_bf16((a), (b), (c), 0, 0, 0)

constexpr int T = 32768, SEQ = 4096, NLAYER = 4, NPH = 16;
constexpr int PW = 5120;
constexpr int C_AB = 0, C_AC = 512, C_AX = 1024, C_NQ = 1536, C_NKV = 2048, C_UV = 2816, C_DQ = 3840, C_DK = 4352, C_DV = 4416,
              C_DQI = 4480, C_DKI = 4992, C_NG = 5056, C_DWI = 5080;
constexpr size_t MiB = 1u << 20;
constexpr size_t WS_CTL = 0, WS_PEB = 1 * MiB, WS_CMPK = 2 * MiB, WS_CMPV = 3 * MiB, WS_SK = 4 * MiB, WS_SGUW = 5 * MiB, WS_CMPA = 8 * MiB,
                 WS_CMPP = 24 * MiB, WS_WCAT = 40 * MiB, WS_WBR = 58 * MiB, WS_WOUT4 = 62 * MiB, WS_WQ = 70 * MiB, WS_WPG = 72 * MiB,
                 WS_WPP = 74 * MiB, WS_W1C = 75 * MiB, WS_PB = 78 * MiB, WS_PTU = 96 * MiB, WS_PTV = 128 * MiB, WS_H = 160 * MiB,
                 WS_Y = 224 * MiB, WS_PROJ = 352 * MiB, WS_GATES = 672 * MiB,
                 WS_KS = 928 * MiB, WS_VS = 936 * MiB, WS_KW = 944 * MiB, WS_VW = 952 * MiB, WS_DK = 960 * MiB, WS_DV = 964 * MiB, WS_DKI = 968 * MiB, WS_END = 972 * MiB;
constexpr size_t WS_ACCF = WS_PROJ, WS_MERGED = WS_PROJ + 128 * MiB, WS_QP = WS_PROJ, WS_PP = WS_PROJ + 64 * MiB, WS_EIDX = WS_PROJ + 128 * MiB, WS_EW = WS_PROJ + 144 * MiB, WS_EU = WS_PROJ + 160 * MiB;
constexpr size_t WS_COEF = WS_PROJ + 176 * MiB, WS_H8 = WS_PROJ + 192 * MiB, WS_HSI = WS_PROJ + 224 * MiB, WS_PD = WS_GATES, PT_SLICE = 2 * MiB;
constexpr int LDS_BYTES = 163840, LDS_PERWAVE = 19456, LDS_BUCK = 8 * LDS_PERWAVE, LDS_TBL = LDS_BUCK + 4096, LDS_XB = LDS_BYTES - 64;

struct Params { const float* in[27]; float* out; unsigned char* ws; int ph_lo, ph_hi; };
enum { I_X = 0, I_P, I_REL, I_GMIX, I_WIN, I_CONVW, I_PE, I_CW1, I_CW2, I_NQG, I_NKG, I_LNG, I_SGUW, I_SGUB, I_DQG, I_DKG, I_WGATE, I_WBR, I_WOUT,
       I_GFFN, I_WQ, I_SUBK, I_PU, I_PV, I_GPLE, I_WPG, I_WPP };

struct Frame { LAS unsigned char* lds; int tid, lane, wave, vb, G; };

DI float bf2f(unsigned short b) { return __uint_as_float(((unsigned)b) << 16); }
DI unsigned f2bf(float f) { unsigned u = __float_as_uint(f); return (u + 0x7fffu + ((u >> 16) & 1u)) >> 16; }
DI unsigned pk2(float lo, float hi) { return pg8::cvt_pk_bf16(lo, hi); }
DI float lo16(unsigned w) { return __uint_as_float(w << 16); }
DI float hi16(unsigned w) { return __uint_as_float(w & 0xffff0000u); }
DI float sigm(float x) { return __builtin_amdgcn_rcpf(1.f + __builtin_amdgcn_exp2f(-1.44269504f * x)); }
DI float gelu_t(float x) { const float y = (-2.f * 0.7978845608f * 1.44269504f) * (x + 0.044715f * x * x * x); return x * __builtin_amdgcn_rcpf(1.f + __builtin_amdgcn_exp2f(y)); }
#define DPP_I(x, ctrl) __builtin_amdgcn_update_dpp(0, (x), (ctrl), 0xF, 0xF, false)
DI float dppf(float x, int) { return x; }
DI float row16_sumf(float v) { v += __builtin_bit_cast(float, DPP_I(__builtin_bit_cast(int, v), 0xB1)); v += __builtin_bit_cast(float, DPP_I(__builtin_bit_cast(int, v), 0x4E));
    v += __builtin_bit_cast(float, DPP_I(__builtin_bit_cast(int, v), 0x141)); v += __builtin_bit_cast(float, DPP_I(__builtin_bit_cast(int, v), 0x140)); return v; }
DI float row16_maxf(float v) { v = fmaxf(v, __builtin_bit_cast(float, DPP_I(__builtin_bit_cast(int, v), 0xB1))); v = fmaxf(v, __builtin_bit_cast(float, DPP_I(__builtin_bit_cast(int, v), 0x4E)));
    v = fmaxf(v, __builtin_bit_cast(float, DPP_I(__builtin_bit_cast(int, v), 0x141))); v = fmaxf(v, __builtin_bit_cast(float, DPP_I(__builtin_bit_cast(int, v), 0x140))); return v; }
DI float quad_sumf(float v) { v += __builtin_bit_cast(float, DPP_I(__builtin_bit_cast(int, v), 0xB1)); v += __builtin_bit_cast(float, DPP_I(__builtin_bit_cast(int, v), 0x4E)); return v; }
DI float oct_sumf(float v) { v = quad_sumf(v); v += __builtin_bit_cast(float, DPP_I(__builtin_bit_cast(int, v), 0x141)); return v; }
DI float x16_sum(float v) { const unsigned u = __float_as_uint(v); const auto r = __builtin_amdgcn_permlane16_swap(u, u, false, false); return __uint_as_float(r[0]) + __uint_as_float(r[1]); }
DI float x32_sum(float v) { const unsigned u = __float_as_uint(v); const auto r = __builtin_amdgcn_permlane32_swap(u, u, false, false); return __uint_as_float(r[0]) + __uint_as_float(r[1]); }
DI float x16_max(float v) { const unsigned u = __float_as_uint(v); const auto r = __builtin_amdgcn_permlane16_swap(u, u, false, false); return fmaxf(__uint_as_float(r[0]), __uint_as_float(r[1])); }
DI float x32_max(float v) { const unsigned u = __float_as_uint(v); const auto r = __builtin_amdgcn_permlane32_swap(u, u, false, false); return fmaxf(__uint_as_float(r[0]), __uint_as_float(r[1])); }
DI float wave_sum(float v) { return x32_sum(x16_sum(row16_sumf(v))); }
DI float wave_max(float v) { return x32_max(x16_max(row16_maxf(v))); }
DI unsigned ordf(float f) { const unsigned u = __float_as_uint(f); return (u & 0x80000000u) ? ~u : (u | 0x80000000u); }
DI float unordf(unsigned x) { return __uint_as_float((x & 0x80000000u) ? (x & 0x7fffffffu) : ~x); }
DI int bucket_of(int n) {
    if (n < 16) return n;
    int b = 16;
    b += (n >= 21); b += (n >= 27); b += (n >= 35); b += (n >= 46); b += (n >= 59); b += (n >= 77); b += (n >= 99); b += (n >= 128);
    b += (n >= 166); b += (n >= 216); b += (n >= 280); b += (n >= 363); b += (n >= 470); b += (n >= 609); b += (n >= 790);
    return b; }

DI int srccol(int n) { return n < 2816 ? n : (n < 5056 ? n + 24 : (n < 5080 ? n - 2240 : (n < 5088 ? n : -1))); }
DI void tr_item(const float* W, int ldw, bf16_t* WT, int ldwt, int k0, int n0, LAS float* scr, int lane, bool remap, int ncopy, int cstride) {
    float tv[32];
#pragma unroll
    for (int i = 0; i < 32; ++i) { const int kk = 2 * i + (lane >> 5), nl = lane & 31; const int n = n0 + nl; const int src = remap ? srccol(n) : n; tv[i] = src >= 0 ? W[(size_t)(k0 + kk) * ldw + src] : 0.f; }
#pragma unroll
    for (int i = 0; i < 32; ++i) { const int kk = 2 * i + (lane >> 5), nl = lane & 31; scr[kk * 33 + nl] = tv[i]; }
    LDS_WAIT();
    const int c = lane & 7;
#pragma unroll
    for (int j = 0; j < 4; ++j) { const int n = (lane >> 3) + 8 * j; const LAS float* s = scr + (8 * c) * 33 + n;
        u32x4 o; o.x = pk2(s[0], s[33]); o.y = pk2(s[66], s[99]); o.z = pk2(s[132], s[165]); o.w = pk2(s[198], s[231]);
        for (int cp = 0; cp < ncopy; ++cp) *(u32x4*)(WT + (size_t)(n0 + n) * ldwt + (size_t)cp * cstride + k0 + 8 * c) = o; }
    LDS_WAIT();
}
DI void cvt_rows(const float* src, bf16_t* dst, size_t ngroups8, int gw, int NGW, int lane) {
    const size_t st = (size_t)NGW * 64;
    for (size_t i0 = (size_t)gw * 64 + lane; i0 < ngroups8; i0 += 4 * st) {
        f32x4 a[4], b[4];
#pragma unroll
        for (int r = 0; r < 4; ++r) { const size_t i = i0 + r * st < ngroups8 ? i0 + r * st : i0; a[r] = ((const f32x4*)src)[2 * i]; b[r] = ((const f32x4*)src)[2 * i + 1]; }
#pragma unroll
        for (int r = 0; r < 4; ++r) { const size_t i = i0 + r * st; if (i >= ngroups8) break;
            u32x4 o; o.x = pk2(a[r].x, a[r].y); o.y = pk2(a[r].z, a[r].w); o.z = pk2(b[r].x, b[r].y); o.w = pk2(b[r].z, b[r].w); ((u32x4*)dst)[i] = o; }
    }
}
DI int pk4_fp8(float a, float b, float c, float d) { int w = 0; w = __builtin_amdgcn_cvt_pk_fp8_f32(a, b, w, false); w = __builtin_amdgcn_cvt_pk_fp8_f32(c, d, w, true); return w; }
DI void cvt_rows_fp8(const float* src, unsigned char* dst, float* scl, int nrows, int gw, int NGW, int lane) {
    for (int r0 = gw; r0 < nrows; r0 += 4 * NGW) {
        f32x4 a[4], b[4], c[4], d[4];
#pragma unroll
        for (int k = 0; k < 4; ++k) { const int r = r0 + k * NGW < nrows ? r0 + k * NGW : r0; const float* s = src + (size_t)r * 1024 + lane * 16;
            a[k] = *(const f32x4*)s; b[k] = *(const f32x4*)(s + 4); c[k] = *(const f32x4*)(s + 8); d[k] = *(const f32x4*)(s + 12); }
#pragma unroll
        for (int k = 0; k < 4; ++k) { const int r = r0 + k * NGW; if (r >= nrows) break;
            float mx = fmaxf(fmaxf(fmaxf(fabsf(a[k].x), fabsf(a[k].y)), fmaxf(fabsf(a[k].z), fabsf(a[k].w))), fmaxf(fmaxf(fabsf(b[k].x), fabsf(b[k].y)), fmaxf(fabsf(b[k].z), fabsf(b[k].w))));
            mx = fmaxf(mx, fmaxf(fmaxf(fmaxf(fabsf(c[k].x), fabsf(c[k].y)), fmaxf(fabsf(c[k].z), fabsf(c[k].w))), fmaxf(fmaxf(fabsf(d[k].x), fabsf(d[k].y)), fmaxf(fabsf(d[k].z), fabsf(d[k].w)))));
            mx = wave_max(mx);
            const float sc = mx > 0.f ? mx * (1.f / 448.f) : 1.f, inv = 1.f / sc;
            u32x4 o; o.x = (unsigned)pk4_fp8(a[k].x * inv, a[k].y * inv, a[k].z * inv, a[k].w * inv); o.y = (unsigned)pk4_fp8(b[k].x * inv, b[k].y * inv, b[k].z * inv, b[k].w * inv);
            o.z = (unsigned)pk4_fp8(c[k].x * inv, c[k].y * inv, c[k].z * inv, c[k].w * inv); o.w = (unsigned)pk4_fp8(d[k].x * inv, d[k].y * inv, d[k].z * inv, d[k].w * inv);
            *(u32x4*)(dst + (size_t)(lane >> 3) * PT_SLICE + (size_t)r * 128 + (lane & 7) * 16) = o;
            if (lane == 0) scl[r] = sc; }
    }
}
DI void rmsnorm_rows(const float* x, const float* g, bf16_t* H, int gw, int NGW, int lane, unsigned char* H8 = nullptr, float* HSI = nullptr) {
    const f32x4 g0 = *(const f32x4*)(g + lane * 8), g1 = *(const f32x4*)(g + lane * 8 + 4), g2 = *(const f32x4*)(g + 512 + lane * 8), g3 = *(const f32x4*)(g + 512 + lane * 8 + 4);
    for (int m0 = gw; m0 < T; m0 += 4 * NGW) {
        f32x4 a[4], b[4], c[4], d[4];
#pragma unroll
        for (int r = 0; r < 4; ++r) { const int m = m0 + r * NGW < T ? m0 + r * NGW : m0; const float* xr = x + (size_t)m * 1024 + lane * 8;
            a[r] = *(const f32x4*)xr; b[r] = *(const f32x4*)(xr + 4); c[r] = *(const f32x4*)(xr + 512); d[r] = *(const f32x4*)(xr + 516); }
#pragma unroll
        for (int r = 0; r < 4; ++r) { const int m = m0 + r * NGW; if (m >= T) break;
            float ss = a[r].x * a[r].x + a[r].y * a[r].y + a[r].z * a[r].z + a[r].w * a[r].w + b[r].x * b[r].x + b[r].y * b[r].y + b[r].z * b[r].z + b[r].w * b[r].w
                     + c[r].x * c[r].x + c[r].y * c[r].y + c[r].z * c[r].z + c[r].w * c[r].w + d[r].x * d[r].x + d[r].y * d[r].y + d[r].z * d[r].z + d[r].w * d[r].w;
            ss = wave_sum(ss);
            const float rr = rsqrtf(ss * (1.f / 1024.f) + 1e-6f);
            u32x4 o0, o1;
            o0.x = pk2(a[r].x * rr * g0.x, a[r].y * rr * g0.y); o0.y = pk2(a[r].z * rr * g0.z, a[r].w * rr * g0.w); o0.z = pk2(b[r].x * rr * g1.x, b[r].y * rr * g1.y); o0.w = pk2(b[r].z * rr * g1.z, b[r].w * rr * g1.w);
            o1.x = pk2(c[r].x * rr * g2.x, c[r].y * rr * g2.y); o1.y = pk2(c[r].z * rr * g2.z, c[r].w * rr * g2.w); o1.z = pk2(d[r].x * rr * g3.x, d[r].y * rr * g3.y); o1.w = pk2(d[r].z * rr * g3.z, d[r].w * rr * g3.w);
            bf16_t* hr = H + (size_t)m * 1024 + lane * 8; *(u32x4*)hr = o0; *(u32x4*)(hr + 512) = o1;
            if (H8) {
                float v[16] = {a[r].x * rr * g0.x, a[r].y * rr * g0.y, a[r].z * rr * g0.z, a[r].w * rr * g0.w, b[r].x * rr * g1.x, b[r].y * rr * g1.y, b[r].z * rr * g1.z, b[r].w * rr * g1.w,
                               c[r].x * rr * g2.x, c[r].y * rr * g2.y, c[r].z * rr * g2.z, c[r].w * rr * g2.w, d[r].x * rr * g3.x, d[r].y * rr * g3.y, d[r].z * rr * g3.z, d[r].w * rr * g3.w};
                float am = 0.f;
#pragma unroll
                for (int e = 0; e < 16; ++e) am = fmaxf(am, fabsf(v[e]));
                am = wave_max(am);
                const float hs = am > 0.f ? 224.f / am : 1.f;
                u32x2 q0, q1; q0.x = (unsigned)pk4_fp8(v[0] * hs, v[1] * hs, v[2] * hs, v[3] * hs); q0.y = (unsigned)pk4_fp8(v[4] * hs, v[5] * hs, v[6] * hs, v[7] * hs);
                q1.x = (unsigned)pk4_fp8(v[8] * hs, v[9] * hs, v[10] * hs, v[11] * hs); q1.y = (unsigned)pk4_fp8(v[12] * hs, v[13] * hs, v[14] * hs, v[15] * hs);
                unsigned char* h8 = H8 + (size_t)m * 1024 + lane * 8; *(u32x2*)h8 = q0; *(u32x2*)(h8 + 512) = q1;
                if (lane == 0) HSI[m] = 1.f / hs; } }
    }
}
DI void phase_prep_w(const Params& p, int l, const Frame& F) {
    LAS float* scr = (LAS float*)(F.lds + F.wave * 8448);
    const int gw = F.vb * 8 + F.wave, NGW = F.G * 8, lane = F.lane;
    unsigned char* ws = p.ws;
    bf16_t* WCAT = (bf16_t*)(ws + WS_WCAT); bf16_t* WBR = (bf16_t*)(ws + WS_WBR); bf16_t* WOUT4 = (bf16_t*)(ws + WS_WOUT4); bf16_t* WQ = (bf16_t*)(ws + WS_WQ);
    bf16_t* WPG = (bf16_t*)(ws + WS_WPG); bf16_t* WPP = (bf16_t*)(ws + WS_WPP); bf16_t* W1C = (bf16_t*)(ws + WS_W1C);
    constexpr int I0 = 2560, I1 = 2048, I2 = 1024, I3 = 512, I4 = 512, I5 = 512, I6 = 128, I7 = 512, NIT = I0 + I1 + I2 + I3 + I4 + I5 + I6 + I7;
    for (int it = gw; it < NIT; it += NGW) {
        int r = it;
        if (r < I0) { tr_item(p.in[I_WIN] + (size_t)l * 1024 * 5088, 5088, WCAT, 1024, (r / 160) * 64, (r % 160) * 32, scr, lane, true, 1, 0); continue; } r -= I0;
        if (r < I1) { tr_item(p.in[I_WGATE] + (size_t)l * 1024 * 4096, 4096, WCAT + (size_t)5120 * 1024, 1024, (r / 128) * 64, (r % 128) * 32, scr, lane, false, 1, 0); continue; } r -= I1;
        if (r < I2) { const int m = r >> 8, rr = r & 255; tr_item(p.in[I_WBR] + ((size_t)l * 2048 + m * 512) * 1024, 1024, WBR + (size_t)m * 1024 * 512, 512, (rr / 32) * 64, (rr % 32) * 32, scr, lane, false, 1, 0); continue; } r -= I2;
        if (r < I3) { tr_item(p.in[I_WOUT] + (size_t)l * 1024 * 1024, 1024, WOUT4, 1024, (r / 32) * 64, (r % 32) * 32, scr, lane, false, 1, 0); continue; } r -= I3;
        if (r < I4) { tr_item(p.in[I_WQ] + (size_t)l * 1024 * 1024, 1024, WQ, 1024, (r / 32) * 64, (r % 32) * 32, scr, lane, false, 1, 0); continue; } r -= I4;
        if (r < I5) { tr_item(p.in[I_WPG] + (size_t)l * 1024 * 1024, 1024, WPG, 1024, (r / 32) * 64, (r % 32) * 32, scr, lane, false, 1, 0); continue; } r -= I5;
        if (r < I6) { tr_item(p.in[I_WPP] + (size_t)l * 256 * 1024, 1024, WPP, 256, (r / 32) * 64, (r % 32) * 32, scr, lane, false, 1, 0); continue; } r -= I6;
        { const int jh = r >> 7, rr = r & 127, j = jh >> 1, half = jh & 1;
          tr_item(p.in[I_CW1] + (((size_t)l * 2 + j) * 2048 + half * 1024) * 256, 256, W1C + ((size_t)j * 512 + half * 256) * 1024, 1024, (rr / 8) * 64, (rr % 8) * 32, scr, lane, false, 1, 0); }
    }
    cvt_rows_fp8(p.in[I_PU] + (size_t)l * 16384 * 1024, ws + WS_PTU, (float*)(ws + WS_PTV), 16384, gw, NGW, lane);
    cvt_rows_fp8(p.in[I_PV] + (size_t)l * 16384 * 1024, ws + WS_PTU + 16 * MiB, (float*)(ws + WS_PTV) + 16384, 16384, gw, NGW, lane);
    cvt_rows(p.in[I_SUBK] + (size_t)l * 131072, (bf16_t*)(ws + WS_SK), 131072 / 8, gw, NGW, lane);
    cvt_rows(p.in[I_P] + (size_t)l * T * 256, (bf16_t*)(ws + WS_PB), (size_t)T * 256 / 8, gw, NGW, lane);
    { const float* sw = p.in[I_SGUW] + (size_t)l * 131072; bf16_t* dst = (bf16_t*)(ws + WS_SGUW);
      for (int i = gw * 64 + lane; i < 131072 / 8; i += NGW * 64) { const int e = i * 8, t = (e >> 7) & 127, s0 = e & 127; float v[8];
#pragma unroll
          for (int k = 0; k < 8; ++k) v[k] = (s0 + k <= t) ? sw[e + k] : 0.f;
          u32x4 o; o.x = pk2(v[0], v[1]); o.y = pk2(v[2], v[3]); o.z = pk2(v[4], v[5]); o.w = pk2(v[6], v[7]); ((u32x4*)dst)[i] = o; } }
    { float* peb = (float*)(ws + WS_PEB);
      for (int o = gw; o < 512; o += NGW) { const int j = o >> 8, n = o & 255; const float* pe = p.in[I_PE] + ((size_t)l * 2 + j) * 2048; const float* w1 = p.in[I_CW1] + ((size_t)l * 2 + j) * 2048 * 256;
          float s = 0.f; for (int k = lane; k < 2048; k += 64) s += pe[k] * w1[(size_t)k * 256 + n];
          s = wave_sum(s); if (lane == 0) peb[o] = s; } }
    rmsnorm_rows(l == 0 ? p.in[I_X] : p.out, p.in[I_GMIX] + l * 1024, (bf16_t*)(ws + WS_H), gw, NGW, lane);
}

struct Epi1 {
    static constexpr bool PERM = true, AFTER_DRAIN = false;
    bf16_t* proj; bf16_t* gates;
    DI void operator()(const f32x4 (&acc)[2][2][4][2], const pg8::Unit& u, int wr, int wc, int fr, int fq) const {
        const int row0 = u.pm * 256 + wr * 64 + fr; const bool isg = u.pn >= 20;
        const int col0 = (isg ? (u.pn - 20) * 256 : u.pn * 256) + wc * 32 + 8 * fq; bf16_t* base = isg ? gates : proj; const int ldc = isg ? 4096 : PW;
#pragma unroll
        for (int ai = 0; ai < 2; ++ai)
#pragma unroll
            for (int m = 0; m < 4; ++m) { bf16_t* rowp = base + (size_t)(row0 + ai * 128 + m * 16) * ldc + col0;
#pragma unroll
                for (int bj = 0; bj < 2; ++bj) { f32x4 v0 = acc[ai][bj][m][0], v1 = acc[ai][bj][m][1];
                    if (isg) { v0.x = sigm(v0.x); v0.y = sigm(v0.y); v0.z = sigm(v0.z); v0.w = sigm(v0.w); v1.x = sigm(v1.x); v1.y = sigm(v1.y); v1.z = sigm(v1.z); v1.w = sigm(v1.w); }
                    u32x4 w; w.x = pk2(v0.x, v0.y); w.y = pk2(v0.z, v0.w); w.z = pk2(v1.x, v1.y); w.w = pk2(v1.z, v1.w);
                    __builtin_nontemporal_store(w, (u32x4*)(rowp + bj * 128)); } }
    }
};
struct EpiBf {
    static constexpr bool PERM = true, AFTER_DRAIN = false;
    bf16_t* O; int ldc;
    DI void operator()(const f32x4 (&acc)[2][2][4][2], const pg8::Unit& u, int wr, int wc, int fr, int fq) const {
        const int row0 = u.pm * 256 + wr * 64 + fr, col0 = u.pn * 256 + wc * 32 + 8 * fq;
#pragma unroll
        for (int ai = 0; ai < 2; ++ai)
#pragma unroll
            for (int m = 0; m < 4; ++m) { bf16_t* rowp = O + (size_t)(row0 + ai * 128 + m * 16) * ldc + col0;
#pragma unroll
                for (int bj = 0; bj < 2; ++bj) { const f32x4 v0 = acc[ai][bj][m][0], v1 = acc[ai][bj][m][1];
                    u32x4 w; w.x = pk2(v0.x, v0.y); w.y = pk2(v0.z, v0.w); w.z = pk2(v1.x, v1.y); w.w = pk2(v1.z, v1.w);
                    *(u32x4*)(rowp + bj * 128) = w; } }
    }
};
struct EpiF32P {
    static constexpr bool PERM = true, AFTER_DRAIN = false;
    float* C; int ldc;
    DI void operator()(const f32x4 (&acc)[2][2][4][2], const pg8::Unit& u, int wr, int wc, int fr, int fq) const {
        const int row0 = u.pm * 256 + wr * 64 + fr, col0 = u.pn * 256 + wc * 32 + 8 * fq;
#pragma unroll
        for (int ai = 0; ai < 2; ++ai)
#pragma unroll
            for (int m = 0; m < 4; ++m) { float* rowp = C + (size_t)(row0 + ai * 128 + m * 16) * ldc + col0;
#pragma unroll
                for (int bj = 0; bj < 2; ++bj) { *(f32x4*)(rowp + bj * 128) = acc[ai][bj][m][0]; *(f32x4*)(rowp + bj * 128 + 4) = acc[ai][bj][m][1]; } }
    }
};
struct XcdColOrder {
    int G, c;
    DI bool next(int i, pg8::Unit& u) const {
        if (G != 256) { const int Lx = i * G + c; if (Lx >= 128 * 36) return false; u.pm = Lx / 36; u.pn = Lx % 36; return true; }
        if (i >= 18) return false;
        const int x = c & 7, w = c >> 3;
        if (i < 16) { u.pm = 8 * i + (w & 7); u.pn = 4 * x + (w >> 3); }
        else { u.pm = 16 * x + 8 * (i - 16) + (w & 7); u.pn = 32 + (w >> 3); }
        return true; }
    DI void a_ready(const pg8::Unit&) const {}
    DI void done(const pg8::Unit&) const {}
};
struct RoundOrder {
    pg8::StaticOrder base; int r;
    DI bool next(int i, pg8::Unit& u) const { return i == 0 && base.next(r, u); }
    DI void a_ready(const pg8::Unit&) const {}
    DI void done(const pg8::Unit&) const {}
};
struct ColRangeOrder {
    int G, c, c0, c1;
    DI bool next(int i, pg8::Unit& u) const { const int nc = c1 - c0; const int Lx = i * G + c; if (Lx >= 128 * nc) return false; u.pm = Lx / nc; u.pn = c0 + Lx % nc; return true; }
    DI void a_ready(const pg8::Unit&) const {}
    DI void done(const pg8::Unit&) const {}
};
struct BranchOrder {
    int G, c;
    DI bool next(int i, pg8::Unit& u) const { const int tile = c + G * (i >> 2), m = i & 3; if (tile >= 512) return false; u.pm = m * 128 + (tile >> 2); u.pn = m * 4 + (tile & 3); return true; }
    DI void a_ready(const pg8::Unit&) const {}
    DI void done(const pg8::Unit&) const {}
};
struct EpiBranch {
    static constexpr bool PERM = true, AFTER_DRAIN = false;
    const bf16_t* gates; bf16_t* merged;
    DI void operator()(const f32x4 (&acc)[2][2][4][2], const pg8::Unit& u, int wr, int wc, int fr, int fq) const {
        const int m4 = u.pn >> 2; const int row0 = (u.pm & 127) * 256 + wr * 64 + fr, gcol0 = u.pn * 256 + wc * 32 + 8 * fq, dcol0 = (u.pn & 3) * 256 + wc * 32 + 8 * fq;
#pragma unroll
        for (int ai = 0; ai < 2; ++ai) {
            u32x4 g[4][2], pr[4][2];
#pragma unroll
            for (int m = 0; m < 4; ++m)
#pragma unroll
                for (int bj = 0; bj < 2; ++bj) { g[m][bj] = *(const u32x4*)(gates + (size_t)(row0 + ai * 128 + m * 16) * 4096 + gcol0 + bj * 128);
                    if (m4 > 0) pr[m][bj] = *(const u32x4*)(merged + (size_t)(row0 + ai * 128 + m * 16) * 1024 + dcol0 + bj * 128); }
#pragma unroll
            for (int m = 0; m < 4; ++m)
#pragma unroll
                for (int bj = 0; bj < 2; ++bj) { const f32x4 v0 = acc[ai][bj][m][0], v1 = acc[ai][bj][m][1]; const u32x4 gg = g[m][bj];
                    f32x4 r0 = {v0.x * lo16(gg.x), v0.y * hi16(gg.x), v0.z * lo16(gg.y), v0.w * hi16(gg.y)}, r1 = {v1.x * lo16(gg.z), v1.y * hi16(gg.z), v1.z * lo16(gg.w), v1.w * hi16(gg.w)};
                    if (m4 > 0) { const u32x4 pp_ = pr[m][bj];
                        r0.x += lo16(pp_.x); r0.y += hi16(pp_.x); r0.z += lo16(pp_.y); r0.w += hi16(pp_.y); r1.x += lo16(pp_.z); r1.y += hi16(pp_.z); r1.z += lo16(pp_.w); r1.w += hi16(pp_.w); }
                    u32x4 w; w.x = pk2(r0.x, r0.y); w.y = pk2(r0.z, r0.w); w.z = pk2(r1.x, r1.y); w.w = pk2(r1.z, r1.w);
                    *(u32x4*)(merged + (size_t)(row0 + ai * 128 + m * 16) * 1024 + dcol0 + bj * 128) = w; }
        }
    }
};
struct EpiRes {
    static constexpr bool PERM = true, AFTER_DRAIN = false;
    const float* xin; float* out;
    DI void operator()(const f32x4 (&acc)[2][2][4][2], const pg8::Unit& u, int wr, int wc, int fr, int fq) const {
        const int row0 = u.pm * 256 + wr * 64 + fr, col0 = u.pn * 256 + wc * 32 + 8 * fq;
#pragma unroll
        for (int ai = 0; ai < 2; ++ai)
#pragma unroll
            for (int mh = 0; mh < 2; ++mh) {
                f32x4 xa[2][2][2];
#pragma unroll
                for (int m2 = 0; m2 < 2; ++m2)
#pragma unroll
                    for (int bj = 0; bj < 2; ++bj) { const size_t off = (size_t)(row0 + ai * 128 + (mh * 2 + m2) * 16) * 1024 + col0 + bj * 128; xa[m2][bj][0] = *(const f32x4*)(xin + off); xa[m2][bj][1] = *(const f32x4*)(xin + off + 4); }
#pragma unroll
                for (int m2 = 0; m2 < 2; ++m2)
#pragma unroll
                    for (int bj = 0; bj < 2; ++bj) { const size_t off = (size_t)(row0 + ai * 128 + (mh * 2 + m2) * 16) * 1024 + col0 + bj * 128;
                        *(f32x4*)(out + off) = xa[m2][bj][0] + acc[ai][bj][mh * 2 + m2][0]; *(f32x4*)(out + off + 4) = xa[m2][bj][1] + acc[ai][bj][mh * 2 + m2][1]; }
            }
    }
};
struct EpiPle {
    static constexpr bool PERM = true, AFTER_DRAIN = false;
    float* x; const bf16_t* pp;
    DI void operator()(const f32x4 (&acc)[2][2][4][2], const pg8::Unit& u, int wr, int wc, int fr, int fq) const {
        const int row0 = u.pm * 256 + wr * 64 + fr, col0 = u.pn * 256 + wc * 32 + 8 * fq;
#pragma unroll
        for (int ai = 0; ai < 2; ++ai)
#pragma unroll
            for (int mh = 0; mh < 2; ++mh) {
                f32x4 xa[2][2][2]; u32x4 ga[2][2];
#pragma unroll
                for (int m2 = 0; m2 < 2; ++m2)
#pragma unroll
                    for (int bj = 0; bj < 2; ++bj) { const size_t off = (size_t)(row0 + ai * 128 + (mh * 2 + m2) * 16) * 1024 + col0 + bj * 128;
                        xa[m2][bj][0] = *(const f32x4*)(x + off); xa[m2][bj][1] = *(const f32x4*)(x + off + 4); ga[m2][bj] = *(const u32x4*)(pp + off); }
#pragma unroll
                for (int m2 = 0; m2 < 2; ++m2)
#pragma unroll
                    for (int bj = 0; bj < 2; ++bj) { const size_t off = (size_t)(row0 + ai * 128 + (mh * 2 + m2) * 16) * 1024 + col0 + bj * 128;
                        const f32x4 v0 = acc[ai][bj][mh * 2 + m2][0], v1 = acc[ai][bj][mh * 2 + m2][1]; const u32x4 g = ga[m2][bj]; f32x4 x0 = xa[m2][bj][0], x1 = xa[m2][bj][1];
                        x0.x += sigm(v0.x) * lo16(g.x); x0.y += sigm(v0.y) * hi16(g.x); x0.z += sigm(v0.z) * lo16(g.y); x0.w += sigm(v0.w) * hi16(g.y);
                        x1.x += sigm(v1.x) * lo16(g.z); x1.y += sigm(v1.y) * hi16(g.z); x1.z += sigm(v1.z) * lo16(g.w); x1.w += sigm(v1.w) * hi16(g.w);
                        *(f32x4*)(x + off) = x0; *(f32x4*)(x + off + 4) = x1; }
            }
    }
};


DI void unpack8(const u32x4 w, float (&f)[8]) { f[0] = lo16(w.x); f[1] = hi16(w.x); f[2] = lo16(w.y); f[3] = hi16(w.y); f[4] = lo16(w.z); f[5] = hi16(w.z); f[6] = lo16(w.w); f[7] = hi16(w.w); }
DI u32x4 pack8(const float (&f)[8]) { u32x4 o; o.x = pk2(f[0], f[1]); o.y = pk2(f[2], f[3]); o.z = pk2(f[4], f[5]); o.w = pk2(f[6], f[7]); return o; }
DI void load8f(const float* p, float (&f)[8]) { const f32x4 a = *(const f32x4*)p, b = *(const f32x4*)(p + 4); f[0] = a.x; f[1] = a.y; f[2] = a.z; f[3] = a.w; f[4] = b.x; f[5] = b.y; f[6] = b.z; f[7] = b.w; }

DI void phase_chunk(const Params& p, int l, const Frame& F) {
    unsigned char* ws = p.ws; const int lane = F.lane, wave = F.wave;
    bf16_t* PROJ = (bf16_t*)(ws + WS_PROJ); bf16_t* YA = (bf16_t*)(ws + WS_Y); bf16_t* YC = YA + (size_t)2 * T * 512; bf16_t* CMPA = (bf16_t*)(ws + WS_CMPA);
    const bf16_t* SGUW = (const bf16_t*)(ws + WS_SGUW);
    LAS unsigned char* vnT = F.lds;
    const float* convw = p.in[I_CONVW] + (size_t)l * 3 * 512; const float* lng = p.in[I_LNG] + (size_t)l * 512; const float* sgub = p.in[I_SGUB] + (size_t)l * 8 * 128;
    float cw0[8], cw1[8], cw2[8], lgn[8];
    load8f(convw + lane * 8, cw0); load8f(convw + 512 + lane * 8, cw1); load8f(convw + 1024 + lane * 8, cw2); load8f(lng + lane * 8, lgn);
    for (int chunk = F.vb; chunk < T / 128; chunk += F.G) {
        const int t0 = chunk * 128;
        for (int tt = wave; tt < 128; tt += 8) {
            const int t = t0 + tt, s = t & (SEQ - 1), b = t >> 12;
            bf16_t* row = PROJ + (size_t)t * PW;
            const int c0 = lane * 8;
            const u32x4 z = {0u, 0u, 0u, 0u};
            const u32x4 rab = *(const u32x4*)(row + C_AB + c0), rc0 = *(const u32x4*)(row + C_AC + c0), rx0 = *(const u32x4*)(row + C_AX + c0);
            u32x4 r1c = z, r1x = z, r2c = z, r2x = z;
            if (s >= 1) { r1c = *(const u32x4*)(row - PW + C_AC + c0); r1x = *(const u32x4*)(row - PW + C_AX + c0); }
            if (s >= 2) { r2c = *(const u32x4*)(row - 2 * PW + C_AC + c0); r2x = *(const u32x4*)(row - 2 * PW + C_AX + c0); }
            u32x4 segv[3]; int segcol[3]; const float* seggp[3]; float segsc[3];
#pragma unroll
            for (int pass = 0; pass < 3; ++pass) {
                const int seg = pass * 8 + (lane >> 3), sg = seg < 20 ? seg : 20; int col; const float* gp; float sc = 1.f;
                if (sg < 8) { col = C_NQ + 64 * sg; gp = p.in[I_NQG] + l * 64; sc = 0.125f * 1.44269504f; }
                else if (sg < 10) { col = C_NKV + 2 * 128 + (sg - 8) * 64; gp = p.in[I_NKG] + (l * 3 + 1) * 64; }
                else if (sg < 12) { col = C_NKV + 4 * 128 + (sg - 10) * 64; gp = p.in[I_NKG] + (l * 3 + 2) * 64; }
                else if (sg < 20) { col = C_DQ + 64 * (sg - 12); gp = p.in[I_DQG] + l * 64; sc = 0.125f * 1.44269504f; }
                else { col = C_DK; gp = p.in[I_DKG] + l * 64; }
                segcol[pass] = col; seggp[pass] = gp; segsc[pass] = sc; segv[pass] = *(const u32x4*)(row + col + (lane & 7) * 8);
            }
            u32x4 rawc = z; const bf16_t* rawsrc = row; bf16_t* rawdst = nullptr;
            if (lane < 48) { const int sgc = lane >> 3;
                if (sgc < 2) { rawsrc = row + C_NKV + 3 * 128 + sgc * 64; rawdst = (bf16_t*)(ws + WS_VS) + ((size_t)((b * 2 + sgc) * SEQ + s)) * 64; }
                else if (sgc < 4) { rawsrc = row + C_NKV + 5 * 128 + (sgc - 2) * 64; rawdst = (bf16_t*)(ws + WS_VW) + ((size_t)((b * 2 + (sgc - 2)) * SEQ + s)) * 64; }
                else if (sgc == 4) { rawsrc = row + C_DV; rawdst = (bf16_t*)(ws + WS_DV) + (size_t)t * 64; }
                else { rawsrc = row + C_DKI; rawdst = (bf16_t*)(ws + WS_DKI) + (size_t)t * 64; }
                rawc = *(const u32x4*)(rawsrc + (lane & 7) * 8); }
            u32x4 cmpc = z;
            if (lane < 32) { const int jg = lane >> 3; cmpc = *(const u32x4*)(row + C_NKV + (jg >> 1) * 128 + (jg & 1) * 64 + (lane & 7) * 8); }
            const u32x4 ruv = *(const u32x4*)(row + C_UV + 512 + lane * 8);
            {
                float ab[8], c0v[8], x0v[8], c1v[8], x1v[8], c2v[8], x2v[8], y[8];
                unpack8(rab, ab); unpack8(rc0, c0v); unpack8(rx0, x0v); unpack8(r1c, c1v); unpack8(r1x, x1v); unpack8(r2c, c2v); unpack8(r2x, x2v);
#pragma unroll
                for (int e = 0; e < 8; ++e) y[e] = ab[e] * (cw2[e] * c0v[e] * x0v[e] + cw1[e] * c1v[e] * x1v[e] + cw0[e] * c2v[e] * x2v[e]);
                *(u32x4*)(YA + (size_t)t * 512 + c0) = pack8(y);
            }
#pragma unroll
            for (int pass = 0; pass < 3; ++pass) {
                const int seg = pass * 8 + (lane >> 3), part = lane & 7, sg = seg < 20 ? seg : 20;
                float v[8], g[8]; unpack8(segv[pass], v); load8f(seggp[pass] + part * 8, g);
                float ss = 0.f;
#pragma unroll
                for (int e = 0; e < 8; ++e) ss += v[e] * v[e];
                ss = oct_sumf(ss);
                const float r = rsqrtf(ss * (1.f / 64.f) + 1e-6f) * segsc[pass];
#pragma unroll
                for (int e = 0; e < 8; ++e) v[e] = v[e] * r * g[e];
                bf16_t* dstp = row + segcol[pass] + part * 8;
                if (sg >= 8 && sg < 10) dstp = (bf16_t*)(ws + WS_KS) + ((size_t)((b * 2 + (sg - 8)) * SEQ + s)) * 64 + part * 8;
                else if (sg >= 10 && sg < 12) dstp = (bf16_t*)(ws + WS_KW) + ((size_t)((b * 2 + (sg - 10)) * SEQ + s)) * 64 + part * 8;
                else if (sg == 20) dstp = (bf16_t*)(ws + WS_DK) + (size_t)t * 64 + part * 8;
                if (seg < 21) *(u32x4*)dstp = pack8(v);
            }
            if (lane < 48) *(u32x4*)(rawdst + (lane & 7) * 8) = rawc;
            if (lane < 32) { const int jg = lane >> 3, j = jg >> 1, g = jg & 1, part = lane & 7;
                *(u32x4*)(CMPA + ((size_t)j * 4096 + ((size_t)(b * 256 + (s >> 4)) * 2 + g)) * 1024 + (s & 15) * 64 + part * 8) = cmpc; }
            {
                float v[8]; unpack8(ruv, v);
                float sm = 0.f;
#pragma unroll
                for (int e = 0; e < 8; ++e) { v[e] = gelu_t(v[e]); sm += v[e]; }
                const float mean = wave_sum(sm) * (1.f / 512.f); float sq = 0.f;
#pragma unroll
                for (int e = 0; e < 8; ++e) { v[e] -= mean; sq += v[e] * v[e]; }
                const float r = rsqrtf(wave_sum(sq) * (1.f / 512.f) + 1e-6f);
#pragma unroll
                for (int e = 0; e < 8; ++e) *(LAS unsigned short*)(vnT + (lane * 8 + e) * 272 + tt * 2) = (unsigned short)f2bf(v[e] * r * lgn[e]);
            }
        }
        __syncthreads();
        {
            const int g = wave, c = lane & 15, q = lane >> 4; const bf16_t* Wg = SGUW + (size_t)g * 128 * 128;
            for (int tt16 = 0; tt16 < 8; ++tt16) {
                const int nk = (tt16 >> 1) + 1;
                bf16x8 bw[4];
#pragma unroll
                for (int kk = 0; kk < 4; ++kk) bw[kk] = *(const bf16x8*)(Wg + (size_t)(16 * tt16 + c) * 128 + 32 * (kk < nk ? kk : 0) + 8 * q);
                const int t = t0 + 16 * tt16 + c; const float bias = sgub[g * 128 + 16 * tt16 + c];
#pragma unroll
                for (int dt = 0; dt < 4; ++dt) {
                    f32x4 acc = {0.f, 0.f, 0.f, 0.f};
#pragma unroll
                    for (int kk = 0; kk < 4; ++kk) if (kk < nk) { const bf16x8 a = *(const LAS bf16x8*)(vnT + (g * 64 + 16 * dt + c) * 272 + (32 * kk + 8 * q) * 2); acc = MFMA16(a, bw[kk], acc); }
                    const int ch = g * 64 + 16 * dt + 4 * q;
                    const u32x2 uu = *(const u32x2*)(PROJ + (size_t)t * PW + C_UV + ch);
                    u32x2 o; o.x = pk2(gelu_t(lo16(uu.x)) * (acc[0] + bias), gelu_t(hi16(uu.x)) * (acc[1] + bias)); o.y = pk2(gelu_t(lo16(uu.y)) * (acc[2] + bias), gelu_t(hi16(uu.y)) * (acc[3] + bias));
                    *(u32x2*)(YC + (size_t)t * 512 + ch) = o;
                }
            }
        }
        __syncthreads();
    }
}

DI void phase_cmp2(const Params& p, int l, const Frame& F) {
    unsigned char* ws = p.ws; const int lane = F.lane; const int gw = F.vb * 8 + F.wave, NGW = F.G * 8;
    LAS float* hid = (LAS float*)(F.lds + 131072 + F.wave * 1024);
    LAS float* w2s = (LAS float*)F.lds;
    { const float* w2g = p.in[I_CW2] + (size_t)l * 2 * 256 * 64;
      for (int i = F.tid; i < 2 * 256 * 64 / 4; i += 512) *(LAS f32x4*)(w2s + i * 4) = *(const f32x4*)(w2g + i * 4); }
    __syncthreads();
    const float* CMPP = (const float*)(ws + WS_CMPP); const float* peb = (const float*)(ws + WS_PEB);
    bf16_t* CMPK = (bf16_t*)(ws + WS_CMPK); bf16_t* CMPV = (bf16_t*)(ws + WS_CMPV);
    const float* kg = p.in[I_NKG] + (l * 3 + 0) * 64;
    for (int it = gw; it < 8 * 256 * 2 * 2; it += NGW) {
        const int j = it & 1, g = (it >> 1) & 1, n = (it >> 2) & 255, b = it >> 10;
        bf16_t* dst = (j ? CMPV : CMPK) + ((size_t)(b * 2 + g) * 256 + n) * 64;
        if (n == 255) { dst[lane] = 0; continue; }
        const float* Pa = CMPP + ((size_t)j * 4096 + (size_t)(b * 256 + n) * 2 + g) * 512; const float* Pb = CMPP + ((size_t)j * 4096 + (size_t)(b * 256 + n + 1) * 2 + g) * 512 + 256;
        const f32x4 a = *(const f32x4*)(Pa + lane * 4), bq = *(const f32x4*)(Pb + lane * 4), pe = *(const f32x4*)(peb + j * 256 + lane * 4);
        f32x4 h; h.x = gelu_t(a.x + bq.x + pe.x); h.y = gelu_t(a.y + bq.y + pe.y); h.z = gelu_t(a.z + bq.z + pe.z); h.w = gelu_t(a.w + bq.w + pe.w);
        *(LAS f32x4*)(hid + lane * 4) = h;
        LDS_WAIT();
        const LAS float* w2 = w2s + j * 256 * 64;
        float o = 0.f;
#pragma unroll 16
        for (int k = 0; k < 256; ++k) o += hid[k] * w2[k * 64 + lane];
        if (j == 0) { const float ss = wave_sum(o * o); o = o * rsqrtf(ss * (1.f / 64.f) + 1e-6f) * kg[lane]; }
        dst[lane] = (bf16_t)f2bf(o);
        LDS_WAIT();
    }
}

DI int bucket_fast(int n) { const int big = 16 + (int)((__log2f((float)n) - 4.f) * 2.6666667f + 2e-4f); return n < 16 ? n : (big < 31 ? big : 31); }
struct KsCmp { static constexpr bool CONTIG = true; static constexpr int DSTEP = 16, DMAX = 1 << 30; const bf16_t* kb; const bf16_t* vb; int t0, hb;
    DI void base(int k0, const bf16_t*& k, const bf16_t*& v) const { k = kb + (size_t)k0 * 64; v = vb + (size_t)k0 * 64; }
    DI int dist0(int k0, int c) const { return t0 + (c >> 2) - (16 * k0 + 31); } };
struct KsSel { static constexpr bool CONTIG = true; static constexpr int DSTEP = 1, DMAX = 1 << 30; const bf16_t* kb; const bf16_t* vb; const LAS int* selb; int t, hb;
    DI int p0(int k0) const { return __builtin_amdgcn_readfirstlane(selb[k0 >> 6]) * 64 + (k0 & 63); }
    DI void base(int k0, const bf16_t*& k, const bf16_t*& v) const { const int ps = p0(k0); k = kb + (size_t)ps * 64; v = vb + (size_t)ps * 64; }
    DI int dist0(int k0, int c) const { return t - p0(k0); } };
struct KsWin { static constexpr bool CONTIG = true; static constexpr int DSTEP = 1, DMAX = 512; const bf16_t* kb; const bf16_t* vb; int pstart, t0, hb;
    DI void base(int k0, const bf16_t*& k, const bf16_t*& v) const { k = kb + (size_t)(pstart + k0) * 64; v = vb + (size_t)(pstart + k0) * 64; }
    DI int dist0(int k0, int c) const { return t0 + (c >> 2) - (pstart + k0); } };
struct KsDsa { static constexpr bool CONTIG = false; static constexpr int DSTEP = 1, DMAX = 1 << 30; const bf16_t* kb; const bf16_t* vb; const LAS int* list; int n, t;
    DI int pos(int idx) const { return idx < n ? list[idx] : -1; }
    DI const bf16_t* krow(int idx) const { const int ps = pos(idx); return kb + (size_t)(ps < 0 ? 0 : ps) * 64; }
    DI const bf16_t* vrow(int idx) const { const int ps = pos(idx); return vb + (size_t)(ps < 0 ? 0 : ps) * 64; }
    DI float adjust(int idx, int c, float s, bool& ok, const LAS unsigned char* buck, const LAS float* tbl) const {
        const int ps = pos(idx); ok = ps >= 0 && ps <= t; const int dd = t - ps; const int dc = ok ? (dd < 1023 ? dd : 1023) : 0; return s + tbl[buck[dc] * 16 + 8 + (c & 7)]; } };

template <int MODE, class KS>
DI void flash_run(const KS& ks, int nkeys, const bf16x8 (&qb)[2], f32x4 (&o)[4], float& m_run, float& l_run, LAS unsigned char* vt, LAS float* al, LAS float* pn,
                  const LAS unsigned char* buck, const LAS float* tbl, int lane) {
    const int c = lane & 15, q = lane >> 4;
    bf16x8 A00, A01, A10, A11, B00, B01, B10, B11; u32x4 Av[4], Bv[4];
#define FL_LOAD(B_, kk0) do { if constexpr (KS::CONTIG) { const bf16_t* kbp_; const bf16_t* vbp_; ks.base((kk0), kbp_, vbp_); const bf16_t* kr0 = kbp_ + c * 64 + 8 * q; \
            B_##00 = *(const bf16x8*)kr0; B_##01 = *(const bf16x8*)(kr0 + 32); B_##10 = *(const bf16x8*)(kr0 + 1024); B_##11 = *(const bf16x8*)(kr0 + 1056); \
            if (MODE != 1) { const bf16_t* vr0 = vbp_ + (lane >> 3) * 64 + (lane & 7) * 8; _Pragma("unroll") for (int m = 0; m < 4; ++m) B_##v[m] = *(const u32x4*)(vr0 + m * 512); } } \
        else { const bf16_t* kr0 = ks.krow((kk0) + c); const bf16_t* kr1 = ks.krow((kk0) + 16 + c); \
            B_##00 = *(const bf16x8*)(kr0 + 8 * q); B_##01 = *(const bf16x8*)(kr0 + 32 + 8 * q); B_##10 = *(const bf16x8*)(kr1 + 8 * q); B_##11 = *(const bf16x8*)(kr1 + 32 + 8 * q); \
            if (MODE != 1) { _Pragma("unroll") for (int m = 0; m < 4; ++m) B_##v[m] = *(const u32x4*)(ks.vrow((kk0) + (lane >> 3) + 8 * m) + (lane & 7) * 8); } } } while (0)
#define FL_STEP(B_, K0_) do { \
        f32x4 s0 = {0.f, 0.f, 0.f, 0.f}, s1 = {0.f, 0.f, 0.f, 0.f}; \
        s0 = MFMA16(B_##00, qb[0], s0); s0 = MFMA16(B_##01, qb[1], s0); s1 = MFMA16(B_##10, qb[0], s1); s1 = MFMA16(B_##11, qb[1], s1); \
        float sv[8], pv[8]; bool ok[8]; \
        if constexpr (KS::CONTIG) { \
            const LAS float* trow = tbl + (c & 3) * 1024; const int d0 = ks.dist0((K0_), c) - KS::DSTEP * 4 * q; \
        _Pragma("unroll") \
            for (int i = 0; i < 4; ++i) { const int da = d0 - KS::DSTEP * i, db = da - KS::DSTEP * 16; \
                ok[i] = da >= 0 && da < KS::DMAX; ok[4 + i] = db >= 0 && db < KS::DMAX; \
                sv[i] = s0[i] + trow[da < 0 ? 0 : (da < 1023 ? da : 1023)]; sv[4 + i] = s1[i] + trow[db < 0 ? 0 : (db < 1023 ? db : 1023)]; } \
        } else { \
        _Pragma("unroll") \
            for (int i = 0; i < 4; ++i) { sv[i] = ks.adjust((K0_) + 4 * q + i, c, s0[i], ok[i], buck, tbl); sv[4 + i] = ks.adjust((K0_) + 16 + 4 * q + i, c, s1[i], ok[4 + i], buck, tbl); } \
        } \
        if (MODE == 2) { \
        _Pragma("unroll") \
            for (int e = 0; e < 8; ++e) { pv[e] = ok[e] ? __builtin_amdgcn_exp2f(sv[e]) * l_run : 0.f; \
                const float x = quad_sumf(pv[e]); \
                if ((c & 3) == 0) pn[(c >> 2) * 256 + (K0_) + (e < 4 ? 4 * q + e : 16 + 4 * q + (e - 4))] = x; } \
        } else { \
            float ps = 0.f; \
        _Pragma("unroll") \
            for (int e = 0; e < 8; ++e) { pv[e] = ok[e] ? __builtin_amdgcn_exp2f(sv[e]) : 0.f; ps += pv[e]; } \
            l_run += ps; \
        } \
        if (MODE != 1) { \
        _Pragma("unroll") \
            for (int m = 0; m < 4; ++m) *(LAS u32x4*)(vt + ((lane >> 3) + 8 * m) * 144 + (lane & 7) * 16) = B_##v[m]; \
            LDS_FENCE(); \
            const bf16x8 pa = __builtin_bit_cast(bf16x8, pack8(pv)); \
        _Pragma("unroll") \
            for (int dt = 0; dt < 4; ++dt) { \
                const s16x4 lo = __builtin_amdgcn_ds_read_tr16_b64_v4i16((LAS s16x4*)(vt + (4 * q + (c >> 2)) * 144 + (16 * dt + 4 * (c & 3)) * 2)); \
                const s16x4 hi = __builtin_amdgcn_ds_read_tr16_b64_v4i16((LAS s16x4*)(vt + (16 + 4 * q + (c >> 2)) * 144 + (16 * dt + 4 * (c & 3)) * 2)); \
                const bf16x8 vb8 = __builtin_shufflevector(lo, hi, 0, 1, 2, 3, 4, 5, 6, 7); \
                o[dt] = MFMA16(pa, vb8, o[dt]); \
            } \
            LDS_FENCE(); \
        } \
    } while (0)
    if (nkeys > 0) FL_LOAD(A, 0);
    for (int k0 = 0; k0 < nkeys; k0 += 64) {
        if (k0 + 32 < nkeys) FL_LOAD(B, k0 + 32);
        FL_STEP(A, k0);
        if (k0 + 32 >= nkeys) break;
        if (k0 + 64 < nkeys) FL_LOAD(A, k0 + 64);
        FL_STEP(B, k0 + 32);
    }
#undef FL_STEP
#undef FL_LOAD
    if (MODE == 0) {
        float lt = x32_sum(x16_sum(l_run));
        const float inv = lt > 0.f ? __builtin_amdgcn_rcpf(lt) : 0.f;
        if (q == 0) al[c] = inv;
        LDS_WAIT();
        const f32x4 a4 = *(const LAS f32x4*)(al + 4 * q);
#pragma unroll
        for (int dt = 0; dt < 4; ++dt) o[dt] = o[dt] * a4;
        LDS_WAIT();
    }
}

DI void nsa_tile(const Params& p, int b, int g, int tb, const Frame& F, const LAS float* lut, int vm = 0) {
    unsigned char* ws = p.ws; const int lane = F.lane, wave = F.wave, c = lane & 15, q = lane >> 4;
    const LAS float* tbl = lut + g * 4096;
    LAS unsigned char* wl = F.lds + wave * 9216; LAS unsigned char* vt = wl; LAS float* al = (LAS float*)(wl + 4608); LAS float* pn = (LAS float*)(wl + 4736);
    LAS float* OS = (LAS float*)F.lds; LAS float* LS = (LAS float*)(F.lds + 65536);
    LAS int* SELB = (LAS int*)(F.lds + 73728); LAS int* CNT = (LAS int*)(F.lds + 75776); LAS unsigned short* UNIT = (LAS unsigned short*)(F.lds + 76032); LAS int* NUNIT = (LAS int*)(F.lds + 76416);
    volatile LAS int* TURN = (volatile LAS int*)(F.lds + 76544); LAS unsigned short* LIST = (LAS unsigned short*)(F.lds + 76800);
    LAS unsigned char* vt2 = F.lds + 84992 + wave * 4608;
    const bf16_t* prow0 = (const bf16_t*)(ws + WS_PROJ) + (size_t)(b * SEQ) * PW;
    bf16_t* YB = (bf16_t*)(ws + WS_Y) + (size_t)T * 512;
    const f32x4 z4 = {0.f, 0.f, 0.f, 0.f};
    for (int ii = 0; ii < 2; ++ii) {
        f32x4 accw[4];
        const int item = wave * 2 + ii, t0 = 64 * tb + 4 * item;
#pragma unroll
        for (int k = 0; k < 4; ++k) *(LAS f32x4*)(pn + lane * 4 + 256 * k) = z4;
        bf16x8 qb[2];
        { const bf16_t* qp = prow0 + (size_t)(t0 + (c >> 2)) * PW + C_NQ + (g * 4 + (c & 3)) * 64 + 8 * q; qb[0] = *(const bf16x8*)qp; qb[1] = *(const bf16x8*)(qp + 32); }
        float g0[4], g2[4];
        { const u32x2 ga = *(const u32x2*)(prow0 + (size_t)(t0 + q) * PW + C_NG + 0 * 8 + g * 4), gc = *(const u32x2*)(prow0 + (size_t)(t0 + q) * PW + C_NG + 2 * 8 + g * 4);
          g0[0] = sigm(lo16(ga.x)); g0[1] = sigm(hi16(ga.x)); g0[2] = sigm(lo16(ga.y)); g0[3] = sigm(hi16(ga.y));
          g2[0] = sigm(lo16(gc.x)); g2[1] = sigm(hi16(gc.x)); g2[2] = sigm(lo16(gc.y)); g2[3] = sigm(hi16(gc.y)); }
#pragma unroll
        for (int dt = 0; dt < 4; ++dt) accw[dt] = z4;
        LDS_WAIT();
        const int tl = t0 + 3, nv = tl >= 31 ? ((tl - 31) >> 4) + 1 : 0;
        if (nv > 0 && (vm == 0 || (vm & 1))) {
            const int nk = (nv + 31) & ~31;
            KsCmp ks{(const bf16_t*)(ws + WS_CMPK) + (size_t)(b * 2 + g) * 256 * 64, (const bf16_t*)(ws + WS_CMPV) + (size_t)(b * 2 + g) * 256 * 64, t0, g * 4};
            float m = 0.f, lr = 0.f; f32x4 o[4] = {z4, z4, z4, z4};
            flash_run<1>(ks, nk, qb, o, m, lr, vt, al, pn, (const LAS unsigned char*)vt, tbl, lane);
            lr = x32_sum(x16_sum(lr)); lr = lr > 0.f ? __builtin_amdgcn_rcpf(lr) : 0.f;
            flash_run<2>(ks, nk, qb, o, m, lr, vt, al, pn, (const LAS unsigned char*)vt, tbl, lane);
#pragma unroll
            for (int dt = 0; dt < 4; ++dt) { accw[dt][0] = g0[0] * o[dt][0]; accw[dt][1] = g0[1] * o[dt][1]; accw[dt][2] = g0[2] * o[dt][2]; accw[dt][3] = g0[3] * o[dt][3]; }
        }
        LDS_WAIT();
        {
            const int j = lane; float val[4];
#pragma unroll
            for (int qi = 0; qi < 4; ++qi) {
                if (j == 0 || j == tb) val[qi] = 1e4f;
                else if (j < tb) { const LAS float* pq = pn + qi * 256 + 4 * j; val[qi] = pq[-1] + pq[0] + pq[1] + pq[2] + pq[3]; }
                else val[qi] = -1e30f;
            }
            for (int k = 0; k < 8; ++k) {
#pragma unroll
                for (int qi = 0; qi < 4; ++qi) {
                    const float mx = wave_max(val[qi]); const unsigned long long who = __ballot(val[qi] == mx); const int w = __builtin_ctzll(who);
                    if (lane == 0) SELB[(item * 4 + qi) * 8 + k] = mx > -1e29f ? w : -1;
                    if (lane == w) val[qi] = -3e38f;
                }
            }
        }
        {
            const int pstart = t0 >= 511 ? t0 - 511 : 0, nk = (t0 + 3 - pstart + 1 + 31) & ~31;
            KsWin ks{(const bf16_t*)(ws + WS_KW) + (size_t)(b * 2 + g) * SEQ * 64, (const bf16_t*)(ws + WS_VW) + (size_t)(b * 2 + g) * SEQ * 64, pstart, t0, g * 4};
            float m = 0.f, lr = 0.f; f32x4 o[4] = {z4, z4, z4, z4};
            if (vm == 0 || (vm & 2)) flash_run<0>(ks, nk, qb, o, m, lr, vt, al, pn, (const LAS unsigned char*)vt, tbl, lane);
            if (vm & 4) { flash_run<1>(ks, nk, qb, o, m, lr, vt, al, pn, (const LAS unsigned char*)vt, tbl, lane); o[0][0] += lr; }
#pragma unroll
            for (int dt = 0; dt < 4; ++dt) { accw[dt][0] += g2[0] * o[dt][0]; accw[dt][1] += g2[1] * o[dt][1]; accw[dt][2] += g2[2] * o[dt][2]; accw[dt][3] += g2[3] * o[dt][3]; }
        }
        if (vm == 0) {
            bf16_t* dst = YB + (size_t)(b * SEQ + t0 + q) * 512 + (g * 4) * 64 + c;
#pragma unroll
            for (int dt = 0; dt < 4; ++dt)
#pragma unroll
                for (int i = 0; i < 4; ++i) dst[i * 64 + 16 * dt] = (bf16_t)f2bf(accw[dt][i]);
        }
        else { asm volatile("" :: "v"(accw[0]), "v"(accw[1]), "v"(accw[2]), "v"(accw[3])); }
        LDS_WAIT();
    }
    __syncthreads();
    if (vm != 0) return;
    for (int i = F.tid; i < 66560 / 16; i += 512) *(LAS f32x4*)(F.lds + i * 16) = z4;
    if (F.tid < 64) { CNT[F.tid] = 0; TURN[F.tid] = 0; }
    __syncthreads();
    { const int blk = SELB[F.tid];
      if (blk >= 0) { int rank = 0;
#pragma unroll
          for (int k = 0; k < 8; ++k) { const int ob = SELB[(F.tid & ~7) + k]; rank += (ob >= 0 && ob < blk) ? 1 : 0; }
          const int pos = __hip_atomic_fetch_add(CNT + blk, 1, __ATOMIC_RELAXED, __HIP_MEMORY_SCOPE_WORKGROUP); LIST[blk * 64 + pos] = (unsigned short)((F.tid >> 3) | (rank << 8)); } }
    __syncthreads();
    if (wave == 0) {
        const int uj = (CNT[lane] + 3) >> 2; int inc = uj;
#pragma unroll
        for (int o_ = 1; o_ < 64; o_ <<= 1) { const int v = __shfl_up(inc, o_); if (lane >= o_) inc += v; }
        const int offs = inc - uj;
        for (int u = 0; u < uj; ++u) UNIT[offs + u] = (unsigned short)(lane | (u << 8));
        if (lane == 63) NUNIT[0] = inc;
    }
    __syncthreads();
    {
        const int nu = NUNIT[0];
        const LAS float* trow = tbl + (c & 3) * 1024;
        const bf16_t* KSb = (const bf16_t*)(ws + WS_KS) + (size_t)(b * 2 + g) * SEQ * 64; const bf16_t* VSb = (const bf16_t*)(ws + WS_VS) + (size_t)(b * 2 + g) * SEQ * 64;
        for (int ui = wave; ui < nu; ui += 8) {
            const int uu = UNIT[ui], j = uu & 255, u = uu >> 8, nj = CNT[j];
            const int slot = 4 * u + (c >> 2); const int qrow = slot < nj ? (int)(LIST[j * 64 + slot] & 255) : -1;
            const int slotq = 4 * u + q; const int qo = slotq < nj ? (int)(LIST[j * 64 + slotq] & 255) : -1;
            bf16x8 qs[2] = {(bf16x8){0, 0, 0, 0, 0, 0, 0, 0}, (bf16x8){0, 0, 0, 0, 0, 0, 0, 0}};
            if (qrow >= 0) { const bf16_t* qp = prow0 + (size_t)(64 * tb + qrow) * PW + C_NQ + (g * 4 + (c & 3)) * 64 + 8 * q; qs[0] = *(const bf16x8*)qp; qs[1] = *(const bf16x8*)(qp + 32); }
            const bf16_t* kb0 = KSb + (size_t)(64 * j) * 64; const bf16_t* vb0 = VSb + (size_t)(64 * j) * 64;
            bf16x8 ka[4]; u32x4 vv[4];
#define SEL_LOADK(st) do { const bf16_t* kr0 = kb0 + (32 * (st) + c) * 64 + 8 * q; ka[0] = *(const bf16x8*)kr0; ka[1] = *(const bf16x8*)(kr0 + 32); ka[2] = *(const bf16x8*)(kr0 + 1024); ka[3] = *(const bf16x8*)(kr0 + 1056); } while (0)
#define SEL_LOADV(st) do { const bf16_t* vr0 = vb0 + (32 * (st) + (lane >> 3)) * 64 + (lane & 7) * 8; _Pragma("unroll") for (int m = 0; m < 4; ++m) vv[m] = *(const u32x4*)(vr0 + m * 512); } while (0)
            SEL_LOADK(0); SEL_LOADV(0);
            f32x4 o[4] = {z4, z4, z4, z4}; float lsum = 0.f;
#pragma unroll
            for (int st = 0; st < 2; ++st) {
                f32x4 s0 = z4, s1 = z4;
                s0 = MFMA16(ka[0], qs[0], s0); s0 = MFMA16(ka[1], qs[1], s0); s1 = MFMA16(ka[2], qs[0], s1); s1 = MFMA16(ka[3], qs[1], s1);
                if (st == 0) SEL_LOADK(1);
                const int d0 = 64 * (tb - j) + (qrow < 0 ? 0 : qrow) - 32 * st - 4 * q; float pv[8];
#pragma unroll
                for (int i = 0; i < 4; ++i) { const int da = d0 - i, db = da - 16;
                    const float ea = __builtin_amdgcn_exp2f(s0[i] + trow[da < 0 ? 0 : (da < 1023 ? da : 1023)]), eb = __builtin_amdgcn_exp2f(s1[i] + trow[db < 0 ? 0 : (db < 1023 ? db : 1023)]);
                    pv[i] = (qrow >= 0 && da >= 0) ? ea : 0.f; pv[4 + i] = (qrow >= 0 && db >= 0) ? eb : 0.f; lsum += pv[i] + pv[4 + i]; }
#pragma unroll
                for (int m = 0; m < 4; ++m) *(LAS u32x4*)(vt2 + ((lane >> 3) + 8 * m) * 144 + (lane & 7) * 16) = vv[m];
                if (st == 0) SEL_LOADV(1);
                LDS_FENCE();
                const bf16x8 pa = __builtin_bit_cast(bf16x8, pack8(pv));
#pragma unroll
                for (int dt = 0; dt < 4; ++dt) {
                    const s16x4 lo = __builtin_amdgcn_ds_read_tr16_b64_v4i16((LAS s16x4*)(vt2 + (4 * q + (c >> 2)) * 144 + (16 * dt + 4 * (c & 3)) * 2));
                    const s16x4 hi = __builtin_amdgcn_ds_read_tr16_b64_v4i16((LAS s16x4*)(vt2 + (16 + 4 * q + (c >> 2)) * 144 + (16 * dt + 4 * (c & 3)) * 2));
                    o[dt] = MFMA16(pa, __builtin_shufflevector(lo, hi, 0, 1, 2, 3, 4, 5, 6, 7), o[dt]);
                }
                LDS_FENCE();
            }
#undef SEL_LOADK
#undef SEL_LOADV
            lsum = x32_sum(x16_sum(lsum));
#pragma unroll 1
            for (int s = 0; s < 4; ++s) {
                if (4 * u + s >= nj) break;
                const int ent = LIST[j * 64 + 4 * u + s], qs_ = ent & 255, rk = ent >> 8;
                unsigned spins = 0;
                while (TURN[qs_] != rk) { __builtin_amdgcn_s_sleep(1); if (++spins > (1u << 22)) break; }
                if (q == s) {
#pragma unroll
                    for (int dt = 0; dt < 4; ++dt)
#pragma unroll
                        for (int i = 0; i < 4; ++i) OS[(qs_ * 4 + i) * 64 + 16 * dt + c] += o[dt][i];
                }
                if ((c >> 2) == s && q == 0) LS[qs_ * 4 + (c & 3)] += lsum;
                LDS_WAIT();
                if (lane == 0) TURN[qs_] = rk + 1;
                LDS_WAIT();
            }
        }
    }
    __syncthreads();
    for (int ii = 0; ii < 2; ++ii) {
        const int item = wave * 2 + ii, qq = item * 4 + q, t = 64 * tb + qq;
        const u32x2 gg = *(const u32x2*)(prow0 + (size_t)t * PW + C_NG + 8 + g * 4);
        const float g1[4] = {sigm(lo16(gg.x)), sigm(hi16(gg.x)), sigm(lo16(gg.y)), sigm(hi16(gg.y))};
        const f32x4 l4 = *(const LAS f32x4*)(LS + qq * 4);
        const float inv[4] = {l4.x > 0.f ? g1[0] / l4.x : 0.f, l4.y > 0.f ? g1[1] / l4.y : 0.f, l4.z > 0.f ? g1[2] / l4.z : 0.f, l4.w > 0.f ? g1[3] / l4.w : 0.f};
        bf16_t* dst = YB + (size_t)(b * SEQ + t) * 512 + (g * 4) * 64 + c;
#pragma unroll
        for (int dt = 0; dt < 4; ++dt)
#pragma unroll
            for (int i = 0; i < 4; ++i) dst[i * 64 + 16 * dt] = (bf16_t)f2bf(bf2f(dst[i * 64 + 16 * dt]) + inv[i] * OS[(qq * 4 + i) * 64 + 16 * dt + c]);
    }
    __syncthreads();
}

DI void dsa_group(const Params& p, int b, int t0, const Frame& F, const LAS unsigned char* buck, const LAS float* tbl, int parts = 7) {
    unsigned char* ws = p.ws; const int lane = F.lane, wave = F.wave, c = lane & 15, q = lane >> 4;
    LAS unsigned* SC = (LAS unsigned*)F.lds;
    LAS int* list = (LAS int*)(F.lds + 131072 + wave * 1024); LAS float* al = (LAS float*)(F.lds + 139264 + wave * 64);
    const bf16_t* prow0 = (const bf16_t*)(ws + WS_PROJ) + (size_t)(b * SEQ) * PW;
    bf16_t* YD = (bf16_t*)(ws + WS_Y) + (size_t)3 * T * 512;
    const bf16x8 zf = {0, 0, 0, 0, 0, 0, 0, 0};
    const int t = t0 + wave; const bf16_t* qrow = prow0 + (size_t)t * PW;
    const bf16_t* dki = (const bf16_t*)(ws + WS_DKI) + (size_t)(b * SEQ) * 64;
    const bool full = t0 >= 256;
    if (full && (parts & 1)) {
        bf16x8 qa[4][2]; float wv[4][4];
#pragma unroll
        for (int rt = 0; rt < 4; ++rt) { const bf16_t* qp = prow0 + (size_t)(t0 + 2 * rt + (c >> 3)) * PW + C_DQI + (c & 7) * 64 + 8 * q; qa[rt][0] = *(const bf16x8*)qp; qa[rt][1] = *(const bf16x8*)(qp + 32);
            const u32x2 w4 = *(const u32x2*)(prow0 + (size_t)(t0 + 2 * rt + (q >> 1)) * PW + C_DWI + (q & 1) * 4);
            wv[rt][0] = lo16(w4.x) * 0.35355339f; wv[rt][1] = hi16(w4.x) * 0.35355339f; wv[rt][2] = lo16(w4.y) * 0.35355339f; wv[rt][3] = hi16(w4.y) * 0.35355339f; }
        const int ntile = ((t0 + 7) >> 4) + 1, nk64 = ((t0 + 7) >> 6) + 1;
        bf16x8 kx0, kx1;
        if (wave < ntile) { const bf16_t* kp = dki + (size_t)(16 * wave + c) * 64 + 8 * q; kx0 = *(const bf16x8*)kp; kx1 = *(const bf16x8*)(kp + 32); }
        for (int tau = wave; tau < ntile; tau += 8) {
            const bf16x8 kb0 = kx0, kb1 = kx1;
            if (tau + 8 < ntile) { const bf16_t* kp = dki + (size_t)(16 * (tau + 8) + c) * 64 + 8 * q; kx0 = *(const bf16x8*)kp; kx1 = *(const bf16x8*)(kp + 32); }
            const int key = 16 * tau + c;
#pragma unroll
            for (int rt = 0; rt < 4; ++rt) {
                f32x4 acc = {0.f, 0.f, 0.f, 0.f};
                acc = MFMA16(qa[rt][0], kb0, acc); acc = MFMA16(qa[rt][1], kb1, acc);
                float s = wv[rt][0] * fmaxf(acc[0], 0.f) + wv[rt][1] * fmaxf(acc[1], 0.f) + wv[rt][2] * fmaxf(acc[2], 0.f) + wv[rt][3] * fmaxf(acc[3], 0.f);
                s = x16_sum(s);
                const int qq = 2 * rt + (q >> 1);
                if ((q & 1) == 0) SC[qq * 4096 + key] = key <= t0 + qq ? ordf(s) : 0u;
            }
        }
        for (int i = F.tid; i < 8 * 64; i += 512) { const int key = ntile * 16 + (i & 63); if (key < nk64 * 64) SC[(i >> 6) * 4096 + key] = 0u; }
    }
    __syncthreads();
    int n;
    if (!full) { n = t + 1; for (int i = lane; i < 256; i += 64) list[i] = i <= t ? i : -1; }
    else if (parts & 2) {
        n = 256;
        const LAS unsigned* sc = SC + wave * 4096; const int nk64 = (t >> 6) + 1;
        unsigned u[64];
#pragma unroll
        for (int k = 0; k < 64; ++k) u[k] = k < nk64 ? sc[k * 64 + lane] : 0u;
#define WAVE_TOTAL(cl, tot) do { tot = 0; _Pragma("unroll") for (int b_ = 0; b_ < 7; ++b_) tot += __popcll(__ballot(((cl) >> b_) & 1u)) << b_; } while (0)
        unsigned prefix = 0u;
        const int nk8 = __builtin_amdgcn_readfirstlane((nk64 + 7) >> 3);
#define CNT_GE(NK) _Pragma("unroll") for (int k = 0; k < NK; ++k) cl += (u[k] >= cand) ? 1u : 0u;
        for (int bit = 31; bit >= 0; --bit) {
            const unsigned cand = prefix | (1u << bit); unsigned cl = 0u; int cnt;
            switch (nk8) { case 1: CNT_GE(8) break; case 2: CNT_GE(16) break; case 3: CNT_GE(24) break; case 4: CNT_GE(32) break;
                           case 5: CNT_GE(40) break; case 6: CNT_GE(48) break; case 7: CNT_GE(56) break; default: CNT_GE(64) break; }
            WAVE_TOTAL(cl, cnt);
            if (cnt >= 256) { prefix = cand; if (cnt == 256) break; }
        }
        int cgt; { unsigned cl = 0u;
#pragma unroll
            for (int k = 0; k < 64; ++k) cl += (u[k] > prefix) ? 1u : 0u;
            WAVE_TOTAL(cl, cgt); }
#undef WAVE_TOTAL
#undef CNT_GE
        const int need_eq = 256 - cgt; int base = 0, eqbase = 0;
#pragma unroll
        for (int k = 0; k < 64; ++k) {
            if (k < nk64) {
                const bool gtp = u[k] > prefix, eq = u[k] == prefix;
                const unsigned long long meq = __ballot(eq);
                const int eqrank = eqbase + (int)__builtin_amdgcn_mbcnt_hi((unsigned)(meq >> 32), __builtin_amdgcn_mbcnt_lo((unsigned)meq, 0u));
                const bool take = gtp || (eq && eqrank < need_eq);
                const unsigned long long mt = __ballot(take);
                const int slot = base + (int)__builtin_amdgcn_mbcnt_hi((unsigned)(mt >> 32), __builtin_amdgcn_mbcnt_lo((unsigned)mt, 0u));
                if (take && slot < 256) list[slot] = k * 64 + lane;
                base += __popcll(mt); eqbase += __popcll(meq);
            }
        }
    }
    else n = 256;
    LDS_WAIT();
    if (!(parts & 4)) { __syncthreads(); return; }
    LAS unsigned char* vt = F.lds + wave * 16384;
    bf16x8 qd[2] = {zf, zf};
    if (c < 8) { qd[0] = *(const bf16x8*)(qrow + C_DQ + c * 64 + 8 * q); qd[1] = *(const bf16x8*)(qrow + C_DQ + c * 64 + 32 + 8 * q); }
    KsDsa ks{(const bf16_t*)(ws + WS_DK) + (size_t)(b * SEQ) * 64, (const bf16_t*)(ws + WS_DV) + (size_t)(b * SEQ) * 64, list, n, t};
    const f32x4 z4 = {0.f, 0.f, 0.f, 0.f};
    float m = -1e30f, lr = 0.f; f32x4 o[4] = {z4, z4, z4, z4};
    flash_run<0>(ks, (n + 31) & ~31, qd, o, m, lr, vt, al, (LAS float*)vt, buck, tbl, lane);
    if (q < 2) {
#pragma unroll
        for (int dt = 0; dt < 4; ++dt)
#pragma unroll
            for (int i = 0; i < 4; ++i) YD[(size_t)(b * SEQ + t) * 512 + (4 * q + i) * 64 + 16 * dt + c] = (bf16_t)f2bf(o[dt][i]);
    }
    __syncthreads();
}

DI void phase_attn(const Params& p, int l, const Frame& F, int mask = 3, int parts = 15) {
    const int gw = F.vb * 8 + F.wave, NGW = F.G * 8; const float* rel = p.in[I_REL];
#ifndef MK_ATTN
#define MK_ATTN 3
#endif
    if ((MK_ATTN & 1) && (mask & 1)) {
        LAS float* lut = (LAS float*)(F.lds + 130048);
        for (int i = F.tid; i < 8 * 1024; i += 512) { const int h = i >> 10, d = i & 1023; lut[i] = rel[bucket_of(d) * 16 + h] * 1.44269504f; }
        __syncthreads();
        for (int it = F.vb; it < 8 * 2 * 64; it += F.G) { const int b = it >> 7, g = (it >> 6) & 1; int tb = it & 63; if (b & 1) tb = 63 - tb; nsa_tile(p, b, g, tb, F, lut, (parts >> 8) & 15); }
    }
    __syncthreads();
    LAS unsigned char* buck = F.lds + 139776; LAS float* tbl = (LAS float*)(F.lds + 140800);
    for (int i = F.tid; i < 1024; i += 512) buck[i] = (unsigned char)bucket_of(i);
    tbl[F.tid] = rel[F.tid] * 1.44269504f;
    __syncthreads();
    if ((MK_ATTN & 2) && (mask & 2)) for (int it = F.vb; it < 8 * 512; it += F.G) { const int b = it >> 9; int tg = it & 511; if (b & 1) tg = 511 - tg; dsa_group(p, b, tg * 8, F, buck, tbl, parts); }
}


#ifndef MK_PROBE
#define MK_PROBE 0
#endif

DI unsigned row16_maxu(unsigned m) { unsigned o;
    o = (unsigned)DPP_I((int)m, 0xB1); m = m > o ? m : o; o = (unsigned)DPP_I((int)m, 0x4E); m = m > o ? m : o;
    o = (unsigned)DPP_I((int)m, 0x141); m = m > o ? m : o; o = (unsigned)DPP_I((int)m, 0x140); m = m > o ? m : o; return m; }
DI void peer_route_tile(const Params& p, int t0, int lane) {
    unsigned char* ws = p.ws; const int c = lane & 15, q = lane >> 4;
    const bf16_t* QP = (const bf16_t*)(ws + WS_QP); const bf16_t* SK = (const bf16_t*)(ws + WS_SK); int* EIDX = (int*)(ws + WS_EIDX); float* EW = (float*)(ws + WS_EW);
    float* EU = (float*)(ws + WS_EU); const float* USr = (const float*)(ws + WS_PTV); const float* VSr = USr + 16384;
    int ca[4], cb[4]; bool cv[4];
    ca[0] = 0; cb[0] = c; cv[0] = true;
    ca[1] = c < 8 ? 1 : (c < 13 ? 2 : 3); cb[1] = c < 8 ? c : (c < 13 ? c - 8 : c - 13); cv[1] = true;
    { const int ci = 32 + c; int a_, b_;
      if (ci == 32) { a_ = 3; b_ = 3; } else if (ci < 36) { a_ = 4; b_ = ci - 33; } else if (ci < 42) { a_ = 5 + ((ci - 36) >> 1); b_ = (ci - 36) & 1; } else { a_ = 8 + (ci - 42); b_ = 0; }
      ca[2] = a_; cb[2] = b_; cv[2] = true; }
    ca[3] = c < 2 ? 14 + c : 0; cb[3] = 0; cv[3] = c < 2;
    for (int h = 0; h < 8; ++h) {
        unsigned top[2][4];
#pragma unroll
        for (int pp = 0; pp < 2; ++pp) {
            const int hp = h * 2 + pp;
            const bf16_t* ap = QP + (size_t)(t0 + c) * 1024 + hp * 64 + 8 * q;
            const bf16x8 a0 = *(const bf16x8*)ap, a1 = *(const bf16x8*)(ap + 32);
            unsigned v[4][8];
#pragma unroll
            for (int kt = 0; kt < 8; ++kt) { const bf16_t* bp = SK + ((size_t)hp * 128 + 16 * kt + c) * 64 + 8 * q;
                const bf16x8 b0 = *(const bf16x8*)bp, b1 = *(const bf16x8*)(bp + 32);
                f32x4 acc = {0.f, 0.f, 0.f, 0.f}; acc = MFMA16(a0, b0, acc); acc = MFMA16(a1, b1, acc);
#pragma unroll
                for (int i = 0; i < 4; ++i) v[i][kt] = (ordf(acc[i]) & 0xFFFFFF80u) | (unsigned)(127 - (16 * kt + c)); }
            { unsigned mine[4] = {0u, 0u, 0u, 0u};
              for (int r = 0; r < 16; ++r) {
#pragma unroll
                  for (int i = 0; i < 4; ++i) { unsigned m = v[i][0];
#pragma unroll
                      for (int kt = 1; kt < 8; ++kt) m = m > v[i][kt] ? m : v[i][kt];
                      m = row16_maxu(m); mine[i] = (c == r) ? m : mine[i];
#pragma unroll
                      for (int kt = 0; kt < 8; ++kt) v[i][kt] = (v[i][kt] == m) ? 0u : v[i][kt]; } }
#pragma unroll
              for (int i = 0; i < 4; ++i) top[pp][i] = mine[i]; }
        }
        unsigned cd[4][4], mine2[4] = {0u, 0u, 0u, 0u}; int i0v[4], i1v[4];
#pragma unroll
        for (int i = 0; i < 4; ++i) {
            const float s0 = unordf(top[0][i] & 0xFFFFFF80u), s1 = unordf(top[1][i] & 0xFFFFFF80u);
            i0v[i] = 127 - (int)(top[0][i] & 127u); i1v[i] = 127 - (int)(top[1][i] & 127u);
#pragma unroll
            for (int k = 0; k < 4; ++k) { const float s0a = __shfl(s0, (lane & 48) | ca[k]), s1b = __shfl(s1, (lane & 48) | cb[k]);
                cd[i][k] = cv[k] ? ((ordf(s0a + s1b) & 0xFFFFFF00u) | (unsigned)(255 - (ca[k] * 16 + cb[k]))) : 0u; }
        }
        for (int r = 0; r < 16; ++r) {
#pragma unroll
            for (int i = 0; i < 4; ++i) { unsigned m = cd[i][0];
#pragma unroll
                for (int k = 1; k < 4; ++k) m = m > cd[i][k] ? m : cd[i][k];
                m = row16_maxu(m); mine2[i] = (c == r) ? m : mine2[i];
#pragma unroll
                for (int k = 0; k < 4; ++k) cd[i][k] = (cd[i][k] == m) ? 0u : cd[i][k]; }
        }
#pragma unroll
        for (int i = 0; i < 4; ++i) {
            const unsigned mine = mine2[i];
            const int pr = 255 - (int)(mine & 255u); const int ea = __shfl(i0v[i], (lane & 48) | (pr >> 4)), eb = __shfl(i1v[i], (lane & 48) | (pr & 15));
            const float scv = unordf(mine & 0xFFFFFF00u);
            const float mx = row16_maxf(scv);
            const float e = __expf(scv - mx); const float sm = row16_sumf(e);
            const size_t o = (size_t)(t0 + 4 * q + i) * 128 + h * 16 + c;
            const int eid = ea * 128 + eb; EIDX[o] = eid; EW[o] = (e / sm) * VSr[eid]; EU[o] = USr[eid];
        }
    }
}
#define MFMA8(a, b, c) __builtin_amdgcn_mfma_f32_16x16x32_fp8_fp8((a), (b), (c), 0, 0, 0)
DI long lo64(const u32x4 v) { return (long)(((unsigned long long)v.y << 32) | v.x); }
DI long hi64(const u32x4 v) { return (long)(((unsigned long long)v.w << 32) | v.z); }
template <int OFF> DI void peer_dma_o(const unsigned char* src, LAS unsigned char* dst) { __builtin_amdgcn_global_load_lds((const unsigned*)src, (LAS unsigned*)(dst - OFF), 16, OFF, 0); }
#define PEER_RD(slot_) (*(const LAS u32x4*)(ring + 1024 * (slot_) + 16 * lane))
#define PEER_VMW(n_) asm volatile("s_waitcnt vmcnt(" #n_ ")" ::: "memory")
struct PeerStream { int u0, ustep, n, xfix; bool al; };
DI PeerStream peer_stream(const Frame& F) { PeerStream s; const int bx = blockIdx.x; s.al = (F.G & 7) == 0; s.u0 = s.al ? (bx >> 3) * 8 + F.wave : bx * 8 + F.wave; s.ustep = s.al ? F.G : F.G * 8;
    const int nu = s.al ? T : T * 8; s.n = (nu - s.u0 + s.ustep - 1) / s.ustep; s.xfix = bx & 7; return s; }
DI void peer_unit(const PeerStream& s, int k, int& t, int& x) { const int u = s.u0 + (k < s.n ? k : s.n - 1) * s.ustep; t = s.al ? u : u >> 3; x = s.al ? s.xfix : u & 7; }

DI void phase_peer_u(const Params& p, const Frame& F) {
    unsigned char* ws = p.ws; const int lane = F.lane, c = lane & 15, q = lane >> 4, c8 = lane & 7, r8 = lane >> 3;
    LAS unsigned char* wl = F.lds + F.wave * LDS_PERWAVE; LAS float* pdl = (LAS float*)wl; LAS unsigned char* ring = wl + 512; LAS unsigned char* meta = wl + 512 + 16384;
    const PeerStream S = peer_stream(F);
    const unsigned char* EIDX = ws + WS_EIDX; const unsigned char* H8 = ws + WS_H8; float* PD = (float*)(ws + WS_PD); const unsigned char* PTU = ws + WS_PTU;
    const int p0 = ((c >> 1) + q) & 7, p1 = (p0 + 4) & 7;
    const int rdo = 1024 * (c >> 3) + 128 * (c & 7);
    int t, x;
#define PU_META(k_, slot_) do { peer_unit(S, (k_), t, x); const unsigned char* s_ = lane < 32 ? EIDX + (size_t)t * 512 + 16 * lane : H8 + (size_t)t * 1024 + 128 * x + 16 * (lane & 7); peer_dma_o<0>(s_, meta + 1024 * (slot_)); } while (0)
#define PU_RD(g_, pc_) (*(const LAS u32x4*)(ring + 2048 * (g_) + rdo + 16 * (pc_)))
    PU_META(0, 0); PU_META(1, 1);
    asm volatile("s_waitcnt vmcnt(0)" ::: "memory");
    u32x4 in_[4], hc0, hc1, hn0, hn1;
    { u32x4 i0_[4];
#pragma unroll
      for (int v_ = 0; v_ < 4; ++v_) i0_[v_] = *(const LAS u32x4*)(meta + 64 * r8 + 16 * v_);
      hn0 = *(const LAS u32x4*)(meta + 512 + 16 * p0); hn1 = *(const LAS u32x4*)(meta + 512 + 16 * p1);
      peer_unit(S, 0, t, x); const unsigned char* tb = PTU + (size_t)x * PT_SLICE + 16 * c8;
#define PU_D0(j) peer_dma_o<0>(tb + (size_t)i0_[(j) >> 2][(j) & 3] * 128, ring + 1024 * (j))
      PU_D0(0); PU_D0(1); PU_D0(2); PU_D0(3); PU_D0(4); PU_D0(5); PU_D0(6); PU_D0(7); PU_D0(8); PU_D0(9); PU_D0(10); PU_D0(11); PU_D0(12); PU_D0(13); PU_D0(14); PU_D0(15);
#undef PU_D0
    }
    PEER_VMW(12);
    u32x4 ra[2], rb[2];
#pragma unroll
    for (int i = 0; i < 2; ++i) { ra[i] = PU_RD(i, p0); rb[i] = PU_RD(i, p1); }
    const f32x4 z4 = {0.f, 0.f, 0.f, 0.f};
    for (int k = 0; k < S.n; ++k) {
        int tc, xc; peer_unit(S, k, tc, xc);
        hc0 = hn0; hc1 = hn1;
        { LAS unsigned char* m1 = meta + 1024 * ((k + 1) & 1);
#pragma unroll
          for (int v_ = 0; v_ < 4; ++v_) in_[v_] = *(const LAS u32x4*)(m1 + 64 * r8 + 16 * v_);
          hn0 = *(const LAS u32x4*)(m1 + 512 + 16 * p0); hn1 = *(const LAS u32x4*)(m1 + 512 + 16 * p1); }
        LDS_WAIT(); PU_META(k + 2, k & 1);
        peer_unit(S, k + 1, t, x);
        const unsigned char* tbn = PTU + (size_t)x * PT_SLICE + 16 * c8;
#define PU_GRP(g) do { if ((g) < 6) PEER_VMW(11); else PEER_VMW(10); const u32x4 na = PU_RD(((g) + 2) & 7, p0), nb = PU_RD(((g) + 2) & 7, p1); \
            f32x4 acc = MFMA8(lo64(ra[(g) & 1]), lo64(hc0), z4); acc = MFMA8(hi64(ra[(g) & 1]), hi64(hc0), acc); acc = MFMA8(lo64(rb[(g) & 1]), lo64(hc1), acc); acc = MFMA8(hi64(rb[(g) & 1]), hi64(hc1), acc); \
            asm volatile("" :: "v"(ra[(g) & 1]), "v"(rb[(g) & 1])); \
            peer_dma_o<0>(tbn + (size_t)in_[(2 * (g)) >> 2][(2 * (g)) & 3] * 128, ring + 2048 * (g)); peer_dma_o<0>(tbn + (size_t)in_[(2 * (g) + 1) >> 2][(2 * (g) + 1) & 3] * 128, ring + 2048 * (g) + 1024); \
            ra[(g) & 1] = na; rb[(g) & 1] = nb; \
            { const float d01 = (c & 1) ? acc[1] : acc[0], d23 = (c & 1) ? acc[3] : acc[2], dg = (c & 2) ? d23 : d01; if (q == (c >> 2)) pdl[16 * (c & 7) + 2 * (g) + (c >> 3)] = dg; } } while (0)
        PU_GRP(0); PU_GRP(1); PU_GRP(2); PU_GRP(3); PU_GRP(4); PU_GRP(5); PU_GRP(6); PU_GRP(7);
#undef PU_GRP
        { const u32x2 pv = *(const LAS u32x2*)(pdl + 2 * lane); *(u32x2*)(PD + ((size_t)xc * T + tc) * 128 + 2 * lane) = pv; }
    }
#undef PU_META
#undef PU_RD
    asm volatile("s_waitcnt vmcnt(0) lgkmcnt(0)" ::: "memory");
}

DI void phase_peer_coef(const Params& p, const Frame& F) {
    unsigned char* ws = p.ws; const float* PD = (const float*)(ws + WS_PD); const float* EW = (const float*)(ws + WS_EW); const float* EU = (const float*)(ws + WS_EU);
    const float* HSI = (const float*)(ws + WS_HSI); float* COEF = (float*)(ws + WS_COEF);
    const size_t NT = (size_t)F.G * 512;
    for (size_t i0 = (size_t)F.vb * 512 + F.tid; i0 < (size_t)T * 128; i0 += 4 * NT) {
        float d[4][8], ew[4], eu[4], hs[4];
#pragma unroll
        for (int r = 0; r < 4; ++r) { size_t i = i0 + r * NT; if (i >= (size_t)T * 128) i = i0; const int t = (int)(i >> 7), pp = (int)(i & 127);
#pragma unroll
            for (int x = 0; x < 8; ++x) d[r][x] = PD[((size_t)x * T + t) * 128 + pp];
            ew[r] = EW[i]; eu[r] = EU[i]; hs[r] = HSI[t]; }
#pragma unroll
        for (int r = 0; r < 4; ++r) { const size_t i = i0 + r * NT; if (i >= (size_t)T * 128) break;
            const float dot = ((d[r][0] + d[r][1]) + (d[r][2] + d[r][3])) + ((d[r][4] + d[r][5]) + (d[r][6] + d[r][7]));
            COEF[i] = ew[r] * gelu_t(dot * eu[r] * hs[r]); }
    }
}

DI void phase_peer_v(const Params& p, const Frame& F, const float* xin, float* xout) {
    unsigned char* ws = p.ws; const int lane = F.lane, c8 = lane & 7, r8 = lane >> 3;
    LAS unsigned char* wl = F.lds + F.wave * LDS_PERWAVE; LAS unsigned char* ring = wl; LAS unsigned char* meta = wl + 16384; LAS unsigned char* xs = wl + 16384 + 2048;
    const PeerStream S = peer_stream(F);
    const unsigned char* EIDX = ws + WS_EIDX; const unsigned char* COEF = ws + WS_COEF; const unsigned char* PTV = ws + WS_PTU + 16 * MiB;
    typedef float f32x2_t __attribute__((ext_vector_type(2)));
    int colofs;
    { const auto ra = __builtin_amdgcn_permlane32_swap(0u, 8u, false, false); const unsigned ta = ra[0];
      const auto rb = __builtin_amdgcn_permlane16_swap(ta, ta + 4u, false, false); const unsigned tb = rb[0];
      colofs = (int)tb + ((lane & 8) ? 2 : 0); }
    int t, x;
#define PV_META(k_, slot_) do { peer_unit(S, (k_), t, x); const unsigned char* s_ = (lane < 32 ? EIDX : COEF) + (size_t)t * 512 + 16 * (lane & 31); peer_dma_o<0>(s_, meta + 1024 * (slot_)); } while (0)
#define PV_XS(k_, slot_) do { peer_unit(S, (k_), t, x); if (lane < 32) peer_dma_o<0>((const unsigned char*)(xin + (size_t)t * 1024 + 128 * x) + 16 * lane, xs + 512 * (slot_)); } while (0)
    PV_META(0, 0); PV_META(1, 1); PV_XS(0, 0);
    asm volatile("s_waitcnt vmcnt(0)" ::: "memory");
    u32x4 in_[4]; f32x4 cf[4], cn[4];
    { u32x4 i0_[4];
#pragma unroll
      for (int v_ = 0; v_ < 4; ++v_) { i0_[v_] = *(const LAS u32x4*)(meta + 64 * r8 + 16 * v_); cn[v_] = *(const LAS f32x4*)(meta + 512 + 64 * r8 + 16 * v_); }
      peer_unit(S, 0, t, x); const unsigned char* tb = PTV + (size_t)x * PT_SLICE + 16 * c8;
#define PV_D0(j) peer_dma_o<0>(tb + (size_t)i0_[(j) >> 2][(j) & 3] * 128, ring + 1024 * (j))
      PV_D0(0); PV_D0(1); PV_D0(2); PV_D0(3); PV_D0(4); PV_D0(5); PV_D0(6); PV_D0(7); PV_D0(8); PV_D0(9); PV_D0(10); PV_D0(11); PV_D0(12); PV_D0(13); PV_D0(14); PV_D0(15);
#undef PV_D0
    }
    PEER_VMW(12);
    u32x4 rr[4];
#pragma unroll
    for (int i = 0; i < 4; ++i) rr[i] = PEER_RD(i);
    for (int k = 0; k < S.n; ++k) {
        int tc, xc; peer_unit(S, k, tc, xc);
#pragma unroll
        for (int v_ = 0; v_ < 4; ++v_) cf[v_] = cn[v_];
        { LAS unsigned char* m1 = meta + 1024 * ((k + 1) & 1);
#pragma unroll
          for (int v_ = 0; v_ < 4; ++v_) { in_[v_] = *(const LAS u32x4*)(m1 + 64 * r8 + 16 * v_); cn[v_] = *(const LAS f32x4*)(m1 + 512 + 64 * r8 + 16 * v_); } }
        LDS_WAIT(); PV_META(k + 2, k & 1);
        PV_XS(k + 1, (k + 1) & 1);
        peer_unit(S, k + 1, t, x);
        const unsigned char* tbn = PTV + (size_t)x * PT_SLICE + 16 * c8;
        f32x2_t out[8];
#pragma unroll
        for (int e = 0; e < 8; ++e) out[e] = (f32x2_t){0.f, 0.f};
#define PV_STEP(j) do { if ((j) < 12) PEER_VMW(13); else PEER_VMW(11); const u32x4 nw = PEER_RD(((j) + 4) & 15); \
            const u32x4 pv_ = rr[(j) & 3]; const float c1_ = cf[(j) >> 2][(j) & 3]; const f32x2_t cc = {c1_, c1_}; \
            out[0] += cc * __builtin_amdgcn_cvt_pk_f32_fp8((int)pv_.x, false); out[1] += cc * __builtin_amdgcn_cvt_pk_f32_fp8((int)pv_.x, true); \
            out[2] += cc * __builtin_amdgcn_cvt_pk_f32_fp8((int)pv_.y, false); out[3] += cc * __builtin_amdgcn_cvt_pk_f32_fp8((int)pv_.y, true); \
            out[4] += cc * __builtin_amdgcn_cvt_pk_f32_fp8((int)pv_.z, false); out[5] += cc * __builtin_amdgcn_cvt_pk_f32_fp8((int)pv_.z, true); \
            out[6] += cc * __builtin_amdgcn_cvt_pk_f32_fp8((int)pv_.w, false); out[7] += cc * __builtin_amdgcn_cvt_pk_f32_fp8((int)pv_.w, true); \
            asm volatile("" :: "v"(rr[(j) & 3])); \
            peer_dma_o<0>(tbn + (size_t)in_[(j) >> 2][(j) & 3] * 128, ring + 1024 * (j)); rr[(j) & 3] = nw; } while (0)
        PV_STEP(0); PV_STEP(1); PV_STEP(2); PV_STEP(3); PV_STEP(4); PV_STEP(5); PV_STEP(6); PV_STEP(7);
        PV_STEP(8); PV_STEP(9); PV_STEP(10); PV_STEP(11); PV_STEP(12); PV_STEP(13); PV_STEP(14); PV_STEP(15);
#undef PV_STEP
        float n8[8], n4[4], f2[2];
#pragma unroll
        for (int i = 0; i < 8; ++i) { const float a_ = (i & 1) ? out[i >> 1].y : out[i >> 1].x, b_ = (i & 1) ? out[4 + (i >> 1)].y : out[4 + (i >> 1)].x;
            const auto r_ = __builtin_amdgcn_permlane32_swap(__float_as_uint(a_), __float_as_uint(b_), false, false); n8[i] = __uint_as_float(r_[0]) + __uint_as_float(r_[1]); }
#pragma unroll
        for (int i = 0; i < 4; ++i) { const auto r_ = __builtin_amdgcn_permlane16_swap(__float_as_uint(n8[i]), __float_as_uint(n8[4 + i]), false, false); n4[i] = __uint_as_float(r_[0]) + __uint_as_float(r_[1]); }
#pragma unroll
        for (int i = 0; i < 2; ++i) { const bool hi8 = (lane & 8) != 0; const float keep = hi8 ? n4[2 + i] : n4[i], send = hi8 ? n4[i] : n4[2 + i];
            f2[i] = keep + __builtin_bit_cast(float, DPP_I(__builtin_bit_cast(int, send), 0x128)); }
        { const f32x2_t xv = *(const LAS f32x2_t*)(xs + 512 * (k & 1) + 4 * (16 * c8 + colofs));
          const f32x2_t o = {xv.x + f2[0], xv.y + f2[1]}; *(f32x2_t*)(xout + (size_t)tc * 1024 + 128 * xc + 16 * c8 + colofs) = o; }
    }
#undef PV_META
#undef PV_XS
    asm volatile("s_waitcnt vmcnt(0) lgkmcnt(0)" ::: "memory");
}
#undef PEER_RD
#undef PEER_VMW

#ifndef MK_MASK
#define MK_MASK 0xffff
#endif
__global__ void __launch_bounds__(512, 2) mega(Params p) {
    extern __shared__ __attribute__((aligned(16))) unsigned char lds_raw[];
#define MKFRAME() Frame F; { int t_ = threadIdx.x; asm volatile("" : "+v"(t_)); F.lds = (LAS unsigned char*)lds_raw; F.tid = t_; F.lane = t_ & 63; F.wave = __builtin_amdgcn_readfirstlane(t_ >> 6); \
        F.G = gridDim.x; const int bx = blockIdx.x; F.vb = (F.G % 8 == 0) ? (bx % 8) * (F.G / 8) + bx / 8 : bx; }
    if (threadIdx.x < 16) ((LAS unsigned*)((LAS unsigned char*)lds_raw + LDS_XB))[threadIdx.x] = 0u;
    __syncthreads();
    const int lo = p.ph_lo, hi = p.ph_hi;
    XcdBarrier bar; bar.bar = (unsigned*)(p.ws + WS_CTL) + 4096; bar.x = 0; bar.st = (volatile LAS unsigned*)((LAS unsigned char*)lds_raw + LDS_XB);
    if (hi - lo > 1) bar = xcd_barrier_post((unsigned*)(p.ws + WS_CTL) + 4096, (volatile LAS unsigned*)((LAS unsigned char*)lds_raw + LDS_XB));
#define WSP(ws) unsigned char* ws = p.ws; asm volatile("" : "+s"(ws))
    for (int l = 0; l < NLAYER; ++l) {
        const int pb = l * NPH;
#define IN(k) (((MK_MASK >> (k)) & 1) && lo <= pb + (k) && pb + (k) < hi)
#if MK_PROBE == 120
#define SEAM(k) do { if (((MK_MASK >> (k)) & 1) && lo <= pb + (k) && pb + (k) + 1 < hi) { xcd_barrier(bar); xcd_barrier(bar); xcd_barrier(bar); } } while (0)
#else
#define SEAM(k) do { if (((MK_MASK >> (k)) & 1) && lo <= pb + (k) && pb + (k) + 1 < hi) xcd_barrier(bar); } while (0)
#endif
        if (IN(0)) { MKFRAME(); phase_prep_w(p, l, F); }
        SEAM(0);
#if MK_PROBE == 100
        if (IN(0)) { MKFRAME(); phase_prep_w(p, l, F); } xcd_barrier(bar);
#endif
        if (IN(1)) { MKFRAME(); WSP(ws); pg8::Gemm g{(const bf16_t*)(ws + WS_H), (const bf16_t*)(ws + WS_WCAT), T, 9216, 1024}; XcdColOrder S{F.G, (int)blockIdx.x};
            Epi1 E{(bf16_t*)(ws + WS_PROJ), (bf16_t*)(ws + WS_GATES)};
            pg8::gemm_phase<Epi1, XcdColOrder, false>(F.lds, g, S, E, nullptr); }
        SEAM(1);
#if MK_PROBE == 104
        if (IN(1)) { for (int rr = 0; rr < 18; ++rr) { MKFRAME(); WSP(ws); pg8::Gemm g{(const bf16_t*)(ws + WS_H), (const bf16_t*)(ws + WS_WCAT), T, 9216, 1024}; RoundOrder S; S.base.init(T, 9216, F.G, (int)blockIdx.x); S.r = rr;
            Epi1 E{(bf16_t*)(ws + WS_PROJ), (bf16_t*)(ws + WS_GATES)};
            pg8::gemm_phase<Epi1, RoundOrder, false>(F.lds, g, S, E, nullptr); xcd_barrier(bar); } }
#endif
#if MK_PROBE == 101 || MK_PROBE == 102 || MK_PROBE == 103
        if (IN(1)) { MKFRAME(); WSP(ws); pg8::Gemm g{(const bf16_t*)(ws + WS_H), (const bf16_t*)(ws + WS_WCAT), T, 9216, 1024}; ColRangeOrder S{F.G, (int)blockIdx.x, MK_PROBE == 103 ? 20 : 0, MK_PROBE == 102 ? 20 : 36};
            Epi1 E{(bf16_t*)(ws + WS_PROJ), (bf16_t*)(ws + WS_GATES)};
            pg8::gemm_phase<Epi1, ColRangeOrder, false>(F.lds, g, S, E, nullptr); } xcd_barrier(bar);
#endif
        if (IN(2)) { MKFRAME(); phase_chunk(p, l, F); }
        SEAM(2);
        if (IN(3)) { MKFRAME(); WSP(ws);
            { pg8::Gemm g{(const bf16_t*)(ws + WS_CMPA), (const bf16_t*)(ws + WS_W1C), 4096, 512, 1024}; pg8::StaticOrder S; S.init(4096, 512, F.G, (int)blockIdx.x); EpiF32P E{(float*)(ws + WS_CMPP), 512};
              pg8::gemm_phase<EpiF32P, pg8::StaticOrder, false>(F.lds, g, S, E, nullptr); }
        }
        if (IN(3)) { MKFRAME(); WSP(ws);
            { pg8::Gemm g{(const bf16_t*)(ws + WS_CMPA) + (size_t)4096 * 1024, (const bf16_t*)(ws + WS_W1C) + (size_t)512 * 1024, 4096, 512, 1024}; pg8::StaticOrder S; S.init(4096, 512, F.G, (int)((blockIdx.x + F.G / 2) % F.G));
              EpiF32P E{(float*)(ws + WS_CMPP) + (size_t)4096 * 512, 512};
              pg8::gemm_phase<EpiF32P, pg8::StaticOrder, false>(F.lds, g, S, E, nullptr); }
        }
        SEAM(3);
        if (IN(4)) { MKFRAME(); phase_cmp2(p, l, F); }
        SEAM(4);
        if (IN(5)) { MKFRAME(); phase_attn(p, l, F, 3, 15); }
        SEAM(5);
#if MK_PROBE == 5 || MK_PROBE == 50 || MK_PROBE == 51 || MK_PROBE == 52 || MK_PROBE == 53
        if (IN(5)) { MKFRAME(); phase_attn(p, l, F, MK_PROBE == 5 ? 3 : (MK_PROBE == 50 ? 1 : 2), MK_PROBE == 52 ? 1 : (MK_PROBE == 53 ? 3 : 15)); xcd_barrier(bar); }
#endif
#if MK_PROBE >= 60 && MK_PROBE < 76
        if (IN(5)) { MKFRAME(); phase_attn(p, l, F, 1, (MK_PROBE - 60) << 8); xcd_barrier(bar); }
#endif
        if (IN(6)) { MKFRAME(); WSP(ws); pg8::Gemm g{(const bf16_t*)(ws + WS_Y), (const bf16_t*)(ws + WS_WBR), 4 * T, 4096, 512}; BranchOrder S{F.G, (int)blockIdx.x};
            EpiBranch E{(const bf16_t*)(ws + WS_GATES), (bf16_t*)(ws + WS_MERGED)};
            pg8::gemm_phase<EpiBranch, BranchOrder, false>(F.lds, g, S, E, nullptr); }
        SEAM(6);
#if MK_PROBE == 106
        if (IN(6)) { MKFRAME(); WSP(ws); pg8::Gemm g{(const bf16_t*)(ws + WS_Y), (const bf16_t*)(ws + WS_WBR), 4 * T, 4096, 512}; BranchOrder S{F.G, (int)blockIdx.x};
            EpiBranch E{(const bf16_t*)(ws + WS_GATES), (bf16_t*)(ws + WS_MERGED)};
            pg8::gemm_phase<EpiBranch, BranchOrder, false>(F.lds, g, S, E, nullptr); } xcd_barrier(bar);
#endif
        if (IN(7)) { MKFRAME(); WSP(ws); pg8::Gemm g{(const bf16_t*)(ws + WS_MERGED), (const bf16_t*)(ws + WS_WOUT4), T, 1024, 1024}; pg8::StaticOrder S; S.init(T, 1024, F.G, (int)blockIdx.x);
            EpiRes E{l == 0 ? p.in[I_X] : p.out, p.out};
            pg8::gemm_phase<EpiRes, pg8::StaticOrder, false>(F.lds, g, S, E, nullptr); }
        SEAM(7);
        if (IN(8)) { MKFRAME(); WSP(ws); rmsnorm_rows(p.out, p.in[I_GFFN] + l * 1024, (bf16_t*)(ws + WS_H), F.vb * 8 + F.wave, F.G * 8, F.lane, ws + WS_H8, (float*)(ws + WS_HSI)); }
        SEAM(8);
#if MK_PROBE == 108
        if (IN(8)) { MKFRAME(); WSP(ws); rmsnorm_rows(p.out, p.in[I_GFFN] + l * 1024, (bf16_t*)(ws + WS_H), F.vb * 8 + F.wave, F.G * 8, F.lane); } xcd_barrier(bar);
#endif
        if (IN(9)) { MKFRAME(); WSP(ws);
            { pg8::Gemm g{(const bf16_t*)(ws + WS_H), (const bf16_t*)(ws + WS_WQ), T, 1024, 1024}; pg8::StaticOrder S; S.init(T, 1024, F.G, (int)blockIdx.x); EpiBf E{(bf16_t*)(ws + WS_QP), 1024};
              pg8::gemm_phase<EpiBf, pg8::StaticOrder, false>(F.lds, g, S, E, nullptr); }
        }
        if (IN(9)) { MKFRAME(); WSP(ws);
            { pg8::Gemm g{(const bf16_t*)(ws + WS_PB), (const bf16_t*)(ws + WS_WPP), T, 1024, 256}; pg8::StaticOrder S; S.init(T, 1024, F.G, (int)blockIdx.x); EpiBf E{(bf16_t*)(ws + WS_PP), 1024};
              pg8::gemm_phase<EpiBf, pg8::StaticOrder, false>(F.lds, g, S, E, nullptr); }
        }
        SEAM(9);
#if MK_PROBE == 110
        if (IN(9)) { for (int rep = 0; rep < 9; ++rep) { MKFRAME(); WSP(ws);
            { pg8::Gemm g{(const bf16_t*)(ws + WS_H), (const bf16_t*)(ws + WS_WQ), T, 1024, 1024}; pg8::StaticOrder S; S.init(T, 1024, F.G, (int)blockIdx.x); EpiBf E{(bf16_t*)(ws + WS_QP), 1024};
              pg8::gemm_phase<EpiBf, pg8::StaticOrder, false>(F.lds, g, S, E, nullptr); } } xcd_barrier(bar); }
#endif
#if MK_PROBE == 109
        if (IN(9)) { MKFRAME(); WSP(ws);
            { pg8::Gemm g{(const bf16_t*)(ws + WS_H), (const bf16_t*)(ws + WS_WQ), T, 1024, 1024}; pg8::StaticOrder S; S.init(T, 1024, F.G, (int)blockIdx.x); EpiBf E{(bf16_t*)(ws + WS_QP), 1024};
              pg8::gemm_phase<EpiBf, pg8::StaticOrder, false>(F.lds, g, S, E, nullptr); } }
        if (IN(9)) { MKFRAME(); WSP(ws);
            { pg8::Gemm g{(const bf16_t*)(ws + WS_PB), (const bf16_t*)(ws + WS_WPP), T, 1024, 256}; pg8::StaticOrder S; S.init(T, 1024, F.G, (int)blockIdx.x); EpiBf E{(bf16_t*)(ws + WS_PP), 1024};
              pg8::gemm_phase<EpiBf, pg8::StaticOrder, false>(F.lds, g, S, E, nullptr); } }
        xcd_barrier(bar);
#endif
        if (IN(10)) { MKFRAME(); for (int tile = F.vb * 8 + F.wave; tile < T / 16; tile += F.G * 8) peer_route_tile(p, tile * 16, F.lane); }
        SEAM(10);
        if (IN(11)) { MKFRAME(); phase_peer_u(p, F); }
        SEAM(11);
        if (IN(12)) { MKFRAME(); phase_peer_coef(p, F); }
        SEAM(12);
        if (IN(13)) { MKFRAME(); phase_peer_v(p, F, p.out, p.out); }
        SEAM(13);
#if MK_PROBE == 130
        if (IN(13)) { MKFRAME(); phase_peer_u(p, F); xcd_barrier(bar); }
#endif
#if MK_PROBE == 131
        if (IN(13)) { MKFRAME(); phase_peer_coef(p, F); xcd_barrier(bar); }
#endif
#if MK_PROBE == 132
        if (IN(13)) { MKFRAME(); phase_peer_v(p, F, p.out, (float*)(p.ws + WS_Y)); xcd_barrier(bar); }
#endif
#if MK_PROBE == 133
        if (IN(13)) { MKFRAME(); for (int tile = F.vb * 8 + F.wave; tile < T / 16; tile += F.G * 8) peer_route_tile(p, tile * 16, F.lane); xcd_barrier(bar); }
#endif
        if (IN(14)) { MKFRAME(); WSP(ws); rmsnorm_rows(p.out, p.in[I_GPLE] + l * 1024, (bf16_t*)(ws + WS_H), F.vb * 8 + F.wave, F.G * 8, F.lane); }
        SEAM(14);
        if (IN(15)) { MKFRAME(); WSP(ws); pg8::Gemm g{(const bf16_t*)(ws + WS_H), (const bf16_t*)(ws + WS_WPG), T, 1024, 1024}; pg8::StaticOrder S; S.init(T, 1024, F.G, (int)blockIdx.x);
            EpiPle E{p.out, (const bf16_t*)(ws + WS_PP)};
            pg8::gemm_phase<EpiPle, pg8::StaticOrder, false>(F.lds, g, S, E, nullptr); }
        SEAM(15);
#undef IN
#undef SEAM
    }
}
}

#ifndef MK_LAUNCH_PER_PHASE
#define MK_LAUNCH_PER_PHASE 0
#endif
extern "C" void kernel_launch(void* const* d_in, const int* in_sizes, int n_in, void* d_out, int out_size, void* d_ws, size_t ws_size, hipStream_t stream) {
    static int grid = 0;
    if (grid == 0) {
        if (n_in != 27 || ws_size < mk::WS_END) { fprintf(stderr, "kernel_launch: need 27 inputs and >= %zu bytes of workspace (got %d, %zu)\n", (size_t)mk::WS_END, n_in, ws_size); grid = -1; return; }
        int dev = 0, cus = 0;
        if (hipGetDevice(&dev) != hipSuccess || hipDeviceGetAttribute(&cus, hipDeviceAttributeMultiprocessorCount, dev) != hipSuccess) { grid = -1; return; }
        if (hipFuncSetAttribute((const void*)mk::mega, hipFuncAttributeMaxDynamicSharedMemorySize, mk::LDS_BYTES) != hipSuccess) { fprintf(stderr, "kernel_launch: hipFuncSetAttribute failed\n"); grid = -1; return; }
        int per_cu = 0;
        if (hipOccupancyMaxActiveBlocksPerMultiprocessor(&per_cu, (const void*)mk::mega, 512, mk::LDS_BYTES) != hipSuccess || per_cu < 1) fprintf(stderr, "kernel_launch: occupancy query says %d\n", per_cu);
        (void)hipGetLastError();
        grid = cus;
    }
    if (grid < 0) return;
    (void)in_sizes; (void)out_size;
    hipMemsetAsync((char*)d_ws + mk::WS_CTL, 0, 1u << 20, stream);
    mk::Params prm{};
    for (int i = 0; i < 27; ++i) prm.in[i] = (const float*)d_in[i];
    prm.out = (float*)d_out; prm.ws = (unsigned char*)d_ws;
#if MK_LAUNCH_PER_PHASE
    for (int ph = 0; ph < mk::NLAYER * mk::NPH; ++ph) { prm.ph_lo = ph; prm.ph_hi = ph + 1; hipLaunchKernelGGL(mk::mega, dim3(grid), dim3(512), mk::LDS_BYTES, stream, prm); }
#else
    prm.ph_lo = 0; prm.ph_hi = mk::NLAYER * mk::NPH; hipLaunchKernelGGL(mk::mega, dim3(grid), dim3(512), mk::LDS_BYTES, stream, prm);
#endif
}
```

```cpp
#include <hip/hip_runtime.h>
#include <stdio.h>
#include <stdint.h>
namespace pg8 {
#define PG8_LAS __attribute__((address_space(3)))
typedef unsigned short bf16_t;
typedef short bf16x8 __attribute__((ext_vector_type(8)));
typedef float f32x4 __attribute__((ext_vector_type(4)));
typedef unsigned u32x4 __attribute__((ext_vector_type(4)));
constexpr int BM = 256, BK = 64, HALF = 128, HTB = HALF * BK * 2  , STAGE_BYTES = 8 * HTB, NXCD = 8, WGM = 8;

__host__ __device__ __forceinline__ int lds_byte(int r, int c) { const int st = (r >> 4) * 2 + (c >> 5), rr = r & 15, cc = c & 31, ob = rr * 64 + cc * 2; return st * 1024 + (ob ^ (((ob >> 9) & 1) << 5)); }
__host__ __device__ __forceinline__ void stage_rc(int b, int& R, int& C) { const int st = b / 1024, sb = b % 1024, swz = sb ^ (((sb >> 9) & 1) << 5); R = (st >> 1) * 16 + swz / 64; C = (st & 1) * 32 + (swz % 64) / 2; }
__host__ __device__ __forceinline__ int perm32(int rho) { const int n = rho >> 4, i = rho & 15; return 8 * (i >> 2) + 4 * n + (i & 3); }

struct Unit { int pm, pn; };
struct Gemm { const bf16_t* A; const bf16_t* Bt; int M, N, K; };

struct StaticOrder {
    int nM, nN, nwg, G, c;
    __host__ __device__ void init(int M, int N, int G_, int c_) { nM = M / BM; nN = N / BM; nwg = nM * nN; G = G_; c = c_; }
    __host__ __device__ bool next(int i, Unit& u) const {
        const long L = (long)i * G + c; if (L >= nwg) return false;
        int wgid = (int)L; { const int q = nwg / NXCD, r = nwg % NXCD, xcd = wgid % NXCD, off = wgid / NXCD; wgid = (xcd < r ? xcd * (q + 1) : r * (q + 1) + (xcd - r) * q) + off; }
        const int nig = WGM * nN, gid = wgid / nig, fm = gid * WGM, gsz = (nM - fm) < WGM ? (nM - fm) : WGM;
        u.pm = fm + ((wgid % nig) % gsz); u.pn = (wgid % nig) / gsz; return true;
    }
    __device__ __forceinline__ void a_ready(const Unit&) const {}
    __device__ __forceinline__ void done(const Unit&) const {}
};
__device__ __forceinline__ unsigned cvt_pk_bf16(float lo, float hi) { unsigned r; asm volatile("v_cvt_pk_bf16_f32 %0, %1, %2" : "=v"(r) : "v"(lo), "v"(hi)); return r; }
template <class Epi, class Sched, bool STAMP = false>
__device__ __forceinline__ void gemm_phase(PG8_LAS unsigned char* lds, const Gemm g, const Sched& S, const Epi& E, unsigned long long* stamps) {
    int tid_l = threadIdx.x; asm volatile("" : "+v"(tid_l));
    const int tid = tid_l, wid = __builtin_amdgcn_readfirstlane(tid >> 6), lane = tid & 63, wr = wid >> 2, wc = wid & 3, fr = lane & 15, fq = lane >> 4;
    const int K = g.K, nt = K / BK;
    int ts_lo = 0, ts_hi = 0, nts = 0; const unsigned long long rt_entry = STAMP ? (unsigned long long)wall_clock64() : 0ull;
#define PG8_STAMP() do { if (STAMP && wid == 0 && nts < 64) { const unsigned long long _c = (unsigned long long)clock64(); \
        ts_lo = (lane == nts) ? (int)(unsigned)_c : ts_lo; ts_hi = (lane == nts) ? (int)(unsigned)(_c >> 32) : ts_hi; ++nts; } } while (0)
    PG8_STAMP();
    unsigned voffA[2], voffB[2];
#pragma unroll
    for (int i = 0; i < 2; ++i) { int R, C; stage_rc(tid * 16 + i * 8192, R, C); const int Rb = Epi::PERM ? ((R & ~31) + perm32(R & 31)) : R;
        voffA[i] = (unsigned)(R * K + C) * 2u; voffB[i] = (unsigned)(Rb * K + C) * 2u; }
    const size_t kstep = (size_t)(BK * 2);
    const size_t hstep = (size_t)HALF * K * 2;
    const size_t tstep = 2 * hstep;
    const unsigned ldsw = (unsigned)wid * 1024u;
    const int aoff = lds_byte(wr * 64 + fr, fq * 8), boff = lds_byte(wc * 32 + fr, fq * 8);
#define PG8_SA(b, h) (((b) * 2 + (h)) * HTB)
#define PG8_SB(b, h) ((4 + (b) * 2 + (h)) * HTB)
#define PG8_STAGE(bufoff, gbase, voff) do { _Pragma("unroll") for (int _i = 0; _i < 2; ++_i) \
        __builtin_amdgcn_global_load_lds((const unsigned*)((const char*)(gbase) + (voff)[_i]), (PG8_LAS unsigned*)(lds + (bufoff) + ldsw + _i * 8192), 16, 0, 0); } while (0)
#define PG8_LDA(dst, b, h) do { _Pragma("unroll") for (int m = 0; m < 4; ++m) _Pragma("unroll") for (int k = 0; k < 2; ++k) dst[m][k] = *(const PG8_LAS bf16x8*)(lds + PG8_SA(b, h) + aoff + m * 2048 + k * 1024); } while (0)
#define PG8_LDB(dst, b, h) do { _Pragma("unroll") for (int n = 0; n < 2; ++n) _Pragma("unroll") for (int k = 0; k < 2; ++k) dst[n][k] = *(const PG8_LAS bf16x8*)(lds + PG8_SB(b, h) + boff + n * 2048 + k * 1024); } while (0)
#define PG8_MMA(ai, bj, At, Bt) do { __builtin_amdgcn_s_setprio(1); _Pragma("unroll") for (int m = 0; m < 4; ++m) _Pragma("unroll") for (int n = 0; n < 2; ++n) _Pragma("unroll") for (int k = 0; k < 2; ++k) \
        acc[ai][bj][m][n] = __builtin_amdgcn_mfma_f32_16x16x32_bf16(Bt[n][k], At[m][k], acc[ai][bj][m][n], 0, 0, 0); __builtin_amdgcn_s_setprio(0); } while (0)
#define PG8_WAIT_V(n) asm volatile("s_waitcnt vmcnt(" #n ")" ::: "memory")
#define PG8_WAIT_L(n) asm volatile("s_waitcnt lgkmcnt(" #n ")" ::: "memory")
#define PG8_BAR __builtin_amdgcn_s_barrier()
#define PG8_SCHED __builtin_amdgcn_sched_barrier(0)
    Unit cur, nxt; int ui = 0;
    if (!S.next(0, cur)) return;
    f32x4 acc[2][2][4][2];
#pragma unroll
    for (int a = 0; a < 2; ++a)
#pragma unroll
        for (int b = 0; b < 2; ++b)
#pragma unroll
            for (int m = 0; m < 4; ++m)
#pragma unroll
                for (int n = 0; n < 2; ++n) acc[a][b][m][n] = (f32x4){0.f, 0.f, 0.f, 0.f};
    bf16x8 At[4][2], B0[2][2], B1[2][2];
    const char* cA = (const char*)g.A + (size_t)cur.pm * tstep; const char* cB = (const char*)g.Bt + (size_t)cur.pn * tstep;
    S.a_ready(cur);
    PG8_STAGE(PG8_SB(0, 0), cB, voffB); PG8_STAGE(PG8_SA(0, 0), cA, voffA); PG8_STAGE(PG8_SB(0, 1), cB + hstep, voffB); PG8_STAGE(PG8_SA(0, 1), cA + hstep, voffA);
    if (wr == 1) PG8_BAR;
    PG8_WAIT_V(4); PG8_BAR;
    PG8_STAGE(PG8_SB(1, 0), cB + kstep, voffB); PG8_STAGE(PG8_SA(1, 0), cA + kstep, voffA); PG8_STAGE(PG8_SB(1, 1), cB + hstep + kstep, voffB);
    PG8_WAIT_V(6); PG8_BAR;
    PG8_STAMP();
    for (;;) {
        const bool has_next = S.next(ui + 1, nxt);
        const char* nA = has_next ? (const char*)g.A + (size_t)nxt.pm * tstep : cA; const char* nB = has_next ? (const char*)g.Bt + (size_t)nxt.pn * tstep : cB;
        for (int t = 0; t < nt; t += 2) {
            const bool last = (t == nt - 2);
            const char* a1 = cA + (size_t)(t + 1) * kstep;
            const char* a2 = last ? nA : cA + (size_t)(t + 2) * kstep; const char* b2 = last ? nB : cB + (size_t)(t + 2) * kstep;
            const char* a3 = a2 + kstep; const char* b3 = b2 + kstep;
            if (last && has_next) S.a_ready(nxt);
            PG8_LDB(B0, 0, 0); PG8_SCHED; PG8_LDA(At, 0, 0); PG8_STAGE(PG8_SA(1, 1), a1 + hstep, voffA);
            PG8_WAIT_L(8); PG8_BAR; PG8_WAIT_L(0); PG8_MMA(0, 0, At, B0); PG8_BAR; PG8_SCHED;
            PG8_LDB(B1, 0, 1); PG8_STAGE(PG8_SB(0, 0), b2, voffB);
            PG8_BAR; PG8_WAIT_L(0); PG8_MMA(0, 1, At, B1); PG8_BAR;
            PG8_LDA(At, 0, 1); PG8_STAGE(PG8_SA(0, 0), a2, voffA);
            PG8_BAR; PG8_WAIT_L(0); PG8_MMA(1, 0, At, B0); PG8_BAR; PG8_SCHED;
            PG8_STAGE(PG8_SB(0, 1), b2 + hstep, voffB);
            PG8_WAIT_V(6); PG8_BAR; PG8_MMA(1, 1, At, B1); PG8_BAR;
            PG8_LDB(B0, 1, 0); PG8_SCHED; PG8_LDA(At, 1, 0); PG8_STAGE(PG8_SA(0, 1), a2 + hstep, voffA);
            PG8_WAIT_L(8); PG8_BAR; PG8_WAIT_L(0); PG8_MMA(0, 0, At, B0); PG8_BAR; PG8_SCHED;
            PG8_LDB(B1, 1, 1); PG8_STAGE(PG8_SB(1, 0), b3, voffB);
            PG8_BAR; PG8_WAIT_L(0); PG8_MMA(0, 1, At, B1); PG8_BAR;
            PG8_LDA(At, 1, 1); PG8_STAGE(PG8_SA(1, 0), a3, voffA);
            PG8_BAR; PG8_WAIT_L(0); PG8_MMA(1, 0, At, B0); PG8_BAR; PG8_SCHED;
            PG8_STAGE(PG8_SB(1, 1), b3 + hstep, voffB);
            PG8_WAIT_V(6); PG8_BAR; PG8_MMA(1, 1, At, B1); PG8_BAR;
        }
        PG8_STAMP();
        if constexpr (!Epi::AFTER_DRAIN) { E(acc, cur, wr, wc, fr, fq); S.done(cur); }
        PG8_STAMP();
        if (!has_next) break;
#pragma unroll
        for (int a = 0; a < 2; ++a)
#pragma unroll
            for (int b = 0; b < 2; ++b)
#pragma unroll
                for (int m = 0; m < 4; ++m)
#pragma unroll
                    for (int n = 0; n < 2; ++n) acc[a][b][m][n] = (f32x4){0.f, 0.f, 0.f, 0.f};
        cur = nxt; cA = nA; cB = nB; ++ui;
    }
    PG8_WAIT_V(0);
    if (wr == 0) PG8_BAR;
    PG8_BAR;
    if constexpr (Epi::AFTER_DRAIN) { E.fused(acc, cur, wr, wc, fr, fq, lds, wid, lane); S.done(cur); }
    PG8_STAMP();
    if (STAMP && wid == 0) { stamps[lane] = lane < nts ? (((unsigned long long)(unsigned)ts_hi << 32) | (unsigned)ts_lo) : 0ull;
        if (lane == 62) stamps[62] = rt_entry; if (lane == 63) stamps[63] = (unsigned long long)wall_clock64(); }
#undef PG8_STAMP
#undef PG8_SA
#undef PG8_SB
#undef PG8_STAGE
#undef PG8_LDA
#undef PG8_LDB
#undef PG8_MMA
#undef PG8_WAIT_V
#undef PG8_WAIT_L
#undef PG8_BAR
#undef PG8_SCHED
}
}
#define XB_TMO      128
#define XB_XCNT(j)  (256  + 64 * (j))
#define XB_XSUB(j)  (1280 + 64 * (j))
#define XB_XGEN(j)  (2304 + 64 * (j))
#define XB_TOP      3328
#define XB_TOPGEN   3392
#define XCD_BAR_WORDS 3456
#define XB_SPIN_CAP (1u << 18)
#define LAS __attribute__((address_space(3)))

__device__ __forceinline__ unsigned xb_ld(unsigned* p)              { return __hip_atomic_load(p, __ATOMIC_RELAXED, __HIP_MEMORY_SCOPE_AGENT); }
__device__ __forceinline__ unsigned xb_add(unsigned* p, unsigned v) { return __hip_atomic_fetch_add(p, v, __ATOMIC_RELAXED, __HIP_MEMORY_SCOPE_AGENT); }
__device__ __forceinline__ unsigned xb_xcc_id() { return (unsigned)__builtin_amdgcn_s_getreg((3 << 11) | 20) & 0xFu; }
#define XB_SPIN(cond, bar) do { unsigned _sp = 0; while (cond) { __builtin_amdgcn_s_sleep(1); \
    if ((++_sp & 255u) == 0u) { if (xb_ld(&(bar)[XB_TMO])) break; if (_sp > XB_SPIN_CAP) { atomicAdd(&(bar)[XB_TMO], 1u); break; } } } } while (0)

struct XcdBarrier {
    unsigned* bar; unsigned x;
    volatile LAS unsigned* st;
};

__device__ __forceinline__ XcdBarrier xcd_barrier_post(unsigned* bar, volatile LAS unsigned* st) {
    XcdBarrier b; b.bar = bar; b.x = xb_xcc_id(); b.st = st;
    if (threadIdx.x == 0) (void)xb_add(&bar[XB_XCNT(b.x)], 1u);
    return b;
}
__device__ __forceinline__ void xcd_barrier_complete(unsigned* bar, unsigned x, unsigned& nloc, unsigned& nx) {
    const unsigned G = gridDim.x * gridDim.y * gridDim.z;
    unsigned sum, cnt, mine, sp = 0u;
    for (;;) {
        sum = 0u; cnt = 0u; mine = 0u;
#pragma unroll
        for (unsigned j = 0; j < 16; ++j) { const unsigned c = xb_ld(&bar[XB_XCNT(j)]); sum += c; cnt += (c > 0u) ? 1u : 0u; mine = (j == x) ? c : mine; }
        if (sum == G) break;
        __builtin_amdgcn_s_sleep(1);
        if ((++sp & 255u) == 0u) { if (xb_ld(&bar[XB_TMO])) break; if (sp > XB_SPIN_CAP) { atomicAdd(&bar[XB_TMO], 1u); break; } }
    }
    nloc = mine > 0u ? mine : 1u; nx = cnt > 0u ? cnt : 1u;
}

__device__ __forceinline__ void xcd_barrier(const XcdBarrier& b) {
    asm volatile("s_waitcnt vmcnt(0)" ::: "memory");
    __syncthreads();
    if (threadIdx.x == 0) {
        unsigned* bar = b.bar;
        __builtin_amdgcn_s_waitcnt(0);
        unsigned nloc = b.st[0], nx = b.st[1];
        if (nloc == 0u) { xcd_barrier_complete(bar, b.x, nloc, nx); b.st[0] = nloc; b.st[1] = nx; }
        const unsigned old = xb_add(&bar[XB_XSUB(b.x)], 1u);
        const unsigned gen = old / nloc;
        if (old + 1u == (gen + 1u) * nloc) {
            __builtin_amdgcn_fence(__ATOMIC_RELEASE, "agent");
            asm volatile("s_waitcnt vmcnt(0)" ::: "memory");
            const unsigned og = xb_add(&bar[XB_TOP], 1u);
            const unsigned tg = og / nx;
            if (og + 1u == (tg + 1u) * nx) xb_add(&bar[XB_TOPGEN], 1u);
            else XB_SPIN(xb_ld(&bar[XB_TOPGEN]) == tg, bar);
            __builtin_amdgcn_fence(__ATOMIC_ACQUIRE, "agent");
            xb_add(&bar[XB_XGEN(b.x)], 1u);
            asm volatile("s_waitcnt vmcnt(0)" ::: "memory");
        } else {
            XB_SPIN(xb_ld(&bar[XB_XGEN(b.x)]) == gen, bar);
            __builtin_amdgcn_fence(__ATOMIC_ACQUIRE, "agent");
            asm volatile("s_waitcnt vmcnt(0)" ::: "memory");
        }
    }
    __syncthreads();
}

namespace mk {
using pg8::bf16_t; using pg8::bf16x8; using pg8::f32x4; using pg8::u32x4;
typedef unsigned u32x2 __attribute__((ext_vector_type(2)));
typedef short s16x4 __attribute__((ext_vector_type(4)));
#define DI __device__ __forceinline__
#define LDS_WAIT() asm volatile("s_waitcnt lgkmcnt(0)" ::: "memory")
#define LDS_FENCE() asm volatile("" ::: "memory")
#define MFMA16(a, b, c) __builtin_amdgcn_mfma_f32_16x16x32_bf16((a), (b), (c), 0, 0, 0)

constexpr int T = 32768, SEQ = 4096, NLAYER = 4, NPH = 16;
constexpr int PW = 5120;
constexpr int C_AB = 0, C_AC = 512, C_AX = 1024, C_NQ = 1536, C_NKV = 2048, C_UV = 2816, C_DQ = 3840, C_DK = 4352, C_DV = 4416,
              C_DQI = 4480, C_DKI = 4992, C_NG = 5056, C_DWI = 5080;
constexpr size_t MiB = 1u << 20;
constexpr size_t WS_CTL = 0, WS_PEB = 1 * MiB, WS_CMPK = 2 * MiB, WS_CMPV = 3 * MiB, WS_SK = 4 * MiB, WS_SGUW = 5 * MiB, WS_CMPA = 8 * MiB,
                 WS_CMPP = 24 * MiB, WS_WCAT = 40 * MiB, WS_WBR = 58 * MiB, WS_WOUT4 = 62 * MiB, WS_WQ = 70 * MiB, WS_WPG = 72 * MiB,
                 WS_WPP = 74 * MiB, WS_W1C = 75 * MiB, WS_PB = 78 * MiB, WS_PTU = 96 * MiB, WS_PTV = 128 * MiB, WS_H = 160 * MiB,
                 WS_Y = 224 * MiB, WS_PROJ = 352 * MiB, WS_GATES = 672 * MiB,
                 WS_KS = 928 * MiB, WS_VS = 936 * MiB, WS_KW = 944 * MiB, WS_VW = 952 * MiB, WS_DK = 960 * MiB, WS_DV = 964 * MiB, WS_DKI = 968 * MiB, WS_END = 972 * MiB;
constexpr size_t WS_ACCF = WS_PROJ, WS_MERGED = WS_PROJ + 128 * MiB, WS_QP = WS_PROJ, WS_PP = WS_PROJ + 64 * MiB, WS_EIDX = WS_PROJ + 128 * MiB, WS_EW = WS_PROJ + 144 * MiB, WS_EU = WS_PROJ + 160 * MiB;
constexpr size_t WS_COEF = WS_PROJ + 176 * MiB, WS_H8 = WS_PROJ + 192 * MiB, WS_HSI = WS_PROJ + 224 * MiB, WS_PD = WS_GATES, PT_SLICE = 2 * MiB;
constexpr int LDS_BYTES = 163840, LDS_PERWAVE = 19456, LDS_BUCK = 8 * LDS_PERWAVE, LDS_TBL = LDS_BUCK + 4096, LDS_XB = LDS_BYTES - 64;

struct Params { const float* in[27]; float* out; unsigned char* ws; int ph_lo, ph_hi; };
enum { I_X = 0, I_P, I_REL, I_GMIX, I_WIN, I_CONVW, I_PE, I_CW1, I_CW2, I_NQG, I_NKG, I_LNG, I_SGUW, I_SGUB, I_DQG, I_DKG, I_WGATE, I_WBR, I_WOUT,
       I_GFFN, I_WQ, I_SUBK, I_PU, I_PV, I_GPLE, I_WPG, I_WPP };

struct Frame { LAS unsigned char* lds; int tid, lane, wave, vb, G; };

DI float bf2f(unsigned short b) { return __uint_as_float(((unsigned)b) << 16); }
DI unsigned f2bf(float f) { unsigned u = __float_as_uint(f); return (u + 0x7fffu + ((u >> 16) & 1u)) >> 16; }
DI unsigned pk2(float lo, float hi) { return pg8::cvt_pk_bf16(lo, hi); }
DI float lo16(unsigned w) { return __uint_as_float(w << 16); }
DI float hi16(unsigned w) { return __uint_as_float(w & 0xffff0000u); }
DI float sigm(float x) { return __builtin_amdgcn_rcpf(1.f + __builtin_amdgcn_exp2f(-1.44269504f * x)); }
DI float gelu_t(float x) { const float y = (-2.f * 0.7978845608f * 1.44269504f) * (x + 0.044715f * x * x * x); return x * __builtin_amdgcn_rcpf(1.f + __builtin_amdgcn_exp2f(y)); }
#define DPP_I(x, ctrl) __builtin_amdgcn_update_dpp(0, (x), (ctrl), 0xF, 0xF, false)
DI float dppf(float x, int) { return x; }
DI float row16_sumf(float v) { v += __builtin_bit_cast(float, DPP_I(__builtin_bit_cast(int, v), 0xB1)); v += __builtin_bit_cast(float, DPP_I(__builtin_bit_cast(int, v), 0x4E));
    v += __builtin_bit_cast(float, DPP_I(__builtin_bit_cast(int, v), 0x141)); v += __builtin_bit_cast(float, DPP_I(__builtin_bit_cast(int, v), 0x140)); return v; }
DI float row16_maxf(float v) { v = fmaxf(v, __builtin_bit_cast(float, DPP_I(__builtin_bit_cast(int, v), 0xB1))); v = fmaxf(v, __builtin_bit_cast(float, DPP_I(__builtin_bit_cast(int, v), 0x4E)));
    v = fmaxf(v, __builtin_bit_cast(float, DPP_I(__builtin_bit_cast(int, v), 0x141))); v = fmaxf(v, __builtin_bit_cast(float, DPP_I(__builtin_bit_cast(int, v), 0x140))); return v; }
DI float quad_sumf(float v) { v += __builtin_bit_cast(float, DPP_I(__builtin_bit_cast(int, v), 0xB1)); v += __builtin_bit_cast(float, DPP_I(__builtin_bit_cast(int, v), 0x4E)); return v; }
DI float oct_sumf(float v) { v = quad_sumf(v); v += __builtin_bit_cast(float, DPP_I(__builtin_bit_cast(int, v), 0x141)); return v; }
DI float x16_sum(float v) { const unsigned u = __float_as_uint(v); const auto r = __builtin_amdgcn_permlane16_swap(u, u, false, false); return __uint_as_float(r[0]) + __uint_as_float(r[1]); }
DI float x32_sum(float v) { const unsigned u = __float_as_uint(v); const auto r = __builtin_amdgcn_permlane32_swap(u, u, false, false); return __uint_as_float(r[0]) + __uint_as_float(r[1]); }
DI float x16_max(float v) { const unsigned u = __float_as_uint(v); const auto r = __builtin_amdgcn_permlane16_swap(u, u, false, false); return fmaxf(__uint_as_float(r[0]), __uint_as_float(r[1])); }
DI float x32_max(float v) { const unsigned u = __float_as_uint(v); const auto r = __builtin_amdgcn_permlane32_swap(u, u, false, false); return fmaxf(__uint_as_float(r[0]), __uint_as_float(r[1])); }
DI float wave_sum(float v) { return x32_sum(x16_sum(row16_sumf(v))); }
DI float wave_max(float v) { return x32_max(x16_max(row16_maxf(v))); }
DI unsigned ordf(float f) { const unsigned u = __float_as_uint(f); return (u & 0x80000000u) ? ~u : (u | 0x80000000u); }
DI float unordf(unsigned x) { return __uint_as_float((x & 0x80000000u) ? (x & 0x7fffffffu) : ~x); }
DI int bucket_of(int n) {
    if (n < 16) return n;
    int b = 16;
    b += (n >= 21); b += (n >= 27); b += (n >= 35); b += (n >= 46); b += (n >= 59); b += (n >= 77); b += (n >= 99); b += (n >= 128);
    b += (n >= 166); b += (n >= 216); b += (n >= 280); b += (n >= 363); b += (n >= 470); b += (n >= 609); b += (n >= 790);
    return b; }

DI int srccol(int n) { return n < 2816 ? n : (n < 5056 ? n + 24 : (n < 5080 ? n - 2240 : (n < 5088 ? n : -1))); }
DI void tr_item(const float* W, int ldw, bf16_t* WT, int ldwt, int k0, int n0, LAS float* scr, int lane, bool remap, int ncopy, int cstride) {
    float tv[32];
#pragma unroll
    for (int i = 0; i < 32; ++i) { const int kk = 2 * i + (lane >> 5), nl = lane & 31; const int n = n0 + nl; const int src = remap ? srccol(n) : n; tv[i] = src >= 0 ? W[(size_t)(k0 + kk) * ldw + src] : 0.f; }
#pragma unroll
    for (int i = 0; i < 32; ++i) { const int kk = 2 * i + (lane >> 5), nl = lane & 31; scr[kk * 33 + nl] = tv[i]; }
    LDS_WAIT();
    const int c = lane & 7;
#pragma unroll
    for (int j = 0; j < 4; ++j) { const int n = (lane >> 3) + 8 * j; const LAS float* s = scr + (8 * c) * 33 + n;
        u32x4 o; o.x = pk2(s[0], s[33]); o.y = pk2(s[66], s[99]); o.z = pk2(s[132], s[165]); o.w = pk2(s[198], s[231]);
        for (int cp = 0; cp < ncopy; ++cp) *(u32x4*)(WT + (size_t)(n0 + n) * ldwt + (size_t)cp * cstride + k0 + 8 * c) = o; }
    LDS_WAIT();
}
DI void cvt_rows(const float* src, bf16_t* dst, size_t ngroups8, int gw, int NGW, int lane) {
    const size_t st = (size_t)NGW * 64;
    for (size_t i0 = (size_t)gw * 64 + lane; i0 < ngroups8; i0 += 4 * st) {
        f32x4 a[4], b[4];
#pragma unroll
        for (int r = 0; r < 4; ++r) { const size_t i = i0 + r * st < ngroups8 ? i0 + r * st : i0; a[r] = ((const f32x4*)src)[2 * i]; b[r] = ((const f32x4*)src)[2 * i + 1]; }
#pragma unroll
        for (int r = 0; r < 4; ++r) { const size_t i = i0 + r * st; if (i >= ngroups8) break;
            u32x4 o; o.x = pk2(a[r].x, a[r].y); o.y = pk2(a[r].z, a[r].w); o.z = pk2(b[r].x, b[r].y); o.w = pk2(b[r].z, b[r].w); ((u32x4*)dst)[i] = o; }
    }
}
DI int pk4_fp8(float a, float b, float c, float d) { int w = 0; w = __builtin_amdgcn_cvt_pk_fp8_f32(a, b, w, false); w = __builtin_amdgcn_cvt_pk_fp8_f32(c, d, w, true); return w; }
DI void cvt_rows_fp8(const float* src, unsigned char* dst, float* scl, int nrows, int gw, int NGW, int lane) {
    for (int r0 = gw; r0 < nrows; r0 += 4 * NGW) {
        f32x4 a[4], b[4], c[4], d[4];
#pragma unroll
        for (int k = 0; k < 4; ++k) { const int r = r0 + k * NGW < nrows ? r0 + k * NGW : r0; const float* s = src + (size_t)r * 1024 + lane * 16;
            a[k] = *(const f32x4*)s; b[k] = *(const f32x4*)(s + 4); c[k] = *(const f32x4*)(s + 8); d[k] = *(const f32x4*)(s + 12); }
#pragma unroll
        for (int k = 0; k < 4; ++k) { const int r = r0 + k * NGW; if (r >= nrows) break;
            float mx = fmaxf(fmaxf(fmaxf(fabsf(a[k].x), fabsf(a[k].y)), fmaxf(fabsf(a[k].z), fabsf(a[k].w))), fmaxf(fmaxf(fabsf(b[k].x), fabsf(b[k].y)), fmaxf(fabsf(b[k].z), fabsf(b[k].w))));
            mx = fmaxf(mx, fmaxf(fmaxf(fmaxf(fabsf(c[k].x), fabsf(c[k].y)), fmaxf(fabsf(c[k].z), fabsf(c[k].w))), fmaxf(fmaxf(fabsf(d[k].x), fabsf(d[k].y)), fmaxf(fabsf(d[k].z), fabsf(d[k].w)))));
            mx = wave_max(mx);
            const float sc = mx > 0.f ? mx * (1.f / 448.f) : 1.f, inv = 1.f / sc;
            u32x4 o; o.x = (unsigned)pk4_fp8(a[k].x * inv, a[k].y * inv, a[k].z * inv, a[k].w * inv); o.y = (unsigned)pk4_fp8(b[k].x * inv, b[k].y * inv, b[k].z * inv, b[k].w * inv);
            o.z = (unsigned)pk4_fp8(c[k].x * inv, c[k].y * inv, c[k].z * inv, c[k].w * inv); o.w = (unsigned)pk4_fp8(d[k].x * inv, d[k].y * inv, d[k].z * inv, d[k].w * inv);
            *(u32x4*)(dst + (size_t)(lane >> 3) * PT_SLICE + (size_t)r * 128 + (lane & 7) * 16) = o;
            if (lane == 0) scl[r] = sc; }
    }
}
DI void rmsnorm_rows(const float* x, const float* g, bf16_t* H, int gw, int NGW, int lane, unsigned char* H8 = nullptr, float* HSI = nullptr) {
    const f32x4 g0 = *(const f32x4*)(g + lane * 8), g1 = *(const f32x4*)(g + lane * 8 + 4), g2 = *(const f32x4*)(g + 512 + lane * 8), g3 = *(const f32x4*)(g + 512 + lane * 8 + 4);
    for (int m0 = gw; m0 < T; m0 += 4 * NGW) {
        f32x4 a[4], b[4], c[4], d[4];
#pragma unroll
        for (int r = 0; r < 4; ++r) { const int m = m0 + r * NGW < T ? m0 + r * NGW : m0; const float* xr = x + (size_t)m * 1024 + lane * 8;
            a[r] = *(const f32x4*)xr; b[r] = *(const f32x4*)(xr + 4); c[r] = *(const f32x4*)(xr + 512); d[r] = *(const f32x4*)(xr + 516); }
#pragma unroll
        for (int r = 0; r < 4; ++r) { const int m = m0 + r * NGW; if (m >= T) break;
            float ss = a[r].x * a[r].x + a[r].y * a[r].y + a[r].z * a[r].z + a[r].w * a[r].w + b[r].x * b[r].x + b[r].y * b[r].y + b[r].z * b[r].z + b[r].w * b[r].w
                     + c[r].x * c[r].x + c[r].y * c[r].y + c[r].z * c[r].z + c[r].w * c[r].w + d[r].x * d[r].x + d[r].y * d[r].y + d[r].z * d[r].z + d[r].w * d[r].w;
            ss = wave_sum(ss);
            const float rr = rsqrtf(ss * (1.f / 1024.f) + 1e-6f);
            u32x4 o0, o1;
            o0.x = pk2(a[r].x * rr * g0.x, a[r].y * rr * g0.y); o0.y = pk2(a[r].z * rr * g0.z, a[r].w * rr * g0.w); o0.z = pk2(b[r].x * rr * g1.x, b[r].y * rr * g1.y); o0.w = pk2(b[r].z * rr * g1.z, b[r].w * rr * g1.w);
            o1.x = pk2(c[r].x * rr * g2.x, c[r].y * rr * g2.y); o1.y = pk2(c[r].z * rr * g2.z, c[r].w * rr * g2.w); o1.z = pk2(d[r].x * rr * g3.x, d[r].y * rr * g3.y); o1.w = pk2(d[r].z * rr * g3.z, d[r].w * rr * g3.w);
            bf16_t* hr = H + (size_t)m * 1024 + lane * 8; *(u32x4*)hr = o0; *(u32x4*)(hr + 512) = o1;
            if (H8) {
                float v[16] = {a[r].x * rr * g0.x, a[r].y * rr * g0.y, a[r].z * rr * g0.z, a[r].w * rr * g0.w, b[r].x * rr * g1.x, b[r].y * rr * g1.y, b[r].z * rr * g1.z, b[r].w * rr * g1.w,
                               c[r].x * rr * g2.x, c[r].y * rr * g2.y, c[r].z * rr * g2.z, c[r].w * rr * g2.w, d[r].x * rr * g3.x, d[r].y * rr * g3.y, d[r].z * rr * g3.z, d[r].w * rr * g3.w};
                float am = 0.f;
#pragma unroll
                for (int e = 0; e < 16; ++e) am = fmaxf(am, fabsf(v[e]));
                am = wave_max(am);
                const float hs = am > 0.f ? 224.f / am : 1.f;
                u32x2 q0, q1; q0.x = (unsigned)pk4_fp8(v[0] * hs, v[1] * hs, v[2] * hs, v[3] * hs); q0.y = (unsigned)pk4_fp8(v[4] * hs, v[5] * hs, v[6] * hs, v[7] * hs);
                q1.x = (unsigned)pk4_fp8(v[8] * hs, v[9] * hs, v[10] * hs, v[11] * hs); q1.y = (unsigned)pk4_fp8(v[12] * hs, v[13] * hs, v[14] * hs, v[15] * hs);
                unsigned char* h8 = H8 + (size_t)m * 1024 + lane * 8; *(u32x2*)h8 = q0; *(u32x2*)(h8 + 512) = q1;
                if (lane == 0) HSI[m] = 1.f / hs; } }
    }
}
DI void phase_prep_w(const Params& p, int l, const Frame& F) {
    LAS float* scr = (LAS float*)(F.lds + F.wave * 8448);
    const int gw = F.vb * 8 + F.wave, NGW = F.G * 8, lane = F.lane;
    unsigned char* ws = p.ws;
    bf16_t* WCAT = (bf16_t*)(ws + WS_WCAT); bf16_t* WBR = (bf16_t*)(ws + WS_WBR); bf16_t* WOUT4 = (bf16_t*)(ws + WS_WOUT4); bf16_t* WQ = (bf16_t*)(ws + WS_WQ);
    bf16_t* WPG = (bf16_t*)(ws + WS_WPG); bf16_t* WPP = (bf16_t*)(ws + WS_WPP); bf16_t* W1C = (bf16_t*)(ws + WS_W1C);
    constexpr int I0 = 2560, I1 = 2048, I2 = 1024, I3 = 512, I4 = 512, I5 = 512, I6 = 128, I7 = 512, NIT = I0 + I1 + I2 + I3 + I4 + I5 + I6 + I7;
    for (int it = gw; it < NIT; it += NGW) {
        int r = it;
        if (r < I0) { tr_item(p.in[I_WIN] + (size_t)l * 1024 * 5088, 5088, WCAT, 1024, (r / 160) * 64, (r % 160) * 32, scr, lane, true, 1, 0); continue; } r -= I0;
        if (r < I1) { tr_item(p.in[I_WGATE] + (size_t)l * 1024 * 4096, 4096, WCAT + (size_t)5120 * 1024, 1024, (r / 128) * 64, (r % 128) * 32, scr, lane, false, 1, 0); continue; } r -= I1;
        if (r < I2) { const int m = r >> 8, rr = r & 255; tr_item(p.in[I_WBR] + ((size_t)l * 2048 + m * 512) * 1024, 1024, WBR + (size_t)m * 1024 * 512, 512, (rr / 32) * 64, (rr % 32) * 32, scr, lane, false, 1, 0); continue; } r -= I2;
        if (r < I3) { tr_item(p.in[I_WOUT] + (size_t)l * 1024 * 1024, 1024, WOUT4, 1024, (r / 32) * 64, (r % 32) * 32, scr, lane, false, 1, 0); continue; } r -= I3;
        if (r < I4) { tr_item(p.in[I_WQ] + (size_t)l * 1024 * 1024, 1024, WQ, 1024, (r / 32) * 64, (r % 32) * 32, scr, lane, false, 1, 0); continue; } r -= I4;
        if (r < I5) { tr_item(p.in[I_WPG] + (size_t)l * 1024 * 1024, 1024, WPG, 1024, (r / 32) * 64, (r % 32) * 32, scr, lane, false, 1, 0); continue; } r -= I5;
        if (r < I6) { tr_item(p.in[I_WPP] + (size_t)l * 256 * 1024, 1024, WPP, 256, (r / 32) * 64, (r % 32) * 32, scr, lane, false, 1, 0); continue; } r -= I6;
        { const int jh = r >> 7, rr = r & 127, j = jh >> 1, half = jh & 1;
          tr_item(p.in[I_CW1] + (((size_t)l * 2 + j) * 2048 + half * 1024) * 256, 256, W1C + ((size_t)j * 512 + half * 256) * 1024, 1024, (rr / 8) * 64, (rr % 8) * 32, scr, lane, false, 1, 0); }
    }
    cvt_rows_fp8(p.in[I_PU] + (size_t)l * 16384 * 1024, ws + WS_PTU, (float*)(ws + WS_PTV), 16384, gw, NGW, lane);
    cvt_rows_fp8(p.in[I_PV] + (size_t)l * 16384 * 1024, ws + WS_PTU + 16 * MiB, (float*)(ws + WS_PTV) + 16384, 16384, gw, NGW, lane);
    cvt_rows(p.in[I_SUBK] + (size_t)l * 131072, (bf16_t*)(ws + WS_SK), 131072 / 8, gw, NGW, lane);
    cvt_rows(p.in[I_P] + (size_t)l * T * 256, (bf16_t*)(ws + WS_PB), (size_t)T * 256 / 8, gw, NGW, lane);
    { const float* sw = p.in[I_SGUW] + (size_t)l * 131072; bf16_t* dst = (bf16_t*)(ws + WS_SGUW);
      for (int i = gw * 64 + lane; i < 131072 / 8; i += NGW * 64) { const int e = i * 8, t = (e >> 7) & 127, s0 = e & 127; float v[8];
#pragma unroll
          for (int k = 0; k < 8; ++k) v[k] = (s0 + k <= t) ? sw[e + k] : 0.f;
          u32x4 o; o.x = pk2(v[0], v[1]); o.y = pk2(v[2], v[3]); o.z = pk2(v[4], v[5]); o.w = pk2(v[6], v[7]); ((u32x4*)dst)[i] = o; } }
    { float* peb = (float*)(ws + WS_PEB);
      for (int o = gw; o < 512; o += NGW) { const int j = o >> 8, n = o & 255; const float* pe = p.in[I_PE] + ((size_t)l * 2 + j) * 2048; const float* w1 = p.in[I_CW1] + ((size_t)l * 2 + j) * 2048 * 256;
          float s = 0.f; for (int k = lane; k < 2048; k += 64) s += pe[k] * w1[(size_t)k * 256 + n];
          s = wave_sum(s); if (lane == 0) peb[o] = s; } }
    rmsnorm_rows(l == 0 ? p.in[I_X] : p.out, p.in[I_GMIX] + l * 1024, (bf16_t*)(ws + WS_H), gw, NGW, lane);
}

struct Epi1 {
    static constexpr bool PERM = true, AFTER_DRAIN = false;
    bf16_t* proj; bf16_t* gates;
    DI void operator()(const f32x4 (&acc)[2][2][4][2], const pg8::Unit& u, int wr, int wc, int fr, int fq) const {
        const int row0 = u.pm * 256 + wr * 64 + fr; const bool isg = u.pn >= 20;
        const int col0 = (isg ? (u.pn - 20) * 256 : u.pn * 256) + wc * 32 + 8 * fq; bf16_t* base = isg ? gates : proj; const int ldc = isg ? 4096 : PW;
#pragma unroll
        for (int ai = 0; ai < 2; ++ai)
#pragma unroll
            for (int m = 0; m < 4; ++m) { bf16_t* rowp = base + (size_t)(row0 + ai * 128 + m * 16) * ldc + col0;
#pragma unroll
                for (int bj = 0; bj < 2; ++bj) { f32x4 v0 = acc[ai][bj][m][0], v1 = acc[ai][bj][m][1];
                    if (isg) { v0.x = sigm(v0.x); v0.y = sigm(v0.y); v0.z = sigm(v0.z); v0.w = sigm(v0.w); v1.x = sigm(v1.x); v1.y = sigm(v1.y); v1.z = sigm(v1.z); v1.w = sigm(v1.w); }
                    u32x4 w; w.x = pk2(v0.x, v0.y); w.y = pk2(v0.z, v0.w); w.z = pk2(v1.x, v1.y); w.w = pk2(v1.z, v1.w);
                    __builtin_nontemporal_store(w, (u32x4*)(rowp + bj * 128)); } }
    }
};
struct EpiBf {
    static constexpr bool PERM = true, AFTER_DRAIN = false;
    bf16_t* O; int ldc;
    DI void operator()(const f32x4 (&acc)[2][2][4][2], const pg8::Unit& u, int wr, int wc, int fr, int fq) const {
        const int row0 = u.pm * 256 + wr * 64 + fr, col0 = u.pn * 256 + wc * 32 + 8 * fq;
#pragma unroll
        for (int ai = 0; ai < 2; ++ai)
#pragma unroll
            for (int m = 0; m < 4; ++m) { bf16_t* rowp = O + (size_t)(row0 + ai * 128 + m * 16) * ldc + col0;
#pragma unroll
                for (int bj = 0; bj < 2; ++bj) { const f32x4 v0 = acc[ai][bj][m][0], v1 = acc[ai][bj][m][1];
                    u32x4 w; w.x = pk2(v0.x, v0.y); w.y = pk2(v0.z, v0.w); w.z = pk2(v1.x, v1.y); w.w = pk2(v1.z, v1.w);
                    *(u32x4*)(rowp + bj * 128) = w; } }
    }
};
struct EpiF32P {
    static constexpr bool PERM = true, AFTER_DRAIN = false;
    float* C; int ldc;
    DI void operator()(const f32x4 (&acc)[2][2][4][2], const pg8::Unit& u, int wr, int wc, int fr, int fq) const {
        const int row0 = u.pm * 256 + wr * 64 + fr, col0 = u.pn * 256 + wc * 32 + 8 * fq;
#pragma unroll
        for (int ai = 0; ai < 2; ++ai)
#pragma unroll
            for (int m = 0; m < 4; ++m) { float* rowp = C + (size_t)(row0 + ai * 128 + m * 16) * ldc + col0;
#pragma unroll
                for (int bj = 0; bj < 2; ++bj) { *(f32x4*)(rowp + bj * 128) = acc[ai][bj][m][0]; *(f32x4*)(rowp + bj * 128 + 4) = acc[ai][bj][m][1]; } }
    }
};
struct XcdColOrder {
    int G, c;
    DI bool next(int i, pg8::Unit& u) const {
        if (G != 256) { const int Lx = i * G + c; if (Lx >= 128 * 36) return false; u.pm = Lx / 36; u.pn = Lx % 36; return true; }
        if (i >= 18) return false;
        const int x = c & 7, w = c >> 3;
        if (i < 16) { u.pm = 8 * i + (w & 7); u.pn = 4 * x + (w >> 3); }
        else { u.pm = 16 * x + 8 * (i - 16) + (w & 7); u.pn = 32 + (w >> 3); }
        return true; }
    DI void a_ready(const pg8::Unit&) const {}
    DI void done(const pg8::Unit&) const {}
};
struct RoundOrder {
    pg8::StaticOrder base; int r;
    DI bool next(int i, pg8::Unit& u) const { return i == 0 && base.next(r, u); }
    DI void a_ready(const pg8::Unit&) const {}
    DI void done(const pg8::Unit&) const {}
};
struct ColRangeOrder {
    int G, c, c0, c1;
    DI bool next(int i, pg8::Unit& u) const { const int nc = c1 - c0; const int Lx = i * G + c; if (Lx >= 128 * nc) return false; u.pm = Lx / nc; u.pn = c0 + Lx % nc; return true; }
    DI void a_ready(const pg8::Unit&) const {}
    DI void done(const pg8::Unit&) const {}
};
struct BranchOrder {
    int G, c;
    DI bool next(int i, pg8::Unit& u) const { const int tile = c + G * (i >> 2), m = i & 3; if (tile >= 512) return false; u.pm = m * 128 + (tile >> 2); u.pn = m * 4 + (tile & 3); return true; }
    DI void a_ready(const pg8::Unit&) const {}
    DI void done(const pg8::Unit&) const {}
};
struct EpiBranch {
    static constexpr bool PERM = true, AFTER_DRAIN = false;
    const bf16_t* gates; bf16_t* merged;
    DI void operator()(const f32x4 (&acc)[2][2][4][2], const pg8::Unit& u, int wr, int wc, int fr, int fq) const {
        const int m4 = u.pn >> 2; const int row0 = (u.pm & 127) * 256 + wr * 64 + fr, gcol0 = u.pn * 256 + wc * 32 + 8 * fq, dcol0 = (u.pn & 3) * 256 + wc * 32 + 8 * fq;
#pragma unroll
        for (int ai = 0; ai < 2; ++ai) {
            u32x4 g[4][2], pr[4][2];
#pragma unroll
            for (int m = 0; m < 4; ++m)
#pragma unroll
                for (int bj = 0; bj < 2; ++bj) { g[m][bj] = *(const u32x4*)(gates + (size_t)(row0 + ai * 128 + m * 16) * 4096 + gcol0 + bj * 128);
                    if (m4 > 0) pr[m][bj] = *(const u32x4*)(merged + (size_t)(row0 + ai * 128 + m * 16) * 1024 + dcol0 + bj * 128); }
#pragma unroll
            for (int m = 0; m < 4; ++m)
#pragma unroll
                for (int bj = 0; bj < 2; ++bj) { const f32x4 v0 = acc[ai][bj][m][0], v1 = acc[ai][bj][m][1]; const u32x4 gg = g[m][bj];
                    f32x4 r0 = {v0.x * lo16(gg.x), v0.y * hi16(gg.x), v0.z * lo16(gg.y), v0.w * hi16(gg.y)}, r1 = {v1.x * lo16(gg.z), v1.y * hi16(gg.z), v1.z * lo16(gg.w), v1.w * hi16(gg.w)};
                    if (m4 > 0) { const u32x4 pp_ = pr[m][bj];
                        r0.x += lo16(pp_.x); r0.y += hi16(pp_.x); r0.z += lo16(pp_.y); r0.w += hi16(pp_.y); r1.x += lo16(pp_.z); r1.y += hi16(pp_.z); r1.z += lo16(pp_.w); r1.w += hi16(pp_.w); }
                    u32x4 w; w.x = pk2(r0.x, r0.y); w.y = pk2(r0.z, r0.w); w.z = pk2(r1.x, r1.y); w.w = pk2(r1.z, r1.w);
                    *(u32x4*)(merged + (size_t)(row0 + ai * 128 + m * 16) * 1024 + dcol0 + bj * 128) = w; }
        }
    }
};
struct EpiRes {
    static constexpr bool PERM = true, AFTER_DRAIN = false;
    const float* xin; float* out;
    DI void operator()(const f32x4 (&acc)[2][2][4][2], const pg8::Unit& u, int wr, int wc, int fr, int fq) const {
        const int row0 = u.pm * 256 + wr * 64 + fr, col0 = u.pn * 256 + wc * 32 + 8 * fq;
#pragma unroll
        for (int ai = 0; ai < 2; ++ai)
#pragma unroll
            for (int mh = 0; mh < 2; ++mh) {
                f32x4 xa[2][2][2];
#pragma unroll
                for (int m2 = 0; m2 < 2; ++m2)
#pragma unroll
                    for (int bj = 0; bj < 2; ++bj) { const size_t off = (size_t)(row0 + ai * 128 + (mh * 2 + m2) * 16) * 1024 + col0 + bj * 128; xa[m2][bj][0] = *(const f32x4*)(xin + off); xa[m2][bj][1] = *(const f32x4*)(xin + off + 4); }
#pragma unroll
                for (int m2 = 0; m2 < 2; ++m2)
#pragma unroll
                    for (int bj = 0; bj < 2; ++bj) { const size_t off = (size_t)(row0 + ai * 128 + (mh * 2 + m2) * 16) * 1024 + col0 + bj * 128;
                        *(f32x4*)(out + off) = xa[m2][bj][0] + acc[ai][bj][mh * 2 + m2][0]; *(f32x4*)(out + off + 4) = xa[m2][bj][1] + acc[ai][bj][mh * 2 + m2][1]; }
            }
    }
};
struct EpiPle {
    static constexpr bool PERM = true, AFTER_DRAIN = false;
    float* x; const bf16_t* pp;
    DI void operator()(const f32x4 (&acc)[2][2][4][2], const pg8::Unit& u, int wr, int wc, int fr, int fq) const {
        const int row0 = u.pm * 256 + wr * 64 + fr, col0 = u.pn * 256 + wc * 32 + 8 * fq;
#pragma unroll
        for (int ai = 0; ai < 2; ++ai)
#pragma unroll
            for (int mh = 0; mh < 2; ++mh) {
                f32x4 xa[2][2][2]; u32x4 ga[2][2];
#pragma unroll
                for (int m2 = 0; m2 < 2; ++m2)
#pragma unroll
                    for (int bj = 0; bj < 2; ++bj) { const size_t off = (size_t)(row0 + ai * 128 + (mh * 2 + m2) * 16) * 1024 + col0 + bj * 128;
                        xa[m2][bj][0] = *(const f32x4*)(x + off); xa[m2][bj][1] = *(const f32x4*)(x + off + 4); ga[m2][bj] = *(const u32x4*)(pp + off); }
#pragma unroll
                for (int m2 = 0; m2 < 2; ++m2)
#pragma unroll
                    for (int bj = 0; bj < 2; ++bj) { const size_t off = (size_t)(row0 + ai * 128 + (mh * 2 + m2) * 16) * 1024 + col0 + bj * 128;
                        const f32x4 v0 = acc[ai][bj][mh * 2 + m2][0], v1 = acc[ai][bj][mh * 2 + m2][1]; const u32x4 g = ga[m2][bj]; f32x4 x0 = xa[m2][bj][0], x1 = xa[m2][bj][1];
                        x0.x += sigm(v0.x) * lo16(g.x); x0.y += sigm(v0.y) * hi16(g.x); x0.z += sigm(v0.z) * lo16(g.y); x0.w += sigm(v0.w) * hi16(g.y);
                        x1.x += sigm(v1.x) * lo16(g.z); x1.y += sigm(v1.y) * hi16(g.z); x1.z += sigm(v1.z) * lo16(g.w); x1.w += sigm(v1.w) * hi16(g.w);
                        *(f32x4*)(x + off) = x0; *(f32x4*)(x + off + 4) = x1; }
            }
    }
};


DI void unpack8(const u32x4 w, float (&f)[8]) { f[0] = lo16(w.x); f[1] = hi16(w.x); f[2] = lo16(w.y); f[3] = hi16(w.y); f[4] = lo16(w.z); f[5] = hi16(w.z); f[6] = lo16(w.w); f[7] = hi16(w.w); }
DI u32x4 pack8(const float (&f)[8]) { u32x4 o; o.x = pk2(f[0], f[1]); o.y = pk2(f[2], f[3]); o.z = pk2(f[4], f[5]); o.w = pk2(f[6], f[7]); return o; }
DI void load8f(const float* p, float (&f)[8]) { const f32x4 a = *(const f32x4*)p, b = *(const f32x4*)(p + 4); f[0] = a.x; f[1] = a.y; f[2] = a.z; f[3] = a.w; f[4] = b.x; f[5] = b.y; f[6] = b.z; f[7] = b.w; }

DI void phase_chunk(const Params& p, int l, const Frame& F) {
    unsigned char* ws = p.ws; const int lane = F.lane, wave = F.wave;
    bf16_t* PROJ = (bf16_t*)(ws + WS_PROJ); bf16_t* YA = (bf16_t*)(ws + WS_Y); bf16_t* YC = YA + (size_t)2 * T * 512; bf16_t* CMPA = (bf16_t*)(ws + WS_CMPA);
    const bf16_t* SGUW = (const bf16_t*)(ws + WS_SGUW);
    LAS unsigned char* vnT = F.lds;
    const float* convw = p.in[I_CONVW] + (size_t)l * 3 * 512; const float* lng = p.in[I_LNG] + (size_t)l * 512; const float* sgub = p.in[I_SGUB] + (size_t)l * 8 * 128;
    float cw0[8], cw1[8], cw2[8], lgn[8];
    load8f(convw + lane * 8, cw0); load8f(convw + 512 + lane * 8, cw1); load8f(convw + 1024 + lane * 8, cw2); load8f(lng + lane * 8, lgn);
    for (int chunk = F.vb; chunk < T / 128; chunk += F.G) {
        const int t0 = chunk * 128;
        for (int tt = wave; tt < 128; tt += 8) {
            const int t = t0 + tt, s = t & (SEQ - 1), b = t >> 12;
            bf16_t* row = PROJ + (size_t)t * PW;
            const int c0 = lane * 8;
            const u32x4 z = {0u, 0u, 0u, 0u};
            const u32x4 rab = *(const u32x4*)(row + C_AB + c0), rc0 = *(const u32x4*)(row + C_AC + c0), rx0 = *(const u32x4*)(row + C_AX + c0);
            u32x4 r1c = z, r1x = z, r2c = z, r2x = z;
            if (s >= 1) { r1c = *(const u32x4*)(row - PW + C_AC + c0); r1x = *(const u32x4*)(row - PW + C_AX + c0); }
            if (s >= 2) { r2c = *(const u32x4*)(row - 2 * PW + C_AC + c0); r2x = *(const u32x4*)(row - 2 * PW + C_AX + c0); }
            u32x4 segv[3]; int segcol[3]; const float* seggp[3]; float segsc[3];
#pragma unroll
            for (int pass = 0; pass < 3; ++pass) {
                const int seg = pass * 8 + (lane >> 3), sg = seg < 20 ? seg : 20; int col; const float* gp; float sc = 1.f;
                if (sg < 8) { col = C_NQ + 64 * sg; gp = p.in[I_NQG] + l * 64; sc = 0.125f * 1.44269504f; }
                else if (sg < 10) { col = C_NKV + 2 * 128 + (sg - 8) * 64; gp = p.in[I_NKG] + (l * 3 + 1) * 64; }
                else if (sg < 12) { col = C_NKV + 4 * 128 + (sg - 10) * 64; gp = p.in[I_NKG] + (l * 3 + 2) * 64; }
                else if (sg < 20) { col = C_DQ + 64 * (sg - 12); gp = p.in[I_DQG] + l * 64; sc = 0.125f * 1.44269504f; }
                else { col = C_DK; gp = p.in[I_DKG] + l * 64; }
                segcol[pass] = col; seggp[pass] = gp; segsc[pass] = sc; segv[pass] = *(const u32x4*)(row + col + (lane & 7) * 8);
            }
            u32x4 rawc = z; const bf16_t* rawsrc = row; bf16_t* rawdst = nullptr;
            if (lane < 48) { const int sgc = lane >> 3;
                if (sgc < 2) { rawsrc = row + C_NKV + 3 * 128 + sgc * 64; rawdst = (bf16_t*)(ws + WS_VS) + ((size_t)((b * 2 + sgc) * SEQ + s)) * 64; }
                else if (sgc < 4) { rawsrc = row + C_NKV + 5 * 128 + (sgc - 2) * 64; rawdst = (bf16_t*)(ws + WS_VW) + ((size_t)((b * 2 + (sgc - 2)) * SEQ + s)) * 64; }
                else if (sgc == 4) { rawsrc = row + C_DV; rawdst = (bf16_t*)(ws + WS_DV) + (size_t)t * 64; }
                else { rawsrc = row + C_DKI; rawdst = (bf16_t*)(ws + WS_DKI) + (size_t)t * 64; }
                rawc = *(const u32x4*)(rawsrc + (lane & 7) * 8); }
            u32x4 cmpc = z;
            if (lane < 32) { const int jg = lane >> 3; cmpc = *(const u32x4*)(row + C_NKV + (jg >> 1) * 128 + (jg & 1) * 64 + (lane & 7) * 8); }
            const u32x4 ruv = *(const u32x4*)(row + C_UV + 512 + lane * 8);
            {
                float ab[8], c0v[8], x0v[8], c1v[8], x1v[8], c2v[8], x2v[8], y[8];
                unpack8(rab, ab); unpack8(rc0, c0v); unpack8(rx0, x0v); unpack8(r1c, c1v); unpack8(r1x, x1v); unpack8(r2c, c2v); unpack8(r2x, x2v);
#pragma unroll
                for (int e = 0; e < 8; ++e) y[e] = ab[e] * (cw2[e] * c0v[e] * x0v[e] + cw1[e] * c1v[e] * x1v[e] + cw0[e] * c2v[e] * x2v[e]);
                *(u32x4*)(YA + (size_t)t * 512 + c0) = pack8(y);
            }
#pragma unroll
            for (int pass = 0; pass < 3; ++pass) {
                const int seg = pass * 8 + (lane >> 3), part = lane & 7, sg = seg < 20 ? seg : 20;
                float v[8], g[8]; unpack8(segv[pass], v); load8f(seggp[pass] + part * 8, g);
                float ss = 0.f;
#pragma unroll
                for (int e = 0; e < 8; ++e) ss += v[e] * v[e];
                ss = oct_sumf(ss);
                const float r = rsqrtf(ss * (1.f / 64.f) + 1e-6f) * segsc[pass];
#pragma unroll
                for (int e = 0; e < 8; ++e) v[e] = v[e] * r * g[e];
                bf16_t* dstp = row + segcol[pass] + part * 8;
                if (sg >= 8 && sg < 10) dstp = (bf16_t*)(ws + WS_KS) + ((size_t)((b * 2 + (sg - 8)) * SEQ + s)) * 64 + part * 8;
                else if (sg >= 10 && sg < 12) dstp = (bf16_t*)(ws + WS_KW) + ((size_t)((b * 2 + (sg - 10)) * SEQ + s)) * 64 + part * 8;
                else if (sg == 20) dstp = (bf16_t*)(ws + WS_DK) + (size_t)t * 64 + part * 8;
                if (seg < 21) *(u32x4*)dstp = pack8(v);
            }
            if (lane < 48) *(u32x4*)(rawdst + (lane & 7) * 8) = rawc;
            if (lane < 32) { const int jg = lane >> 3, j = jg >> 1, g = jg & 1, part = lane & 7;
                *(u32x4*)(CMPA + ((size_t)j * 4096 + ((size_t)(b * 256 + (s >> 4)) * 2 + g)) * 1024 + (s & 15) * 64 + part * 8) = cmpc; }
            {
                float v[8]; unpack8(ruv, v);
                float sm = 0.f;
#pragma unroll
                for (int e = 0; e < 8; ++e) { v[e] = gelu_t(v[e]); sm += v[e]; }
                const float mean = wave_sum(sm) * (1.f / 512.f); float sq = 0.f;
#pragma unroll
                for (int e = 0; e < 8; ++e) { v[e] -= mean; sq += v[e] * v[e]; }
                const float r = rsqrtf(wave_sum(sq) * (1.f / 512.f) + 1e-6f);
#pragma unroll
                for (int e = 0; e < 8; ++e) *(LAS unsigned short*)(vnT + (lane * 8 + e) * 272 + tt * 2) = (unsigned short)f2bf(v[e] * r * lgn[e]);
            }
        }
        __syncthreads();
        {
            const int g = wave, c = lane & 15, q = lane >> 4; const bf16_t* Wg = SGUW + (size_t)g * 128 * 128;
            for (int tt16 = 0; tt16 < 8; ++tt16) {
                const int nk = (tt16 >> 1) + 1;
                bf16x8 bw[4];
#pragma unroll
                for (int kk = 0; kk < 4; ++kk) bw[kk] = *(const bf16x8*)(Wg + (size_t)(16 * tt16 + c) * 128 + 32 * (kk < nk ? kk : 0) + 8 * q);
                const int t = t0 + 16 * tt16 + c; const float bias = sgub[g * 128 + 16 * tt16 + c];
#pragma unroll
                for (int dt = 0; dt < 4; ++dt) {
                    f32x4 acc = {0.f, 0.f, 0.f, 0.f};
#pragma unroll
                    for (int kk = 0; kk < 4; ++kk) if (kk < nk) { const bf16x8 a = *(const LAS bf16x8*)(vnT + (g * 64 + 16 * dt + c) * 272 + (32 * kk + 8 * q) * 2); acc = MFMA16(a, bw[kk], acc); }
                    const int ch = g * 64 + 16 * dt + 4 * q;
                    const u32x2 uu = *(const u32x2*)(PROJ + (size_t)t * PW + C_UV + ch);
                    u32x2 o; o.x = pk2(gelu_t(lo16(uu.x)) * (acc[0] + bias), gelu_t(hi16(uu.x)) * (acc[1] + bias)); o.y = pk2(gelu_t(lo16(uu.y)) * (acc[2] + bias), gelu_t(hi16(uu.y)) * (acc[3] + bias));
                    *(u32x2*)(YC + (size_t)t * 512 + ch) = o;
                }
            }
        }
        __syncthreads();
    }
}

DI void phase_cmp2(const Params& p, int l, const Frame& F) {
    unsigned char* ws = p.ws; const int lane = F.lane; const int gw = F.vb * 8 + F.wave, NGW = F.G * 8;
    LAS float* hid = (LAS float*)(F.lds + 131072 + F.wave * 1024);
    LAS float* w2s = (LAS float*)F.lds;
    { const float* w2g = p.in[I_CW2] + (size_t)l * 2 * 256 * 64;
      for (int i = F.tid; i < 2 * 256 * 64 / 4; i += 512) *(LAS f32x4*)(w2s + i * 4) = *(const f32x4*)(w2g + i * 4); }
    __syncthreads();
    const float* CMPP = (const float*)(ws + WS_CMPP); const float* peb = (const float*)(ws + WS_PEB);
    bf16_t* CMPK = (bf16_t*)(ws + WS_CMPK); bf16_t* CMPV = (bf16_t*)(ws + WS_CMPV);
    const float* kg = p.in[I_NKG] + (l * 3 + 0) * 64;
    for (int it = gw; it < 8 * 256 * 2 * 2; it += NGW) {
        const int j = it & 1, g = (it >> 1) & 1, n = (it >> 2) & 255, b = it >> 10;
        bf16_t* dst = (j ? CMPV : CMPK) + ((size_t)(b * 2 + g) * 256 + n) * 64;
        if (n == 255) { dst[lane] = 0; continue; }
        const float* Pa = CMPP + ((size_t)j * 4096 + (size_t)(b * 256 + n) * 2 + g) * 512; const float* Pb = CMPP + ((size_t)j * 4096 + (size_t)(b * 256 + n + 1) * 2 + g) * 512 + 256;
        const f32x4 a = *(const f32x4*)(Pa + lane * 4), bq = *(const f32x4*)(Pb + lane * 4), pe = *(const f32x4*)(peb + j * 256 + lane * 4);
        f32x4 h; h.x = gelu_t(a.x + bq.x + pe.x); h.y = gelu_t(a.y + bq.y + pe.y); h.z = gelu_t(a.z + bq.z + pe.z); h.w = gelu_t(a.w + bq.w + pe.w);
        *(LAS f32x4*)(hid + lane * 4) = h;
        LDS_WAIT();
        const LAS float* w2 = w2s + j * 256 * 64;
        float o = 0.f;
#pragma unroll 16
        for (int k = 0; k < 256; ++k) o += hid[k] * w2[k * 64 + lane];
        if (j == 0) { const float ss = wave_sum(o * o); o = o * rsqrtf(ss * (1.f / 64.f) + 1e-6f) * kg[lane]; }
        dst[lane] = (bf16_t)f2bf(o);
        LDS_WAIT();
    }
}

DI int bucket_fast(int n) { const int big = 16 + (int)((__log2f((float)n) - 4.f) * 2.6666667f + 2e-4f); return n < 16 ? n : (big < 31 ? big : 31); }
struct KsCmp { static constexpr bool CONTIG = true; static constexpr int DSTEP = 16, DMAX = 1 << 30; const bf16_t* kb; const bf16_t* vb; int t0, hb;
    DI void base(int k0, const bf16_t*& k, const bf16_t*& v) const { k = kb + (size_t)k0 * 64; v = vb + (size_t)k0 * 64; }
    DI int dist0(int k0, int c) const { return t0 + (c >> 2) - (16 * k0 + 31); } };
struct KsSel { static constexpr bool CONTIG = true; static constexpr int DSTEP = 1, DMAX = 1 << 30; const bf16_t* kb; const bf16_t* vb; const LAS int* selb; int t, hb;
    DI int p0(int k0) const { return __builtin_amdgcn_readfirstlane(selb[k0 >> 6]) * 64 + (k0 & 63); }
    DI void base(int k0, const bf16_t*& k, const bf16_t*& v) const { const int ps = p0(k0); k = kb + (size_t)ps * 64; v = vb + (size_t)ps * 64; }
    DI int dist0(int k0, int c) const { return t - p0(k0); } };
struct KsWin { static constexpr bool CONTIG = true; static constexpr int DSTEP = 1, DMAX = 512; const bf16_t* kb; const bf16_t* vb; int pstart, t0, hb;
    DI void base(int k0, const bf16_t*& k, const bf16_t*& v) const { k = kb + (size_t)(pstart + k0) * 64; v = vb + (size_t)(pstart + k0) * 64; }
    DI int dist0(int k0, int c) const { return t0 + (c >> 2) - (pstart + k0); } };
struct KsDsa { static constexpr bool CONTIG = false; static constexpr int DSTEP = 1, DMAX = 1 << 30; const bf16_t* kb; const bf16_t* vb; const LAS int* list; int n, t;
    DI int pos(int idx) const { return idx < n ? list[idx] : -1; }
    DI const bf16_t* krow(int idx) const { const int ps = pos(idx); return kb + (size_t)(ps < 0 ? 0 : ps) * 64; }
    DI const bf16_t* vrow(int idx) const { const int ps = pos(idx); return vb + (size_t)(ps < 0 ? 0 : ps) * 64; }
    DI float adjust(int idx, int c, float s, bool& ok, const LAS unsigned char* buck, const LAS float* tbl) const {
        const int ps = pos(idx); ok = ps >= 0 && ps <= t; const int dd = t - ps; const int dc = ok ? (dd < 1023 ? dd : 1023) : 0; return s + tbl[buck[dc] * 16 + 8 + (c & 7)]; } };

template <int MODE, class KS>
DI void flash_run(const KS& ks, int nkeys, const bf16x8 (&qb)[2], f32x4 (&o)[4], float& m_run, float& l_run, LAS unsigned char* vt, LAS float* al, LAS float* pn,
                  const LAS unsigned char* buck, const LAS float* tbl, int lane) {
    const int c = lane & 15, q = lane >> 4;
    bf16x8 A00, A01, A10, A11, B00, B01, B10, B11; u32x4 Av[4], Bv[4];
#define FL_LOAD(B_, kk0) do { if constexpr (KS::CONTIG) { const bf16_t* kbp_; const bf16_t* vbp_; ks.base((kk0), kbp_, vbp_); const bf16_t* kr0 = kbp_ + c * 64 + 8 * q; \
            B_##00 = *(const bf16x8*)kr0; B_##01 = *(const bf16x8*)(kr0 + 32); B_##10 = *(const bf16x8*)(kr0 + 1024); B_##11 = *(const bf16x8*)(kr0 + 1056); \
            if (MODE != 1) { const bf16_t* vr0 = vbp_ + (lane >> 3) * 64 + (lane & 7) * 8; _Pragma("unroll") for (int m = 0; m < 4; ++m) B_##v[m] = *(const u32x4*)(vr0 + m * 512); } } \
        else { const bf16_t* kr0 = ks.krow((kk0) + c); const bf16_t* kr1 = ks.krow((kk0) + 16 + c); \
            B_##00 = *(const bf16x8*)(kr0 + 8 * q); B_##01 = *(const bf16x8*)(kr0 + 32 + 8 * q); B_##10 = *(const bf16x8*)(kr1 + 8 * q); B_##11 = *(const bf16x8*)(kr1 + 32 + 8 * q); \
            if (MODE != 1) { _Pragma("unroll") for (int m = 0; m < 4; ++m) B_##v[m] = *(const u32x4*)(ks.vrow((kk0) + (lane >> 3) + 8 * m) + (lane & 7) * 8); } } } while (0)
#define FL_STEP(B_, K0_) do { \
        f32x4 s0 = {0.f, 0.f, 0.f, 0.f}, s1 = {0.f, 0.f, 0.f, 0.f}; \
        s0 = MFMA16(B_##00, qb[0], s0); s0 = MFMA16(B_##01, qb[1], s0); s1 = MFMA16(B_##10, qb[0], s1); s1 = MFMA16(B_##11, qb[1], s1); \
        float sv[8], pv[8]; bool ok[8]; \
        if constexpr (KS::CONTIG) { \
            const LAS float* trow = tbl + (c & 3) * 1024; const int d0 = ks.dist0((K0_), c) - KS::DSTEP * 4 * q; \
        _Pragma("unroll") \
            for (int i = 0; i < 4; ++i) { const int da = d0 - KS::DSTEP * i, db = da - KS::DSTEP * 16; \
                ok[i] = da >= 0 && da < KS::DMAX; ok[4 + i] = db >= 0 && db < KS::DMAX; \
                sv[i] = s0[i] + trow[da < 0 ? 0 : (da < 1023 ? da : 1023)]; sv[4 + i] = s1[i] + trow[db < 0 ? 0 : (db < 1023 ? db : 1023)]; } \
        } else { \
        _Pragma("unroll") \
            for (int i = 0; i < 4; ++i) { sv[i] = ks.adjust((K0_) + 4 * q + i, c, s0[i], ok[i], buck, tbl); sv[4 + i] = ks.adjust((K0_) + 16 + 4 * q + i, c, s1[i], ok[4 + i], buck, tbl); } \
        } \
        if (MODE == 2) { \
        _Pragma("unroll") \
            for (int e = 0; e < 8; ++e) { pv[e] = ok[e] ? __builtin_amdgcn_exp2f(sv[e]) * l_run : 0.f; \
                const float x = quad_sumf(pv[e]); \
                if ((c & 3) == 0) pn[(c >> 2) * 256 + (K0_) + (e < 4 ? 4 * q + e : 16 + 4 * q + (e - 4))] = x; } \
        } else { \
            float ps = 0.f; \
        _Pragma("unroll") \
            for (int e = 0; e < 8; ++e) { pv[e] = ok[e] ? __builtin_amdgcn_exp2f(sv[e]) : 0.f; ps += pv[e]; } \
            l_run += ps; \
        } \
        if (MODE != 1) { \
        _Pragma("unroll") \
            for (int m = 0; m < 4; ++m) *(LAS u32x4*)(vt + ((lane >> 3) + 8 * m) * 144 + (lane & 7) * 16) = B_##v[m]; \
            LDS_FENCE(); \
            const bf16x8 pa = __builtin_bit_cast(bf16x8, pack8(pv)); \
        _Pragma("unroll") \
            for (int dt = 0; dt < 4; ++dt) { \
                const s16x4 lo = __builtin_amdgcn_ds_read_tr16_b64_v4i16((LAS s16x4*)(vt + (4 * q + (c >> 2)) * 144 + (16 * dt + 4 * (c & 3)) * 2)); \
                const s16x4 hi = __builtin_amdgcn_ds_read_tr16_b64_v4i16((LAS s16x4*)(vt + (16 + 4 * q + (c >> 2)) * 144 + (16 * dt + 4 * (c & 3)) * 2)); \
                const bf16x8 vb8 = __builtin_shufflevector(lo, hi, 0, 1, 2, 3, 4, 5, 6, 7); \
                o[dt] = MFMA16(pa, vb8, o[dt]); \
            } \
            LDS_FENCE(); \
        } \
    } while (0)
    if (nkeys > 0) FL_LOAD(A, 0);
    for (int k0 = 0; k0 < nkeys; k0 += 64) {
        if (k0 + 32 < nkeys) FL_LOAD(B, k0 + 32);
        FL_STEP(A, k0);
        if (k0 + 32 >= nkeys) break;
        if (k0 + 64 < nkeys) FL_LOAD(A, k0 + 64);
        FL_STEP(B, k0 + 32);
    }
#undef FL_STEP
#undef FL_LOAD
    if (MODE == 0) {
        float lt = x32_sum(x16_sum(l_run));
        const float inv = lt > 0.f ? __builtin_amdgcn_rcpf(lt) : 0.f;
        if (q == 0) al[c] = inv;
        LDS_WAIT();
        const f32x4 a4 = *(const LAS f32x4*)(al + 4 * q);
#pragma unroll
        for (int dt = 0; dt < 4; ++dt) o[dt] = o[dt] * a4;
        LDS_WAIT();
    }
}

DI void nsa_tile(const Params& p, int b, int g, int tb, const Frame& F, const LAS float* lut, int vm = 0) {
    unsigned char* ws = p.ws; const int lane = F.lane, wave = F.wave, c = lane & 15, q = lane >> 4;
    const LAS float* tbl = lut + g * 4096;
    LAS unsigned char* wl = F.lds + wave * 9216; LAS unsigned char* vt = wl; LAS float* al = (LAS float*)(wl + 4608); LAS float* pn = (LAS float*)(wl + 4736);
    LAS float* OS = (LAS float*)F.lds; LAS float* LS = (LAS float*)(F.lds + 65536);
    LAS int* SELB = (LAS int*)(F.lds + 73728); LAS int* CNT = (LAS int*)(F.lds + 75776); LAS unsigned short* UNIT = (LAS unsigned short*)(F.lds + 76032); LAS int* NUNIT = (LAS int*)(F.lds + 76416);
    volatile LAS int* TURN = (volatile LAS int*)(F.lds + 76544); LAS unsigned short* LIST = (LAS unsigned short*)(F.lds + 76800);
    LAS unsigned char* vt2 = F.lds + 84992 + wave * 4608;
    const bf16_t* prow0 = (const bf16_t*)(ws + WS_PROJ) + (size_t)(b * SEQ) * PW;
    bf16_t* YB = (bf16_t*)(ws + WS_Y) + (size_t)T * 512;
    const f32x4 z4 = {0.f, 0.f, 0.f, 0.f};
    for (int ii = 0; ii < 2; ++ii) {
        f32x4 accw[4];
        const int item = wave * 2 + ii, t0 = 64 * tb + 4 * item;
#pragma unroll
        for (int k = 0; k < 4; ++k) *(LAS f32x4*)(pn + lane * 4 + 256 * k) = z4;
        bf16x8 qb[2];
        { const bf16_t* qp = prow0 + (size_t)(t0 + (c >> 2)) * PW + C_NQ + (g * 4 + (c & 3)) * 64 + 8 * q; qb[0] = *(const bf16x8*)qp; qb[1] = *(const bf16x8*)(qp + 32); }
        float g0[4], g2[4];
        { const u32x2 ga = *(const u32x2*)(prow0 + (size_t)(t0 + q) * PW + C_NG + 0 * 8 + g * 4), gc = *(const u32x2*)(prow0 + (size_t)(t0 + q) * PW + C_NG + 2 * 8 + g * 4);
          g0[0] = sigm(lo16(ga.x)); g0[1] = sigm(hi16(ga.x)); g0[2] = sigm(lo16(ga.y)); g0[3] = sigm(hi16(ga.y));
          g2[0] = sigm(lo16(gc.x)); g2[1] = sigm(hi16(gc.x)); g2[2] = sigm(lo16(gc.y)); g2[3] = sigm(hi16(gc.y)); }
#pragma unroll
        for (int dt = 0; dt < 4; ++dt) accw[dt] = z4;
        LDS_WAIT();
        const int tl = t0 + 3, nv = tl >= 31 ? ((tl - 31) >> 4) + 1 : 0;
        if (nv > 0 && (vm == 0 || (vm & 1))) {
            const int nk = (nv + 31) & ~31;
            KsCmp ks{(const bf16_t*)(ws + WS_CMPK) + (size_t)(b * 2 + g) * 256 * 64, (const bf16_t*)(ws + WS_CMPV) + (size_t)(b * 2 + g) * 256 * 64, t0, g * 4};
            float m = 0.f, lr = 0.f; f32x4 o[4] = {z4, z4, z4, z4};
            flash_run<1>(ks, nk, qb, o, m, lr, vt, al, pn, (const LAS unsigned char*)vt, tbl, lane);
            lr = x32_sum(x16_sum(lr)); lr = lr > 0.f ? __builtin_amdgcn_rcpf(lr) : 0.f;
            flash_run<2>(ks, nk, qb, o, m, lr, vt, al, pn, (const LAS unsigned char*)vt, tbl, lane);
#pragma unroll
            for (int dt = 0; dt < 4; ++dt) { accw[dt][0] = g0[0] * o[dt][0]; accw[dt][1] = g0[1] * o[dt][1]; accw[dt][2] = g0[2] * o[dt][2]; accw[dt][3] = g0[3] * o[dt][3]; }
        }
        LDS_WAIT();
        {
            const int j = lane; float val[4];
#pragma unroll
            for (int qi = 0; qi < 4; ++qi) {
                if (j == 0 || j == tb) val[qi] = 1e4f;
                else if (j < tb) { const LAS float* pq = pn + qi * 256 + 4 * j; val[qi] = pq[-1] + pq[0] + pq[1] + pq[2] + pq[3]; }
                else val[qi] = -1e30f;
            }
            for (int k = 0; k < 8; ++k) {
#pragma unroll
                for (int qi = 0; qi < 4; ++qi) {
                    const float mx = wave_max(val[qi]); const unsigned long long who = __ballot(val[qi] == mx); const int w = __builtin_ctzll(who);
                    if (lane == 0) SELB[(item * 4 + qi) * 8 + k] = mx > -1e29f ? w : -1;
                    if (lane == w) val[qi] = -3e38f;
                }
            }
        }
        {
            const int pstart = t0 >= 511 ? t0 - 511 : 0, nk = (t0 + 3 - pstart + 1 + 31) & ~31;
            KsWin ks{(const bf16_t*)(ws + WS_KW) + (size_t)(b * 2 + g) * SEQ * 64, (const bf16_t*)(ws + WS_VW) + (size_t)(b * 2 + g) * SEQ * 64, pstart, t0, g * 4};
            float m = 0.f, lr = 0.f; f32x4 o[4] = {z4, z4, z4, z4};
            if (vm == 0 || (vm & 2)) flash_run<0>(ks, nk, qb, o, m, lr, vt, al, pn, (const LAS unsigned char*)vt, tbl, lane);
            if (vm & 4) { flash_run<1>(ks, nk, qb, o, m, lr, vt, al, pn, (const LAS unsigned char*)vt, tbl, lane); o[0][0] += lr; }
#pragma unroll
            for (int dt = 0; dt < 4; ++dt) { accw[dt][0] += g2[0] * o[dt][0]; accw[dt][1] += g2[1] * o[dt][1]; accw[dt][2] += g2[2] * o[dt][2]; accw[dt][3] += g2[3] * o[dt][3]; }
        }
        if (vm == 0) {
            bf16_t* dst = YB + (size_t)(b * SEQ + t0 + q) * 512 + (g * 4) * 64 + c;
#pragma unroll
            for (int dt = 0; dt < 4; ++dt)
#pragma unroll
                for (int i = 0; i < 4; ++i) dst[i * 64 + 16 * dt] = (bf16_t)f2bf(accw[dt][i]);
        }
        else { asm volatile("" :: "v"(accw[0]), "v"(accw[1]), "v"(accw[2]), "v"(accw[3])); }
        LDS_WAIT();
    }
    __syncthreads();
    if (vm != 0) return;
    for (int i = F.tid; i < 66560 / 16; i += 512) *(LAS f32x4*)(F.lds + i * 16) = z4;
    if (F.tid < 64) { CNT[F.tid] = 0; TURN[F.tid] = 0; }
    __syncthreads();
    { const int blk = SELB[F.tid];
      if (blk >= 0) { int rank = 0;
#pragma unroll
          for (int k = 0; k < 8; ++k) { const int ob = SELB[(F.tid & ~7) + k]; rank += (ob >= 0 && ob < blk) ? 1 : 0; }
          const int pos = __hip_atomic_fetch_add(CNT + blk, 1, __ATOMIC_RELAXED, __HIP_MEMORY_SCOPE_WORKGROUP); LIST[blk * 64 + pos] = (unsigned short)((F.tid >> 3) | (rank << 8)); } }
    __syncthreads();
    if (wave == 0) {
        const int uj = (CNT[lane] + 3) >> 2; int inc = uj;
#pragma unroll
        for (int o_ = 1; o_ < 64; o_ <<= 1) { const int v = __shfl_up(inc, o_); if (lane >= o_) inc += v; }
        const int offs = inc - uj;
        for (int u = 0; u < uj; ++u) UNIT[offs + u] = (unsigned short)(lane | (u << 8));
        if (lane == 63) NUNIT[0] = inc;
    }
    __syncthreads();
    {
        const int nu = NUNIT[0];
        const LAS float* trow = tbl + (c & 3) * 1024;
        const bf16_t* KSb = (const bf16_t*)(ws + WS_KS) + (size_t)(b * 2 + g) * SEQ * 64; const bf16_t* VSb = (const bf16_t*)(ws + WS_VS) + (size_t)(b * 2 + g) * SEQ * 64;
        for (int ui = wave; ui < nu; ui += 8) {
            const int uu = UNIT[ui], j = uu & 255, u = uu >> 8, nj = CNT[j];
            const int slot = 4 * u + (c >> 2); const int qrow = slot < nj ? (int)(LIST[j * 64 + slot] & 255) : -1;
            const int slotq = 4 * u + q; const int qo = slotq < nj ? (int)(LIST[j * 64 + slotq] & 255) : -1;
            bf16x8 qs[2] = {(bf16x8){0, 0, 0, 0, 0, 0, 0, 0}, (bf16x8){0, 0, 0, 0, 0, 0, 0, 0}};
            if (qrow >= 0) { const bf16_t* qp = prow0 + (size_t)(64 * tb + qrow) * PW + C_NQ + (g * 4 + (c & 3)) * 64 + 8 * q; qs[0] = *(const bf16x8*)qp; qs[1] = *(const bf16x8*)(qp + 32); }
            const bf16_t* kb0 = KSb + (size_t)(64 * j) * 64; const bf16_t* vb0 = VSb + (size_t)(64 * j) * 64;
            bf16x8 ka[4]; u32x4 vv[4];
#define SEL_LOADK(st) do { const bf16_t* kr0 = kb0 + (32 * (st) + c) * 64 + 8 * q; ka[0] = *(const bf16x8*)kr0; ka[1] = *(const bf16x8*)(kr0 + 32); ka[2] = *(const bf16x8*)(kr0 + 1024); ka[3] = *(const bf16x8*)(kr0 + 1056); } while (0)
#define SEL_LOADV(st) do { const bf16_t* vr0 = vb0 + (32 * (st) + (lane >> 3)) * 64 + (lane & 7) * 8; _Pragma("unroll") for (int m = 0; m < 4; ++m) vv[m] = *(const u32x4*)(vr0 + m * 512); } while (0)
            SEL_LOADK(0); SEL_LOADV(0);
            f32x4 o[4] = {z4, z4, z4, z4}; float lsum = 0.f;
#pragma unroll
            for (int st = 0; st < 2; ++st) {
                f32x4 s0 = z4, s1 = z4;
                s0 = MFMA16(ka[0], qs[0], s0); s0 = MFMA16(ka[1], qs[1], s0); s1 = MFMA16(ka[2], qs[0], s1); s1 = MFMA16(ka[3], qs[1], s1);
                if (st == 0) SEL_LOADK(1);
                const int d0 = 64 * (tb - j) + (qrow < 0 ? 0 : qrow) - 32 * st - 4 * q; float pv[8];
#pragma unroll
                for (int i = 0; i < 4; ++i) { const int da = d0 - i, db = da - 16;
                    const float ea = __builtin_amdgcn_exp2f(s0[i] + trow[da < 0 ? 0 : (da < 1023 ? da : 1023)]), eb = __builtin_amdgcn_exp2f(s1[i] + trow[db < 0 ? 0 : (db < 1023 ? db : 1023)]);
                    pv[i] = (qrow >= 0 && da >= 0) ? ea : 0.f; pv[4 + i] = (qrow >= 0 && db >= 0) ? eb : 0.f; lsum += pv[i] + pv[4 + i]; }
#pragma unroll
                for (int m = 0; m < 4; ++m) *(LAS u32x4*)(vt2 + ((lane >> 3) + 8 * m) * 144 + (lane & 7) * 16) = vv[m];
                if (st == 0) SEL_LOADV(1);
                LDS_FENCE();
                const bf16x8 pa = __builtin_bit_cast(bf16x8, pack8(pv));
#pragma unroll
                for (int dt = 0; dt < 4; ++dt) {
                    const s16x4 lo = __builtin_amdgcn_ds_read_tr16_b64_v4i16((LAS s16x4*)(vt2 + (4 * q + (c >> 2)) * 144 + (16 * dt + 4 * (c & 3)) * 2));
                    const s16x4 hi = __builtin_amdgcn_ds_read_tr16_b64_v4i16((LAS s16x4*)(vt2 + (16 + 4 * q + (c >> 2)) * 144 + (16 * dt + 4 * (c & 3)) * 2));
                    o[dt] = MFMA16(pa, __builtin_shufflevector(lo, hi, 0, 1, 2, 3, 4, 5, 6, 7), o[dt]);
                }
                LDS_FENCE();
            }
#undef SEL_LOADK
#undef SEL_LOADV
            lsum = x32_sum(x16_sum(lsum));
#pragma unroll 1
            for (int s = 0; s < 4; ++s) {
                if (4 * u + s >= nj) break;
                const int ent = LIST[j * 64 + 4 * u + s], qs_ = ent & 255, rk = ent >> 8;
                unsigned spins = 0;
                while (TURN[qs_] != rk) { __builtin_amdgcn_s_sleep(1); if (++spins > (1u << 22)) break; }
                if (q == s) {
#pragma unroll
                    for (int dt = 0; dt < 4; ++dt)
#pragma unroll
                        for (int i = 0; i < 4; ++i) OS[(qs_ * 4 + i) * 64 + 16 * dt + c] += o[dt][i];
                }
                if ((c >> 2) == s && q == 0) LS[qs_ * 4 + (c & 3)] += lsum;
                LDS_WAIT();
                if (lane == 0) TURN[qs_] = rk + 1;
                LDS_WAIT();
            }
        }
    }
    __syncthreads();
    for (int ii = 0; ii < 2; ++ii) {
        const int item = wave * 2 + ii, qq = item * 4 + q, t = 64 * tb + qq;
        const u32x2 gg = *(const u32x2*)(prow0 + (size_t)t * PW + C_NG + 8 + g * 4);
        const float g1[4] = {sigm(lo16(gg.x)), sigm(hi16(gg.x)), sigm(lo16(gg.y)), sigm(hi16(gg.y))};
        const f32x4 l4 = *(const LAS f32x4*)(LS + qq * 4);
        const float inv[4] = {l4.x > 0.f ? g1[0] / l4.x : 0.f, l4.y > 0.f ? g1[1] / l4.y : 0.f, l4.z > 0.f ? g1[2] / l4.z : 0.f, l4.w > 0.f ? g1[3] / l4.w : 0.f};
        bf16_t* dst = YB + (size_t)(b * SEQ + t) * 512 + (g * 4) * 64 + c;
#pragma unroll
        for (int dt = 0; dt < 4; ++dt)
#pragma unroll
            for (int i = 0; i < 4; ++i) dst[i * 64 + 16 * dt] = (bf16_t)f2bf(bf2f(dst[i * 64 + 16 * dt]) + inv[i] * OS[(qq * 4 + i) * 64 + 16 * dt + c]);
    }
    __syncthreads();
}

DI void dsa_group(const Params& p, int b, int t0, const Frame& F, const LAS unsigned char* buck, const LAS float* tbl, int parts = 7) {
    unsigned char* ws = p.ws; const int lane = F.lane, wave = F.wave, c = lane & 15, q = lane >> 4;
    LAS unsigned* SC = (LAS unsigned*)F.lds;
    LAS int* list = (LAS int*)(F.lds + 131072 + wave * 1024); LAS float* al = (LAS float*)(F.lds + 139264 + wave * 64);
    const bf16_t* prow0 = (const bf16_t*)(ws + WS_PROJ) + (size_t)(b * SEQ) * PW;
    bf16_t* YD = (bf16_t*)(ws + WS_Y) + (size_t)3 * T * 512;
    const bf16x8 zf = {0, 0, 0, 0, 0, 0, 0, 0};
    const int t = t0 + wave; const bf16_t* qrow = prow0 + (size_t)t * PW;
    const bf16_t* dki = (const bf16_t*)(ws + WS_DKI) + (size_t)(b * SEQ) * 64;
    const bool full = t0 >= 256;
    if (full && (parts & 1)) {
        bf16x8 qa[4][2]; float wv[4][4];
#pragma unroll
        for (int rt = 0; rt < 4; ++rt) { const bf16_t* qp = prow0 + (size_t)(t0 + 2 * rt + (c >> 3)) * PW + C_DQI + (c & 7) * 64 + 8 * q; qa[rt][0] = *(const bf16x8*)qp; qa[rt][1] = *(const bf16x8*)(qp + 32);
            const u32x2 w4 = *(const u32x2*)(prow0 + (size_t)(t0 + 2 * rt + (q >> 1)) * PW + C_DWI + (q & 1) * 4);
            wv[rt][0] = lo16(w4.x) * 0.35355339f; wv[rt][1] = hi16(w4.x) * 0.35355339f; wv[rt][2] = lo16(w4.y) * 0.35355339f; wv[rt][3] = hi16(w4.y) * 0.35355339f; }
        const int ntile = ((t0 + 7) >> 4) + 1, nk64 = ((t0 + 7) >> 6) + 1;
        bf16x8 kx0, kx1;
        if (wave < ntile) { const bf16_t* kp = dki + (size_t)(16 * wave + c) * 64 + 8 * q; kx0 = *(const bf16x8*)kp; kx1 = *(const bf16x8*)(kp + 32); }
        for (int tau = wave; tau < ntile; tau += 8) {
            const bf16x8 kb0 = kx0, kb1 = kx1;
            if (tau + 8 < ntile) { const bf16_t* kp = dki + (size_t)(16 * (tau + 8) + c) * 64 + 8 * q; kx0 = *(const bf16x8*)kp; kx1 = *(const bf16x8*)(kp + 32); }
            const int key = 16 * tau + c;
#pragma unroll
            for (int rt = 0; rt < 4; ++rt) {
                f32x4 acc = {0.f, 0.f, 0.f, 0.f};
                acc = MFMA16(qa[rt][0], kb0, acc); acc = MFMA16(qa[rt][1], kb1, acc);
                float s = wv[rt][0] * fmaxf(acc[0], 0.f) + wv[rt][1] * fmaxf(acc[1], 0.f) + wv[rt][2] * fmaxf(acc[2], 0.f) + wv[rt][3] * fmaxf(acc[3], 0.f);
                s = x16_sum(s);
                const int qq = 2 * rt + (q >> 1);
                if ((q & 1) == 0) SC[qq * 4096 + key] = key <= t0 + qq ? ordf(s) : 0u;
            }
        }
        for (int i = F.tid; i < 8 * 64; i += 512) { const int key = ntile * 16 + (i & 63); if (key < nk64 * 64) SC[(i >> 6) * 4096 + key] = 0u; }
    }
    __syncthreads();
    int n;
    if (!full) { n = t + 1; for (int i = lane; i < 256; i += 64) list[i] = i <= t ? i : -1; }
    else if (parts & 2) {
        n = 256;
        const LAS unsigned* sc = SC + wave * 4096; const int nk64 = (t >> 6) + 1;
        unsigned u[64];
#pragma unroll
        for (int k = 0; k < 64; ++k) u[k] = k < nk64 ? sc[k * 64 + lane] : 0u;
#define WAVE_TOTAL(cl, tot) do { tot = 0; _Pragma("unroll") for (int b_ = 0; b_ < 7; ++b_) tot += __popcll(__ballot(((cl) >> b_) & 1u)) << b_; } while (0)
        unsigned prefix = 0u;
        const int nk8 = __builtin_amdgcn_readfirstlane((nk64 + 7) >> 3);
#define CNT_GE(NK) _Pragma("unroll") for (int k = 0; k < NK; ++k) cl += (u[k] >= cand) ? 1u : 0u;
        for (int bit = 31; bit >= 0; --bit) {
            const unsigned cand = prefix | (1u << bit); unsigned cl = 0u; int cnt;
            switch (nk8) { case 1: CNT_GE(8) break; case 2: CNT_GE(16) break; case 3: CNT_GE(24) break; case 4: CNT_GE(32) break;
                           case 5: CNT_GE(40) break; case 6: CNT_GE(48) break; case 7: CNT_GE(56) break; default: CNT_GE(64) break; }
            WAVE_TOTAL(cl, cnt);
            if (cnt >= 256) { prefix = cand; if (cnt == 256) break; }
        }
        int cgt; { unsigned cl = 0u;
#pragma unroll
            for (int k = 0; k < 64; ++k) cl += (u[k] > prefix) ? 1u : 0u;
            WAVE_TOTAL(cl, cgt); }
#undef WAVE_TOTAL
#undef CNT_GE
        const int need_eq = 256 - cgt; int base = 0, eqbase = 0;
#pragma unroll
        for (int k = 0; k < 64; ++k) {
            if (k < nk64) {
                const bool gtp = u[k] > prefix, eq = u[k] == prefix;
                const unsigned long long meq = __ballot(eq);
                const int eqrank = eqbase + (int)__builtin_amdgcn_mbcnt_hi((unsigned)(meq >> 32), __builtin_amdgcn_mbcnt_lo((unsigned)meq, 0u));
                const bool take = gtp || (eq && eqrank < need_eq);
                const unsigned long long mt = __ballot(take);
                const int slot = base + (int)__builtin_amdgcn_mbcnt_hi((unsigned)(mt >> 32), __builtin_amdgcn_mbcnt_lo((unsigned)mt, 0u));
                if (take && slot < 256) list[slot] = k * 64 + lane;
                base += __popcll(mt); eqbase += __popcll(meq);
            }
        }
    }
    else n = 256;
    LDS_WAIT();
    if (!(parts & 4)) { __syncthreads(); return; }
    LAS unsigned char* vt = F.lds + wave * 16384;
    bf16x8 qd[2] = {zf, zf};
    if (c < 8) { qd[0] = *(const bf16x8*)(qrow + C_DQ + c * 64 + 8 * q); qd[1] = *(const bf16x8*)(qrow + C_DQ + c * 64 + 32 + 8 * q); }
    KsDsa ks{(const bf16_t*)(ws + WS_DK) + (size_t)(b * SEQ) * 64, (const bf16_t*)(ws + WS_DV) + (size_t)(b * SEQ) * 64, list, n, t};
    const f32x4 z4 = {0.f, 0.f, 0.f, 0.f};
    float m = -1e30f, lr = 0.f; f32x4 o[4] = {z4, z4, z4, z4};
    flash_run<0>(ks, (n + 31) & ~31, qd, o, m, lr, vt, al, (LAS float*)vt, buck, tbl, lane);
    if (q < 2) {
#pragma unroll
        for (int dt = 0; dt < 4; ++dt)
#pragma unroll
            for (int i = 0; i < 4; ++i) YD[(size_t)(b * SEQ + t) * 512 + (4 * q + i) * 64 + 16 * dt + c] = (bf16_t)f2bf(o[dt][i]);
    }
    __syncthreads();
}

DI void phase_attn(const Params& p, int l, const Frame& F, int mask = 3, int parts = 15) {
    const int gw = F.vb * 8 + F.wave, NGW = F.G * 8; const float* rel = p.in[I_REL];
#ifndef MK_ATTN
#define MK_ATTN 3
#endif
    if ((MK_ATTN & 1) && (mask & 1)) {
        LAS float* lut = (LAS float*)(F.lds + 130048);
        for (int i = F.tid; i < 8 * 1024; i += 512) { const int h = i >> 10, d = i & 1023; lut[i] = rel[bucket_of(d) * 16 + h] * 1.44269504f; }
        __syncthreads();
        for (int it = F.vb; it < 8 * 2 * 64; it += F.G) { const int b = it >> 7, g = (it >> 6) & 1; int tb = it & 63; if (b & 1) tb = 63 - tb; nsa_tile(p, b, g, tb, F, lut, (parts >> 8) & 15); }
    }
    __syncthreads();
    LAS unsigned char* buck = F.lds + 139776; LAS float* tbl = (LAS float*)(F.lds + 140800);
    for (int i = F.tid; i < 1024; i += 512) buck[i] = (unsigned char)bucket_of(i);
    tbl[F.tid] = rel[F.tid] * 1.44269504f;
    __syncthreads();
    if ((MK_ATTN & 2) && (mask & 2)) for (int it = F.vb; it < 8 * 512; it += F.G) { const int b = it >> 9; int tg = it & 511; if (b & 1) tg = 511 - tg; dsa_group(p, b, tg * 8, F, buck, tbl, parts); }
}


#ifndef MK_PROBE
#define MK_PROBE 0
#endif

DI unsigned row16_maxu(unsigned m) { unsigned o;
    o = (unsigned)DPP_I((int)m, 0xB1); m = m > o ? m : o; o = (unsigned)DPP_I((int)m, 0x4E); m = m > o ? m : o;
    o = (unsigned)DPP_I((int)m, 0x141); m = m > o ? m : o; o = (unsigned)DPP_I((int)m, 0x140); m = m > o ? m : o; return m; }
DI void peer_route_tile(const Params& p, int t0, int lane) {
    unsigned char* ws = p.ws; const int c = lane & 15, q = lane >> 4;
    const bf16_t* QP = (const bf16_t*)(ws + WS_QP); const bf16_t* SK = (const bf16_t*)(ws + WS_SK); int* EIDX = (int*)(ws + WS_EIDX); float* EW = (float*)(ws + WS_EW);
    float* EU = (float*)(ws + WS_EU); const float* USr = (const float*)(ws + WS_PTV); const float* VSr = USr + 16384;
    int ca[4], cb[4]; bool cv[4];
    ca[0] = 0; cb[0] = c; cv[0] = true;
    ca[1] = c < 8 ? 1 : (c < 13 ? 2 : 3); cb[1] = c < 8 ? c : (c < 13 ? c - 8 : c - 13); cv[1] = true;
    { const int ci = 32 + c; int a_, b_;
      if (ci == 32) { a_ = 3; b_ = 3; } else if (ci < 36) { a_ = 4; b_ = ci - 33; } else if (ci < 42) { a_ = 5 + ((ci - 36) >> 1); b_ = (ci - 36) & 1; } else { a_ = 8 + (ci - 42); b_ = 0; }
      ca[2] = a_; cb[2] = b_; cv[2] = true; }
    ca[3] = c < 2 ? 14 + c : 0; cb[3] = 0; cv[3] = c < 2;
    for (int h = 0; h < 8; ++h) {
        unsigned top[2][4];
#pragma unroll
        for (int pp = 0; pp < 2; ++pp) {
            const int hp = h * 2 + pp;
            const bf16_t* ap = QP + (size_t)(t0 + c) * 1024 + hp * 64 + 8 * q;
            const bf16x8 a0 = *(const bf16x8*)ap, a1 = *(const bf16x8*)(ap + 32);
            unsigned v[4][8];
#pragma unroll
            for (int kt = 0; kt < 8; ++kt) { const bf16_t* bp = SK + ((size_t)hp * 128 + 16 * kt + c) * 64 + 8 * q;
                const bf16x8 b0 = *(const bf16x8*)bp, b1 = *(const bf16x8*)(bp + 32);
                f32x4 acc = {0.f, 0.f, 0.f, 0.f}; acc = MFMA16(a0, b0, acc); acc = MFMA16(a1, b1, acc);
#pragma unroll
                for (int i = 0; i < 4; ++i) v[i][kt] = (ordf(acc[i]) & 0xFFFFFF80u) | (unsigned)(127 - (16 * kt + c)); }
            { unsigned mine[4] = {0u, 0u, 0u, 0u};
#define CE_(a, b) { const unsigned hi_ = v[i][a] > v[i][b] ? v[i][a] : v[i][b], lo_ = v[i][a] > v[i][b] ? v[i][b] : v[i][a]; v[i][a] = hi_; v[i][b] = lo_; }
#pragma unroll
              for (int i = 0; i < 4; ++i) { CE_(0, 1) CE_(2, 3) CE_(4, 5) CE_(6, 7) CE_(0, 2) CE_(1, 3) CE_(4, 6) CE_(5, 7) CE_(1, 2) CE_(5, 6) CE_(0, 4) CE_(3, 7) CE_(1, 5) CE_(2, 6) CE_(1, 4) CE_(3, 6) CE_(2, 4) CE_(3, 5) CE_(3, 4) }
#undef CE_
              for (int r = 0; r < 16; ++r) {
#pragma unroll
                  for (int i = 0; i < 4; ++i) { const unsigned m = row16_maxu(v[i][0]); mine[i] = (c == r) ? m : mine[i];
                      const bool win = v[i][0] == m;
#pragma unroll
                      for (int kt = 0; kt < 7; ++kt) v[i][kt] = win ? v[i][kt + 1] : v[i][kt];
                      v[i][7] = win ? 0u : v[i][7]; } }
#pragma unroll
              for (int i = 0; i < 4; ++i) top[pp][i] = mine[i]; }
        }
        unsigned cd[4][4], mine2[4] = {0u, 0u, 0u, 0u}; int i0v[4], i1v[4];
#pragma unroll
        for (int i = 0; i < 4; ++i) {
            const float s0 = unordf(top[0][i] & 0xFFFFFF80u), s1 = unordf(top[1][i] & 0xFFFFFF80u);
            i0v[i] = 127 - (int)(top[0][i] & 127u); i1v[i] = 127 - (int)(top[1][i] & 127u);
#pragma unroll
            for (int k = 0; k < 4; ++k) { const float s0a = __shfl(s0, (lane & 48) | ca[k]), s1b = __shfl(s1, (lane & 48) | cb[k]);
                cd[i][k] = cv[k] ? ((ordf(s0a + s1b) & 0xFFFFFF00u) | (unsigned)(255 - (ca[k] * 16 + cb[k]))) : 0u; }
        }
#define CE_(a, b) { const unsigned hi_ = cd[i][a] > cd[i][b] ? cd[i][a] : cd[i][b], lo_ = cd[i][a] > cd[i][b] ? cd[i][b] : cd[i][a]; cd[i][a] = hi_; cd[i][b] = lo_; }
#pragma unroll
        for (int i = 0; i < 4; ++i) { CE_(0, 1) CE_(2, 3) CE_(0, 2) CE_(1, 3) CE_(1, 2) }
#undef CE_
        for (int r = 0; r < 16; ++r) {
#pragma unroll
            for (int i = 0; i < 4; ++i) { const unsigned m = row16_maxu(cd[i][0]); mine2[i] = (c == r) ? m : mine2[i];
                const bool win = cd[i][0] == m;
#pragma unroll
                for (int k = 0; k < 3; ++k) cd[i][k] = win ? cd[i][k + 1] : cd[i][k];
                cd[i][3] = win ? 0u : cd[i][3]; }
        }
#pragma unroll
        for (int i = 0; i < 4; ++i) {
            const unsigned mine = mine2[i];
            const int pr = 255 - (int)(mine & 255u); const int ea = __shfl(i0v[i], (lane & 48) | (pr >> 4)), eb = __shfl(i1v[i], (lane & 48) | (pr & 15));
            const float scv = unordf(mine & 0xFFFFFF00u);
            const float mx = row16_maxf(scv);
            const float e = __expf(scv - mx); const float sm = row16_sumf(e);
            const size_t o = (size_t)(t0 + 4 * q + i) * 128 + h * 16 + c;
            const int eid = ea * 128 + eb; EIDX[o] = eid; EW[o] = (e / sm) * VSr[eid]; EU[o] = USr[eid];
        }
    }
}
#define MFMA8(a, b, c) __builtin_amdgcn_mfma_f32_16x16x32_fp8_fp8((a), (b), (c), 0, 0, 0)
DI long lo64(const u32x4 v) { return (long)(((unsigned long long)v.y << 32) | v.x); }
DI long hi64(const u32x4 v) { return (long)(((unsigned long long)v.w << 32) | v.z); }
template <int OFF> DI void peer_dma_o(const unsigned char* src, LAS unsigned char* dst) { __builtin_amdgcn_global_load_lds((const unsigned*)src, (LAS unsigned*)(dst - OFF), 16, OFF, 0); }
#define PEER_RD(slot_) (*(const LAS u32x4*)(ring + 1024 * (slot_) + 16 * lane))
#define PEER_VMW(n_) asm volatile("s_waitcnt vmcnt(" #n_ ")" ::: "memory")
struct PeerStream { int u0, ustep, n, xfix; bool al; };
DI PeerStream peer_stream(const Frame& F) { PeerStream s; const int bx = blockIdx.x; s.al = (F.G & 7) == 0; s.u0 = s.al ? (bx >> 3) * 8 + F.wave : bx * 8 + F.wave; s.ustep = s.al ? F.G : F.G * 8;
    const int nu = s.al ? T : T * 8; s.n = (nu - s.u0 + s.ustep - 1) / s.ustep; s.xfix = bx & 7; return s; }
DI void peer_unit(const PeerStream& s, int k, int& t, int& x) { const int u = s.u0 + (k < s.n ? k : s.n - 1) * s.ustep; t = s.al ? u : u >> 3; x = s.al ? s.xfix : u & 7; }

DI void phase_peer_u(const Params& p, const Frame& F) {
    unsigned char* ws = p.ws; const int lane = F.lane, c = lane & 15, q = lane >> 4, c8 = lane & 7, r8 = lane >> 3;
    LAS unsigned char* wl = F.lds + F.wave * LDS_PERWAVE; LAS float* pdl = (LAS float*)wl; LAS unsigned char* ring = wl + 512; LAS unsigned char* meta = wl + 512 + 16384;
    const PeerStream S = peer_stream(F);
    const unsigned char* EIDX = ws + WS_EIDX; const unsigned char* H8 = ws + WS_H8; float* PD = (float*)(ws + WS_PD); const unsigned char* PTU = ws + WS_PTU;
    const int p0 = ((c >> 1) + q) & 7, p1 = (p0 + 4) & 7;
    const int rdo = 1024 * (c >> 3) + 128 * (c & 7);
    int t, x;
#define PU_META(k_, slot_) do { peer_unit(S, (k_), t, x); const unsigned char* s_ = lane < 32 ? EIDX + (size_t)t * 512 + 16 * lane : H8 + (size_t)t * 1024 + 128 * x + 16 * (lane & 7); peer_dma_o<0>(s_, meta + 1024 * (slot_)); } while (0)
#define PU_RD(g_, pc_) (*(const LAS u32x4*)(ring + 2048 * (g_) + rdo + 16 * (pc_)))
    PU_META(0, 0); PU_META(1, 1);
    asm volatile("s_waitcnt vmcnt(0)" ::: "memory");
    u32x4 in_[4], hc0, hc1, hn0, hn1;
    { u32x4 i0_[4];
#pragma unroll
      for (int v_ = 0; v_ < 4; ++v_) i0_[v_] = *(const LAS u32x4*)(meta + 64 * r8 + 16 * v_);
      hn0 = *(const LAS u32x4*)(meta + 512 + 16 * p0); hn1 = *(const LAS u32x4*)(meta + 512 + 16 * p1);
      peer_unit(S, 0, t, x); const unsigned char* tb = PTU + (size_t)x * PT_SLICE + 16 * c8;
#define PU_D0(j) peer_dma_o<0>(tb + (size_t)i0_[(j) >> 2][(j) & 3] * 128, ring + 1024 * (j))
      PU_D0(0); PU_D0(1); PU_D0(2); PU_D0(3); PU_D0(4); PU_D0(5); PU_D0(6); PU_D0(7); PU_D0(8); PU_D0(9); PU_D0(10); PU_D0(11); PU_D0(12); PU_D0(13); PU_D0(14); PU_D0(15);
#undef PU_D0
    }
    PEER_VMW(12);
    u32x4 ra[2], rb[2];
#pragma unroll
    for (int i = 0; i < 2; ++i) { ra[i] = PU_RD(i, p0); rb[i] = PU_RD(i, p1); }
    const f32x4 z4 = {0.f, 0.f, 0.f, 0.f};
    for (int k = 0; k < S.n; ++k) {
        int tc, xc; peer_unit(S, k, tc, xc);
        hc0 = hn0; hc1 = hn1;
        { LAS unsigned char* m1 = meta + 1024 * ((k + 1) & 1);
#pragma unroll
          for (int v_ = 0; v_ < 4; ++v_) in_[v_] = *(const LAS u32x4*)(m1 + 64 * r8 + 16 * v_);
          hn0 = *(const LAS u32x4*)(m1 + 512 + 16 * p0); hn1 = *(const LAS u32x4*)(m1 + 512 + 16 * p1); }
        LDS_WAIT(); PU_META(k + 2, k & 1);
        peer_unit(S, k + 1, t, x);
        const unsigned char* tbn = PTU + (size_t)x * PT_SLICE + 16 * c8;
#define PU_GRP(g) do { if ((g) < 6) PEER_VMW(11); else PEER_VMW(10); const u32x4 na = PU_RD(((g) + 2) & 7, p0), nb = PU_RD(((g) + 2) & 7, p1); \
            f32x4 acc = MFMA8(lo64(ra[(g) & 1]), lo64(hc0), z4); acc = MFMA8(hi64(ra[(g) & 1]), hi64(hc0), acc); acc = MFMA8(lo64(rb[(g) & 1]), lo64(hc1), acc); acc = MFMA8(hi64(rb[(g) & 1]), hi64(hc1), acc); \
            asm volatile("" :: "v"(ra[(g) & 1]), "v"(rb[(g) & 1])); \
            peer_dma_o<0>(tbn + (size_t)in_[(2 * (g)) >> 2][(2 * (g)) & 3] * 128, ring + 2048 * (g)); peer_dma_o<0>(tbn + (size_t)in_[(2 * (g) + 1) >> 2][(2 * (g) + 1) & 3] * 128, ring + 2048 * (g) + 1024); \
            ra[(g) & 1] = na; rb[(g) & 1] = nb; \
            { const float d01 = (c & 1) ? acc[1] : acc[0], d23 = (c & 1) ? acc[3] : acc[2], dg = (c & 2) ? d23 : d01; if (q == (c >> 2)) pdl[16 * (c & 7) + 2 * (g) + (c >> 3)] = dg; } } while (0)
        PU_GRP(0); PU_GRP(1); PU_GRP(2); PU_GRP(3); PU_GRP(4); PU_GRP(5); PU_GRP(6); PU_GRP(7);
#undef PU_GRP
        { const u32x2 pv = *(const LAS u32x2*)(pdl + 2 * lane); *(u32x2*)(PD + ((size_t)xc * T + tc) * 128 + 2 * lane) = pv; }
    }
#undef PU_META
#undef PU_RD
    asm volatile("s_waitcnt vmcnt(0) lgkmcnt(0)" ::: "memory");
}

DI void phase_peer_coef(const Params& p, const Frame& F) {
    unsigned char* ws = p.ws; const float* PD = (const float*)(ws + WS_PD); const float* EW = (const float*)(ws + WS_EW); const float* EU = (const float*)(ws + WS_EU);
    const float* HSI = (const float*)(ws + WS_HSI); float* COEF = (float*)(ws + WS_COEF);
    const size_t NT = (size_t)F.G * 512;
    for (size_t i0 = (size_t)F.vb * 512 + F.tid; i0 < (size_t)T * 128; i0 += 4 * NT) {
        float d[4][8], ew[4], eu[4], hs[4];
#pragma unroll
        for (int r = 0; r < 4; ++r) { size_t i = i0 + r * NT; if (i >= (size_t)T * 128) i = i0; const int t = (int)(i >> 7), pp = (int)(i & 127);
#pragma unroll
            for (int x = 0; x < 8; ++x) d[r][x] = PD[((size_t)x * T + t) * 128 + pp];
            ew[r] = EW[i]; eu[r] = EU[i]; hs[r] = HSI[t]; }
#pragma unroll
        for (int r = 0; r < 4; ++r) { const size_t i = i0 + r * NT; if (i >= (size_t)T * 128) break;
            const float dot = ((d[r][0] + d[r][1]) + (d[r][2] + d[r][3])) + ((d[r][4] + d[r][5]) + (d[r][6] + d[r][7]));
            COEF[i] = ew[r] * gelu_t(dot * eu[r] * hs[r]); }
    }
}

DI void phase_peer_v(const Params& p, const Frame& F, const float* xin, float* xout) {
    unsigned char* ws = p.ws; const int lane = F.lane, c8 = lane & 7, r8 = lane >> 3;
    LAS unsigned char* wl = F.lds + F.wave * LDS_PERWAVE; LAS unsigned char* ring = wl; LAS unsigned char* meta = wl + 16384; LAS unsigned char* xs = wl + 16384 + 2048;
    const PeerStream S = peer_stream(F);
    const unsigned char* EIDX = ws + WS_EIDX; const unsigned char* COEF = ws + WS_COEF; const unsigned char* PTV = ws + WS_PTU + 16 * MiB;
    typedef float f32x2_t __attribute__((ext_vector_type(2)));
    int colofs;
    { const auto ra = __builtin_amdgcn_permlane32_swap(0u, 8u, false, false); const unsigned ta = ra[0];
      const auto rb = __builtin_amdgcn_permlane16_swap(ta, ta + 4u, false, false); const unsigned tb = rb[0];
      colofs = (int)tb + ((lane & 8) ? 2 : 0); }
    int t, x;
#define PV_META(k_, slot_) do { peer_unit(S, (k_), t, x); const unsigned char* s_ = (lane < 32 ? EIDX : COEF) + (size_t)t * 512 + 16 * (lane & 31); peer_dma_o<0>(s_, meta + 1024 * (slot_)); } while (0)
#define PV_XS(k_, slot_) do { peer_unit(S, (k_), t, x); if (lane < 32) peer_dma_o<0>((const unsigned char*)(xin + (size_t)t * 1024 + 128 * x) + 16 * lane, xs + 512 * (slot_)); } while (0)
    PV_META(0, 0); PV_META(1, 1); PV_XS(0, 0);
    asm volatile("s_waitcnt vmcnt(0)" ::: "memory");
    u32x4 in_[4]; f32x4 cf[4], cn[4];
    { u32x4 i0_[4];
#pragma unroll
      for (int v_ = 0; v_ < 4; ++v_) { i0_[v_] = *(const LAS u32x4*)(meta + 64 * r8 + 16 * v_); cn[v_] = *(const LAS f32x4*)(meta + 512 + 64 * r8 + 16 * v_); }
      peer_unit(S, 0, t, x); const unsigned char* tb = PTV + (size_t)x * PT_SLICE + 16 * c8;
#define PV_D0(j) peer_dma_o<0>(tb + (size_t)i0_[(j) >> 2][(j) & 3] * 128, ring + 1024 * (j))
      PV_D0(0); PV_D0(1); PV_D0(2); PV_D0(3); PV_D0(4); PV_D0(5); PV_D0(6); PV_D0(7); PV_D0(8); PV_D0(9); PV_D0(10); PV_D0(11); PV_D0(12); PV_D0(13); PV_D0(14); PV_D0(15);
#undef PV_D0
    }
    PEER_VMW(12);
    u32x4 rr[4];
#pragma unroll
    for (int i = 0; i < 4; ++i) rr[i] = PEER_RD(i);
    for (int k = 0; k < S.n; ++k) {
        int tc, xc; peer_unit(S, k, tc, xc);
#pragma unroll
        for (int v_ = 0; v_ < 4; ++v_) cf[v_] = cn[v_];
        { LAS unsigned char* m1 = meta + 1024 * ((k + 1) & 1);
#pragma unroll
          for (int v_ = 0; v_ < 4; ++v_) { in_[v_] = *(const LAS u32x4*)(m1 + 64 * r8 + 16 * v_); cn[v_] = *(const LAS f32x4*)(m1 + 512 + 64 * r8 + 16 * v_); } }
        LDS_WAIT(); PV_META(k + 2, k & 1);
        PV_XS(k + 1, (k + 1) & 1);
        peer_unit(S, k + 1, t, x);
        const unsigned char* tbn = PTV + (size_t)x * PT_SLICE + 16 * c8;
        f32x2_t out[8];
#pragma unroll
        for (int e = 0; e < 8; ++e) out[e] = (f32x2_t){0.f, 0.f};
#define PV_STEP(j) do { if ((j) < 12) PEER_VMW(13); else PEER_VMW(11); const u32x4 nw = PEER_RD(((j) + 4) & 15); \
            const u32x4 pv_ = rr[(j) & 3]; const float c1_ = cf[(j) >> 2][(j) & 3]; const f32x2_t cc = {c1_, c1_}; \
            out[0] += cc * __builtin_amdgcn_cvt_pk_f32_fp8((int)pv_.x, false); out[1] += cc * __builtin_amdgcn_cvt_pk_f32_fp8((int)pv_.x, true); \
            out[2] += cc * __builtin_amdgcn_cvt_pk_f32_fp8((int)pv_.y, false); out[3] += cc * __builtin_amdgcn_cvt_pk_f32_fp8((int)pv_.y, true); \
            out[4] += cc * __builtin_amdgcn_cvt_pk_f32_fp8((int)pv_.z, false); out[5] += cc * __builtin_amdgcn_cvt_pk_f32_fp8((int)pv_.z, true); \
            out[6] += cc * __builtin_amdgcn_cvt_pk_f32_fp8((int)pv_.w, false); out[7] += cc * __builtin_amdgcn_cvt_pk_f32_fp8((int)pv_.w, true); \
            asm volatile("" :: "v"(rr[(j) & 3])); \
            peer_dma_o<0>(tbn + (size_t)in_[(j) >> 2][(j) & 3] * 128, ring + 1024 * (j)); rr[(j) & 3] = nw; } while (0)
        PV_STEP(0); PV_STEP(1); PV_STEP(2); PV_STEP(3); PV_STEP(4); PV_STEP(5); PV_STEP(6); PV_STEP(7);
        PV_STEP(8); PV_STEP(9); PV_STEP(10); PV_STEP(11); PV_STEP(12); PV_STEP(13); PV_STEP(14); PV_STEP(15);
#undef PV_STEP
        float n8[8], n4[4], f2[2];
#pragma unroll
        for (int i = 0; i < 8; ++i) { const float a_ = (i & 1) ? out[i >> 1].y : out[i >> 1].x, b_ = (i & 1) ? out[4 + (i >> 1)].y : out[4 + (i >> 1)].x;
            const auto r_ = __builtin_amdgcn_permlane32_swap(__float_as_uint(a_), __float_as_uint(b_), false, false); n8[i] = __uint_as_float(r_[0]) + __uint_as_float(r_[1]); }
#pragma unroll
        for (int i = 0; i < 4; ++i) { const auto r_ = __builtin_amdgcn_permlane16_swap(__float_as_uint(n8[i]), __float_as_uint(n8[4 + i]), false, false); n4[i] = __uint_as_float(r_[0]) + __uint_as_float(r_[1]); }
#pragma unroll
        for (int i = 0; i < 2; ++i) { const bool hi8 = (lane & 8) != 0; const float keep = hi8 ? n4[2 + i] : n4[i], send = hi8 ? n4[i] : n4[2 + i];
            f2[i] = keep + __builtin_bit_cast(float, DPP_I(__builtin_bit_cast(int, send), 0x128)); }
        { const f32x2_t xv = *(const LAS f32x2_t*)(xs + 512 * (k & 1) + 4 * (16 * c8 + colofs));
          const f32x2_t o = {xv.x + f2[0], xv.y + f2[1]}; *(f32x2_t*)(xout + (size_t)tc * 1024 + 128 * xc + 16 * c8 + colofs) = o; }
    }
#undef PV_META
#undef PV_XS
    asm volatile("s_waitcnt vmcnt(0) lgkmcnt(0)" ::: "memory");
}
#undef PEER_RD
#undef PEER_VMW

#ifndef MK_MASK
#define MK_MASK 0xffff
#endif
__global__ void __launch_bounds__(512, 2) mega(Params p) {
    extern __shared__ __attribute__((aligned(16))) unsigned char lds_raw[];
#define MKFRAME() Frame F; { int t_ = threadIdx.x; asm volatile("" : "+v"(t_)); F.lds = (LAS unsigned char*)lds_raw; F.tid = t_; F.lane = t_ & 63; F.wave = __builtin_amdgcn_readfirstlane(t_ >> 6); \
        F.G = gridDim.x; const int bx = blockIdx.x; F.vb = (F.G % 8 == 0) ? (bx % 8) * (F.G / 8) + bx / 8 : bx; }
    if (threadIdx.x < 16) ((LAS unsigned*)((LAS unsigned char*)lds_raw + LDS_XB))[threadIdx.x] = 0u;
    __syncthreads();
    const int lo = p.ph_lo, hi = p.ph_hi;
    XcdBarrier bar; bar.bar = (unsigned*)(p.ws + WS_CTL) + 4096; bar.x = 0; bar.st = (volatile LAS unsigned*)((LAS unsigned char*)lds_raw + LDS_XB);
    if (hi - lo > 1) bar = xcd_barrier_post((unsigned*)(p.ws + WS_CTL) + 4096, (volatile LAS unsigned*)((LAS unsigned char*)lds_raw + LDS_XB));
#define WSP(ws) unsigned char* ws = p.ws; asm volatile("" : "+s"(ws))
    for (int l = 0; l < NLAYER; ++l) {
        const int pb = l * NPH;
#define IN(k) (((MK_MASK >> (k)) & 1) && lo <= pb + (k) && pb + (k) < hi)
#if MK_PROBE == 120
#define SEAM(k) do { if (((MK_MASK >> (k)) & 1) && lo <= pb + (k) && pb + (k) + 1 < hi) { xcd_barrier(bar); xcd_barrier(bar); xcd_barrier(bar); } } while (0)
#else
#define SEAM(k) do { if (((MK_MASK >> (k)) & 1) && lo <= pb + (k) && pb + (k) + 1 < hi) xcd_barrier(bar); } while (0)
#endif
        if (IN(0)) { MKFRAME(); phase_prep_w(p, l, F); }
        SEAM(0);
#if MK_PROBE == 100
        if (IN(0)) { MKFRAME(); phase_prep_w(p, l, F); } xcd_barrier(bar);
#endif
        if (IN(1)) { MKFRAME(); WSP(ws); pg8::Gemm g{(const bf16_t*)(ws + WS_H), (const bf16_t*)(ws + WS_WCAT), T, 9216, 1024}; XcdColOrder S{F.G, (int)blockIdx.x};
            Epi1 E{(bf16_t*)(ws + WS_PROJ), (bf16_t*)(ws + WS_GATES)};
            pg8::gemm_phase<Epi1, XcdColOrder, false>(F.lds, g, S, E, nullptr); }
        SEAM(1);
#if MK_PROBE == 104
        if (IN(1)) { for (int rr = 0; rr < 18; ++rr) { MKFRAME(); WSP(ws); pg8::Gemm g{(const bf16_t*)(ws + WS_H), (const bf16_t*)(ws + WS_WCAT), T, 9216, 1024}; RoundOrder S; S.base.init(T, 9216, F.G, (int)blockIdx.x); S.r = rr;
            Epi1 E{(bf16_t*)(ws + WS_PROJ), (bf16_t*)(ws + WS_GATES)};
            pg8::gemm_phase<Epi1, RoundOrder, false>(F.lds, g, S, E, nullptr); xcd_barrier(bar); } }
#endif
#if MK_PROBE == 101 || MK_PROBE == 102 || MK_PROBE == 103
        if (IN(1)) { MKFRAME(); WSP(ws); pg8::Gemm g{(const bf16_t*)(ws + WS_H), (const bf16_t*)(ws + WS_WCAT), T, 9216, 1024}; ColRangeOrder S{F.G, (int)blockIdx.x, MK_PROBE == 103 ? 20 : 0, MK_PROBE == 102 ? 20 : 36};
            Epi1 E{(bf16_t*)(ws + WS_PROJ), (bf16_t*)(ws + WS_GATES)};
            pg8::gemm_phase<Epi1, ColRangeOrder, false>(F.lds, g, S, E, nullptr); } xcd_barrier(bar);
#endif
        if (IN(2)) { MKFRAME(); phase_chunk(p, l, F); }
        SEAM(2);
        if (IN(3)) { MKFRAME(); WSP(ws);
            { pg8::Gemm g{(const bf16_t*)(ws + WS_CMPA), (const bf16_t*)(ws + WS_W1C), 4096, 512, 1024}; pg8::StaticOrder S; S.init(4096, 512, F.G, (int)blockIdx.x); EpiF32P E{(float*)(ws + WS_CMPP), 512};
              pg8::gemm_phase<EpiF32P, pg8::StaticOrder, false>(F.lds, g, S, E, nullptr); }
        }
        if (IN(3)) { MKFRAME(); WSP(ws);
            { pg8::Gemm g{(const bf16_t*)(ws + WS_CMPA) + (size_t)4096 * 1024, (const bf16_t*)(ws + WS_W1C) + (size_t)512 * 1024, 4096, 512, 1024}; pg8::StaticOrder S; S.init(4096, 512, F.G, (int)((blockIdx.x + F.G / 2) % F.G));
              EpiF32P E{(float*)(ws + WS_CMPP) + (size_t)4096 * 512, 512};
              pg8::gemm_phase<EpiF32P, pg8::StaticOrder, false>(F.lds, g, S, E, nullptr); }
        }
        SEAM(3);
        if (IN(4)) { MKFRAME(); phase_cmp2(p, l, F); }
        SEAM(4);
        if (IN(5)) { MKFRAME(); phase_attn(p, l, F, 3, 15); }
        SEAM(5);
#if MK_PROBE == 5 || MK_PROBE == 50 || MK_PROBE == 51 || MK_PROBE == 52 || MK_PROBE == 53
        if (IN(5)) { MKFRAME(); phase_attn(p, l, F, MK_PROBE == 5 ? 3 : (MK_PROBE == 50 ? 1 : 2), MK_PROBE == 52 ? 1 : (MK_PROBE == 53 ? 3 : 15)); xcd_barrier(bar); }
#endif
#if MK_PROBE >= 60 && MK_PROBE < 76
        if (IN(5)) { MKFRAME(); phase_attn(p, l, F, 1, (MK_PROBE - 60) << 8); xcd_barrier(bar); }
#endif
        if (IN(6)) { MKFRAME(); WSP(ws); pg8::Gemm g{(const bf16_t*)(ws + WS_Y), (const bf16_t*)(ws + WS_WBR), 4 * T, 4096, 512}; BranchOrder S{F.G, (int)blockIdx.x};
            EpiBranch E{(const bf16_t*)(ws + WS_GATES), (bf16_t*)(ws + WS_MERGED)};
            pg8::gemm_phase<EpiBranch, BranchOrder, false>(F.lds, g, S, E, nullptr); }
        SEAM(6);
#if MK_PROBE == 106
        if (IN(6)) { MKFRAME(); WSP(ws); pg8::Gemm g{(const bf16_t*)(ws + WS_Y), (const bf16_t*)(ws + WS_WBR), 4 * T, 4096, 512}; BranchOrder S{F.G, (int)blockIdx.x};
            EpiBranch E{(const bf16_t*)(ws + WS_GATES), (bf16_t*)(ws + WS_MERGED)};
            pg8::gemm_phase<EpiBranch, BranchOrder, false>(F.lds, g, S, E, nullptr); } xcd_barrier(bar);
#endif
        if (IN(7)) { MKFRAME(); WSP(ws); pg8::Gemm g{(const bf16_t*)(ws + WS_MERGED), (const bf16_t*)(ws + WS_WOUT4), T, 1024, 1024}; pg8::StaticOrder S; S.init(T, 1024, F.G, (int)blockIdx.x);
            EpiRes E{l == 0 ? p.in[I_X] : p.out, p.out};
            pg8::gemm_phase<EpiRes, pg8::StaticOrder, false>(F.lds, g, S, E, nullptr); }
        SEAM(7);
        if (IN(8)) { MKFRAME(); WSP(ws); rmsnorm_rows(p.out, p.in[I_GFFN] + l * 1024, (bf16_t*)(ws + WS_H), F.vb * 8 + F.wave, F.G * 8, F.lane, ws + WS_H8, (float*)(ws + WS_HSI)); }
        SEAM(8);
#if MK_PROBE == 108
        if (IN(8)) { MKFRAME(); WSP(ws); rmsnorm_rows(p.out, p.in[I_GFFN] + l * 1024, (bf16_t*)(ws + WS_H), F.vb * 8 + F.wave, F.G * 8, F.lane); } xcd_barrier(bar);
#endif
        if (IN(9)) { MKFRAME(); WSP(ws);
            { pg8::Gemm g{(const bf16_t*)(ws + WS_H), (const bf16_t*)(ws + WS_WQ), T, 1024, 1024}; pg8::StaticOrder S; S.init(T, 1024, F.G, (int)blockIdx.x); EpiBf E{(bf16_t*)(ws + WS_QP), 1024};
              pg8::gemm_phase<EpiBf, pg8::StaticOrder, false>(F.lds, g, S, E, nullptr); }
        }
        if (IN(9)) { MKFRAME(); WSP(ws);
            { pg8::Gemm g{(const bf16_t*)(ws + WS_PB), (const bf16_t*)(ws + WS_WPP), T, 1024, 256}; pg8::StaticOrder S; S.init(T, 1024, F.G, (int)blockIdx.x); EpiBf E{(bf16_t*)(ws + WS_PP), 1024};
              pg8::gemm_phase<EpiBf, pg8::StaticOrder, false>(F.lds, g, S, E, nullptr); }
        }
        SEAM(9);
#if MK_PROBE == 110
        if (IN(9)) { for (int rep = 0; rep < 9; ++rep) { MKFRAME(); WSP(ws);
            { pg8::Gemm g{(const bf16_t*)(ws + WS_H), (const bf16_t*)(ws + WS_WQ), T, 1024, 1024}; pg8::StaticOrder S; S.init(T, 1024, F.G, (int)blockIdx.x); EpiBf E{(bf16_t*)(ws + WS_QP), 1024};
              pg8::gemm_phase<EpiBf, pg8::StaticOrder, false>(F.lds, g, S, E, nullptr); } } xcd_barrier(bar); }
#endif
#if MK_PROBE == 109
        if (IN(9)) { MKFRAME(); WSP(ws);
            { pg8::Gemm g{(const bf16_t*)(ws + WS_H), (const bf16_t*)(ws + WS_WQ), T, 1024, 1024}; pg8::StaticOrder S; S.init(T, 1024, F.G, (int)blockIdx.x); EpiBf E{(bf16_t*)(ws + WS_QP), 1024};
              pg8::gemm_phase<EpiBf, pg8::StaticOrder, false>(F.lds, g, S, E, nullptr); } }
        if (IN(9)) { MKFRAME(); WSP(ws);
            { pg8::Gemm g{(const bf16_t*)(ws + WS_PB), (const bf16_t*)(ws + WS_WPP), T, 1024, 256}; pg8::StaticOrder S; S.init(T, 1024, F.G, (int)blockIdx.x); EpiBf E{(bf16_t*)(ws + WS_PP), 1024};
              pg8::gemm_phase<EpiBf, pg8::StaticOrder, false>(F.lds, g, S, E, nullptr); } }
        xcd_barrier(bar);
#endif
        if (IN(10)) { MKFRAME(); for (int tile = F.vb * 8 + F.wave; tile < T / 16; tile += F.G * 8) peer_route_tile(p, tile * 16, F.lane); }
        SEAM(10);
        if (IN(11)) { MKFRAME(); phase_peer_u(p, F); }
        SEAM(11);
        if (IN(12)) { MKFRAME(); phase_peer_coef(p, F); }
        SEAM(12);
        if (IN(13)) { MKFRAME(); phase_peer_v(p, F, p.out, p.out); }
        SEAM(13);
#if MK_PROBE == 130
        if (IN(13)) { MKFRAME(); phase_peer_u(p, F); xcd_barrier(bar); }
#endif
#if MK_PROBE == 131
        if (IN(13)) { MKFRAME(); phase_peer_coef(p, F); xcd_barrier(bar); }
#endif
#if MK_PROBE == 132
        if (IN(13)) { MKFRAME(); phase_peer_v(p, F, p.out, (float*)(p.ws + WS_Y)); xcd_barrier(bar); }
#endif
#if MK_PROBE == 133
        if (IN(13)) { MKFRAME(); for (int tile = F.vb * 8 + F.wave; tile < T / 16; tile += F.G * 8) peer_route_tile(p, tile * 16, F.lane); xcd_barrier(bar); }
#endif
        if (IN(14)) { MKFRAME(); WSP(ws); rmsnorm_rows(p.out, p.in[I_GPLE] + l * 1024, (bf16_t*)(ws + WS_H), F.vb * 8 + F.wave, F.G * 8, F.lane); }
        SEAM(14);
        if (IN(15)) { MKFRAME(); WSP(ws); pg8::Gemm g{(const bf16_t*)(ws + WS_H), (const bf16_t*)(ws + WS_WPG), T, 1024, 1024}; pg8::StaticOrder S; S.init(T, 1024, F.G, (int)blockIdx.x);
            EpiPle E{p.out, (const bf16_t*)(ws + WS_PP)};
            pg8::gemm_phase<EpiPle, pg8::StaticOrder, false>(F.lds, g, S, E, nullptr); }
        SEAM(15);
#undef IN
#undef SEAM
    }
}
}

#ifndef MK_LAUNCH_PER_PHASE
#define MK_LAUNCH_PER_PHASE 0
#endif
extern "C" void kernel_launch(void* const* d_in, const int* in_sizes, int n_in, void* d_out, int out_size, void* d_ws, size_t ws_size, hipStream_t stream) {
    static int grid = 0;
    if (grid == 0) {
        if (n_in != 27 || ws_size < mk::WS_END) { fprintf(stderr, "kernel_launch: need 27 inputs and >= %zu bytes of workspace (got %d, %zu)\n", (size_t)mk::WS_END, n_in, ws_size); grid = -1; return; }
        int dev = 0, cus = 0;
        if (hipGetDevice(&dev) != hipSuccess || hipDeviceGetAttribute(&cus, hipDeviceAttributeMultiprocessorCount, dev) != hipSuccess) { grid = -1; return; }
        if (hipFuncSetAttribute((const void*)mk::mega, hipFuncAttributeMaxDynamicSharedMemorySize, mk::LDS_BYTES) != hipSuccess) { fprintf(stderr, "kernel_launch: hipFuncSetAttribute failed\n"); grid = -1; return; }
        int per_cu = 0;
        if (hipOccupancyMaxActiveBlocksPerMultiprocessor(&per_cu, (const void*)mk::mega, 512, mk::LDS_BYTES) != hipSuccess || per_cu < 1) fprintf(stderr, "kernel_launch: occupancy query says %d\n", per_cu);
        (void)hipGetLastError();
        grid = cus;
    }
    if (grid < 0) return;
    (void)in_sizes; (void)out_size;
    hipMemsetAsync((char*)d_ws + mk::WS_CTL, 0, 1u << 20, stream);
    mk::Params prm{};
    for (int i = 0; i < 27; ++i) prm.in[i] = (const float*)d_in[i];
    prm.out = (float*)d_out; prm.ws = (unsigned char*)d_ws;
#if MK_LAUNCH_PER_PHASE
    for (int ph = 0; ph < mk::NLAYER * mk::NPH; ++ph) { prm.ph_lo = ph; prm.ph_hi = ph + 1; hipLaunchKernelGGL(mk::mega, dim3(grid), dim3(512), mk::LDS_BYTES, stream, prm); }
#else
    prm.ph_lo = 0; prm.ph_hi = mk::NLAYER * mk::NPH; hipLaunchKernelGGL(mk::mega, dim3(grid), dim3(512), mk::LDS_BYTES, stream, prm);
#endif
}
```

```cpp
#include <hip/hip_runtime.h>
#include <stdio.h>
#include <stdint.h>
namespace pg8 {
#define PG8_LAS __attribute__((address_space(3)))
typedef unsigned short bf16_t;
typedef short bf16x8 __attribute__((ext_vector_type(8)));
typedef float f32x4 __attribute__((ext_vector_type(4)));
typedef unsigned u32x4 __attribute__((ext_vector_type(4)));
constexpr int BM = 256, BK = 64, HALF = 128, HTB = HALF * BK * 2  , STAGE_BYTES = 8 * HTB, NXCD = 8, WGM = 8;

__host__ __device__ __forceinline__ int lds_byte(int r, int c) { const int st = (r >> 4) * 2 + (c >> 5), rr = r & 15, cc = c & 31, ob = rr * 64 + cc * 2; return st * 1024 + (ob ^ (((ob >> 9) & 1) << 5)); }
__host__ __device__ __forceinline__ void stage_rc(int b, int& R, int& C) { const int st = b / 1024, sb = b % 1024, swz = sb ^ (((sb >> 9) & 1) << 5); R = (st >> 1) * 16 + swz / 64; C = (st & 1) * 32 + (swz % 64) / 2; }
__host__ __device__ __forceinline__ int perm32(int rho) { const int n = rho >> 4, i = rho & 15; return 8 * (i >> 2) + 4 * n + (i & 3); }

struct Unit { int pm, pn; };
struct Gemm { const bf16_t* A; const bf16_t* Bt; int M, N, K; };

struct StaticOrder {
    int nM, nN, nwg, G, c;
    __host__ __device__ void init(int M, int N, int G_, int c_) { nM = M / BM; nN = N / BM; nwg = nM * nN; G = G_; c = c_; }
    __host__ __device__ bool next(int i, Unit& u) const {
        const long L = (long)i * G + c; if (L >= nwg) return false;
        int wgid = (int)L; { const int q = nwg / NXCD, r = nwg % NXCD, xcd = wgid % NXCD, off = wgid / NXCD; wgid = (xcd < r ? xcd * (q + 1) : r * (q + 1) + (xcd - r) * q) + off; }
        const int nig = WGM * nN, gid = wgid / nig, fm = gid * WGM, gsz = (nM - fm) < WGM ? (nM - fm) : WGM;
        u.pm = fm + ((wgid % nig) % gsz); u.pn = (wgid % nig) / gsz; return true;
    }
    __device__ __forceinline__ void a_ready(const Unit&) const {}
    __device__ __forceinline__ void done(const Unit&) const {}
};
__device__ __forceinline__ unsigned cvt_pk_bf16(float lo, float hi) { unsigned r; asm volatile("v_cvt_pk_bf16_f32 %0, %1, %2" : "=v"(r) : "v"(lo), "v"(hi)); return r; }
template <class Epi, class Sched, bool STAMP = false>
__device__ __forceinline__ void gemm_phase(PG8_LAS unsigned char* lds, const Gemm g, const Sched& S, const Epi& E, unsigned long long* stamps) {
    int tid_l = threadIdx.x; asm volatile("" : "+v"(tid_l));
    const int tid = tid_l, wid = __builtin_amdgcn_readfirstlane(tid >> 6), lane = tid & 63, wr = wid >> 2, wc = wid & 3, fr = lane & 15, fq = lane >> 4;
    const int K = g.K, nt = K / BK;
    int ts_lo = 0, ts_hi = 0, nts = 0; const unsigned long long rt_entry = STAMP ? (unsigned long long)wall_clock64() : 0ull;
#define PG8_STAMP() do { if (STAMP && wid == 0 && nts < 64) { const unsigned long long _c = (unsigned long long)clock64(); \
        ts_lo = (lane == nts) ? (int)(unsigned)_c : ts_lo; ts_hi = (lane == nts) ? (int)(unsigned)(_c >> 32) : ts_hi; ++nts; } } while (0)
    PG8_STAMP();
    unsigned voffA[2], voffB[2];
#pragma unroll
    for (int i = 0; i < 2; ++i) { int R, C; stage_rc(tid * 16 + i * 8192, R, C); const int Rb = Epi::PERM ? ((R & ~31) + perm32(R & 31)) : R;
        voffA[i] = (unsigned)(R * K + C) * 2u; voffB[i] = (unsigned)(Rb * K + C) * 2u; }
    const size_t kstep = (size_t)(BK * 2);
    const size_t hstep = (size_t)HALF * K * 2;
    const size_t tstep = 2 * hstep;
    const unsigned ldsw = (unsigned)wid * 1024u;
    const int aoff = lds_byte(wr * 64 + fr, fq * 8), boff = lds_byte(wc * 32 + fr, fq * 8);
#define PG8_SA(b, h) (((b) * 2 + (h)) * HTB)
#define PG8_SB(b, h) ((4 + (b) * 2 + (h)) * HTB)
#define PG8_STAGE(bufoff, gbase, voff) do { _Pragma("unroll") for (int _i = 0; _i < 2; ++_i) \
        __builtin_amdgcn_global_load_lds((const unsigned*)((const char*)(gbase) + (voff)[_i]), (PG8_LAS unsigned*)(lds + (bufoff) + ldsw + _i * 8192), 16, 0, 0); } while (0)
#define PG8_LDA(dst, b, h) do { _Pragma("unroll") for (int m = 0; m < 4; ++m) _Pragma("unroll") for (int k = 0; k < 2; ++k) dst[m][k] = *(const PG8_LAS bf16x8*)(lds + PG8_SA(b, h) + aoff + m * 2048 + k * 1024); } while (0)
#define PG8_LDB(dst, b, h) do { _Pragma("unroll") for (int n = 0; n < 2; ++n) _Pragma("unroll") for (int k = 0; k < 2; ++k) dst[n][k] = *(const PG8_LAS bf16x8*)(lds + PG8_SB(b, h) + boff + n * 2048 + k * 1024); } while (0)
#define PG8_MMA(ai, bj, At, Bt) do { __builtin_amdgcn_s_setprio(1); _Pragma("unroll") for (int m = 0; m < 4; ++m) _Pragma("unroll") for (int n = 0; n < 2; ++n) _Pragma("unroll") for (int k = 0; k < 2; ++k) \
        acc[ai][bj][m][n] = __builtin_amdgcn_mfma_f32_16x16x32_bf16(Bt[n][k], At[m][k], acc[ai][bj][m][n], 0, 0, 0); __builtin_amdgcn_s_setprio(0); } while (0)
#define PG8_WAIT_V(n) asm volatile("s_waitcnt vmcnt(" #n ")" ::: "memory")
#define PG8_WAIT_L(n) asm volatile("s_waitcnt lgkmcnt(" #n ")" ::: "memory")
#define PG8_BAR __builtin_amdgcn_s_barrier()
#define PG8_SCHED __builtin_amdgcn_sched_barrier(0)
    Unit cur, nxt; int ui = 0;
    if (!S.next(0, cur)) return;
    f32x4 acc[2][2][4][2];
#pragma unroll
    for (int a = 0; a < 2; ++a)
#pragma unroll
        for (int b = 0; b < 2; ++b)
#pragma unroll
            for (int m = 0; m < 4; ++m)
#pragma unroll
                for (int n = 0; n < 2; ++n) acc[a][b][m][n] = (f32x4){0.f, 0.f, 0.f, 0.f};
    bf16x8 At[4][2], B0[2][2], B1[2][2];
    const char* cA = (const char*)g.A + (size_t)cur.pm * tstep; const char* cB = (const char*)g.Bt + (size_t)cur.pn * tstep;
    S.a_ready(cur);
    PG8_STAGE(PG8_SB(0, 0), cB, voffB); PG8_STAGE(PG8_SA(0, 0), cA, voffA); PG8_STAGE(PG8_SB(0, 1), cB + hstep, voffB); PG8_STAGE(PG8_SA(0, 1), cA + hstep, voffA);
    if (wr == 1) PG8_BAR;
    PG8_WAIT_V(4); PG8_BAR;
    PG8_STAGE(PG8_SB(1, 0), cB + kstep, voffB); PG8_STAGE(PG8_SA(1, 0), cA + kstep, voffA); PG8_STAGE(PG8_SB(1, 1), cB + hstep + kstep, voffB);
    PG8_WAIT_V(6); PG8_BAR;
    PG8_STAMP();
    for (;;) {
        const bool has_next = S.next(ui + 1, nxt);
        const char* nA = has_next ? (const char*)g.A + (size_t)nxt.pm * tstep : cA; const char* nB = has_next ? (const char*)g.Bt + (size_t)nxt.pn * tstep : cB;
        for (int t = 0; t < nt; t += 2) {
            const bool last = (t == nt - 2);
            const char* a1 = cA + (size_t)(t + 1) * kstep;
            const char* a2 = last ? nA : cA + (size_t)(t + 2) * kstep; const char* b2 = last ? nB : cB + (size_t)(t + 2) * kstep;
            const char* a3 = a2 + kstep; const char* b3 = b2 + kstep;
            if (last && has_next) S.a_ready(nxt);
            PG8_LDB(B0, 0, 0); PG8_SCHED; PG8_LDA(At, 0, 0); PG8_STAGE(PG8_SA(1, 1), a1 + hstep, voffA);
            PG8_WAIT_L(8); PG8_BAR; PG8_WAIT_L(0); PG8_MMA(0, 0, At, B0); PG8_BAR; PG8_SCHED;
            PG8_LDB(B1, 0, 1); PG8_STAGE(PG8_SB(0, 0), b2, voffB);
            PG8_BAR; PG8_WAIT_L(0); PG8_MMA(0, 1, At, B1); PG8_BAR;
            PG8_LDA(At, 0, 1); PG8_STAGE(PG8_SA(0, 0), a2, voffA);
            PG8_BAR; PG8_WAIT_L(0); PG8_MMA(1, 0, At, B0); PG8_BAR; PG8_SCHED;
            PG8_STAGE(PG8_SB(0, 1), b2 + hstep, voffB);
            PG8_WAIT_V(6); PG8_BAR; PG8_MMA(1, 1, At, B1); PG8_BAR;
            PG8_LDB(B0, 1, 0); PG8_SCHED; PG8_LDA(At, 1, 0); PG8_STAGE(PG8_SA(0, 1), a2 + hstep, voffA);
            PG8_WAIT_L(8); PG8_BAR; PG8_WAIT_L(0); PG8_MMA(0, 0, At, B0); PG8_BAR; PG8_SCHED;
            PG8_LDB(B1, 1, 1); PG8_STAGE(PG8_SB(1, 0), b3, voffB);
            PG8_BAR; PG8_WAIT_L(0); PG8_MMA(0, 1, At, B1); PG8_BAR;
            PG8_LDA(At, 1, 1); PG8_STAGE(PG8_SA(1, 0), a3, voffA);
            PG8_BAR; PG8_WAIT_L(0); PG8_MMA(1, 0, At, B0); PG8_BAR; PG8_SCHED;
            PG8_STAGE(PG8_SB(1, 1), b3 + hstep, voffB);
            PG8_WAIT_V(6); PG8_BAR; PG8_MMA(1, 1, At, B1); PG8_BAR;
        }
        PG8_STAMP();
        if constexpr (!Epi::AFTER_DRAIN) { E(acc, cur, wr, wc, fr, fq); S.done(cur); }
        PG8_STAMP();
        if (!has_next) break;
#pragma unroll
        for (int a = 0; a < 2; ++a)
#pragma unroll
            for (int b = 0; b < 2; ++b)
#pragma unroll
                for (int m = 0; m < 4; ++m)
#pragma unroll
                    for (int n = 0; n < 2; ++n) acc[a][b][m][n] = (f32x4){0.f, 0.f, 0.f, 0.f};
        cur = nxt; cA = nA; cB = nB; ++ui;
    }
    PG8_WAIT_V(0);
    if (wr == 0) PG8_BAR;
    PG8_BAR;
    if constexpr (Epi::AFTER_DRAIN) { E.fused(acc, cur, wr, wc, fr, fq, lds, wid, lane); S.done(cur); }
    PG8_STAMP();
    if (STAMP && wid == 0) { stamps[lane] = lane < nts ? (((unsigned long long)(unsigned)ts_hi << 32) | (unsigned)ts_lo) : 0ull;
        if (lane == 62) stamps[62] = rt_entry; if (lane == 63) stamps[63] = (unsigned long long)wall_clock64(); }
#undef PG8_STAMP
#undef PG8_SA
#undef PG8_SB
#undef PG8_STAGE
#undef PG8_LDA
#undef PG8_LDB
#undef PG8_MMA
#undef PG8_WAIT_V
#undef PG8_WAIT_L
#undef PG8_BAR
#undef PG8_SCHED
}
}
#define XB_TMO      128
#define XB_XCNT(j)  (256  + 64 * (j))
#define XB_XSUB(j)  (1280 + 64 * (j))
#define XB_XGEN(j)  (2304 + 64 * (j))
#define XB_TOP      3328
#define XB_TOPGEN   3392
#define XCD_BAR_WORDS 3456
#define XB_SPIN_CAP (1u << 18)
#define LAS __attribute__((address_space(3)))

__device__ __forceinline__ unsigned xb_ld(unsigned* p)              { return __hip_atomic_load(p, __ATOMIC_RELAXED, __HIP_MEMORY_SCOPE_AGENT); }
__device__ __forceinline__ unsigned xb_add(unsigned* p, unsigned v) { return __hip_atomic_fetch_add(p, v, __ATOMIC_RELAXED, __HIP_MEMORY_SCOPE_AGENT); }
__device__ __forceinline__ unsigned xb_xcc_id() { return (unsigned)__builtin_amdgcn_s_getreg((3 << 11) | 20) & 0xFu; }
#define XB_SPIN(cond, bar) do { unsigned _sp = 0; while (cond) { __builtin_amdgcn_s_sleep(1); \
    if ((++_sp & 255u) == 0u) { if (xb_ld(&(bar)[XB_TMO])) break; if (_sp > XB_SPIN_CAP) { atomicAdd(&(bar)[XB_TMO], 1u); break; } } } } while (0)

struct XcdBarrier {
    unsigned* bar; unsigned x;
    volatile LAS unsigned* st;
};

__device__ __forceinline__ XcdBarrier xcd_barrier_post(unsigned* bar, volatile LAS unsigned* st) {
    XcdBarrier b; b.bar = bar; b.x = xb_xcc_id(); b.st = st;
    if (threadIdx.x == 0) (void)xb_add(&bar[XB_XCNT(b.x)], 1u);
    return b;
}
__device__ __forceinline__ void xcd_barrier_complete(unsigned* bar, unsigned x, unsigned& nloc, unsigned& nx) {
    const unsigned G = gridDim.x * gridDim.y * gridDim.z;
    unsigned sum, cnt, mine, sp = 0u;
    for (;;) {
        sum = 0u; cnt = 0u; mine = 0u;
#pragma unroll
        for (unsigned j = 0; j < 16; ++j) { const unsigned c = xb_ld(&bar[XB_XCNT(j)]); sum += c; cnt += (c > 0u) ? 1u : 0u; mine = (j == x) ? c : mine; }
        if (sum == G) break;
        __builtin_amdgcn_s_sleep(1);
        if ((++sp & 255u) == 0u) { if (xb_ld(&bar[XB_TMO])) break; if (sp > XB_SPIN_CAP) { atomicAdd(&bar[XB_TMO], 1u); break; } }
    }
    nloc = mine > 0u ? mine : 1u; nx = cnt > 0u ? cnt : 1u;
}

__device__ __forceinline__ void xcd_barrier(const XcdBarrier& b) {
    asm volatile("s_waitcnt vmcnt(0)" ::: "memory");
    __syncthreads();
    if (threadIdx.x == 0) {
        unsigned* bar = b.bar;
        __builtin_amdgcn_s_waitcnt(0);
        unsigned nloc = b.st[0], nx = b.st[1];
        if (nloc == 0u) { xcd_barrier_complete(bar, b.x, nloc, nx); b.st[0] = nloc; b.st[1] = nx; }
        const unsigned old = xb_add(&bar[XB_XSUB(b.x)], 1u);
        const unsigned gen = old / nloc;
        if (old + 1u == (gen + 1u) * nloc) {
            __builtin_amdgcn_fence(__ATOMIC_RELEASE, "agent");
            asm volatile("s_waitcnt vmcnt(0)" ::: "memory");
            const unsigned og = xb_add(&bar[XB_TOP], 1u);
            const unsigned tg = og / nx;
            if (og + 1u == (tg + 1u) * nx) xb_add(&bar[XB_TOPGEN], 1u);
            else XB_SPIN(xb_ld(&bar[XB_TOPGEN]) == tg, bar);
            __builtin_amdgcn_fence(__ATOMIC_ACQUIRE, "agent");
            xb_add(&bar[XB_XGEN(b.x)], 1u);
            asm volatile("s_waitcnt vmcnt(0)" ::: "memory");
        } else {
            XB_SPIN(xb_ld(&bar[XB_XGEN(b.x)]) == gen, bar);
            __builtin_amdgcn_fence(__ATOMIC_ACQUIRE, "agent");
            asm volatile("s_waitcnt vmcnt(0)" ::: "memory");
        }
    }
    __syncthreads();
}

namespace mk {
using pg8::bf16_t; using pg8::bf16x8; using pg8::f32x4; using pg8::u32x4;
typedef unsigned u32x2 __attribute__((ext_vector_type(2)));
typedef short s16x4 __attribute__((ext_vector_type(4)));
#define DI __device__ __forceinline__
#define LDS_WAIT() asm volatile("s_waitcnt lgkmcnt(0)" ::: "memory")
#define LDS_FENCE() asm volatile("" ::: "memory")
#define MFMA16(a, b, c) __builtin_amdgcn_mfma_f32_16x16x32_bf16((a), (b), (c), 0, 0, 0)

constexpr int T = 32768, SEQ = 4096, NLAYER = 4, NPH = 16;
constexpr int PW = 5120;
constexpr int C_AB = 0, C_AC = 512, C_AX = 1024, C_NQ = 1536, C_NKV = 2048, C_UV = 2816, C_DQ = 3840, C_DK = 4352, C_DV = 4416,
              C_DQI = 4480, C_DKI = 4992, C_NG = 5056, C_DWI = 5080;
constexpr size_t MiB = 1u << 20;
constexpr size_t WS_CTL = 0, WS_PEB = 1 * MiB, WS_CMPK = 2 * MiB, WS_CMPV = 3 * MiB, WS_SK = 4 * MiB, WS_SGUW = 5 * MiB, WS_CMPA = 8 * MiB,
                 WS_CMPP = 24 * MiB, WS_WCAT = 40 * MiB, WS_WBR = 58 * MiB, WS_WOUT4 = 62 * MiB, WS_WQ = 70 * MiB, WS_WPG = 72 * MiB,
                 WS_WPP = 74 * MiB, WS_W1C = 75 * MiB, WS_PB = 78 * MiB, WS_PTU = 96 * MiB, WS_PTV = 128 * MiB, WS_H = 160 * MiB,
                 WS_Y = 224 * MiB, WS_PROJ = 352 * MiB, WS_GATES = 672 * MiB,
                 WS_KS = 928 * MiB, WS_VS = 936 * MiB, WS_KW = 944 * MiB, WS_VW = 952 * MiB, WS_DK = 960 * MiB, WS_DV = 964 * MiB, WS_DKI = 968 * MiB, WS_END = 972 * MiB;
constexpr size_t WS_ACCF = WS_PROJ, WS_MERGED = WS_PROJ + 128 * MiB, WS_QP = WS_PROJ, WS_PP = WS_PROJ + 64 * MiB, WS_EIDX = WS_PROJ + 128 * MiB, WS_EW = WS_PROJ + 144 * MiB, WS_EU = WS_PROJ + 160 * MiB;
constexpr size_t WS_COEF = WS_PROJ + 176 * MiB, WS_H8 = WS_PROJ + 192 * MiB, WS_HSI = WS_PROJ + 224 * MiB, WS_SSQ = WS_PROJ + 225 * MiB, WS_PD = WS_GATES, PT_SLICE = 2 * MiB;
constexpr int LDS_BYTES = 163840, LDS_PERWAVE = 19456, LDS_BUCK = 8 * LDS_PERWAVE, LDS_TBL = LDS_BUCK + 4096, LDS_XB = LDS_BYTES - 64;

struct Params { const float* in[27]; float* out; unsigned char* ws; int ph_lo, ph_hi; };
enum { I_X = 0, I_P, I_REL, I_GMIX, I_WIN, I_CONVW, I_PE, I_CW1, I_CW2, I_NQG, I_NKG, I_LNG, I_SGUW, I_SGUB, I_DQG, I_DKG, I_WGATE, I_WBR, I_WOUT,
       I_GFFN, I_WQ, I_SUBK, I_PU, I_PV, I_GPLE, I_WPG, I_WPP };

struct Frame { LAS unsigned char* lds; int tid, lane, wave, vb, G; };

DI float bf2f(unsigned short b) { return __uint_as_float(((unsigned)b) << 16); }
DI unsigned f2bf(float f) { unsigned u = __float_as_uint(f); return (u + 0x7fffu + ((u >> 16) & 1u)) >> 16; }
DI unsigned pk2(float lo, float hi) { return pg8::cvt_pk_bf16(lo, hi); }
DI float lo16(unsigned w) { return __uint_as_float(w << 16); }
DI float hi16(unsigned w) { return __uint_as_float(w & 0xffff0000u); }
DI float sigm(float x) { return __builtin_amdgcn_rcpf(1.f + __builtin_amdgcn_exp2f(-1.44269504f * x)); }
DI float gelu_t(float x) { const float y = (-2.f * 0.7978845608f * 1.44269504f) * (x + 0.044715f * x * x * x); return x * __builtin_amdgcn_rcpf(1.f + __builtin_amdgcn_exp2f(y)); }
#define DPP_I(x, ctrl) __builtin_amdgcn_update_dpp(0, (x), (ctrl), 0xF, 0xF, false)
DI float dppf(float x, int) { return x; }
DI float row16_sumf(float v) { v += __builtin_bit_cast(float, DPP_I(__builtin_bit_cast(int, v), 0xB1)); v += __builtin_bit_cast(float, DPP_I(__builtin_bit_cast(int, v), 0x4E));
    v += __builtin_bit_cast(float, DPP_I(__builtin_bit_cast(int, v), 0x141)); v += __builtin_bit_cast(float, DPP_I(__builtin_bit_cast(int, v), 0x140)); return v; }
DI float row16_maxf(float v) { v = fmaxf(v, __builtin_bit_cast(float, DPP_I(__builtin_bit_cast(int, v), 0xB1))); v = fmaxf(v, __builtin_bit_cast(float, DPP_I(__builtin_bit_cast(int, v), 0x4E)));
    v = fmaxf(v, __builtin_bit_cast(float, DPP_I(__builtin_bit_cast(int, v), 0x141))); v = fmaxf(v, __builtin_bit_cast(float, DPP_I(__builtin_bit_cast(int, v), 0x140))); return v; }
DI float quad_sumf(float v) { v += __builtin_bit_cast(float, DPP_I(__builtin_bit_cast(int, v), 0xB1)); v += __builtin_bit_cast(float, DPP_I(__builtin_bit_cast(int, v), 0x4E)); return v; }
DI float oct_sumf(float v) { v = quad_sumf(v); v += __builtin_bit_cast(float, DPP_I(__builtin_bit_cast(int, v), 0x141)); return v; }
DI float x16_sum(float v) { const unsigned u = __float_as_uint(v); const auto r = __builtin_amdgcn_permlane16_swap(u, u, false, false); return __uint_as_float(r[0]) + __uint_as_float(r[1]); }
DI float x32_sum(float v) { const unsigned u = __float_as_uint(v); const auto r = __builtin_amdgcn_permlane32_swap(u, u, false, false); return __uint_as_float(r[0]) + __uint_as_float(r[1]); }
DI float x16_max(float v) { const unsigned u = __float_as_uint(v); const auto r = __builtin_amdgcn_permlane16_swap(u, u, false, false); return fmaxf(__uint_as_float(r[0]), __uint_as_float(r[1])); }
DI float x32_max(float v) { const unsigned u = __float_as_uint(v); const auto r = __builtin_amdgcn_permlane32_swap(u, u, false, false); return fmaxf(__uint_as_float(r[0]), __uint_as_float(r[1])); }
DI float wave_sum(float v) { return x32_sum(x16_sum(row16_sumf(v))); }
DI float wave_max(float v) { return x32_max(x16_max(row16_maxf(v))); }
DI unsigned ordf(float f) { const unsigned u = __float_as_uint(f); return (u & 0x80000000u) ? ~u : (u | 0x80000000u); }
DI float unordf(unsigned x) { return __uint_as_float((x & 0x80000000u) ? (x & 0x7fffffffu) : ~x); }
DI int bucket_of(int n) {
    if (n < 16) return n;
    int b = 16;
    b += (n >= 21); b += (n >= 27); b += (n >= 35); b += (n >= 46); b += (n >= 59); b += (n >= 77); b += (n >= 99); b += (n >= 128);
    b += (n >= 166); b += (n >= 216); b += (n >= 280); b += (n >= 363); b += (n >= 470); b += (n >= 609); b += (n >= 790);
    return b; }

DI int srccol(int n) { return n < 2816 ? n : (n < 5056 ? n + 24 : (n < 5080 ? n - 2240 : (n < 5088 ? n : -1))); }
DI void tr_item(const float* W, int ldw, bf16_t* WT, int ldwt, int k0, int n0, LAS float* scr, int lane, bool remap, int ncopy, int cstride) {
    float tv[32];
#pragma unroll
    for (int i = 0; i < 32; ++i) { const int kk = 2 * i + (lane >> 5), nl = lane & 31; const int n = n0 + nl; const int src = remap ? srccol(n) : n; tv[i] = src >= 0 ? W[(size_t)(k0 + kk) * ldw + src] : 0.f; }
#pragma unroll
    for (int i = 0; i < 32; ++i) { const int kk = 2 * i + (lane >> 5), nl = lane & 31; scr[kk * 33 + nl] = tv[i]; }
    LDS_WAIT();
    const int c = lane & 7;
#pragma unroll
    for (int j = 0; j < 4; ++j) { const int n = (lane >> 3) + 8 * j; const LAS float* s = scr + (8 * c) * 33 + n;
        u32x4 o; o.x = pk2(s[0], s[33]); o.y = pk2(s[66], s[99]); o.z = pk2(s[132], s[165]); o.w = pk2(s[198], s[231]);
        for (int cp = 0; cp < ncopy; ++cp) *(u32x4*)(WT + (size_t)(n0 + n) * ldwt + (size_t)cp * cstride + k0 + 8 * c) = o; }
    LDS_WAIT();
}
DI void cvt_rows(const float* src, bf16_t* dst, size_t ngroups8, int gw, int NGW, int lane) {
    const size_t st = (size_t)NGW * 64;
    for (size_t i0 = (size_t)gw * 64 + lane; i0 < ngroups8; i0 += 4 * st) {
        f32x4 a[4], b[4];
#pragma unroll
        for (int r = 0; r < 4; ++r) { const size_t i = i0 + r * st < ngroups8 ? i0 + r * st : i0; a[r] = ((const f32x4*)src)[2 * i]; b[r] = ((const f32x4*)src)[2 * i + 1]; }
#pragma unroll
        for (int r = 0; r < 4; ++r) { const size_t i = i0 + r * st; if (i >= ngroups8) break;
            u32x4 o; o.x = pk2(a[r].x, a[r].y); o.y = pk2(a[r].z, a[r].w); o.z = pk2(b[r].x, b[r].y); o.w = pk2(b[r].z, b[r].w); ((u32x4*)dst)[i] = o; }
    }
}
DI int pk4_fp8(float a, float b, float c, float d) { int w = 0; w = __builtin_amdgcn_cvt_pk_fp8_f32(a, b, w, false); w = __builtin_amdgcn_cvt_pk_fp8_f32(c, d, w, true); return w; }
DI void cvt_rows_fp8(const float* src, unsigned char* dst, float* scl, int nrows, int gw, int NGW, int lane) {
    for (int r0 = gw; r0 < nrows; r0 += 4 * NGW) {
        f32x4 a[4], b[4], c[4], d[4];
#pragma unroll
        for (int k = 0; k < 4; ++k) { const int r = r0 + k * NGW < nrows ? r0 + k * NGW : r0; const float* s = src + (size_t)r * 1024 + lane * 16;
            a[k] = *(const f32x4*)s; b[k] = *(const f32x4*)(s + 4); c[k] = *(const f32x4*)(s + 8); d[k] = *(const f32x4*)(s + 12); }
#pragma unroll
        for (int k = 0; k < 4; ++k) { const int r = r0 + k * NGW; if (r >= nrows) break;
            float mx = fmaxf(fmaxf(fmaxf(fabsf(a[k].x), fabsf(a[k].y)), fmaxf(fabsf(a[k].z), fabsf(a[k].w))), fmaxf(fmaxf(fabsf(b[k].x), fabsf(b[k].y)), fmaxf(fabsf(b[k].z), fabsf(b[k].w))));
            mx = fmaxf(mx, fmaxf(fmaxf(fmaxf(fabsf(c[k].x), fabsf(c[k].y)), fmaxf(fabsf(c[k].z), fabsf(c[k].w))), fmaxf(fmaxf(fabsf(d[k].x), fabsf(d[k].y)), fmaxf(fabsf(d[k].z), fabsf(d[k].w)))));
            mx = wave_max(mx);
            const float sc = mx > 0.f ? mx * (1.f / 448.f) : 1.f, inv = 1.f / sc;
            u32x4 o; o.x = (unsigned)pk4_fp8(a[k].x * inv, a[k].y * inv, a[k].z * inv, a[k].w * inv); o.y = (unsigned)pk4_fp8(b[k].x * inv, b[k].y * inv, b[k].z * inv, b[k].w * inv);
            o.z = (unsigned)pk4_fp8(c[k].x * inv, c[k].y * inv, c[k].z * inv, c[k].w * inv); o.w = (unsigned)pk4_fp8(d[k].x * inv, d[k].y * inv, d[k].z * inv, d[k].w * inv);
            *(u32x4*)(dst + (size_t)(lane >> 3) * PT_SLICE + (size_t)r * 128 + (lane & 7) * 16) = o;
            if (lane == 0) scl[r] = sc; }
    }
}
DI void rmsnorm_rows(const float* x, const float* g, bf16_t* H, int gw, int NGW, int lane, unsigned char* H8 = nullptr, float* HSI = nullptr) {
    const f32x4 g0 = *(const f32x4*)(g + lane * 8), g1 = *(const f32x4*)(g + lane * 8 + 4), g2 = *(const f32x4*)(g + 512 + lane * 8), g3 = *(const f32x4*)(g + 512 + lane * 8 + 4);
    for (int m0 = gw; m0 < T; m0 += 4 * NGW) {
        f32x4 a[4], b[4], c[4], d[4];
#pragma unroll
        for (int r = 0; r < 4; ++r) { const int m = m0 + r * NGW < T ? m0 + r * NGW : m0; const float* xr = x + (size_t)m * 1024 + lane * 8;
            a[r] = *(const f32x4*)xr; b[r] = *(const f32x4*)(xr + 4); c[r] = *(const f32x4*)(xr + 512); d[r] = *(const f32x4*)(xr + 516); }
#pragma unroll
        for (int r = 0; r < 4; ++r) { const int m = m0 + r * NGW; if (m >= T) break;
            float ss = a[r].x * a[r].x + a[r].y * a[r].y + a[r].z * a[r].z + a[r].w * a[r].w + b[r].x * b[r].x + b[r].y * b[r].y + b[r].z * b[r].z + b[r].w * b[r].w
                     + c[r].x * c[r].x + c[r].y * c[r].y + c[r].z * c[r].z + c[r].w * c[r].w + d[r].x * d[r].x + d[r].y * d[r].y + d[r].z * d[r].z + d[r].w * d[r].w;
            ss = wave_sum(ss);
            const float rr = rsqrtf(ss * (1.f / 1024.f) + 1e-6f);
            u32x4 o0, o1;
            o0.x = pk2(a[r].x * rr * g0.x, a[r].y * rr * g0.y); o0.y = pk2(a[r].z * rr * g0.z, a[r].w * rr * g0.w); o0.z = pk2(b[r].x * rr * g1.x, b[r].y * rr * g1.y); o0.w = pk2(b[r].z * rr * g1.z, b[r].w * rr * g1.w);
            o1.x = pk2(c[r].x * rr * g2.x, c[r].y * rr * g2.y); o1.y = pk2(c[r].z * rr * g2.z, c[r].w * rr * g2.w); o1.z = pk2(d[r].x * rr * g3.x, d[r].y * rr * g3.y); o1.w = pk2(d[r].z * rr * g3.z, d[r].w * rr * g3.w);
            bf16_t* hr = H + (size_t)m * 1024 + lane * 8; *(u32x4*)hr = o0; *(u32x4*)(hr + 512) = o1;
            if (H8) {
                float v[16] = {a[r].x * rr * g0.x, a[r].y * rr * g0.y, a[r].z * rr * g0.z, a[r].w * rr * g0.w, b[r].x * rr * g1.x, b[r].y * rr * g1.y, b[r].z * rr * g1.z, b[r].w * rr * g1.w,
                               c[r].x * rr * g2.x, c[r].y * rr * g2.y, c[r].z * rr * g2.z, c[r].w * rr * g2.w, d[r].x * rr * g3.x, d[r].y * rr * g3.y, d[r].z * rr * g3.z, d[r].w * rr * g3.w};
                float am = 0.f;
#pragma unroll
                for (int e = 0; e < 16; ++e) am = fmaxf(am, fabsf(v[e]));
                am = wave_max(am);
                const float hs = am > 0.f ? 224.f / am : 1.f;
                u32x2 q0, q1; q0.x = (unsigned)pk4_fp8(v[0] * hs, v[1] * hs, v[2] * hs, v[3] * hs); q0.y = (unsigned)pk4_fp8(v[4] * hs, v[5] * hs, v[6] * hs, v[7] * hs);
                q1.x = (unsigned)pk4_fp8(v[8] * hs, v[9] * hs, v[10] * hs, v[11] * hs); q1.y = (unsigned)pk4_fp8(v[12] * hs, v[13] * hs, v[14] * hs, v[15] * hs);
                unsigned char* h8 = H8 + (size_t)m * 1024 + lane * 8; *(u32x2*)h8 = q0; *(u32x2*)(h8 + 512) = q1;
                if (lane == 0) HSI[m] = 1.f / hs; } }
    }
}
DI void phase_prep_w(const Params& p, int l, const Frame& F) {
    LAS float* scr = (LAS float*)(F.lds + F.wave * 8448);
    const int gw = F.vb * 8 + F.wave, NGW = F.G * 8, lane = F.lane;
    unsigned char* ws = p.ws;
    bf16_t* WCAT = (bf16_t*)(ws + WS_WCAT); bf16_t* WBR = (bf16_t*)(ws + WS_WBR); bf16_t* WOUT4 = (bf16_t*)(ws + WS_WOUT4); bf16_t* WQ = (bf16_t*)(ws + WS_WQ);
    bf16_t* WPG = (bf16_t*)(ws + WS_WPG); bf16_t* WPP = (bf16_t*)(ws + WS_WPP); bf16_t* W1C = (bf16_t*)(ws + WS_W1C);
    constexpr int I0 = 2560, I1 = 2048, I2 = 1024, I3 = 512, I4 = 512, I5 = 512, I6 = 128, I7 = 512, NIT = I0 + I1 + I2 + I3 + I4 + I5 + I6 + I7;
    for (int it = gw; it < NIT; it += NGW) {
        int r = it;
        if (r < I0) { tr_item(p.in[I_WIN] + (size_t)l * 1024 * 5088, 5088, WCAT, 1024, (r / 160) * 64, (r % 160) * 32, scr, lane, true, 1, 0); continue; } r -= I0;
        if (r < I1) { tr_item(p.in[I_WGATE] + (size_t)l * 1024 * 4096, 4096, WCAT + (size_t)5120 * 1024, 1024, (r / 128) * 64, (r % 128) * 32, scr, lane, false, 1, 0); continue; } r -= I1;
        if (r < I2) { const int m = r >> 8, rr = r & 255; tr_item(p.in[I_WBR] + ((size_t)l * 2048 + m * 512) * 1024, 1024, WBR + (size_t)m * 1024 * 512, 512, (rr / 32) * 64, (rr % 32) * 32, scr, lane, false, 1, 0); continue; } r -= I2;
        if (r < I3) { tr_item(p.in[I_WOUT] + (size_t)l * 1024 * 1024, 1024, WOUT4, 1024, (r / 32) * 64, (r % 32) * 32, scr, lane, false, 1, 0); continue; } r -= I3;
        if (r < I4) { tr_item(p.in[I_WQ] + (size_t)l * 1024 * 1024, 1024, WQ, 1024, (r / 32) * 64, (r % 32) * 32, scr, lane, false, 1, 0); continue; } r -= I4;
        if (r < I5) { tr_item(p.in[I_WPG] + (size_t)l * 1024 * 1024, 1024, WPG, 1024, (r / 32) * 64, (r % 32) * 32, scr, lane, false, 1, 0); continue; } r -= I5;
        if (r < I6) { tr_item(p.in[I_WPP] + (size_t)l * 256 * 1024, 1024, WPP, 256, (r / 32) * 64, (r % 32) * 32, scr, lane, false, 1, 0); continue; } r -= I6;
        { const int jh = r >> 7, rr = r & 127, j = jh >> 1, half = jh & 1;
          tr_item(p.in[I_CW1] + (((size_t)l * 2 + j) * 2048 + half * 1024) * 256, 256, W1C + ((size_t)j * 512 + half * 256) * 1024, 1024, (rr / 8) * 64, (rr % 8) * 32, scr, lane, false, 1, 0); }
    }
    cvt_rows_fp8(p.in[I_PU] + (size_t)l * 16384 * 1024, ws + WS_PTU, (float*)(ws + WS_PTV), 16384, gw, NGW, lane);
    cvt_rows_fp8(p.in[I_PV] + (size_t)l * 16384 * 1024, ws + WS_PTU + 16 * MiB, (float*)(ws + WS_PTV) + 16384, 16384, gw, NGW, lane);
    cvt_rows(p.in[I_SUBK] + (size_t)l * 131072, (bf16_t*)(ws + WS_SK), 131072 / 8, gw, NGW, lane);
    cvt_rows(p.in[I_P] + (size_t)l * T * 256, (bf16_t*)(ws + WS_PB), (size_t)T * 256 / 8, gw, NGW, lane);
    { const float* sw = p.in[I_SGUW] + (size_t)l * 131072; bf16_t* dst = (bf16_t*)(ws + WS_SGUW);
      for (int i = gw * 64 + lane; i < 131072 / 8; i += NGW * 64) { const int e = i * 8, t = (e >> 7) & 127, s0 = e & 127; float v[8];
#pragma unroll
          for (int k = 0; k < 8; ++k) v[k] = (s0 + k <= t) ? sw[e + k] : 0.f;
          u32x4 o; o.x = pk2(v[0], v[1]); o.y = pk2(v[2], v[3]); o.z = pk2(v[4], v[5]); o.w = pk2(v[6], v[7]); ((u32x4*)dst)[i] = o; } }
    { float* peb = (float*)(ws + WS_PEB);
      for (int o = gw; o < 512; o += NGW) { const int j = o >> 8, n = o & 255; const float* pe = p.in[I_PE] + ((size_t)l * 2 + j) * 2048; const float* w1 = p.in[I_CW1] + ((size_t)l * 2 + j) * 2048 * 256;
          float s = 0.f; for (int k = lane; k < 2048; k += 64) s += pe[k] * w1[(size_t)k * 256 + n];
          s = wave_sum(s); if (lane == 0) peb[o] = s; } }
    rmsnorm_rows(l == 0 ? p.in[I_X] : p.out, p.in[I_GMIX] + l * 1024, (bf16_t*)(ws + WS_H), gw, NGW, lane);
}

struct Epi1 {
    static constexpr bool PERM = true, AFTER_DRAIN = false;
    bf16_t* proj; bf16_t* gates;
    DI void operator()(const f32x4 (&acc)[2][2][4][2], const pg8::Unit& u, int wr, int wc, int fr, int fq) const {
        const int row0 = u.pm * 256 + wr * 64 + fr; const bool isg = u.pn >= 20;
        const int col0 = (isg ? (u.pn - 20) * 256 : u.pn * 256) + wc * 32 + 8 * fq; bf16_t* base = isg ? gates : proj; const int ldc = isg ? 4096 : PW;
#pragma unroll
        for (int ai = 0; ai < 2; ++ai)
#pragma unroll
            for (int m = 0; m < 4; ++m) { bf16_t* rowp = base + (size_t)(row0 + ai * 128 + m * 16) * ldc + col0;
#pragma unroll
                for (int bj = 0; bj < 2; ++bj) { f32x4 v0 = acc[ai][bj][m][0], v1 = acc[ai][bj][m][1];
                    if (isg) { v0.x = sigm(v0.x); v0.y = sigm(v0.y); v0.z = sigm(v0.z); v0.w = sigm(v0.w); v1.x = sigm(v1.x); v1.y = sigm(v1.y); v1.z = sigm(v1.z); v1.w = sigm(v1.w); }
                    u32x4 w; w.x = pk2(v0.x, v0.y); w.y = pk2(v0.z, v0.w); w.z = pk2(v1.x, v1.y); w.w = pk2(v1.z, v1.w);
                    __builtin_nontemporal_store(w, (u32x4*)(rowp + bj * 128)); } }
    }
};
struct EpiBf {
    static constexpr bool PERM = true, AFTER_DRAIN = false;
    bf16_t* O; int ldc;
    DI void operator()(const f32x4 (&acc)[2][2][4][2], const pg8::Unit& u, int wr, int wc, int fr, int fq) const {
        const int row0 = u.pm * 256 + wr * 64 + fr, col0 = u.pn * 256 + wc * 32 + 8 * fq;
#pragma unroll
        for (int ai = 0; ai < 2; ++ai)
#pragma unroll
            for (int m = 0; m < 4; ++m) { bf16_t* rowp = O + (size_t)(row0 + ai * 128 + m * 16) * ldc + col0;
#pragma unroll
                for (int bj = 0; bj < 2; ++bj) { const f32x4 v0 = acc[ai][bj][m][0], v1 = acc[ai][bj][m][1];
                    u32x4 w; w.x = pk2(v0.x, v0.y); w.y = pk2(v0.z, v0.w); w.z = pk2(v1.x, v1.y); w.w = pk2(v1.z, v1.w);
                    *(u32x4*)(rowp + bj * 128) = w; } }
    }
};
struct EpiF32P {
    static constexpr bool PERM = true, AFTER_DRAIN = false;
    float* C; int ldc;
    DI void operator()(const f32x4 (&acc)[2][2][4][2], const pg8::Unit& u, int wr, int wc, int fr, int fq) const {
        const int row0 = u.pm * 256 + wr * 64 + fr, col0 = u.pn * 256 + wc * 32 + 8 * fq;
#pragma unroll
        for (int ai = 0; ai < 2; ++ai)
#pragma unroll
            for (int m = 0; m < 4; ++m) { float* rowp = C + (size_t)(row0 + ai * 128 + m * 16) * ldc + col0;
#pragma unroll
                for (int bj = 0; bj < 2; ++bj) { *(f32x4*)(rowp + bj * 128) = acc[ai][bj][m][0]; *(f32x4*)(rowp + bj * 128 + 4) = acc[ai][bj][m][1]; } }
    }
};
struct XcdColOrder {
    int G, c;
    DI bool next(int i, pg8::Unit& u) const {
        if (G != 256) { const int Lx = i * G + c; if (Lx >= 128 * 36) return false; u.pm = Lx / 36; u.pn = Lx % 36; return true; }
        if (i >= 18) return false;
        const int x = c & 7, w = c >> 3;
        if (i < 16) { u.pm = 8 * i + (w & 7); u.pn = 4 * x + (w >> 3); }
        else { u.pm = 16 * x + 8 * (i - 16) + (w & 7); u.pn = 32 + (w >> 3); }
        return true; }
    DI void a_ready(const pg8::Unit&) const {}
    DI void done(const pg8::Unit&) const {}
};
struct RoundOrder {
    pg8::StaticOrder base; int r;
    DI bool next(int i, pg8::Unit& u) const { return i == 0 && base.next(r, u); }
    DI void a_ready(const pg8::Unit&) const {}
    DI void done(const pg8::Unit&) const {}
};
struct ColRangeOrder {
    int G, c, c0, c1;
    DI bool next(int i, pg8::Unit& u) const { const int nc = c1 - c0; const int Lx = i * G + c; if (Lx >= 128 * nc) return false; u.pm = Lx / nc; u.pn = c0 + Lx % nc; return true; }
    DI void a_ready(const pg8::Unit&) const {}
    DI void done(const pg8::Unit&) const {}
};
struct BranchOrder {
    int G, c;
    DI bool next(int i, pg8::Unit& u) const { const int tile = c + G * (i >> 2), m = i & 3; if (tile >= 512) return false; u.pm = m * 128 + (tile >> 2); u.pn = m * 4 + (tile & 3); return true; }
    DI void a_ready(const pg8::Unit&) const {}
    DI void done(const pg8::Unit&) const {}
};
struct EpiBranch {
    static constexpr bool PERM = true, AFTER_DRAIN = false;
    const bf16_t* gates; bf16_t* merged;
    DI void operator()(const f32x4 (&acc)[2][2][4][2], const pg8::Unit& u, int wr, int wc, int fr, int fq) const {
        const int m4 = u.pn >> 2; const int row0 = (u.pm & 127) * 256 + wr * 64 + fr, gcol0 = u.pn * 256 + wc * 32 + 8 * fq, dcol0 = (u.pn & 3) * 256 + wc * 32 + 8 * fq;
#pragma unroll
        for (int ai = 0; ai < 2; ++ai) {
            u32x4 g[4][2], pr[4][2];
#pragma unroll
            for (int m = 0; m < 4; ++m)
#pragma unroll
                for (int bj = 0; bj < 2; ++bj) { g[m][bj] = *(const u32x4*)(gates + (size_t)(row0 + ai * 128 + m * 16) * 4096 + gcol0 + bj * 128);
                    if (m4 > 0) pr[m][bj] = *(const u32x4*)(merged + (size_t)(row0 + ai * 128 + m * 16) * 1024 + dcol0 + bj * 128); }
#pragma unroll
            for (int m = 0; m < 4; ++m)
#pragma unroll
                for (int bj = 0; bj < 2; ++bj) { const f32x4 v0 = acc[ai][bj][m][0], v1 = acc[ai][bj][m][1]; const u32x4 gg = g[m][bj];
                    f32x4 r0 = {v0.x * lo16(gg.x), v0.y * hi16(gg.x), v0.z * lo16(gg.y), v0.w * hi16(gg.y)}, r1 = {v1.x * lo16(gg.z), v1.y * hi16(gg.z), v1.z * lo16(gg.w), v1.w * hi16(gg.w)};
                    if (m4 > 0) { const u32x4 pp_ = pr[m][bj];
                        r0.x += lo16(pp_.x); r0.y += hi16(pp_.x); r0.z += lo16(pp_.y); r0.w += hi16(pp_.y); r1.x += lo16(pp_.z); r1.y += hi16(pp_.z); r1.z += lo16(pp_.w); r1.w += hi16(pp_.w); }
                    u32x4 w; w.x = pk2(r0.x, r0.y); w.y = pk2(r0.z, r0.w); w.z = pk2(r1.x, r1.y); w.w = pk2(r1.z, r1.w);
                    *(u32x4*)(merged + (size_t)(row0 + ai * 128 + m * 16) * 1024 + dcol0 + bj * 128) = w; }
        }
    }
};
struct EpiRes {
    static constexpr bool PERM = true, AFTER_DRAIN = false;
    const float* xin; float* out;
    DI void operator()(const f32x4 (&acc)[2][2][4][2], const pg8::Unit& u, int wr, int wc, int fr, int fq) const {
        const int row0 = u.pm * 256 + wr * 64 + fr, col0 = u.pn * 256 + wc * 32 + 8 * fq;
#pragma unroll
        for (int ai = 0; ai < 2; ++ai)
#pragma unroll
            for (int mh = 0; mh < 2; ++mh) {
                f32x4 xa[2][2][2];
#pragma unroll
                for (int m2 = 0; m2 < 2; ++m2)
#pragma unroll
                    for (int bj = 0; bj < 2; ++bj) { const size_t off = (size_t)(row0 + ai * 128 + (mh * 2 + m2) * 16) * 1024 + col0 + bj * 128; xa[m2][bj][0] = *(const f32x4*)(xin + off); xa[m2][bj][1] = *(const f32x4*)(xin + off + 4); }
#pragma unroll
                for (int m2 = 0; m2 < 2; ++m2)
#pragma unroll
                    for (int bj = 0; bj < 2; ++bj) { const size_t off = (size_t)(row0 + ai * 128 + (mh * 2 + m2) * 16) * 1024 + col0 + bj * 128;
                        *(f32x4*)(out + off) = xa[m2][bj][0] + acc[ai][bj][mh * 2 + m2][0]; *(f32x4*)(out + off + 4) = xa[m2][bj][1] + acc[ai][bj][mh * 2 + m2][1]; }
            }
    }
};
struct EpiPle {
    static constexpr bool PERM = true, AFTER_DRAIN = false;
    float* x; const bf16_t* pp; const float* ssq;
    DI void operator()(const f32x4 (&acc)[2][2][4][2], const pg8::Unit& u, int wr, int wc, int fr, int fq) const {
        const int row0 = u.pm * 256 + wr * 64 + fr, col0 = u.pn * 256 + wc * 32 + 8 * fq;
#pragma unroll
        for (int ai = 0; ai < 2; ++ai)
#pragma unroll
            for (int mh = 0; mh < 2; ++mh) {
                f32x4 xa[2][2][2]; u32x4 ga[2][2]; f32x4 sq[2][2];
#pragma unroll
                for (int m2 = 0; m2 < 2; ++m2) { const float* sp = ssq + (size_t)(row0 + ai * 128 + (mh * 2 + m2) * 16) * 8; sq[m2][0] = *(const f32x4*)sp; sq[m2][1] = *(const f32x4*)(sp + 4);
#pragma unroll
                    for (int bj = 0; bj < 2; ++bj) { const size_t off = (size_t)(row0 + ai * 128 + (mh * 2 + m2) * 16) * 1024 + col0 + bj * 128;
                        xa[m2][bj][0] = *(const f32x4*)(x + off); xa[m2][bj][1] = *(const f32x4*)(x + off + 4); ga[m2][bj] = *(const u32x4*)(pp + off); } }
#pragma unroll
                for (int m2 = 0; m2 < 2; ++m2) {
                    const float rr = rsqrtf((((sq[m2][0].x + sq[m2][0].y) + (sq[m2][0].z + sq[m2][0].w)) + ((sq[m2][1].x + sq[m2][1].y) + (sq[m2][1].z + sq[m2][1].w))) * (1.f / 1024.f) + 1e-6f);
#pragma unroll
                    for (int bj = 0; bj < 2; ++bj) { const size_t off = (size_t)(row0 + ai * 128 + (mh * 2 + m2) * 16) * 1024 + col0 + bj * 128;
                        const f32x4 v0 = acc[ai][bj][mh * 2 + m2][0] * rr, v1 = acc[ai][bj][mh * 2 + m2][1] * rr; const u32x4 g = ga[m2][bj]; f32x4 x0 = xa[m2][bj][0], x1 = xa[m2][bj][1];
                        x0.x += sigm(v0.x) * lo16(g.x); x0.y += sigm(v0.y) * hi16(g.x); x0.z += sigm(v0.z) * lo16(g.y); x0.w += sigm(v0.w) * hi16(g.y);
                        x1.x += sigm(v1.x) * lo16(g.z); x1.y += sigm(v1.y) * hi16(g.z); x1.z += sigm(v1.z) * lo16(g.w); x1.w += sigm(v1.w) * hi16(g.w);
                        *(f32x4*)(x + off) = x0; *(f32x4*)(x + off + 4) = x1; } }
            }
    }
};


DI void unpack8(const u32x4 w, float (&f)[8]) { f[0] = lo16(w.x); f[1] = hi16(w.x); f[2] = lo16(w.y); f[3] = hi16(w.y); f[4] = lo16(w.z); f[5] = hi16(w.z); f[6] = lo16(w.w); f[7] = hi16(w.w); }
DI u32x4 pack8(const float (&f)[8]) { u32x4 o; o.x = pk2(f[0], f[1]); o.y = pk2(f[2], f[3]); o.z = pk2(f[4], f[5]); o.w = pk2(f[6], f[7]); return o; }
DI void load8f(const float* p, float (&f)[8]) { const f32x4 a = *(const f32x4*)p, b = *(const f32x4*)(p + 4); f[0] = a.x; f[1] = a.y; f[2] = a.z; f[3] = a.w; f[4] = b.x; f[5] = b.y; f[6] = b.z; f[7] = b.w; }

DI void phase_chunk(const Params& p, int l, const Frame& F) {
    unsigned char* ws = p.ws; const int lane = F.lane, wave = F.wave;
    bf16_t* PROJ = (bf16_t*)(ws + WS_PROJ); bf16_t* YA = (bf16_t*)(ws + WS_Y); bf16_t* YC = YA + (size_t)2 * T * 512; bf16_t* CMPA = (bf16_t*)(ws + WS_CMPA);
    const bf16_t* SGUW = (const bf16_t*)(ws + WS_SGUW);
    LAS unsigned char* vnT = F.lds;
    const float* convw = p.in[I_CONVW] + (size_t)l * 3 * 512; const float* lng = p.in[I_LNG] + (size_t)l * 512; const float* sgub = p.in[I_SGUB] + (size_t)l * 8 * 128;
    float cw0[8], cw1[8], cw2[8], lgn[8];
    load8f(convw + lane * 8, cw0); load8f(convw + 512 + lane * 8, cw1); load8f(convw + 1024 + lane * 8, cw2); load8f(lng + lane * 8, lgn);
    for (int chunk = F.vb; chunk < T / 128; chunk += F.G) {
        const int t0 = chunk * 128;
        for (int tt = wave; tt < 128; tt += 8) {
            const int t = t0 + tt, s = t & (SEQ - 1), b = t >> 12;
            bf16_t* row = PROJ + (size_t)t * PW;
            const int c0 = lane * 8;
            const u32x4 z = {0u, 0u, 0u, 0u};
            const u32x4 rab = *(const u32x4*)(row + C_AB + c0), rc0 = *(const u32x4*)(row + C_AC + c0), rx0 = *(const u32x4*)(row + C_AX + c0);
            u32x4 r1c = z, r1x = z, r2c = z, r2x = z;
            if (s >= 1) { r1c = *(const u32x4*)(row - PW + C_AC + c0); r1x = *(const u32x4*)(row - PW + C_AX + c0); }
            if (s >= 2) { r2c = *(const u32x4*)(row - 2 * PW + C_AC + c0); r2x = *(const u32x4*)(row - 2 * PW + C_AX + c0); }
            u32x4 segv[3]; int segcol[3]; const float* seggp[3]; float segsc[3];
#pragma unroll
            for (int pass = 0; pass < 3; ++pass) {
                const int seg = pass * 8 + (lane >> 3), sg = seg < 20 ? seg : 20; int col; const float* gp; float sc = 1.f;
                if (sg < 8) { col = C_NQ + 64 * sg; gp = p.in[I_NQG] + l * 64; sc = 0.125f * 1.44269504f; }
                else if (sg < 10) { col = C_NKV + 2 * 128 + (sg - 8) * 64; gp = p.in[I_NKG] + (l * 3 + 1) * 64; }
                else if (sg < 12) { col = C_NKV + 4 * 128 + (sg - 10) * 64; gp = p.in[I_NKG] + (l * 3 + 2) * 64; }
                else if (sg < 20) { col = C_DQ + 64 * (sg - 12); gp = p.in[I_DQG] + l * 64; sc = 0.125f * 1.44269504f; }
                else { col = C_DK; gp = p.in[I_DKG] + l * 64; }
                segcol[pass] = col; seggp[pass] = gp; segsc[pass] = sc; segv[pass] = *(const u32x4*)(row + col + (lane & 7) * 8);
            }
            u32x4 rawc = z; const bf16_t* rawsrc = row; bf16_t* rawdst = nullptr;
            if (lane < 48) { const int sgc = lane >> 3;
                if (sgc < 2) { rawsrc = row + C_NKV + 3 * 128 + sgc * 64; rawdst = (bf16_t*)(ws + WS_VS) + ((size_t)((b * 2 + sgc) * SEQ + s)) * 64; }
                else if (sgc < 4) { rawsrc = row + C_NKV + 5 * 128 + (sgc - 2) * 64; rawdst = (bf16_t*)(ws + WS_VW) + ((size_t)((b * 2 + (sgc - 2)) * SEQ + s)) * 64; }
                else if (sgc == 4) { rawsrc = row + C_DV; rawdst = (bf16_t*)(ws + WS_DV) + (size_t)t * 64; }
                else { rawsrc = row + C_DKI; rawdst = (bf16_t*)(ws + WS_DKI) + (size_t)t * 64; }
                rawc = *(const u32x4*)(rawsrc + (lane & 7) * 8); }
            u32x4 cmpc = z;
            if (lane < 32) { const int jg = lane >> 3; cmpc = *(const u32x4*)(row + C_NKV + (jg >> 1) * 128 + (jg & 1) * 64 + (lane & 7) * 8); }
            const u32x4 ruv = *(const u32x4*)(row + C_UV + 512 + lane * 8);
            {
                float ab[8], c0v[8], x0v[8], c1v[8], x1v[8], c2v[8], x2v[8], y[8];
                unpack8(rab, ab); unpack8(rc0, c0v); unpack8(rx0, x0v); unpack8(r1c, c1v); unpack8(r1x, x1v); unpack8(r2c, c2v); unpack8(r2x, x2v);
#pragma unroll
                for (int e = 0; e < 8; ++e) y[e] = ab[e] * (cw2[e] * c0v[e] * x0v[e] + cw1[e] * c1v[e] * x1v[e] + cw0[e] * c2v[e] * x2v[e]);
                *(u32x4*)(YA + (size_t)t * 512 + c0) = pack8(y);
            }
#pragma unroll
            for (int pass = 0; pass < 3; ++pass) {
                const int seg = pass * 8 + (lane >> 3), part = lane & 7, sg = seg < 20 ? seg : 20;
                float v[8], g[8]; unpack8(segv[pass], v); load8f(seggp[pass] + part * 8, g);
                float ss = 0.f;
#pragma unroll
                for (int e = 0; e < 8; ++e) ss += v[e] * v[e];
                ss = oct_sumf(ss);
                const float r = rsqrtf(ss * (1.f / 64.f) + 1e-6f) * segsc[pass];
#pragma unroll
                for (int e = 0; e < 8; ++e) v[e] = v[e] * r * g[e];
                bf16_t* dstp = row + segcol[pass] + part * 8;
                if (sg >= 8 && sg < 10) dstp = (bf16_t*)(ws + WS_KS) + ((size_t)((b * 2 + (sg - 8)) * SEQ + s)) * 64 + part * 8;
                else if (sg >= 10 && sg < 12) dstp = (bf16_t*)(ws + WS_KW) + ((size_t)((b * 2 + (sg - 10)) * SEQ + s)) * 64 + part * 8;
                else if (sg == 20) dstp = (bf16_t*)(ws + WS_DK) + (size_t)t * 64 + part * 8;
                if (seg < 21) *(u32x4*)dstp = pack8(v);
            }
            if (lane < 48) *(u32x4*)(rawdst + (lane & 7) * 8) = rawc;
            if (lane < 32) { const int jg = lane >> 3, j = jg >> 1, g = jg & 1, part = lane & 7;
                *(u32x4*)(CMPA + ((size_t)j * 4096 + ((size_t)(b * 256 + (s >> 4)) * 2 + g)) * 1024 + (s & 15) * 64 + part * 8) = cmpc; }
            {
                float v[8]; unpack8(ruv, v);
                float sm = 0.f;
#pragma unroll
                for (int e = 0; e < 8; ++e) { v[e] = gelu_t(v[e]); sm += v[e]; }
                const float mean = wave_sum(sm) * (1.f / 512.f); float sq = 0.f;
#pragma unroll
                for (int e = 0; e < 8; ++e) { v[e] -= mean; sq += v[e] * v[e]; }
                const float r = rsqrtf(wave_sum(sq) * (1.f / 512.f) + 1e-6f);
#pragma unroll
                for (int e = 0; e < 8; ++e) *(LAS unsigned short*)(vnT + (lane * 8 + e) * 272 + tt * 2) = (unsigned short)f2bf(v[e] * r * lgn[e]);
            }
        }
        __syncthreads();
        {
            const int g = wave, c = lane & 15, q = lane >> 4; const bf16_t* Wg = SGUW + (size_t)g * 128 * 128;
            for (int tt16 = 0; tt16 < 8; ++tt16) {
                const int nk = (tt16 >> 1) + 1;
                bf16x8 bw[4];
#pragma unroll
                for (int kk = 0; kk < 4; ++kk) bw[kk] = *(const bf16x8*)(Wg + (size_t)(16 * tt16 + c) * 128 + 32 * (kk < nk ? kk : 0) + 8 * q);
                const int t = t0 + 16 * tt16 + c; const float bias = sgub[g * 128 + 16 * tt16 + c];
#pragma unroll
                for (int dt = 0; dt < 4; ++dt) {
                    f32x4 acc = {0.f, 0.f, 0.f, 0.f};
#pragma unroll
                    for (int kk = 0; kk < 4; ++kk) if (kk < nk) { const bf16x8 a = *(const LAS bf16x8*)(vnT + (g * 64 + 16 * dt + c) * 272 + (32 * kk + 8 * q) * 2); acc = MFMA16(a, bw[kk], acc); }
                    const int ch = g * 64 + 16 * dt + 4 * q;
                    const u32x2 uu = *(const u32x2*)(PROJ + (size_t)t * PW + C_UV + ch);
                    u32x2 o; o.x = pk2(gelu_t(lo16(uu.x)) * (acc[0] + bias), gelu_t(hi16(uu.x)) * (acc[1] + bias)); o.y = pk2(gelu_t(lo16(uu.y)) * (acc[2] + bias), gelu_t(hi16(uu.y)) * (acc[3] + bias));
                    *(u32x2*)(YC + (size_t)t * 512 + ch) = o;
                }
            }
        }
        __syncthreads();
    }
}

DI void phase_cmp2(const Params& p, int l, const Frame& F) {
    unsigned char* ws = p.ws; const int lane = F.lane; const int gw = F.vb * 8 + F.wave, NGW = F.G * 8;
    LAS float* hid = (LAS float*)(F.lds + 131072 + F.wave * 1024);
    LAS float* w2s = (LAS float*)F.lds;
    { const float* w2g = p.in[I_CW2] + (size_t)l * 2 * 256 * 64;
      for (int i = F.tid; i < 2 * 256 * 64 / 4; i += 512) *(LAS f32x4*)(w2s + i * 4) = *(const f32x4*)(w2g + i * 4); }
    __syncthreads();
    const float* CMPP = (const float*)(ws + WS_CMPP); const float* peb = (const float*)(ws + WS_PEB);
    bf16_t* CMPK = (bf16_t*)(ws + WS_CMPK); bf16_t* CMPV = (bf16_t*)(ws + WS_CMPV);
    const float* kg = p.in[I_NKG] + (l * 3 + 0) * 64;
    for (int it = gw; it < 8 * 256 * 2 * 2; it += NGW) {
        const int j = it & 1, g = (it >> 1) & 1, n = (it >> 2) & 255, b = it >> 10;
        bf16_t* dst = (j ? CMPV : CMPK) + ((size_t)(b * 2 + g) * 256 + n) * 64;
        if (n == 255) { dst[lane] = 0; continue; }
        const float* Pa = CMPP + ((size_t)j * 4096 + (size_t)(b * 256 + n) * 2 + g) * 512; const float* Pb = CMPP + ((size_t)j * 4096 + (size_t)(b * 256 + n + 1) * 2 + g) * 512 + 256;
        const f32x4 a = *(const f32x4*)(Pa + lane * 4), bq = *(const f32x4*)(Pb + lane * 4), pe = *(const f32x4*)(peb + j * 256 + lane * 4);
        f32x4 h; h.x = gelu_t(a.x + bq.x + pe.x); h.y = gelu_t(a.y + bq.y + pe.y); h.z = gelu_t(a.z + bq.z + pe.z); h.w = gelu_t(a.w + bq.w + pe.w);
        *(LAS f32x4*)(hid + lane * 4) = h;
        LDS_WAIT();
        const LAS float* w2 = w2s + j * 256 * 64;
        float o = 0.f;
#pragma unroll 16
        for (int k = 0; k < 256; ++k) o += hid[k] * w2[k * 64 + lane];
        if (j == 0) { const float ss = wave_sum(o * o); o = o * rsqrtf(ss * (1.f / 64.f) + 1e-6f) * kg[lane]; }
        dst[lane] = (bf16_t)f2bf(o);
        LDS_WAIT();
    }
}

DI int bucket_fast(int n) { const int big = 16 + (int)((__log2f((float)n) - 4.f) * 2.6666667f + 2e-4f); return n < 16 ? n : (big < 31 ? big : 31); }
struct KsCmp { static constexpr bool CONTIG = true; static constexpr int DSTEP = 16, DMAX = 1 << 30; const bf16_t* kb; const bf16_t* vb; int t0, hb;
    DI void base(int k0, const bf16_t*& k, const bf16_t*& v) const { k = kb + (size_t)k0 * 64; v = vb + (size_t)k0 * 64; }
    DI int dist0(int k0, int c) const { return t0 + (c >> 2) - (16 * k0 + 31); } };
struct KsSel { static constexpr bool CONTIG = true; static constexpr int DSTEP = 1, DMAX = 1 << 30; const bf16_t* kb; const bf16_t* vb; const LAS int* selb; int t, hb;
    DI int p0(int k0) const { return __builtin_amdgcn_readfirstlane(selb[k0 >> 6]) * 64 + (k0 & 63); }
    DI void base(int k0, const bf16_t*& k, const bf16_t*& v) const { const int ps = p0(k0); k = kb + (size_t)ps * 64; v = vb + (size_t)ps * 64; }
    DI int dist0(int k0, int c) const { return t - p0(k0); } };
struct KsWin { static constexpr bool CONTIG = true; static constexpr int DSTEP = 1, DMAX = 512; const bf16_t* kb; const bf16_t* vb; int pstart, t0, hb;
    DI void base(int k0, const bf16_t*& k, const bf16_t*& v) const { k = kb + (size_t)(pstart + k0) * 64; v = vb + (size_t)(pstart + k0) * 64; }
    DI int dist0(int k0, int c) const { return t0 + (c >> 2) - (pstart + k0); } };
struct KsDsa { static constexpr bool CONTIG = false; static constexpr int DSTEP = 1, DMAX = 1 << 30; const bf16_t* kb; const bf16_t* vb; const LAS int* list; int n, t;
    DI int pos(int idx) const { return idx < n ? list[idx] : -1; }
    DI const bf16_t* krow(int idx) const { const int ps = pos(idx); return kb + (size_t)(ps < 0 ? 0 : ps) * 64; }
    DI const bf16_t* vrow(int idx) const { const int ps = pos(idx); return vb + (size_t)(ps < 0 ? 0 : ps) * 64; }
    DI float adjust(int idx, int c, float s, bool& ok, const LAS unsigned char* buck, const LAS float* tbl) const {
        const int ps = pos(idx); ok = ps >= 0 && ps <= t; const int dd = t - ps; const int dc = ok ? (dd < 1023 ? dd : 1023) : 0; return s + tbl[buck[dc] * 16 + 8 + (c & 7)]; } };

template <int MODE, class KS>
DI void flash_run(const KS& ks, int nkeys, const bf16x8 (&qb)[2], f32x4 (&o)[4], float& m_run, float& l_run, LAS unsigned char* vt, LAS float* al, LAS float* pn,
                  const LAS unsigned char* buck, const LAS float* tbl, int lane) {
    const int c = lane & 15, q = lane >> 4;
    bf16x8 A00, A01, A10, A11, B00, B01, B10, B11; u32x4 Av[4], Bv[4];
#define FL_LOAD(B_, kk0) do { if constexpr (KS::CONTIG) { const bf16_t* kbp_; const bf16_t* vbp_; ks.base((kk0), kbp_, vbp_); const bf16_t* kr0 = kbp_ + c * 64 + 8 * q; \
            B_##00 = *(const bf16x8*)kr0; B_##01 = *(const bf16x8*)(kr0 + 32); B_##10 = *(const bf16x8*)(kr0 + 1024); B_##11 = *(const bf16x8*)(kr0 + 1056); \
            if (MODE != 1) { const bf16_t* vr0 = vbp_ + (lane >> 3) * 64 + (lane & 7) * 8; _Pragma("unroll") for (int m = 0; m < 4; ++m) B_##v[m] = *(const u32x4*)(vr0 + m * 512); } } \
        else { const bf16_t* kr0 = ks.krow((kk0) + c); const bf16_t* kr1 = ks.krow((kk0) + 16 + c); \
            B_##00 = *(const bf16x8*)(kr0 + 8 * q); B_##01 = *(const bf16x8*)(kr0 + 32 + 8 * q); B_##10 = *(const bf16x8*)(kr1 + 8 * q); B_##11 = *(const bf16x8*)(kr1 + 32 + 8 * q); \
            if (MODE != 1) { _Pragma("unroll") for (int m = 0; m < 4; ++m) B_##v[m] = *(const u32x4*)(ks.vrow((kk0) + (lane >> 3) + 8 * m) + (lane & 7) * 8); } } } while (0)
#define FL_STEP(B_, K0_) do { \
        f32x4 s0 = {0.f, 0.f, 0.f, 0.f}, s1 = {0.f, 0.f, 0.f, 0.f}; \
        s0 = MFMA16(B_##00, qb[0], s0); s0 = MFMA16(B_##01, qb[1], s0); s1 = MFMA16(B_##10, qb[0], s1); s1 = MFMA16(B_##11, qb[1], s1); \
        float sv[8], pv[8]; bool ok[8]; \
        if constexpr (KS::CONTIG) { \
            const LAS float* trow = tbl + (c & 3) * 1024; const int d0 = ks.dist0((K0_), c) - KS::DSTEP * 4 * q; \
        _Pragma("unroll") \
            for (int i = 0; i < 4; ++i) { const int da = d0 - KS::DSTEP * i, db = da - KS::DSTEP * 16; \
                ok[i] = da >= 0 && da < KS::DMAX; ok[4 + i] = db >= 0 && db < KS::DMAX; \
                sv[i] = s0[i] + trow[da < 0 ? 0 : (da < 1023 ? da : 1023)]; sv[4 + i] = s1[i] + trow[db < 0 ? 0 : (db < 1023 ? db : 1023)]; } \
        } else { \
        _Pragma("unroll") \
            for (int i = 0; i < 4; ++i) { sv[i] = ks.adjust((K0_) + 4 * q + i, c, s0[i], ok[i], buck, tbl); sv[4 + i] = ks.adjust((K0_) + 16 + 4 * q + i, c, s1[i], ok[4 + i], buck, tbl); } \
        } \
        if (MODE == 2) { \
        _Pragma("unroll") \
            for (int e = 0; e < 8; ++e) { pv[e] = ok[e] ? __builtin_amdgcn_exp2f(sv[e]) * l_run : 0.f; \
                const float x = quad_sumf(pv[e]); \
                if ((c & 3) == 0) pn[(c >> 2) * 256 + (K0_) + (e < 4 ? 4 * q + e : 16 + 4 * q + (e - 4))] = x; } \
        } else { \
            float ps = 0.f; \
        _Pragma("unroll") \
            for (int e = 0; e < 8; ++e) { pv[e] = ok[e] ? __builtin_amdgcn_exp2f(sv[e]) : 0.f; ps += pv[e]; } \
            l_run += ps; \
        } \
        if (MODE != 1) { \
        _Pragma("unroll") \
            for (int m = 0; m < 4; ++m) *(LAS u32x4*)(vt + ((lane >> 3) + 8 * m) * 144 + (lane & 7) * 16) = B_##v[m]; \
            LDS_FENCE(); \
            const bf16x8 pa = __builtin_bit_cast(bf16x8, pack8(pv)); \
        _Pragma("unroll") \
            for (int dt = 0; dt < 4; ++dt) { \
                const s16x4 lo = __builtin_amdgcn_ds_read_tr16_b64_v4i16((LAS s16x4*)(vt + (4 * q + (c >> 2)) * 144 + (16 * dt + 4 * (c & 3)) * 2)); \
                const s16x4 hi = __builtin_amdgcn_ds_read_tr16_b64_v4i16((LAS s16x4*)(vt + (16 + 4 * q + (c >> 2)) * 144 + (16 * dt + 4 * (c & 3)) * 2)); \
                const bf16x8 vb8 = __builtin_shufflevector(lo, hi, 0, 1, 2, 3, 4, 5, 6, 7); \
                o[dt] = MFMA16(pa, vb8, o[dt]); \
            } \
            LDS_FENCE(); \
        } \
    } while (0)
    if (nkeys > 0) FL_LOAD(A, 0);
    for (int k0 = 0; k0 < nkeys; k0 += 64) {
        if (k0 + 32 < nkeys) FL_LOAD(B, k0 + 32);
        FL_STEP(A, k0);
        if (k0 + 32 >= nkeys) break;
        if (k0 + 64 < nkeys) FL_LOAD(A, k0 + 64);
        FL_STEP(B, k0 + 32);
    }
#undef FL_STEP
#undef FL_LOAD
    if (MODE == 0) {
        float lt = x32_sum(x16_sum(l_run));
        const float inv = lt > 0.f ? __builtin_amdgcn_rcpf(lt) : 0.f;
        if (q == 0) al[c] = inv;
        LDS_WAIT();
        const f32x4 a4 = *(const LAS f32x4*)(al + 4 * q);
#pragma unroll
        for (int dt = 0; dt < 4; ++dt) o[dt] = o[dt] * a4;
        LDS_WAIT();
    }
}

DI void nsa_tile(const Params& p, int b, int g, int tb, const Frame& F, const LAS float* lut, int vm = 0) {
    unsigned char* ws = p.ws; const int lane = F.lane, wave = F.wave, c = lane & 15, q = lane >> 4;
    const LAS float* tbl = lut + g * 4096;
    LAS unsigned char* wl = F.lds + wave * 9216; LAS unsigned char* vt = wl; LAS float* al = (LAS float*)(wl + 4608); LAS float* pn = (LAS float*)(wl + 4736);
    LAS float* OS = (LAS float*)F.lds; LAS float* LS = (LAS float*)(F.lds + 65536);
    LAS int* SELB = (LAS int*)(F.lds + 73728); LAS int* CNT = (LAS int*)(F.lds + 75776); LAS unsigned short* UNIT = (LAS unsigned short*)(F.lds + 76032); LAS int* NUNIT = (LAS int*)(F.lds + 76416);
    volatile LAS int* TURN = (volatile LAS int*)(F.lds + 76544); LAS unsigned short* LIST = (LAS unsigned short*)(F.lds + 76800);
    LAS unsigned char* vt2 = F.lds + 84992 + wave * 4608;
    const bf16_t* prow0 = (const bf16_t*)(ws + WS_PROJ) + (size_t)(b * SEQ) * PW;
    bf16_t* YB = (bf16_t*)(ws + WS_Y) + (size_t)T * 512;
    const f32x4 z4 = {0.f, 0.f, 0.f, 0.f};
    for (int ii = 0; ii < 2; ++ii) {
        f32x4 accw[4];
        const int item = wave * 2 + ii, t0 = 64 * tb + 4 * item;
#pragma unroll
        for (int k = 0; k < 4; ++k) *(LAS f32x4*)(pn + lane * 4 + 256 * k) = z4;
        bf16x8 qb[2];
        { const bf16_t* qp = prow0 + (size_t)(t0 + (c >> 2)) * PW + C_NQ + (g * 4 + (c & 3)) * 64 + 8 * q; qb[0] = *(const bf16x8*)qp; qb[1] = *(const bf16x8*)(qp + 32); }
        float g0[4], g2[4];
        { const u32x2 ga = *(const u32x2*)(prow0 + (size_t)(t0 + q) * PW + C_NG + 0 * 8 + g * 4), gc = *(const u32x2*)(prow0 + (size_t)(t0 + q) * PW + C_NG + 2 * 8 + g * 4);
          g0[0] = sigm(lo16(ga.x)); g0[1] = sigm(hi16(ga.x)); g0[2] = sigm(lo16(ga.y)); g0[3] = sigm(hi16(ga.y));
          g2[0] = sigm(lo16(gc.x)); g2[1] = sigm(hi16(gc.x)); g2[2] = sigm(lo16(gc.y)); g2[3] = sigm(hi16(gc.y)); }
#pragma unroll
        for (int dt = 0; dt < 4; ++dt) accw[dt] = z4;
        LDS_WAIT();
        const int tl = t0 + 3, nv = tl >= 31 ? ((tl - 31) >> 4) + 1 : 0;
        if (nv > 0 && (vm == 0 || (vm & 1))) {
            const int nk = (nv + 31) & ~31;
            KsCmp ks{(const bf16_t*)(ws + WS_CMPK) + (size_t)(b * 2 + g) * 256 * 64, (const bf16_t*)(ws + WS_CMPV) + (size_t)(b * 2 + g) * 256 * 64, t0, g * 4};
            float m = 0.f, lr = 0.f; f32x4 o[4] = {z4, z4, z4, z4};
            flash_run<1>(ks, nk, qb, o, m, lr, vt, al, pn, (const LAS unsigned char*)vt, tbl, lane);
            lr = x32_sum(x16_sum(lr)); lr = lr > 0.f ? __builtin_amdgcn_rcpf(lr) : 0.f;
            flash_run<2>(ks, nk, qb, o, m, lr, vt, al, pn, (const LAS unsigned char*)vt, tbl, lane);
#pragma unroll
            for (int dt = 0; dt < 4; ++dt) { accw[dt][0] = g0[0] * o[dt][0]; accw[dt][1] = g0[1] * o[dt][1]; accw[dt][2] = g0[2] * o[dt][2]; accw[dt][3] = g0[3] * o[dt][3]; }
        }
        LDS_WAIT();
        {
            const int j = lane; float val[4];
#pragma unroll
            for (int qi = 0; qi < 4; ++qi) {
                if (j == 0 || j == tb) val[qi] = 1e4f;
                else if (j < tb) { const LAS float* pq = pn + qi * 256 + 4 * j; val[qi] = pq[-1] + pq[0] + pq[1] + pq[2] + pq[3]; }
                else val[qi] = -1e30f;
            }
            for (int k = 0; k < 8; ++k) {
#pragma unroll
                for (int qi = 0; qi < 4; ++qi) {
                    const float mx = wave_max(val[qi]); const unsigned long long who = __ballot(val[qi] == mx); const int w = __builtin_ctzll(who);
                    if (lane == 0) SELB[(item * 4 + qi) * 8 + k] = mx > -1e29f ? w : -1;
                    if (lane == w) val[qi] = -3e38f;
                }
            }
        }
        {
            const int pstart = t0 >= 511 ? t0 - 511 : 0, nk = (t0 + 3 - pstart + 1 + 31) & ~31;
            KsWin ks{(const bf16_t*)(ws + WS_KW) + (size_t)(b * 2 + g) * SEQ * 64, (const bf16_t*)(ws + WS_VW) + (size_t)(b * 2 + g) * SEQ * 64, pstart, t0, g * 4};
            float m = 0.f, lr = 0.f; f32x4 o[4] = {z4, z4, z4, z4};
            if (vm == 0 || (vm & 2)) flash_run<0>(ks, nk, qb, o, m, lr, vt, al, pn, (const LAS unsigned char*)vt, tbl, lane);
            if (vm & 4) { flash_run<1>(ks, nk, qb, o, m, lr, vt, al, pn, (const LAS unsigned char*)vt, tbl, lane); o[0][0] += lr; }
#pragma unroll
            for (int dt = 0; dt < 4; ++dt) { accw[dt][0] += g2[0] * o[dt][0]; accw[dt][1] += g2[1] * o[dt][1]; accw[dt][2] += g2[2] * o[dt][2]; accw[dt][3] += g2[3] * o[dt][3]; }
        }
        if (vm == 0) {
            bf16_t* dst = YB + (size_t)(b * SEQ + t0 + q) * 512 + (g * 4) * 64 + c;
#pragma unroll
            for (int dt = 0; dt < 4; ++dt)
#pragma unroll
                for (int i = 0; i < 4; ++i) dst[i * 64 + 16 * dt] = (bf16_t)f2bf(accw[dt][i]);
        }
        else { asm volatile("" :: "v"(accw[0]), "v"(accw[1]), "v"(accw[2]), "v"(accw[3])); }
        LDS_WAIT();
    }
    __syncthreads();
    if (vm != 0) return;
    for (int i = F.tid; i < 66560 / 16; i += 512) *(LAS f32x4*)(F.lds + i * 16) = z4;
    if (F.tid < 64) { CNT[F.tid] = 0; TURN[F.tid] = 0; }
    __syncthreads();
    { const int blk = SELB[F.tid];
      if (blk >= 0) { int rank = 0;
#pragma unroll
          for (int k = 0; k < 8; ++k) { const int ob = SELB[(F.tid & ~7) + k]; rank += (ob >= 0 && ob < blk) ? 1 : 0; }
          const int pos = __hip_atomic_fetch_add(CNT + blk, 1, __ATOMIC_RELAXED, __HIP_MEMORY_SCOPE_WORKGROUP); LIST[blk * 64 + pos] = (unsigned short)((F.tid >> 3) | (rank << 8)); } }
    __syncthreads();
    if (wave == 0) {
        const int uj = (CNT[lane] + 3) >> 2; int inc = uj;
#pragma unroll
        for (int o_ = 1; o_ < 64; o_ <<= 1) { const int v = __shfl_up(inc, o_); if (lane >= o_) inc += v; }
        const int offs = inc - uj;
        for (int u = 0; u < uj; ++u) UNIT[offs + u] = (unsigned short)(lane | (u << 8));
        if (lane == 63) NUNIT[0] = inc;
    }
    __syncthreads();
    {
        const int nu = NUNIT[0];
        const LAS float* trow = tbl + (c & 3) * 1024;
        const bf16_t* KSb = (const bf16_t*)(ws + WS_KS) + (size_t)(b * 2 + g) * SEQ * 64; const bf16_t* VSb = (const bf16_t*)(ws + WS_VS) + (size_t)(b * 2 + g) * SEQ * 64;
        for (int ui = wave; ui < nu; ui += 8) {
            const int uu = UNIT[ui], j = uu & 255, u = uu >> 8, nj = CNT[j];
            const int slot = 4 * u + (c >> 2); const int qrow = slot < nj ? (int)(LIST[j * 64 + slot] & 255) : -1;
            const int slotq = 4 * u + q; const int qo = slotq < nj ? (int)(LIST[j * 64 + slotq] & 255) : -1;
            bf16x8 qs[2] = {(bf16x8){0, 0, 0, 0, 0, 0, 0, 0}, (bf16x8){0, 0, 0, 0, 0, 0, 0, 0}};
            if (qrow >= 0) { const bf16_t* qp = prow0 + (size_t)(64 * tb + qrow) * PW + C_NQ + (g * 4 + (c & 3)) * 64 + 8 * q; qs[0] = *(const bf16x8*)qp; qs[1] = *(const bf16x8*)(qp + 32); }
            const bf16_t* kb0 = KSb + (size_t)(64 * j) * 64; const bf16_t* vb0 = VSb + (size_t)(64 * j) * 64;
            bf16x8 ka[4]; u32x4 vv[4];
#define SEL_LOADK(st) do { const bf16_t* kr0 = kb0 + (32 * (st) + c) * 64 + 8 * q; ka[0] = *(const bf16x8*)kr0; ka[1] = *(const bf16x8*)(kr0 + 32); ka[2] = *(const bf16x8*)(kr0 + 1024); ka[3] = *(const bf16x8*)(kr0 + 1056); } while (0)
#define SEL_LOADV(st) do { const bf16_t* vr0 = vb0 + (32 * (st) + (lane >> 3)) * 64 + (lane & 7) * 8; _Pragma("unroll") for (int m = 0; m < 4; ++m) vv[m] = *(const u32x4*)(vr0 + m * 512); } while (0)
            SEL_LOADK(0); SEL_LOADV(0);
            f32x4 o[4] = {z4, z4, z4, z4}; float lsum = 0.f;
#pragma unroll
            for (int st = 0; st < 2; ++st) {
                f32x4 s0 = z4, s1 = z4;
                s0 = MFMA16(ka[0], qs[0], s0); s0 = MFMA16(ka[1], qs[1], s0); s1 = MFMA16(ka[2], qs[0], s1); s1 = MFMA16(ka[3], qs[1], s1);
                if (st == 0) SEL_LOADK(1);
                const int d0 = 64 * (tb - j) + (qrow < 0 ? 0 : qrow) - 32 * st - 4 * q; float pv[8];
#pragma unroll
                for (int i = 0; i < 4; ++i) { const int da = d0 - i, db = da - 16;
                    const float ea = __builtin_amdgcn_exp2f(s0[i] + trow[da < 0 ? 0 : (da < 1023 ? da : 1023)]), eb = __builtin_amdgcn_exp2f(s1[i] + trow[db < 0 ? 0 : (db < 1023 ? db : 1023)]);
                    pv[i] = (qrow >= 0 && da >= 0) ? ea : 0.f; pv[4 + i] = (qrow >= 0 && db >= 0) ? eb : 0.f; lsum += pv[i] + pv[4 + i]; }
#pragma unroll
                for (int m = 0; m < 4; ++m) *(LAS u32x4*)(vt2 + ((lane >> 3) + 8 * m) * 144 + (lane & 7) * 16) = vv[m];
                if (st == 0) SEL_LOADV(1);
                LDS_FENCE();
                const bf16x8 pa = __builtin_bit_cast(bf16x8, pack8(pv));
#pragma unroll
                for (int dt = 0; dt < 4; ++dt) {
                    const s16x4 lo = __builtin_amdgcn_ds_read_tr16_b64_v4i16((LAS s16x4*)(vt2 + (4 * q + (c >> 2)) * 144 + (16 * dt + 4 * (c & 3)) * 2));
                    const s16x4 hi = __builtin_amdgcn_ds_read_tr16_b64_v4i16((LAS s16x4*)(vt2 + (16 + 4 * q + (c >> 2)) * 144 + (16 * dt + 4 * (c & 3)) * 2));
                    o[dt] = MFMA16(pa, __builtin_shufflevector(lo, hi, 0, 1, 2, 3, 4, 5, 6, 7), o[dt]);
                }
                LDS_FENCE();
            }
#undef SEL_LOADK
#undef SEL_LOADV
            lsum = x32_sum(x16_sum(lsum));
#pragma unroll 1
            for (int s = 0; s < 4; ++s) {
                if (4 * u + s >= nj) break;
                const int ent = LIST[j * 64 + 4 * u + s], qs_ = ent & 255, rk = ent >> 8;
                unsigned spins = 0;
                while (TURN[qs_] != rk) { __builtin_amdgcn_s_sleep(1); if (++spins > (1u << 22)) break; }
                if (q == s) {
#pragma unroll
                    for (int dt = 0; dt < 4; ++dt)
#pragma unroll
                        for (int i = 0; i < 4; ++i) OS[(qs_ * 4 + i) * 64 + 16 * dt + c] += o[dt][i];
                }
                if ((c >> 2) == s && q == 0) LS[qs_ * 4 + (c & 3)] += lsum;
                LDS_WAIT();
                if (lane == 0) TURN[qs_] = rk + 1;
                LDS_WAIT();
            }
        }
    }
    __syncthreads();
    for (int ii = 0; ii < 2; ++ii) {
        const int item = wave * 2 + ii, qq = item * 4 + q, t = 64 * tb + qq;
        const u32x2 gg = *(const u32x2*)(prow0 + (size_t)t * PW + C_NG + 8 + g * 4);
        const float g1[4] = {sigm(lo16(gg.x)), sigm(hi16(gg.x)), sigm(lo16(gg.y)), sigm(hi16(gg.y))};
        const f32x4 l4 = *(const LAS f32x4*)(LS + qq * 4);
        const float inv[4] = {l4.x > 0.f ? g1[0] / l4.x : 0.f, l4.y > 0.f ? g1[1] / l4.y : 0.f, l4.z > 0.f ? g1[2] / l4.z : 0.f, l4.w > 0.f ? g1[3] / l4.w : 0.f};
        bf16_t* dst = YB + (size_t)(b * SEQ + t) * 512 + (g * 4) * 64 + c;
#pragma unroll
        for (int dt = 0; dt < 4; ++dt)
#pragma unroll
            for (int i = 0; i < 4; ++i) dst[i * 64 + 16 * dt] = (bf16_t)f2bf(bf2f(dst[i * 64 + 16 * dt]) + inv[i] * OS[(qq * 4 + i) * 64 + 16 * dt + c]);
    }
    __syncthreads();
}

DI void dsa_group(const Params& p, int b, int t0, const Frame& F, const LAS unsigned char* buck, const LAS float* tbl, int parts = 7) {
    unsigned char* ws = p.ws; const int lane = F.lane, wave = F.wave, c = lane & 15, q = lane >> 4;
    LAS unsigned* SC = (LAS unsigned*)F.lds;
    LAS int* list = (LAS int*)(F.lds + 131072 + wave * 1024); LAS float* al = (LAS float*)(F.lds + 139264 + wave * 64);
    const bf16_t* prow0 = (const bf16_t*)(ws + WS_PROJ) + (size_t)(b * SEQ) * PW;
    bf16_t* YD = (bf16_t*)(ws + WS_Y) + (size_t)3 * T * 512;
    const bf16x8 zf = {0, 0, 0, 0, 0, 0, 0, 0};
    const int t = t0 + wave; const bf16_t* qrow = prow0 + (size_t)t * PW;
    const bf16_t* dki = (const bf16_t*)(ws + WS_DKI) + (size_t)(b * SEQ) * 64;
    const bool full = t0 >= 256;
    if (full && (parts & 1)) {
        bf16x8 qa[4][2]; float wv[4][4];
#pragma unroll
        for (int rt = 0; rt < 4; ++rt) { const bf16_t* qp = prow0 + (size_t)(t0 + 2 * rt + (c >> 3)) * PW + C_DQI + (c & 7) * 64 + 8 * q; qa[rt][0] = *(const bf16x8*)qp; qa[rt][1] = *(const bf16x8*)(qp + 32);
            const u32x2 w4 = *(const u32x2*)(prow0 + (size_t)(t0 + 2 * rt + (q >> 1)) * PW + C_DWI + (q & 1) * 4);
            wv[rt][0] = lo16(w4.x) * 0.35355339f; wv[rt][1] = hi16(w4.x) * 0.35355339f; wv[rt][2] = lo16(w4.y) * 0.35355339f; wv[rt][3] = hi16(w4.y) * 0.35355339f; }
        const int ntile = ((t0 + 7) >> 4) + 1, nk64 = ((t0 + 7) >> 6) + 1;
        bf16x8 kx0, kx1;
        if (wave < ntile) { const bf16_t* kp = dki + (size_t)(16 * wave + c) * 64 + 8 * q; kx0 = *(const bf16x8*)kp; kx1 = *(const bf16x8*)(kp + 32); }
        for (int tau = wave; tau < ntile; tau += 8) {
            const bf16x8 kb0 = kx0, kb1 = kx1;
            if (tau + 8 < ntile) { const bf16_t* kp = dki + (size_t)(16 * (tau + 8) + c) * 64 + 8 * q; kx0 = *(const bf16x8*)kp; kx1 = *(const bf16x8*)(kp + 32); }
            const int key = 16 * tau + c;
#pragma unroll
            for (int rt = 0; rt < 4; ++rt) {
                f32x4 acc = {0.f, 0.f, 0.f, 0.f};
                acc = MFMA16(qa[rt][0], kb0, acc); acc = MFMA16(qa[rt][1], kb1, acc);
                float s = wv[rt][0] * fmaxf(acc[0], 0.f) + wv[rt][1] * fmaxf(acc[1], 0.f) + wv[rt][2] * fmaxf(acc[2], 0.f) + wv[rt][3] * fmaxf(acc[3], 0.f);
                s = x16_sum(s);
                const int qq = 2 * rt + (q >> 1);
                if ((q & 1) == 0) SC[qq * 4096 + key] = key <= t0 + qq ? ordf(s) : 0u;
            }
        }
        for (int i = F.tid; i < 8 * 64; i += 512) { const int key = ntile * 16 + (i & 63); if (key < nk64 * 64) SC[(i >> 6) * 4096 + key] = 0u; }
    }
    __syncthreads();
    int n;
    if (!full) { n = t + 1; for (int i = lane; i < 256; i += 64) list[i] = i <= t ? i : -1; }
    else if (parts & 2) {
        n = 256;
        const LAS unsigned* sc = SC + wave * 4096; const int nk64 = (t >> 6) + 1;
        unsigned u[64];
#pragma unroll
        for (int k = 0; k < 64; ++k) u[k] = k < nk64 ? sc[k * 64 + lane] : 0u;
#define WAVE_TOTAL(cl, tot) do { tot = 0; _Pragma("unroll") for (int b_ = 0; b_ < 7; ++b_) tot += __popcll(__ballot(((cl) >> b_) & 1u)) << b_; } while (0)
        unsigned prefix = 0u;
        const int nk8 = __builtin_amdgcn_readfirstlane((nk64 + 7) >> 3);
#define CNT_GE(NK) _Pragma("unroll") for (int k = 0; k < NK; ++k) cl += (u[k] >= cand) ? 1u : 0u;
        for (int bit = 31; bit >= 0; --bit) {
            const unsigned cand = prefix | (1u << bit); unsigned cl = 0u; int cnt;
            switch (nk8) { case 1: CNT_GE(8) break; case 2: CNT_GE(16) break; case 3: CNT_GE(24) break; case 4: CNT_GE(32) break;
                           case 5: CNT_GE(40) break; case 6: CNT_GE(48) break; case 7: CNT_GE(56) break; default: CNT_GE(64) break; }
            WAVE_TOTAL(cl, cnt);
            if (cnt >= 256) { prefix = cand; if (cnt == 256) break; }
        }
        int cgt; { unsigned cl = 0u;
#pragma unroll
            for (int k = 0; k < 64; ++k) cl += (u[k] > prefix) ? 1u : 0u;
            WAVE_TOTAL(cl, cgt); }
#undef WAVE_TOTAL
#undef CNT_GE
        const int need_eq = 256 - cgt; int base = 0, eqbase = 0;
#pragma unroll
        for (int k = 0; k < 64; ++k) {
            if (k < nk64) {
                const bool gtp = u[k] > prefix, eq = u[k] == prefix;
                const unsigned long long meq = __ballot(eq);
                const int eqrank = eqbase + (int)__builtin_amdgcn_mbcnt_hi((unsigned)(meq >> 32), __builtin_amdgcn_mbcnt_lo((unsigned)meq, 0u));
                const bool take = gtp || (eq && eqrank < need_eq);
                const unsigned long long mt = __ballot(take);
                const int slot = base + (int)__builtin_amdgcn_mbcnt_hi((unsigned)(mt >> 32), __builtin_amdgcn_mbcnt_lo((unsigned)mt, 0u));
                if (take && slot < 256) list[slot] = k * 64 + lane;
                base += __popcll(mt); eqbase += __popcll(meq);
            }
        }
    }
    else n = 256;
    LDS_WAIT();
    if (!(parts & 4)) { __syncthreads(); return; }
    LAS unsigned char* vt = F.lds + wave * 16384;
    bf16x8 qd[2] = {zf, zf};
    if (c < 8) { qd[0] = *(const bf16x8*)(qrow + C_DQ + c * 64 + 8 * q); qd[1] = *(const bf16x8*)(qrow + C_DQ + c * 64 + 32 + 8 * q); }
    KsDsa ks{(const bf16_t*)(ws + WS_DK) + (size_t)(b * SEQ) * 64, (const bf16_t*)(ws + WS_DV) + (size_t)(b * SEQ) * 64, list, n, t};
    const f32x4 z4 = {0.f, 0.f, 0.f, 0.f};
    float m = -1e30f, lr = 0.f; f32x4 o[4] = {z4, z4, z4, z4};
    flash_run<0>(ks, (n + 31) & ~31, qd, o, m, lr, vt, al, (LAS float*)vt, buck, tbl, lane);
    if (q < 2) {
#pragma unroll
        for (int dt = 0; dt < 4; ++dt)
#pragma unroll
            for (int i = 0; i < 4; ++i) YD[(size_t)(b * SEQ + t) * 512 + (4 * q + i) * 64 + 16 * dt + c] = (bf16_t)f2bf(o[dt][i]);
    }
    __syncthreads();
}

DI void phase_attn(const Params& p, int l, const Frame& F, int mask = 3, int parts = 15) {
    const int gw = F.vb * 8 + F.wave, NGW = F.G * 8; const float* rel = p.in[I_REL];
#ifndef MK_ATTN
#define MK_ATTN 3
#endif
    if ((MK_ATTN & 1) && (mask & 1)) {
        LAS float* lut = (LAS float*)(F.lds + 130048);
        for (int i = F.tid; i < 8 * 1024; i += 512) { const int h = i >> 10, d = i & 1023; lut[i] = rel[bucket_of(d) * 16 + h] * 1.44269504f; }
        __syncthreads();
        for (int it = F.vb; it < 8 * 2 * 64; it += F.G) { const int b = it >> 7, g = (it >> 6) & 1; int tb = it & 63; if (b & 1) tb = 63 - tb; nsa_tile(p, b, g, tb, F, lut, (parts >> 8) & 15); }
    }
    __syncthreads();
    LAS unsigned char* buck = F.lds + 139776; LAS float* tbl = (LAS float*)(F.lds + 140800);
    for (int i = F.tid; i < 1024; i += 512) buck[i] = (unsigned char)bucket_of(i);
    tbl[F.tid] = rel[F.tid] * 1.44269504f;
    __syncthreads();
    if ((MK_ATTN & 2) && (mask & 2)) for (int it = F.vb; it < 8 * 512; it += F.G) { const int b = it >> 9; int tg = it & 511; if (b & 1) tg = 511 - tg; dsa_group(p, b, tg * 8, F, buck, tbl, parts); }
}


#ifndef MK_PROBE
#define MK_PROBE 0
#endif

DI unsigned row16_maxu(unsigned m) { unsigned o;
    o = (unsigned)DPP_I((int)m, 0xB1); m = m > o ? m : o; o = (unsigned)DPP_I((int)m, 0x4E); m = m > o ? m : o;
    o = (unsigned)DPP_I((int)m, 0x141); m = m > o ? m : o; o = (unsigned)DPP_I((int)m, 0x140); m = m > o ? m : o; return m; }
DI void peer_route_tile(const Params& p, int t0, int lane) {
    unsigned char* ws = p.ws; const int c = lane & 15, q = lane >> 4;
    const bf16_t* QP = (const bf16_t*)(ws + WS_QP); const bf16_t* SK = (const bf16_t*)(ws + WS_SK); int* EIDX = (int*)(ws + WS_EIDX); float* EW = (float*)(ws + WS_EW);
    float* EU = (float*)(ws + WS_EU); const float* USr = (const float*)(ws + WS_PTV); const float* VSr = USr + 16384;
    int ca[4], cb[4]; bool cv[4];
    ca[0] = 0; cb[0] = c; cv[0] = true;
    ca[1] = c < 8 ? 1 : (c < 13 ? 2 : 3); cb[1] = c < 8 ? c : (c < 13 ? c - 8 : c - 13); cv[1] = true;
    { const int ci = 32 + c; int a_, b_;
      if (ci == 32) { a_ = 3; b_ = 3; } else if (ci < 36) { a_ = 4; b_ = ci - 33; } else if (ci < 42) { a_ = 5 + ((ci - 36) >> 1); b_ = (ci - 36) & 1; } else { a_ = 8 + (ci - 42); b_ = 0; }
      ca[2] = a_; cb[2] = b_; cv[2] = true; }
    ca[3] = c < 2 ? 14 + c : 0; cb[3] = 0; cv[3] = c < 2;
    for (int h = 0; h < 8; ++h) {
        unsigned top[2][4];
#pragma unroll
        for (int pp = 0; pp < 2; ++pp) {
            const int hp = h * 2 + pp;
            const bf16_t* ap = QP + (size_t)(t0 + c) * 1024 + hp * 64 + 8 * q;
            const bf16x8 a0 = *(const bf16x8*)ap, a1 = *(const bf16x8*)(ap + 32);
            unsigned v[4][8];
#pragma unroll
            for (int kt = 0; kt < 8; ++kt) { const bf16_t* bp = SK + ((size_t)hp * 128 + 16 * kt + c) * 64 + 8 * q;
                const bf16x8 b0 = *(const bf16x8*)bp, b1 = *(const bf16x8*)(bp + 32);
                f32x4 acc = {0.f, 0.f, 0.f, 0.f}; acc = MFMA16(a0, b0, acc); acc = MFMA16(a1, b1, acc);
#pragma unroll
                for (int i = 0; i < 4; ++i) v[i][kt] = (ordf(acc[i]) & 0xFFFFFF80u) | (unsigned)(127 - (16 * kt + c)); }
            { unsigned mine[4] = {0u, 0u, 0u, 0u};
#define CE_(a, b) { const unsigned hi_ = v[i][a] > v[i][b] ? v[i][a] : v[i][b], lo_ = v[i][a] > v[i][b] ? v[i][b] : v[i][a]; v[i][a] = hi_; v[i][b] = lo_; }
#pragma unroll
              for (int i = 0; i < 4; ++i) { CE_(0, 1) CE_(2, 3) CE_(4, 5) CE_(6, 7) CE_(0, 2) CE_(1, 3) CE_(4, 6) CE_(5, 7) CE_(1, 2) CE_(5, 6) CE_(0, 4) CE_(3, 7) CE_(1, 5) CE_(2, 6) CE_(1, 4) CE_(3, 6) CE_(2, 4) CE_(3, 5) CE_(3, 4) }
#undef CE_
              for (int r = 0; r < 16; ++r) {
#pragma unroll
                  for (int i = 0; i < 4; ++i) { const unsigned m = row16_maxu(v[i][0]); mine[i] = (c == r) ? m : mine[i];
                      const bool win = v[i][0] == m;
#pragma unroll
                      for (int kt = 0; kt < 7; ++kt) v[i][kt] = win ? v[i][kt + 1] : v[i][kt];
                      v[i][7] = win ? 0u : v[i][7]; } }
#pragma unroll
              for (int i = 0; i < 4; ++i) top[pp][i] = mine[i]; }
        }
        unsigned cd[4][4], mine2[4] = {0u, 0u, 0u, 0u}; int i0v[4], i1v[4];
#pragma unroll
        for (int i = 0; i < 4; ++i) {
            const float s0 = unordf(top[0][i] & 0xFFFFFF80u), s1 = unordf(top[1][i] & 0xFFFFFF80u);
            i0v[i] = 127 - (int)(top[0][i] & 127u); i1v[i] = 127 - (int)(top[1][i] & 127u);
#pragma unroll
            for (int k = 0; k < 4; ++k) { const float s0a = __shfl(s0, (lane & 48) | ca[k]), s1b = __shfl(s1, (lane & 48) | cb[k]);
                cd[i][k] = cv[k] ? ((ordf(s0a + s1b) & 0xFFFFFF00u) | (unsigned)(255 - (ca[k] * 16 + cb[k]))) : 0u; }
        }
#define CE_(a, b) { const unsigned hi_ = cd[i][a] > cd[i][b] ? cd[i][a] : cd[i][b], lo_ = cd[i][a] > cd[i][b] ? cd[i][b] : cd[i][a]; cd[i][a] = hi_; cd[i][b] = lo_; }
#pragma unroll
        for (int i = 0; i < 4; ++i) { CE_(0, 1) CE_(2, 3) CE_(0, 2) CE_(1, 3) CE_(1, 2) }
#undef CE_
        for (int r = 0; r < 16; ++r) {
#pragma unroll
            for (int i = 0; i < 4; ++i) { const unsigned m = row16_maxu(cd[i][0]); mine2[i] = (c == r) ? m : mine2[i];
                const bool win = cd[i][0] == m;
#pragma unroll
                for (int k = 0; k < 3; ++k) cd[i][k] = win ? cd[i][k + 1] : cd[i][k];
                cd[i][3] = win ? 0u : cd[i][3]; }
        }
#pragma unroll
        for (int i = 0; i < 4; ++i) {
            const unsigned mine = mine2[i];
            const int pr = 255 - (int)(mine & 255u); const int ea = __shfl(i0v[i], (lane & 48) | (pr >> 4)), eb = __shfl(i1v[i], (lane & 48) | (pr & 15));
            const float scv = unordf(mine & 0xFFFFFF00u);
            const float mx = row16_maxf(scv);
            const float e = __expf(scv - mx); const float sm = row16_sumf(e);
            const size_t o = (size_t)(t0 + 4 * q + i) * 128 + h * 16 + c;
            const int eid = ea * 128 + eb; EIDX[o] = eid; EW[o] = (e / sm) * VSr[eid]; EU[o] = USr[eid];
        }
    }
}
#define MFMA8(a, b, c) __builtin_amdgcn_mfma_f32_16x16x32_fp8_fp8((a), (b), (c), 0, 0, 0)
DI long lo64(const u32x4 v) { return (long)(((unsigned long long)v.y << 32) | v.x); }
DI long hi64(const u32x4 v) { return (long)(((unsigned long long)v.w << 32) | v.z); }
template <int OFF> DI void peer_dma_o(const unsigned char* src, LAS unsigned char* dst) { __builtin_amdgcn_global_load_lds((const unsigned*)src, (LAS unsigned*)(dst - OFF), 16, OFF, 0); }
#define PEER_RD(slot_) (*(const LAS u32x4*)(ring + 1024 * (slot_) + 16 * lane))
#define PEER_VMW(n_) asm volatile("s_waitcnt vmcnt(" #n_ ")" ::: "memory")
struct PeerStream { int u0, ustep, n, xfix; bool al; };
DI PeerStream peer_stream(const Frame& F) { PeerStream s; const int bx = blockIdx.x; s.al = (F.G & 7) == 0; s.u0 = s.al ? (bx >> 3) * 8 + F.wave : bx * 8 + F.wave; s.ustep = s.al ? F.G : F.G * 8;
    const int nu = s.al ? T : T * 8; s.n = (nu - s.u0 + s.ustep - 1) / s.ustep; s.xfix = bx & 7; return s; }
DI void peer_unit(const PeerStream& s, int k, int& t, int& x) { const int u = s.u0 + (k < s.n ? k : s.n - 1) * s.ustep; t = s.al ? u : u >> 3; x = s.al ? s.xfix : u & 7; }

DI void phase_peer_u(const Params& p, const Frame& F) {
    unsigned char* ws = p.ws; const int lane = F.lane, c = lane & 15, q = lane >> 4, c8 = lane & 7, r8 = lane >> 3;
    LAS unsigned char* wl = F.lds + F.wave * LDS_PERWAVE; LAS float* pdl = (LAS float*)wl; LAS unsigned char* ring = wl + 512; LAS unsigned char* meta = wl + 512 + 16384;
    const PeerStream S = peer_stream(F);
    const unsigned char* EIDX = ws + WS_EIDX; const unsigned char* H8 = ws + WS_H8; float* PD = (float*)(ws + WS_PD); const unsigned char* PTU = ws + WS_PTU;
    const int p0 = ((c >> 1) + q) & 7, p1 = (p0 + 4) & 7;
    const int rdo = 1024 * (c >> 3) + 128 * (c & 7);
    int t, x;
#define PU_META(k_, slot_) do { peer_unit(S, (k_), t, x); const unsigned char* s_ = lane < 32 ? EIDX + (size_t)t * 512 + 16 * lane : H8 + (size_t)t * 1024 + 128 * x + 16 * (lane & 7); peer_dma_o<0>(s_, meta + 1024 * (slot_)); } while (0)
#define PU_RD(g_, pc_) (*(const LAS u32x4*)(ring + 2048 * (g_) + rdo + 16 * (pc_)))
    PU_META(0, 0); PU_META(1, 1);
    asm volatile("s_waitcnt vmcnt(0)" ::: "memory");
    u32x4 in_[4], hc0, hc1, hn0, hn1;
    { u32x4 i0_[4];
#pragma unroll
      for (int v_ = 0; v_ < 4; ++v_) i0_[v_] = *(const LAS u32x4*)(meta + 64 * r8 + 16 * v_);
      hn0 = *(const LAS u32x4*)(meta + 512 + 16 * p0); hn1 = *(const LAS u32x4*)(meta + 512 + 16 * p1);
      peer_unit(S, 0, t, x); const unsigned char* tb = PTU + (size_t)x * PT_SLICE + 16 * c8;
#define PU_D0(j) peer_dma_o<0>(tb + (size_t)i0_[(j) >> 2][(j) & 3] * 128, ring + 1024 * (j))
      PU_D0(0); PU_D0(1); PU_D0(2); PU_D0(3); PU_D0(4); PU_D0(5); PU_D0(6); PU_D0(7); PU_D0(8); PU_D0(9); PU_D0(10); PU_D0(11); PU_D0(12); PU_D0(13); PU_D0(14); PU_D0(15);
#undef PU_D0
    }
    PEER_VMW(12);
    u32x4 ra[2], rb[2];
#pragma unroll
    for (int i = 0; i < 2; ++i) { ra[i] = PU_RD(i, p0); rb[i] = PU_RD(i, p1); }
    const f32x4 z4 = {0.f, 0.f, 0.f, 0.f};
    for (int k = 0; k < S.n; ++k) {
        int tc, xc; peer_unit(S, k, tc, xc);
        hc0 = hn0; hc1 = hn1;
        { LAS unsigned char* m1 = meta + 1024 * ((k + 1) & 1);
#pragma unroll
          for (int v_ = 0; v_ < 4; ++v_) in_[v_] = *(const LAS u32x4*)(m1 + 64 * r8 + 16 * v_);
          hn0 = *(const LAS u32x4*)(m1 + 512 + 16 * p0); hn1 = *(const LAS u32x4*)(m1 + 512 + 16 * p1); }
        LDS_WAIT(); PU_META(k + 2, k & 1);
        peer_unit(S, k + 1, t, x);
        const unsigned char* tbn = PTU + (size_t)x * PT_SLICE + 16 * c8;
#define PU_GRP(g) do { if ((g) < 6) PEER_VMW(11); else PEER_VMW(10); const u32x4 na = PU_RD(((g) + 2) & 7, p0), nb = PU_RD(((g) + 2) & 7, p1); \
            f32x4 acc = MFMA8(lo64(ra[(g) & 1]), lo64(hc0), z4); acc = MFMA8(hi64(ra[(g) & 1]), hi64(hc0), acc); acc = MFMA8(lo64(rb[(g) & 1]), lo64(hc1), acc); acc = MFMA8(hi64(rb[(g) & 1]), hi64(hc1), acc); \
            asm volatile("" :: "v"(ra[(g) & 1]), "v"(rb[(g) & 1])); \
            peer_dma_o<0>(tbn + (size_t)in_[(2 * (g)) >> 2][(2 * (g)) & 3] * 128, ring + 2048 * (g)); peer_dma_o<0>(tbn + (size_t)in_[(2 * (g) + 1) >> 2][(2 * (g) + 1) & 3] * 128, ring + 2048 * (g) + 1024); \
            ra[(g) & 1] = na; rb[(g) & 1] = nb; \
            { const float d01 = (c & 1) ? acc[1] : acc[0], d23 = (c & 1) ? acc[3] : acc[2], dg = (c & 2) ? d23 : d01; if (q == (c >> 2)) pdl[16 * (c & 7) + 2 * (g) + (c >> 3)] = dg; } } while (0)
        PU_GRP(0); PU_GRP(1); PU_GRP(2); PU_GRP(3); PU_GRP(4); PU_GRP(5); PU_GRP(6); PU_GRP(7);
#undef PU_GRP
        { const u32x2 pv = *(const LAS u32x2*)(pdl + 2 * lane); *(u32x2*)(PD + ((size_t)xc * T + tc) * 128 + 2 * lane) = pv; }
    }
#undef PU_META
#undef PU_RD
    asm volatile("s_waitcnt vmcnt(0) lgkmcnt(0)" ::: "memory");
}

DI void phase_peer_coef(const Params& p, const Frame& F) {
    unsigned char* ws = p.ws; const float* PD = (const float*)(ws + WS_PD); const float* EW = (const float*)(ws + WS_EW); const float* EU = (const float*)(ws + WS_EU);
    const float* HSI = (const float*)(ws + WS_HSI); float* COEF = (float*)(ws + WS_COEF);
    const size_t NT = (size_t)F.G * 512;
    for (size_t i0 = (size_t)F.vb * 512 + F.tid; i0 < (size_t)T * 128; i0 += 4 * NT) {
        float d[4][8], ew[4], eu[4], hs[4];
#pragma unroll
        for (int r = 0; r < 4; ++r) { size_t i = i0 + r * NT; if (i >= (size_t)T * 128) i = i0; const int t = (int)(i >> 7), pp = (int)(i & 127);
#pragma unroll
            for (int x = 0; x < 8; ++x) d[r][x] = PD[((size_t)x * T + t) * 128 + pp];
            ew[r] = EW[i]; eu[r] = EU[i]; hs[r] = HSI[t]; }
#pragma unroll
        for (int r = 0; r < 4; ++r) { const size_t i = i0 + r * NT; if (i >= (size_t)T * 128) break;
            const float dot = ((d[r][0] + d[r][1]) + (d[r][2] + d[r][3])) + ((d[r][4] + d[r][5]) + (d[r][6] + d[r][7]));
            COEF[i] = ew[r] * gelu_t(dot * eu[r] * hs[r]); }
    }
}

DI void phase_peer_v(const Params& p, const Frame& F, const float* xin, float* xout, const float* gple, bool fuse) {
    unsigned char* ws = p.ws; const int lane = F.lane, c8 = lane & 7, r8 = lane >> 3;
    LAS unsigned char* wl = F.lds + F.wave * LDS_PERWAVE; LAS unsigned char* ring = wl; LAS unsigned char* meta = wl + 16384; LAS unsigned char* xs = wl + 16384 + 2048;
    const PeerStream S = peer_stream(F);
    const unsigned char* EIDX = ws + WS_EIDX; const unsigned char* COEF = ws + WS_COEF; const unsigned char* PTV = ws + WS_PTU + 16 * MiB;
    typedef float f32x2_t __attribute__((ext_vector_type(2)));
    int colofs;
    { const auto ra = __builtin_amdgcn_permlane32_swap(0u, 8u, false, false); const unsigned ta = ra[0];
      const auto rb = __builtin_amdgcn_permlane16_swap(ta, ta + 4u, false, false); const unsigned tb = rb[0];
      colofs = (int)tb + ((lane & 8) ? 2 : 0); }
    LAS float* gl = (LAS float*)(F.lds + 8 * LDS_PERWAVE);
    for (int i = F.tid; i < 1024; i += 512) gl[i] = gple[i];
    __syncthreads();
    bf16_t* Hn = (bf16_t*)(ws + WS_H); float* SSQ = (float*)(ws + WS_SSQ);
    int t, x;
#define PV_META(k_, slot_) do { peer_unit(S, (k_), t, x); const unsigned char* s_ = (lane < 32 ? EIDX : COEF) + (size_t)t * 512 + 16 * (lane & 31); peer_dma_o<0>(s_, meta + 1024 * (slot_)); } while (0)
#define PV_XS(k_, slot_) do { peer_unit(S, (k_), t, x); if (lane < 32) peer_dma_o<0>((const unsigned char*)(xin + (size_t)t * 1024 + 128 * x) + 16 * lane, xs + 512 * (slot_)); } while (0)
    PV_META(0, 0); PV_META(1, 1); PV_XS(0, 0);
    asm volatile("s_waitcnt vmcnt(0)" ::: "memory");
    u32x4 in_[4]; f32x4 cf[4], cn[4];
    { u32x4 i0_[4];
#pragma unroll
      for (int v_ = 0; v_ < 4; ++v_) { i0_[v_] = *(const LAS u32x4*)(meta + 64 * r8 + 16 * v_); cn[v_] = *(const LAS f32x4*)(meta + 512 + 64 * r8 + 16 * v_); }
      peer_unit(S, 0, t, x); const unsigned char* tb = PTV + (size_t)x * PT_SLICE + 16 * c8;
#define PV_D0(j) peer_dma_o<0>(tb + (size_t)i0_[(j) >> 2][(j) & 3] * 128, ring + 1024 * (j))
      PV_D0(0); PV_D0(1); PV_D0(2); PV_D0(3); PV_D0(4); PV_D0(5); PV_D0(6); PV_D0(7); PV_D0(8); PV_D0(9); PV_D0(10); PV_D0(11); PV_D0(12); PV_D0(13); PV_D0(14); PV_D0(15);
#undef PV_D0
    }
    PEER_VMW(12);
    u32x4 rr[4];
#pragma unroll
    for (int i = 0; i < 4; ++i) rr[i] = PEER_RD(i);
    for (int k = 0; k < S.n; ++k) {
        int tc, xc; peer_unit(S, k, tc, xc);
#pragma unroll
        for (int v_ = 0; v_ < 4; ++v_) cf[v_] = cn[v_];
        { LAS unsigned char* m1 = meta + 1024 * ((k + 1) & 1);
#pragma unroll
          for (int v_ = 0; v_ < 4; ++v_) { in_[v_] = *(const LAS u32x4*)(m1 + 64 * r8 + 16 * v_); cn[v_] = *(const LAS f32x4*)(m1 + 512 + 64 * r8 + 16 * v_); } }
        LDS_WAIT(); PV_META(k + 2, k & 1);
        PV_XS(k + 1, (k + 1) & 1);
        peer_unit(S, k + 1, t, x);
        const unsigned char* tbn = PTV + (size_t)x * PT_SLICE + 16 * c8;
        f32x2_t out[8];
#pragma unroll
        for (int e = 0; e < 8; ++e) out[e] = (f32x2_t){0.f, 0.f};
#define PV_STEP(j) do { if ((j) < 12) PEER_VMW(13); else PEER_VMW(11); const u32x4 nw = PEER_RD(((j) + 4) & 15); \
            const u32x4 pv_ = rr[(j) & 3]; const float c1_ = cf[(j) >> 2][(j) & 3]; const f32x2_t cc = {c1_, c1_}; \
            out[0] += cc * __builtin_amdgcn_cvt_pk_f32_fp8((int)pv_.x, false); out[1] += cc * __builtin_amdgcn_cvt_pk_f32_fp8((int)pv_.x, true); \
            out[2] += cc * __builtin_amdgcn_cvt_pk_f32_fp8((int)pv_.y, false); out[3] += cc * __builtin_amdgcn_cvt_pk_f32_fp8((int)pv_.y, true); \
            out[4] += cc * __builtin_amdgcn_cvt_pk_f32_fp8((int)pv_.z, false); out[5] += cc * __builtin_amdgcn_cvt_pk_f32_fp8((int)pv_.z, true); \
            out[6] += cc * __builtin_amdgcn_cvt_pk_f32_fp8((int)pv_.w, false); out[7] += cc * __builtin_amdgcn_cvt_pk_f32_fp8((int)pv_.w, true); \
            asm volatile("" :: "v"(rr[(j) & 3])); \
            peer_dma_o<0>(tbn + (size_t)in_[(j) >> 2][(j) & 3] * 128, ring + 1024 * (j)); rr[(j) & 3] = nw; } while (0)
        PV_STEP(0); PV_STEP(1); PV_STEP(2); PV_STEP(3); PV_STEP(4); PV_STEP(5); PV_STEP(6); PV_STEP(7);
        PV_STEP(8); PV_STEP(9); PV_STEP(10); PV_STEP(11); PV_STEP(12); PV_STEP(13); PV_STEP(14); PV_STEP(15);
#undef PV_STEP
        float n8[8], n4[4], f2[2];
#pragma unroll
        for (int i = 0; i < 8; ++i) { const float a_ = (i & 1) ? out[i >> 1].y : out[i >> 1].x, b_ = (i & 1) ? out[4 + (i >> 1)].y : out[4 + (i >> 1)].x;
            const auto r_ = __builtin_amdgcn_permlane32_swap(__float_as_uint(a_), __float_as_uint(b_), false, false); n8[i] = __uint_as_float(r_[0]) + __uint_as_float(r_[1]); }
#pragma unroll
        for (int i = 0; i < 4; ++i) { const auto r_ = __builtin_amdgcn_permlane16_swap(__float_as_uint(n8[i]), __float_as_uint(n8[4 + i]), false, false); n4[i] = __uint_as_float(r_[0]) + __uint_as_float(r_[1]); }
#pragma unroll
        for (int i = 0; i < 2; ++i) { const bool hi8 = (lane & 8) != 0; const float keep = hi8 ? n4[2 + i] : n4[i], send = hi8 ? n4[i] : n4[2 + i];
            f2[i] = keep + __builtin_bit_cast(float, DPP_I(__builtin_bit_cast(int, send), 0x128)); }
        { const f32x2_t xv = *(const LAS f32x2_t*)(xs + 512 * (k & 1) + 4 * (16 * c8 + colofs));
          const f32x2_t o = {xv.x + f2[0], xv.y + f2[1]}; *(f32x2_t*)(xout + (size_t)tc * 1024 + 128 * xc + 16 * c8 + colofs) = o;
          if (fuse) { const f32x2_t gg = *(const LAS f32x2_t*)(gl + 128 * xc + 16 * c8 + colofs);
              *(unsigned*)(Hn + (size_t)tc * 1024 + 128 * xc + 16 * c8 + colofs) = pk2(o.x * gg.x, o.y * gg.y);
              const float ss = wave_sum(o.x * o.x + o.y * o.y); if (lane == 0) SSQ[(size_t)tc * 8 + xc] = ss; } }
    }
#undef PV_META
#undef PV_XS
    asm volatile("s_waitcnt vmcnt(0) lgkmcnt(0)" ::: "memory");
}
#undef PEER_RD
#undef PEER_VMW

#ifndef MK_MASK
#define MK_MASK 0xffff
#endif
__global__ void __launch_bounds__(512, 2) mega(Params p) {
    extern __shared__ __attribute__((aligned(16))) unsigned char lds_raw[];
#define MKFRAME() Frame F; { int t_ = threadIdx.x; asm volatile("" : "+v"(t_)); F.lds = (LAS unsigned char*)lds_raw; F.tid = t_; F.lane = t_ & 63; F.wave = __builtin_amdgcn_readfirstlane(t_ >> 6); \
        F.G = gridDim.x; const int bx = blockIdx.x; F.vb = (F.G % 8 == 0) ? (bx % 8) * (F.G / 8) + bx / 8 : bx; }
    if (threadIdx.x < 16) ((LAS unsigned*)((LAS unsigned char*)lds_raw + LDS_XB))[threadIdx.x] = 0u;
    __syncthreads();
    const int lo = p.ph_lo, hi = p.ph_hi;
    XcdBarrier bar; bar.bar = (unsigned*)(p.ws + WS_CTL) + 4096; bar.x = 0; bar.st = (volatile LAS unsigned*)((LAS unsigned char*)lds_raw + LDS_XB);
    if (hi - lo > 1) bar = xcd_barrier_post((unsigned*)(p.ws + WS_CTL) + 4096, (volatile LAS unsigned*)((LAS unsigned char*)lds_raw + LDS_XB));
#define WSP(ws) unsigned char* ws = p.ws; asm volatile("" : "+s"(ws))
    for (int l = 0; l < NLAYER; ++l) {
        const int pb = l * NPH;
#define IN(k) (((MK_MASK >> (k)) & 1) && lo <= pb + (k) && pb + (k) < hi)
#if MK_PROBE == 120
#define SEAM(k) do { if (((MK_MASK >> (k)) & 1) && lo <= pb + (k) && pb + (k) + 1 < hi) { xcd_barrier(bar); xcd_barrier(bar); xcd_barrier(bar); } } while (0)
#else
#define SEAM(k) do { if (((MK_MASK >> (k)) & 1) && lo <= pb + (k) && pb + (k) + 1 < hi) xcd_barrier(bar); } while (0)
#endif
        if (IN(0)) { MKFRAME(); phase_prep_w(p, l, F); }
        SEAM(0);
#if MK_PROBE == 100
        if (IN(0)) { MKFRAME(); phase_prep_w(p, l, F); } xcd_barrier(bar);
#endif
        if (IN(1)) { MKFRAME(); WSP(ws); pg8::Gemm g{(const bf16_t*)(ws + WS_H), (const bf16_t*)(ws + WS_WCAT), T, 9216, 1024}; XcdColOrder S{F.G, (int)blockIdx.x};
            Epi1 E{(bf16_t*)(ws + WS_PROJ), (bf16_t*)(ws + WS_GATES)};
            pg8::gemm_phase<Epi1, XcdColOrder, false>(F.lds, g, S, E, nullptr); }
        SEAM(1);
#if MK_PROBE == 104
        if (IN(1)) { for (int rr = 0; rr < 18; ++rr) { MKFRAME(); WSP(ws); pg8::Gemm g{(const bf16_t*)(ws + WS_H), (const bf16_t*)(ws + WS_WCAT), T, 9216, 1024}; RoundOrder S; S.base.init(T, 9216, F.G, (int)blockIdx.x); S.r = rr;
            Epi1 E{(bf16_t*)(ws + WS_PROJ), (bf16_t*)(ws + WS_GATES)};
            pg8::gemm_phase<Epi1, RoundOrder, false>(F.lds, g, S, E, nullptr); xcd_barrier(bar); } }
#endif
#if MK_PROBE == 101 || MK_PROBE == 102 || MK_PROBE == 103
        if (IN(1)) { MKFRAME(); WSP(ws); pg8::Gemm g{(const bf16_t*)(ws + WS_H), (const bf16_t*)(ws + WS_WCAT), T, 9216, 1024}; ColRangeOrder S{F.G, (int)blockIdx.x, MK_PROBE == 103 ? 20 : 0, MK_PROBE == 102 ? 20 : 36};
            Epi1 E{(bf16_t*)(ws + WS_PROJ), (bf16_t*)(ws + WS_GATES)};
            pg8::gemm_phase<Epi1, ColRangeOrder, false>(F.lds, g, S, E, nullptr); } xcd_barrier(bar);
#endif
        if (IN(2)) { MKFRAME(); phase_chunk(p, l, F); }
        SEAM(2);
        if (IN(3)) { MKFRAME(); WSP(ws);
            { pg8::Gemm g{(const bf16_t*)(ws + WS_CMPA), (const bf16_t*)(ws + WS_W1C), 4096, 512, 1024}; pg8::StaticOrder S; S.init(4096, 512, F.G, (int)blockIdx.x); EpiF32P E{(float*)(ws + WS_CMPP), 512};
              pg8::gemm_phase<EpiF32P, pg8::StaticOrder, false>(F.lds, g, S, E, nullptr); }
        }
        if (IN(3)) { MKFRAME(); WSP(ws);
            { pg8::Gemm g{(const bf16_t*)(ws + WS_CMPA) + (size_t)4096 * 1024, (const bf16_t*)(ws + WS_W1C) + (size_t)512 * 1024, 4096, 512, 1024}; pg8::StaticOrder S; S.init(4096, 512, F.G, (int)((blockIdx.x + F.G / 2) % F.G));
              EpiF32P E{(float*)(ws + WS_CMPP) + (size_t)4096 * 512, 512};
              pg8::gemm_phase<EpiF32P, pg8::StaticOrder, false>(F.lds, g, S, E, nullptr); }
        }
        SEAM(3);
        if (IN(4)) { MKFRAME(); phase_cmp2(p, l, F); }
        SEAM(4);
        if (IN(5)) { MKFRAME(); phase_attn(p, l, F, 3, 15); }
        SEAM(5);
#if MK_PROBE == 5 || MK_PROBE == 50 || MK_PROBE == 51 || MK_PROBE == 52 || MK_PROBE == 53
        if (IN(5)) { MKFRAME(); phase_attn(p, l, F, MK_PROBE == 5 ? 3 : (MK_PROBE == 50 ? 1 : 2), MK_PROBE == 52 ? 1 : (MK_PROBE == 53 ? 3 : 15)); xcd_barrier(bar); }
#endif
#if MK_PROBE >= 60 && MK_PROBE < 76
        if (IN(5)) { MKFRAME(); phase_attn(p, l, F, 1, (MK_PROBE - 60) << 8); xcd_barrier(bar); }
#endif
        if (IN(6)) { MKFRAME(); WSP(ws); pg8::Gemm g{(const bf16_t*)(ws + WS_Y), (const bf16_t*)(ws + WS_WBR), 4 * T, 4096, 512}; BranchOrder S{F.G, (int)blockIdx.x};
            EpiBranch E{(const bf16_t*)(ws + WS_GATES), (bf16_t*)(ws + WS_MERGED)};
            pg8::gemm_phase<EpiBranch, BranchOrder, false>(F.lds, g, S, E, nullptr); }
        SEAM(6);
#if MK_PROBE == 106
        if (IN(6)) { MKFRAME(); WSP(ws); pg8::Gemm g{(const bf16_t*)(ws + WS_Y), (const bf16_t*)(ws + WS_WBR), 4 * T, 4096, 512}; BranchOrder S{F.G, (int)blockIdx.x};
            EpiBranch E{(const bf16_t*)(ws + WS_GATES), (bf16_t*)(ws + WS_MERGED)};
            pg8::gemm_phase<EpiBranch, BranchOrder, false>(F.lds, g, S, E, nullptr); } xcd_barrier(bar);
#endif
        if (IN(7)) { MKFRAME(); WSP(ws); pg8::Gemm g{(const bf16_t*)(ws + WS_MERGED), (const bf16_t*)(ws + WS_WOUT4), T, 1024, 1024}; pg8::StaticOrder S; S.init(T, 1024, F.G, (int)blockIdx.x);
            EpiRes E{l == 0 ? p.in[I_X] : p.out, p.out};
            pg8::gemm_phase<EpiRes, pg8::StaticOrder, false>(F.lds, g, S, E, nullptr); }
        SEAM(7);
        if (IN(8)) { MKFRAME(); WSP(ws); rmsnorm_rows(p.out, p.in[I_GFFN] + l * 1024, (bf16_t*)(ws + WS_H), F.vb * 8 + F.wave, F.G * 8, F.lane, ws + WS_H8, (float*)(ws + WS_HSI)); }
        SEAM(8);
#if MK_PROBE == 108
        if (IN(8)) { MKFRAME(); WSP(ws); rmsnorm_rows(p.out, p.in[I_GFFN] + l * 1024, (bf16_t*)(ws + WS_H), F.vb * 8 + F.wave, F.G * 8, F.lane); } xcd_barrier(bar);
#endif
        if (IN(9)) { MKFRAME(); WSP(ws);
            { pg8::Gemm g{(const bf16_t*)(ws + WS_H), (const bf16_t*)(ws + WS_WQ), T, 1024, 1024}; pg8::StaticOrder S; S.init(T, 1024, F.G, (int)blockIdx.x); EpiBf E{(bf16_t*)(ws + WS_QP), 1024};
              pg8::gemm_phase<EpiBf, pg8::StaticOrder, false>(F.lds, g, S, E, nullptr); }
        }
        if (IN(9)) { MKFRAME(); WSP(ws);
            { pg8::Gemm g{(const bf16_t*)(ws + WS_PB), (const bf16_t*)(ws + WS_WPP), T, 1024, 256}; pg8::StaticOrder S; S.init(T, 1024, F.G, (int)blockIdx.x); EpiBf E{(bf16_t*)(ws + WS_PP), 1024};
              pg8::gemm_phase<EpiBf, pg8::StaticOrder, false>(F.lds, g, S, E, nullptr); }
        }
        SEAM(9);
#if MK_PROBE == 110
        if (IN(9)) { for (int rep = 0; rep < 9; ++rep) { MKFRAME(); WSP(ws);
            { pg8::Gemm g{(const bf16_t*)(ws + WS_H), (const bf16_t*)(ws + WS_WQ), T, 1024, 1024}; pg8::StaticOrder S; S.init(T, 1024, F.G, (int)blockIdx.x); EpiBf E{(bf16_t*)(ws + WS_QP), 1024};
              pg8::gemm_phase<EpiBf, pg8::StaticOrder, false>(F.lds, g, S, E, nullptr); } } xcd_barrier(bar); }
#endif
#if MK_PROBE == 109
        if (IN(9)) { MKFRAME(); WSP(ws);
            { pg8::Gemm g{(const bf16_t*)(ws + WS_H), (const bf16_t*)(ws + WS_WQ), T, 1024, 1024}; pg8::StaticOrder S; S.init(T, 1024, F.G, (int)blockIdx.x); EpiBf E{(bf16_t*)(ws + WS_QP), 1024};
              pg8::gemm_phase<EpiBf, pg8::StaticOrder, false>(F.lds, g, S, E, nullptr); } }
        if (IN(9)) { MKFRAME(); WSP(ws);
            { pg8::Gemm g{(const bf16_t*)(ws + WS_PB), (const bf16_t*)(ws + WS_WPP), T, 1024, 256}; pg8::StaticOrder S; S.init(T, 1024, F.G, (int)blockIdx.x); EpiBf E{(bf16_t*)(ws + WS_PP), 1024};
              pg8::gemm_phase<EpiBf, pg8::StaticOrder, false>(F.lds, g, S, E, nullptr); } }
        xcd_barrier(bar);
#endif
        if (IN(10)) { MKFRAME(); for (int tile = F.vb * 8 + F.wave; tile < T / 16; tile += F.G * 8) peer_route_tile(p, tile * 16, F.lane); }
        SEAM(10);
        if (IN(11)) { MKFRAME(); phase_peer_u(p, F); }
        SEAM(11);
        if (IN(12)) { MKFRAME(); phase_peer_coef(p, F); }
        SEAM(12);
        if (IN(13)) { MKFRAME(); phase_peer_v(p, F, p.out, p.out, p.in[I_GPLE] + l * 1024, true); }
        SEAM(13);
#if MK_PROBE == 130
        if (IN(13)) { MKFRAME(); phase_peer_u(p, F); xcd_barrier(bar); }
#endif
#if MK_PROBE == 131
        if (IN(13)) { MKFRAME(); phase_peer_coef(p, F); xcd_barrier(bar); }
#endif
#if MK_PROBE == 132
        if (IN(13)) { MKFRAME(); phase_peer_v(p, F, p.out, (float*)(p.ws + WS_Y), p.in[I_GPLE] + l * 1024, false); xcd_barrier(bar); }
#endif
#if MK_PROBE == 133
        if (IN(13)) { MKFRAME(); for (int tile = F.vb * 8 + F.wave; tile < T / 16; tile += F.G * 8) peer_route_tile(p, tile * 16, F.lane); xcd_barrier(bar); }
#endif
        if (IN(15)) { MKFRAME(); WSP(ws); pg8::Gemm g{(const bf16_t*)(ws + WS_H), (const bf16_t*)(ws + WS_WPG), T, 1024, 1024}; pg8::StaticOrder S; S.init(T, 1024, F.G, (int)blockIdx.x);
            EpiPle E{p.out, (const bf16_t*)(ws + WS_PP), (const float*)(ws + WS_SSQ)};
            pg8::gemm_phase<EpiPle, pg8::StaticOrder, false>(F.lds, g, S, E, nullptr); }
        SEAM(15);
#undef IN
#undef SEAM
    }
}
}

#ifndef MK_LAUNCH_PER_PHASE
#define MK_LAUNCH_PER_PHASE 0
#endif
extern "C" void kernel_launch(void* const* d_in, const int* in_sizes, int n_in, void* d_out, int out_size, void* d_ws, size_t ws_size, hipStream_t stream) {
    static int grid = 0;
    if (grid == 0) {
        if (n_in != 27 || ws_size < mk::WS_END) { fprintf(stderr, "kernel_launch: need 27 inputs and >= %zu bytes of workspace (got %d, %zu)\n", (size_t)mk::WS_END, n_in, ws_size); grid = -1; return; }
        int dev = 0, cus = 0;
        if (hipGetDevice(&dev) != hipSuccess || hipDeviceGetAttribute(&cus, hipDeviceAttributeMultiprocessorCount, dev) != hipSuccess) { grid = -1; return; }
        if (hipFuncSetAttribute((const void*)mk::mega, hipFuncAttributeMaxDynamicSharedMemorySize, mk::LDS_BYTES) != hipSuccess) { fprintf(stderr, "kernel_launch: hipFuncSetAttribute failed\n"); grid = -1; return; }
        int per_cu = 0;
        if (hipOccupancyMaxActiveBlocksPerMultiprocessor(&per_cu, (const void*)mk::mega, 512, mk::LDS_BYTES) != hipSuccess || per_cu < 1) fprintf(stderr, "kernel_launch: occupancy query says %d\n", per_cu);
        (void)hipGetLastError();
        grid = cus;
    }
    if (grid < 0) return;
    (void)in_sizes; (void)out_size;
    hipMemsetAsync((char*)d_ws + mk::WS_CTL, 0, 1u << 20, stream);
    mk::Params prm{};
    for (int i = 0; i < 27; ++i) prm.in[i] = (const float*)d_in[i];
    prm.out = (float*)d_out; prm.ws = (unsigned char*)d_ws;
#if MK_LAUNCH_PER_PHASE
    for (int ph = 0; ph < mk::NLAYER * mk::NPH; ++ph) { prm.ph_lo = ph; prm.ph_hi = ph + 1; hipLaunchKernelGGL(mk::mega, dim3(grid), dim3(512), mk::LDS_BYTES, stream, prm); }
#else
    prm.ph_lo = 0; prm.ph_hi = mk::NLAYER * mk::NPH; hipLaunchKernelGGL(mk::mega, dim3(grid), dim3(512), mk::LDS_BYTES, stream, prm);
#endif
}
```

```cpp
#include <hip/hip_runtime.h>
#include <stdio.h>
#include <stdint.h>
namespace pg8 {
#define PG8_LAS __attribute__((address_space(3)))
typedef unsigned short bf16_t;
typedef short bf16x8 __attribute__((ext_vector_type(8)));
typedef float f32x4 __attribute__((ext_vector_type(4)));
typedef unsigned u32x4 __attribute__((ext_vector_type(4)));
constexpr int BM = 256, BK = 64, HALF = 128, HTB = HALF * BK * 2  , STAGE_BYTES = 8 * HTB, NXCD = 8, WGM = 8;

__host__ __device__ __forceinline__ int lds_byte(int r, int c) { const int st = (r >> 4) * 2 + (c >> 5), rr = r & 15, cc = c & 31, ob = rr * 64 + cc * 2; return st * 1024 + (ob ^ (((ob >> 9) & 1) << 5)); }
__host__ __device__ __forceinline__ void stage_rc(int b, int& R, int& C) { const int st = b / 1024, sb = b % 1024, swz = sb ^ (((sb >> 9) & 1) << 5); R = (st >> 1) * 16 + swz / 64; C = (st & 1) * 32 + (swz % 64) / 2; }
__host__ __device__ __forceinline__ int perm32(int rho) { const int n = rho >> 4, i = rho & 15; return 8 * (i >> 2) + 4 * n + (i & 3); }

struct Unit { int pm, pn; };
struct Gemm { const bf16_t* A; const bf16_t* Bt; int M, N, K; };

struct StaticOrder {
    int nM, nN, nwg, G, c;
    __host__ __device__ void init(int M, int N, int G_, int c_) { nM = M / BM; nN = N / BM; nwg = nM * nN; G = G_; c = c_; }
    __host__ __device__ bool next(int i, Unit& u) const {
        const long L = (long)i * G + c; if (L >= nwg) return false;
        int wgid = (int)L; { const int q = nwg / NXCD, r = nwg % NXCD, xcd = wgid % NXCD, off = wgid / NXCD; wgid = (xcd < r ? xcd * (q + 1) : r * (q + 1) + (xcd - r) * q) + off; }
        const int nig = WGM * nN, gid = wgid / nig, fm = gid * WGM, gsz = (nM - fm) < WGM ? (nM - fm) : WGM;
        u.pm = fm + ((wgid % nig) % gsz); u.pn = (wgid % nig) / gsz; return true;
    }
    __device__ __forceinline__ void a_ready(const Unit&) const {}
    __device__ __forceinline__ void done(const Unit&) const {}
};
__device__ __forceinline__ unsigned cvt_pk_bf16(float lo, float hi) { unsigned r; asm volatile("v_cvt_pk_bf16_f32 %0, %1, %2" : "=v"(r) : "v"(lo), "v"(hi)); return r; }
template <class Epi, class Sched, bool STAMP = false>
__device__ __forceinline__ void gemm_phase(PG8_LAS unsigned char* lds, const Gemm g, const Sched& S, const Epi& E, unsigned long long* stamps) {
    int tid_l = threadIdx.x; asm volatile("" : "+v"(tid_l));
    const int tid = tid_l, wid = __builtin_amdgcn_readfirstlane(tid >> 6), lane = tid & 63, wr = wid >> 2, wc = wid & 3, fr = lane & 15, fq = lane >> 4;
    const int K = g.K, nt = K / BK;
    int ts_lo = 0, ts_hi = 0, nts = 0; const unsigned long long rt_entry = STAMP ? (unsigned long long)wall_clock64() : 0ull;
#define PG8_STAMP() do { if (STAMP && wid == 0 && nts < 64) { const unsigned long long _c = (unsigned long long)clock64(); \
        ts_lo = (lane == nts) ? (int)(unsigned)_c : ts_lo; ts_hi = (lane == nts) ? (int)(unsigned)(_c >> 32) : ts_hi; ++nts; } } while (0)
    PG8_STAMP();
    unsigned voffA[2], voffB[2];
#pragma unroll
    for (int i = 0; i < 2; ++i) { int R, C; stage_rc(tid * 16 + i * 8192, R, C); const int Rb = Epi::PERM ? ((R & ~31) + perm32(R & 31)) : R;
        voffA[i] = (unsigned)(R * K + C) * 2u; voffB[i] = (unsigned)(Rb * K + C) * 2u; }
    const size_t kstep = (size_t)(BK * 2);
    const size_t hstep = (size_t)HALF * K * 2;
    const size_t tstep = 2 * hstep;
    const unsigned ldsw = (unsigned)wid * 1024u;
    const int aoff = lds_byte(wr * 64 + fr, fq * 8), boff = lds_byte(wc * 32 + fr, fq * 8);
#define PG8_SA(b, h) (((b) * 2 + (h)) * HTB)
#define PG8_SB(b, h) ((4 + (b) * 2 + (h)) * HTB)
#define PG8_STAGE(bufoff, gbase, voff) do { _Pragma("unroll") for (int _i = 0; _i < 2; ++_i) \
        __builtin_amdgcn_global_load_lds((const unsigned*)((const char*)(gbase) + (voff)[_i]), (PG8_LAS unsigned*)(lds + (bufoff) + ldsw + _i * 8192), 16, 0, 0); } while (0)
#define PG8_LDA(dst, b, h) do { _Pragma("unroll") for (int m = 0; m < 4; ++m) _Pragma("unroll") for (int k = 0; k < 2; ++k) dst[m][k] = *(const PG8_LAS bf16x8*)(lds + PG8_SA(b, h) + aoff + m * 2048 + k * 1024); } while (0)
#define PG8_LDB(dst, b, h) do { _Pragma("unroll") for (int n = 0; n < 2; ++n) _Pragma("unroll") for (int k = 0; k < 2; ++k) dst[n][k] = *(const PG8_LAS bf16x8*)(lds + PG8_SB(b, h) + boff + n * 2048 + k * 1024); } while (0)
#define PG8_MMA(ai, bj, At, Bt) do { __builtin_amdgcn_s_setprio(1); _Pragma("unroll") for (int m = 0; m < 4; ++m) _Pragma("unroll") for (int n = 0; n < 2; ++n) _Pragma("unroll") for (int k = 0; k < 2; ++k) \
        acc[ai][bj][m][n] = __builtin_amdgcn_mfma_f32_16x16x32_bf16(Bt[n][k], At[m][k], acc[ai][bj][m][n], 0, 0, 0); __builtin_amdgcn_s_setprio(0); } while (0)
#define PG8_WAIT_V(n) asm volatile("s_waitcnt vmcnt(" #n ")" ::: "memory")
#define PG8_WAIT_L(n) asm volatile("s_waitcnt lgkmcnt(" #n ")" ::: "memory")
#define PG8_BAR __builtin_amdgcn_s_barrier()
#define PG8_SCHED __builtin_amdgcn_sched_barrier(0)
    Unit cur, nxt; int ui = 0;
    if (!S.next(0, cur)) return;
    f32x4 acc[2][2][4][2];
#pragma unroll
    for (int a = 0; a < 2; ++a)
#pragma unroll
        for (int b = 0; b < 2; ++b)
#pragma unroll
            for (int m = 0; m < 4; ++m)
#pragma unroll
                for (int n = 0; n < 2; ++n) acc[a][b][m][n] = (f32x4){0.f, 0.f, 0.f, 0.f};
    bf16x8 At[4][2], B0[2][2], B1[2][2];
    const char* cA = (const char*)g.A + (size_t)cur.pm * tstep; const char* cB = (const char*)g.Bt + (size_t)cur.pn * tstep;
    S.a_ready(cur);
    PG8_STAGE(PG8_SB(0, 0), cB, voffB); PG8_STAGE(PG8_SA(0, 0), cA, voffA); PG8_STAGE(PG8_SB(0, 1), cB + hstep, voffB); PG8_STAGE(PG8_SA(0, 1), cA + hstep, voffA);
    if (wr == 1) PG8_BAR;
    PG8_WAIT_V(4); PG8_BAR;
    PG8_STAGE(PG8_SB(1, 0), cB + kstep, voffB); PG8_STAGE(PG8_SA(1, 0), cA + kstep, voffA); PG8_STAGE(PG8_SB(1, 1), cB + hstep + kstep, voffB);
    PG8_WAIT_V(6); PG8_BAR;
    PG8_STAMP();
    for (;;) {
        const bool has_next = S.next(ui + 1, nxt);
        const char* nA = has_next ? (const char*)g.A + (size_t)nxt.pm * tstep : cA; const char* nB = has_next ? (const char*)g.Bt + (size_t)nxt.pn * tstep : cB;
        for (int t = 0; t < nt; t += 2) {
            const bool last = (t == nt - 2);
            const char* a1 = cA + (size_t)(t + 1) * kstep;
            const char* a2 = last ? nA : cA + (size_t)(t + 2) * kstep; const char* b2 = last ? nB : cB + (size_t)(t + 2) * kstep;
            const char* a3 = a2 + kstep; const char* b3 = b2 + kstep;
            if (last && has_next) S.a_ready(nxt);
            PG8_LDB(B0, 0, 0); PG8_SCHED; PG8_LDA(At, 0, 0); PG8_STAGE(PG8_SA(1, 1), a1 + hstep, voffA);
            PG8_WAIT_L(8); PG8_BAR; PG8_WAIT_L(0); PG8_MMA(0, 0, At, B0); PG8_BAR; PG8_SCHED;
            PG8_LDB(B1, 0, 1); PG8_STAGE(PG8_SB(0, 0), b2, voffB);
            PG8_BAR; PG8_WAIT_L(0); PG8_MMA(0, 1, At, B1); PG8_BAR;
            PG8_LDA(At, 0, 1); PG8_STAGE(PG8_SA(0, 0), a2, voffA);
            PG8_BAR; PG8_WAIT_L(0); PG8_MMA(1, 0, At, B0); PG8_BAR; PG8_SCHED;
            PG8_STAGE(PG8_SB(0, 1), b2 + hstep, voffB);
            PG8_WAIT_V(6); PG8_BAR; PG8_MMA(1, 1, At, B1); PG8_BAR;
            PG8_LDB(B0, 1, 0); PG8_SCHED; PG8_LDA(At, 1, 0); PG8_STAGE(PG8_SA(0, 1), a2 + hstep, voffA);
            PG8_WAIT_L(8); PG8_BAR; PG8_WAIT_L(0); PG8_MMA(0, 0, At, B0); PG8_BAR; PG8_SCHED;
            PG8_LDB(B1, 1, 1); PG8_STAGE(PG8_SB(1, 0), b3, voffB);
            PG8_BAR; PG8_WAIT_L(0); PG8_MMA(0, 1, At, B1); PG8_BAR;
            PG8_LDA(At, 1, 1); PG8_STAGE(PG8_SA(1, 0), a3, voffA);
            PG8_BAR; PG8_WAIT_L(0); PG8_MMA(1, 0, At, B0); PG8_BAR; PG8_SCHED;
            PG8_STAGE(PG8_SB(1, 1), b3 + hstep, voffB);
            PG8_WAIT_V(6); PG8_BAR; PG8_MMA(1, 1, At, B1); PG8_BAR;
        }
        PG8_STAMP();
        if constexpr (!Epi::AFTER_DRAIN) { E(acc, cur, wr, wc, fr, fq); S.done(cur); }
        PG8_STAMP();
        if (!has_next) break;
#pragma unroll
        for (int a = 0; a < 2; ++a)
#pragma unroll
            for (int b = 0; b < 2; ++b)
#pragma unroll
                for (int m = 0; m < 4; ++m)
#pragma unroll
                    for (int n = 0; n < 2; ++n) acc[a][b][m][n] = (f32x4){0.f, 0.f, 0.f, 0.f};
        cur = nxt; cA = nA; cB = nB; ++ui;
    }
    PG8_WAIT_V(0);
    if (wr == 0) PG8_BAR;
    PG8_BAR;
    if constexpr (Epi::AFTER_DRAIN) { E.fused(acc, cur, wr, wc, fr, fq, lds, wid, lane); S.done(cur); }
    PG8_STAMP();
    if (STAMP && wid == 0) { stamps[lane] = lane < nts ? (((unsigned long long)(unsigned)ts_hi << 32) | (unsigned)ts_lo) : 0ull;
        if (lane == 62) stamps[62] = rt_entry; if (lane == 63) stamps[63] = (unsigned long long)wall_clock64(); }
#undef PG8_STAMP
#undef PG8_SA
#undef PG8_SB
#undef PG8_STAGE
#undef PG8_LDA
#undef PG8_LDB
#undef PG8_MMA
#undef PG8_WAIT_V
#undef PG8_WAIT_L
#undef PG8_BAR
#undef PG8_SCHED
}
}
#define XB_TMO      128
#define XB_XCNT(j)  (256  + 64 * (j))
#define XB_XSUB(j)  (1280 + 64 * (j))
#define XB_XGEN(j)  (2304 + 64 * (j))
#define XB_TOP      3328
#define XB_TOPGEN   3392
#define XCD_BAR_WORDS 3456
#define XB_SPIN_CAP (1u << 18)
#define LAS __attribute__((address_space(3)))

__device__ __forceinline__ unsigned xb_ld(unsigned* p)              { return __hip_atomic_load(p, __ATOMIC_RELAXED, __HIP_MEMORY_SCOPE_AGENT); }
__device__ __forceinline__ unsigned xb_add(unsigned* p, unsigned v) { return __hip_atomic_fetch_add(p, v, __ATOMIC_RELAXED, __HIP_MEMORY_SCOPE_AGENT); }
__device__ __forceinline__ unsigned xb_xcc_id() { return (unsigned)__builtin_amdgcn_s_getreg((3 << 11) | 20) & 0xFu; }
#define XB_SPIN(cond, bar) do { unsigned _sp = 0; while (cond) { __builtin_amdgcn_s_sleep(1); \
    if ((++_sp & 255u) == 0u) { if (xb_ld(&(bar)[XB_TMO])) break; if (_sp > XB_SPIN_CAP) { atomicAdd(&(bar)[XB_TMO], 1u); break; } } } } while (0)

struct XcdBarrier {
    unsigned* bar; unsigned x;
    volatile LAS unsigned* st;
};

__device__ __forceinline__ XcdBarrier xcd_barrier_post(unsigned* bar, volatile LAS unsigned* st) {
    XcdBarrier b; b.bar = bar; b.x = xb_xcc_id(); b.st = st;
    if (threadIdx.x == 0) (void)xb_add(&bar[XB_XCNT(b.x)], 1u);
    return b;
}
__device__ __forceinline__ void xcd_barrier_complete(unsigned* bar, unsigned x, unsigned& nloc, unsigned& nx) {
    const unsigned G = gridDim.x * gridDim.y * gridDim.z;
    unsigned sum, cnt, mine, sp = 0u;
    for (;;) {
        sum = 0u; cnt = 0u; mine = 0u;
#pragma unroll
        for (unsigned j = 0; j < 16; ++j) { const unsigned c = xb_ld(&bar[XB_XCNT(j)]); sum += c; cnt += (c > 0u) ? 1u : 0u; mine = (j == x) ? c : mine; }
        if (sum == G) break;
        __builtin_amdgcn_s_sleep(1);
        if ((++sp & 255u) == 0u) { if (xb_ld(&bar[XB_TMO])) break; if (sp > XB_SPIN_CAP) { atomicAdd(&bar[XB_TMO], 1u); break; } }
    }
    nloc = mine > 0u ? mine : 1u; nx = cnt > 0u ? cnt : 1u;
}

__device__ __forceinline__ void xcd_barrier(const XcdBarrier& b) {
    asm volatile("s_waitcnt vmcnt(0)" ::: "memory");
    __syncthreads();
    if (threadIdx.x == 0) {
        unsigned* bar = b.bar;
        __builtin_amdgcn_s_waitcnt(0);
        unsigned nloc = b.st[0], nx = b.st[1];
        if (nloc == 0u) { xcd_barrier_complete(bar, b.x, nloc, nx); b.st[0] = nloc; b.st[1] = nx; }
        const unsigned old = xb_add(&bar[XB_XSUB(b.x)], 1u);
        const unsigned gen = old / nloc;
        if (old + 1u == (gen + 1u) * nloc) {
            __builtin_amdgcn_fence(__ATOMIC_RELEASE, "agent");
            asm volatile("s_waitcnt vmcnt(0)" ::: "memory");
            const unsigned og = xb_add(&bar[XB_TOP], 1u);
            const unsigned tg = og / nx;
            if (og + 1u == (tg + 1u) * nx) xb_add(&bar[XB_TOPGEN], 1u);
            else XB_SPIN(xb_ld(&bar[XB_TOPGEN]) == tg, bar);
            __builtin_amdgcn_fence(__ATOMIC_ACQUIRE, "agent");
            xb_add(&bar[XB_XGEN(b.x)], 1u);
            asm volatile("s_waitcnt vmcnt(0)" ::: "memory");
        } else {
            XB_SPIN(xb_ld(&bar[XB_XGEN(b.x)]) == gen, bar);
            __builtin_amdgcn_fence(__ATOMIC_ACQUIRE, "agent");
            asm volatile("s_waitcnt vmcnt(0)" ::: "memory");
        }
    }
    __syncthreads();
}

namespace mk {
using pg8::bf16_t; using pg8::bf16x8; using pg8::f32x4; using pg8::u32x4;
typedef unsigned u32x2 __attribute__((ext_vector_type(2)));
typedef short s16x4 __attribute__((ext_vector_type(4)));
#define DI __device__ __forceinline__
#define LDS_WAIT() asm volatile("s_waitcnt lgkmcnt(0)" ::: "memory")
#define LDS_FENCE() asm volatile("" ::: "memory")
#define MFMA16(a, b, c) __builtin_amdgcn_mfma_f32_16x16x32_bf16((a), (b), (c), 0, 0, 0)

constexpr int T = 32768, SEQ = 4096, NLAYER = 4, NPH = 16;
constexpr int PW = 5120;
constexpr int C_AB = 0, C_AC = 512, C_AX = 1024, C_NQ = 1536, C_NKV = 2048, C_UV = 2816, C_DQ = 3840, C_DK = 4352, C_DV = 4416,
              C_DQI = 4480, C_DKI = 4992, C_NG = 5056, C_DWI = 5080;
constexpr size_t MiB = 1u << 20;
constexpr size_t WS_CTL = 0, WS_PEB = 1 * MiB, WS_CMPK = 2 * MiB, WS_CMPV = 3 * MiB, WS_SK = 4 * MiB, WS_SGUW = 5 * MiB, WS_CMPA = 8 * MiB,
                 WS_CMPP = 24 * MiB, WS_WCAT = 40 * MiB, WS_WBR = 58 * MiB, WS_WOUT4 = 62 * MiB, WS_WQ = 70 * MiB, WS_WPG = 72 * MiB,
                 WS_WPP = 74 * MiB, WS_W1C = 75 * MiB, WS_PB = 78 * MiB, WS_PTU = 96 * MiB, WS_PTV = 128 * MiB, WS_H = 160 * MiB,
                 WS_Y = 224 * MiB, WS_PROJ = 352 * MiB, WS_GATES = 672 * MiB,
                 WS_KS = 928 * MiB, WS_VS = 936 * MiB, WS_KW = 944 * MiB, WS_VW = 952 * MiB, WS_DK = 960 * MiB, WS_DV = 964 * MiB, WS_DKI = 968 * MiB, WS_END = 972 * MiB;
constexpr size_t WS_ACCF = WS_PROJ, WS_MERGED = WS_PROJ + 128 * MiB, WS_QP = WS_PROJ, WS_PP = WS_PROJ + 64 * MiB, WS_EIDX = WS_PROJ + 128 * MiB, WS_EW = WS_PROJ + 144 * MiB, WS_EU = WS_PROJ + 160 * MiB;
constexpr size_t WS_COEF = WS_PROJ + 176 * MiB, WS_H8 = WS_PROJ + 192 * MiB, WS_HSI = WS_PROJ + 224 * MiB, WS_SSQ = WS_PROJ + 225 * MiB, WS_PD = WS_GATES, PT_SLICE = 2 * MiB;
constexpr int LDS_BYTES = 163840, LDS_PERWAVE = 19456, LDS_BUCK = 8 * LDS_PERWAVE, LDS_TBL = LDS_BUCK + 4096, LDS_XB = LDS_BYTES - 64;

struct Params { const float* in[27]; float* out; unsigned char* ws; int ph_lo, ph_hi; };
enum { I_X = 0, I_P, I_REL, I_GMIX, I_WIN, I_CONVW, I_PE, I_CW1, I_CW2, I_NQG, I_NKG, I_LNG, I_SGUW, I_SGUB, I_DQG, I_DKG, I_WGATE, I_WBR, I_WOUT,
       I_GFFN, I_WQ, I_SUBK, I_PU, I_PV, I_GPLE, I_WPG, I_WPP };

struct Frame { LAS unsigned char* lds; int tid, lane, wave, vb, G; };

DI float bf2f(unsigned short b) { return __uint_as_float(((unsigned)b) << 16); }
DI unsigned f2bf(float f) { unsigned u = __float_as_uint(f); return (u + 0x7fffu + ((u >> 16) & 1u)) >> 16; }
DI unsigned pk2(float lo, float hi) { return pg8::cvt_pk_bf16(lo, hi); }
DI float lo16(unsigned w) { return __uint_as_float(w << 16); }
DI float hi16(unsigned w) { return __uint_as_float(w & 0xffff0000u); }
DI float sigm(float x) { return __builtin_amdgcn_rcpf(1.f + __builtin_amdgcn_exp2f(-1.44269504f * x)); }
DI float gelu_t(float x) { const float y = (-2.f * 0.7978845608f * 1.44269504f) * (x + 0.044715f * x * x * x); return x * __builtin_amdgcn_rcpf(1.f + __builtin_amdgcn_exp2f(y)); }
#define DPP_I(x, ctrl) __builtin_amdgcn_update_dpp(0, (x), (ctrl), 0xF, 0xF, false)
DI float dppf(float x, int) { return x; }
DI float row16_sumf(float v) { v += __builtin_bit_cast(float, DPP_I(__builtin_bit_cast(int, v), 0xB1)); v += __builtin_bit_cast(float, DPP_I(__builtin_bit_cast(int, v), 0x4E));
    v += __builtin_bit_cast(float, DPP_I(__builtin_bit_cast(int, v), 0x141)); v += __builtin_bit_cast(float, DPP_I(__builtin_bit_cast(int, v), 0x140)); return v; }
DI float row16_maxf(float v) { v = fmaxf(v, __builtin_bit_cast(float, DPP_I(__builtin_bit_cast(int, v), 0xB1))); v = fmaxf(v, __builtin_bit_cast(float, DPP_I(__builtin_bit_cast(int, v), 0x4E)));
    v = fmaxf(v, __builtin_bit_cast(float, DPP_I(__builtin_bit_cast(int, v), 0x141))); v = fmaxf(v, __builtin_bit_cast(float, DPP_I(__builtin_bit_cast(int, v), 0x140))); return v; }
DI float quad_sumf(float v) { v += __builtin_bit_cast(float, DPP_I(__builtin_bit_cast(int, v), 0xB1)); v += __builtin_bit_cast(float, DPP_I(__builtin_bit_cast(int, v), 0x4E)); return v; }
DI float oct_sumf(float v) { v = quad_sumf(v); v += __builtin_bit_cast(float, DPP_I(__builtin_bit_cast(int, v), 0x141)); return v; }
DI float x16_sum(float v) { const unsigned u = __float_as_uint(v); const auto r = __builtin_amdgcn_permlane16_swap(u, u, false, false); return __uint_as_float(r[0]) + __uint_as_float(r[1]); }
DI float x32_sum(float v) { const unsigned u = __float_as_uint(v); const auto r = __builtin_amdgcn_permlane32_swap(u, u, false, false); return __uint_as_float(r[0]) + __uint_as_float(r[1]); }
DI float x16_max(float v) { const unsigned u = __float_as_uint(v); const auto r = __builtin_amdgcn_permlane16_swap(u, u, false, false); return fmaxf(__uint_as_float(r[0]), __uint_as_float(r[1])); }
DI float x32_max(float v) { const unsigned u = __float_as_uint(v); const auto r = __builtin_amdgcn_permlane32_swap(u, u, false, false); return fmaxf(__uint_as_float(r[0]), __uint_as_float(r[1])); }
DI unsigned wave_sum_u(unsigned v) { v += (unsigned)DPP_I((int)v, 0xB1); v += (unsigned)DPP_I((int)v, 0x4E); v += (unsigned)DPP_I((int)v, 0x141); v += (unsigned)DPP_I((int)v, 0x140);
    { const auto r = __builtin_amdgcn_permlane16_swap(v, v, false, false); v = r[0] + r[1]; } { const auto r = __builtin_amdgcn_permlane32_swap(v, v, false, false); v = r[0] + r[1]; } return v; }
DI float wave_sum(float v) { return x32_sum(x16_sum(row16_sumf(v))); }
DI float wave_max(float v) { return x32_max(x16_max(row16_maxf(v))); }
DI unsigned ordf(float f) { const unsigned u = __float_as_uint(f); return (u & 0x80000000u) ? ~u : (u | 0x80000000u); }
DI float unordf(unsigned x) { return __uint_as_float((x & 0x80000000u) ? (x & 0x7fffffffu) : ~x); }
DI int bucket_of(int n) {
    if (n < 16) return n;
    int b = 16;
    b += (n >= 21); b += (n >= 27); b += (n >= 35); b += (n >= 46); b += (n >= 59); b += (n >= 77); b += (n >= 99); b += (n >= 128);
    b += (n >= 166); b += (n >= 216); b += (n >= 280); b += (n >= 363); b += (n >= 470); b += (n >= 609); b += (n >= 790);
    return b; }

DI int srccol(int n) { return n < 2816 ? n : (n < 5056 ? n + 24 : (n < 5080 ? n - 2240 : (n < 5088 ? n : -1))); }
DI void tr_item(const float* W, int ldw, bf16_t* WT, int ldwt, int k0, int n0, LAS float* scr, int lane, bool remap, int ncopy, int cstride) {
    float tv[32];
#pragma unroll
    for (int i = 0; i < 32; ++i) { const int kk = 2 * i + (lane >> 5), nl = lane & 31; const int n = n0 + nl; const int src = remap ? srccol(n) : n; tv[i] = src >= 0 ? W[(size_t)(k0 + kk) * ldw + src] : 0.f; }
#pragma unroll
    for (int i = 0; i < 32; ++i) { const int kk = 2 * i + (lane >> 5), nl = lane & 31; scr[kk * 33 + nl] = tv[i]; }
    LDS_WAIT();
    const int c = lane & 7;
#pragma unroll
    for (int j = 0; j < 4; ++j) { const int n = (lane >> 3) + 8 * j; const LAS float* s = scr + (8 * c) * 33 + n;
        u32x4 o; o.x = pk2(s[0], s[33]); o.y = pk2(s[66], s[99]); o.z = pk2(s[132], s[165]); o.w = pk2(s[198], s[231]);
        for (int cp = 0; cp < ncopy; ++cp) *(u32x4*)(WT + (size_t)(n0 + n) * ldwt + (size_t)cp * cstride + k0 + 8 * c) = o; }
    LDS_WAIT();
}
DI void cvt_rows(const float* src, bf16_t* dst, size_t ngroups8, int gw, int NGW, int lane) {
    const size_t st = (size_t)NGW * 64;
    for (size_t i0 = (size_t)gw * 64 + lane; i0 < ngroups8; i0 += 4 * st) {
        f32x4 a[4], b[4];
#pragma unroll
        for (int r = 0; r < 4; ++r) { const size_t i = i0 + r * st < ngroups8 ? i0 + r * st : i0; a[r] = ((const f32x4*)src)[2 * i]; b[r] = ((const f32x4*)src)[2 * i + 1]; }
#pragma unroll
        for (int r = 0; r < 4; ++r) { const size_t i = i0 + r * st; if (i >= ngroups8) break;
            u32x4 o; o.x = pk2(a[r].x, a[r].y); o.y = pk2(a[r].z, a[r].w); o.z = pk2(b[r].x, b[r].y); o.w = pk2(b[r].z, b[r].w); ((u32x4*)dst)[i] = o; }
    }
}
DI int pk4_fp8(float a, float b, float c, float d) { int w = 0; w = __builtin_amdgcn_cvt_pk_fp8_f32(a, b, w, false); w = __builtin_amdgcn_cvt_pk_fp8_f32(c, d, w, true); return w; }
DI void cvt_rows_fp8(const float* src, unsigned char* dst, float* scl, int nrows, int gw, int NGW, int lane) {
    for (int r0 = gw; r0 < nrows; r0 += 4 * NGW) {
        f32x4 a[4], b[4], c[4], d[4];
#pragma unroll
        for (int k = 0; k < 4; ++k) { const int r = r0 + k * NGW < nrows ? r0 + k * NGW : r0; const float* s = src + (size_t)r * 1024 + lane * 16;
            a[k] = *(const f32x4*)s; b[k] = *(const f32x4*)(s + 4); c[k] = *(const f32x4*)(s + 8); d[k] = *(const f32x4*)(s + 12); }
#pragma unroll
        for (int k = 0; k < 4; ++k) { const int r = r0 + k * NGW; if (r >= nrows) break;
            float mx = fmaxf(fmaxf(fmaxf(fabsf(a[k].x), fabsf(a[k].y)), fmaxf(fabsf(a[k].z), fabsf(a[k].w))), fmaxf(fmaxf(fabsf(b[k].x), fabsf(b[k].y)), fmaxf(fabsf(b[k].z), fabsf(b[k].w))));
            mx = fmaxf(mx, fmaxf(fmaxf(fmaxf(fabsf(c[k].x), fabsf(c[k].y)), fmaxf(fabsf(c[k].z), fabsf(c[k].w))), fmaxf(fmaxf(fabsf(d[k].x), fabsf(d[k].y)), fmaxf(fabsf(d[k].z), fabsf(d[k].w)))));
            mx = wave_max(mx);
            const float sc = mx > 0.f ? mx * (1.f / 448.f) : 1.f, inv = 1.f / sc;
            u32x4 o; o.x = (unsigned)pk4_fp8(a[k].x * inv, a[k].y * inv, a[k].z * inv, a[k].w * inv); o.y = (unsigned)pk4_fp8(b[k].x * inv, b[k].y * inv, b[k].z * inv, b[k].w * inv);
            o.z = (unsigned)pk4_fp8(c[k].x * inv, c[k].y * inv, c[k].z * inv, c[k].w * inv); o.w = (unsigned)pk4_fp8(d[k].x * inv, d[k].y * inv, d[k].z * inv, d[k].w * inv);
            *(u32x4*)(dst + (size_t)(lane >> 3) * PT_SLICE + (size_t)r * 128 + (lane & 7) * 16) = o;
            if (lane == 0) scl[r] = sc; }
    }
}
DI void rmsnorm_rows(const float* x, const float* g, bf16_t* H, int gw, int NGW, int lane, unsigned char* H8 = nullptr, float* HSI = nullptr) {
    const f32x4 g0 = *(const f32x4*)(g + lane * 8), g1 = *(const f32x4*)(g + lane * 8 + 4), g2 = *(const f32x4*)(g + 512 + lane * 8), g3 = *(const f32x4*)(g + 512 + lane * 8 + 4);
    for (int m0 = gw; m0 < T; m0 += 4 * NGW) {
        f32x4 a[4], b[4], c[4], d[4];
#pragma unroll
        for (int r = 0; r < 4; ++r) { const int m = m0 + r * NGW < T ? m0 + r * NGW : m0; const float* xr = x + (size_t)m * 1024 + lane * 8;
            a[r] = *(const f32x4*)xr; b[r] = *(const f32x4*)(xr + 4); c[r] = *(const f32x4*)(xr + 512); d[r] = *(const f32x4*)(xr + 516); }
#pragma unroll
        for (int r = 0; r < 4; ++r) { const int m = m0 + r * NGW; if (m >= T) break;
            float ss = a[r].x * a[r].x + a[r].y * a[r].y + a[r].z * a[r].z + a[r].w * a[r].w + b[r].x * b[r].x + b[r].y * b[r].y + b[r].z * b[r].z + b[r].w * b[r].w
                     + c[r].x * c[r].x + c[r].y * c[r].y + c[r].z * c[r].z + c[r].w * c[r].w + d[r].x * d[r].x + d[r].y * d[r].y + d[r].z * d[r].z + d[r].w * d[r].w;
            ss = wave_sum(ss);
            const float rr = rsqrtf(ss * (1.f / 1024.f) + 1e-6f);
            u32x4 o0, o1;
            o0.x = pk2(a[r].x * rr * g0.x, a[r].y * rr * g0.y); o0.y = pk2(a[r].z * rr * g0.z, a[r].w * rr * g0.w); o0.z = pk2(b[r].x * rr * g1.x, b[r].y * rr * g1.y); o0.w = pk2(b[r].z * rr * g1.z, b[r].w * rr * g1.w);
            o1.x = pk2(c[r].x * rr * g2.x, c[r].y * rr * g2.y); o1.y = pk2(c[r].z * rr * g2.z, c[r].w * rr * g2.w); o1.z = pk2(d[r].x * rr * g3.x, d[r].y * rr * g3.y); o1.w = pk2(d[r].z * rr * g3.z, d[r].w * rr * g3.w);
            bf16_t* hr = H + (size_t)m * 1024 + lane * 8; *(u32x4*)hr = o0; *(u32x4*)(hr + 512) = o1;
            if (H8) {
                float v[16] = {a[r].x * rr * g0.x, a[r].y * rr * g0.y, a[r].z * rr * g0.z, a[r].w * rr * g0.w, b[r].x * rr * g1.x, b[r].y * rr * g1.y, b[r].z * rr * g1.z, b[r].w * rr * g1.w,
                               c[r].x * rr * g2.x, c[r].y * rr * g2.y, c[r].z * rr * g2.z, c[r].w * rr * g2.w, d[r].x * rr * g3.x, d[r].y * rr * g3.y, d[r].z * rr * g3.z, d[r].w * rr * g3.w};
                float am = 0.f;
#pragma unroll
                for (int e = 0; e < 16; ++e) am = fmaxf(am, fabsf(v[e]));
                am = wave_max(am);
                const float hs = am > 0.f ? 224.f / am : 1.f;
                u32x2 q0, q1; q0.x = (unsigned)pk4_fp8(v[0] * hs, v[1] * hs, v[2] * hs, v[3] * hs); q0.y = (unsigned)pk4_fp8(v[4] * hs, v[5] * hs, v[6] * hs, v[7] * hs);
                q1.x = (unsigned)pk4_fp8(v[8] * hs, v[9] * hs, v[10] * hs, v[11] * hs); q1.y = (unsigned)pk4_fp8(v[12] * hs, v[13] * hs, v[14] * hs, v[15] * hs);
                unsigned char* h8 = H8 + (size_t)m * 1024 + lane * 8; *(u32x2*)h8 = q0; *(u32x2*)(h8 + 512) = q1;
                if (lane == 0) HSI[m] = 1.f / hs; } }
    }
}
DI void phase_prep_w(const Params& p, int l, const Frame& F) {
    LAS float* scr = (LAS float*)(F.lds + F.wave * 8448);
    const int gw = F.vb * 8 + F.wave, NGW = F.G * 8, lane = F.lane;
    unsigned char* ws = p.ws;
    bf16_t* WCAT = (bf16_t*)(ws + WS_WCAT); bf16_t* WBR = (bf16_t*)(ws + WS_WBR); bf16_t* WOUT4 = (bf16_t*)(ws + WS_WOUT4); bf16_t* WQ = (bf16_t*)(ws + WS_WQ);
    bf16_t* WPG = (bf16_t*)(ws + WS_WPG); bf16_t* WPP = (bf16_t*)(ws + WS_WPP); bf16_t* W1C = (bf16_t*)(ws + WS_W1C);
    constexpr int I0 = 2560, I1 = 2048, I2 = 1024, I3 = 512, I4 = 512, I5 = 512, I6 = 128, I7 = 512, NIT = I0 + I1 + I2 + I3 + I4 + I5 + I6 + I7;
    for (int it = gw; it < NIT; it += NGW) {
        int r = it;
        if (r < I0) { tr_item(p.in[I_WIN] + (size_t)l * 1024 * 5088, 5088, WCAT, 1024, (r / 160) * 64, (r % 160) * 32, scr, lane, true, 1, 0); continue; } r -= I0;
        if (r < I1) { tr_item(p.in[I_WGATE] + (size_t)l * 1024 * 4096, 4096, WCAT + (size_t)5120 * 1024, 1024, (r / 128) * 64, (r % 128) * 32, scr, lane, false, 1, 0); continue; } r -= I1;
        if (r < I2) { const int m = r >> 8, rr = r & 255; tr_item(p.in[I_WBR] + ((size_t)l * 2048 + m * 512) * 1024, 1024, WBR + (size_t)m * 1024 * 512, 512, (rr / 32) * 64, (rr % 32) * 32, scr, lane, false, 1, 0); continue; } r -= I2;
        if (r < I3) { tr_item(p.in[I_WOUT] + (size_t)l * 1024 * 1024, 1024, WOUT4, 1024, (r / 32) * 64, (r % 32) * 32, scr, lane, false, 1, 0); continue; } r -= I3;
        if (r < I4) { tr_item(p.in[I_WQ] + (size_t)l * 1024 * 1024, 1024, WQ, 1024, (r / 32) * 64, (r % 32) * 32, scr, lane, false, 1, 0); continue; } r -= I4;
        if (r < I5) { tr_item(p.in[I_WPG] + (size_t)l * 1024 * 1024, 1024, WPG, 1024, (r / 32) * 64, (r % 32) * 32, scr, lane, false, 1, 0); continue; } r -= I5;
        if (r < I6) { tr_item(p.in[I_WPP] + (size_t)l * 256 * 1024, 1024, WPP, 256, (r / 32) * 64, (r % 32) * 32, scr, lane, false, 1, 0); continue; } r -= I6;
        { const int jh = r >> 7, rr = r & 127, j = jh >> 1, half = jh & 1;
          tr_item(p.in[I_CW1] + (((size_t)l * 2 + j) * 2048 + half * 1024) * 256, 256, W1C + ((size_t)j * 512 + half * 256) * 1024, 1024, (rr / 8) * 64, (rr % 8) * 32, scr, lane, false, 1, 0); }
    }
    cvt_rows_fp8(p.in[I_PU] + (size_t)l * 16384 * 1024, ws + WS_PTU, (float*)(ws + WS_PTV), 16384, gw, NGW, lane);
    cvt_rows_fp8(p.in[I_PV] + (size_t)l * 16384 * 1024, ws + WS_PTU + 16 * MiB, (float*)(ws + WS_PTV) + 16384, 16384, gw, NGW, lane);
    cvt_rows(p.in[I_SUBK] + (size_t)l * 131072, (bf16_t*)(ws + WS_SK), 131072 / 8, gw, NGW, lane);
    cvt_rows(p.in[I_P] + (size_t)l * T * 256, (bf16_t*)(ws + WS_PB), (size_t)T * 256 / 8, gw, NGW, lane);
    { const float* sw = p.in[I_SGUW] + (size_t)l * 131072; bf16_t* dst = (bf16_t*)(ws + WS_SGUW);
      for (int i = gw * 64 + lane; i < 131072 / 8; i += NGW * 64) { const int e = i * 8, t = (e >> 7) & 127, s0 = e & 127; float v[8];
#pragma unroll
          for (int k = 0; k < 8; ++k) v[k] = (s0 + k <= t) ? sw[e + k] : 0.f;
          u32x4 o; o.x = pk2(v[0], v[1]); o.y = pk2(v[2], v[3]); o.z = pk2(v[4], v[5]); o.w = pk2(v[6], v[7]); ((u32x4*)dst)[i] = o; } }
    { float* peb = (float*)(ws + WS_PEB);
      for (int o = gw; o < 512; o += NGW) { const int j = o >> 8, n = o & 255; const float* pe = p.in[I_PE] + ((size_t)l * 2 + j) * 2048; const float* w1 = p.in[I_CW1] + ((size_t)l * 2 + j) * 2048 * 256;
          float s = 0.f; for (int k = lane; k < 2048; k += 64) s += pe[k] * w1[(size_t)k * 256 + n];
          s = wave_sum(s); if (lane == 0) peb[o] = s; } }
    rmsnorm_rows(l == 0 ? p.in[I_X] : p.out, p.in[I_GMIX] + l * 1024, (bf16_t*)(ws + WS_H), gw, NGW, lane);
}

struct Epi1 {
    static constexpr bool PERM = true, AFTER_DRAIN = false;
    bf16_t* proj; bf16_t* gates;
    DI void operator()(const f32x4 (&acc)[2][2][4][2], const pg8::Unit& u, int wr, int wc, int fr, int fq) const {
        const int row0 = u.pm * 256 + wr * 64 + fr; const bool isg = u.pn >= 20;
        const int col0 = (isg ? (u.pn - 20) * 256 : u.pn * 256) + wc * 32 + 8 * fq; bf16_t* base = isg ? gates : proj; const int ldc = isg ? 4096 : PW;
#pragma unroll
        for (int ai = 0; ai < 2; ++ai)
#pragma unroll
            for (int m = 0; m < 4; ++m) { bf16_t* rowp = base + (size_t)(row0 + ai * 128 + m * 16) * ldc + col0;
#pragma unroll
                for (int bj = 0; bj < 2; ++bj) { f32x4 v0 = acc[ai][bj][m][0], v1 = acc[ai][bj][m][1];
                    if (isg) { v0.x = sigm(v0.x); v0.y = sigm(v0.y); v0.z = sigm(v0.z); v0.w = sigm(v0.w); v1.x = sigm(v1.x); v1.y = sigm(v1.y); v1.z = sigm(v1.z); v1.w = sigm(v1.w); }
                    u32x4 w; w.x = pk2(v0.x, v0.y); w.y = pk2(v0.z, v0.w); w.z = pk2(v1.x, v1.y); w.w = pk2(v1.z, v1.w);
                    __builtin_nontemporal_store(w, (u32x4*)(rowp + bj * 128)); } }
    }
};
struct EpiBf {
    static constexpr bool PERM = true, AFTER_DRAIN = false;
    bf16_t* O; int ldc;
    DI void operator()(const f32x4 (&acc)[2][2][4][2], const pg8::Unit& u, int wr, int wc, int fr, int fq) const {
        const int row0 = u.pm * 256 + wr * 64 + fr, col0 = u.pn * 256 + wc * 32 + 8 * fq;
#pragma unroll
        for (int ai = 0; ai < 2; ++ai)
#pragma unroll
            for (int m = 0; m < 4; ++m) { bf16_t* rowp = O + (size_t)(row0 + ai * 128 + m * 16) * ldc + col0;
#pragma unroll
                for (int bj = 0; bj < 2; ++bj) { const f32x4 v0 = acc[ai][bj][m][0], v1 = acc[ai][bj][m][1];
                    u32x4 w; w.x = pk2(v0.x, v0.y); w.y = pk2(v0.z, v0.w); w.z = pk2(v1.x, v1.y); w.w = pk2(v1.z, v1.w);
                    *(u32x4*)(rowp + bj * 128) = w; } }
    }
};
struct EpiF32P {
    static constexpr bool PERM = true, AFTER_DRAIN = false;
    float* C; int ldc;
    DI void operator()(const f32x4 (&acc)[2][2][4][2], const pg8::Unit& u, int wr, int wc, int fr, int fq) const {
        const int row0 = u.pm * 256 + wr * 64 + fr, col0 = u.pn * 256 + wc * 32 + 8 * fq;
#pragma unroll
        for (int ai = 0; ai < 2; ++ai)
#pragma unroll
            for (int m = 0; m < 4; ++m) { float* rowp = C + (size_t)(row0 + ai * 128 + m * 16) * ldc + col0;
#pragma unroll
                for (int bj = 0; bj < 2; ++bj) { *(f32x4*)(rowp + bj * 128) = acc[ai][bj][m][0]; *(f32x4*)(rowp + bj * 128 + 4) = acc[ai][bj][m][1]; } }
    }
};
struct XcdColOrder {
    int G, c;
    DI bool next(int i, pg8::Unit& u) const {
        if (G != 256) { const int Lx = i * G + c; if (Lx >= 128 * 36) return false; u.pm = Lx / 36; u.pn = Lx % 36; return true; }
        if (i >= 18) return false;
        const int x = c & 7, w = c >> 3;
        if (i < 16) { u.pm = 8 * i + (w & 7); u.pn = 4 * x + (w >> 3); }
        else { u.pm = 16 * x + 8 * (i - 16) + (w & 7); u.pn = 32 + (w >> 3); }
        return true; }
    DI void a_ready(const pg8::Unit&) const {}
    DI void done(const pg8::Unit&) const {}
};
struct RoundOrder {
    pg8::StaticOrder base; int r;
    DI bool next(int i, pg8::Unit& u) const { return i == 0 && base.next(r, u); }
    DI void a_ready(const pg8::Unit&) const {}
    DI void done(const pg8::Unit&) const {}
};
struct ColRangeOrder {
    int G, c, c0, c1;
    DI bool next(int i, pg8::Unit& u) const { const int nc = c1 - c0; const int Lx = i * G + c; if (Lx >= 128 * nc) return false; u.pm = Lx / nc; u.pn = c0 + Lx % nc; return true; }
    DI void a_ready(const pg8::Unit&) const {}
    DI void done(const pg8::Unit&) const {}
};
struct BranchOrder {
    int G, c;
    DI bool next(int i, pg8::Unit& u) const { const int tile = c + G * (i >> 2), m = i & 3; if (tile >= 512) return false; u.pm = m * 128 + (tile >> 2); u.pn = m * 4 + (tile & 3); return true; }
    DI void a_ready(const pg8::Unit&) const {}
    DI void done(const pg8::Unit&) const {}
};
struct EpiBranch {
    static constexpr bool PERM = true, AFTER_DRAIN = false;
    const bf16_t* gates; bf16_t* merged;
    DI void operator()(const f32x4 (&acc)[2][2][4][2], const pg8::Unit& u, int wr, int wc, int fr, int fq) const {
        const int m4 = u.pn >> 2; const int row0 = (u.pm & 127) * 256 + wr * 64 + fr, gcol0 = u.pn * 256 + wc * 32 + 8 * fq, dcol0 = (u.pn & 3) * 256 + wc * 32 + 8 * fq;
#pragma unroll
        for (int ai = 0; ai < 2; ++ai) {
            u32x4 g[4][2], pr[4][2];
#pragma unroll
            for (int m = 0; m < 4; ++m)
#pragma unroll
                for (int bj = 0; bj < 2; ++bj) { g[m][bj] = *(const u32x4*)(gates + (size_t)(row0 + ai * 128 + m * 16) * 4096 + gcol0 + bj * 128);
                    if (m4 > 0) pr[m][bj] = *(const u32x4*)(merged + (size_t)(row0 + ai * 128 + m * 16) * 1024 + dcol0 + bj * 128); }
#pragma unroll
            for (int m = 0; m < 4; ++m)
#pragma unroll
                for (int bj = 0; bj < 2; ++bj) { const f32x4 v0 = acc[ai][bj][m][0], v1 = acc[ai][bj][m][1]; const u32x4 gg = g[m][bj];
                    f32x4 r0 = {v0.x * lo16(gg.x), v0.y * hi16(gg.x), v0.z * lo16(gg.y), v0.w * hi16(gg.y)}, r1 = {v1.x * lo16(gg.z), v1.y * hi16(gg.z), v1.z * lo16(gg.w), v1.w * hi16(gg.w)};
                    if (m4 > 0) { const u32x4 pp_ = pr[m][bj];
                        r0.x += lo16(pp_.x); r0.y += hi16(pp_.x); r0.z += lo16(pp_.y); r0.w += hi16(pp_.y); r1.x += lo16(pp_.z); r1.y += hi16(pp_.z); r1.z += lo16(pp_.w); r1.w += hi16(pp_.w); }
                    u32x4 w; w.x = pk2(r0.x, r0.y); w.y = pk2(r0.z, r0.w); w.z = pk2(r1.x, r1.y); w.w = pk2(r1.z, r1.w);
                    *(u32x4*)(merged + (size_t)(row0 + ai * 128 + m * 16) * 1024 + dcol0 + bj * 128) = w; }
        }
    }
};
struct EpiRes {
    static constexpr bool PERM = true, AFTER_DRAIN = false;
    const float* xin; float* out;
    DI void operator()(const f32x4 (&acc)[2][2][4][2], const pg8::Unit& u, int wr, int wc, int fr, int fq) const {
        const int row0 = u.pm * 256 + wr * 64 + fr, col0 = u.pn * 256 + wc * 32 + 8 * fq;
#pragma unroll
        for (int ai = 0; ai < 2; ++ai)
#pragma unroll
            for (int mh = 0; mh < 2; ++mh) {
                f32x4 xa[2][2][2];
#pragma unroll
                for (int m2 = 0; m2 < 2; ++m2)
#pragma unroll
                    for (int bj = 0; bj < 2; ++bj) { const size_t off = (size_t)(row0 + ai * 128 + (mh * 2 + m2) * 16) * 1024 + col0 + bj * 128; xa[m2][bj][0] = *(const f32x4*)(xin + off); xa[m2][bj][1] = *(const f32x4*)(xin + off + 4); }
#pragma unroll
                for (int m2 = 0; m2 < 2; ++m2)
#pragma unroll
                    for (int bj = 0; bj < 2; ++bj) { const size_t off = (size_t)(row0 + ai * 128 + (mh * 2 + m2) * 16) * 1024 + col0 + bj * 128;
                        *(f32x4*)(out + off) = xa[m2][bj][0] + acc[ai][bj][mh * 2 + m2][0]; *(f32x4*)(out + off + 4) = xa[m2][bj][1] + acc[ai][bj][mh * 2 + m2][1]; }
            }
    }
};
struct EpiPle {
    static constexpr bool PERM = true, AFTER_DRAIN = false;
    float* x; const bf16_t* pp; const float* ssq;
    DI void operator()(const f32x4 (&acc)[2][2][4][2], const pg8::Unit& u, int wr, int wc, int fr, int fq) const {
        const int row0 = u.pm * 256 + wr * 64 + fr, col0 = u.pn * 256 + wc * 32 + 8 * fq;
#pragma unroll
        for (int ai = 0; ai < 2; ++ai)
#pragma unroll
            for (int mh = 0; mh < 2; ++mh) {
                f32x4 xa[2][2][2]; u32x4 ga[2][2]; f32x4 sq[2][2];
#pragma unroll
                for (int m2 = 0; m2 < 2; ++m2) { const float* sp = ssq + (size_t)(row0 + ai * 128 + (mh * 2 + m2) * 16) * 8; sq[m2][0] = *(const f32x4*)sp; sq[m2][1] = *(const f32x4*)(sp + 4);
#pragma unroll
                    for (int bj = 0; bj < 2; ++bj) { const size_t off = (size_t)(row0 + ai * 128 + (mh * 2 + m2) * 16) * 1024 + col0 + bj * 128;
                        xa[m2][bj][0] = *(const f32x4*)(x + off); xa[m2][bj][1] = *(const f32x4*)(x + off + 4); ga[m2][bj] = *(const u32x4*)(pp + off); } }
#pragma unroll
                for (int m2 = 0; m2 < 2; ++m2) {
                    const float rr = rsqrtf((((sq[m2][0].x + sq[m2][0].y) + (sq[m2][0].z + sq[m2][0].w)) + ((sq[m2][1].x + sq[m2][1].y) + (sq[m2][1].z + sq[m2][1].w))) * (1.f / 1024.f) + 1e-6f);
#pragma unroll
                    for (int bj = 0; bj < 2; ++bj) { const size_t off = (size_t)(row0 + ai * 128 + (mh * 2 + m2) * 16) * 1024 + col0 + bj * 128;
                        const f32x4 v0 = acc[ai][bj][mh * 2 + m2][0] * rr, v1 = acc[ai][bj][mh * 2 + m2][1] * rr; const u32x4 g = ga[m2][bj]; f32x4 x0 = xa[m2][bj][0], x1 = xa[m2][bj][1];
                        x0.x += sigm(v0.x) * lo16(g.x); x0.y += sigm(v0.y) * hi16(g.x); x0.z += sigm(v0.z) * lo16(g.y); x0.w += sigm(v0.w) * hi16(g.y);
                        x1.x += sigm(v1.x) * lo16(g.z); x1.y += sigm(v1.y) * hi16(g.z); x1.z += sigm(v1.z) * lo16(g.w); x1.w += sigm(v1.w) * hi16(g.w);
                        *(f32x4*)(x + off) = x0; *(f32x4*)(x + off + 4) = x1; } }
            }
    }
};


DI void unpack8(const u32x4 w, float (&f)[8]) { f[0] = lo16(w.x); f[1] = hi16(w.x); f[2] = lo16(w.y); f[3] = hi16(w.y); f[4] = lo16(w.z); f[5] = hi16(w.z); f[6] = lo16(w.w); f[7] = hi16(w.w); }
DI u32x4 pack8(const float (&f)[8]) { u32x4 o; o.x = pk2(f[0], f[1]); o.y = pk2(f[2], f[3]); o.z = pk2(f[4], f[5]); o.w = pk2(f[6], f[7]); return o; }
DI void load8f(const float* p, float (&f)[8]) { const f32x4 a = *(const f32x4*)p, b = *(const f32x4*)(p + 4); f[0] = a.x; f[1] = a.y; f[2] = a.z; f[3] = a.w; f[4] = b.x; f[5] = b.y; f[6] = b.z; f[7] = b.w; }

DI void phase_chunk(const Params& p, int l, const Frame& F) {
    unsigned char* ws = p.ws; const int lane = F.lane, wave = F.wave;
    bf16_t* PROJ = (bf16_t*)(ws + WS_PROJ); bf16_t* YA = (bf16_t*)(ws + WS_Y); bf16_t* YC = YA + (size_t)2 * T * 512; bf16_t* CMPA = (bf16_t*)(ws + WS_CMPA);
    const bf16_t* SGUW = (const bf16_t*)(ws + WS_SGUW);
    LAS unsigned char* vnT = F.lds;
    const float* convw = p.in[I_CONVW] + (size_t)l * 3 * 512; const float* lng = p.in[I_LNG] + (size_t)l * 512; const float* sgub = p.in[I_SGUB] + (size_t)l * 8 * 128;
    float cw0[8], cw1[8], cw2[8], lgn[8];
    load8f(convw + lane * 8, cw0); load8f(convw + 512 + lane * 8, cw1); load8f(convw + 1024 + lane * 8, cw2); load8f(lng + lane * 8, lgn);
    for (int chunk = F.vb; chunk < T / 128; chunk += F.G) {
        const int t0 = chunk * 128;
        for (int tt = wave; tt < 128; tt += 8) {
            const int t = t0 + tt, s = t & (SEQ - 1), b = t >> 12;
            bf16_t* row = PROJ + (size_t)t * PW;
            const int c0 = lane * 8;
            const u32x4 z = {0u, 0u, 0u, 0u};
            const u32x4 rab = *(const u32x4*)(row + C_AB + c0), rc0 = *(const u32x4*)(row + C_AC + c0), rx0 = *(const u32x4*)(row + C_AX + c0);
            u32x4 r1c = z, r1x = z, r2c = z, r2x = z;
            if (s >= 1) { r1c = *(const u32x4*)(row - PW + C_AC + c0); r1x = *(const u32x4*)(row - PW + C_AX + c0); }
            if (s >= 2) { r2c = *(const u32x4*)(row - 2 * PW + C_AC + c0); r2x = *(const u32x4*)(row - 2 * PW + C_AX + c0); }
            u32x4 segv[3]; int segcol[3]; const float* seggp[3]; float segsc[3];
#pragma unroll
            for (int pass = 0; pass < 3; ++pass) {
                const int seg = pass * 8 + (lane >> 3), sg = seg < 20 ? seg : 20; int col; const float* gp; float sc = 1.f;
                if (sg < 8) { col = C_NQ + 64 * sg; gp = p.in[I_NQG] + l * 64; sc = 0.125f * 1.44269504f; }
                else if (sg < 10) { col = C_NKV + 2 * 128 + (sg - 8) * 64; gp = p.in[I_NKG] + (l * 3 + 1) * 64; }
                else if (sg < 12) { col = C_NKV + 4 * 128 + (sg - 10) * 64; gp = p.in[I_NKG] + (l * 3 + 2) * 64; }
                else if (sg < 20) { col = C_DQ + 64 * (sg - 12); gp = p.in[I_DQG] + l * 64; sc = 0.125f * 1.44269504f; }
                else { col = C_DK; gp = p.in[I_DKG] + l * 64; }
                segcol[pass] = col; seggp[pass] = gp; segsc[pass] = sc; segv[pass] = *(const u32x4*)(row + col + (lane & 7) * 8);
            }
            u32x4 rawc = z; const bf16_t* rawsrc = row; bf16_t* rawdst = nullptr;
            if (lane < 48) { const int sgc = lane >> 3;
                if (sgc < 2) { rawsrc = row + C_NKV + 3 * 128 + sgc * 64; rawdst = (bf16_t*)(ws + WS_VS) + ((size_t)((b * 2 + sgc) * SEQ + s)) * 64; }
                else if (sgc < 4) { rawsrc = row + C_NKV + 5 * 128 + (sgc - 2) * 64; rawdst = (bf16_t*)(ws + WS_VW) + ((size_t)((b * 2 + (sgc - 2)) * SEQ + s)) * 64; }
                else if (sgc == 4) { rawsrc = row + C_DV; rawdst = (bf16_t*)(ws + WS_DV) + (size_t)t * 64; }
                else { rawsrc = row + C_DKI; rawdst = (bf16_t*)(ws + WS_DKI) + (size_t)t * 64; }
                rawc = *(const u32x4*)(rawsrc + (lane & 7) * 8); }
            u32x4 cmpc = z;
            if (lane < 32) { const int jg = lane >> 3; cmpc = *(const u32x4*)(row + C_NKV + (jg >> 1) * 128 + (jg & 1) * 64 + (lane & 7) * 8); }
            const u32x4 ruv = *(const u32x4*)(row + C_UV + 512 + lane * 8);
            {
                float ab[8], c0v[8], x0v[8], c1v[8], x1v[8], c2v[8], x2v[8], y[8];
                unpack8(rab, ab); unpack8(rc0, c0v); unpack8(rx0, x0v); unpack8(r1c, c1v); unpack8(r1x, x1v); unpack8(r2c, c2v); unpack8(r2x, x2v);
#pragma unroll
                for (int e = 0; e < 8; ++e) y[e] = ab[e] * (cw2[e] * c0v[e] * x0v[e] + cw1[e] * c1v[e] * x1v[e] + cw0[e] * c2v[e] * x2v[e]);
                *(u32x4*)(YA + (size_t)t * 512 + c0) = pack8(y);
            }
#pragma unroll
            for (int pass = 0; pass < 3; ++pass) {
                const int seg = pass * 8 + (lane >> 3), part = lane & 7, sg = seg < 20 ? seg : 20;
                float v[8], g[8]; unpack8(segv[pass], v); load8f(seggp[pass] + part * 8, g);
                float ss = 0.f;
#pragma unroll
                for (int e = 0; e < 8; ++e) ss += v[e] * v[e];
                ss = oct_sumf(ss);
                const float r = rsqrtf(ss * (1.f / 64.f) + 1e-6f) * segsc[pass];
#pragma unroll
                for (int e = 0; e < 8; ++e) v[e] = v[e] * r * g[e];
                bf16_t* dstp = row + segcol[pass] + part * 8;
                if (sg >= 8 && sg < 10) dstp = (bf16_t*)(ws + WS_KS) + ((size_t)((b * 2 + (sg - 8)) * SEQ + s)) * 64 + part * 8;
                else if (sg >= 10 && sg < 12) dstp = (bf16_t*)(ws + WS_KW) + ((size_t)((b * 2 + (sg - 10)) * SEQ + s)) * 64 + part * 8;
                else if (sg == 20) dstp = (bf16_t*)(ws + WS_DK) + (size_t)t * 64 + part * 8;
                if (seg < 21) *(u32x4*)dstp = pack8(v);
            }
            if (lane < 48) *(u32x4*)(rawdst + (lane & 7) * 8) = rawc;
            if (lane < 32) { const int jg = lane >> 3, j = jg >> 1, g = jg & 1, part = lane & 7;
                *(u32x4*)(CMPA + ((size_t)j * 4096 + ((size_t)(b * 256 + (s >> 4)) * 2 + g)) * 1024 + (s & 15) * 64 + part * 8) = cmpc; }
            {
                float v[8]; unpack8(ruv, v);
                float sm = 0.f;
#pragma unroll
                for (int e = 0; e < 8; ++e) { v[e] = gelu_t(v[e]); sm += v[e]; }
                const float mean = wave_sum(sm) * (1.f / 512.f); float sq = 0.f;
#pragma unroll
                for (int e = 0; e < 8; ++e) { v[e] -= mean; sq += v[e] * v[e]; }
                const float r = rsqrtf(wave_sum(sq) * (1.f / 512.f) + 1e-6f);
#pragma unroll
                for (int e = 0; e < 8; ++e) *(LAS unsigned short*)(vnT + (lane * 8 + e) * 272 + tt * 2) = (unsigned short)f2bf(v[e] * r * lgn[e]);
            }
        }
        __syncthreads();
        {
            const int g = wave, c = lane & 15, q = lane >> 4; const bf16_t* Wg = SGUW + (size_t)g * 128 * 128;
            for (int tt16 = 0; tt16 < 8; ++tt16) {
                const int nk = (tt16 >> 1) + 1;
                bf16x8 bw[4];
#pragma unroll
                for (int kk = 0; kk < 4; ++kk) bw[kk] = *(const bf16x8*)(Wg + (size_t)(16 * tt16 + c) * 128 + 32 * (kk < nk ? kk : 0) + 8 * q);
                const int t = t0 + 16 * tt16 + c; const float bias = sgub[g * 128 + 16 * tt16 + c];
#pragma unroll
                for (int dt = 0; dt < 4; ++dt) {
                    f32x4 acc = {0.f, 0.f, 0.f, 0.f};
#pragma unroll
                    for (int kk = 0; kk < 4; ++kk) if (kk < nk) { const bf16x8 a = *(const LAS bf16x8*)(vnT + (g * 64 + 16 * dt + c) * 272 + (32 * kk + 8 * q) * 2); acc = MFMA16(a, bw[kk], acc); }
                    const int ch = g * 64 + 16 * dt + 4 * q;
                    const u32x2 uu = *(const u32x2*)(PROJ + (size_t)t * PW + C_UV + ch);
                    u32x2 o; o.x = pk2(gelu_t(lo16(uu.x)) * (acc[0] + bias), gelu_t(hi16(uu.x)) * (acc[1] + bias)); o.y = pk2(gelu_t(lo16(uu.y)) * (acc[2] + bias), gelu_t(hi16(uu.y)) * (acc[3] + bias));
                    *(u32x2*)(YC + (size_t)t * 512 + ch) = o;
                }
            }
        }
        __syncthreads();
    }
}

DI void phase_cmp2(const Params& p, int l, const Frame& F) {
    unsigned char* ws = p.ws; const int lane = F.lane; const int gw = F.vb * 8 + F.wave, NGW = F.G * 8;
    LAS float* hid = (LAS float*)(F.lds + 131072 + F.wave * 1024);
    LAS float* w2s = (LAS float*)F.lds;
    { const float* w2g = p.in[I_CW2] + (size_t)l * 2 * 256 * 64;
      for (int i = F.tid; i < 2 * 256 * 64 / 4; i += 512) *(LAS f32x4*)(w2s + i * 4) = *(const f32x4*)(w2g + i * 4); }
    __syncthreads();
    const float* CMPP = (const float*)(ws + WS_CMPP); const float* peb = (const float*)(ws + WS_PEB);
    bf16_t* CMPK = (bf16_t*)(ws + WS_CMPK); bf16_t* CMPV = (bf16_t*)(ws + WS_CMPV);
    const float* kg = p.in[I_NKG] + (l * 3 + 0) * 64;
    for (int it = gw; it < 8 * 256 * 2 * 2; it += NGW) {
        const int j = it & 1, g = (it >> 1) & 1, n = (it >> 2) & 255, b = it >> 10;
        bf16_t* dst = (j ? CMPV : CMPK) + ((size_t)(b * 2 + g) * 256 + n) * 64;
        if (n == 255) { dst[lane] = 0; continue; }
        const float* Pa = CMPP + ((size_t)j * 4096 + (size_t)(b * 256 + n) * 2 + g) * 512; const float* Pb = CMPP + ((size_t)j * 4096 + (size_t)(b * 256 + n + 1) * 2 + g) * 512 + 256;
        const f32x4 a = *(const f32x4*)(Pa + lane * 4), bq = *(const f32x4*)(Pb + lane * 4), pe = *(const f32x4*)(peb + j * 256 + lane * 4);
        f32x4 h; h.x = gelu_t(a.x + bq.x + pe.x); h.y = gelu_t(a.y + bq.y + pe.y); h.z = gelu_t(a.z + bq.z + pe.z); h.w = gelu_t(a.w + bq.w + pe.w);
        *(LAS f32x4*)(hid + lane * 4) = h;
        LDS_WAIT();
        const LAS float* w2 = w2s + j * 256 * 64;
        float o = 0.f;
#pragma unroll 16
        for (int k = 0; k < 256; ++k) o += hid[k] * w2[k * 64 + lane];
        if (j == 0) { const float ss = wave_sum(o * o); o = o * rsqrtf(ss * (1.f / 64.f) + 1e-6f) * kg[lane]; }
        dst[lane] = (bf16_t)f2bf(o);
        LDS_WAIT();
    }
}

DI int bucket_fast(int n) { const int big = 16 + (int)((__log2f((float)n) - 4.f) * 2.6666667f + 2e-4f); return n < 16 ? n : (big < 31 ? big : 31); }
struct KsCmp { static constexpr bool CONTIG = true; static constexpr int DSTEP = 16, DMAX = 1 << 30; const bf16_t* kb; const bf16_t* vb; int t0, hb;
    DI void base(int k0, const bf16_t*& k, const bf16_t*& v) const { k = kb + (size_t)k0 * 64; v = vb + (size_t)k0 * 64; }
    DI int dist0(int k0, int c) const { return t0 + (c >> 2) - (16 * k0 + 31); } };
struct KsSel { static constexpr bool CONTIG = true; static constexpr int DSTEP = 1, DMAX = 1 << 30; const bf16_t* kb; const bf16_t* vb; const LAS int* selb; int t, hb;
    DI int p0(int k0) const { return __builtin_amdgcn_readfirstlane(selb[k0 >> 6]) * 64 + (k0 & 63); }
    DI void base(int k0, const bf16_t*& k, const bf16_t*& v) const { const int ps = p0(k0); k = kb + (size_t)ps * 64; v = vb + (size_t)ps * 64; }
    DI int dist0(int k0, int c) const { return t - p0(k0); } };
struct KsWin { static constexpr bool CONTIG = true; static constexpr int DSTEP = 1, DMAX = 512; const bf16_t* kb; const bf16_t* vb; int pstart, t0, hb;
    DI void base(int k0, const bf16_t*& k, const bf16_t*& v) const { k = kb + (size_t)(pstart + k0) * 64; v = vb + (size_t)(pstart + k0) * 64; }
    DI int dist0(int k0, int c) const { return t0 + (c >> 2) - (pstart + k0); } };
struct KsDsa { static constexpr bool CONTIG = false; static constexpr int DSTEP = 1, DMAX = 1 << 30; const bf16_t* kb; const bf16_t* vb; const LAS int* list; int n, t;
    DI int pos(int idx) const { return idx < n ? list[idx] : -1; }
    DI const bf16_t* krow(int idx) const { const int ps = pos(idx); return kb + (size_t)(ps < 0 ? 0 : ps) * 64; }
    DI const bf16_t* vrow(int idx) const { const int ps = pos(idx); return vb + (size_t)(ps < 0 ? 0 : ps) * 64; }
    DI float adjust(int idx, int c, float s, bool& ok, const LAS unsigned char* buck, const LAS float* tbl) const {
        const int ps = pos(idx); ok = ps >= 0 && ps <= t; const int dd = t - ps; const int dc = ok ? (dd < 1023 ? dd : 1023) : 0; return s + tbl[buck[dc] * 16 + 8 + (c & 7)]; } };

template <int MODE, class KS>
DI void flash_run(const KS& ks, int nkeys, const bf16x8 (&qb)[2], f32x4 (&o)[4], float& m_run, float& l_run, LAS unsigned char* vt, LAS float* al, LAS float* pn,
                  const LAS unsigned char* buck, const LAS float* tbl, int lane) {
    const int c = lane & 15, q = lane >> 4;
    bf16x8 A00, A01, A10, A11, B00, B01, B10, B11; u32x4 Av[4], Bv[4];
#define FL_LOAD(B_, kk0) do { if constexpr (KS::CONTIG) { const bf16_t* kbp_; const bf16_t* vbp_; ks.base((kk0), kbp_, vbp_); const bf16_t* kr0 = kbp_ + c * 64 + 8 * q; \
            B_##00 = *(const bf16x8*)kr0; B_##01 = *(const bf16x8*)(kr0 + 32); B_##10 = *(const bf16x8*)(kr0 + 1024); B_##11 = *(const bf16x8*)(kr0 + 1056); \
            if (MODE != 1) { const bf16_t* vr0 = vbp_ + (lane >> 3) * 64 + (lane & 7) * 8; _Pragma("unroll") for (int m = 0; m < 4; ++m) B_##v[m] = *(const u32x4*)(vr0 + m * 512); } } \
        else { const bf16_t* kr0 = ks.krow((kk0) + c); const bf16_t* kr1 = ks.krow((kk0) + 16 + c); \
            B_##00 = *(const bf16x8*)(kr0 + 8 * q); B_##01 = *(const bf16x8*)(kr0 + 32 + 8 * q); B_##10 = *(const bf16x8*)(kr1 + 8 * q); B_##11 = *(const bf16x8*)(kr1 + 32 + 8 * q); \
            if (MODE != 1) { _Pragma("unroll") for (int m = 0; m < 4; ++m) B_##v[m] = *(const u32x4*)(ks.vrow((kk0) + (lane >> 3) + 8 * m) + (lane & 7) * 8); } } } while (0)
#define FL_STEP(B_, K0_) do { \
        f32x4 s0 = {0.f, 0.f, 0.f, 0.f}, s1 = {0.f, 0.f, 0.f, 0.f}; \
        s0 = MFMA16(B_##00, qb[0], s0); s0 = MFMA16(B_##01, qb[1], s0); s1 = MFMA16(B_##10, qb[0], s1); s1 = MFMA16(B_##11, qb[1], s1); \
        float sv[8], pv[8]; bool ok[8]; \
        if constexpr (KS::CONTIG) { \
            const LAS float* trow = tbl + (c & 3) * 1024; const int d0 = ks.dist0((K0_), c) - KS::DSTEP * 4 * q; \
        _Pragma("unroll") \
            for (int i = 0; i < 4; ++i) { const int da = d0 - KS::DSTEP * i, db = da - KS::DSTEP * 16; \
                ok[i] = da >= 0 && da < KS::DMAX; ok[4 + i] = db >= 0 && db < KS::DMAX; \
                sv[i] = s0[i] + trow[da < 0 ? 0 : (da < 1023 ? da : 1023)]; sv[4 + i] = s1[i] + trow[db < 0 ? 0 : (db < 1023 ? db : 1023)]; } \
        } else { \
        _Pragma("unroll") \
            for (int i = 0; i < 4; ++i) { sv[i] = ks.adjust((K0_) + 4 * q + i, c, s0[i], ok[i], buck, tbl); sv[4 + i] = ks.adjust((K0_) + 16 + 4 * q + i, c, s1[i], ok[4 + i], buck, tbl); } \
        } \
        if (MODE == 2) { \
        _Pragma("unroll") \
            for (int e = 0; e < 8; ++e) { pv[e] = ok[e] ? __builtin_amdgcn_exp2f(sv[e]) * l_run : 0.f; \
                const float x = quad_sumf(pv[e]); \
                if ((c & 3) == 0) pn[(c >> 2) * 256 + (K0_) + (e < 4 ? 4 * q + e : 16 + 4 * q + (e - 4))] = x; } \
        } else { \
            float ps = 0.f; \
        _Pragma("unroll") \
            for (int e = 0; e < 8; ++e) { pv[e] = ok[e] ? __builtin_amdgcn_exp2f(sv[e]) : 0.f; ps += pv[e]; } \
            l_run += ps; \
        } \
        if (MODE != 1) { \
        _Pragma("unroll") \
            for (int m = 0; m < 4; ++m) *(LAS u32x4*)(vt + ((lane >> 3) + 8 * m) * 144 + (lane & 7) * 16) = B_##v[m]; \
            LDS_FENCE(); \
            const bf16x8 pa = __builtin_bit_cast(bf16x8, pack8(pv)); \
        _Pragma("unroll") \
            for (int dt = 0; dt < 4; ++dt) { \
                const s16x4 lo = __builtin_amdgcn_ds_read_tr16_b64_v4i16((LAS s16x4*)(vt + (4 * q + (c >> 2)) * 144 + (16 * dt + 4 * (c & 3)) * 2)); \
                const s16x4 hi = __builtin_amdgcn_ds_read_tr16_b64_v4i16((LAS s16x4*)(vt + (16 + 4 * q + (c >> 2)) * 144 + (16 * dt + 4 * (c & 3)) * 2)); \
                const bf16x8 vb8 = __builtin_shufflevector(lo, hi, 0, 1, 2, 3, 4, 5, 6, 7); \
                o[dt] = MFMA16(pa, vb8, o[dt]); \
            } \
            LDS_FENCE(); \
        } \
    } while (0)
    if (nkeys > 0) FL_LOAD(A, 0);
    for (int k0 = 0; k0 < nkeys; k0 += 64) {
        if (k0 + 32 < nkeys) FL_LOAD(B, k0 + 32);
        FL_STEP(A, k0);
        if (k0 + 32 >= nkeys) break;
        if (k0 + 64 < nkeys) FL_LOAD(A, k0 + 64);
        FL_STEP(B, k0 + 32);
    }
#undef FL_STEP
#undef FL_LOAD
    if (MODE == 0) {
        float lt = x32_sum(x16_sum(l_run));
        const float inv = lt > 0.f ? __builtin_amdgcn_rcpf(lt) : 0.f;
        if (q == 0) al[c] = inv;
        LDS_WAIT();
        const f32x4 a4 = *(const LAS f32x4*)(al + 4 * q);
#pragma unroll
        for (int dt = 0; dt < 4; ++dt) o[dt] = o[dt] * a4;
        LDS_WAIT();
    }
}

DI void nsa_tile(const Params& p, int b, int g, int tb, const Frame& F, const LAS float* lut, int vm = 0) {
    unsigned char* ws = p.ws; const int lane = F.lane, wave = F.wave, c = lane & 15, q = lane >> 4;
    const LAS float* tbl = lut + g * 4096;
    LAS unsigned char* wl = F.lds + wave * 9216; LAS unsigned char* vt = wl; LAS float* al = (LAS float*)(wl + 4608); LAS float* pn = (LAS float*)(wl + 4736);
    LAS float* OS = (LAS float*)F.lds; LAS float* LS = (LAS float*)(F.lds + 65536);
    LAS int* SELB = (LAS int*)(F.lds + 73728); LAS int* CNT = (LAS int*)(F.lds + 75776); LAS unsigned short* UNIT = (LAS unsigned short*)(F.lds + 76032); LAS int* NUNIT = (LAS int*)(F.lds + 76416);
    volatile LAS int* TURN = (volatile LAS int*)(F.lds + 76544); LAS unsigned short* LIST = (LAS unsigned short*)(F.lds + 76800);
    LAS unsigned char* vt2 = F.lds + 84992 + wave * 4608;
    const bf16_t* prow0 = (const bf16_t*)(ws + WS_PROJ) + (size_t)(b * SEQ) * PW;
    bf16_t* YB = (bf16_t*)(ws + WS_Y) + (size_t)T * 512;
    const f32x4 z4 = {0.f, 0.f, 0.f, 0.f};
    for (int ii = 0; ii < 2; ++ii) {
        f32x4 accw[4];
        const int item = wave * 2 + ii, t0 = 64 * tb + 4 * item;
#pragma unroll
        for (int k = 0; k < 4; ++k) *(LAS f32x4*)(pn + lane * 4 + 256 * k) = z4;
        bf16x8 qb[2];
        { const bf16_t* qp = prow0 + (size_t)(t0 + (c >> 2)) * PW + C_NQ + (g * 4 + (c & 3)) * 64 + 8 * q; qb[0] = *(const bf16x8*)qp; qb[1] = *(const bf16x8*)(qp + 32); }
        float g0[4], g2[4];
        { const u32x2 ga = *(const u32x2*)(prow0 + (size_t)(t0 + q) * PW + C_NG + 0 * 8 + g * 4), gc = *(const u32x2*)(prow0 + (size_t)(t0 + q) * PW + C_NG + 2 * 8 + g * 4);
          g0[0] = sigm(lo16(ga.x)); g0[1] = sigm(hi16(ga.x)); g0[2] = sigm(lo16(ga.y)); g0[3] = sigm(hi16(ga.y));
          g2[0] = sigm(lo16(gc.x)); g2[1] = sigm(hi16(gc.x)); g2[2] = sigm(lo16(gc.y)); g2[3] = sigm(hi16(gc.y)); }
#pragma unroll
        for (int dt = 0; dt < 4; ++dt) accw[dt] = z4;
        LDS_WAIT();
        const int tl = t0 + 3, nv = tl >= 31 ? ((tl - 31) >> 4) + 1 : 0;
        if (nv > 0 && (vm == 0 || (vm & 1))) {
            const int nk = (nv + 31) & ~31;
            KsCmp ks{(const bf16_t*)(ws + WS_CMPK) + (size_t)(b * 2 + g) * 256 * 64, (const bf16_t*)(ws + WS_CMPV) + (size_t)(b * 2 + g) * 256 * 64, t0, g * 4};
            float m = 0.f, lr = 0.f; f32x4 o[4] = {z4, z4, z4, z4};
            flash_run<1>(ks, nk, qb, o, m, lr, vt, al, pn, (const LAS unsigned char*)vt, tbl, lane);
            lr = x32_sum(x16_sum(lr)); lr = lr > 0.f ? __builtin_amdgcn_rcpf(lr) : 0.f;
            flash_run<2>(ks, nk, qb, o, m, lr, vt, al, pn, (const LAS unsigned char*)vt, tbl, lane);
#pragma unroll
            for (int dt = 0; dt < 4; ++dt) { accw[dt][0] = g0[0] * o[dt][0]; accw[dt][1] = g0[1] * o[dt][1]; accw[dt][2] = g0[2] * o[dt][2]; accw[dt][3] = g0[3] * o[dt][3]; }
        }
        LDS_WAIT();
        {
            const int j = lane; float val[4];
#pragma unroll
            for (int qi = 0; qi < 4; ++qi) {
                if (j == 0 || j == tb) val[qi] = 1e4f;
                else if (j < tb) { const LAS float* pq = pn + qi * 256 + 4 * j; val[qi] = pq[-1] + pq[0] + pq[1] + pq[2] + pq[3]; }
                else val[qi] = -1e30f;
            }
            for (int k = 0; k < 8; ++k) {
#pragma unroll
                for (int qi = 0; qi < 4; ++qi) {
                    const float mx = wave_max(val[qi]); const unsigned long long who = __ballot(val[qi] == mx); const int w = __builtin_ctzll(who);
                    if (lane == 0) SELB[(item * 4 + qi) * 8 + k] = mx > -1e29f ? w : -1;
                    if (lane == w) val[qi] = -3e38f;
                }
            }
        }
        {
            const int pstart = t0 >= 511 ? t0 - 511 : 0, nk = (t0 + 3 - pstart + 1 + 31) & ~31;
            KsWin ks{(const bf16_t*)(ws + WS_KW) + (size_t)(b * 2 + g) * SEQ * 64, (const bf16_t*)(ws + WS_VW) + (size_t)(b * 2 + g) * SEQ * 64, pstart, t0, g * 4};
            float m = 0.f, lr = 0.f; f32x4 o[4] = {z4, z4, z4, z4};
            if (vm == 0 || (vm & 2)) flash_run<0>(ks, nk, qb, o, m, lr, vt, al, pn, (const LAS unsigned char*)vt, tbl, lane);
            if (vm & 4) { flash_run<1>(ks, nk, qb, o, m, lr, vt, al, pn, (const LAS unsigned char*)vt, tbl, lane); o[0][0] += lr; }
#pragma unroll
            for (int dt = 0; dt < 4; ++dt) { accw[dt][0] += g2[0] * o[dt][0]; accw[dt][1] += g2[1] * o[dt][1]; accw[dt][2] += g2[2] * o[dt][2]; accw[dt][3] += g2[3] * o[dt][3]; }
        }
        if (vm == 0) {
            bf16_t* dst = YB + (size_t)(b * SEQ + t0 + q) * 512 + (g * 4) * 64 + c;
#pragma unroll
            for (int dt = 0; dt < 4; ++dt)
#pragma unroll
                for (int i = 0; i < 4; ++i) dst[i * 64 + 16 * dt] = (bf16_t)f2bf(accw[dt][i]);
        }
        else { asm volatile("" :: "v"(accw[0]), "v"(accw[1]), "v"(accw[2]), "v"(accw[3])); }
        LDS_WAIT();
    }
    __syncthreads();
    if (vm != 0) return;
    for (int i = F.tid; i < 66560 / 16; i += 512) *(LAS f32x4*)(F.lds + i * 16) = z4;
    if (F.tid < 64) { CNT[F.tid] = 0; TURN[F.tid] = 0; }
    __syncthreads();
    { const int blk = SELB[F.tid];
      if (blk >= 0) { int rank = 0;
#pragma unroll
          for (int k = 0; k < 8; ++k) { const int ob = SELB[(F.tid & ~7) + k]; rank += (ob >= 0 && ob < blk) ? 1 : 0; }
          const int pos = __hip_atomic_fetch_add(CNT + blk, 1, __ATOMIC_RELAXED, __HIP_MEMORY_SCOPE_WORKGROUP); LIST[blk * 64 + pos] = (unsigned short)((F.tid >> 3) | (rank << 8)); } }
    __syncthreads();
    if (wave == 0) {
        const int uj = (CNT[lane] + 3) >> 2; int inc = uj;
#pragma unroll
        for (int o_ = 1; o_ < 64; o_ <<= 1) { const int v = __shfl_up(inc, o_); if (lane >= o_) inc += v; }
        const int offs = inc - uj;
        for (int u = 0; u < uj; ++u) UNIT[offs + u] = (unsigned short)(lane | (u << 8));
        if (lane == 63) NUNIT[0] = inc;
    }
    __syncthreads();
    {
        const int nu = NUNIT[0];
        const LAS float* trow = tbl + (c & 3) * 1024;
        const bf16_t* KSb = (const bf16_t*)(ws + WS_KS) + (size_t)(b * 2 + g) * SEQ * 64; const bf16_t* VSb = (const bf16_t*)(ws + WS_VS) + (size_t)(b * 2 + g) * SEQ * 64;
        for (int ui = wave; ui < nu; ui += 8) {
            const int uu = UNIT[ui], j = uu & 255, u = uu >> 8, nj = CNT[j];
            const int slot = 4 * u + (c >> 2); const int qrow = slot < nj ? (int)(LIST[j * 64 + slot] & 255) : -1;
            const int slotq = 4 * u + q; const int qo = slotq < nj ? (int)(LIST[j * 64 + slotq] & 255) : -1;
            bf16x8 qs[2] = {(bf16x8){0, 0, 0, 0, 0, 0, 0, 0}, (bf16x8){0, 0, 0, 0, 0, 0, 0, 0}};
            if (qrow >= 0) { const bf16_t* qp = prow0 + (size_t)(64 * tb + qrow) * PW + C_NQ + (g * 4 + (c & 3)) * 64 + 8 * q; qs[0] = *(const bf16x8*)qp; qs[1] = *(const bf16x8*)(qp + 32); }
            const bf16_t* kb0 = KSb + (size_t)(64 * j) * 64; const bf16_t* vb0 = VSb + (size_t)(64 * j) * 64;
            bf16x8 ka[4]; u32x4 vv[4];
#define SEL_LOADK(st) do { const bf16_t* kr0 = kb0 + (32 * (st) + c) * 64 + 8 * q; ka[0] = *(const bf16x8*)kr0; ka[1] = *(const bf16x8*)(kr0 + 32); ka[2] = *(const bf16x8*)(kr0 + 1024); ka[3] = *(const bf16x8*)(kr0 + 1056); } while (0)
#define SEL_LOADV(st) do { const bf16_t* vr0 = vb0 + (32 * (st) + (lane >> 3)) * 64 + (lane & 7) * 8; _Pragma("unroll") for (int m = 0; m < 4; ++m) vv[m] = *(const u32x4*)(vr0 + m * 512); } while (0)
            SEL_LOADK(0); SEL_LOADV(0);
            f32x4 o[4] = {z4, z4, z4, z4}; float lsum = 0.f;
#pragma unroll
            for (int st = 0; st < 2; ++st) {
                f32x4 s0 = z4, s1 = z4;
                s0 = MFMA16(ka[0], qs[0], s0); s0 = MFMA16(ka[1], qs[1], s0); s1 = MFMA16(ka[2], qs[0], s1); s1 = MFMA16(ka[3], qs[1], s1);
                if (st == 0) SEL_LOADK(1);
                const int d0 = 64 * (tb - j) + (qrow < 0 ? 0 : qrow) - 32 * st - 4 * q; float pv[8];
#pragma unroll
                for (int i = 0; i < 4; ++i) { const int da = d0 - i, db = da - 16;
                    const float ea = __builtin_amdgcn_exp2f(s0[i] + trow[da < 0 ? 0 : (da < 1023 ? da : 1023)]), eb = __builtin_amdgcn_exp2f(s1[i] + trow[db < 0 ? 0 : (db < 1023 ? db : 1023)]);
                    pv[i] = (qrow >= 0 && da >= 0) ? ea : 0.f; pv[4 + i] = (qrow >= 0 && db >= 0) ? eb : 0.f; lsum += pv[i] + pv[4 + i]; }
#pragma unroll
                for (int m = 0; m < 4; ++m) *(LAS u32x4*)(vt2 + ((lane >> 3) + 8 * m) * 144 + (lane & 7) * 16) = vv[m];
                if (st == 0) SEL_LOADV(1);
                LDS_FENCE();
                const bf16x8 pa = __builtin_bit_cast(bf16x8, pack8(pv));
#pragma unroll
                for (int dt = 0; dt < 4; ++dt) {
                    const s16x4 lo = __builtin_amdgcn_ds_read_tr16_b64_v4i16((LAS s16x4*)(vt2 + (4 * q + (c >> 2)) * 144 + (16 * dt + 4 * (c & 3)) * 2));
                    const s16x4 hi = __builtin_amdgcn_ds_read_tr16_b64_v4i16((LAS s16x4*)(vt2 + (16 + 4 * q + (c >> 2)) * 144 + (16 * dt + 4 * (c & 3)) * 2));
                    o[dt] = MFMA16(pa, __builtin_shufflevector(lo, hi, 0, 1, 2, 3, 4, 5, 6, 7), o[dt]);
                }
                LDS_FENCE();
            }
#undef SEL_LOADK
#undef SEL_LOADV
            lsum = x32_sum(x16_sum(lsum));
#pragma unroll 1
            for (int s = 0; s < 4; ++s) {
                if (4 * u + s >= nj) break;
                const int ent = LIST[j * 64 + 4 * u + s], qs_ = ent & 255, rk = ent >> 8;
                unsigned spins = 0;
                while (TURN[qs_] != rk) { __builtin_amdgcn_s_sleep(1); if (++spins > (1u << 22)) break; }
                if (q == s) {
#pragma unroll
                    for (int dt = 0; dt < 4; ++dt)
#pragma unroll
                        for (int i = 0; i < 4; ++i) OS[(qs_ * 4 + i) * 64 + 16 * dt + c] += o[dt][i];
                }
                if ((c >> 2) == s && q == 0) LS[qs_ * 4 + (c & 3)] += lsum;
                LDS_WAIT();
                if (lane == 0) TURN[qs_] = rk + 1;
                LDS_WAIT();
            }
        }
    }
    __syncthreads();
    for (int ii = 0; ii < 2; ++ii) {
        const int item = wave * 2 + ii, qq = item * 4 + q, t = 64 * tb + qq;
        const u32x2 gg = *(const u32x2*)(prow0 + (size_t)t * PW + C_NG + 8 + g * 4);
        const float g1[4] = {sigm(lo16(gg.x)), sigm(hi16(gg.x)), sigm(lo16(gg.y)), sigm(hi16(gg.y))};
        const f32x4 l4 = *(const LAS f32x4*)(LS + qq * 4);
        const float inv[4] = {l4.x > 0.f ? g1[0] / l4.x : 0.f, l4.y > 0.f ? g1[1] / l4.y : 0.f, l4.z > 0.f ? g1[2] / l4.z : 0.f, l4.w > 0.f ? g1[3] / l4.w : 0.f};
        bf16_t* dst = YB + (size_t)(b * SEQ + t) * 512 + (g * 4) * 64 + c;
#pragma unroll
        for (int dt = 0; dt < 4; ++dt)
#pragma unroll
            for (int i = 0; i < 4; ++i) dst[i * 64 + 16 * dt] = (bf16_t)f2bf(bf2f(dst[i * 64 + 16 * dt]) + inv[i] * OS[(qq * 4 + i) * 64 + 16 * dt + c]);
    }
    __syncthreads();
}

DI void dsa_group(const Params& p, int b, int t0, const Frame& F, const LAS unsigned char* buck, const LAS float* tbl, int parts = 7) {
    unsigned char* ws = p.ws; const int lane = F.lane, wave = F.wave, c = lane & 15, q = lane >> 4;
    LAS unsigned* SC = (LAS unsigned*)F.lds;
    LAS int* list = (LAS int*)(F.lds + 131072 + wave * 1024); LAS float* al = (LAS float*)(F.lds + 139264 + wave * 64);
    const bf16_t* prow0 = (const bf16_t*)(ws + WS_PROJ) + (size_t)(b * SEQ) * PW;
    bf16_t* YD = (bf16_t*)(ws + WS_Y) + (size_t)3 * T * 512;
    const bf16x8 zf = {0, 0, 0, 0, 0, 0, 0, 0};
    const int t = t0 + wave; const bf16_t* qrow = prow0 + (size_t)t * PW;
    const bf16_t* dki = (const bf16_t*)(ws + WS_DKI) + (size_t)(b * SEQ) * 64;
    const bool full = t0 >= 256;
    if (full && (parts & 1)) {
        bf16x8 qa[4][2]; float wv[4][4];
#pragma unroll
        for (int rt = 0; rt < 4; ++rt) { const bf16_t* qp = prow0 + (size_t)(t0 + 2 * rt + (c >> 3)) * PW + C_DQI + (c & 7) * 64 + 8 * q; qa[rt][0] = *(const bf16x8*)qp; qa[rt][1] = *(const bf16x8*)(qp + 32);
            const u32x2 w4 = *(const u32x2*)(prow0 + (size_t)(t0 + 2 * rt + (q >> 1)) * PW + C_DWI + (q & 1) * 4);
            wv[rt][0] = lo16(w4.x) * 0.35355339f; wv[rt][1] = hi16(w4.x) * 0.35355339f; wv[rt][2] = lo16(w4.y) * 0.35355339f; wv[rt][3] = hi16(w4.y) * 0.35355339f; }
        const int ntile = ((t0 + 7) >> 4) + 1, nk64 = ((t0 + 7) >> 6) + 1;
        bf16x8 kx0, kx1;
        if (wave < ntile) { const bf16_t* kp = dki + (size_t)(16 * wave + c) * 64 + 8 * q; kx0 = *(const bf16x8*)kp; kx1 = *(const bf16x8*)(kp + 32); }
        for (int tau = wave; tau < ntile; tau += 8) {
            const bf16x8 kb0 = kx0, kb1 = kx1;
            if (tau + 8 < ntile) { const bf16_t* kp = dki + (size_t)(16 * (tau + 8) + c) * 64 + 8 * q; kx0 = *(const bf16x8*)kp; kx1 = *(const bf16x8*)(kp + 32); }
            const int key = 16 * tau + c;
#pragma unroll
            for (int rt = 0; rt < 4; ++rt) {
                f32x4 acc = {0.f, 0.f, 0.f, 0.f};
                acc = MFMA16(qa[rt][0], kb0, acc); acc = MFMA16(qa[rt][1], kb1, acc);
                float s = wv[rt][0] * fmaxf(acc[0], 0.f) + wv[rt][1] * fmaxf(acc[1], 0.f) + wv[rt][2] * fmaxf(acc[2], 0.f) + wv[rt][3] * fmaxf(acc[3], 0.f);
                s = x16_sum(s);
                const int qq = 2 * rt + (q >> 1);
                if ((q & 1) == 0) SC[qq * 4096 + key] = key <= t0 + qq ? ordf(s) : 0u;
            }
        }
        for (int i = F.tid; i < 8 * 64; i += 512) { const int key = ntile * 16 + (i & 63); if (key < nk64 * 64) SC[(i >> 6) * 4096 + key] = 0u; }
    }
    __syncthreads();
    int n;
    if (!full) { n = t + 1; for (int i = lane; i < 256; i += 64) list[i] = i <= t ? i : -1; }
    else if (parts & 2) {
        n = 256;
        const LAS unsigned* sc = SC + wave * 4096; const int nk64 = (t >> 6) + 1;
        unsigned u[64];
#pragma unroll
        for (int k = 0; k < 64; ++k) u[k] = k < nk64 ? sc[k * 64 + lane] : 0u;
#define WAVE_TOTAL(cl, tot) do { tot = __builtin_amdgcn_readfirstlane((int)wave_sum_u(cl)); } while (0)
        unsigned prefix = 0u;
        const int nk8 = __builtin_amdgcn_readfirstlane((nk64 + 7) >> 3);
#define CNT_GE(NK) _Pragma("unroll") for (int k = 0; k < NK; ++k) cl += (u[k] >= cand) ? 1u : 0u;
        for (int bit = 31; bit >= 0; --bit) {
            const unsigned cand = prefix | (1u << bit); unsigned cl = 0u; int cnt;
            switch (nk8) { case 1: CNT_GE(8) break; case 2: CNT_GE(16) break; case 3: CNT_GE(24) break; case 4: CNT_GE(32) break;
                           case 5: CNT_GE(40) break; case 6: CNT_GE(48) break; case 7: CNT_GE(56) break; default: CNT_GE(64) break; }
            WAVE_TOTAL(cl, cnt);
            if (cnt >= 256) { prefix = cand; if (cnt == 256) break; }
        }
        int cgt; { unsigned cl = 0u;
#pragma unroll
            for (int k = 0; k < 64; ++k) cl += (u[k] > prefix) ? 1u : 0u;
            WAVE_TOTAL(cl, cgt); }
#undef WAVE_TOTAL
#undef CNT_GE
        const int need_eq = 256 - cgt; int base = 0, eqbase = 0;
#pragma unroll
        for (int k = 0; k < 64; ++k) {
            if (k < nk64) {
                const bool gtp = u[k] > prefix, eq = u[k] == prefix;
                const unsigned long long meq = __ballot(eq);
                const int eqrank = eqbase + (int)__builtin_amdgcn_mbcnt_hi((unsigned)(meq >> 32), __builtin_amdgcn_mbcnt_lo((unsigned)meq, 0u));
                const bool take = gtp || (eq && eqrank < need_eq);
                const unsigned long long mt = __ballot(take);
                const int slot = base + (int)__builtin_amdgcn_mbcnt_hi((unsigned)(mt >> 32), __builtin_amdgcn_mbcnt_lo((unsigned)mt, 0u));
                if (take && slot < 256) list[slot] = k * 64 + lane;
                base += __popcll(mt); eqbase += __popcll(meq);
            }
        }
    }
    else n = 256;
    LDS_WAIT();
    if (!(parts & 4)) { __syncthreads(); return; }
    LAS unsigned char* vt = F.lds + wave * 16384;
    bf16x8 qd[2] = {zf, zf};
    if (c < 8) { qd[0] = *(const bf16x8*)(qrow + C_DQ + c * 64 + 8 * q); qd[1] = *(const bf16x8*)(qrow + C_DQ + c * 64 + 32 + 8 * q); }
    KsDsa ks{(const bf16_t*)(ws + WS_DK) + (size_t)(b * SEQ) * 64, (const bf16_t*)(ws + WS_DV) + (size_t)(b * SEQ) * 64, list, n, t};
    const f32x4 z4 = {0.f, 0.f, 0.f, 0.f};
    float m = -1e30f, lr = 0.f; f32x4 o[4] = {z4, z4, z4, z4};
    flash_run<0>(ks, (n + 31) & ~31, qd, o, m, lr, vt, al, (LAS float*)vt, buck, tbl, lane);
    if (q < 2) {
#pragma unroll
        for (int dt = 0; dt < 4; ++dt)
#pragma unroll
            for (int i = 0; i < 4; ++i) YD[(size_t)(b * SEQ + t) * 512 + (4 * q + i) * 64 + 16 * dt + c] = (bf16_t)f2bf(o[dt][i]);
    }
    __syncthreads();
}

DI void phase_attn(const Params& p, int l, const Frame& F, int mask = 3, int parts = 15) {
    const int gw = F.vb * 8 + F.wave, NGW = F.G * 8; const float* rel = p.in[I_REL];
#ifndef MK_ATTN
#define MK_ATTN 3
#endif
    if ((MK_ATTN & 1) && (mask & 1)) {
        LAS float* lut = (LAS float*)(F.lds + 130048);
        for (int i = F.tid; i < 8 * 1024; i += 512) { const int h = i >> 10, d = i & 1023; lut[i] = rel[bucket_of(d) * 16 + h] * 1.44269504f; }
        __syncthreads();
        for (int it = F.vb; it < 8 * 2 * 64; it += F.G) { const int b = it >> 7, g = (it >> 6) & 1; int tb = it & 63; if (b & 1) tb = 63 - tb; nsa_tile(p, b, g, tb, F, lut, (parts >> 8) & 15); }
    }
    __syncthreads();
    LAS unsigned char* buck = F.lds + 139776; LAS float* tbl = (LAS float*)(F.lds + 140800);
    for (int i = F.tid; i < 1024; i += 512) buck[i] = (unsigned char)bucket_of(i);
    tbl[F.tid] = rel[F.tid] * 1.44269504f;
    __syncthreads();
    if ((MK_ATTN & 2) && (mask & 2)) for (int it = F.vb; it < 8 * 512; it += F.G) { const int b = it >> 9; int tg = it & 511; if (b & 1) tg = 511 - tg; dsa_group(p, b, tg * 8, F, buck, tbl, parts); }
}


#ifndef MK_PROBE
#define MK_PROBE 0
#endif

DI unsigned row16_maxu(unsigned m) { unsigned o;
    o = (unsigned)DPP_I((int)m, 0xB1); m = m > o ? m : o; o = (unsigned)DPP_I((int)m, 0x4E); m = m > o ? m : o;
    o = (unsigned)DPP_I((int)m, 0x141); m = m > o ? m : o; o = (unsigned)DPP_I((int)m, 0x140); m = m > o ? m : o; return m; }
DI void peer_route_tile(const Params& p, int t0, int lane) {
    unsigned char* ws = p.ws; const int c = lane & 15, q = lane >> 4;
    const bf16_t* QP = (const bf16_t*)(ws + WS_QP); const bf16_t* SK = (const bf16_t*)(ws + WS_SK); int* EIDX = (int*)(ws + WS_EIDX); float* EW = (float*)(ws + WS_EW);
    float* EU = (float*)(ws + WS_EU); const float* USr = (const float*)(ws + WS_PTV); const float* VSr = USr + 16384;
    int ca[4], cb[4]; bool cv[4];
    ca[0] = 0; cb[0] = c; cv[0] = true;
    ca[1] = c < 8 ? 1 : (c < 13 ? 2 : 3); cb[1] = c < 8 ? c : (c < 13 ? c - 8 : c - 13); cv[1] = true;
    { const int ci = 32 + c; int a_, b_;
      if (ci == 32) { a_ = 3; b_ = 3; } else if (ci < 36) { a_ = 4; b_ = ci - 33; } else if (ci < 42) { a_ = 5 + ((ci - 36) >> 1); b_ = (ci - 36) & 1; } else { a_ = 8 + (ci - 42); b_ = 0; }
      ca[2] = a_; cb[2] = b_; cv[2] = true; }
    ca[3] = c < 2 ? 14 + c : 0; cb[3] = 0; cv[3] = c < 2;
    for (int h = 0; h < 8; ++h) {
        unsigned top[2][4];
#pragma unroll
        for (int pp = 0; pp < 2; ++pp) {
            const int hp = h * 2 + pp;
            const bf16_t* ap = QP + (size_t)(t0 + c) * 1024 + hp * 64 + 8 * q;
            const bf16x8 a0 = *(const bf16x8*)ap, a1 = *(const bf16x8*)(ap + 32);
            unsigned v[4][8];
#pragma unroll
            for (int kt = 0; kt < 8; ++kt) { const bf16_t* bp = SK + ((size_t)hp * 128 + 16 * kt + c) * 64 + 8 * q;
                const bf16x8 b0 = *(const bf16x8*)bp, b1 = *(const bf16x8*)(bp + 32);
                f32x4 acc = {0.f, 0.f, 0.f, 0.f}; acc = MFMA16(a0, b0, acc); acc = MFMA16(a1, b1, acc);
#pragma unroll
                for (int i = 0; i < 4; ++i) v[i][kt] = (ordf(acc[i]) & 0xFFFFFF80u) | (unsigned)(127 - (16 * kt + c)); }
            { unsigned mine[4] = {0u, 0u, 0u, 0u};
#define CE_(a, b) { const unsigned hi_ = v[i][a] > v[i][b] ? v[i][a] : v[i][b], lo_ = v[i][a] > v[i][b] ? v[i][b] : v[i][a]; v[i][a] = hi_; v[i][b] = lo_; }
#pragma unroll
              for (int i = 0; i < 4; ++i) { CE_(0, 1) CE_(2, 3) CE_(4, 5) CE_(6, 7) CE_(0, 2) CE_(1, 3) CE_(4, 6) CE_(5, 7) CE_(1, 2) CE_(5, 6) CE_(0, 4) CE_(3, 7) CE_(1, 5) CE_(2, 6) CE_(1, 4) CE_(3, 6) CE_(2, 4) CE_(3, 5) CE_(3, 4) }
#undef CE_
              for (int r = 0; r < 16; ++r) {
#pragma unroll
                  for (int i = 0; i < 4; ++i) { const unsigned m = row16_maxu(v[i][0]); mine[i] = (c == r) ? m : mine[i];
                      const bool win = v[i][0] == m;
#pragma unroll
                      for (int kt = 0; kt < 7; ++kt) v[i][kt] = win ? v[i][kt + 1] : v[i][kt];
                      v[i][7] = win ? 0u : v[i][7]; } }
#pragma unroll
              for (int i = 0; i < 4; ++i) top[pp][i] = mine[i]; }
        }
        unsigned cd[4][4], mine2[4] = {0u, 0u, 0u, 0u}; int i0v[4], i1v[4];
#pragma unroll
        for (int i = 0; i < 4; ++i) {
            const float s0 = unordf(top[0][i] & 0xFFFFFF80u), s1 = unordf(top[1][i] & 0xFFFFFF80u);
            i0v[i] = 127 - (int)(top[0][i] & 127u); i1v[i] = 127 - (int)(top[1][i] & 127u);
#pragma unroll
            for (int k = 0; k < 4; ++k) { const float s0a = __shfl(s0, (lane & 48) | ca[k]), s1b = __shfl(s1, (lane & 48) | cb[k]);
                cd[i][k] = cv[k] ? ((ordf(s0a + s1b) & 0xFFFFFF00u) | (unsigned)(255 - (ca[k] * 16 + cb[k]))) : 0u; }
        }
#define CE_(a, b) { const unsigned hi_ = cd[i][a] > cd[i][b] ? cd[i][a] : cd[i][b], lo_ = cd[i][a] > cd[i][b] ? cd[i][b] : cd[i][a]; cd[i][a] = hi_; cd[i][b] = lo_; }
#pragma unroll
        for (int i = 0; i < 4; ++i) { CE_(0, 1) CE_(2, 3) CE_(0, 2) CE_(1, 3) CE_(1, 2) }
#undef CE_
        for (int r = 0; r < 16; ++r) {
#pragma unroll
            for (int i = 0; i < 4; ++i) { const unsigned m = row16_maxu(cd[i][0]); mine2[i] = (c == r) ? m : mine2[i];
                const bool win = cd[i][0] == m;
#pragma unroll
                for (int k = 0; k < 3; ++k) cd[i][k] = win ? cd[i][k + 1] : cd[i][k];
                cd[i][3] = win ? 0u : cd[i][3]; }
        }
#pragma unroll
        for (int i = 0; i < 4; ++i) {
            const unsigned mine = mine2[i];
            const int pr = 255 - (int)(mine & 255u); const int ea = __shfl(i0v[i], (lane & 48) | (pr >> 4)), eb = __shfl(i1v[i], (lane & 48) | (pr & 15));
            const float scv = unordf(mine & 0xFFFFFF00u);
            const float mx = row16_maxf(scv);
            const float e = __expf(scv - mx); const float sm = row16_sumf(e);
            const size_t o = (size_t)(t0 + 4 * q + i) * 128 + h * 16 + c;
            const int eid = ea * 128 + eb; EIDX[o] = eid; EW[o] = (e / sm) * VSr[eid]; EU[o] = USr[eid];
        }
    }
}
#define MFMA8(a, b, c) __builtin_amdgcn_mfma_f32_16x16x32_fp8_fp8((a), (b), (c), 0, 0, 0)
DI long lo64(const u32x4 v) { return (long)(((unsigned long long)v.y << 32) | v.x); }
DI long hi64(const u32x4 v) { return (long)(((unsigned long long)v.w << 32) | v.z); }
template <int OFF> DI void peer_dma_o(const unsigned char* src, LAS unsigned char* dst) { __builtin_amdgcn_global_load_lds((const unsigned*)src, (LAS unsigned*)(dst - OFF), 16, OFF, 0); }
#define PEER_RD(slot_) (*(const LAS u32x4*)(ring + 1024 * (slot_) + 16 * lane))
#define PEER_VMW(n_) asm volatile("s_waitcnt vmcnt(" #n_ ")" ::: "memory")
struct PeerStream { int u0, ustep, n, xfix; bool al; };
DI PeerStream peer_stream(const Frame& F) { PeerStream s; const int bx = blockIdx.x; s.al = (F.G & 7) == 0; s.u0 = s.al ? (bx >> 3) * 8 + F.wave : bx * 8 + F.wave; s.ustep = s.al ? F.G : F.G * 8;
    const int nu = s.al ? T : T * 8; s.n = (nu - s.u0 + s.ustep - 1) / s.ustep; s.xfix = bx & 7; return s; }
DI void peer_unit(const PeerStream& s, int k, int& t, int& x) { const int u = s.u0 + (k < s.n ? k : s.n - 1) * s.ustep; t = s.al ? u : u >> 3; x = s.al ? s.xfix : u & 7; }

DI void phase_peer_u(const Params& p, const Frame& F) {
    unsigned char* ws = p.ws; const int lane = F.lane, c = lane & 15, q = lane >> 4, c8 = lane & 7, r8 = lane >> 3;
    LAS unsigned char* wl = F.lds + F.wave * LDS_PERWAVE; LAS float* pdl = (LAS float*)wl; LAS unsigned char* ring = wl + 512; LAS unsigned char* meta = wl + 512 + 16384;
    const PeerStream S = peer_stream(F);
    const unsigned char* EIDX = ws + WS_EIDX; const unsigned char* H8 = ws + WS_H8; float* PD = (float*)(ws + WS_PD); const unsigned char* PTU = ws + WS_PTU;
    const int p0 = ((c >> 1) + q) & 7, p1 = (p0 + 4) & 7;
    const int rdo = 1024 * (c >> 3) + 128 * (c & 7);
    int t, x;
#define PU_META(k_, slot_) do { peer_unit(S, (k_), t, x); const unsigned char* s_ = lane < 32 ? EIDX + (size_t)t * 512 + 16 * lane : H8 + (size_t)t * 1024 + 128 * x + 16 * (lane & 7); peer_dma_o<0>(s_, meta + 1024 * (slot_)); } while (0)
#define PU_RD(g_, pc_) (*(const LAS u32x4*)(ring + 2048 * (g_) + rdo + 16 * (pc_)))
    PU_META(0, 0); PU_META(1, 1);
    asm volatile("s_waitcnt vmcnt(0)" ::: "memory");
    u32x4 in_[4], hc0, hc1, hn0, hn1;
    { u32x4 i0_[4];
#pragma unroll
      for (int v_ = 0; v_ < 4; ++v_) i0_[v_] = *(const LAS u32x4*)(meta + 64 * r8 + 16 * v_);
      hn0 = *(const LAS u32x4*)(meta + 512 + 16 * p0); hn1 = *(const LAS u32x4*)(meta + 512 + 16 * p1);
      peer_unit(S, 0, t, x); const unsigned char* tb = PTU + (size_t)x * PT_SLICE + 16 * c8;
#define PU_D0(j) peer_dma_o<0>(tb + (size_t)i0_[(j) >> 2][(j) & 3] * 128, ring + 1024 * (j))
      PU_D0(0); PU_D0(1); PU_D0(2); PU_D0(3); PU_D0(4); PU_D0(5); PU_D0(6); PU_D0(7); PU_D0(8); PU_D0(9); PU_D0(10); PU_D0(11); PU_D0(12); PU_D0(13); PU_D0(14); PU_D0(15);
#undef PU_D0
    }
    PEER_VMW(12);
    u32x4 ra[2], rb[2];
#pragma unroll
    for (int i = 0; i < 2; ++i) { ra[i] = PU_RD(i, p0); rb[i] = PU_RD(i, p1); }
    const f32x4 z4 = {0.f, 0.f, 0.f, 0.f};
    for (int k = 0; k < S.n; ++k) {
        int tc, xc; peer_unit(S, k, tc, xc);
        hc0 = hn0; hc1 = hn1;
        { LAS unsigned char* m1 = meta + 1024 * ((k + 1) & 1);
#pragma unroll
          for (int v_ = 0; v_ < 4; ++v_) in_[v_] = *(const LAS u32x4*)(m1 + 64 * r8 + 16 * v_);
          hn0 = *(const LAS u32x4*)(m1 + 512 + 16 * p0); hn1 = *(const LAS u32x4*)(m1 + 512 + 16 * p1); }
        LDS_WAIT(); PU_META(k + 2, k & 1);
        peer_unit(S, k + 1, t, x);
        const unsigned char* tbn = PTU + (size_t)x * PT_SLICE + 16 * c8;
#define PU_GRP(g) do { if ((g) < 6) PEER_VMW(11); else PEER_VMW(10); const u32x4 na = PU_RD(((g) + 2) & 7, p0), nb = PU_RD(((g) + 2) & 7, p1); \
            f32x4 acc = MFMA8(lo64(ra[(g) & 1]), lo64(hc0), z4); acc = MFMA8(hi64(ra[(g) & 1]), hi64(hc0), acc); acc = MFMA8(lo64(rb[(g) & 1]), lo64(hc1), acc); acc = MFMA8(hi64(rb[(g) & 1]), hi64(hc1), acc); \
            asm volatile("" :: "v"(ra[(g) & 1]), "v"(rb[(g) & 1])); \
            peer_dma_o<0>(tbn + (size_t)in_[(2 * (g)) >> 2][(2 * (g)) & 3] * 128, ring + 2048 * (g)); peer_dma_o<0>(tbn + (size_t)in_[(2 * (g) + 1) >> 2][(2 * (g) + 1) & 3] * 128, ring + 2048 * (g) + 1024); \
            ra[(g) & 1] = na; rb[(g) & 1] = nb; \
            { const float d01 = (c & 1) ? acc[1] : acc[0], d23 = (c & 1) ? acc[3] : acc[2], dg = (c & 2) ? d23 : d01; if (q == (c >> 2)) pdl[16 * (c & 7) + 2 * (g) + (c >> 3)] = dg; } } while (0)
        PU_GRP(0); PU_GRP(1); PU_GRP(2); PU_GRP(3); PU_GRP(4); PU_GRP(5); PU_GRP(6); PU_GRP(7);
#undef PU_GRP
        { const u32x2 pv = *(const LAS u32x2*)(pdl + 2 * lane); *(u32x2*)(PD + ((size_t)xc * T + tc) * 128 + 2 * lane) = pv; }
    }
#undef PU_META
#undef PU_RD
    asm volatile("s_waitcnt vmcnt(0) lgkmcnt(0)" ::: "memory");
}

DI void phase_peer_coef(const Params& p, const Frame& F) {
    unsigned char* ws = p.ws; const float* PD = (const float*)(ws + WS_PD); const float* EW = (const float*)(ws + WS_EW); const float* EU = (const float*)(ws + WS_EU);
    const float* HSI = (const float*)(ws + WS_HSI); float* COEF = (float*)(ws + WS_COEF);
    const size_t NT = (size_t)F.G * 512;
    for (size_t i0 = (size_t)F.vb * 512 + F.tid; i0 < (size_t)T * 128; i0 += 4 * NT) {
        float d[4][8], ew[4], eu[4], hs[4];
#pragma unroll
        for (int r = 0; r < 4; ++r) { size_t i = i0 + r * NT; if (i >= (size_t)T * 128) i = i0; const int t = (int)(i >> 7), pp = (int)(i & 127);
#pragma unroll
            for (int x = 0; x < 8; ++x) d[r][x] = PD[((size_t)x * T + t) * 128 + pp];
            ew[r] = EW[i]; eu[r] = EU[i]; hs[r] = HSI[t]; }
#pragma unroll
        for (int r = 0; r < 4; ++r) { const size_t i = i0 + r * NT; if (i >= (size_t)T * 128) break;
            const float dot = ((d[r][0] + d[r][1]) + (d[r][2] + d[r][3])) + ((d[r][4] + d[r][5]) + (d[r][6] + d[r][7]));
            COEF[i] = ew[r] * gelu_t(dot * eu[r] * hs[r]); }
    }
}

DI void phase_peer_v(const Params& p, const Frame& F, const float* xin, float* xout, const float* gple, bool fuse) {
    unsigned char* ws = p.ws; const int lane = F.lane, c8 = lane & 7, r8 = lane >> 3;
    LAS unsigned char* wl = F.lds + F.wave * LDS_PERWAVE; LAS unsigned char* ring = wl; LAS unsigned char* meta = wl + 16384; LAS unsigned char* xs = wl + 16384 + 2048;
    const PeerStream S = peer_stream(F);
    const unsigned char* EIDX = ws + WS_EIDX; const unsigned char* COEF = ws + WS_COEF; const unsigned char* PTV = ws + WS_PTU + 16 * MiB;
    typedef float f32x2_t __attribute__((ext_vector_type(2)));
    int colofs;
    { const auto ra = __builtin_amdgcn_permlane32_swap(0u, 8u, false, false); const unsigned ta = ra[0];
      const auto rb = __builtin_amdgcn_permlane16_swap(ta, ta + 4u, false, false); const unsigned tb = rb[0];
      colofs = (int)tb + ((lane & 8) ? 2 : 0); }
    LAS float* gl = (LAS float*)(F.lds + 8 * LDS_PERWAVE);
    for (int i = F.tid; i < 1024; i += 512) gl[i] = gple[i];
    __syncthreads();
    bf16_t* Hn = (bf16_t*)(ws + WS_H); float* SSQ = (float*)(ws + WS_SSQ);
    int t, x;
#define PV_META(k_, slot_) do { peer_unit(S, (k_), t, x); const unsigned char* s_ = (lane < 32 ? EIDX : COEF) + (size_t)t * 512 + 16 * (lane & 31); peer_dma_o<0>(s_, meta + 1024 * (slot_)); } while (0)
#define PV_XS(k_, slot_) do { peer_unit(S, (k_), t, x); if (lane < 32) peer_dma_o<0>((const unsigned char*)(xin + (size_t)t * 1024 + 128 * x) + 16 * lane, xs + 512 * (slot_)); } while (0)
    PV_META(0, 0); PV_META(1, 1); PV_XS(0, 0);
    asm volatile("s_waitcnt vmcnt(0)" ::: "memory");
    u32x4 in_[4]; f32x4 cf[4], cn[4];
    { u32x4 i0_[4];
#pragma unroll
      for (int v_ = 0; v_ < 4; ++v_) { i0_[v_] = *(const LAS u32x4*)(meta + 64 * r8 + 16 * v_); cn[v_] = *(const LAS f32x4*)(meta + 512 + 64 * r8 + 16 * v_); }
      peer_unit(S, 0, t, x); const unsigned char* tb = PTV + (size_t)x * PT_SLICE + 16 * c8;
#define PV_D0(j) peer_dma_o<0>(tb + (size_t)i0_[(j) >> 2][(j) & 3] * 128, ring + 1024 * (j))
      PV_D0(0); PV_D0(1); PV_D0(2); PV_D0(3); PV_D0(4); PV_D0(5); PV_D0(6); PV_D0(7); PV_D0(8); PV_D0(9); PV_D0(10); PV_D0(11); PV_D0(12); PV_D0(13); PV_D0(14); PV_D0(15);
#undef PV_D0
    }
    PEER_VMW(12);
    u32x4 rr[4];
#pragma unroll
    for (int i = 0; i < 4; ++i) rr[i] = PEER_RD(i);
    for (int k = 0; k < S.n; ++k) {
        int tc, xc; peer_unit(S, k, tc, xc);
#pragma unroll
        for (int v_ = 0; v_ < 4; ++v_) cf[v_] = cn[v_];
        { LAS unsigned char* m1 = meta + 1024 * ((k + 1) & 1);
#pragma unroll
          for (int v_ = 0; v_ < 4; ++v_) { in_[v_] = *(const LAS u32x4*)(m1 + 64 * r8 + 16 * v_); cn[v_] = *(const LAS f32x4*)(m1 + 512 + 64 * r8 + 16 * v_); } }
        LDS_WAIT(); PV_META(k + 2, k & 1);
        PV_XS(k + 1, (k + 1) & 1);
        peer_unit(S, k + 1, t, x);
        const unsigned char* tbn = PTV + (size_t)x * PT_SLICE + 16 * c8;
        f32x2_t out[8];
#pragma unroll
        for (int e = 0; e < 8; ++e) out[e] = (f32x2_t){0.f, 0.f};
#define PV_STEP(j) do { if ((j) < 12) PEER_VMW(13); else PEER_VMW(11); const u32x4 nw = PEER_RD(((j) + 4) & 15); \
            const u32x4 pv_ = rr[(j) & 3]; const float c1_ = cf[(j) >> 2][(j) & 3]; const f32x2_t cc = {c1_, c1_}; \
            out[0] += cc * __builtin_amdgcn_cvt_pk_f32_fp8((int)pv_.x, false); out[1] += cc * __builtin_amdgcn_cvt_pk_f32_fp8((int)pv_.x, true); \
            out[2] += cc * __builtin_amdgcn_cvt_pk_f32_fp8((int)pv_.y, false); out[3] += cc * __builtin_amdgcn_cvt_pk_f32_fp8((int)pv_.y, true); \
            out[4] += cc * __builtin_amdgcn_cvt_pk_f32_fp8((int)pv_.z, false); out[5] += cc * __builtin_amdgcn_cvt_pk_f32_fp8((int)pv_.z, true); \
            out[6] += cc * __builtin_amdgcn_cvt_pk_f32_fp8((int)pv_.w, false); out[7] += cc * __builtin_amdgcn_cvt_pk_f32_fp8((int)pv_.w, true); \
            asm volatile("" :: "v"(rr[(j) & 3])); \
            peer_dma_o<0>(tbn + (size_t)in_[(j) >> 2][(j) & 3] * 128, ring + 1024 * (j)); rr[(j) & 3] = nw; } while (0)
        PV_STEP(0); PV_STEP(1); PV_STEP(2); PV_STEP(3); PV_STEP(4); PV_STEP(5); PV_STEP(6); PV_STEP(7);
        PV_STEP(8); PV_STEP(9); PV_STEP(10); PV_STEP(11); PV_STEP(12); PV_STEP(13); PV_STEP(14); PV_STEP(15);
#undef PV_STEP
        float n8[8], n4[4], f2[2];
#pragma unroll
        for (int i = 0; i < 8; ++i) { const float a_ = (i & 1) ? out[i >> 1].y : out[i >> 1].x, b_ = (i & 1) ? out[4 + (i >> 1)].y : out[4 + (i >> 1)].x;
            const auto r_ = __builtin_amdgcn_permlane32_swap(__float_as_uint(a_), __float_as_uint(b_), false, false); n8[i] = __uint_as_float(r_[0]) + __uint_as_float(r_[1]); }
#pragma unroll
        for (int i = 0; i < 4; ++i) { const auto r_ = __builtin_amdgcn_permlane16_swap(__float_as_uint(n8[i]), __float_as_uint(n8[4 + i]), false, false); n4[i] = __uint_as_float(r_[0]) + __uint_as_float(r_[1]); }
#pragma unroll
        for (int i = 0; i < 2; ++i) { const bool hi8 = (lane & 8) != 0; const float keep = hi8 ? n4[2 + i] : n4[i], send = hi8 ? n4[i] : n4[2 + i];
            f2[i] = keep + __builtin_bit_cast(float, DPP_I(__builtin_bit_cast(int, send), 0x128)); }
        { const f32x2_t xv = *(const LAS f32x2_t*)(xs + 512 * (k & 1) + 4 * (16 * c8 + colofs));
          const f32x2_t o = {xv.x + f2[0], xv.y + f2[1]}; *(f32x2_t*)(xout + (size_t)tc * 1024 + 128 * xc + 16 * c8 + colofs) = o;
          if (fuse) { const f32x2_t gg = *(const LAS f32x2_t*)(gl + 128 * xc + 16 * c8 + colofs);
              *(unsigned*)(Hn + (size_t)tc * 1024 + 128 * xc + 16 * c8 + colofs) = pk2(o.x * gg.x, o.y * gg.y);
              const float ss = wave_sum(o.x * o.x + o.y * o.y); if (lane == 0) SSQ[(size_t)tc * 8 + xc] = ss; } }
    }
#undef PV_META
#undef PV_XS
    asm volatile("s_waitcnt vmcnt(0) lgkmcnt(0)" ::: "memory");
}
#undef PEER_RD
#undef PEER_VMW

#ifndef MK_MASK
#define MK_MASK 0xffff
#endif
__global__ void __launch_bounds__(512, 2) mega(Params p) {
    extern __shared__ __attribute__((aligned(16))) unsigned char lds_raw[];
#define MKFRAME() Frame F; { int t_ = threadIdx.x; asm volatile("" : "+v"(t_)); F.lds = (LAS unsigned char*)lds_raw; F.tid = t_; F.lane = t_ & 63; F.wave = __builtin_amdgcn_readfirstlane(t_ >> 6); \
        F.G = gridDim.x; const int bx = blockIdx.x; F.vb = (F.G % 8 == 0) ? (bx % 8) * (F.G / 8) + bx / 8 : bx; }
    if (threadIdx.x < 16) ((LAS unsigned*)((LAS unsigned char*)lds_raw + LDS_XB))[threadIdx.x] = 0u;
    __syncthreads();
    const int lo = p.ph_lo, hi = p.ph_hi;
    XcdBarrier bar; bar.bar = (unsigned*)(p.ws + WS_CTL) + 4096; bar.x = 0; bar.st = (volatile LAS unsigned*)((LAS unsigned char*)lds_raw + LDS_XB);
    if (hi - lo > 1) bar = xcd_barrier_post((unsigned*)(p.ws + WS_CTL) + 4096, (volatile LAS unsigned*)((LAS unsigned char*)lds_raw + LDS_XB));
#define WSP(ws) unsigned char* ws = p.ws; asm volatile("" : "+s"(ws))
    for (int l = 0; l < NLAYER; ++l) {
        const int pb = l * NPH;
#define IN(k) (((MK_MASK >> (k)) & 1) && lo <= pb + (k) && pb + (k) < hi)
#if MK_PROBE == 120
#define SEAM(k) do { if (((MK_MASK >> (k)) & 1) && lo <= pb + (k) && pb + (k) + 1 < hi) { xcd_barrier(bar); xcd_barrier(bar); xcd_barrier(bar); } } while (0)
#else
#define SEAM(k) do { if (((MK_MASK >> (k)) & 1) && lo <= pb + (k) && pb + (k) + 1 < hi) xcd_barrier(bar); } while (0)
#endif
        if (IN(0)) { MKFRAME(); phase_prep_w(p, l, F); }
        SEAM(0);
#if MK_PROBE == 100
        if (IN(0)) { MKFRAME(); phase_prep_w(p, l, F); } xcd_barrier(bar);
#endif
        if (IN(1)) { MKFRAME(); WSP(ws); pg8::Gemm g{(const bf16_t*)(ws + WS_H), (const bf16_t*)(ws + WS_WCAT), T, 9216, 1024}; XcdColOrder S{F.G, (int)blockIdx.x};
            Epi1 E{(bf16_t*)(ws + WS_PROJ), (bf16_t*)(ws + WS_GATES)};
            pg8::gemm_phase<Epi1, XcdColOrder, false>(F.lds, g, S, E, nullptr); }
        SEAM(1);
#if MK_PROBE == 104
        if (IN(1)) { for (int rr = 0; rr < 18; ++rr) { MKFRAME(); WSP(ws); pg8::Gemm g{(const bf16_t*)(ws + WS_H), (const bf16_t*)(ws + WS_WCAT), T, 9216, 1024}; RoundOrder S; S.base.init(T, 9216, F.G, (int)blockIdx.x); S.r = rr;
            Epi1 E{(bf16_t*)(ws + WS_PROJ), (bf16_t*)(ws + WS_GATES)};
            pg8::gemm_phase<Epi1, RoundOrder, false>(F.lds, g, S, E, nullptr); xcd_barrier(bar); } }
#endif
#if MK_PROBE == 101 || MK_PROBE == 102 || MK_PROBE == 103
        if (IN(1)) { MKFRAME(); WSP(ws); pg8::Gemm g{(const bf16_t*)(ws + WS_H), (const bf16_t*)(ws + WS_WCAT), T, 9216, 1024}; ColRangeOrder S{F.G, (int)blockIdx.x, MK_PROBE == 103 ? 20 : 0, MK_PROBE == 102 ? 20 : 36};
            Epi1 E{(bf16_t*)(ws + WS_PROJ), (bf16_t*)(ws + WS_GATES)};
            pg8::gemm_phase<Epi1, ColRangeOrder, false>(F.lds, g, S, E, nullptr); } xcd_barrier(bar);
#endif
        if (IN(2)) { MKFRAME(); phase_chunk(p, l, F); }
        SEAM(2);
        if (IN(3)) { MKFRAME(); WSP(ws);
            { pg8::Gemm g{(const bf16_t*)(ws + WS_CMPA), (const bf16_t*)(ws + WS_W1C), 4096, 512, 1024}; pg8::StaticOrder S; S.init(4096, 512, F.G, (int)blockIdx.x); EpiF32P E{(float*)(ws + WS_CMPP), 512};
              pg8::gemm_phase<EpiF32P, pg8::StaticOrder, false>(F.lds, g, S, E, nullptr); }
        }
        if (IN(3)) { MKFRAME(); WSP(ws);
            { pg8::Gemm g{(const bf16_t*)(ws + WS_CMPA) + (size_t)4096 * 1024, (const bf16_t*)(ws + WS_W1C) + (size_t)512 * 1024, 4096, 512, 1024}; pg8::StaticOrder S; S.init(4096, 512, F.G, (int)((blockIdx.x + F.G / 2) % F.G));
              EpiF32P E{(float*)(ws + WS_CMPP) + (size_t)4096 * 512, 512};
              pg8::gemm_phase<EpiF32P, pg8::StaticOrder, false>(F.lds, g, S, E, nullptr); }
        }
        SEAM(3);
        if (IN(4)) { MKFRAME(); phase_cmp2(p, l, F); }
        SEAM(4);
        if (IN(5)) { MKFRAME(); phase_attn(p, l, F, 3, 15); }
        SEAM(5);
#if MK_PROBE == 5 || MK_PROBE == 50 || MK_PROBE == 51 || MK_PROBE == 52 || MK_PROBE == 53
        if (IN(5)) { MKFRAME(); phase_attn(p, l, F, MK_PROBE == 5 ? 3 : (MK_PROBE == 50 ? 1 : 2), MK_PROBE == 52 ? 1 : (MK_PROBE == 53 ? 3 : 15)); xcd_barrier(bar); }
#endif
#if MK_PROBE >= 60 && MK_PROBE < 76
        if (IN(5)) { MKFRAME(); phase_attn(p, l, F, 1, (MK_PROBE - 60) << 8); xcd_barrier(bar); }
#endif
        if (IN(6)) { MKFRAME(); WSP(ws); pg8::Gemm g{(const bf16_t*)(ws + WS_Y), (const bf16_t*)(ws + WS_WBR), 4 * T, 4096, 512}; BranchOrder S{F.G, (int)blockIdx.x};
            EpiBranch E{(const bf16_t*)(ws + WS_GATES), (bf16_t*)(ws + WS_MERGED)};
            pg8::gemm_phase<EpiBranch, BranchOrder, false>(F.lds, g, S, E, nullptr); }
        SEAM(6);
#if MK_PROBE == 106
        if (IN(6)) { MKFRAME(); WSP(ws); pg8::Gemm g{(const bf16_t*)(ws + WS_Y), (const bf16_t*)(ws + WS_WBR), 4 * T, 4096, 512}; BranchOrder S{F.G, (int)blockIdx.x};
            EpiBranch E{(const bf16_t*)(ws + WS_GATES), (bf16_t*)(ws + WS_MERGED)};
            pg8::gemm_phase<EpiBranch, BranchOrder, false>(F.lds, g, S, E, nullptr); } xcd_barrier(bar);
#endif
        if (IN(7)) { MKFRAME(); WSP(ws); pg8::Gemm g{(const bf16_t*)(ws + WS_MERGED), (const bf16_t*)(ws + WS_WOUT4), T, 1024, 1024}; pg8::StaticOrder S; S.init(T, 1024, F.G, (int)blockIdx.x);
            EpiRes E{l == 0 ? p.in[I_X] : p.out, p.out};
            pg8::gemm_phase<EpiRes, pg8::StaticOrder, false>(F.lds, g, S, E, nullptr); }
        SEAM(7);
        if (IN(8)) { MKFRAME(); WSP(ws); rmsnorm_rows(p.out, p.in[I_GFFN] + l * 1024, (bf16_t*)(ws + WS_H), F.vb * 8 + F.wave, F.G * 8, F.lane, ws + WS_H8, (float*)(ws + WS_HSI)); }
        SEAM(8);
#if MK_PROBE == 108
        if (IN(8)) { MKFRAME(); WSP(ws); rmsnorm_rows(p.out, p.in[I_GFFN] + l * 1024, (bf16_t*)(ws + WS_H), F.vb * 8 + F.wave, F.G * 8, F.lane); } xcd_barrier(bar);
#endif
        if (IN(9)) { MKFRAME(); WSP(ws);
            { pg8::Gemm g{(const bf16_t*)(ws + WS_H), (const bf16_t*)(ws + WS_WQ), T, 1024, 1024}; pg8::StaticOrder S; S.init(T, 1024, F.G, (int)blockIdx.x); EpiBf E{(bf16_t*)(ws + WS_QP), 1024};
              pg8::gemm_phase<EpiBf, pg8::StaticOrder, false>(F.lds, g, S, E, nullptr); }
        }
        if (IN(9)) { MKFRAME(); WSP(ws);
            { pg8::Gemm g{(const bf16_t*)(ws + WS_PB), (const bf16_t*)(ws + WS_WPP), T, 1024, 256}; pg8::StaticOrder S; S.init(T, 1024, F.G, (int)blockIdx.x); EpiBf E{(bf16_t*)(ws + WS_PP), 1024};
              pg8::gemm_phase<EpiBf, pg8::StaticOrder, false>(F.lds, g, S, E, nullptr); }
        }
        SEAM(9);
#if MK_PROBE == 110
        if (IN(9)) { for (int rep = 0; rep < 9; ++rep) { MKFRAME(); WSP(ws);
            { pg8::Gemm g{(const bf16_t*)(ws + WS_H), (const bf16_t*)(ws + WS_WQ), T, 1024, 1024}; pg8::StaticOrder S; S.init(T, 1024, F.G, (int)blockIdx.x); EpiBf E{(bf16_t*)(ws + WS_QP), 1024};
              pg8::gemm_phase<EpiBf, pg8::StaticOrder, false>(F.lds, g, S, E, nullptr); } } xcd_barrier(bar); }
#endif
#if MK_PROBE == 109
        if (IN(9)) { MKFRAME(); WSP(ws);
            { pg8::Gemm g{(const bf16_t*)(ws + WS_H), (const bf16_t*)(ws + WS_WQ), T, 1024, 1024}; pg8::StaticOrder S; S.init(T, 1024, F.G, (int)blockIdx.x); EpiBf E{(bf16_t*)(ws + WS_QP), 1024};
              pg8::gemm_phase<EpiBf, pg8::StaticOrder, false>(F.lds, g, S, E, nullptr); } }
        if (IN(9)) { MKFRAME(); WSP(ws);
            { pg8::Gemm g{(const bf16_t*)(ws + WS_PB), (const bf16_t*)(ws + WS_WPP), T, 1024, 256}; pg8::StaticOrder S; S.init(T, 1024, F.G, (int)blockIdx.x); EpiBf E{(bf16_t*)(ws + WS_PP), 1024};
              pg8::gemm_phase<EpiBf, pg8::StaticOrder, false>(F.lds, g, S, E, nullptr); } }
        xcd_barrier(bar);
#endif
        if (IN(10)) { MKFRAME(); for (int tile = F.vb * 8 + F.wave; tile < T / 16; tile += F.G * 8) peer_route_tile(p, tile * 16, F.lane); }
        SEAM(10);
        if (IN(11)) { MKFRAME(); phase_peer_u(p, F); }
        SEAM(11);
        if (IN(12)) { MKFRAME(); phase_peer_coef(p, F); }
        SEAM(12);
        if (IN(13)) { MKFRAME(); phase_peer_v(p, F, p.out, p.out, p.in[I_GPLE] + l * 1024, true); }
        SEAM(13);
#if MK_PROBE == 130
        if (IN(13)) { MKFRAME(); phase_peer_u(p, F); xcd_barrier(bar); }
#endif
#if MK_PROBE == 131
        if (IN(13)) { MKFRAME(); phase_peer_coef(p, F); xcd_barrier(bar); }
#endif
#if MK_PROBE == 132
        if (IN(13)) { MKFRAME(); phase_peer_v(p, F, p.out, (float*)(p.ws + WS_Y), p.in[I_GPLE] + l * 1024, false); xcd_barrier(bar); }
#endif
#if MK_PROBE == 133
        if (IN(13)) { MKFRAME(); for (int tile = F.vb * 8 + F.wave; tile < T / 16; tile += F.G * 8) peer_route_tile(p, tile * 16, F.lane); xcd_barrier(bar); }
#endif
        if (IN(15)) { MKFRAME(); WSP(ws); pg8::Gemm g{(const bf16_t*)(ws + WS_H), (const bf16_t*)(ws + WS_WPG), T, 1024, 1024}; pg8::StaticOrder S; S.init(T, 1024, F.G, (int)blockIdx.x);
            EpiPle E{p.out, (const bf16_t*)(ws + WS_PP), (const float*)(ws + WS_SSQ)};
            pg8::gemm_phase<EpiPle, pg8::StaticOrder, false>(F.lds, g, S, E, nullptr); }
        SEAM(15);
#undef IN
#undef SEAM
    }
}
}

#ifndef MK_LAUNCH_PER_PHASE
#define MK_LAUNCH_PER_PHASE 0
#endif
extern "C" void kernel_launch(void* const* d_in, const int* in_sizes, int n_in, void* d_out, int out_size, void* d_ws, size_t ws_size, hipStream_t stream) {
    static int grid = 0;
    if (grid == 0) {
        if (n_in != 27 || ws_size < mk::WS_END) { fprintf(stderr, "kernel_launch: need 27 inputs and >= %zu bytes of workspace (got %d, %zu)\n", (size_t)mk::WS_END, n_in, ws_size); grid = -1; return; }
        int dev = 0, cus = 0;
        if (hipGetDevice(&dev) != hipSuccess || hipDeviceGetAttribute(&cus, hipDeviceAttributeMultiprocessorCount, dev) != hipSuccess) { grid = -1; return; }
        if (hipFuncSetAttribute((const void*)mk::mega, hipFuncAttributeMaxDynamicSharedMemorySize, mk::LDS_BYTES) != hipSuccess) { fprintf(stderr, "kernel_launch: hipFuncSetAttribute failed\n"); grid = -1; return; }
        int per_cu = 0;
        if (hipOccupancyMaxActiveBlocksPerMultiprocessor(&per_cu, (const void*)mk::mega, 512, mk::LDS_BYTES) != hipSuccess || per_cu < 1) fprintf(stderr, "kernel_launch: occupancy query says %d\n", per_cu);
        (void)hipGetLastError();
        grid = cus;
    }
    if (grid < 0) return;
    (void)in_sizes; (void)out_size;
    hipMemsetAsync((char*)d_ws + mk::WS_CTL, 0, 1u << 20, stream);
    mk::Params prm{};
    for (int i = 0; i < 27; ++i) prm.in[i] = (const float*)d_in[i];
    prm.out = (float*)d_out; prm.ws = (unsigned char*)d_ws;
#if MK_LAUNCH_PER_PHASE
    for (int ph = 0; ph < mk::NLAYER * mk::NPH; ++ph) { prm.ph_lo = ph; prm.ph_hi = ph + 1; hipLaunchKernelGGL(mk::mega, dim3(grid), dim3(512), mk::LDS_BYTES, stream, prm); }
#else
    prm.ph_lo = 0; prm.ph_hi = mk::NLAYER * mk::NPH; hipLaunchKernelGGL(mk::mega, dim3(grid), dim3(512), mk::LDS_BYTES, stream, prm);
#endif
}
```

```cpp
#include <hip/hip_runtime.h>
#include <stdio.h>
#include <stdint.h>
namespace pg8 {
#define PG8_LAS __attribute__((address_space(3)))
typedef unsigned short bf16_t;
typedef short bf16x8 __attribute__((ext_vector_type(8)));
typedef float f32x4 __attribute__((ext_vector_type(4)));
typedef unsigned u32x4 __attribute__((ext_vector_type(4)));
constexpr int BM = 256, BK = 64, HALF = 128, HTB = HALF * BK * 2  , STAGE_BYTES = 8 * HTB, NXCD = 8, WGM = 8;

__host__ __device__ __forceinline__ int lds_byte(int r, int c) { const int st = (r >> 4) * 2 + (c >> 5), rr = r & 15, cc = c & 31, ob = rr * 64 + cc * 2; return st * 1024 + (ob ^ (((ob >> 9) & 1) << 5)); }
__host__ __device__ __forceinline__ void stage_rc(int b, int& R, int& C) { const int st = b / 1024, sb = b % 1024, swz = sb ^ (((sb >> 9) & 1) << 5); R = (st >> 1) * 16 + swz / 64; C = (st & 1) * 32 + (swz % 64) / 2; }
__host__ __device__ __forceinline__ int perm32(int rho) { const int n = rho >> 4, i = rho & 15; return 8 * (i >> 2) + 4 * n + (i & 3); }

struct Unit { int pm, pn; };
struct Gemm { const bf16_t* A; const bf16_t* Bt; int M, N, K; };

struct StaticOrder {
    int nM, nN, nwg, G, c;
    __host__ __device__ void init(int M, int N, int G_, int c_) { nM = M / BM; nN = N / BM; nwg = nM * nN; G = G_; c = c_; }
    __host__ __device__ bool next(int i, Unit& u) const {
        const long L = (long)i * G + c; if (L >= nwg) return false;
        int wgid = (int)L; { const int q = nwg / NXCD, r = nwg % NXCD, xcd = wgid % NXCD, off = wgid / NXCD; wgid = (xcd < r ? xcd * (q + 1) : r * (q + 1) + (xcd - r) * q) + off; }
        const int nig = WGM * nN, gid = wgid / nig, fm = gid * WGM, gsz = (nM - fm) < WGM ? (nM - fm) : WGM;
        u.pm = fm + ((wgid % nig) % gsz); u.pn = (wgid % nig) / gsz; return true;
    }
    __device__ __forceinline__ void a_ready(const Unit&) const {}
    __device__ __forceinline__ void done(const Unit&) const {}
};
__device__ __forceinline__ unsigned cvt_pk_bf16(float lo, float hi) { unsigned r; asm volatile("v_cvt_pk_bf16_f32 %0, %1, %2" : "=v"(r) : "v"(lo), "v"(hi)); return r; }
template <class Epi, class Sched, bool STAMP = false>
__device__ __forceinline__ void gemm_phase(PG8_LAS unsigned char* lds, const Gemm g, const Sched& S, const Epi& E, unsigned long long* stamps) {
    int tid_l = threadIdx.x; asm volatile("" : "+v"(tid_l));
    const int tid = tid_l, wid = __builtin_amdgcn_readfirstlane(tid >> 6), lane = tid & 63, wr = wid >> 2, wc = wid & 3, fr = lane & 15, fq = lane >> 4;
    const int K = g.K, nt = K / BK;
    int ts_lo = 0, ts_hi = 0, nts = 0; const unsigned long long rt_entry = STAMP ? (unsigned long long)wall_clock64() : 0ull;
#define PG8_STAMP() do { if (STAMP && wid == 0 && nts < 64) { const unsigned long long _c = (unsigned long long)clock64(); \
        ts_lo = (lane == nts) ? (int)(unsigned)_c : ts_lo; ts_hi = (lane == nts) ? (int)(unsigned)(_c >> 32) : ts_hi; ++nts; } } while (0)
    PG8_STAMP();
    unsigned voffA[2], voffB[2];
#pragma unroll
    for (int i = 0; i < 2; ++i) { int R, C; stage_rc(tid * 16 + i * 8192, R, C); const int Rb = Epi::PERM ? ((R & ~31) + perm32(R & 31)) : R;
        voffA[i] = (unsigned)(R * K + C) * 2u; voffB[i] = (unsigned)(Rb * K + C) * 2u; }
    const size_t kstep = (size_t)(BK * 2);
    const size_t hstep = (size_t)HALF * K * 2;
    const size_t tstep = 2 * hstep;
    const unsigned ldsw = (unsigned)wid * 1024u;
    const int aoff = lds_byte(wr * 64 + fr, fq * 8), boff = lds_byte(wc * 32 + fr, fq * 8);
#define PG8_SA(b, h) (((b) * 2 + (h)) * HTB)
#define PG8_SB(b, h) ((4 + (b) * 2 + (h)) * HTB)
#define PG8_STAGE(bufoff, gbase, voff) do { _Pragma("unroll") for (int _i = 0; _i < 2; ++_i) \
        __builtin_amdgcn_global_load_lds((const unsigned*)((const char*)(gbase) + (voff)[_i]), (PG8_LAS unsigned*)(lds + (bufoff) + ldsw + _i * 8192), 16, 0, 0); } while (0)
#define PG8_LDA(dst, b, h) do { _Pragma("unroll") for (int m = 0; m < 4; ++m) _Pragma("unroll") for (int k = 0; k < 2; ++k) dst[m][k] = *(const PG8_LAS bf16x8*)(lds + PG8_SA(b, h) + aoff + m * 2048 + k * 1024); } while (0)
#define PG8_LDB(dst, b, h) do { _Pragma("unroll") for (int n = 0; n < 2; ++n) _Pragma("unroll") for (int k = 0; k < 2; ++k) dst[n][k] = *(const PG8_LAS bf16x8*)(lds + PG8_SB(b, h) + boff + n * 2048 + k * 1024); } while (0)
#define PG8_MMA(ai, bj, At, Bt) do { __builtin_amdgcn_s_setprio(1); _Pragma("unroll") for (int m = 0; m < 4; ++m) _Pragma("unroll") for (int n = 0; n < 2; ++n) _Pragma("unroll") for (int k = 0; k < 2; ++k) \
        acc[ai][bj][m][n] = __builtin_amdgcn_mfma_f32_16x16x32_bf16(Bt[n][k], At[m][k], acc[ai][bj][m][n], 0, 0, 0); __builtin_amdgcn_s_setprio(0); } while (0)
#define PG8_WAIT_V(n) asm volatile("s_waitcnt vmcnt(" #n ")" ::: "memory")
#define PG8_WAIT_L(n) asm volatile("s_waitcnt lgkmcnt(" #n ")" ::: "memory")
#define PG8_BAR __builtin_amdgcn_s_barrier()
#define PG8_SCHED __builtin_amdgcn_sched_barrier(0)
    Unit cur, nxt; int ui = 0;
    if (!S.next(0, cur)) return;
    f32x4 acc[2][2][4][2];
#pragma unroll
    for (int a = 0; a < 2; ++a)
#pragma unroll
        for (int b = 0; b < 2; ++b)
#pragma unroll
            for (int m = 0; m < 4; ++m)
#pragma unroll
                for (int n = 0; n < 2; ++n) acc[a][b][m][n] = (f32x4){0.f, 0.f, 0.f, 0.f};
    bf16x8 At[4][2], B0[2][2], B1[2][2];
    const char* cA = (const char*)g.A + (size_t)cur.pm * tstep; const char* cB = (const char*)g.Bt + (size_t)cur.pn * tstep;
    S.a_ready(cur);
    PG8_STAGE(PG8_SB(0, 0), cB, voffB); PG8_STAGE(PG8_SA(0, 0), cA, voffA); PG8_STAGE(PG8_SB(0, 1), cB + hstep, voffB); PG8_STAGE(PG8_SA(0, 1), cA + hstep, voffA);
    if (wr == 1) PG8_BAR;
    PG8_WAIT_V(4); PG8_BAR;
    PG8_STAGE(PG8_SB(1, 0), cB + kstep, voffB); PG8_STAGE(PG8_SA(1, 0), cA + kstep, voffA); PG8_STAGE(PG8_SB(1, 1), cB + hstep + kstep, voffB);
    PG8_WAIT_V(6); PG8_BAR;
    PG8_STAMP();
    for (;;) {
        const bool has_next = S.next(ui + 1, nxt);
        const char* nA = has_next ? (const char*)g.A + (size_t)nxt.pm * tstep : cA; const char* nB = has_next ? (const char*)g.Bt + (size_t)nxt.pn * tstep : cB;
        for (int t = 0; t < nt; t += 2) {
            const bool last = (t == nt - 2);
            const char* a1 = cA + (size_t)(t + 1) * kstep;
            const char* a2 = last ? nA : cA + (size_t)(t + 2) * kstep; const char* b2 = last ? nB : cB + (size_t)(t + 2) * kstep;
            const char* a3 = a2 + kstep; const char* b3 = b2 + kstep;
            if (last && has_next) S.a_ready(nxt);
            PG8_LDB(B0, 0, 0); PG8_SCHED; PG8_LDA(At, 0, 0); PG8_STAGE(PG8_SA(1, 1), a1 + hstep, voffA);
            PG8_WAIT_L(8); PG8_BAR; PG8_WAIT_L(0); PG8_MMA(0, 0, At, B0); PG8_BAR; PG8_SCHED;
            PG8_LDB(B1, 0, 1); PG8_STAGE(PG8_SB(0, 0), b2, voffB);
            PG8_BAR; PG8_WAIT_L(0); PG8_MMA(0, 1, At, B1); PG8_BAR;
            PG8_LDA(At, 0, 1); PG8_STAGE(PG8_SA(0, 0), a2, voffA);
            PG8_BAR; PG8_WAIT_L(0); PG8_MMA(1, 0, At, B0); PG8_BAR; PG8_SCHED;
            PG8_STAGE(PG8_SB(0, 1), b2 + hstep, voffB);
            PG8_WAIT_V(6); PG8_BAR; PG8_MMA(1, 1, At, B1); PG8_BAR;
            PG8_LDB(B0, 1, 0); PG8_SCHED; PG8_LDA(At, 1, 0); PG8_STAGE(PG8_SA(0, 1), a2 + hstep, voffA);
            PG8_WAIT_L(8); PG8_BAR; PG8_WAIT_L(0); PG8_MMA(0, 0, At, B0); PG8_BAR; PG8_SCHED;
            PG8_LDB(B1, 1, 1); PG8_STAGE(PG8_SB(1, 0), b3, voffB);
            PG8_BAR; PG8_WAIT_L(0); PG8_MMA(0, 1, At, B1); PG8_BAR;
            PG8_LDA(At, 1, 1); PG8_STAGE(PG8_SA(1, 0), a3, voffA);
            PG8_BAR; PG8_WAIT_L(0); PG8_MMA(1, 0, At, B0); PG8_BAR; PG8_SCHED;
            PG8_STAGE(PG8_SB(1, 1), b3 + hstep, voffB);
            PG8_WAIT_V(6); PG8_BAR; PG8_MMA(1, 1, At, B1); PG8_BAR;
        }
        PG8_STAMP();
        if constexpr (!Epi::AFTER_DRAIN) { E(acc, cur, wr, wc, fr, fq); S.done(cur); }
        PG8_STAMP();
        if (!has_next) break;
#pragma unroll
        for (int a = 0; a < 2; ++a)
#pragma unroll
            for (int b = 0; b < 2; ++b)
#pragma unroll
                for (int m = 0; m < 4; ++m)
#pragma unroll
                    for (int n = 0; n < 2; ++n) acc[a][b][m][n] = (f32x4){0.f, 0.f, 0.f, 0.f};
        cur = nxt; cA = nA; cB = nB; ++ui;
    }
    PG8_WAIT_V(0);
    if (wr == 0) PG8_BAR;
    PG8_BAR;
    if constexpr (Epi::AFTER_DRAIN) { E.fused(acc, cur, wr, wc, fr, fq, lds, wid, lane); S.done(cur); }
    PG8_STAMP();
    if (STAMP && wid == 0) { stamps[lane] = lane < nts ? (((unsigned long long)(unsigned)ts_hi << 32) | (unsigned)ts_lo) : 0ull;
        if (lane == 62) stamps[62] = rt_entry; if (lane == 63) stamps[63] = (unsigned long long)wall_clock64(); }
#undef PG8_STAMP
#undef PG8_SA
#undef PG8_SB
#undef PG8_STAGE
#undef PG8_LDA
#undef PG8_LDB
#undef PG8_MMA
#undef PG8_WAIT_V
#undef PG8_WAIT_L
#undef PG8_BAR
#undef PG8_SCHED
}
}
#define XB_TMO      128
#define XB_XCNT(j)  (256  + 64 * (j))
#define XB_XSUB(j)  (1280 + 64 * (j))
#define XB_XGEN(j)  (2304 + 64 * (j))
#define XB_TOP      3328
#define XB_TOPGEN   3392
#define XCD_BAR_WORDS 3456
#define XB_SPIN_CAP (1u << 18)
#define LAS __attribute__((address_space(3)))

__device__ __forceinline__ unsigned xb_ld(unsigned* p)              { return __hip_atomic_load(p, __ATOMIC_RELAXED, __HIP_MEMORY_SCOPE_AGENT); }
__device__ __forceinline__ unsigned xb_add(unsigned* p, unsigned v) { return __hip_atomic_fetch_add(p, v, __ATOMIC_RELAXED, __HIP_MEMORY_SCOPE_AGENT); }
__device__ __forceinline__ unsigned xb_xcc_id() { return (unsigned)__builtin_amdgcn_s_getreg((3 << 11) | 20) & 0xFu; }
#define XB_SPIN(cond, bar) do { unsigned _sp = 0; while (cond) { __builtin_amdgcn_s_sleep(1); \
    if ((++_sp & 255u) == 0u) { if (xb_ld(&(bar)[XB_TMO])) break; if (_sp > XB_SPIN_CAP) { atomicAdd(&(bar)[XB_TMO], 1u); break; } } } } while (0)

struct XcdBarrier {
    unsigned* bar; unsigned x;
    volatile LAS unsigned* st;
};

__device__ __forceinline__ XcdBarrier xcd_barrier_post(unsigned* bar, volatile LAS unsigned* st) {
    XcdBarrier b; b.bar = bar; b.x = xb_xcc_id(); b.st = st;
    if (threadIdx.x == 0) (void)xb_add(&bar[XB_XCNT(b.x)], 1u);
    return b;
}
__device__ __forceinline__ void xcd_barrier_complete(unsigned* bar, unsigned x, unsigned& nloc, unsigned& nx) {
    const unsigned G = gridDim.x * gridDim.y * gridDim.z;
    unsigned sum, cnt, mine, sp = 0u;
    for (;;) {
        sum = 0u; cnt = 0u; mine = 0u;
#pragma unroll
        for (unsigned j = 0; j < 16; ++j) { const unsigned c = xb_ld(&bar[XB_XCNT(j)]); sum += c; cnt += (c > 0u) ? 1u : 0u; mine = (j == x) ? c : mine; }
        if (sum == G) break;
        __builtin_amdgcn_s_sleep(1);
        if ((++sp & 255u) == 0u) { if (xb_ld(&bar[XB_TMO])) break; if (sp > XB_SPIN_CAP) { atomicAdd(&bar[XB_TMO], 1u); break; } }
    }
    nloc = mine > 0u ? mine : 1u; nx = cnt > 0u ? cnt : 1u;
}

__device__ __forceinline__ void xcd_barrier(const XcdBarrier& b) {
    asm volatile("s_waitcnt vmcnt(0)" ::: "memory");
    __syncthreads();
    if (threadIdx.x == 0) {
        unsigned* bar = b.bar;
        __builtin_amdgcn_s_waitcnt(0);
        unsigned nloc = b.st[0], nx = b.st[1];
        if (nloc == 0u) { xcd_barrier_complete(bar, b.x, nloc, nx); b.st[0] = nloc; b.st[1] = nx; }
        const unsigned old = xb_add(&bar[XB_XSUB(b.x)], 1u);
        const unsigned gen = old / nloc;
        if (old + 1u == (gen + 1u) * nloc) {
            __builtin_amdgcn_fence(__ATOMIC_RELEASE, "agent");
            asm volatile("s_waitcnt vmcnt(0)" ::: "memory");
            const unsigned og = xb_add(&bar[XB_TOP], 1u);
            const unsigned tg = og / nx;
            if (og + 1u == (tg + 1u) * nx) xb_add(&bar[XB_TOPGEN], 1u);
            else XB_SPIN(xb_ld(&bar[XB_TOPGEN]) == tg, bar);
            __builtin_amdgcn_fence(__ATOMIC_ACQUIRE, "agent");
            xb_add(&bar[XB_XGEN(b.x)], 1u);
            asm volatile("s_waitcnt vmcnt(0)" ::: "memory");
        } else {
            XB_SPIN(xb_ld(&bar[XB_XGEN(b.x)]) == gen, bar);
            __builtin_amdgcn_fence(__ATOMIC_ACQUIRE, "agent");
            asm volatile("s_waitcnt vmcnt(0)" ::: "memory");
        }
    }
    __syncthreads();
}

namespace mk {
using pg8::bf16_t; using pg8::bf16x8; using pg8::f32x4; using pg8::u32x4;
typedef unsigned u32x2 __attribute__((ext_vector_type(2)));
typedef short s16x4 __attribute__((ext_vector_type(4)));
#define DI __device__ __forceinline__
#define LDS_WAIT() asm volatile("s_waitcnt lgkmcnt(0)" ::: "memory")
#define LDS_FENCE() asm volatile("" ::: "memory")
#define MFMA16(a, b, c) __builtin_amdgcn_mfma_f32_16x16x32_bf16((a), (b), (c), 0, 0, 0)

constexpr int T = 32768, SEQ = 4096, NLAYER = 4, NPH = 16;
constexpr int PW = 5120;
constexpr int C_AB = 0, C_AC = 512, C_AX = 1024, C_NQ = 1536, C_NKV = 2048, C_UV = 2816, C_DQ = 3840, C_DK = 4352, C_DV = 4416,
              C_DQI = 4480, C_DKI = 4992, C_NG = 5056, C_DWI = 5080;
constexpr size_t MiB = 1u << 20;
constexpr size_t WS_CTL = 0, WS_PEB = 1 * MiB, WS_CMPK = 2 * MiB, WS_CMPV = 3 * MiB, WS_SK = 4 * MiB, WS_SGUW = 5 * MiB, WS_CMPA = 8 * MiB,
                 WS_CMPP = 24 * MiB, WS_WCAT = 40 * MiB, WS_WBR = 58 * MiB, WS_WOUT4 = 62 * MiB, WS_WQ = 70 * MiB, WS_WPG = 72 * MiB,
                 WS_WPP = 74 * MiB, WS_W1C = 75 * MiB, WS_PB = 78 * MiB, WS_PTU = 96 * MiB, WS_PTV = 128 * MiB, WS_H = 160 * MiB,
                 WS_Y = 224 * MiB, WS_PROJ = 352 * MiB, WS_GATES = 672 * MiB,
                 WS_KS = 928 * MiB, WS_VS = 936 * MiB, WS_KW = 944 * MiB, WS_VW = 952 * MiB, WS_DK = 960 * MiB, WS_DV = 964 * MiB, WS_DKI = 968 * MiB, WS_END = 972 * MiB;
constexpr size_t WS_ACCF = WS_PROJ, WS_MERGED = WS_PROJ + 128 * MiB, WS_QP = WS_PROJ, WS_PP = WS_PROJ + 64 * MiB, WS_EIDX = WS_PROJ + 128 * MiB, WS_EW = WS_PROJ + 144 * MiB, WS_EU = WS_PROJ + 160 * MiB;
constexpr size_t WS_COEF = WS_PROJ + 176 * MiB, WS_H8 = WS_PROJ + 192 * MiB, WS_HSI = WS_PROJ + 224 * MiB, WS_SSQ = WS_PROJ + 225 * MiB, WS_PD = WS_GATES, PT_SLICE = 2 * MiB;
constexpr int LDS_BYTES = 163840, LDS_PERWAVE = 19456, LDS_BUCK = 8 * LDS_PERWAVE, LDS_TBL = LDS_BUCK + 4096, LDS_XB = LDS_BYTES - 64;

struct Params { const float* in[27]; float* out; unsigned char* ws; int ph_lo, ph_hi; };
enum { I_X = 0, I_P, I_REL, I_GMIX, I_WIN, I_CONVW, I_PE, I_CW1, I_CW2, I_NQG, I_NKG, I_LNG, I_SGUW, I_SGUB, I_DQG, I_DKG, I_WGATE, I_WBR, I_WOUT,
       I_GFFN, I_WQ, I_SUBK, I_PU, I_PV, I_GPLE, I_WPG, I_WPP };

struct Frame { LAS unsigned char* lds; int tid, lane, wave, vb, G; };

DI float bf2f(unsigned short b) { return __uint_as_float(((unsigned)b) << 16); }
DI unsigned f2bf(float f) { unsigned u = __float_as_uint(f); return (u + 0x7fffu + ((u >> 16) & 1u)) >> 16; }
DI unsigned pk2(float lo, float hi) { return pg8::cvt_pk_bf16(lo, hi); }
DI float lo16(unsigned w) { return __uint_as_float(w << 16); }
DI float hi16(unsigned w) { return __uint_as_float(w & 0xffff0000u); }
DI float sigm(float x) { return __builtin_amdgcn_rcpf(1.f + __builtin_amdgcn_exp2f(-1.44269504f * x)); }
DI float gelu_t(float x) { const float y = (-2.f * 0.7978845608f * 1.44269504f) * (x + 0.044715f * x * x * x); return x * __builtin_amdgcn_rcpf(1.f + __builtin_amdgcn_exp2f(y)); }
#define DPP_I(x, ctrl) __builtin_amdgcn_update_dpp(0, (x), (ctrl), 0xF, 0xF, false)
DI float dppf(float x, int) { return x; }
DI float row16_sumf(float v) { v += __builtin_bit_cast(float, DPP_I(__builtin_bit_cast(int, v), 0xB1)); v += __builtin_bit_cast(float, DPP_I(__builtin_bit_cast(int, v), 0x4E));
    v += __builtin_bit_cast(float, DPP_I(__builtin_bit_cast(int, v), 0x141)); v += __builtin_bit_cast(float, DPP_I(__builtin_bit_cast(int, v), 0x140)); return v; }
DI float row16_maxf(float v) { v = fmaxf(v, __builtin_bit_cast(float, DPP_I(__builtin_bit_cast(int, v), 0xB1))); v = fmaxf(v, __builtin_bit_cast(float, DPP_I(__builtin_bit_cast(int, v), 0x4E)));
    v = fmaxf(v, __builtin_bit_cast(float, DPP_I(__builtin_bit_cast(int, v), 0x141))); v = fmaxf(v, __builtin_bit_cast(float, DPP_I(__builtin_bit_cast(int, v), 0x140))); return v; }
DI float quad_sumf(float v) { v += __builtin_bit_cast(float, DPP_I(__builtin_bit_cast(int, v), 0xB1)); v += __builtin_bit_cast(float, DPP_I(__builtin_bit_cast(int, v), 0x4E)); return v; }
DI float oct_sumf(float v) { v = quad_sumf(v); v += __builtin_bit_cast(float, DPP_I(__builtin_bit_cast(int, v), 0x141)); return v; }
DI float x16_sum(float v) { const unsigned u = __float_as_uint(v); const auto r = __builtin_amdgcn_permlane16_swap(u, u, false, false); return __uint_as_float(r[0]) + __uint_as_float(r[1]); }
DI float x32_sum(float v) { const unsigned u = __float_as_uint(v); const auto r = __builtin_amdgcn_permlane32_swap(u, u, false, false); return __uint_as_float(r[0]) + __uint_as_float(r[1]); }
DI float x16_max(float v) { const unsigned u = __float_as_uint(v); const auto r = __builtin_amdgcn_permlane16_swap(u, u, false, false); return fmaxf(__uint_as_float(r[0]), __uint_as_float(r[1])); }
DI float x32_max(float v) { const unsigned u = __float_as_uint(v); const auto r = __builtin_amdgcn_permlane32_swap(u, u, false, false); return fmaxf(__uint_as_float(r[0]), __uint_as_float(r[1])); }
DI unsigned wave_sum_u(unsigned v) { v += (unsigned)DPP_I((int)v, 0xB1); v += (unsigned)DPP_I((int)v, 0x4E); v += (unsigned)DPP_I((int)v, 0x141); v += (unsigned)DPP_I((int)v, 0x140);
    { const auto r = __builtin_amdgcn_permlane16_swap(v, v, false, false); v = r[0] + r[1]; } { const auto r = __builtin_amdgcn_permlane32_swap(v, v, false, false); v = r[0] + r[1]; } return v; }
DI float wave_sum(float v) { return x32_sum(x16_sum(row16_sumf(v))); }
DI float wave_max(float v) { return x32_max(x16_max(row16_maxf(v))); }
DI unsigned ordf(float f) { const unsigned u = __float_as_uint(f); return (u & 0x80000000u) ? ~u : (u | 0x80000000u); }
DI float unordf(unsigned x) { return __uint_as_float((x & 0x80000000u) ? (x & 0x7fffffffu) : ~x); }
DI int bucket_of(int n) {
    if (n < 16) return n;
    int b = 16;
    b += (n >= 21); b += (n >= 27); b += (n >= 35); b += (n >= 46); b += (n >= 59); b += (n >= 77); b += (n >= 99); b += (n >= 128);
    b += (n >= 166); b += (n >= 216); b += (n >= 280); b += (n >= 363); b += (n >= 470); b += (n >= 609); b += (n >= 790);
    return b; }

DI int srccol(int n) { return n < 2816 ? n : (n < 5056 ? n + 24 : (n < 5080 ? n - 2240 : (n < 5088 ? n : -1))); }
DI void tr_item(const float* W, int ldw, bf16_t* WT, int ldwt, int k0, int n0, LAS float* scr, int lane, bool remap, int ncopy, int cstride) {
    float tv[32];
#pragma unroll
    for (int i = 0; i < 32; ++i) { const int kk = 2 * i + (lane >> 5), nl = lane & 31; const int n = n0 + nl; const int src = remap ? srccol(n) : n; tv[i] = src >= 0 ? W[(size_t)(k0 + kk) * ldw + src] : 0.f; }
#pragma unroll
    for (int i = 0; i < 32; ++i) { const int kk = 2 * i + (lane >> 5), nl = lane & 31; scr[kk * 33 + nl] = tv[i]; }
    LDS_WAIT();
    const int c = lane & 7;
#pragma unroll
    for (int j = 0; j < 4; ++j) { const int n = (lane >> 3) + 8 * j; const LAS float* s = scr + (8 * c) * 33 + n;
        u32x4 o; o.x = pk2(s[0], s[33]); o.y = pk2(s[66], s[99]); o.z = pk2(s[132], s[165]); o.w = pk2(s[198], s[231]);
        for (int cp = 0; cp < ncopy; ++cp) *(u32x4*)(WT + (size_t)(n0 + n) * ldwt + (size_t)cp * cstride + k0 + 8 * c) = o; }
    LDS_WAIT();
}
DI void cvt_rows(const float* src, bf16_t* dst, size_t ngroups8, int gw, int NGW, int lane) {
    const size_t st = (size_t)NGW * 64;
    for (size_t i0 = (size_t)gw * 64 + lane; i0 < ngroups8; i0 += 4 * st) {
        f32x4 a[4], b[4];
#pragma unroll
        for (int r = 0; r < 4; ++r) { const size_t i = i0 + r * st < ngroups8 ? i0 + r * st : i0; a[r] = ((const f32x4*)src)[2 * i]; b[r] = ((const f32x4*)src)[2 * i + 1]; }
#pragma unroll
        for (int r = 0; r < 4; ++r) { const size_t i = i0 + r * st; if (i >= ngroups8) break;
            u32x4 o; o.x = pk2(a[r].x, a[r].y); o.y = pk2(a[r].z, a[r].w); o.z = pk2(b[r].x, b[r].y); o.w = pk2(b[r].z, b[r].w); ((u32x4*)dst)[i] = o; }
    }
}
DI int pk4_fp8(float a, float b, float c, float d) { int w = 0; w = __builtin_amdgcn_cvt_pk_fp8_f32(a, b, w, false); w = __builtin_amdgcn_cvt_pk_fp8_f32(c, d, w, true); return w; }
DI void cvt_rows_fp8(const float* src, unsigned char* dst, float* scl, int nrows, int gw, int NGW, int lane) {
    for (int r0 = gw; r0 < nrows; r0 += 4 * NGW) {
        f32x4 a[4], b[4], c[4], d[4];
#pragma unroll
        for (int k = 0; k < 4; ++k) { const int r = r0 + k * NGW < nrows ? r0 + k * NGW : r0; const float* s = src + (size_t)r * 1024 + lane * 16;
            a[k] = *(const f32x4*)s; b[k] = *(const f32x4*)(s + 4); c[k] = *(const f32x4*)(s + 8); d[k] = *(const f32x4*)(s + 12); }
#pragma unroll
        for (int k = 0; k < 4; ++k) { const int r = r0 + k * NGW; if (r >= nrows) break;
            float mx = fmaxf(fmaxf(fmaxf(fabsf(a[k].x), fabsf(a[k].y)), fmaxf(fabsf(a[k].z), fabsf(a[k].w))), fmaxf(fmaxf(fabsf(b[k].x), fabsf(b[k].y)), fmaxf(fabsf(b[k].z), fabsf(b[k].w))));
            mx = fmaxf(mx, fmaxf(fmaxf(fmaxf(fabsf(c[k].x), fabsf(c[k].y)), fmaxf(fabsf(c[k].z), fabsf(c[k].w))), fmaxf(fmaxf(fabsf(d[k].x), fabsf(d[k].y)), fmaxf(fabsf(d[k].z), fabsf(d[k].w)))));
            mx = wave_max(mx);
            const float sc = mx > 0.f ? mx * (1.f / 448.f) : 1.f, inv = 1.f / sc;
            u32x4 o; o.x = (unsigned)pk4_fp8(a[k].x * inv, a[k].y * inv, a[k].z * inv, a[k].w * inv); o.y = (unsigned)pk4_fp8(b[k].x * inv, b[k].y * inv, b[k].z * inv, b[k].w * inv);
            o.z = (unsigned)pk4_fp8(c[k].x * inv, c[k].y * inv, c[k].z * inv, c[k].w * inv); o.w = (unsigned)pk4_fp8(d[k].x * inv, d[k].y * inv, d[k].z * inv, d[k].w * inv);
            *(u32x4*)(dst + (size_t)(lane >> 3) * PT_SLICE + (size_t)r * 128 + (lane & 7) * 16) = o;
            if (lane == 0) scl[r] = sc; }
    }
}
DI void rmsnorm_rows(const float* x, const float* g, bf16_t* H, int gw, int NGW, int lane, unsigned char* H8 = nullptr, float* HSI = nullptr) {
    const f32x4 g0 = *(const f32x4*)(g + lane * 8), g1 = *(const f32x4*)(g + lane * 8 + 4), g2 = *(const f32x4*)(g + 512 + lane * 8), g3 = *(const f32x4*)(g + 512 + lane * 8 + 4);
    for (int m0 = gw; m0 < T; m0 += 4 * NGW) {
        f32x4 a[4], b[4], c[4], d[4];
#pragma unroll
        for (int r = 0; r < 4; ++r) { const int m = m0 + r * NGW < T ? m0 + r * NGW : m0; const float* xr = x + (size_t)m * 1024 + lane * 8;
            a[r] = *(const f32x4*)xr; b[r] = *(const f32x4*)(xr + 4); c[r] = *(const f32x4*)(xr + 512); d[r] = *(const f32x4*)(xr + 516); }
#pragma unroll
        for (int r = 0; r < 4; ++r) { const int m = m0 + r * NGW; if (m >= T) break;
            float ss = a[r].x * a[r].x + a[r].y * a[r].y + a[r].z * a[r].z + a[r].w * a[r].w + b[r].x * b[r].x + b[r].y * b[r].y + b[r].z * b[r].z + b[r].w * b[r].w
                     + c[r].x * c[r].x + c[r].y * c[r].y + c[r].z * c[r].z + c[r].w * c[r].w + d[r].x * d[r].x + d[r].y * d[r].y + d[r].z * d[r].z + d[r].w * d[r].w;
            ss = wave_sum(ss);
            const float rr = rsqrtf(ss * (1.f / 1024.f) + 1e-6f);
            u32x4 o0, o1;
            o0.x = pk2(a[r].x * rr * g0.x, a[r].y * rr * g0.y); o0.y = pk2(a[r].z * rr * g0.z, a[r].w * rr * g0.w); o0.z = pk2(b[r].x * rr * g1.x, b[r].y * rr * g1.y); o0.w = pk2(b[r].z * rr * g1.z, b[r].w * rr * g1.w);
            o1.x = pk2(c[r].x * rr * g2.x, c[r].y * rr * g2.y); o1.y = pk2(c[r].z * rr * g2.z, c[r].w * rr * g2.w); o1.z = pk2(d[r].x * rr * g3.x, d[r].y * rr * g3.y); o1.w = pk2(d[r].z * rr * g3.z, d[r].w * rr * g3.w);
            bf16_t* hr = H + (size_t)m * 1024 + lane * 8; *(u32x4*)hr = o0; *(u32x4*)(hr + 512) = o1;
            if (H8) {
                float v[16] = {a[r].x * rr * g0.x, a[r].y * rr * g0.y, a[r].z * rr * g0.z, a[r].w * rr * g0.w, b[r].x * rr * g1.x, b[r].y * rr * g1.y, b[r].z * rr * g1.z, b[r].w * rr * g1.w,
                               c[r].x * rr * g2.x, c[r].y * rr * g2.y, c[r].z * rr * g2.z, c[r].w * rr * g2.w, d[r].x * rr * g3.x, d[r].y * rr * g3.y, d[r].z * rr * g3.z, d[r].w * rr * g3.w};
                float am = 0.f;
#pragma unroll
                for (int e = 0; e < 16; ++e) am = fmaxf(am, fabsf(v[e]));
                am = wave_max(am);
                const float hs = am > 0.f ? 224.f / am : 1.f;
                u32x2 q0, q1; q0.x = (unsigned)pk4_fp8(v[0] * hs, v[1] * hs, v[2] * hs, v[3] * hs); q0.y = (unsigned)pk4_fp8(v[4] * hs, v[5] * hs, v[6] * hs, v[7] * hs);
                q1.x = (unsigned)pk4_fp8(v[8] * hs, v[9] * hs, v[10] * hs, v[11] * hs); q1.y = (unsigned)pk4_fp8(v[12] * hs, v[13] * hs, v[14] * hs, v[15] * hs);
                unsigned char* h8 = H8 + (size_t)m * 1024 + lane * 8; *(u32x2*)h8 = q0; *(u32x2*)(h8 + 512) = q1;
                if (lane == 0) HSI[m] = 1.f / hs; } }
    }
}
DI void phase_prep_w(const Params& p, int l, const Frame& F) {
    LAS float* scr = (LAS float*)(F.lds + F.wave * 8448);
    const int gw = F.vb * 8 + F.wave, NGW = F.G * 8, lane = F.lane;
    unsigned char* ws = p.ws;
    bf16_t* WCAT = (bf16_t*)(ws + WS_WCAT); bf16_t* WBR = (bf16_t*)(ws + WS_WBR); bf16_t* WOUT4 = (bf16_t*)(ws + WS_WOUT4); bf16_t* WQ = (bf16_t*)(ws + WS_WQ);
    bf16_t* WPG = (bf16_t*)(ws + WS_WPG); bf16_t* WPP = (bf16_t*)(ws + WS_WPP); bf16_t* W1C = (bf16_t*)(ws + WS_W1C);
    constexpr int I0 = 2560, I1 = 2048, I2 = 1024, I3 = 512, I4 = 512, I5 = 512, I6 = 128, I7 = 512, NIT = I0 + I1 + I2 + I3 + I4 + I5 + I6 + I7;
    for (int it = gw; it < NIT; it += NGW) {
        int r = it;
        if (r < I0) { tr_item(p.in[I_WIN] + (size_t)l * 1024 * 5088, 5088, WCAT, 1024, (r / 160) * 64, (r % 160) * 32, scr, lane, true, 1, 0); continue; } r -= I0;
        if (r < I1) { tr_item(p.in[I_WGATE] + (size_t)l * 1024 * 4096, 4096, WCAT + (size_t)5120 * 1024, 1024, (r / 128) * 64, (r % 128) * 32, scr, lane, false, 1, 0); continue; } r -= I1;
        if (r < I2) { const int m = r >> 8, rr = r & 255; tr_item(p.in[I_WBR] + ((size_t)l * 2048 + m * 512) * 1024, 1024, WBR + (size_t)m * 1024 * 512, 512, (rr / 32) * 64, (rr % 32) * 32, scr, lane, false, 1, 0); continue; } r -= I2;
        if (r < I3) { tr_item(p.in[I_WOUT] + (size_t)l * 1024 * 1024, 1024, WOUT4, 1024, (r / 32) * 64, (r % 32) * 32, scr, lane, false, 1, 0); continue; } r -= I3;
        if (r < I4) { tr_item(p.in[I_WQ] + (size_t)l * 1024 * 1024, 1024, WQ, 1024, (r / 32) * 64, (r % 32) * 32, scr, lane, false, 1, 0); continue; } r -= I4;
        if (r < I5) { tr_item(p.in[I_WPG] + (size_t)l * 1024 * 1024, 1024, WPG, 1024, (r / 32) * 64, (r % 32) * 32, scr, lane, false, 1, 0); continue; } r -= I5;
        if (r < I6) { tr_item(p.in[I_WPP] + (size_t)l * 256 * 1024, 1024, WPP, 256, (r / 32) * 64, (r % 32) * 32, scr, lane, false, 1, 0); continue; } r -= I6;
        { const int jh = r >> 7, rr = r & 127, j = jh >> 1, half = jh & 1;
          tr_item(p.in[I_CW1] + (((size_t)l * 2 + j) * 2048 + half * 1024) * 256, 256, W1C + ((size_t)j * 512 + half * 256) * 1024, 1024, (rr / 8) * 64, (rr % 8) * 32, scr, lane, false, 1, 0); }
    }
    cvt_rows_fp8(p.in[I_PU] + (size_t)l * 16384 * 1024, ws + WS_PTU, (float*)(ws + WS_PTV), 16384, gw, NGW, lane);
    cvt_rows_fp8(p.in[I_PV] + (size_t)l * 16384 * 1024, ws + WS_PTU + 16 * MiB, (float*)(ws + WS_PTV) + 16384, 16384, gw, NGW, lane);
    cvt_rows(p.in[I_SUBK] + (size_t)l * 131072, (bf16_t*)(ws + WS_SK), 131072 / 8, gw, NGW, lane);
    cvt_rows(p.in[I_P] + (size_t)l * T * 256, (bf16_t*)(ws + WS_PB), (size_t)T * 256 / 8, gw, NGW, lane);
    { const float* sw = p.in[I_SGUW] + (size_t)l * 131072; bf16_t* dst = (bf16_t*)(ws + WS_SGUW);
      for (int i = gw * 64 + lane; i < 131072 / 8; i += NGW * 64) { const int e = i * 8, t = (e >> 7) & 127, s0 = e & 127; float v[8];
#pragma unroll
          for (int k = 0; k < 8; ++k) v[k] = (s0 + k <= t) ? sw[e + k] : 0.f;
          u32x4 o; o.x = pk2(v[0], v[1]); o.y = pk2(v[2], v[3]); o.z = pk2(v[4], v[5]); o.w = pk2(v[6], v[7]); ((u32x4*)dst)[i] = o; } }
    { float* peb = (float*)(ws + WS_PEB);
      for (int o = gw; o < 512; o += NGW) { const int j = o >> 8, n = o & 255; const float* pe = p.in[I_PE] + ((size_t)l * 2 + j) * 2048; const float* w1 = p.in[I_CW1] + ((size_t)l * 2 + j) * 2048 * 256;
          float s = 0.f; for (int k = lane; k < 2048; k += 64) s += pe[k] * w1[(size_t)k * 256 + n];
          s = wave_sum(s); if (lane == 0) peb[o] = s; } }
    rmsnorm_rows(l == 0 ? p.in[I_X] : p.out, p.in[I_GMIX] + l * 1024, (bf16_t*)(ws + WS_H), gw, NGW, lane);
}

struct Epi1 {
    static constexpr bool PERM = true, AFTER_DRAIN = false;
    bf16_t* proj; bf16_t* gates;
    DI void operator()(const f32x4 (&acc)[2][2][4][2], const pg8::Unit& u, int wr, int wc, int fr, int fq) const {
        const int row0 = u.pm * 256 + wr * 64 + fr; const bool isg = u.pn >= 20;
        const int col0 = (isg ? (u.pn - 20) * 256 : u.pn * 256) + wc * 32 + 8 * fq; bf16_t* base = isg ? gates : proj; const int ldc = isg ? 4096 : PW;
#pragma unroll
        for (int ai = 0; ai < 2; ++ai)
#pragma unroll
            for (int m = 0; m < 4; ++m) { bf16_t* rowp = base + (size_t)(row0 + ai * 128 + m * 16) * ldc + col0;
#pragma unroll
                for (int bj = 0; bj < 2; ++bj) { f32x4 v0 = acc[ai][bj][m][0], v1 = acc[ai][bj][m][1];
                    if (isg) { v0.x = sigm(v0.x); v0.y = sigm(v0.y); v0.z = sigm(v0.z); v0.w = sigm(v0.w); v1.x = sigm(v1.x); v1.y = sigm(v1.y); v1.z = sigm(v1.z); v1.w = sigm(v1.w); }
                    u32x4 w; w.x = pk2(v0.x, v0.y); w.y = pk2(v0.z, v0.w); w.z = pk2(v1.x, v1.y); w.w = pk2(v1.z, v1.w);
                    __builtin_nontemporal_store(w, (u32x4*)(rowp + bj * 128)); } }
    }
};
struct EpiBf {
    static constexpr bool PERM = true, AFTER_DRAIN = false;
    bf16_t* O; int ldc;
    DI void operator()(const f32x4 (&acc)[2][2][4][2], const pg8::Unit& u, int wr, int wc, int fr, int fq) const {
        const int row0 = u.pm * 256 + wr * 64 + fr, col0 = u.pn * 256 + wc * 32 + 8 * fq;
#pragma unroll
        for (int ai = 0; ai < 2; ++ai)
#pragma unroll
            for (int m = 0; m < 4; ++m) { bf16_t* rowp = O + (size_t)(row0 + ai * 128 + m * 16) * ldc + col0;
#pragma unroll
                for (int bj = 0; bj < 2; ++bj) { const f32x4 v0 = acc[ai][bj][m][0], v1 = acc[ai][bj][m][1];
                    u32x4 w; w.x = pk2(v0.x, v0.y); w.y = pk2(v0.z, v0.w); w.z = pk2(v1.x, v1.y); w.w = pk2(v1.z, v1.w);
                    *(u32x4*)(rowp + bj * 128) = w; } }
    }
};
struct EpiF32P {
    static constexpr bool PERM = true, AFTER_DRAIN = false;
    float* C; int ldc;
    DI void operator()(const f32x4 (&acc)[2][2][4][2], const pg8::Unit& u, int wr, int wc, int fr, int fq) const {
        const int row0 = u.pm * 256 + wr * 64 + fr, col0 = u.pn * 256 + wc * 32 + 8 * fq;
#pragma unroll
        for (int ai = 0; ai < 2; ++ai)
#pragma unroll
            for (int m = 0; m < 4; ++m) { float* rowp = C + (size_t)(row0 + ai * 128 + m * 16) * ldc + col0;
#pragma unroll
                for (int bj = 0; bj < 2; ++bj) { *(f32x4*)(rowp + bj * 128) = acc[ai][bj][m][0]; *(f32x4*)(rowp + bj * 128 + 4) = acc[ai][bj][m][1]; } }
    }
};
struct XcdColOrder {
    int G, c;
    DI bool next(int i, pg8::Unit& u) const {
        if (G != 256) { const int Lx = i * G + c; if (Lx >= 128 * 36) return false; u.pm = Lx / 36; u.pn = Lx % 36; return true; }
        if (i >= 18) return false;
        const int x = c & 7, w = c >> 3;
        if (i < 16) { u.pm = 8 * i + (w & 7); u.pn = 4 * x + (w >> 3); }
        else { u.pm = 16 * x + 8 * (i - 16) + (w & 7); u.pn = 32 + (w >> 3); }
        return true; }
    DI void a_ready(const pg8::Unit&) const {}
    DI void done(const pg8::Unit&) const {}
};
struct RoundOrder {
    pg8::StaticOrder base; int r;
    DI bool next(int i, pg8::Unit& u) const { return i == 0 && base.next(r, u); }
    DI void a_ready(const pg8::Unit&) const {}
    DI void done(const pg8::Unit&) const {}
};
struct ColRangeOrder {
    int G, c, c0, c1;
    DI bool next(int i, pg8::Unit& u) const { const int nc = c1 - c0; const int Lx = i * G + c; if (Lx >= 128 * nc) return false; u.pm = Lx / nc; u.pn = c0 + Lx % nc; return true; }
    DI void a_ready(const pg8::Unit&) const {}
    DI void done(const pg8::Unit&) const {}
};
struct BranchOrder {
    int G, c;
    DI bool next(int i, pg8::Unit& u) const { const int tile = c + G * (i >> 2), m = i & 3; if (tile >= 512) return false; u.pm = m * 128 + (tile >> 2); u.pn = m * 4 + (tile & 3); return true; }
    DI void a_ready(const pg8::Unit&) const {}
    DI void done(const pg8::Unit&) const {}
};
struct EpiBranch {
    static constexpr bool PERM = true, AFTER_DRAIN = false;
    const bf16_t* gates; bf16_t* merged;
    DI void operator()(const f32x4 (&acc)[2][2][4][2], const pg8::Unit& u, int wr, int wc, int fr, int fq) const {
        const int m4 = u.pn >> 2; const int row0 = (u.pm & 127) * 256 + wr * 64 + fr, gcol0 = u.pn * 256 + wc * 32 + 8 * fq, dcol0 = (u.pn & 3) * 256 + wc * 32 + 8 * fq;
#pragma unroll
        for (int ai = 0; ai < 2; ++ai) {
            u32x4 g[4][2], pr[4][2];
#pragma unroll
            for (int m = 0; m < 4; ++m)
#pragma unroll
                for (int bj = 0; bj < 2; ++bj) { g[m][bj] = *(const u32x4*)(gates + (size_t)(row0 + ai * 128 + m * 16) * 4096 + gcol0 + bj * 128);
                    if (m4 > 0) pr[m][bj] = *(const u32x4*)(merged + (size_t)(row0 + ai * 128 + m * 16) * 1024 + dcol0 + bj * 128); }
#pragma unroll
            for (int m = 0; m < 4; ++m)
#pragma unroll
                for (int bj = 0; bj < 2; ++bj) { const f32x4 v0 = acc[ai][bj][m][0], v1 = acc[ai][bj][m][1]; const u32x4 gg = g[m][bj];
                    f32x4 r0 = {v0.x * lo16(gg.x), v0.y * hi16(gg.x), v0.z * lo16(gg.y), v0.w * hi16(gg.y)}, r1 = {v1.x * lo16(gg.z), v1.y * hi16(gg.z), v1.z * lo16(gg.w), v1.w * hi16(gg.w)};
                    if (m4 > 0) { const u32x4 pp_ = pr[m][bj];
                        r0.x += lo16(pp_.x); r0.y += hi16(pp_.x); r0.z += lo16(pp_.y); r0.w += hi16(pp_.y); r1.x += lo16(pp_.z); r1.y += hi16(pp_.z); r1.z += lo16(pp_.w); r1.w += hi16(pp_.w); }
                    u32x4 w; w.x = pk2(r0.x, r0.y); w.y = pk2(r0.z, r0.w); w.z = pk2(r1.x, r1.y); w.w = pk2(r1.z, r1.w);
                    *(u32x4*)(merged + (size_t)(row0 + ai * 128 + m * 16) * 1024 + dcol0 + bj * 128) = w; }
        }
    }
};
struct EpiRes {
    static constexpr bool PERM = true, AFTER_DRAIN = false;
    const float* xin; float* out;
    DI void operator()(const f32x4 (&acc)[2][2][4][2], const pg8::Unit& u, int wr, int wc, int fr, int fq) const {
        const int row0 = u.pm * 256 + wr * 64 + fr, col0 = u.pn * 256 + wc * 32 + 8 * fq;
#pragma unroll
        for (int ai = 0; ai < 2; ++ai)
#pragma unroll
            for (int mh = 0; mh < 2; ++mh) {
                f32x4 xa[2][2][2];
#pragma unroll
                for (int m2 = 0; m2 < 2; ++m2)
#pragma unroll
                    for (int bj = 0; bj < 2; ++bj) { const size_t off = (size_t)(row0 + ai * 128 + (mh * 2 + m2) * 16) * 1024 + col0 + bj * 128; xa[m2][bj][0] = *(const f32x4*)(xin + off); xa[m2][bj][1] = *(const f32x4*)(xin + off + 4); }
#pragma unroll
                for (int m2 = 0; m2 < 2; ++m2)
#pragma unroll
                    for (int bj = 0; bj < 2; ++bj) { const size_t off = (size_t)(row0 + ai * 128 + (mh * 2 + m2) * 16) * 1024 + col0 + bj * 128;
                        *(f32x4*)(out + off) = xa[m2][bj][0] + acc[ai][bj][mh * 2 + m2][0]; *(f32x4*)(out + off + 4) = xa[m2][bj][1] + acc[ai][bj][mh * 2 + m2][1]; }
            }
    }
};
struct EpiPle {
    static constexpr bool PERM = true, AFTER_DRAIN = false;
    float* x; const bf16_t* pp; const float* ssq;
    DI void operator()(const f32x4 (&acc)[2][2][4][2], const pg8::Unit& u, int wr, int wc, int fr, int fq) const {
        const int row0 = u.pm * 256 + wr * 64 + fr, col0 = u.pn * 256 + wc * 32 + 8 * fq;
#pragma unroll
        for (int ai = 0; ai < 2; ++ai)
#pragma unroll
            for (int mh = 0; mh < 2; ++mh) {
                f32x4 xa[2][2][2]; u32x4 ga[2][2]; f32x4 sq[2][2];
#pragma unroll
                for (int m2 = 0; m2 < 2; ++m2) { const float* sp = ssq + (size_t)(row0 + ai * 128 + (mh * 2 + m2) * 16) * 8; sq[m2][0] = *(const f32x4*)sp; sq[m2][1] = *(const f32x4*)(sp + 4);
#pragma unroll
                    for (int bj = 0; bj < 2; ++bj) { const size_t off = (size_t)(row0 + ai * 128 + (mh * 2 + m2) * 16) * 1024 + col0 + bj * 128;
                        xa[m2][bj][0] = *(const f32x4*)(x + off); xa[m2][bj][1] = *(const f32x4*)(x + off + 4); ga[m2][bj] = *(const u32x4*)(pp + off); } }
#pragma unroll
                for (int m2 = 0; m2 < 2; ++m2) {
                    const float rr = rsqrtf((((sq[m2][0].x + sq[m2][0].y) + (sq[m2][0].z + sq[m2][0].w)) + ((sq[m2][1].x + sq[m2][1].y) + (sq[m2][1].z + sq[m2][1].w))) * (1.f / 1024.f) + 1e-6f);
#pragma unroll
                    for (int bj = 0; bj < 2; ++bj) { const size_t off = (size_t)(row0 + ai * 128 + (mh * 2 + m2) * 16) * 1024 + col0 + bj * 128;
                        const f32x4 v0 = acc[ai][bj][mh * 2 + m2][0] * rr, v1 = acc[ai][bj][mh * 2 + m2][1] * rr; const u32x4 g = ga[m2][bj]; f32x4 x0 = xa[m2][bj][0], x1 = xa[m2][bj][1];
                        x0.x += sigm(v0.x) * lo16(g.x); x0.y += sigm(v0.y) * hi16(g.x); x0.z += sigm(v0.z) * lo16(g.y); x0.w += sigm(v0.w) * hi16(g.y);
                        x1.x += sigm(v1.x) * lo16(g.z); x1.y += sigm(v1.y) * hi16(g.z); x1.z += sigm(v1.z) * lo16(g.w); x1.w += sigm(v1.w) * hi16(g.w);
                        *(f32x4*)(x + off) = x0; *(f32x4*)(x + off + 4) = x1; } }
            }
    }
};


DI void unpack8(const u32x4 w, float (&f)[8]) { f[0] = lo16(w.x); f[1] = hi16(w.x); f[2] = lo16(w.y); f[3] = hi16(w.y); f[4] = lo16(w.z); f[5] = hi16(w.z); f[6] = lo16(w.w); f[7] = hi16(w.w); }
DI u32x4 pack8(const float (&f)[8]) { u32x4 o; o.x = pk2(f[0], f[1]); o.y = pk2(f[2], f[3]); o.z = pk2(f[4], f[5]); o.w = pk2(f[6], f[7]); return o; }
DI void load8f(const float* p, float (&f)[8]) { const f32x4 a = *(const f32x4*)p, b = *(const f32x4*)(p + 4); f[0] = a.x; f[1] = a.y; f[2] = a.z; f[3] = a.w; f[4] = b.x; f[5] = b.y; f[6] = b.z; f[7] = b.w; }

DI void phase_chunk(const Params& p, int l, const Frame& F) {
    unsigned char* ws = p.ws; const int lane = F.lane, wave = F.wave;
    bf16_t* PROJ = (bf16_t*)(ws + WS_PROJ); bf16_t* YA = (bf16_t*)(ws + WS_Y); bf16_t* YC = YA + (size_t)2 * T * 512; bf16_t* CMPA = (bf16_t*)(ws + WS_CMPA);
    const bf16_t* SGUW = (const bf16_t*)(ws + WS_SGUW);
    LAS unsigned char* vnT = F.lds;
    const float* convw = p.in[I_CONVW] + (size_t)l * 3 * 512; const float* lng = p.in[I_LNG] + (size_t)l * 512; const float* sgub = p.in[I_SGUB] + (size_t)l * 8 * 128;
    float cw0[8], cw1[8], cw2[8], lgn[8];
    load8f(convw + lane * 8, cw0); load8f(convw + 512 + lane * 8, cw1); load8f(convw + 1024 + lane * 8, cw2); load8f(lng + lane * 8, lgn);
    for (int chunk = F.vb; chunk < T / 128; chunk += F.G) {
        const int t0 = chunk * 128;
        for (int tt = wave; tt < 128; tt += 8) {
            const int t = t0 + tt, s = t & (SEQ - 1), b = t >> 12;
            bf16_t* row = PROJ + (size_t)t * PW;
            const int c0 = lane * 8;
            const u32x4 z = {0u, 0u, 0u, 0u};
            const u32x4 rab = *(const u32x4*)(row + C_AB + c0), rc0 = *(const u32x4*)(row + C_AC + c0), rx0 = *(const u32x4*)(row + C_AX + c0);
            u32x4 r1c = z, r1x = z, r2c = z, r2x = z;
            if (s >= 1) { r1c = *(const u32x4*)(row - PW + C_AC + c0); r1x = *(const u32x4*)(row - PW + C_AX + c0); }
            if (s >= 2) { r2c = *(const u32x4*)(row - 2 * PW + C_AC + c0); r2x = *(const u32x4*)(row - 2 * PW + C_AX + c0); }
            u32x4 segv[3]; int segcol[3]; const float* seggp[3]; float segsc[3];
#pragma unroll
            for (int pass = 0; pass < 3; ++pass) {
                const int seg = pass * 8 + (lane >> 3), sg = seg < 20 ? seg : 20; int col; const float* gp; float sc = 1.f;
                if (sg < 8) { col = C_NQ + 64 * sg; gp = p.in[I_NQG] + l * 64; sc = 0.125f * 1.44269504f; }
                else if (sg < 10) { col = C_NKV + 2 * 128 + (sg - 8) * 64; gp = p.in[I_NKG] + (l * 3 + 1) * 64; }
                else if (sg < 12) { col = C_NKV + 4 * 128 + (sg - 10) * 64; gp = p.in[I_NKG] + (l * 3 + 2) * 64; }
                else if (sg < 20) { col = C_DQ + 64 * (sg - 12); gp = p.in[I_DQG] + l * 64; sc = 0.125f * 1.44269504f; }
                else { col = C_DK; gp = p.in[I_DKG] + l * 64; }
                segcol[pass] = col; seggp[pass] = gp; segsc[pass] = sc; segv[pass] = *(const u32x4*)(row + col + (lane & 7) * 8);
            }
            u32x4 rawc = z; const bf16_t* rawsrc = row; bf16_t* rawdst = nullptr;
            if (lane < 48) { const int sgc = lane >> 3;
                if (sgc < 2) { rawsrc = row + C_NKV + 3 * 128 + sgc * 64; rawdst = (bf16_t*)(ws + WS_VS) + ((size_t)((b * 2 + sgc) * SEQ + s)) * 64; }
                else if (sgc < 4) { rawsrc = row + C_NKV + 5 * 128 + (sgc - 2) * 64; rawdst = (bf16_t*)(ws + WS_VW) + ((size_t)((b * 2 + (sgc - 2)) * SEQ + s)) * 64; }
                else if (sgc == 4) { rawsrc = row + C_DV; rawdst = (bf16_t*)(ws + WS_DV) + (size_t)t * 64; }
                else { rawsrc = row + C_DKI; rawdst = (bf16_t*)(ws + WS_DKI) + (size_t)t * 64; }
                rawc = *(const u32x4*)(rawsrc + (lane & 7) * 8); }
            u32x4 cmpc = z;
            if (lane < 32) { const int jg = lane >> 3; cmpc = *(const u32x4*)(row + C_NKV + (jg >> 1) * 128 + (jg & 1) * 64 + (lane & 7) * 8); }
            const u32x4 ruv = *(const u32x4*)(row + C_UV + 512 + lane * 8);
            {
                float ab[8], c0v[8], x0v[8], c1v[8], x1v[8], c2v[8], x2v[8], y[8];
                unpack8(rab, ab); unpack8(rc0, c0v); unpack8(rx0, x0v); unpack8(r1c, c1v); unpack8(r1x, x1v); unpack8(r2c, c2v); unpack8(r2x, x2v);
#pragma unroll
                for (int e = 0; e < 8; ++e) y[e] = ab[e] * (cw2[e] * c0v[e] * x0v[e] + cw1[e] * c1v[e] * x1v[e] + cw0[e] * c2v[e] * x2v[e]);
                *(u32x4*)(YA + (size_t)t * 512 + c0) = pack8(y);
            }
#pragma unroll
            for (int pass = 0; pass < 3; ++pass) {
                const int seg = pass * 8 + (lane >> 3), part = lane & 7, sg = seg < 20 ? seg : 20;
                float v[8], g[8]; unpack8(segv[pass], v); load8f(seggp[pass] + part * 8, g);
                float ss = 0.f;
#pragma unroll
                for (int e = 0; e < 8; ++e) ss += v[e] * v[e];
                ss = oct_sumf(ss);
                const float r = rsqrtf(ss * (1.f / 64.f) + 1e-6f) * segsc[pass];
#pragma unroll
                for (int e = 0; e < 8; ++e) v[e] = v[e] * r * g[e];
                bf16_t* dstp = row + segcol[pass] + part * 8;
                if (sg >= 8 && sg < 10) dstp = (bf16_t*)(ws + WS_KS) + ((size_t)((b * 2 + (sg - 8)) * SEQ + s)) * 64 + part * 8;
                else if (sg >= 10 && sg < 12) dstp = (bf16_t*)(ws + WS_KW) + ((size_t)((b * 2 + (sg - 10)) * SEQ + s)) * 64 + part * 8;
                else if (sg == 20) dstp = (bf16_t*)(ws + WS_DK) + (size_t)t * 64 + part * 8;
                if (seg < 21) *(u32x4*)dstp = pack8(v);
            }
            if (lane < 48) *(u32x4*)(rawdst + (lane & 7) * 8) = rawc;
            if (lane < 32) { const int jg = lane >> 3, j = jg >> 1, g = jg & 1, part = lane & 7;
                *(u32x4*)(CMPA + ((size_t)j * 4096 + ((size_t)(b * 256 + (s >> 4)) * 2 + g)) * 1024 + (s & 15) * 64 + part * 8) = cmpc; }
            {
                float v[8]; unpack8(ruv, v);
                float sm = 0.f;
#pragma unroll
                for (int e = 0; e < 8; ++e) { v[e] = gelu_t(v[e]); sm += v[e]; }
                const float mean = wave_sum(sm) * (1.f / 512.f); float sq = 0.f;
#pragma unroll
                for (int e = 0; e < 8; ++e) { v[e] -= mean; sq += v[e] * v[e]; }
                const float r = rsqrtf(wave_sum(sq) * (1.f / 512.f) + 1e-6f);
#pragma unroll
                for (int e = 0; e < 8; ++e) *(LAS unsigned short*)(vnT + (lane * 8 + e) * 272 + tt * 2) = (unsigned short)f2bf(v[e] * r * lgn[e]);
            }
        }
        __syncthreads();
        {
            const int g = wave, c = lane & 15, q = lane >> 4; const bf16_t* Wg = SGUW + (size_t)g * 128 * 128;
            for (int tt16 = 0; tt16 < 8; ++tt16) {
                const int nk = (tt16 >> 1) + 1;
                bf16x8 bw[4];
#pragma unroll
                for (int kk = 0; kk < 4; ++kk) bw[kk] = *(const bf16x8*)(Wg + (size_t)(16 * tt16 + c) * 128 + 32 * (kk < nk ? kk : 0) + 8 * q);
                const int t = t0 + 16 * tt16 + c; const float bias = sgub[g * 128 + 16 * tt16 + c];
#pragma unroll
                for (int dt = 0; dt < 4; ++dt) {
                    f32x4 acc = {0.f, 0.f, 0.f, 0.f};
#pragma unroll
                    for (int kk = 0; kk < 4; ++kk) if (kk < nk) { const bf16x8 a = *(const LAS bf16x8*)(vnT + (g * 64 + 16 * dt + c) * 272 + (32 * kk + 8 * q) * 2); acc = MFMA16(a, bw[kk], acc); }
                    const int ch = g * 64 + 16 * dt + 4 * q;
                    const u32x2 uu = *(const u32x2*)(PROJ + (size_t)t * PW + C_UV + ch);
                    u32x2 o; o.x = pk2(gelu_t(lo16(uu.x)) * (acc[0] + bias), gelu_t(hi16(uu.x)) * (acc[1] + bias)); o.y = pk2(gelu_t(lo16(uu.y)) * (acc[2] + bias), gelu_t(hi16(uu.y)) * (acc[3] + bias));
                    *(u32x2*)(YC + (size_t)t * 512 + ch) = o;
                }
            }
        }
        __syncthreads();
    }
}

DI void phase_cmp2(const Params& p, int l, const Frame& F) {
    unsigned char* ws = p.ws; const int lane = F.lane; const int gw = F.vb * 8 + F.wave, NGW = F.G * 8;
    LAS float* hid = (LAS float*)(F.lds + 131072 + F.wave * 1024);
    LAS float* w2s = (LAS float*)F.lds;
    { const float* w2g = p.in[I_CW2] + (size_t)l * 2 * 256 * 64;
      for (int i = F.tid; i < 2 * 256 * 64 / 4; i += 512) *(LAS f32x4*)(w2s + i * 4) = *(const f32x4*)(w2g + i * 4); }
    __syncthreads();
    const float* CMPP = (const float*)(ws + WS_CMPP); const float* peb = (const float*)(ws + WS_PEB);
    bf16_t* CMPK = (bf16_t*)(ws + WS_CMPK); bf16_t* CMPV = (bf16_t*)(ws + WS_CMPV);
    const float* kg = p.in[I_NKG] + (l * 3 + 0) * 64;
    for (int it = gw; it < 8 * 256 * 2 * 2; it += NGW) {
        const int j = it & 1, g = (it >> 1) & 1, n = (it >> 2) & 255, b = it >> 10;
        bf16_t* dst = (j ? CMPV : CMPK) + ((size_t)(b * 2 + g) * 256 + n) * 64;
        if (n == 255) { dst[lane] = 0; continue; }
        const float* Pa = CMPP + ((size_t)j * 4096 + (size_t)(b * 256 + n) * 2 + g) * 512; const float* Pb = CMPP + ((size_t)j * 4096 + (size_t)(b * 256 + n + 1) * 2 + g) * 512 + 256;
        const f32x4 a = *(const f32x4*)(Pa + lane * 4), bq = *(const f32x4*)(Pb + lane * 4), pe = *(const f32x4*)(peb + j * 256 + lane * 4);
        f32x4 h; h.x = gelu_t(a.x + bq.x + pe.x); h.y = gelu_t(a.y + bq.y + pe.y); h.z = gelu_t(a.z + bq.z + pe.z); h.w = gelu_t(a.w + bq.w + pe.w);
        *(LAS f32x4*)(hid + lane * 4) = h;
        LDS_WAIT();
        const LAS float* w2 = w2s + j * 256 * 64;
        float o = 0.f;
#pragma unroll 16
        for (int k = 0; k < 256; ++k) o += hid[k] * w2[k * 64 + lane];
        if (j == 0) { const float ss = wave_sum(o * o); o = o * rsqrtf(ss * (1.f / 64.f) + 1e-6f) * kg[lane]; }
        dst[lane] = (bf16_t)f2bf(o);
        LDS_WAIT();
    }
}

DI int bucket_fast(int n) { const int big = 16 + (int)((__log2f((float)n) - 4.f) * 2.6666667f + 2e-4f); return n < 16 ? n : (big < 31 ? big : 31); }
struct KsCmp { static constexpr bool CONTIG = true; static constexpr int DSTEP = 16, DMAX = 1 << 30; const bf16_t* kb; const bf16_t* vb; int t0, hb;
    DI void base(int k0, const bf16_t*& k, const bf16_t*& v) const { k = kb + (size_t)k0 * 64; v = vb + (size_t)k0 * 64; }
    DI int dist0(int k0, int c) const { return t0 + (c >> 2) - (16 * k0 + 31); } };
struct KsSel { static constexpr bool CONTIG = true; static constexpr int DSTEP = 1, DMAX = 1 << 30; const bf16_t* kb; const bf16_t* vb; const LAS int* selb; int t, hb;
    DI int p0(int k0) const { return __builtin_amdgcn_readfirstlane(selb[k0 >> 6]) * 64 + (k0 & 63); }
    DI void base(int k0, const bf16_t*& k, const bf16_t*& v) const { const int ps = p0(k0); k = kb + (size_t)ps * 64; v = vb + (size_t)ps * 64; }
    DI int dist0(int k0, int c) const { return t - p0(k0); } };
struct KsWin { static constexpr bool CONTIG = true; static constexpr int DSTEP = 1, DMAX = 512; const bf16_t* kb; const bf16_t* vb; int pstart, t0, hb;
    DI void base(int k0, const bf16_t*& k, const bf16_t*& v) const { k = kb + (size_t)(pstart + k0) * 64; v = vb + (size_t)(pstart + k0) * 64; }
    DI int dist0(int k0, int c) const { return t0 + (c >> 2) - (pstart + k0); } };
struct KsDsa { static constexpr bool CONTIG = false; static constexpr int DSTEP = 1, DMAX = 1 << 30; const bf16_t* kb; const bf16_t* vb; const LAS int* list; int n, t;
    DI int pos(int idx) const { return idx < n ? list[idx] : -1; }
    DI const bf16_t* krow(int idx) const { const int ps = pos(idx); return kb + (size_t)(ps < 0 ? 0 : ps) * 64; }
    DI const bf16_t* vrow(int idx) const { const int ps = pos(idx); return vb + (size_t)(ps < 0 ? 0 : ps) * 64; }
    DI float adjust(int idx, int c, float s, bool& ok, const LAS unsigned char* buck, const LAS float* tbl) const {
        const int ps = pos(idx); ok = ps >= 0 && ps <= t; const int dd = t - ps; const int dc = ok ? (dd < 1023 ? dd : 1023) : 0; return s + tbl[buck[dc] * 16 + 8 + (c & 7)]; } };

template <int MODE, class KS>
DI void flash_run(const KS& ks, int nkeys, const bf16x8 (&qb)[2], f32x4 (&o)[4], float& m_run, float& l_run, LAS unsigned char* vt, LAS float* al, LAS float* pn,
                  const LAS unsigned char* buck, const LAS float* tbl, int lane) {
    const int c = lane & 15, q = lane >> 4;
    bf16x8 A00, A01, A10, A11, B00, B01, B10, B11; u32x4 Av[4], Bv[4];
#define FL_LOAD(B_, kk0) do { if constexpr (KS::CONTIG) { const bf16_t* kbp_; const bf16_t* vbp_; ks.base((kk0), kbp_, vbp_); const bf16_t* kr0 = kbp_ + c * 64 + 8 * q; \
            B_##00 = *(const bf16x8*)kr0; B_##01 = *(const bf16x8*)(kr0 + 32); B_##10 = *(const bf16x8*)(kr0 + 1024); B_##11 = *(const bf16x8*)(kr0 + 1056); \
            if (MODE != 1) { const bf16_t* vr0 = vbp_ + (lane >> 3) * 64 + (lane & 7) * 8; _Pragma("unroll") for (int m = 0; m < 4; ++m) B_##v[m] = *(const u32x4*)(vr0 + m * 512); } } \
        else { const bf16_t* kr0 = ks.krow((kk0) + c); const bf16_t* kr1 = ks.krow((kk0) + 16 + c); \
            B_##00 = *(const bf16x8*)(kr0 + 8 * q); B_##01 = *(const bf16x8*)(kr0 + 32 + 8 * q); B_##10 = *(const bf16x8*)(kr1 + 8 * q); B_##11 = *(const bf16x8*)(kr1 + 32 + 8 * q); \
            if (MODE != 1) { _Pragma("unroll") for (int m = 0; m < 4; ++m) B_##v[m] = *(const u32x4*)(ks.vrow((kk0) + (lane >> 3) + 8 * m) + (lane & 7) * 8); } } } while (0)
#define FL_STEP(B_, K0_) do { \
        f32x4 s0 = {0.f, 0.f, 0.f, 0.f}, s1 = {0.f, 0.f, 0.f, 0.f}; \
        s0 = MFMA16(B_##00, qb[0], s0); s0 = MFMA16(B_##01, qb[1], s0); s1 = MFMA16(B_##10, qb[0], s1); s1 = MFMA16(B_##11, qb[1], s1); \
        float sv[8], pv[8]; bool ok[8]; \
        if constexpr (KS::CONTIG) { \
            const LAS float* trow = tbl + (c & 3) * 1024; const int d0 = ks.dist0((K0_), c) - KS::DSTEP * 4 * q; \
        _Pragma("unroll") \
            for (int i = 0; i < 4; ++i) { const int da = d0 - KS::DSTEP * i, db = da - KS::DSTEP * 16; \
                ok[i] = da >= 0 && da < KS::DMAX; ok[4 + i] = db >= 0 && db < KS::DMAX; \
                sv[i] = s0[i] + trow[da < 0 ? 0 : (da < 1023 ? da : 1023)]; sv[4 + i] = s1[i] + trow[db < 0 ? 0 : (db < 1023 ? db : 1023)]; } \
        } else { \
        _Pragma("unroll") \
            for (int i = 0; i < 4; ++i) { sv[i] = ks.adjust((K0_) + 4 * q + i, c, s0[i], ok[i], buck, tbl); sv[4 + i] = ks.adjust((K0_) + 16 + 4 * q + i, c, s1[i], ok[4 + i], buck, tbl); } \
        } \
        if (MODE == 2) { \
        _Pragma("unroll") \
            for (int e = 0; e < 8; ++e) { pv[e] = ok[e] ? __builtin_amdgcn_exp2f(sv[e]) * l_run : 0.f; \
                const float x = quad_sumf(pv[e]); \
                if ((c & 3) == 0) pn[(c >> 2) * 256 + (K0_) + (e < 4 ? 4 * q + e : 16 + 4 * q + (e - 4))] = x; } \
        } else { \
            float ps = 0.f; \
        _Pragma("unroll") \
            for (int e = 0; e < 8; ++e) { pv[e] = ok[e] ? __builtin_amdgcn_exp2f(sv[e]) : 0.f; ps += pv[e]; } \
            l_run += ps; \
        } \
        if (MODE != 1) { \
        _Pragma("unroll") \
            for (int m = 0; m < 4; ++m) *(LAS u32x4*)(vt + ((lane >> 3) + 8 * m) * 144 + (lane & 7) * 16) = B_##v[m]; \
            LDS_FENCE(); \
            const bf16x8 pa = __builtin_bit_cast(bf16x8, pack8(pv)); \
        _Pragma("unroll") \
            for (int dt = 0; dt < 4; ++dt) { \
                const s16x4 lo = __builtin_amdgcn_ds_read_tr16_b64_v4i16((LAS s16x4*)(vt + (4 * q + (c >> 2)) * 144 + (16 * dt + 4 * (c & 3)) * 2)); \
                const s16x4 hi = __builtin_amdgcn_ds_read_tr16_b64_v4i16((LAS s16x4*)(vt + (16 + 4 * q + (c >> 2)) * 144 + (16 * dt + 4 * (c & 3)) * 2)); \
                const bf16x8 vb8 = __builtin_shufflevector(lo, hi, 0, 1, 2, 3, 4, 5, 6, 7); \
                o[dt] = MFMA16(pa, vb8, o[dt]); \
            } \
            LDS_FENCE(); \
        } \
    } while (0)
    if (nkeys > 0) FL_LOAD(A, 0);
    for (int k0 = 0; k0 < nkeys; k0 += 64) {
        if (k0 + 32 < nkeys) FL_LOAD(B, k0 + 32);
        FL_STEP(A, k0);
        if (k0 + 32 >= nkeys) break;
        if (k0 + 64 < nkeys) FL_LOAD(A, k0 + 64);
        FL_STEP(B, k0 + 32);
    }
#undef FL_STEP
#undef FL_LOAD
    if (MODE == 0) {
        float lt = x32_sum(x16_sum(l_run));
        const float inv = lt > 0.f ? __builtin_amdgcn_rcpf(lt) : 0.f;
        if (q == 0) al[c] = inv;
        LDS_WAIT();
        const f32x4 a4 = *(const LAS f32x4*)(al + 4 * q);
#pragma unroll
        for (int dt = 0; dt < 4; ++dt) o[dt] = o[dt] * a4;
        LDS_WAIT();
    }
}

DI void nsa_tile(const Params& p, int b, int g, int tb, const Frame& F, const LAS float* lut, int vm = 0) {
    unsigned char* ws = p.ws; const int lane = F.lane, wave = F.wave, c = lane & 15, q = lane >> 4;
    const LAS float* tbl = lut + g * 4096;
    LAS unsigned char* wl = F.lds + wave * 9216; LAS unsigned char* vt = wl; LAS float* al = (LAS float*)(wl + 4608); LAS float* pn = (LAS float*)(wl + 4736);
    LAS float* OS = (LAS float*)F.lds; LAS float* LS = (LAS float*)(F.lds + 65536);
    LAS int* SELB = (LAS int*)(F.lds + 73728); LAS int* CNT = (LAS int*)(F.lds + 75776); LAS unsigned short* UNIT = (LAS unsigned short*)(F.lds + 76032); LAS int* NUNIT = (LAS int*)(F.lds + 76416);
    volatile LAS int* TURN = (volatile LAS int*)(F.lds + 76544); LAS unsigned short* LIST = (LAS unsigned short*)(F.lds + 76800);
    LAS unsigned char* vt2 = F.lds + 84992 + wave * 4608;
    const bf16_t* prow0 = (const bf16_t*)(ws + WS_PROJ) + (size_t)(b * SEQ) * PW;
    bf16_t* YB = (bf16_t*)(ws + WS_Y) + (size_t)T * 512;
    const f32x4 z4 = {0.f, 0.f, 0.f, 0.f};
    for (int ii = 0; ii < 2; ++ii) {
        f32x4 accw[4];
        const int item = wave * 2 + ii, t0 = 64 * tb + 4 * item;
#pragma unroll
        for (int k = 0; k < 4; ++k) *(LAS f32x4*)(pn + lane * 4 + 256 * k) = z4;
        bf16x8 qb[2];
        { const bf16_t* qp = prow0 + (size_t)(t0 + (c >> 2)) * PW + C_NQ + (g * 4 + (c & 3)) * 64 + 8 * q; qb[0] = *(const bf16x8*)qp; qb[1] = *(const bf16x8*)(qp + 32); }
        float g0[4], g2[4];
        { const u32x2 ga = *(const u32x2*)(prow0 + (size_t)(t0 + q) * PW + C_NG + 0 * 8 + g * 4), gc = *(const u32x2*)(prow0 + (size_t)(t0 + q) * PW + C_NG + 2 * 8 + g * 4);
          g0[0] = sigm(lo16(ga.x)); g0[1] = sigm(hi16(ga.x)); g0[2] = sigm(lo16(ga.y)); g0[3] = sigm(hi16(ga.y));
          g2[0] = sigm(lo16(gc.x)); g2[1] = sigm(hi16(gc.x)); g2[2] = sigm(lo16(gc.y)); g2[3] = sigm(hi16(gc.y)); }
#pragma unroll
        for (int dt = 0; dt < 4; ++dt) accw[dt] = z4;
        LDS_WAIT();
        const int tl = t0 + 3, nv = tl >= 31 ? ((tl - 31) >> 4) + 1 : 0;
        if (nv > 0 && (vm == 0 || (vm & 1))) {
            const int nk = (nv + 31) & ~31;
            KsCmp ks{(const bf16_t*)(ws + WS_CMPK) + (size_t)(b * 2 + g) * 256 * 64, (const bf16_t*)(ws + WS_CMPV) + (size_t)(b * 2 + g) * 256 * 64, t0, g * 4};
            float m = 0.f, lr = 0.f; f32x4 o[4] = {z4, z4, z4, z4};
            flash_run<1>(ks, nk, qb, o, m, lr, vt, al, pn, (const LAS unsigned char*)vt, tbl, lane);
            lr = x32_sum(x16_sum(lr)); lr = lr > 0.f ? __builtin_amdgcn_rcpf(lr) : 0.f;
            flash_run<2>(ks, nk, qb, o, m, lr, vt, al, pn, (const LAS unsigned char*)vt, tbl, lane);
#pragma unroll
            for (int dt = 0; dt < 4; ++dt) { accw[dt][0] = g0[0] * o[dt][0]; accw[dt][1] = g0[1] * o[dt][1]; accw[dt][2] = g0[2] * o[dt][2]; accw[dt][3] = g0[3] * o[dt][3]; }
        }
        LDS_WAIT();
        {
            const int j = lane; float val[4];
#pragma unroll
            for (int qi = 0; qi < 4; ++qi) {
                if (j == 0 || j == tb) val[qi] = 1e4f;
                else if (j < tb) { const LAS float* pq = pn + qi * 256 + 4 * j; val[qi] = pq[-1] + pq[0] + pq[1] + pq[2] + pq[3]; }
                else val[qi] = -1e30f;
            }
            for (int k = 0; k < 8; ++k) {
#pragma unroll
                for (int qi = 0; qi < 4; ++qi) {
                    const float mx = wave_max(val[qi]); const unsigned long long who = __ballot(val[qi] == mx); const int w = __builtin_ctzll(who);
                    if (lane == 0) SELB[(item * 4 + qi) * 8 + k] = mx > -1e29f ? w : -1;
                    if (lane == w) val[qi] = -3e38f;
                }
            }
        }
        {
            const int pstart = t0 >= 511 ? t0 - 511 : 0, nk = (t0 + 3 - pstart + 1 + 31) & ~31;
            KsWin ks{(const bf16_t*)(ws + WS_KW) + (size_t)(b * 2 + g) * SEQ * 64, (const bf16_t*)(ws + WS_VW) + (size_t)(b * 2 + g) * SEQ * 64, pstart, t0, g * 4};
            float m = 0.f, lr = 0.f; f32x4 o[4] = {z4, z4, z4, z4};
            if (vm == 0 || (vm & 2)) flash_run<0>(ks, nk, qb, o, m, lr, vt, al, pn, (const LAS unsigned char*)vt, tbl, lane);
            if (vm & 4) { flash_run<1>(ks, nk, qb, o, m, lr, vt, al, pn, (const LAS unsigned char*)vt, tbl, lane); o[0][0] += lr; }
#pragma unroll
            for (int dt = 0; dt < 4; ++dt) { accw[dt][0] += g2[0] * o[dt][0]; accw[dt][1] += g2[1] * o[dt][1]; accw[dt][2] += g2[2] * o[dt][2]; accw[dt][3] += g2[3] * o[dt][3]; }
        }
        if (vm == 0) {
            bf16_t* dst = YB + (size_t)(b * SEQ + t0 + q) * 512 + (g * 4) * 64 + c;
#pragma unroll
            for (int dt = 0; dt < 4; ++dt)
#pragma unroll
                for (int i = 0; i < 4; ++i) dst[i * 64 + 16 * dt] = (bf16_t)f2bf(accw[dt][i]);
        }
        else { asm volatile("" :: "v"(accw[0]), "v"(accw[1]), "v"(accw[2]), "v"(accw[3])); }
        LDS_WAIT();
    }
    __syncthreads();
    if (vm != 0) return;
    for (int i = F.tid; i < 66560 / 16; i += 512) *(LAS f32x4*)(F.lds + i * 16) = z4;
    if (F.tid < 64) { CNT[F.tid] = 0; TURN[F.tid] = 0; }
    __syncthreads();
    { const int blk = SELB[F.tid];
      if (blk >= 0) { int rank = 0;
#pragma unroll
          for (int k = 0; k < 8; ++k) { const int ob = SELB[(F.tid & ~7) + k]; rank += (ob >= 0 && ob < blk) ? 1 : 0; }
          const int pos = __hip_atomic_fetch_add(CNT + blk, 1, __ATOMIC_RELAXED, __HIP_MEMORY_SCOPE_WORKGROUP); LIST[blk * 64 + pos] = (unsigned short)((F.tid >> 3) | (rank << 8)); } }
    __syncthreads();
    if (wave == 0) {
        const int uj = (CNT[lane] + 3) >> 2; int inc = uj;
#pragma unroll
        for (int o_ = 1; o_ < 64; o_ <<= 1) { const int v = __shfl_up(inc, o_); if (lane >= o_) inc += v; }
        const int offs = inc - uj;
        for (int u = 0; u < uj; ++u) UNIT[offs + u] = (unsigned short)(lane | (u << 8));
        if (lane == 63) NUNIT[0] = inc;
    }
    __syncthreads();
    {
        const int nu = NUNIT[0];
        const LAS float* trow = tbl + (c & 3) * 1024;
        const bf16_t* KSb = (const bf16_t*)(ws + WS_KS) + (size_t)(b * 2 + g) * SEQ * 64; const bf16_t* VSb = (const bf16_t*)(ws + WS_VS) + (size_t)(b * 2 + g) * SEQ * 64;
        for (int ui = wave; ui < nu; ui += 8) {
            const int uu = UNIT[ui], j = uu & 255, u = uu >> 8, nj = CNT[j];
            const int slot = 4 * u + (c >> 2); const int qrow = slot < nj ? (int)(LIST[j * 64 + slot] & 255) : -1;
            const int slotq = 4 * u + q; const int qo = slotq < nj ? (int)(LIST[j * 64 + slotq] & 255) : -1;
            bf16x8 qs[2] = {(bf16x8){0, 0, 0, 0, 0, 0, 0, 0}, (bf16x8){0, 0, 0, 0, 0, 0, 0, 0}};
            if (qrow >= 0) { const bf16_t* qp = prow0 + (size_t)(64 * tb + qrow) * PW + C_NQ + (g * 4 + (c & 3)) * 64 + 8 * q; qs[0] = *(const bf16x8*)qp; qs[1] = *(const bf16x8*)(qp + 32); }
            const bf16_t* kb0 = KSb + (size_t)(64 * j) * 64; const bf16_t* vb0 = VSb + (size_t)(64 * j) * 64;
            bf16x8 ka[4]; u32x4 vv[4];
#define SEL_LOADK(st) do { const bf16_t* kr0 = kb0 + (32 * (st) + c) * 64 + 8 * q; ka[0] = *(const bf16x8*)kr0; ka[1] = *(const bf16x8*)(kr0 + 32); ka[2] = *(const bf16x8*)(kr0 + 1024); ka[3] = *(const bf16x8*)(kr0 + 1056); } while (0)
#define SEL_LOADV(st) do { const bf16_t* vr0 = vb0 + (32 * (st) + (lane >> 3)) * 64 + (lane & 7) * 8; _Pragma("unroll") for (int m = 0; m < 4; ++m) vv[m] = *(const u32x4*)(vr0 + m * 512); } while (0)
            SEL_LOADK(0); SEL_LOADV(0);
            f32x4 o[4] = {z4, z4, z4, z4}; float lsum = 0.f;
#pragma unroll
            for (int st = 0; st < 2; ++st) {
                f32x4 s0 = z4, s1 = z4;
                s0 = MFMA16(ka[0], qs[0], s0); s0 = MFMA16(ka[1], qs[1], s0); s1 = MFMA16(ka[2], qs[0], s1); s1 = MFMA16(ka[3], qs[1], s1);
                if (st == 0) SEL_LOADK(1);
                const int d0 = 64 * (tb - j) + (qrow < 0 ? 0 : qrow) - 32 * st - 4 * q; float pv[8];
#pragma unroll
                for (int i = 0; i < 4; ++i) { const int da = d0 - i, db = da - 16;
                    const float ea = __builtin_amdgcn_exp2f(s0[i] + trow[da < 0 ? 0 : (da < 1023 ? da : 1023)]), eb = __builtin_amdgcn_exp2f(s1[i] + trow[db < 0 ? 0 : (db < 1023 ? db : 1023)]);
                    pv[i] = (qrow >= 0 && da >= 0) ? ea : 0.f; pv[4 + i] = (qrow >= 0 && db >= 0) ? eb : 0.f; lsum += pv[i] + pv[4 + i]; }
#pragma unroll
                for (int m = 0; m < 4; ++m) *(LAS u32x4*)(vt2 + ((lane >> 3) + 8 * m) * 144 + (lane & 7) * 16) = vv[m];
                if (st == 0) SEL_LOADV(1);
                LDS_FENCE();
                const bf16x8 pa = __builtin_bit_cast(bf16x8, pack8(pv));
#pragma unroll
                for (int dt = 0; dt < 4; ++dt) {
                    const s16x4 lo = __builtin_amdgcn_ds_read_tr16_b64_v4i16((LAS s16x4*)(vt2 + (4 * q + (c >> 2)) * 144 + (16 * dt + 4 * (c & 3)) * 2));
                    const s16x4 hi = __builtin_amdgcn_ds_read_tr16_b64_v4i16((LAS s16x4*)(vt2 + (16 + 4 * q + (c >> 2)) * 144 + (16 * dt + 4 * (c & 3)) * 2));
                    o[dt] = MFMA16(pa, __builtin_shufflevector(lo, hi, 0, 1, 2, 3, 4, 5, 6, 7), o[dt]);
                }
                LDS_FENCE();
            }
#undef SEL_LOADK
#undef SEL_LOADV
            lsum = x32_sum(x16_sum(lsum));
#pragma unroll 1
            for (int s = 0; s < 4; ++s) {
                if (4 * u + s >= nj) break;
                const int ent = LIST[j * 64 + 4 * u + s], qs_ = ent & 255, rk = ent >> 8;
                unsigned spins = 0;
                while (TURN[qs_] != rk) { __builtin_amdgcn_s_sleep(1); if (++spins > (1u << 22)) break; }
                if (q == s) {
#pragma unroll
                    for (int dt = 0; dt < 4; ++dt)
#pragma unroll
                        for (int i = 0; i < 4; ++i) OS[(qs_ * 4 + i) * 64 + 16 * dt + c] += o[dt][i];
                }
                if ((c >> 2) == s && q == 0) LS[qs_ * 4 + (c & 3)] += lsum;
                LDS_WAIT();
                if (lane == 0) TURN[qs_] = rk + 1;
                LDS_WAIT();
            }
        }
    }
    __syncthreads();
    for (int ii = 0; ii < 2; ++ii) {
        const int item = wave * 2 + ii, qq = item * 4 + q, t = 64 * tb + qq;
        const u32x2 gg = *(const u32x2*)(prow0 + (size_t)t * PW + C_NG + 8 + g * 4);
        const float g1[4] = {sigm(lo16(gg.x)), sigm(hi16(gg.x)), sigm(lo16(gg.y)), sigm(hi16(gg.y))};
        const f32x4 l4 = *(const LAS f32x4*)(LS + qq * 4);
        const float inv[4] = {l4.x > 0.f ? g1[0] / l4.x : 0.f, l4.y > 0.f ? g1[1] / l4.y : 0.f, l4.z > 0.f ? g1[2] / l4.z : 0.f, l4.w > 0.f ? g1[3] / l4.w : 0.f};
        bf16_t* dst = YB + (size_t)(b * SEQ + t) * 512 + (g * 4) * 64 + c;
#pragma unroll
        for (int dt = 0; dt < 4; ++dt)
#pragma unroll
            for (int i = 0; i < 4; ++i) dst[i * 64 + 16 * dt] = (bf16_t)f2bf(bf2f(dst[i * 64 + 16 * dt]) + inv[i] * OS[(qq * 4 + i) * 64 + 16 * dt + c]);
    }
    __syncthreads();
}

DI void dsa_group(const Params& p, int b, int t0, const Frame& F, const LAS unsigned char* buck, const LAS float* tbl, int parts = 7) {
    unsigned char* ws = p.ws; const int lane = F.lane, wave = F.wave, c = lane & 15, q = lane >> 4;
    LAS unsigned* SC = (LAS unsigned*)F.lds;
    LAS int* list = (LAS int*)(F.lds + 131072 + wave * 1024); LAS float* al = (LAS float*)(F.lds + 139264 + wave * 64);
    const bf16_t* prow0 = (const bf16_t*)(ws + WS_PROJ) + (size_t)(b * SEQ) * PW;
    bf16_t* YD = (bf16_t*)(ws + WS_Y) + (size_t)3 * T * 512;
    const bf16x8 zf = {0, 0, 0, 0, 0, 0, 0, 0};
    const int t = t0 + wave; const bf16_t* qrow = prow0 + (size_t)t * PW;
    const bf16_t* dki = (const bf16_t*)(ws + WS_DKI) + (size_t)(b * SEQ) * 64;
    const bool full = t0 >= 256;
    if (full && (parts & 1)) {
        bf16x8 qa[4][2]; float wv[4][4];
#pragma unroll
        for (int rt = 0; rt < 4; ++rt) { const bf16_t* qp = prow0 + (size_t)(t0 + 2 * rt + (c >> 3)) * PW + C_DQI + (c & 7) * 64 + 8 * q; qa[rt][0] = *(const bf16x8*)qp; qa[rt][1] = *(const bf16x8*)(qp + 32);
            const u32x2 w4 = *(const u32x2*)(prow0 + (size_t)(t0 + 2 * rt + (q >> 1)) * PW + C_DWI + (q & 1) * 4);
            wv[rt][0] = lo16(w4.x) * 0.35355339f; wv[rt][1] = hi16(w4.x) * 0.35355339f; wv[rt][2] = lo16(w4.y) * 0.35355339f; wv[rt][3] = hi16(w4.y) * 0.35355339f; }
        const int ntile = ((t0 + 7) >> 4) + 1, nk64 = ((t0 + 7) >> 6) + 1;
        bf16x8 kx0, kx1;
        if (wave < ntile) { const bf16_t* kp = dki + (size_t)(16 * wave + c) * 64 + 8 * q; kx0 = *(const bf16x8*)kp; kx1 = *(const bf16x8*)(kp + 32); }
        for (int tau = wave; tau < ntile; tau += 8) {
            const bf16x8 kb0 = kx0, kb1 = kx1;
            if (tau + 8 < ntile) { const bf16_t* kp = dki + (size_t)(16 * (tau + 8) + c) * 64 + 8 * q; kx0 = *(const bf16x8*)kp; kx1 = *(const bf16x8*)(kp + 32); }
            const int key = 16 * tau + c;
#pragma unroll
            for (int rt = 0; rt < 4; ++rt) {
                f32x4 acc = {0.f, 0.f, 0.f, 0.f};
                acc = MFMA16(qa[rt][0], kb0, acc); acc = MFMA16(qa[rt][1], kb1, acc);
                float s = wv[rt][0] * fmaxf(acc[0], 0.f) + wv[rt][1] * fmaxf(acc[1], 0.f) + wv[rt][2] * fmaxf(acc[2], 0.f) + wv[rt][3] * fmaxf(acc[3], 0.f);
                s = x16_sum(s);
                const int qq = 2 * rt + (q >> 1);
                if ((q & 1) == 0) SC[qq * 4096 + key] = key <= t0 + qq ? ordf(s) : 0u;
            }
        }
        for (int i = F.tid; i < 8 * 64; i += 512) { const int key = ntile * 16 + (i & 63); if (key < nk64 * 64) SC[(i >> 6) * 4096 + key] = 0u; }
    }
    __syncthreads();
    int n;
    if (!full) { n = t + 1; for (int i = lane; i < 256; i += 64) list[i] = i <= t ? i : -1; }
    else if (parts & 2) {
        n = 256;
        const LAS unsigned* sc = SC + wave * 4096; const int nk64 = (t >> 6) + 1;
        unsigned u[64];
#pragma unroll
        for (int k = 0; k < 64; ++k) u[k] = k < nk64 ? sc[k * 64 + lane] : 0u;
#define WAVE_TOTAL(cl, tot) do { tot = __builtin_amdgcn_readfirstlane((int)wave_sum_u(cl)); } while (0)
        unsigned prefix = 0u;
        const int nk8 = __builtin_amdgcn_readfirstlane((nk64 + 7) >> 3);
#define CNT_GE(NK) _Pragma("unroll") for (int k = 0; k < NK; ++k) cl += (u[k] >= cand) ? 1u : 0u;
        for (int bit = 31; bit >= 0; --bit) {
            const unsigned cand = prefix | (1u << bit); unsigned cl = 0u; int cnt;
            switch (nk8) { case 1: CNT_GE(8) break; case 2: CNT_GE(16) break; case 3: CNT_GE(24) break; case 4: CNT_GE(32) break;
                           case 5: CNT_GE(40) break; case 6: CNT_GE(48) break; case 7: CNT_GE(56) break; default: CNT_GE(64) break; }
            WAVE_TOTAL(cl, cnt);
            if (cnt >= 256) { prefix = cand; if (cnt == 256) break; }
        }
        int cgt; { unsigned cl = 0u;
#pragma unroll
            for (int k = 0; k < 64; ++k) cl += (u[k] > prefix) ? 1u : 0u;
            WAVE_TOTAL(cl, cgt); }
#undef WAVE_TOTAL
#undef CNT_GE
        const int need_eq = 256 - cgt; int base = 0, eqbase = 0;
#pragma unroll
        for (int k = 0; k < 64; ++k) {
            if (k < nk64) {
                const bool gtp = u[k] > prefix, eq = u[k] == prefix;
                const unsigned long long meq = __ballot(eq);
                const int eqrank = eqbase + (int)__builtin_amdgcn_mbcnt_hi((unsigned)(meq >> 32), __builtin_amdgcn_mbcnt_lo((unsigned)meq, 0u));
                const bool take = gtp || (eq && eqrank < need_eq);
                const unsigned long long mt = __ballot(take);
                const int slot = base + (int)__builtin_amdgcn_mbcnt_hi((unsigned)(mt >> 32), __builtin_amdgcn_mbcnt_lo((unsigned)mt, 0u));
                if (take && slot < 256) list[slot] = k * 64 + lane;
                base += __popcll(mt); eqbase += __popcll(meq);
            }
        }
    }
    else n = 256;
    LDS_WAIT();
    if (!(parts & 4)) { __syncthreads(); return; }
    LAS unsigned char* vt = F.lds + wave * 16384;
    bf16x8 qd[2] = {zf, zf};
    if (c < 8) { qd[0] = *(const bf16x8*)(qrow + C_DQ + c * 64 + 8 * q); qd[1] = *(const bf16x8*)(qrow + C_DQ + c * 64 + 32 + 8 * q); }
    KsDsa ks{(const bf16_t*)(ws + WS_DK) + (size_t)(b * SEQ) * 64, (const bf16_t*)(ws + WS_DV) + (size_t)(b * SEQ) * 64, list, n, t};
    const f32x4 z4 = {0.f, 0.f, 0.f, 0.f};
    float m = -1e30f, lr = 0.f; f32x4 o[4] = {z4, z4, z4, z4};
    flash_run<0>(ks, (n + 31) & ~31, qd, o, m, lr, vt, al, (LAS float*)vt, buck, tbl, lane);
    if (q < 2) {
#pragma unroll
        for (int dt = 0; dt < 4; ++dt)
#pragma unroll
            for (int i = 0; i < 4; ++i) YD[(size_t)(b * SEQ + t) * 512 + (4 * q + i) * 64 + 16 * dt + c] = (bf16_t)f2bf(o[dt][i]);
    }
    __syncthreads();
}

DI void phase_attn(const Params& p, int l, const Frame& F, int mask = 3, int parts = 15) {
    const int gw = F.vb * 8 + F.wave, NGW = F.G * 8; const float* rel = p.in[I_REL];
#ifndef MK_ATTN
#define MK_ATTN 3
#endif
    if ((MK_ATTN & 1) && (mask & 1)) {
        LAS float* lut = (LAS float*)(F.lds + 130048);
        for (int i = F.tid; i < 8 * 1024; i += 512) { const int h = i >> 10, d = i & 1023; lut[i] = rel[bucket_of(d) * 16 + h] * 1.44269504f; }
        __syncthreads();
        for (int it = F.vb; it < 8 * 2 * 64; it += F.G) { const int b = it >> 7, g = (it >> 6) & 1; int tb = it & 63; if ((it / F.G) & 1) tb = 63 - tb; nsa_tile(p, b, g, tb, F, lut, (parts >> 8) & 15); }
    }
    __syncthreads();
    LAS unsigned char* buck = F.lds + 139776; LAS float* tbl = (LAS float*)(F.lds + 140800);
    for (int i = F.tid; i < 1024; i += 512) buck[i] = (unsigned char)bucket_of(i);
    tbl[F.tid] = rel[F.tid] * 1.44269504f;
    __syncthreads();
    if ((MK_ATTN & 2) && (mask & 2)) for (int it = F.vb; it < 8 * 512; it += F.G) { const int b = it >> 9; int tg = it & 511; if (b & 1) tg = 511 - tg; dsa_group(p, b, tg * 8, F, buck, tbl, parts); }
}


#ifndef MK_PROBE
#define MK_PROBE 0
#endif

DI unsigned row16_maxu(unsigned m) { unsigned o;
    o = (unsigned)DPP_I((int)m, 0xB1); m = m > o ? m : o; o = (unsigned)DPP_I((int)m, 0x4E); m = m > o ? m : o;
    o = (unsigned)DPP_I((int)m, 0x141); m = m > o ? m : o; o = (unsigned)DPP_I((int)m, 0x140); m = m > o ? m : o; return m; }
DI void peer_route_tile(const Params& p, int t0, int lane) {
    unsigned char* ws = p.ws; const int c = lane & 15, q = lane >> 4;
    const bf16_t* QP = (const bf16_t*)(ws + WS_QP); const bf16_t* SK = (const bf16_t*)(ws + WS_SK); int* EIDX = (int*)(ws + WS_EIDX); float* EW = (float*)(ws + WS_EW);
    float* EU = (float*)(ws + WS_EU); const float* USr = (const float*)(ws + WS_PTV); const float* VSr = USr + 16384;
    int ca[4], cb[4]; bool cv[4];
    ca[0] = 0; cb[0] = c; cv[0] = true;
    ca[1] = c < 8 ? 1 : (c < 13 ? 2 : 3); cb[1] = c < 8 ? c : (c < 13 ? c - 8 : c - 13); cv[1] = true;
    { const int ci = 32 + c; int a_, b_;
      if (ci == 32) { a_ = 3; b_ = 3; } else if (ci < 36) { a_ = 4; b_ = ci - 33; } else if (ci < 42) { a_ = 5 + ((ci - 36) >> 1); b_ = (ci - 36) & 1; } else { a_ = 8 + (ci - 42); b_ = 0; }
      ca[2] = a_; cb[2] = b_; cv[2] = true; }
    ca[3] = c < 2 ? 14 + c : 0; cb[3] = 0; cv[3] = c < 2;
    for (int h = 0; h < 8; ++h) {
        unsigned top[2][4];
#pragma unroll
        for (int pp = 0; pp < 2; ++pp) {
            const int hp = h * 2 + pp;
            const bf16_t* ap = QP + (size_t)(t0 + c) * 1024 + hp * 64 + 8 * q;
            const bf16x8 a0 = *(const bf16x8*)ap, a1 = *(const bf16x8*)(ap + 32);
            unsigned v[4][8];
#pragma unroll
            for (int kt = 0; kt < 8; ++kt) { const bf16_t* bp = SK + ((size_t)hp * 128 + 16 * kt + c) * 64 + 8 * q;
                const bf16x8 b0 = *(const bf16x8*)bp, b1 = *(const bf16x8*)(bp + 32);
                f32x4 acc = {0.f, 0.f, 0.f, 0.f}; acc = MFMA16(a0, b0, acc); acc = MFMA16(a1, b1, acc);
#pragma unroll
                for (int i = 0; i < 4; ++i) v[i][kt] = (ordf(acc[i]) & 0xFFFFFF80u) | (unsigned)(127 - (16 * kt + c)); }
            { unsigned mine[4] = {0u, 0u, 0u, 0u};
#define CE_(a, b) { const unsigned hi_ = v[i][a] > v[i][b] ? v[i][a] : v[i][b], lo_ = v[i][a] > v[i][b] ? v[i][b] : v[i][a]; v[i][a] = hi_; v[i][b] = lo_; }
#pragma unroll
              for (int i = 0; i < 4; ++i) { CE_(0, 1) CE_(2, 3) CE_(4, 5) CE_(6, 7) CE_(0, 2) CE_(1, 3) CE_(4, 6) CE_(5, 7) CE_(1, 2) CE_(5, 6) CE_(0, 4) CE_(3, 7) CE_(1, 5) CE_(2, 6) CE_(1, 4) CE_(3, 6) CE_(2, 4) CE_(3, 5) CE_(3, 4) }
#undef CE_
              for (int r = 0; r < 16; ++r) {
#pragma unroll
                  for (int i = 0; i < 4; ++i) { const unsigned m = row16_maxu(v[i][0]); mine[i] = (c == r) ? m : mine[i];
                      const bool win = v[i][0] == m;
#pragma unroll
                      for (int kt = 0; kt < 7; ++kt) v[i][kt] = win ? v[i][kt + 1] : v[i][kt];
                      v[i][7] = win ? 0u : v[i][7]; } }
#pragma unroll
              for (int i = 0; i < 4; ++i) top[pp][i] = mine[i]; }
        }
        unsigned cd[4][4], mine2[4] = {0u, 0u, 0u, 0u}; int i0v[4], i1v[4];
#pragma unroll
        for (int i = 0; i < 4; ++i) {
            const float s0 = unordf(top[0][i] & 0xFFFFFF80u), s1 = unordf(top[1][i] & 0xFFFFFF80u);
            i0v[i] = 127 - (int)(top[0][i] & 127u); i1v[i] = 127 - (int)(top[1][i] & 127u);
#pragma unroll
            for (int k = 0; k < 4; ++k) { const float s0a = __shfl(s0, (lane & 48) | ca[k]), s1b = __shfl(s1, (lane & 48) | cb[k]);
                cd[i][k] = cv[k] ? ((ordf(s0a + s1b) & 0xFFFFFF00u) | (unsigned)(255 - (ca[k] * 16 + cb[k]))) : 0u; }
        }
#define CE_(a, b) { const unsigned hi_ = cd[i][a] > cd[i][b] ? cd[i][a] : cd[i][b], lo_ = cd[i][a] > cd[i][b] ? cd[i][b] : cd[i][a]; cd[i][a] = hi_; cd[i][b] = lo_; }
#pragma unroll
        for (int i = 0; i < 4; ++i) { CE_(0, 1) CE_(2, 3) CE_(0, 2) CE_(1, 3) CE_(1, 2) }
#undef CE_
        for (int r = 0; r < 16; ++r) {
#pragma unroll
            for (int i = 0; i < 4; ++i) { const unsigned m = row16_maxu(cd[i][0]); mine2[i] = (c == r) ? m : mine2[i];
                const bool win = cd[i][0] == m;
#pragma unroll
                for (int k = 0; k < 3; ++k) cd[i][k] = win ? cd[i][k + 1] : cd[i][k];
                cd[i][3] = win ? 0u : cd[i][3]; }
        }
#pragma unroll
        for (int i = 0; i < 4; ++i) {
            const unsigned mine = mine2[i];
            const int pr = 255 - (int)(mine & 255u); const int ea = __shfl(i0v[i], (lane & 48) | (pr >> 4)), eb = __shfl(i1v[i], (lane & 48) | (pr & 15));
            const float scv = unordf(mine & 0xFFFFFF00u);
            const float mx = row16_maxf(scv);
            const float e = __expf(scv - mx); const float sm = row16_sumf(e);
            const size_t o = (size_t)(t0 + 4 * q + i) * 128 + h * 16 + c;
            const int eid = ea * 128 + eb; EIDX[o] = eid; EW[o] = (e / sm) * VSr[eid]; EU[o] = USr[eid];
        }
    }
}
#define MFMA8(a, b, c) __builtin_amdgcn_mfma_f32_16x16x32_fp8_fp8((a), (b), (c), 0, 0, 0)
DI long lo64(const u32x4 v) { return (long)(((unsigned long long)v.y << 32) | v.x); }
DI long hi64(const u32x4 v) { return (long)(((unsigned long long)v.w << 32) | v.z); }
template <int OFF> DI void peer_dma_o(const unsigned char* src, LAS unsigned char* dst) { __builtin_amdgcn_global_load_lds((const unsigned*)src, (LAS unsigned*)(dst - OFF), 16, OFF, 0); }
#define PEER_RD(slot_) (*(const LAS u32x4*)(ring + 1024 * (slot_) + 16 * lane))
#define PEER_VMW(n_) asm volatile("s_waitcnt vmcnt(" #n_ ")" ::: "memory")
struct PeerStream { int u0, ustep, n, xfix; bool al; };
DI PeerStream peer_stream(const Frame& F) { PeerStream s; const int bx = blockIdx.x; s.al = (F.G & 7) == 0; s.u0 = s.al ? (bx >> 3) * 8 + F.wave : bx * 8 + F.wave; s.ustep = s.al ? F.G : F.G * 8;
    const int nu = s.al ? T : T * 8; s.n = (nu - s.u0 + s.ustep - 1) / s.ustep; s.xfix = bx & 7; return s; }
DI void peer_unit(const PeerStream& s, int k, int& t, int& x) { const int u = s.u0 + (k < s.n ? k : s.n - 1) * s.ustep; t = s.al ? u : u >> 3; x = s.al ? s.xfix : u & 7; }

DI void phase_peer_u(const Params& p, const Frame& F) {
    unsigned char* ws = p.ws; const int lane = F.lane, c = lane & 15, q = lane >> 4, c8 = lane & 7, r8 = lane >> 3;
    LAS unsigned char* wl = F.lds + F.wave * LDS_PERWAVE; LAS float* pdl = (LAS float*)wl; LAS unsigned char* ring = wl + 512; LAS unsigned char* meta = wl + 512 + 16384;
    const PeerStream S = peer_stream(F);
    const unsigned char* EIDX = ws + WS_EIDX; const unsigned char* H8 = ws + WS_H8; float* PD = (float*)(ws + WS_PD); const unsigned char* PTU = ws + WS_PTU;
    const int p0 = ((c >> 1) + q) & 7, p1 = (p0 + 4) & 7;
    const int rdo = 1024 * (c >> 3) + 128 * (c & 7);
    int t, x;
#define PU_META(k_, slot_) do { peer_unit(S, (k_), t, x); const unsigned char* s_ = lane < 32 ? EIDX + (size_t)t * 512 + 16 * lane : H8 + (size_t)t * 1024 + 128 * x + 16 * (lane & 7); peer_dma_o<0>(s_, meta + 1024 * (slot_)); } while (0)
#define PU_RD(g_, pc_) (*(const LAS u32x4*)(ring + 2048 * (g_) + rdo + 16 * (pc_)))
    PU_META(0, 0); PU_META(1, 1);
    asm volatile("s_waitcnt vmcnt(0)" ::: "memory");
    u32x4 in_[4], hc0, hc1, hn0, hn1;
    { u32x4 i0_[4];
#pragma unroll
      for (int v_ = 0; v_ < 4; ++v_) i0_[v_] = *(const LAS u32x4*)(meta + 64 * r8 + 16 * v_);
      hn0 = *(const LAS u32x4*)(meta + 512 + 16 * p0); hn1 = *(const LAS u32x4*)(meta + 512 + 16 * p1);
      peer_unit(S, 0, t, x); const unsigned char* tb = PTU + (size_t)x * PT_SLICE + 16 * c8;
#define PU_D0(j) peer_dma_o<0>(tb + (size_t)i0_[(j) >> 2][(j) & 3] * 128, ring + 1024 * (j))
      PU_D0(0); PU_D0(1); PU_D0(2); PU_D0(3); PU_D0(4); PU_D0(5); PU_D0(6); PU_D0(7); PU_D0(8); PU_D0(9); PU_D0(10); PU_D0(11); PU_D0(12); PU_D0(13); PU_D0(14); PU_D0(15);
#undef PU_D0
    }
    PEER_VMW(12);
    u32x4 ra[2], rb[2];
#pragma unroll
    for (int i = 0; i < 2; ++i) { ra[i] = PU_RD(i, p0); rb[i] = PU_RD(i, p1); }
    const f32x4 z4 = {0.f, 0.f, 0.f, 0.f};
    for (int k = 0; k < S.n; ++k) {
        int tc, xc; peer_unit(S, k, tc, xc);
        hc0 = hn0; hc1 = hn1;
        { LAS unsigned char* m1 = meta + 1024 * ((k + 1) & 1);
#pragma unroll
          for (int v_ = 0; v_ < 4; ++v_) in_[v_] = *(const LAS u32x4*)(m1 + 64 * r8 + 16 * v_);
          hn0 = *(const LAS u32x4*)(m1 + 512 + 16 * p0); hn1 = *(const LAS u32x4*)(m1 + 512 + 16 * p1); }
        LDS_WAIT(); PU_META(k + 2, k & 1);
        peer_unit(S, k + 1, t, x);
        const unsigned char* tbn = PTU + (size_t)x * PT_SLICE + 16 * c8;
#define PU_GRP(g) do { if ((g) < 6) PEER_VMW(11); else PEER_VMW(10); const u32x4 na = PU_RD(((g) + 2) & 7, p0), nb = PU_RD(((g) + 2) & 7, p1); \
            f32x4 acc = MFMA8(lo64(ra[(g) & 1]), lo64(hc0), z4); acc = MFMA8(hi64(ra[(g) & 1]), hi64(hc0), acc); acc = MFMA8(lo64(rb[(g) & 1]), lo64(hc1), acc); acc = MFMA8(hi64(rb[(g) & 1]), hi64(hc1), acc); \
            asm volatile("" :: "v"(ra[(g) & 1]), "v"(rb[(g) & 1])); \
            peer_dma_o<0>(tbn + (size_t)in_[(2 * (g)) >> 2][(2 * (g)) & 3] * 128, ring + 2048 * (g)); peer_dma_o<0>(tbn + (size_t)in_[(2 * (g) + 1) >> 2][(2 * (g) + 1) & 3] * 128, ring + 2048 * (g) + 1024); \
            ra[(g) & 1] = na; rb[(g) & 1] = nb; \
            { const float d01 = (c & 1) ? acc[1] : acc[0], d23 = (c & 1) ? acc[3] : acc[2], dg = (c & 2) ? d23 : d01; if (q == (c >> 2)) pdl[16 * (c & 7) + 2 * (g) + (c >> 3)] = dg; } } while (0)
        PU_GRP(0); PU_GRP(1); PU_GRP(2); PU_GRP(3); PU_GRP(4); PU_GRP(5); PU_GRP(6); PU_GRP(7);
#undef PU_GRP
        { const u32x2 pv = *(const LAS u32x2*)(pdl + 2 * lane); *(u32x2*)(PD + ((size_t)xc * T + tc) * 128 + 2 * lane) = pv; }
    }
#undef PU_META
#undef PU_RD
    asm volatile("s_waitcnt vmcnt(0) lgkmcnt(0)" ::: "memory");
}

DI void phase_peer_coef(const Params& p, const Frame& F) {
    unsigned char* ws = p.ws; const float* PD = (const float*)(ws + WS_PD); const float* EW = (const float*)(ws + WS_EW); const float* EU = (const float*)(ws + WS_EU);
    const float* HSI = (const float*)(ws + WS_HSI); float* COEF = (float*)(ws + WS_COEF);
    const size_t NT = (size_t)F.G * 512;
    for (size_t i0 = (size_t)F.vb * 512 + F.tid; i0 < (size_t)T * 128; i0 += 4 * NT) {
        float d[4][8], ew[4], eu[4], hs[4];
#pragma unroll
        for (int r = 0; r < 4; ++r) { size_t i = i0 + r * NT; if (i >= (size_t)T * 128) i = i0; const int t = (int)(i >> 7), pp = (int)(i & 127);
#pragma unroll
            for (int x = 0; x < 8; ++x) d[r][x] = PD[((size_t)x * T + t) * 128 + pp];
            ew[r] = EW[i]; eu[r] = EU[i]; hs[r] = HSI[t]; }
#pragma unroll
        for (int r = 0; r < 4; ++r) { const size_t i = i0 + r * NT; if (i >= (size_t)T * 128) break;
            const float dot = ((d[r][0] + d[r][1]) + (d[r][2] + d[r][3])) + ((d[r][4] + d[r][5]) + (d[r][6] + d[r][7]));
            COEF[i] = ew[r] * gelu_t(dot * eu[r] * hs[r]); }
    }
}

DI void phase_peer_v(const Params& p, const Frame& F, const float* xin, float* xout, const float* gple, bool fuse) {
    unsigned char* ws = p.ws; const int lane = F.lane, c8 = lane & 7, r8 = lane >> 3;
    LAS unsigned char* wl = F.lds + F.wave * LDS_PERWAVE; LAS unsigned char* ring = wl; LAS unsigned char* meta = wl + 16384; LAS unsigned char* xs = wl + 16384 + 2048;
    const PeerStream S = peer_stream(F);
    const unsigned char* EIDX = ws + WS_EIDX; const unsigned char* COEF = ws + WS_COEF; const unsigned char* PTV = ws + WS_PTU + 16 * MiB;
    typedef float f32x2_t __attribute__((ext_vector_type(2)));
    int colofs;
    { const auto ra = __builtin_amdgcn_permlane32_swap(0u, 8u, false, false); const unsigned ta = ra[0];
      const auto rb = __builtin_amdgcn_permlane16_swap(ta, ta + 4u, false, false); const unsigned tb = rb[0];
      colofs = (int)tb + ((lane & 8) ? 2 : 0); }
    LAS float* gl = (LAS float*)(F.lds + 8 * LDS_PERWAVE);
    for (int i = F.tid; i < 1024; i += 512) gl[i] = gple[i];
    __syncthreads();
    bf16_t* Hn = (bf16_t*)(ws + WS_H); float* SSQ = (float*)(ws + WS_SSQ);
    int t, x;
#define PV_META(k_, slot_) do { peer_unit(S, (k_), t, x); const unsigned char* s_ = (lane < 32 ? EIDX : COEF) + (size_t)t * 512 + 16 * (lane & 31); peer_dma_o<0>(s_, meta + 1024 * (slot_)); } while (0)
#define PV_XS(k_, slot_) do { peer_unit(S, (k_), t, x); if (lane < 32) peer_dma_o<0>((const unsigned char*)(xin + (size_t)t * 1024 + 128 * x) + 16 * lane, xs + 512 * (slot_)); } while (0)
    PV_META(0, 0); PV_META(1, 1); PV_XS(0, 0);
    asm volatile("s_waitcnt vmcnt(0)" ::: "memory");
    u32x4 in_[4]; f32x4 cf[4], cn[4];
    { u32x4 i0_[4];
#pragma unroll
      for (int v_ = 0; v_ < 4; ++v_) { i0_[v_] = *(const LAS u32x4*)(meta + 64 * r8 + 16 * v_); cn[v_] = *(const LAS f32x4*)(meta + 512 + 64 * r8 + 16 * v_); }
      peer_unit(S, 0, t, x); const unsigned char* tb = PTV + (size_t)x * PT_SLICE + 16 * c8;
#define PV_D0(j) peer_dma_o<0>(tb + (size_t)i0_[(j) >> 2][(j) & 3] * 128, ring + 1024 * (j))
      PV_D0(0); PV_D0(1); PV_D0(2); PV_D0(3); PV_D0(4); PV_D0(5); PV_D0(6); PV_D0(7); PV_D0(8); PV_D0(9); PV_D0(10); PV_D0(11); PV_D0(12); PV_D0(13); PV_D0(14); PV_D0(15);
#undef PV_D0
    }
    PEER_VMW(12);
    u32x4 rr[4];
#pragma unroll
    for (int i = 0; i < 4; ++i) rr[i] = PEER_RD(i);
    for (int k = 0; k < S.n; ++k) {
        int tc, xc; peer_unit(S, k, tc, xc);
#pragma unroll
        for (int v_ = 0; v_ < 4; ++v_) cf[v_] = cn[v_];
        { LAS unsigned char* m1 = meta + 1024 * ((k + 1) & 1);
#pragma unroll
          for (int v_ = 0; v_ < 4; ++v_) { in_[v_] = *(const LAS u32x4*)(m1 + 64 * r8 + 16 * v_); cn[v_] = *(const LAS f32x4*)(m1 + 512 + 64 * r8 + 16 * v_); } }
        LDS_WAIT(); PV_META(k + 2, k & 1);
        PV_XS(k + 1, (k + 1) & 1);
        peer_unit(S, k + 1, t, x);
        const unsigned char* tbn = PTV + (size_t)x * PT_SLICE + 16 * c8;
        f32x2_t out[8];
#pragma unroll
        for (int e = 0; e < 8; ++e) out[e] = (f32x2_t){0.f, 0.f};
#define PV_STEP(j) do { if ((j) < 12) PEER_VMW(13); else PEER_VMW(11); const u32x4 nw = PEER_RD(((j) + 4) & 15); \
            const u32x4 pv_ = rr[(j) & 3]; const float c1_ = cf[(j) >> 2][(j) & 3]; const f32x2_t cc = {c1_, c1_}; \
            out[0] += cc * __builtin_amdgcn_cvt_pk_f32_fp8((int)pv_.x, false); out[1] += cc * __builtin_amdgcn_cvt_pk_f32_fp8((int)pv_.x, true); \
            out[2] += cc * __builtin_amdgcn_cvt_pk_f32_fp8((int)pv_.y, false); out[3] += cc * __builtin_amdgcn_cvt_pk_f32_fp8((int)pv_.y, true); \
            out[4] += cc * __builtin_amdgcn_cvt_pk_f32_fp8((int)pv_.z, false); out[5] += cc * __builtin_amdgcn_cvt_pk_f32_fp8((int)pv_.z, true); \
            out[6] += cc * __builtin_amdgcn_cvt_pk_f32_fp8((int)pv_.w, false); out[7] += cc * __builtin_amdgcn_cvt_pk_f32_fp8((int)pv_.w, true); \
            asm volatile("" :: "v"(rr[(j) & 3])); \
            peer_dma_o<0>(tbn + (size_t)in_[(j) >> 2][(j) & 3] * 128, ring + 1024 * (j)); rr[(j) & 3] = nw; } while (0)
        PV_STEP(0); PV_STEP(1); PV_STEP(2); PV_STEP(3); PV_STEP(4); PV_STEP(5); PV_STEP(6); PV_STEP(7);
        PV_STEP(8); PV_STEP(9); PV_STEP(10); PV_STEP(11); PV_STEP(12); PV_STEP(13); PV_STEP(14); PV_STEP(15);
#undef PV_STEP
        float n8[8], n4[4], f2[2];
#pragma unroll
        for (int i = 0; i < 8; ++i) { const float a_ = (i & 1) ? out[i >> 1].y : out[i >> 1].x, b_ = (i & 1) ? out[4 + (i >> 1)].y : out[4 + (i >> 1)].x;
            const auto r_ = __builtin_amdgcn_permlane32_swap(__float_as_uint(a_), __float_as_uint(b_), false, false); n8[i] = __uint_as_float(r_[0]) + __uint_as_float(r_[1]); }
#pragma unroll
        for (int i = 0; i < 4; ++i) { const auto r_ = __builtin_amdgcn_permlane16_swap(__float_as_uint(n8[i]), __float_as_uint(n8[4 + i]), false, false); n4[i] = __uint_as_float(r_[0]) + __uint_as_float(r_[1]); }
#pragma unroll
        for (int i = 0; i < 2; ++i) { const bool hi8 = (lane & 8) != 0; const float keep = hi8 ? n4[2 + i] : n4[i], send = hi8 ? n4[i] : n4[2 + i];
            f2[i] = keep + __builtin_bit_cast(float, DPP_I(__builtin_bit_cast(int, send), 0x128)); }
        { const f32x2_t xv = *(const LAS f32x2_t*)(xs + 512 * (k & 1) + 4 * (16 * c8 + colofs));
          const f32x2_t o = {xv.x + f2[0], xv.y + f2[1]}; *(f32x2_t*)(xout + (size_t)tc * 1024 + 128 * xc + 16 * c8 + colofs) = o;
          if (fuse) { const f32x2_t gg = *(const LAS f32x2_t*)(gl + 128 * xc + 16 * c8 + colofs);
              *(unsigned*)(Hn + (size_t)tc * 1024 + 128 * xc + 16 * c8 + colofs) = pk2(o.x * gg.x, o.y * gg.y);
              const float ss = wave_sum(o.x * o.x + o.y * o.y); if (lane == 0) SSQ[(size_t)tc * 8 + xc] = ss; } }
    }
#undef PV_META
#undef PV_XS
    asm volatile("s_waitcnt vmcnt(0) lgkmcnt(0)" ::: "memory");
}
#undef PEER_RD
#undef PEER_VMW

#ifndef MK_MASK
#define MK_MASK 0xffff
#endif
__global__ void __launch_bounds__(512, 2) mega(Params p) {
    extern __shared__ __attribute__((aligned(16))) unsigned char lds_raw[];
#define MKFRAME() Frame F; { int t_ = threadIdx.x; asm volatile("" : "+v"(t_)); F.lds = (LAS unsigned char*)lds_raw; F.tid = t_; F.lane = t_ & 63; F.wave = __builtin_amdgcn_readfirstlane(t_ >> 6); \
        F.G = gridDim.x; const int bx = blockIdx.x; F.vb = (F.G % 8 == 0) ? (bx % 8) * (F.G / 8) + bx / 8 : bx; }
    if (threadIdx.x < 16) ((LAS unsigned*)((LAS unsigned char*)lds_raw + LDS_XB))[threadIdx.x] = 0u;
    __syncthreads();
    const int lo = p.ph_lo, hi = p.ph_hi;
    XcdBarrier bar; bar.bar = (unsigned*)(p.ws + WS_CTL) + 4096; bar.x = 0; bar.st = (volatile LAS unsigned*)((LAS unsigned char*)lds_raw + LDS_XB);
    if (hi - lo > 1) bar = xcd_barrier_post((unsigned*)(p.ws + WS_CTL) + 4096, (volatile LAS unsigned*)((LAS unsigned char*)lds_raw + LDS_XB));
#define WSP(ws) unsigned char* ws = p.ws; asm volatile("" : "+s"(ws))
    for (int l = 0; l < NLAYER; ++l) {
        const int pb = l * NPH;
#define IN(k) (((MK_MASK >> (k)) & 1) && lo <= pb + (k) && pb + (k) < hi)
#if MK_PROBE == 120
#define SEAM(k) do { if (((MK_MASK >> (k)) & 1) && lo <= pb + (k) && pb + (k) + 1 < hi) { xcd_barrier(bar); xcd_barrier(bar); xcd_barrier(bar); } } while (0)
#else
#define SEAM(k) do { if (((MK_MASK >> (k)) & 1) && lo <= pb + (k) && pb + (k) + 1 < hi) xcd_barrier(bar); } while (0)
#endif
        if (IN(0)) { MKFRAME(); phase_prep_w(p, l, F); }
        SEAM(0);
#if MK_PROBE == 100
        if (IN(0)) { MKFRAME(); phase_prep_w(p, l, F); } xcd_barrier(bar);
#endif
        if (IN(1)) { MKFRAME(); WSP(ws); pg8::Gemm g{(const bf16_t*)(ws + WS_H), (const bf16_t*)(ws + WS_WCAT), T, 9216, 1024}; XcdColOrder S{F.G, (int)blockIdx.x};
            Epi1 E{(bf16_t*)(ws + WS_PROJ), (bf16_t*)(ws + WS_GATES)};
            pg8::gemm_phase<Epi1, XcdColOrder, false>(F.lds, g, S, E, nullptr); }
        SEAM(1);
#if MK_PROBE == 104
        if (IN(1)) { for (int rr = 0; rr < 18; ++rr) { MKFRAME(); WSP(ws); pg8::Gemm g{(const bf16_t*)(ws + WS_H), (const bf16_t*)(ws + WS_WCAT), T, 9216, 1024}; RoundOrder S; S.base.init(T, 9216, F.G, (int)blockIdx.x); S.r = rr;
            Epi1 E{(bf16_t*)(ws + WS_PROJ), (bf16_t*)(ws + WS_GATES)};
            pg8::gemm_phase<Epi1, RoundOrder, false>(F.lds, g, S, E, nullptr); xcd_barrier(bar); } }
#endif
#if MK_PROBE == 101 || MK_PROBE == 102 || MK_PROBE == 103
        if (IN(1)) { MKFRAME(); WSP(ws); pg8::Gemm g{(const bf16_t*)(ws + WS_H), (const bf16_t*)(ws + WS_WCAT), T, 9216, 1024}; ColRangeOrder S{F.G, (int)blockIdx.x, MK_PROBE == 103 ? 20 : 0, MK_PROBE == 102 ? 20 : 36};
            Epi1 E{(bf16_t*)(ws + WS_PROJ), (bf16_t*)(ws + WS_GATES)};
            pg8::gemm_phase<Epi1, ColRangeOrder, false>(F.lds, g, S, E, nullptr); } xcd_barrier(bar);
#endif
        if (IN(2)) { MKFRAME(); phase_chunk(p, l, F); }
        SEAM(2);
#if MK_PROBE == 140
        if (IN(2)) { MKFRAME(); phase_chunk(p, l, F); xcd_barrier(bar); }
#endif
        if (IN(3)) { MKFRAME(); WSP(ws);
            { pg8::Gemm g{(const bf16_t*)(ws + WS_CMPA), (const bf16_t*)(ws + WS_W1C), 4096, 512, 1024}; pg8::StaticOrder S; S.init(4096, 512, F.G, (int)blockIdx.x); EpiF32P E{(float*)(ws + WS_CMPP), 512};
              pg8::gemm_phase<EpiF32P, pg8::StaticOrder, false>(F.lds, g, S, E, nullptr); }
        }
        if (IN(3)) { MKFRAME(); WSP(ws);
            { pg8::Gemm g{(const bf16_t*)(ws + WS_CMPA) + (size_t)4096 * 1024, (const bf16_t*)(ws + WS_W1C) + (size_t)512 * 1024, 4096, 512, 1024}; pg8::StaticOrder S; S.init(4096, 512, F.G, (int)((blockIdx.x + F.G / 2) % F.G));
              EpiF32P E{(float*)(ws + WS_CMPP) + (size_t)4096 * 512, 512};
              pg8::gemm_phase<EpiF32P, pg8::StaticOrder, false>(F.lds, g, S, E, nullptr); }
        }
        SEAM(3);
        if (IN(4)) { MKFRAME(); phase_cmp2(p, l, F); }
        SEAM(4);
#if MK_PROBE == 141
        if (IN(4)) { MKFRAME(); phase_cmp2(p, l, F); xcd_barrier(bar); }
#endif
        if (IN(5)) { MKFRAME(); phase_attn(p, l, F, 3, 15); }
        SEAM(5);
#if MK_PROBE == 5 || MK_PROBE == 50 || MK_PROBE == 51 || MK_PROBE == 52 || MK_PROBE == 53
        if (IN(5)) { MKFRAME(); phase_attn(p, l, F, MK_PROBE == 5 ? 3 : (MK_PROBE == 50 ? 1 : 2), MK_PROBE == 52 ? 1 : (MK_PROBE == 53 ? 3 : 15)); xcd_barrier(bar); }
#endif
#if MK_PROBE >= 60 && MK_PROBE < 76
        if (IN(5)) { MKFRAME(); phase_attn(p, l, F, 1, (MK_PROBE - 60) << 8); xcd_barrier(bar); }
#endif
        if (IN(6)) { MKFRAME(); WSP(ws); pg8::Gemm g{(const bf16_t*)(ws + WS_Y), (const bf16_t*)(ws + WS_WBR), 4 * T, 4096, 512}; BranchOrder S{F.G, (int)blockIdx.x};
            EpiBranch E{(const bf16_t*)(ws + WS_GATES), (bf16_t*)(ws + WS_MERGED)};
            pg8::gemm_phase<EpiBranch, BranchOrder, false>(F.lds, g, S, E, nullptr); }
        SEAM(6);
#if MK_PROBE == 106
        if (IN(6)) { MKFRAME(); WSP(ws); pg8::Gemm g{(const bf16_t*)(ws + WS_Y), (const bf16_t*)(ws + WS_WBR), 4 * T, 4096, 512}; BranchOrder S{F.G, (int)blockIdx.x};
            EpiBranch E{(const bf16_t*)(ws + WS_GATES), (bf16_t*)(ws + WS_MERGED)};
            pg8::gemm_phase<EpiBranch, BranchOrder, false>(F.lds, g, S, E, nullptr); } xcd_barrier(bar);
#endif
        if (IN(7)) { MKFRAME(); WSP(ws); pg8::Gemm g{(const bf16_t*)(ws + WS_MERGED), (const bf16_t*)(ws + WS_WOUT4), T, 1024, 1024}; pg8::StaticOrder S; S.init(T, 1024, F.G, (int)blockIdx.x);
            EpiRes E{l == 0 ? p.in[I_X] : p.out, p.out};
            pg8::gemm_phase<EpiRes, pg8::StaticOrder, false>(F.lds, g, S, E, nullptr); }
        SEAM(7);
        if (IN(8)) { MKFRAME(); WSP(ws); rmsnorm_rows(p.out, p.in[I_GFFN] + l * 1024, (bf16_t*)(ws + WS_H), F.vb * 8 + F.wave, F.G * 8, F.lane, ws + WS_H8, (float*)(ws + WS_HSI)); }
        SEAM(8);
#if MK_PROBE == 108
        if (IN(8)) { MKFRAME(); WSP(ws); rmsnorm_rows(p.out, p.in[I_GFFN] + l * 1024, (bf16_t*)(ws + WS_H), F.vb * 8 + F.wave, F.G * 8, F.lane); } xcd_barrier(bar);
#endif
        if (IN(9)) { MKFRAME(); WSP(ws);
            { pg8::Gemm g{(const bf16_t*)(ws + WS_H), (const bf16_t*)(ws + WS_WQ), T, 1024, 1024}; pg8::StaticOrder S; S.init(T, 1024, F.G, (int)blockIdx.x); EpiBf E{(bf16_t*)(ws + WS_QP), 1024};
              pg8::gemm_phase<EpiBf, pg8::StaticOrder, false>(F.lds, g, S, E, nullptr); }
        }
        if (IN(9)) { MKFRAME(); WSP(ws);
            { pg8::Gemm g{(const bf16_t*)(ws + WS_PB), (const bf16_t*)(ws + WS_WPP), T, 1024, 256}; pg8::StaticOrder S; S.init(T, 1024, F.G, (int)blockIdx.x); EpiBf E{(bf16_t*)(ws + WS_PP), 1024};
              pg8::gemm_phase<EpiBf, pg8::StaticOrder, false>(F.lds, g, S, E, nullptr); }
        }
        SEAM(9);
#if MK_PROBE == 110
        if (IN(9)) { for (int rep = 0; rep < 9; ++rep) { MKFRAME(); WSP(ws);
            { pg8::Gemm g{(const bf16_t*)(ws + WS_H), (const bf16_t*)(ws + WS_WQ), T, 1024, 1024}; pg8::StaticOrder S; S.init(T, 1024, F.G, (int)blockIdx.x); EpiBf E{(bf16_t*)(ws + WS_QP), 1024};
              pg8::gemm_phase<EpiBf, pg8::StaticOrder, false>(F.lds, g, S, E, nullptr); } } xcd_barrier(bar); }
#endif
#if MK_PROBE == 109
        if (IN(9)) { MKFRAME(); WSP(ws);
            { pg8::Gemm g{(const bf16_t*)(ws + WS_H), (const bf16_t*)(ws + WS_WQ), T, 1024, 1024}; pg8::StaticOrder S; S.init(T, 1024, F.G, (int)blockIdx.x); EpiBf E{(bf16_t*)(ws + WS_QP), 1024};
              pg8::gemm_phase<EpiBf, pg8::StaticOrder, false>(F.lds, g, S, E, nullptr); } }
        if (IN(9)) { MKFRAME(); WSP(ws);
            { pg8::Gemm g{(const bf16_t*)(ws + WS_PB), (const bf16_t*)(ws + WS_WPP), T, 1024, 256}; pg8::StaticOrder S; S.init(T, 1024, F.G, (int)blockIdx.x); EpiBf E{(bf16_t*)(ws + WS_PP), 1024};
              pg8::gemm_phase<EpiBf, pg8::StaticOrder, false>(F.lds, g, S, E, nullptr); } }
        xcd_barrier(bar);
#endif
        if (IN(10)) { MKFRAME(); for (int tile = F.vb * 8 + F.wave; tile < T / 16; tile += F.G * 8) peer_route_tile(p, tile * 16, F.lane); }
        SEAM(10);
        if (IN(11)) { MKFRAME(); phase_peer_u(p, F); }
        SEAM(11);
        if (IN(12)) { MKFRAME(); phase_peer_coef(p, F); }
        SEAM(12);
        if (IN(13)) { MKFRAME(); phase_peer_v(p, F, p.out, p.out, p.in[I_GPLE] + l * 1024, true); }
        SEAM(13);
#if MK_PROBE == 130
        if (IN(13)) { MKFRAME(); phase_peer_u(p, F); xcd_barrier(bar); }
#endif
#if MK_PROBE == 131
        if (IN(13)) { MKFRAME(); phase_peer_coef(p, F); xcd_barrier(bar); }
#endif
#if MK_PROBE == 132
        if (IN(13)) { MKFRAME(); phase_peer_v(p, F, p.out, (float*)(p.ws + WS_Y), p.in[I_GPLE] + l * 1024, false); xcd_barrier(bar); }
#endif
#if MK_PROBE == 133
        if (IN(13)) { MKFRAME(); for (int tile = F.vb * 8 + F.wave; tile < T / 16; tile += F.G * 8) peer_route_tile(p, tile * 16, F.lane); xcd_barrier(bar); }
#endif
        if (IN(15)) { MKFRAME(); WSP(ws); pg8::Gemm g{(const bf16_t*)(ws + WS_H), (const bf16_t*)(ws + WS_WPG), T, 1024, 1024}; pg8::StaticOrder S; S.init(T, 1024, F.G, (int)blockIdx.x);
            EpiPle E{p.out, (const bf16_t*)(ws + WS_PP), (const float*)(ws + WS_SSQ)};
            pg8::gemm_phase<EpiPle, pg8::StaticOrder, false>(F.lds, g, S, E, nullptr); }
        SEAM(15);
#undef IN
#undef SEAM
    }
}
}

#ifndef MK_LAUNCH_PER_PHASE
#define MK_LAUNCH_PER_PHASE 0
#endif
extern "C" void kernel_launch(void* const* d_in, const int* in_sizes, int n_in, void* d_out, int out_size, void* d_ws, size_t ws_size, hipStream_t stream) {
    static int grid = 0;
    if (grid == 0) {
        if (n_in != 27 || ws_size < mk::WS_END) { fprintf(stderr, "kernel_launch: need 27 inputs and >= %zu bytes of workspace (got %d, %zu)\n", (size_t)mk::WS_END, n_in, ws_size); grid = -1; return; }
        int dev = 0, cus = 0;
        if (hipGetDevice(&dev) != hipSuccess || hipDeviceGetAttribute(&cus, hipDeviceAttributeMultiprocessorCount, dev) != hipSuccess) { grid = -1; return; }
        if (hipFuncSetAttribute((const void*)mk::mega, hipFuncAttributeMaxDynamicSharedMemorySize, mk::LDS_BYTES) != hipSuccess) { fprintf(stderr, "kernel_launch: hipFuncSetAttribute failed\n"); grid = -1; return; }
        int per_cu = 0;
        if (hipOccupancyMaxActiveBlocksPerMultiprocessor(&per_cu, (const void*)mk::mega, 512, mk::LDS_BYTES) != hipSuccess || per_cu < 1) fprintf(stderr, "kernel_launch: occupancy query says %d\n", per_cu);
        (void)hipGetLastError();
        grid = cus;
    }
    if (grid < 0) return;
    (void)in_sizes; (void)out_size;
    hipMemsetAsync((char*)d_ws + mk::WS_CTL, 0, 1u << 20, stream);
    mk::Params prm{};
    for (int i = 0; i < 27; ++i) prm.in[i] = (const float*)d_in[i];
    prm.out = (float*)d_out; prm.ws = (unsigned char*)d_ws;
#if MK_LAUNCH_PER_PHASE
    for (int ph = 0; ph < mk::NLAYER * mk::NPH; ++ph) { prm.ph_lo = ph; prm.ph_hi = ph + 1; hipLaunchKernelGGL(mk::mega, dim3(grid), dim3(512), mk::LDS_BYTES, stream, prm); }
#else
    prm.ph_lo = 0; prm.ph_hi = mk::NLAYER * mk::NPH; hipLaunchKernelGGL(mk::mega, dim3(grid), dim3(512), mk::LDS_BYTES, stream, prm);
#endif
}
```

```cpp
#include <hip/hip_runtime.h>
#include <stdio.h>
#include <stdint.h>
namespace pg8 {
#define PG8_LAS __attribute__((address_space(3)))
typedef unsigned short bf16_t;
typedef short bf16x8 __attribute__((ext_vector_type(8)));
typedef float f32x4 __attribute__((ext_vector_type(4)));
typedef unsigned u32x4 __attribute__((ext_vector_type(4)));
constexpr int BM = 256, BK = 64, HALF = 128, HTB = HALF * BK * 2  , STAGE_BYTES = 8 * HTB, NXCD = 8, WGM = 8;

__host__ __device__ __forceinline__ int lds_byte(int r, int c) { const int st = (r >> 4) * 2 + (c >> 5), rr = r & 15, cc = c & 31, ob = rr * 64 + cc * 2; return st * 1024 + (ob ^ (((ob >> 9) & 1) << 5)); }
__host__ __device__ __forceinline__ void stage_rc(int b, int& R, int& C) { const int st = b / 1024, sb = b % 1024, swz = sb ^ (((sb >> 9) & 1) << 5); R = (st >> 1) * 16 + swz / 64; C = (st & 1) * 32 + (swz % 64) / 2; }
__host__ __device__ __forceinline__ int perm32(int rho) { const int n = rho >> 4, i = rho & 15; return 8 * (i >> 2) + 4 * n + (i & 3); }

struct Unit { int pm, pn; };
struct Gemm { const bf16_t* A; const bf16_t* Bt; int M, N, K; };

struct StaticOrder {
    int nM, nN, nwg, G, c;
    __host__ __device__ void init(int M, int N, int G_, int c_) { nM = M / BM; nN = N / BM; nwg = nM * nN; G = G_; c = c_; }
    __host__ __device__ bool next(int i, Unit& u) const {
        const long L = (long)i * G + c; if (L >= nwg) return false;
        int wgid = (int)L; { const int q = nwg / NXCD, r = nwg % NXCD, xcd = wgid % NXCD, off = wgid / NXCD; wgid = (xcd < r ? xcd * (q + 1) : r * (q + 1) + (xcd - r) * q) + off; }
        const int nig = WGM * nN, gid = wgid / nig, fm = gid * WGM, gsz = (nM - fm) < WGM ? (nM - fm) : WGM;
        u.pm = fm + ((wgid % nig) % gsz); u.pn = (wgid % nig) / gsz; return true;
    }
    __device__ __forceinline__ void a_ready(const Unit&) const {}
    __device__ __forceinline__ void done(const Unit&) const {}
};
__device__ __forceinline__ unsigned cvt_pk_bf16(float lo, float hi) { unsigned r; asm volatile("v_cvt_pk_bf16_f32 %0, %1, %2" : "=v"(r) : "v"(lo), "v"(hi)); return r; }
template <class Epi, class Sched, bool STAMP = false>
__device__ __forceinline__ void gemm_phase(PG8_LAS unsigned char* lds, const Gemm g, const Sched& S, const Epi& E, unsigned long long* stamps) {
    int tid_l = threadIdx.x; asm volatile("" : "+v"(tid_l));
    const int tid = tid_l, wid = __builtin_amdgcn_readfirstlane(tid >> 6), lane = tid & 63, wr = wid >> 2, wc = wid & 3, fr = lane & 15, fq = lane >> 4;
    const int K = g.K, nt = K / BK;
    int ts_lo = 0, ts_hi = 0, nts = 0; const unsigned long long rt_entry = STAMP ? (unsigned long long)wall_clock64() : 0ull;
#define PG8_STAMP() do { if (STAMP && wid == 0 && nts < 64) { const unsigned long long _c = (unsigned long long)clock64(); \
        ts_lo = (lane == nts) ? (int)(unsigned)_c : ts_lo; ts_hi = (lane == nts) ? (int)(unsigned)(_c >> 32) : ts_hi; ++nts; } } while (0)
    PG8_STAMP();
    unsigned voffA[2], voffB[2];
#pragma unroll
    for (int i = 0; i < 2; ++i) { int R, C; stage_rc(tid * 16 + i * 8192, R, C); const int Rb = Epi::PERM ? ((R & ~31) + perm32(R & 31)) : R;
        voffA[i] = (unsigned)(R * K + C) * 2u; voffB[i] = (unsigned)(Rb * K + C) * 2u; }
    const size_t kstep = (size_t)(BK * 2);
    const size_t hstep = (size_t)HALF * K * 2;
    const size_t tstep = 2 * hstep;
    const unsigned ldsw = (unsigned)wid * 1024u;
    const int aoff = lds_byte(wr * 64 + fr, fq * 8), boff = lds_byte(wc * 32 + fr, fq * 8);
#define PG8_SA(b, h) (((b) * 2 + (h)) * HTB)
#define PG8_SB(b, h) ((4 + (b) * 2 + (h)) * HTB)
#define PG8_STAGE(bufoff, gbase, voff) do { _Pragma("unroll") for (int _i = 0; _i < 2; ++_i) \
        __builtin_amdgcn_global_load_lds((const unsigned*)((const char*)(gbase) + (voff)[_i]), (PG8_LAS unsigned*)(lds + (bufoff) + ldsw + _i * 8192), 16, 0, 0); } while (0)
#define PG8_LDA(dst, b, h) do { _Pragma("unroll") for (int m = 0; m < 4; ++m) _Pragma("unroll") for (int k = 0; k < 2; ++k) dst[m][k] = *(const PG8_LAS bf16x8*)(lds + PG8_SA(b, h) + aoff + m * 2048 + k * 1024); } while (0)
#define PG8_LDB(dst, b, h) do { _Pragma("unroll") for (int n = 0; n < 2; ++n) _Pragma("unroll") for (int k = 0; k < 2; ++k) dst[n][k] = *(const PG8_LAS bf16x8*)(lds + PG8_SB(b, h) + boff + n * 2048 + k * 1024); } while (0)
#define PG8_MMA(ai, bj, At, Bt) do { __builtin_amdgcn_s_setprio(1); _Pragma("unroll") for (int m = 0; m < 4; ++m) _Pragma("unroll") for (int n = 0; n < 2; ++n) _Pragma("unroll") for (int k = 0; k < 2; ++k) \
        acc[ai][bj][m][n] = __builtin_amdgcn_mfma_f32_16x16x32_bf16(Bt[n][k], At[m][k], acc[ai][bj][m][n], 0, 0, 0); __builtin_amdgcn_s_setprio(0); } while (0)
#define PG8_WAIT_V(n) asm volatile("s_waitcnt vmcnt(" #n ")" ::: "memory")
#define PG8_WAIT_L(n) asm volatile("s_waitcnt lgkmcnt(" #n ")" ::: "memory")
#define PG8_BAR __builtin_amdgcn_s_barrier()
#define PG8_SCHED __builtin_amdgcn_sched_barrier(0)
    Unit cur, nxt; int ui = 0;
    if (!S.next(0, cur)) return;
    f32x4 acc[2][2][4][2];
#pragma unroll
    for (int a = 0; a < 2; ++a)
#pragma unroll
        for (int b = 0; b < 2; ++b)
#pragma unroll
            for (int m = 0; m < 4; ++m)
#pragma unroll
                for (int n = 0; n < 2; ++n) acc[a][b][m][n] = (f32x4){0.f, 0.f, 0.f, 0.f};
    bf16x8 At[4][2], B0[2][2], B1[2][2];
    const char* cA = (const char*)g.A + (size_t)cur.pm * tstep; const char* cB = (const char*)g.Bt + (size_t)cur.pn * tstep;
    S.a_ready(cur);
    PG8_STAGE(PG8_SB(0, 0), cB, voffB); PG8_STAGE(PG8_SA(0, 0), cA, voffA); PG8_STAGE(PG8_SB(0, 1), cB + hstep, voffB); PG8_STAGE(PG8_SA(0, 1), cA + hstep, voffA);
    if (wr == 1) PG8_BAR;
    PG8_WAIT_V(4); PG8_BAR;
    PG8_STAGE(PG8_SB(1, 0), cB + kstep, voffB); PG8_STAGE(PG8_SA(1, 0), cA + kstep, voffA); PG8_STAGE(PG8_SB(1, 1), cB + hstep + kstep, voffB);
    PG8_WAIT_V(6); PG8_BAR;
    PG8_STAMP();
    for (;;) {
        const bool has_next = S.next(ui + 1, nxt);
        const char* nA = has_next ? (const char*)g.A + (size_t)nxt.pm * tstep : cA; const char* nB = has_next ? (const char*)g.Bt + (size_t)nxt.pn * tstep : cB;
        for (int t = 0; t < nt; t += 2) {
            const bool last = (t == nt - 2);
            const char* a1 = cA + (size_t)(t + 1) * kstep;
            const char* a2 = last ? nA : cA + (size_t)(t + 2) * kstep; const char* b2 = last ? nB : cB + (size_t)(t + 2) * kstep;
            const char* a3 = a2 + kstep; const char* b3 = b2 + kstep;
            if (last && has_next) S.a_ready(nxt);
            PG8_LDB(B0, 0, 0); PG8_SCHED; PG8_LDA(At, 0, 0); PG8_STAGE(PG8_SA(1, 1), a1 + hstep, voffA);
            PG8_WAIT_L(8); PG8_BAR; PG8_WAIT_L(0); PG8_MMA(0, 0, At, B0); PG8_BAR; PG8_SCHED;
            PG8_LDB(B1, 0, 1); PG8_STAGE(PG8_SB(0, 0), b2, voffB);
            PG8_BAR; PG8_WAIT_L(0); PG8_MMA(0, 1, At, B1); PG8_BAR;
            PG8_LDA(At, 0, 1); PG8_STAGE(PG8_SA(0, 0), a2, voffA);
            PG8_BAR; PG8_WAIT_L(0); PG8_MMA(1, 0, At, B0); PG8_BAR; PG8_SCHED;
            PG8_STAGE(PG8_SB(0, 1), b2 + hstep, voffB);
            PG8_WAIT_V(6); PG8_BAR; PG8_MMA(1, 1, At, B1); PG8_BAR;
            PG8_LDB(B0, 1, 0); PG8_SCHED; PG8_LDA(At, 1, 0); PG8_STAGE(PG8_SA(0, 1), a2 + hstep, voffA);
            PG8_WAIT_L(8); PG8_BAR; PG8_WAIT_L(0); PG8_MMA(0, 0, At, B0); PG8_BAR; PG8_SCHED;
            PG8_LDB(B1, 1, 1); PG8_STAGE(PG8_SB(1, 0), b3, voffB);
            PG8_BAR; PG8_WAIT_L(0); PG8_MMA(0, 1, At, B1); PG8_BAR;
            PG8_LDA(At, 1, 1); PG8_STAGE(PG8_SA(1, 0), a3, voffA);
            PG8_BAR; PG8_WAIT_L(0); PG8_MMA(1, 0, At, B0); PG8_BAR; PG8_SCHED;
            PG8_STAGE(PG8_SB(1, 1), b3 + hstep, voffB);
            PG8_WAIT_V(6); PG8_BAR; PG8_MMA(1, 1, At, B1); PG8_BAR;
        }
        PG8_STAMP();
        if constexpr (!Epi::AFTER_DRAIN) { E(acc, cur, wr, wc, fr, fq); S.done(cur); }
        PG8_STAMP();
        if (!has_next) break;
#pragma unroll
        for (int a = 0; a < 2; ++a)
#pragma unroll
            for (int b = 0; b < 2; ++b)
#pragma unroll
                for (int m = 0; m < 4; ++m)
#pragma unroll
                    for (int n = 0; n < 2; ++n) acc[a][b][m][n] = (f32x4){0.f, 0.f, 0.f, 0.f};
        cur = nxt; cA = nA; cB = nB; ++ui;
    }
    PG8_WAIT_V(0);
    if (wr == 0) PG8_BAR;
    PG8_BAR;
    if constexpr (Epi::AFTER_DRAIN) { E.fused(acc, cur, wr, wc, fr, fq, lds, wid, lane); S.done(cur); }
    PG8_STAMP();
    if (STAMP && wid == 0) { stamps[lane] = lane < nts ? (((unsigned long long)(unsigned)ts_hi << 32) | (unsigned)ts_lo) : 0ull;
        if (lane == 62) stamps[62] = rt_entry; if (lane == 63) stamps[63] = (unsigned long long)wall_clock64(); }
#undef PG8_STAMP
#undef PG8_SA
#undef PG8_SB
#undef PG8_STAGE
#undef PG8_LDA
#undef PG8_LDB
#undef PG8_MMA
#undef PG8_WAIT_V
#undef PG8_WAIT_L
#undef PG8_BAR
#undef PG8_SCHED
}
}
#define XB_TMO      128
#define XB_XCNT(j)  (256  + 64 * (j))
#define XB_XSUB(j)  (1280 + 64 * (j))
#define XB_XGEN(j)  (2304 + 64 * (j))
#define XB_TOP      3328
#define XB_TOPGEN   3392
#define XCD_BAR_WORDS 3456
#define XB_SPIN_CAP (1u << 18)
#define LAS __attribute__((address_space(3)))

__device__ __forceinline__ unsigned xb_ld(unsigned* p)              { return __hip_atomic_load(p, __ATOMIC_RELAXED, __HIP_MEMORY_SCOPE_AGENT); }
__device__ __forceinline__ unsigned xb_add(unsigned* p, unsigned v) { return __hip_atomic_fetch_add(p, v, __ATOMIC_RELAXED, __HIP_MEMORY_SCOPE_AGENT); }
__device__ __forceinline__ unsigned xb_xcc_id() { return (unsigned)__builtin_amdgcn_s_getreg((3 << 11) | 20) & 0xFu; }
#define XB_SPIN(cond, bar) do { unsigned _sp = 0; while (cond) { __builtin_amdgcn_s_sleep(1); \
    if ((++_sp & 255u) == 0u) { if (xb_ld(&(bar)[XB_TMO])) break; if (_sp > XB_SPIN_CAP) { atomicAdd(&(bar)[XB_TMO], 1u); break; } } } } while (0)

struct XcdBarrier {
    unsigned* bar; unsigned x;
    volatile LAS unsigned* st;
};

__device__ __forceinline__ XcdBarrier xcd_barrier_post(unsigned* bar, volatile LAS unsigned* st) {
    XcdBarrier b; b.bar = bar; b.x = xb_xcc_id(); b.st = st;
    if (threadIdx.x == 0) (void)xb_add(&bar[XB_XCNT(b.x)], 1u);
    return b;
}
__device__ __forceinline__ void xcd_barrier_complete(unsigned* bar, unsigned x, unsigned& nloc, unsigned& nx) {
    const unsigned G = gridDim.x * gridDim.y * gridDim.z;
    unsigned sum, cnt, mine, sp = 0u;
    for (;;) {
        sum = 0u; cnt = 0u; mine = 0u;
#pragma unroll
        for (unsigned j = 0; j < 16; ++j) { const unsigned c = xb_ld(&bar[XB_XCNT(j)]); sum += c; cnt += (c > 0u) ? 1u : 0u; mine = (j == x) ? c : mine; }
        if (sum == G) break;
        __builtin_amdgcn_s_sleep(1);
        if ((++sp & 255u) == 0u) { if (xb_ld(&bar[XB_TMO])) break; if (sp > XB_SPIN_CAP) { atomicAdd(&bar[XB_TMO], 1u); break; } }
    }
    nloc = mine > 0u ? mine : 1u; nx = cnt > 0u ? cnt : 1u;
}

__device__ __forceinline__ void xcd_barrier(const XcdBarrier& b) {
    asm volatile("s_waitcnt vmcnt(0)" ::: "memory");
    __syncthreads();
    if (threadIdx.x == 0) {
        unsigned* bar = b.bar;
        __builtin_amdgcn_s_waitcnt(0);
        unsigned nloc = b.st[0], nx = b.st[1];
        if (nloc == 0u) { xcd_barrier_complete(bar, b.x, nloc, nx); b.st[0] = nloc; b.st[1] = nx; }
        const unsigned old = xb_add(&bar[XB_XSUB(b.x)], 1u);
        const unsigned gen = old / nloc;
        if (old + 1u == (gen + 1u) * nloc) {
            __builtin_amdgcn_fence(__ATOMIC_RELEASE, "agent");
            asm volatile("s_waitcnt vmcnt(0)" ::: "memory");
            const unsigned og = xb_add(&bar[XB_TOP], 1u);
            const unsigned tg = og / nx;
            if (og + 1u == (tg + 1u) * nx) xb_add(&bar[XB_TOPGEN], 1u);
            else XB_SPIN(xb_ld(&bar[XB_TOPGEN]) == tg, bar);
            __builtin_amdgcn_fence(__ATOMIC_ACQUIRE, "agent");
            xb_add(&bar[XB_XGEN(b.x)], 1u);
            asm volatile("s_waitcnt vmcnt(0)" ::: "memory");
        } else {
            XB_SPIN(xb_ld(&bar[XB_XGEN(b.x)]) == gen, bar);
            __builtin_amdgcn_fence(__ATOMIC_ACQUIRE, "agent");
            asm volatile("s_waitcnt vmcnt(0)" ::: "memory");
        }
    }
    __syncthreads();
}

namespace mk {
using pg8::bf16_t; using pg8::bf16x8; using pg8::f32x4; using pg8::u32x4;
typedef unsigned u32x2 __attribute__((ext_vector_type(2)));
typedef short s16x4 __attribute__((ext_vector_type(4)));
#define DI __device__ __forceinline__
#define LDS_WAIT() asm volatile("s_waitcnt lgkmcnt(0)" ::: "memory")
#define LDS_FENCE() asm volatile("" ::: "memory")
#define MFMA16(a, b, c) __builtin_amdgcn_mfma_f32_16x16x32_bf16((a), (b), (c), 0, 0, 0)

constexpr int T = 32768, SEQ = 4096, NLAYER = 4, NPH = 16;
constexpr int PW = 5120;
constexpr int C_AB = 0, C_AC = 512, C_AX = 1024, C_NQ = 1536, C_NKV = 2048, C_UV = 2816, C_DQ = 3840, C_DK = 4352, C_DV = 4416,
              C_DQI = 4480, C_DKI = 4992, C_NG = 5056, C_DWI = 5080;
constexpr size_t MiB = 1u << 20;
constexpr size_t WS_CTL = 0, WS_PEB = 1 * MiB, WS_CMPK = 2 * MiB, WS_CMPV = 3 * MiB, WS_SK = 4 * MiB, WS_SGUW = 5 * MiB, WS_CMPA = 8 * MiB,
                 WS_CMPP = 24 * MiB, WS_WCAT = 40 * MiB, WS_WBR = 58 * MiB, WS_WOUT4 = 62 * MiB, WS_WQ = 70 * MiB, WS_WPG = 72 * MiB,
                 WS_WPP = 74 * MiB, WS_W1C = 75 * MiB, WS_PB = 78 * MiB, WS_PTU = 96 * MiB, WS_PTV = 128 * MiB, WS_H = 160 * MiB,
                 WS_Y = 224 * MiB, WS_PROJ = 352 * MiB, WS_GATES = 672 * MiB,
                 WS_KS = 928 * MiB, WS_VS = 936 * MiB, WS_KW = 944 * MiB, WS_VW = 952 * MiB, WS_DK = 960 * MiB, WS_DV = 964 * MiB, WS_DKI = 968 * MiB, WS_END = 972 * MiB;
constexpr size_t WS_ACCF = WS_PROJ, WS_MERGED = WS_PROJ + 128 * MiB, WS_QP = WS_PROJ, WS_PP = WS_PROJ + 64 * MiB, WS_EIDX = WS_PROJ + 128 * MiB, WS_EW = WS_PROJ + 144 * MiB, WS_EU = WS_PROJ + 160 * MiB;
constexpr size_t WS_COEF = WS_PROJ + 176 * MiB, WS_H8 = WS_PROJ + 192 * MiB, WS_HSI = WS_PROJ + 224 * MiB, WS_SSQ = WS_PROJ + 225 * MiB, WS_PD = WS_GATES, PT_SLICE = 2 * MiB;
constexpr int LDS_BYTES = 163840, LDS_PERWAVE = 19456, LDS_BUCK = 8 * LDS_PERWAVE, LDS_TBL = LDS_BUCK + 4096, LDS_XB = LDS_BYTES - 64;

struct Params { const float* in[27]; float* out; unsigned char* ws; int ph_lo, ph_hi; };
enum { I_X = 0, I_P, I_REL, I_GMIX, I_WIN, I_CONVW, I_PE, I_CW1, I_CW2, I_NQG, I_NKG, I_LNG, I_SGUW, I_SGUB, I_DQG, I_DKG, I_WGATE, I_WBR, I_WOUT,
       I_GFFN, I_WQ, I_SUBK, I_PU, I_PV, I_GPLE, I_WPG, I_WPP };

struct Frame { LAS unsigned char* lds; int tid, lane, wave, vb, G; };

DI float bf2f(unsigned short b) { return __uint_as_float(((unsigned)b) << 16); }
DI unsigned f2bf(float f) { unsigned u = __float_as_uint(f); return (u + 0x7fffu + ((u >> 16) & 1u)) >> 16; }
DI unsigned pk2(float lo, float hi) { return pg8::cvt_pk_bf16(lo, hi); }
DI float lo16(unsigned w) { return __uint_as_float(w << 16); }
DI float hi16(unsigned w) { return __uint_as_float(w & 0xffff0000u); }
DI float sigm(float x) { return __builtin_amdgcn_rcpf(1.f + __builtin_amdgcn_exp2f(-1.44269504f * x)); }
DI float gelu_t(float x) { const float y = (-2.f * 0.7978845608f * 1.44269504f) * (x + 0.044715f * x * x * x); return x * __builtin_amdgcn_rcpf(1.f + __builtin_amdgcn_exp2f(y)); }
#define DPP_I(x, ctrl) __builtin_amdgcn_update_dpp(0, (x), (ctrl), 0xF, 0xF, false)
DI float dppf(float x, int) { return x; }
DI float row16_sumf(float v) { v += __builtin_bit_cast(float, DPP_I(__builtin_bit_cast(int, v), 0xB1)); v += __builtin_bit_cast(float, DPP_I(__builtin_bit_cast(int, v), 0x4E));
    v += __builtin_bit_cast(float, DPP_I(__builtin_bit_cast(int, v), 0x141)); v += __builtin_bit_cast(float, DPP_I(__builtin_bit_cast(int, v), 0x140)); return v; }
DI float row16_maxf(float v) { v = fmaxf(v, __builtin_bit_cast(float, DPP_I(__builtin_bit_cast(int, v), 0xB1))); v = fmaxf(v, __builtin_bit_cast(float, DPP_I(__builtin_bit_cast(int, v), 0x4E)));
    v = fmaxf(v, __builtin_bit_cast(float, DPP_I(__builtin_bit_cast(int, v), 0x141))); v = fmaxf(v, __builtin_bit_cast(float, DPP_I(__builtin_bit_cast(int, v), 0x140))); return v; }
DI float quad_sumf(float v) { v += __builtin_bit_cast(float, DPP_I(__builtin_bit_cast(int, v), 0xB1)); v += __builtin_bit_cast(float, DPP_I(__builtin_bit_cast(int, v), 0x4E)); return v; }
DI float oct_sumf(float v) { v = quad_sumf(v); v += __builtin_bit_cast(float, DPP_I(__builtin_bit_cast(int, v), 0x141)); return v; }
DI float x16_sum(float v) { const unsigned u = __float_as_uint(v); const auto r = __builtin_amdgcn_permlane16_swap(u, u, false, false); return __uint_as_float(r[0]) + __uint_as_float(r[1]); }
DI float x32_sum(float v) { const unsigned u = __float_as_uint(v); const auto r = __builtin_amdgcn_permlane32_swap(u, u, false, false); return __uint_as_float(r[0]) + __uint_as_float(r[1]); }
DI float x16_max(float v) { const unsigned u = __float_as_uint(v); const auto r = __builtin_amdgcn_permlane16_swap(u, u, false, false); return fmaxf(__uint_as_float(r[0]), __uint_as_float(r[1])); }
DI float x32_max(float v) { const unsigned u = __float_as_uint(v); const auto r = __builtin_amdgcn_permlane32_swap(u, u, false, false); return fmaxf(__uint_as_float(r[0]), __uint_as_float(r[1])); }
DI unsigned wave_sum_u(unsigned v) { v += (unsigned)DPP_I((int)v, 0xB1); v += (unsigned)DPP_I((int)v, 0x4E); v += (unsigned)DPP_I((int)v, 0x141); v += (unsigned)DPP_I((int)v, 0x140);
    { const auto r = __builtin_amdgcn_permlane16_swap(v, v, false, false); v = r[0] + r[1]; } { const auto r = __builtin_amdgcn_permlane32_swap(v, v, false, false); v = r[0] + r[1]; } return v; }
DI float wave_sum(float v) { return x32_sum(x16_sum(row16_sumf(v))); }
DI float wave_max(float v) { return x32_max(x16_max(row16_maxf(v))); }
DI unsigned ordf(float f) { const unsigned u = __float_as_uint(f); return (u & 0x80000000u) ? ~u : (u | 0x80000000u); }
DI float unordf(unsigned x) { return __uint_as_float((x & 0x80000000u) ? (x & 0x7fffffffu) : ~x); }
DI int bucket_of(int n) {
    if (n < 16) return n;
    int b = 16;
    b += (n >= 21); b += (n >= 27); b += (n >= 35); b += (n >= 46); b += (n >= 59); b += (n >= 77); b += (n >= 99); b += (n >= 128);
    b += (n >= 166); b += (n >= 216); b += (n >= 280); b += (n >= 363); b += (n >= 470); b += (n >= 609); b += (n >= 790);
    return b; }

DI int srccol(int n) { return n < 2816 ? n : (n < 5056 ? n + 24 : (n < 5080 ? n - 2240 : (n < 5088 ? n : -1))); }
DI void tr_item(const float* W, int ldw, bf16_t* WT, int ldwt, int k0, int n0, LAS float* scr, int lane, bool remap, int ncopy, int cstride) {
    float tv[32];
#pragma unroll
    for (int i = 0; i < 32; ++i) { const int kk = 2 * i + (lane >> 5), nl = lane & 31; const int n = n0 + nl; const int src = remap ? srccol(n) : n; tv[i] = src >= 0 ? W[(size_t)(k0 + kk) * ldw + src] : 0.f; }
#pragma unroll
    for (int i = 0; i < 32; ++i) { const int kk = 2 * i + (lane >> 5), nl = lane & 31; scr[kk * 33 + nl] = tv[i]; }
    LDS_WAIT();
    const int c = lane & 7;
#pragma unroll
    for (int j = 0; j < 4; ++j) { const int n = (lane >> 3) + 8 * j; const LAS float* s = scr + (8 * c) * 33 + n;
        u32x4 o; o.x = pk2(s[0], s[33]); o.y = pk2(s[66], s[99]); o.z = pk2(s[132], s[165]); o.w = pk2(s[198], s[231]);
        for (int cp = 0; cp < ncopy; ++cp) *(u32x4*)(WT + (size_t)(n0 + n) * ldwt + (size_t)cp * cstride + k0 + 8 * c) = o; }
    LDS_WAIT();
}
DI void cvt_rows(const float* src, bf16_t* dst, size_t ngroups8, int gw, int NGW, int lane) {
    const size_t st = (size_t)NGW * 64;
    for (size_t i0 = (size_t)gw * 64 + lane; i0 < ngroups8; i0 += 4 * st) {
        f32x4 a[4], b[4];
#pragma unroll
        for (int r = 0; r < 4; ++r) { const size_t i = i0 + r * st < ngroups8 ? i0 + r * st : i0; a[r] = ((const f32x4*)src)[2 * i]; b[r] = ((const f32x4*)src)[2 * i + 1]; }
#pragma unroll
        for (int r = 0; r < 4; ++r) { const size_t i = i0 + r * st; if (i >= ngroups8) break;
            u32x4 o; o.x = pk2(a[r].x, a[r].y); o.y = pk2(a[r].z, a[r].w); o.z = pk2(b[r].x, b[r].y); o.w = pk2(b[r].z, b[r].w); ((u32x4*)dst)[i] = o; }
    }
}
DI int pk4_fp8(float a, float b, float c, float d) { int w = 0; w = __builtin_amdgcn_cvt_pk_fp8_f32(a, b, w, false); w = __builtin_amdgcn_cvt_pk_fp8_f32(c, d, w, true); return w; }
DI void cvt_rows_fp8(const float* src, unsigned char* dst, float* scl, int nrows, int gw, int NGW, int lane) {
    for (int r0 = gw; r0 < nrows; r0 += 4 * NGW) {
        f32x4 a[4], b[4], c[4], d[4];
#pragma unroll
        for (int k = 0; k < 4; ++k) { const int r = r0 + k * NGW < nrows ? r0 + k * NGW : r0; const float* s = src + (size_t)r * 1024 + lane * 16;
            a[k] = *(const f32x4*)s; b[k] = *(const f32x4*)(s + 4); c[k] = *(const f32x4*)(s + 8); d[k] = *(const f32x4*)(s + 12); }
#pragma unroll
        for (int k = 0; k < 4; ++k) { const int r = r0 + k * NGW; if (r >= nrows) break;
            float mx = fmaxf(fmaxf(fmaxf(fabsf(a[k].x), fabsf(a[k].y)), fmaxf(fabsf(a[k].z), fabsf(a[k].w))), fmaxf(fmaxf(fabsf(b[k].x), fabsf(b[k].y)), fmaxf(fabsf(b[k].z), fabsf(b[k].w))));
            mx = fmaxf(mx, fmaxf(fmaxf(fmaxf(fabsf(c[k].x), fabsf(c[k].y)), fmaxf(fabsf(c[k].z), fabsf(c[k].w))), fmaxf(fmaxf(fabsf(d[k].x), fabsf(d[k].y)), fmaxf(fabsf(d[k].z), fabsf(d[k].w)))));
            mx = wave_max(mx);
            const float sc = mx > 0.f ? mx * (1.f / 448.f) : 1.f, inv = 1.f / sc;
            u32x4 o; o.x = (unsigned)pk4_fp8(a[k].x * inv, a[k].y * inv, a[k].z * inv, a[k].w * inv); o.y = (unsigned)pk4_fp8(b[k].x * inv, b[k].y * inv, b[k].z * inv, b[k].w * inv);
            o.z = (unsigned)pk4_fp8(c[k].x * inv, c[k].y * inv, c[k].z * inv, c[k].w * inv); o.w = (unsigned)pk4_fp8(d[k].x * inv, d[k].y * inv, d[k].z * inv, d[k].w * inv);
            *(u32x4*)(dst + (size_t)(lane >> 3) * PT_SLICE + (size_t)r * 128 + (lane & 7) * 16) = o;
            if (lane == 0) scl[r] = sc; }
    }
}
DI void rmsnorm_rows(const float* x, const float* g, bf16_t* H, int gw, int NGW, int lane, unsigned char* H8 = nullptr, float* HSI = nullptr) {
    const f32x4 g0 = *(const f32x4*)(g + lane * 8), g1 = *(const f32x4*)(g + lane * 8 + 4), g2 = *(const f32x4*)(g + 512 + lane * 8), g3 = *(const f32x4*)(g + 512 + lane * 8 + 4);
    for (int m0 = gw; m0 < T; m0 += 4 * NGW) {
        f32x4 a[4], b[4], c[4], d[4];
#pragma unroll
        for (int r = 0; r < 4; ++r) { const int m = m0 + r * NGW < T ? m0 + r * NGW : m0; const float* xr = x + (size_t)m * 1024 + lane * 8;
            a[r] = *(const f32x4*)xr; b[r] = *(const f32x4*)(xr + 4); c[r] = *(const f32x4*)(xr + 512); d[r] = *(const f32x4*)(xr + 516); }
#pragma unroll
        for (int r = 0; r < 4; ++r) { const int m = m0 + r * NGW; if (m >= T) break;
            float ss = a[r].x * a[r].x + a[r].y * a[r].y + a[r].z * a[r].z + a[r].w * a[r].w + b[r].x * b[r].x + b[r].y * b[r].y + b[r].z * b[r].z + b[r].w * b[r].w
                     + c[r].x * c[r].x + c[r].y * c[r].y + c[r].z * c[r].z + c[r].w * c[r].w + d[r].x * d[r].x + d[r].y * d[r].y + d[r].z * d[r].z + d[r].w * d[r].w;
            ss = wave_sum(ss);
            const float rr = rsqrtf(ss * (1.f / 1024.f) + 1e-6f);
            u32x4 o0, o1;
            o0.x = pk2(a[r].x * rr * g0.x, a[r].y * rr * g0.y); o0.y = pk2(a[r].z * rr * g0.z, a[r].w * rr * g0.w); o0.z = pk2(b[r].x * rr * g1.x, b[r].y * rr * g1.y); o0.w = pk2(b[r].z * rr * g1.z, b[r].w * rr * g1.w);
            o1.x = pk2(c[r].x * rr * g2.x, c[r].y * rr * g2.y); o1.y = pk2(c[r].z * rr * g2.z, c[r].w * rr * g2.w); o1.z = pk2(d[r].x * rr * g3.x, d[r].y * rr * g3.y); o1.w = pk2(d[r].z * rr * g3.z, d[r].w * rr * g3.w);
            bf16_t* hr = H + (size_t)m * 1024 + lane * 8; *(u32x4*)hr = o0; *(u32x4*)(hr + 512) = o1;
            if (H8) {
                float v[16] = {a[r].x * rr * g0.x, a[r].y * rr * g0.y, a[r].z * rr * g0.z, a[r].w * rr * g0.w, b[r].x * rr * g1.x, b[r].y * rr * g1.y, b[r].z * rr * g1.z, b[r].w * rr * g1.w,
                               c[r].x * rr * g2.x, c[r].y * rr * g2.y, c[r].z * rr * g2.z, c[r].w * rr * g2.w, d[r].x * rr * g3.x, d[r].y * rr * g3.y, d[r].z * rr * g3.z, d[r].w * rr * g3.w};
                float am = 0.f;
#pragma unroll
                for (int e = 0; e < 16; ++e) am = fmaxf(am, fabsf(v[e]));
                am = wave_max(am);
                const float hs = am > 0.f ? 224.f / am : 1.f;
                u32x2 q0, q1; q0.x = (unsigned)pk4_fp8(v[0] * hs, v[1] * hs, v[2] * hs, v[3] * hs); q0.y = (unsigned)pk4_fp8(v[4] * hs, v[5] * hs, v[6] * hs, v[7] * hs);
                q1.x = (unsigned)pk4_fp8(v[8] * hs, v[9] * hs, v[10] * hs, v[11] * hs); q1.y = (unsigned)pk4_fp8(v[12] * hs, v[13] * hs, v[14] * hs, v[15] * hs);
                unsigned char* h8 = H8 + (size_t)m * 1024 + lane * 8; *(u32x2*)h8 = q0; *(u32x2*)(h8 + 512) = q1;
                if (lane == 0) HSI[m] = 1.f / hs; } }
    }
}
DI void phase_prep_w(const Params& p, int l, const Frame& F) {
    LAS float* scr = (LAS float*)(F.lds + F.wave * 8448);
    const int gw = F.vb * 8 + F.wave, NGW = F.G * 8, lane = F.lane;
    unsigned char* ws = p.ws;
    bf16_t* WCAT = (bf16_t*)(ws + WS_WCAT); bf16_t* WBR = (bf16_t*)(ws + WS_WBR); bf16_t* WOUT4 = (bf16_t*)(ws + WS_WOUT4); bf16_t* WQ = (bf16_t*)(ws + WS_WQ);
    bf16_t* WPG = (bf16_t*)(ws + WS_WPG); bf16_t* WPP = (bf16_t*)(ws + WS_WPP); bf16_t* W1C = (bf16_t*)(ws + WS_W1C);
    constexpr int I0 = 2560, I1 = 2048, I2 = 1024, I3 = 512, I4 = 512, I5 = 512, I6 = 128, I7 = 512, NIT = I0 + I1 + I2 + I3 + I4 + I5 + I6 + I7;
    for (int it = gw; it < NIT; it += NGW) {
        int r = it;
        if (r < I0) { tr_item(p.in[I_WIN] + (size_t)l * 1024 * 5088, 5088, WCAT, 1024, (r / 160) * 64, (r % 160) * 32, scr, lane, true, 1, 0); continue; } r -= I0;
        if (r < I1) { tr_item(p.in[I_WGATE] + (size_t)l * 1024 * 4096, 4096, WCAT + (size_t)5120 * 1024, 1024, (r / 128) * 64, (r % 128) * 32, scr, lane, false, 1, 0); continue; } r -= I1;
        if (r < I2) { const int m = r >> 8, rr = r & 255; tr_item(p.in[I_WBR] + ((size_t)l * 2048 + m * 512) * 1024, 1024, WBR + (size_t)m * 1024 * 512, 512, (rr / 32) * 64, (rr % 32) * 32, scr, lane, false, 1, 0); continue; } r -= I2;
        if (r < I3) { tr_item(p.in[I_WOUT] + (size_t)l * 1024 * 1024, 1024, WOUT4, 1024, (r / 32) * 64, (r % 32) * 32, scr, lane, false, 1, 0); continue; } r -= I3;
        if (r < I4) { tr_item(p.in[I_WQ] + (size_t)l * 1024 * 1024, 1024, WQ, 1024, (r / 32) * 64, (r % 32) * 32, scr, lane, false, 1, 0); continue; } r -= I4;
        if (r < I5) { tr_item(p.in[I_WPG] + (size_t)l * 1024 * 1024, 1024, WPG, 1024, (r / 32) * 64, (r % 32) * 32, scr, lane, false, 1, 0); continue; } r -= I5;
        if (r < I6) { tr_item(p.in[I_WPP] + (size_t)l * 256 * 1024, 1024, WPP, 256, (r / 32) * 64, (r % 32) * 32, scr, lane, false, 1, 0); continue; } r -= I6;
        { const int jh = r >> 7, rr = r & 127, j = jh >> 1, half = jh & 1;
          tr_item(p.in[I_CW1] + (((size_t)l * 2 + j) * 2048 + half * 1024) * 256, 256, W1C + ((size_t)j * 512 + half * 256) * 1024, 1024, (rr / 8) * 64, (rr % 8) * 32, scr, lane, false, 1, 0); }
    }
    cvt_rows_fp8(p.in[I_PU] + (size_t)l * 16384 * 1024, ws + WS_PTU, (float*)(ws + WS_PTV), 16384, gw, NGW, lane);
    cvt_rows_fp8(p.in[I_PV] + (size_t)l * 16384 * 1024, ws + WS_PTU + 16 * MiB, (float*)(ws + WS_PTV) + 16384, 16384, gw, NGW, lane);
    cvt_rows(p.in[I_SUBK] + (size_t)l * 131072, (bf16_t*)(ws + WS_SK), 131072 / 8, gw, NGW, lane);
    cvt_rows(p.in[I_P] + (size_t)l * T * 256, (bf16_t*)(ws + WS_PB), (size_t)T * 256 / 8, gw, NGW, lane);
    { const float* sw = p.in[I_SGUW] + (size_t)l * 131072; bf16_t* dst = (bf16_t*)(ws + WS_SGUW);
      for (int i = gw * 64 + lane; i < 131072 / 8; i += NGW * 64) { const int e = i * 8, t = (e >> 7) & 127, s0 = e & 127; float v[8];
#pragma unroll
          for (int k = 0; k < 8; ++k) v[k] = (s0 + k <= t) ? sw[e + k] : 0.f;
          u32x4 o; o.x = pk2(v[0], v[1]); o.y = pk2(v[2], v[3]); o.z = pk2(v[4], v[5]); o.w = pk2(v[6], v[7]); ((u32x4*)dst)[i] = o; } }
    { float* peb = (float*)(ws + WS_PEB);
      for (int o = gw; o < 512; o += NGW) { const int j = o >> 8, n = o & 255; const float* pe = p.in[I_PE] + ((size_t)l * 2 + j) * 2048; const float* w1 = p.in[I_CW1] + ((size_t)l * 2 + j) * 2048 * 256;
          float s = 0.f; for (int k = lane; k < 2048; k += 64) s += pe[k] * w1[(size_t)k * 256 + n];
          s = wave_sum(s); if (lane == 0) peb[o] = s; } }
    rmsnorm_rows(l == 0 ? p.in[I_X] : p.out, p.in[I_GMIX] + l * 1024, (bf16_t*)(ws + WS_H), gw, NGW, lane);
}

struct Epi1 {
    static constexpr bool PERM = true, AFTER_DRAIN = false;
    bf16_t* proj; bf16_t* gates;
    DI void operator()(const f32x4 (&acc)[2][2][4][2], const pg8::Unit& u, int wr, int wc, int fr, int fq) const {
        const int row0 = u.pm * 256 + wr * 64 + fr; const bool isg = u.pn >= 20;
        const int col0 = (isg ? (u.pn - 20) * 256 : u.pn * 256) + wc * 32 + 8 * fq; bf16_t* base = isg ? gates : proj; const int ldc = isg ? 4096 : PW;
#pragma unroll
        for (int ai = 0; ai < 2; ++ai)
#pragma unroll
            for (int m = 0; m < 4; ++m) { bf16_t* rowp = base + (size_t)(row0 + ai * 128 + m * 16) * ldc + col0;
#pragma unroll
                for (int bj = 0; bj < 2; ++bj) { f32x4 v0 = acc[ai][bj][m][0], v1 = acc[ai][bj][m][1];
                    if (isg) { v0.x = sigm(v0.x); v0.y = sigm(v0.y); v0.z = sigm(v0.z); v0.w = sigm(v0.w); v1.x = sigm(v1.x); v1.y = sigm(v1.y); v1.z = sigm(v1.z); v1.w = sigm(v1.w); }
                    u32x4 w; w.x = pk2(v0.x, v0.y); w.y = pk2(v0.z, v0.w); w.z = pk2(v1.x, v1.y); w.w = pk2(v1.z, v1.w);
                    __builtin_nontemporal_store(w, (u32x4*)(rowp + bj * 128)); } }
    }
};
struct EpiBf {
    static constexpr bool PERM = true, AFTER_DRAIN = false;
    bf16_t* O; int ldc;
    DI void operator()(const f32x4 (&acc)[2][2][4][2], const pg8::Unit& u, int wr, int wc, int fr, int fq) const {
        const int row0 = u.pm * 256 + wr * 64 + fr, col0 = u.pn * 256 + wc * 32 + 8 * fq;
#pragma unroll
        for (int ai = 0; ai < 2; ++ai)
#pragma unroll
            for (int m = 0; m < 4; ++m) { bf16_t* rowp = O + (size_t)(row0 + ai * 128 + m * 16) * ldc + col0;
#pragma unroll
                for (int bj = 0; bj < 2; ++bj) { const f32x4 v0 = acc[ai][bj][m][0], v1 = acc[ai][bj][m][1];
                    u32x4 w; w.x = pk2(v0.x, v0.y); w.y = pk2(v0.z, v0.w); w.z = pk2(v1.x, v1.y); w.w = pk2(v1.z, v1.w);
                    *(u32x4*)(rowp + bj * 128) = w; } }
    }
};
struct EpiF32P {
    static constexpr bool PERM = true, AFTER_DRAIN = false;
    float* C; int ldc;
    DI void operator()(const f32x4 (&acc)[2][2][4][2], const pg8::Unit& u, int wr, int wc, int fr, int fq) const {
        const int row0 = u.pm * 256 + wr * 64 + fr, col0 = u.pn * 256 + wc * 32 + 8 * fq;
#pragma unroll
        for (int ai = 0; ai < 2; ++ai)
#pragma unroll
            for (int m = 0; m < 4; ++m) { float* rowp = C + (size_t)(row0 + ai * 128 + m * 16) * ldc + col0;
#pragma unroll
                for (int bj = 0; bj < 2; ++bj) { *(f32x4*)(rowp + bj * 128) = acc[ai][bj][m][0]; *(f32x4*)(rowp + bj * 128 + 4) = acc[ai][bj][m][1]; } }
    }
};
struct XcdColOrder {
    int G, c;
    DI bool next(int i, pg8::Unit& u) const {
        if (G != 256) { const int Lx = i * G + c; if (Lx >= 128 * 36) return false; u.pm = Lx / 36; u.pn = Lx % 36; return true; }
        if (i >= 18) return false;
        const int x = c & 7, w = c >> 3;
        if (i < 16) { u.pm = 8 * i + (w & 7); u.pn = 4 * x + (w >> 3); }
        else { u.pm = 16 * x + 8 * (i - 16) + (w & 7); u.pn = 32 + (w >> 3); }
        return true; }
    DI void a_ready(const pg8::Unit&) const {}
    DI void done(const pg8::Unit&) const {}
};
struct RoundOrder {
    pg8::StaticOrder base; int r;
    DI bool next(int i, pg8::Unit& u) const { return i == 0 && base.next(r, u); }
    DI void a_ready(const pg8::Unit&) const {}
    DI void done(const pg8::Unit&) const {}
};
struct ColRangeOrder {
    int G, c, c0, c1;
    DI bool next(int i, pg8::Unit& u) const { const int nc = c1 - c0; const int Lx = i * G + c; if (Lx >= 128 * nc) return false; u.pm = Lx / nc; u.pn = c0 + Lx % nc; return true; }
    DI void a_ready(const pg8::Unit&) const {}
    DI void done(const pg8::Unit&) const {}
};
struct BranchOrder {
    int G, c;
    DI bool next(int i, pg8::Unit& u) const { const int tile = c + G * (i >> 2), m = i & 3; if (tile >= 512) return false; u.pm = m * 128 + (tile >> 2); u.pn = m * 4 + (tile & 3); return true; }
    DI void a_ready(const pg8::Unit&) const {}
    DI void done(const pg8::Unit&) const {}
};
struct EpiBranch {
    static constexpr bool PERM = true, AFTER_DRAIN = false;
    const bf16_t* gates; bf16_t* merged;
    DI void operator()(const f32x4 (&acc)[2][2][4][2], const pg8::Unit& u, int wr, int wc, int fr, int fq) const {
        const int m4 = u.pn >> 2; const int row0 = (u.pm & 127) * 256 + wr * 64 + fr, gcol0 = u.pn * 256 + wc * 32 + 8 * fq, dcol0 = (u.pn & 3) * 256 + wc * 32 + 8 * fq;
#pragma unroll
        for (int ai = 0; ai < 2; ++ai) {
            u32x4 g[4][2], pr[4][2];
#pragma unroll
            for (int m = 0; m < 4; ++m)
#pragma unroll
                for (int bj = 0; bj < 2; ++bj) { g[m][bj] = *(const u32x4*)(gates + (size_t)(row0 + ai * 128 + m * 16) * 4096 + gcol0 + bj * 128);
                    if (m4 > 0) pr[m][bj] = *(const u32x4*)(merged + (size_t)(row0 + ai * 128 + m * 16) * 1024 + dcol0 + bj * 128); }
#pragma unroll
            for (int m = 0; m < 4; ++m)
#pragma unroll
                for (int bj = 0; bj < 2; ++bj) { const f32x4 v0 = acc[ai][bj][m][0], v1 = acc[ai][bj][m][1]; const u32x4 gg = g[m][bj];
                    f32x4 r0 = {v0.x * lo16(gg.x), v0.y * hi16(gg.x), v0.z * lo16(gg.y), v0.w * hi16(gg.y)}, r1 = {v1.x * lo16(gg.z), v1.y * hi16(gg.z), v1.z * lo16(gg.w), v1.w * hi16(gg.w)};
                    if (m4 > 0) { const u32x4 pp_ = pr[m][bj];
                        r0.x += lo16(pp_.x); r0.y += hi16(pp_.x); r0.z += lo16(pp_.y); r0.w += hi16(pp_.y); r1.x += lo16(pp_.z); r1.y += hi16(pp_.z); r1.z += lo16(pp_.w); r1.w += hi16(pp_.w); }
                    u32x4 w; w.x = pk2(r0.x, r0.y); w.y = pk2(r0.z, r0.w); w.z = pk2(r1.x, r1.y); w.w = pk2(r1.z, r1.w);
                    *(u32x4*)(merged + (size_t)(row0 + ai * 128 + m * 16) * 1024 + dcol0 + bj * 128) = w; }
        }
    }
};
struct EpiRes {
    static constexpr bool PERM = true, AFTER_DRAIN = false;
    const float* xin; float* out;
    DI void operator()(const f32x4 (&acc)[2][2][4][2], const pg8::Unit& u, int wr, int wc, int fr, int fq) const {
        const int row0 = u.pm * 256 + wr * 64 + fr, col0 = u.pn * 256 + wc * 32 + 8 * fq;
#pragma unroll
        for (int ai = 0; ai < 2; ++ai)
#pragma unroll
            for (int mh = 0; mh < 2; ++mh) {
                f32x4 xa[2][2][2];
#pragma unroll
                for (int m2 = 0; m2 < 2; ++m2)
#pragma unroll
                    for (int bj = 0; bj < 2; ++bj) { const size_t off = (size_t)(row0 + ai * 128 + (mh * 2 + m2) * 16) * 1024 + col0 + bj * 128; xa[m2][bj][0] = *(const f32x4*)(xin + off); xa[m2][bj][1] = *(const f32x4*)(xin + off + 4); }
#pragma unroll
                for (int m2 = 0; m2 < 2; ++m2)
#pragma unroll
                    for (int bj = 0; bj < 2; ++bj) { const size_t off = (size_t)(row0 + ai * 128 + (mh * 2 + m2) * 16) * 1024 + col0 + bj * 128;
                        *(f32x4*)(out + off) = xa[m2][bj][0] + acc[ai][bj][mh * 2 + m2][0]; *(f32x4*)(out + off + 4) = xa[m2][bj][1] + acc[ai][bj][mh * 2 + m2][1]; }
            }
    }
};
struct EpiPle {
    static constexpr bool PERM = true, AFTER_DRAIN = false;
    float* x; const bf16_t* pp; const float* ssq;
    DI void operator()(const f32x4 (&acc)[2][2][4][2], const pg8::Unit& u, int wr, int wc, int fr, int fq) const {
        const int row0 = u.pm * 256 + wr * 64 + fr, col0 = u.pn * 256 + wc * 32 + 8 * fq;
#pragma unroll
        for (int ai = 0; ai < 2; ++ai)
#pragma unroll
            for (int mh = 0; mh < 2; ++mh) {
                f32x4 xa[2][2][2]; u32x4 ga[2][2]; f32x4 sq[2][2];
#pragma unroll
                for (int m2 = 0; m2 < 2; ++m2) { const float* sp = ssq + (size_t)(row0 + ai * 128 + (mh * 2 + m2) * 16) * 8; sq[m2][0] = *(const f32x4*)sp; sq[m2][1] = *(const f32x4*)(sp + 4);
#pragma unroll
                    for (int bj = 0; bj < 2; ++bj) { const size_t off = (size_t)(row0 + ai * 128 + (mh * 2 + m2) * 16) * 1024 + col0 + bj * 128;
                        xa[m2][bj][0] = *(const f32x4*)(x + off); xa[m2][bj][1] = *(const f32x4*)(x + off + 4); ga[m2][bj] = *(const u32x4*)(pp + off); } }
#pragma unroll
                for (int m2 = 0; m2 < 2; ++m2) {
                    const float rr = rsqrtf((((sq[m2][0].x + sq[m2][0].y) + (sq[m2][0].z + sq[m2][0].w)) + ((sq[m2][1].x + sq[m2][1].y) + (sq[m2][1].z + sq[m2][1].w))) * (1.f / 1024.f) + 1e-6f);
#pragma unroll
                    for (int bj = 0; bj < 2; ++bj) { const size_t off = (size_t)(row0 + ai * 128 + (mh * 2 + m2) * 16) * 1024 + col0 + bj * 128;
                        const f32x4 v0 = acc[ai][bj][mh * 2 + m2][0] * rr, v1 = acc[ai][bj][mh * 2 + m2][1] * rr; const u32x4 g = ga[m2][bj]; f32x4 x0 = xa[m2][bj][0], x1 = xa[m2][bj][1];
                        x0.x += sigm(v0.x) * lo16(g.x); x0.y += sigm(v0.y) * hi16(g.x); x0.z += sigm(v0.z) * lo16(g.y); x0.w += sigm(v0.w) * hi16(g.y);
                        x1.x += sigm(v1.x) * lo16(g.z); x1.y += sigm(v1.y) * hi16(g.z); x1.z += sigm(v1.z) * lo16(g.w); x1.w += sigm(v1.w) * hi16(g.w);
                        *(f32x4*)(x + off) = x0; *(f32x4*)(x + off + 4) = x1; } }
            }
    }
};


DI void unpack8(const u32x4 w, float (&f)[8]) { f[0] = lo16(w.x); f[1] = hi16(w.x); f[2] = lo16(w.y); f[3] = hi16(w.y); f[4] = lo16(w.z); f[5] = hi16(w.z); f[6] = lo16(w.w); f[7] = hi16(w.w); }
DI u32x4 pack8(const float (&f)[8]) { u32x4 o; o.x = pk2(f[0], f[1]); o.y = pk2(f[2], f[3]); o.z = pk2(f[4], f[5]); o.w = pk2(f[6], f[7]); return o; }
DI void load8f(const float* p, float (&f)[8]) { const f32x4 a = *(const f32x4*)p, b = *(const f32x4*)(p + 4); f[0] = a.x; f[1] = a.y; f[2] = a.z; f[3] = a.w; f[4] = b.x; f[5] = b.y; f[6] = b.z; f[7] = b.w; }

DI void phase_chunk(const Params& p, int l, const Frame& F) {
    unsigned char* ws = p.ws; const int lane = F.lane, wave = F.wave;
    bf16_t* PROJ = (bf16_t*)(ws + WS_PROJ); bf16_t* YA = (bf16_t*)(ws + WS_Y); bf16_t* YC = YA + (size_t)2 * T * 512; bf16_t* CMPA = (bf16_t*)(ws + WS_CMPA);
    const bf16_t* SGUW = (const bf16_t*)(ws + WS_SGUW);
    LAS unsigned char* vnT = F.lds;
    const float* convw = p.in[I_CONVW] + (size_t)l * 3 * 512; const float* lng = p.in[I_LNG] + (size_t)l * 512; const float* sgub = p.in[I_SGUB] + (size_t)l * 8 * 128;
    float cw0[8], cw1[8], cw2[8], lgn[8];
    load8f(convw + lane * 8, cw0); load8f(convw + 512 + lane * 8, cw1); load8f(convw + 1024 + lane * 8, cw2); load8f(lng + lane * 8, lgn);
    for (int chunk = F.vb; chunk < T / 128; chunk += F.G) {
        const int t0 = chunk * 128;
        for (int tt = wave; tt < 128; tt += 8) {
            const int t = t0 + tt, s = t & (SEQ - 1), b = t >> 12;
            bf16_t* row = PROJ + (size_t)t * PW;
            const int c0 = lane * 8;
            const u32x4 z = {0u, 0u, 0u, 0u};
            const u32x4 rab = *(const u32x4*)(row + C_AB + c0), rc0 = *(const u32x4*)(row + C_AC + c0), rx0 = *(const u32x4*)(row + C_AX + c0);
            u32x4 r1c = z, r1x = z, r2c = z, r2x = z;
            if (s >= 1) { r1c = *(const u32x4*)(row - PW + C_AC + c0); r1x = *(const u32x4*)(row - PW + C_AX + c0); }
            if (s >= 2) { r2c = *(const u32x4*)(row - 2 * PW + C_AC + c0); r2x = *(const u32x4*)(row - 2 * PW + C_AX + c0); }
            u32x4 segv[3]; int segcol[3]; const float* seggp[3]; float segsc[3];
#pragma unroll
            for (int pass = 0; pass < 3; ++pass) {
                const int seg = pass * 8 + (lane >> 3), sg = seg < 20 ? seg : 20; int col; const float* gp; float sc = 1.f;
                if (sg < 8) { col = C_NQ + 64 * sg; gp = p.in[I_NQG] + l * 64; sc = 0.125f * 1.44269504f; }
                else if (sg < 10) { col = C_NKV + 2 * 128 + (sg - 8) * 64; gp = p.in[I_NKG] + (l * 3 + 1) * 64; }
                else if (sg < 12) { col = C_NKV + 4 * 128 + (sg - 10) * 64; gp = p.in[I_NKG] + (l * 3 + 2) * 64; }
                else if (sg < 20) { col = C_DQ + 64 * (sg - 12); gp = p.in[I_DQG] + l * 64; sc = 0.125f * 1.44269504f; }
                else { col = C_DK; gp = p.in[I_DKG] + l * 64; }
                segcol[pass] = col; seggp[pass] = gp; segsc[pass] = sc; segv[pass] = *(const u32x4*)(row + col + (lane & 7) * 8);
            }
            u32x4 rawc = z; const bf16_t* rawsrc = row; bf16_t* rawdst = nullptr;
            if (lane < 48) { const int sgc = lane >> 3;
                if (sgc < 2) { rawsrc = row + C_NKV + 3 * 128 + sgc * 64; rawdst = (bf16_t*)(ws + WS_VS) + ((size_t)((b * 2 + sgc) * SEQ + s)) * 64; }
                else if (sgc < 4) { rawsrc = row + C_NKV + 5 * 128 + (sgc - 2) * 64; rawdst = (bf16_t*)(ws + WS_VW) + ((size_t)((b * 2 + (sgc - 2)) * SEQ + s)) * 64; }
                else if (sgc == 4) { rawsrc = row + C_DV; rawdst = (bf16_t*)(ws + WS_DV) + (size_t)t * 64; }
                else { rawsrc = row + C_DKI; rawdst = (bf16_t*)(ws + WS_DKI) + (size_t)t * 64; }
                rawc = *(const u32x4*)(rawsrc + (lane & 7) * 8); }
            u32x4 cmpc = z;
            if (lane < 32) { const int jg = lane >> 3; cmpc = *(const u32x4*)(row + C_NKV + (jg >> 1) * 128 + (jg & 1) * 64 + (lane & 7) * 8); }
            const u32x4 ruv = *(const u32x4*)(row + C_UV + 512 + lane * 8);
            {
                float ab[8], c0v[8], x0v[8], c1v[8], x1v[8], c2v[8], x2v[8], y[8];
                unpack8(rab, ab); unpack8(rc0, c0v); unpack8(rx0, x0v); unpack8(r1c, c1v); unpack8(r1x, x1v); unpack8(r2c, c2v); unpack8(r2x, x2v);
#pragma unroll
                for (int e = 0; e < 8; ++e) y[e] = ab[e] * (cw2[e] * c0v[e] * x0v[e] + cw1[e] * c1v[e] * x1v[e] + cw0[e] * c2v[e] * x2v[e]);
                *(u32x4*)(YA + (size_t)t * 512 + c0) = pack8(y);
            }
#pragma unroll
            for (int pass = 0; pass < 3; ++pass) {
                const int seg = pass * 8 + (lane >> 3), part = lane & 7, sg = seg < 20 ? seg : 20;
                float v[8], g[8]; unpack8(segv[pass], v); load8f(seggp[pass] + part * 8, g);
                float ss = 0.f;
#pragma unroll
                for (int e = 0; e < 8; ++e) ss += v[e] * v[e];
                ss = oct_sumf(ss);
                const float r = rsqrtf(ss * (1.f / 64.f) + 1e-6f) * segsc[pass];
#pragma unroll
                for (int e = 0; e < 8; ++e) v[e] = v[e] * r * g[e];
                bf16_t* dstp = row + segcol[pass] + part * 8;
                if (sg >= 8 && sg < 10) dstp = (bf16_t*)(ws + WS_KS) + ((size_t)((b * 2 + (sg - 8)) * SEQ + s)) * 64 + part * 8;
                else if (sg >= 10 && sg < 12) dstp = (bf16_t*)(ws + WS_KW) + ((size_t)((b * 2 + (sg - 10)) * SEQ + s)) * 64 + part * 8;
                else if (sg == 20) dstp = (bf16_t*)(ws + WS_DK) + (size_t)t * 64 + part * 8;
                if (seg < 21) *(u32x4*)dstp = pack8(v);
            }
            if (lane < 48) *(u32x4*)(rawdst + (lane & 7) * 8) = rawc;
            if (lane < 32) { const int jg = lane >> 3, j = jg >> 1, g = jg & 1, part = lane & 7;
                *(u32x4*)(CMPA + ((size_t)j * 4096 + ((size_t)(b * 256 + (s >> 4)) * 2 + g)) * 1024 + (s & 15) * 64 + part * 8) = cmpc; }
            {
                float v[8]; unpack8(ruv, v);
                float sm = 0.f;
#pragma unroll
                for (int e = 0; e < 8; ++e) { v[e] = gelu_t(v[e]); sm += v[e]; }
                const float mean = wave_sum(sm) * (1.f / 512.f); float sq = 0.f;
#pragma unroll
                for (int e = 0; e < 8; ++e) { v[e] -= mean; sq += v[e] * v[e]; }
                const float r = rsqrtf(wave_sum(sq) * (1.f / 512.f) + 1e-6f);
#pragma unroll
                for (int e = 0; e < 8; ++e) *(LAS unsigned short*)(vnT + (lane * 8 + e) * 272 + tt * 2) = (unsigned short)f2bf(v[e] * r * lgn[e]);
            }
        }
        __syncthreads();
        {
            const int g = wave, c = lane & 15, q = lane >> 4; const bf16_t* Wg = SGUW + (size_t)g * 128 * 128;
            for (int tt16 = 0; tt16 < 8; ++tt16) {
                const int nk = (tt16 >> 1) + 1;
                bf16x8 bw[4];
#pragma unroll
                for (int kk = 0; kk < 4; ++kk) bw[kk] = *(const bf16x8*)(Wg + (size_t)(16 * tt16 + c) * 128 + 32 * (kk < nk ? kk : 0) + 8 * q);
                const int t = t0 + 16 * tt16 + c; const float bias = sgub[g * 128 + 16 * tt16 + c];
#pragma unroll
                for (int dt = 0; dt < 4; ++dt) {
                    f32x4 acc = {0.f, 0.f, 0.f, 0.f};
#pragma unroll
                    for (int kk = 0; kk < 4; ++kk) if (kk < nk) { const bf16x8 a = *(const LAS bf16x8*)(vnT + (g * 64 + 16 * dt + c) * 272 + (32 * kk + 8 * q) * 2); acc = MFMA16(a, bw[kk], acc); }
                    const int ch = g * 64 + 16 * dt + 4 * q;
                    const u32x2 uu = *(const u32x2*)(PROJ + (size_t)t * PW + C_UV + ch);
                    u32x2 o; o.x = pk2(gelu_t(lo16(uu.x)) * (acc[0] + bias), gelu_t(hi16(uu.x)) * (acc[1] + bias)); o.y = pk2(gelu_t(lo16(uu.y)) * (acc[2] + bias), gelu_t(hi16(uu.y)) * (acc[3] + bias));
                    *(u32x2*)(YC + (size_t)t * 512 + ch) = o;
                }
            }
        }
        __syncthreads();
    }
}

DI void phase_cmp2(const Params& p, int l, const Frame& F) {
    unsigned char* ws = p.ws; const int lane = F.lane; const int gw = F.vb * 8 + F.wave, NGW = F.G * 8;
    LAS float* hid = (LAS float*)(F.lds + 131072 + F.wave * 1024);
    LAS float* w2s = (LAS float*)F.lds;
    { const float* w2g = p.in[I_CW2] + (size_t)l * 2 * 256 * 64;
      for (int i = F.tid; i < 2 * 256 * 64 / 4; i += 512) *(LAS f32x4*)(w2s + i * 4) = *(const f32x4*)(w2g + i * 4); }
    __syncthreads();
    const float* CMPP = (const float*)(ws + WS_CMPP); const float* peb = (const float*)(ws + WS_PEB);
    bf16_t* CMPK = (bf16_t*)(ws + WS_CMPK); bf16_t* CMPV = (bf16_t*)(ws + WS_CMPV);
    const float* kg = p.in[I_NKG] + (l * 3 + 0) * 64;
    for (int it = gw; it < 8 * 256 * 2 * 2; it += NGW) {
        const int j = it & 1, g = (it >> 1) & 1, n = (it >> 2) & 255, b = it >> 10;
        bf16_t* dst = (j ? CMPV : CMPK) + ((size_t)(b * 2 + g) * 256 + n) * 64;
        if (n == 255) { dst[lane] = 0; continue; }
        const float* Pa = CMPP + ((size_t)j * 4096 + (size_t)(b * 256 + n) * 2 + g) * 512; const float* Pb = CMPP + ((size_t)j * 4096 + (size_t)(b * 256 + n + 1) * 2 + g) * 512 + 256;
        const f32x4 a = *(const f32x4*)(Pa + lane * 4), bq = *(const f32x4*)(Pb + lane * 4), pe = *(const f32x4*)(peb + j * 256 + lane * 4);
        f32x4 h; h.x = gelu_t(a.x + bq.x + pe.x); h.y = gelu_t(a.y + bq.y + pe.y); h.z = gelu_t(a.z + bq.z + pe.z); h.w = gelu_t(a.w + bq.w + pe.w);
        *(LAS f32x4*)(hid + lane * 4) = h;
        LDS_WAIT();
        const LAS float* w2 = w2s + j * 256 * 64;
        float o = 0.f;
#pragma unroll 16
        for (int k = 0; k < 256; ++k) o += hid[k] * w2[k * 64 + lane];
        if (j == 0) { const float ss = wave_sum(o * o); o = o * rsqrtf(ss * (1.f / 64.f) + 1e-6f) * kg[lane]; }
        dst[lane] = (bf16_t)f2bf(o);
        LDS_WAIT();
    }
}

constexpr int LUTP = 1040;
DI int bucket_fast(int n) { const int big = 16 + (int)((__log2f((float)n) - 4.f) * 2.6666667f + 2e-4f); return n < 16 ? n : (big < 31 ? big : 31); }
struct KsCmp { static constexpr bool CONTIG = true; static constexpr int DSTEP = 16, DMAX = 1 << 30; const bf16_t* kb; const bf16_t* vb; int t0, hb;
    DI void base(int k0, const bf16_t*& k, const bf16_t*& v) const { k = kb + (size_t)k0 * 64; v = vb + (size_t)k0 * 64; }
    DI int dist0(int k0, int c) const { return t0 + (c >> 2) - (16 * k0 + 31); } };
struct KsSel { static constexpr bool CONTIG = true; static constexpr int DSTEP = 1, DMAX = 1 << 30; const bf16_t* kb; const bf16_t* vb; const LAS int* selb; int t, hb;
    DI int p0(int k0) const { return __builtin_amdgcn_readfirstlane(selb[k0 >> 6]) * 64 + (k0 & 63); }
    DI void base(int k0, const bf16_t*& k, const bf16_t*& v) const { const int ps = p0(k0); k = kb + (size_t)ps * 64; v = vb + (size_t)ps * 64; }
    DI int dist0(int k0, int c) const { return t - p0(k0); } };
struct KsWin { static constexpr bool CONTIG = true; static constexpr int DSTEP = 1, DMAX = 512; const bf16_t* kb; const bf16_t* vb; int pstart, t0, hb;
    DI void base(int k0, const bf16_t*& k, const bf16_t*& v) const { k = kb + (size_t)(pstart + k0) * 64; v = vb + (size_t)(pstart + k0) * 64; }
    DI int dist0(int k0, int c) const { return t0 + (c >> 2) - (pstart + k0); } };
struct KsDsa { static constexpr bool CONTIG = false; static constexpr int DSTEP = 1, DMAX = 1 << 30; const bf16_t* kb; const bf16_t* vb; const LAS int* list; int n, t;
    DI int pos(int idx) const { return idx < n ? list[idx] : -1; }
    DI const bf16_t* krow(int idx) const { const int ps = pos(idx); return kb + (size_t)(ps < 0 ? 0 : ps) * 64; }
    DI const bf16_t* vrow(int idx) const { const int ps = pos(idx); return vb + (size_t)(ps < 0 ? 0 : ps) * 64; }
    DI float adjust(int idx, int c, float s, bool& ok, const LAS unsigned char* buck, const LAS float* tbl) const {
        const int ps = pos(idx); ok = ps >= 0 && ps <= t; const int dd = t - ps; const int dc = ok ? (dd < 1023 ? dd : 1023) : 0; return s + tbl[buck[dc] * 16 + 8 + (c & 7)]; } };

template <int MODE, class KS>
DI void flash_run(const KS& ks, int nkeys, const bf16x8 (&qb)[2], f32x4 (&o)[4], float& m_run, float& l_run, LAS unsigned char* vt, LAS float* al, LAS float* pn,
                  const LAS unsigned char* buck, const LAS float* tbl, int lane) {
    const int c = lane & 15, q = lane >> 4;
    bf16x8 A00, A01, A10, A11, B00, B01, B10, B11; u32x4 Av[4], Bv[4];
#define FL_LOAD(B_, kk0) do { if constexpr (KS::CONTIG) { const bf16_t* kbp_; const bf16_t* vbp_; ks.base((kk0), kbp_, vbp_); const bf16_t* kr0 = kbp_ + c * 64 + 8 * q; \
            B_##00 = *(const bf16x8*)kr0; B_##01 = *(const bf16x8*)(kr0 + 32); B_##10 = *(const bf16x8*)(kr0 + 1024); B_##11 = *(const bf16x8*)(kr0 + 1056); \
            if (MODE != 1) { const bf16_t* vr0 = vbp_ + (lane >> 3) * 64 + (lane & 7) * 8; _Pragma("unroll") for (int m = 0; m < 4; ++m) B_##v[m] = *(const u32x4*)(vr0 + m * 512); } } \
        else { const bf16_t* kr0 = ks.krow((kk0) + c); const bf16_t* kr1 = ks.krow((kk0) + 16 + c); \
            B_##00 = *(const bf16x8*)(kr0 + 8 * q); B_##01 = *(const bf16x8*)(kr0 + 32 + 8 * q); B_##10 = *(const bf16x8*)(kr1 + 8 * q); B_##11 = *(const bf16x8*)(kr1 + 32 + 8 * q); \
            if (MODE != 1) { _Pragma("unroll") for (int m = 0; m < 4; ++m) B_##v[m] = *(const u32x4*)(ks.vrow((kk0) + (lane >> 3) + 8 * m) + (lane & 7) * 8); } } } while (0)
#define FL_STEP(B_, K0_) do { \
        f32x4 s0 = {0.f, 0.f, 0.f, 0.f}, s1 = {0.f, 0.f, 0.f, 0.f}; \
        s0 = MFMA16(B_##00, qb[0], s0); s0 = MFMA16(B_##01, qb[1], s0); s1 = MFMA16(B_##10, qb[0], s1); s1 = MFMA16(B_##11, qb[1], s1); \
        float sv[8], pv[8]; bool ok[8]; \
        if constexpr (KS::CONTIG) { \
            const LAS float* trow = tbl + (c & 3) * LUTP; const int d0 = ks.dist0((K0_), c) - KS::DSTEP * 4 * q; \
        _Pragma("unroll") \
            for (int i = 0; i < 4; ++i) { const int da = d0 - KS::DSTEP * i, db = da - KS::DSTEP * 16; \
                ok[i] = da >= 0 && da < KS::DMAX; ok[4 + i] = db >= 0 && db < KS::DMAX; \
                sv[i] = s0[i] + trow[da < 0 ? 0 : (da < 1023 ? da : 1023)]; sv[4 + i] = s1[i] + trow[db < 0 ? 0 : (db < 1023 ? db : 1023)]; } \
        } else { \
        _Pragma("unroll") \
            for (int i = 0; i < 4; ++i) { sv[i] = ks.adjust((K0_) + 4 * q + i, c, s0[i], ok[i], buck, tbl); sv[4 + i] = ks.adjust((K0_) + 16 + 4 * q + i, c, s1[i], ok[4 + i], buck, tbl); } \
        } \
        if (MODE == 2) { \
        _Pragma("unroll") \
            for (int e = 0; e < 8; ++e) { pv[e] = ok[e] ? __builtin_amdgcn_exp2f(sv[e]) * l_run : 0.f; \
                const float x = quad_sumf(pv[e]); \
                if ((c & 3) == 0) pn[(c >> 2) * 256 + (K0_) + (e < 4 ? 4 * q + e : 16 + 4 * q + (e - 4))] = x; } \
        } else { \
            float ps = 0.f; \
        _Pragma("unroll") \
            for (int e = 0; e < 8; ++e) { pv[e] = ok[e] ? __builtin_amdgcn_exp2f(sv[e]) : 0.f; ps += pv[e]; } \
            l_run += ps; \
        } \
        if (MODE != 1) { \
        _Pragma("unroll") \
            for (int m = 0; m < 4; ++m) *(LAS u32x4*)(vt + ((lane >> 3) + 8 * m) * 144 + (lane & 7) * 16) = B_##v[m]; \
            LDS_FENCE(); \
            const bf16x8 pa = __builtin_bit_cast(bf16x8, pack8(pv)); \
        _Pragma("unroll") \
            for (int dt = 0; dt < 4; ++dt) { \
                const s16x4 lo = __builtin_amdgcn_ds_read_tr16_b64_v4i16((LAS s16x4*)(vt + (4 * q + (c >> 2)) * 144 + (16 * dt + 4 * (c & 3)) * 2)); \
                const s16x4 hi = __builtin_amdgcn_ds_read_tr16_b64_v4i16((LAS s16x4*)(vt + (16 + 4 * q + (c >> 2)) * 144 + (16 * dt + 4 * (c & 3)) * 2)); \
                const bf16x8 vb8 = __builtin_shufflevector(lo, hi, 0, 1, 2, 3, 4, 5, 6, 7); \
                o[dt] = MFMA16(pa, vb8, o[dt]); \
            } \
            LDS_FENCE(); \
        } \
    } while (0)
    FL_LOAD(A, 0);
    for (int k0 = 0; k0 < nkeys; k0 += 64) {
        { const int kn = k0 + 32 < nkeys ? k0 + 32 : k0; FL_LOAD(B, kn); }
        FL_STEP(A, k0);
        if (k0 + 32 >= nkeys) break;
        { const int kn = k0 + 64 < nkeys ? k0 + 64 : k0; FL_LOAD(A, kn); }
        FL_STEP(B, k0 + 32);
    }
#undef FL_STEP
#undef FL_LOAD
    if (MODE == 0) {
        float lt = x32_sum(x16_sum(l_run));
        const float inv = lt > 0.f ? __builtin_amdgcn_rcpf(lt) : 0.f;
        if (q == 0) al[c] = inv;
        LDS_WAIT();
        const f32x4 a4 = *(const LAS f32x4*)(al + 4 * q);
#pragma unroll
        for (int dt = 0; dt < 4; ++dt) o[dt] = o[dt] * a4;
        LDS_WAIT();
    }
}

DI void nsa_tile(const Params& p, int b, int g, int tb, const Frame& F, const LAS float* lut, int vm = 0) {
    unsigned char* ws = p.ws; const int lane = F.lane, wave = F.wave, c = lane & 15, q = lane >> 4;
    const LAS float* tbl = lut + g * 4 * LUTP;
    LAS unsigned char* wl = F.lds + wave * 9216; LAS unsigned char* vt = wl; LAS float* al = (LAS float*)(wl + 4608); LAS float* pn = (LAS float*)(wl + 4736);
    LAS float* OS = (LAS float*)F.lds; LAS float* LS = (LAS float*)(F.lds + 65536);
    LAS int* SELB = (LAS int*)(F.lds + 73728); LAS int* CNT = (LAS int*)(F.lds + 75776); LAS unsigned short* UNIT = (LAS unsigned short*)(F.lds + 76032); LAS int* NUNIT = (LAS int*)(F.lds + 76416);
    volatile LAS int* TURN = (volatile LAS int*)(F.lds + 76544); LAS unsigned short* LIST = (LAS unsigned short*)(F.lds + 76800);
    LAS unsigned char* vt2 = F.lds + 84992 + wave * 4608;
    const bf16_t* prow0 = (const bf16_t*)(ws + WS_PROJ) + (size_t)(b * SEQ) * PW;
    bf16_t* YB = (bf16_t*)(ws + WS_Y) + (size_t)T * 512;
    const f32x4 z4 = {0.f, 0.f, 0.f, 0.f};
    for (int ii = 0; ii < 2; ++ii) {
        f32x4 accw[4];
        const int item = wave * 2 + ii, t0 = 64 * tb + 4 * item;
#pragma unroll
        for (int k = 0; k < 4; ++k) *(LAS f32x4*)(pn + lane * 4 + 256 * k) = z4;
        bf16x8 qb[2];
        { const bf16_t* qp = prow0 + (size_t)(t0 + (c >> 2)) * PW + C_NQ + (g * 4 + (c & 3)) * 64 + 8 * q; qb[0] = *(const bf16x8*)qp; qb[1] = *(const bf16x8*)(qp + 32); }
        float g0[4], g2[4];
        { const u32x2 ga = *(const u32x2*)(prow0 + (size_t)(t0 + q) * PW + C_NG + 0 * 8 + g * 4), gc = *(const u32x2*)(prow0 + (size_t)(t0 + q) * PW + C_NG + 2 * 8 + g * 4);
          g0[0] = sigm(lo16(ga.x)); g0[1] = sigm(hi16(ga.x)); g0[2] = sigm(lo16(ga.y)); g0[3] = sigm(hi16(ga.y));
          g2[0] = sigm(lo16(gc.x)); g2[1] = sigm(hi16(gc.x)); g2[2] = sigm(lo16(gc.y)); g2[3] = sigm(hi16(gc.y)); }
#pragma unroll
        for (int dt = 0; dt < 4; ++dt) accw[dt] = z4;
        LDS_WAIT();
        const int tl = t0 + 3, nv = tl >= 31 ? ((tl - 31) >> 4) + 1 : 0;
        if (nv > 0 && (vm == 0 || (vm & 1))) {
            const int nk = (nv + 31) & ~31;
            KsCmp ks{(const bf16_t*)(ws + WS_CMPK) + (size_t)(b * 2 + g) * 256 * 64, (const bf16_t*)(ws + WS_CMPV) + (size_t)(b * 2 + g) * 256 * 64, t0, g * 4};
            float m = 0.f, lr = 0.f; f32x4 o[4] = {z4, z4, z4, z4};
            flash_run<1>(ks, nk, qb, o, m, lr, vt, al, pn, (const LAS unsigned char*)vt, tbl, lane);
            lr = x32_sum(x16_sum(lr)); lr = lr > 0.f ? __builtin_amdgcn_rcpf(lr) : 0.f;
            flash_run<2>(ks, nk, qb, o, m, lr, vt, al, pn, (const LAS unsigned char*)vt, tbl, lane);
#pragma unroll
            for (int dt = 0; dt < 4; ++dt) { accw[dt][0] = g0[0] * o[dt][0]; accw[dt][1] = g0[1] * o[dt][1]; accw[dt][2] = g0[2] * o[dt][2]; accw[dt][3] = g0[3] * o[dt][3]; }
        }
        LDS_WAIT();
        {
            const int j = lane; float val[4];
#pragma unroll
            for (int qi = 0; qi < 4; ++qi) {
                if (j == 0 || j == tb) val[qi] = 1e4f;
                else if (j < tb) { const LAS float* pq = pn + qi * 256 + 4 * j; val[qi] = pq[-1] + pq[0] + pq[1] + pq[2] + pq[3]; }
                else val[qi] = -1e30f;
            }
            for (int k = 0; k < 8; ++k) {
#pragma unroll
                for (int qi = 0; qi < 4; ++qi) {
                    const float mx = wave_max(val[qi]); const unsigned long long who = __ballot(val[qi] == mx); const int w = __builtin_ctzll(who);
                    if (lane == 0) SELB[(item * 4 + qi) * 8 + k] = mx > -1e29f ? w : -1;
                    if (lane == w) val[qi] = -3e38f;
                }
            }
        }
        {
            const int pstart = t0 >= 511 ? t0 - 511 : 0, nk = (t0 + 3 - pstart + 1 + 31) & ~31;
            KsWin ks{(const bf16_t*)(ws + WS_KW) + (size_t)(b * 2 + g) * SEQ * 64, (const bf16_t*)(ws + WS_VW) + (size_t)(b * 2 + g) * SEQ * 64, pstart, t0, g * 4};
            float m = 0.f, lr = 0.f; f32x4 o[4] = {z4, z4, z4, z4};
            if (vm == 0 || (vm & 2)) flash_run<0>(ks, nk, qb, o, m, lr, vt, al, pn, (const LAS unsigned char*)vt, tbl, lane);
            if (vm & 4) { flash_run<1>(ks, nk, qb, o, m, lr, vt, al, pn, (const LAS unsigned char*)vt, tbl, lane); o[0][0] += lr; }
#pragma unroll
            for (int dt = 0; dt < 4; ++dt) { accw[dt][0] += g2[0] * o[dt][0]; accw[dt][1] += g2[1] * o[dt][1]; accw[dt][2] += g2[2] * o[dt][2]; accw[dt][3] += g2[3] * o[dt][3]; }
        }
        if (vm == 0) {
            bf16_t* dst = YB + (size_t)(b * SEQ + t0 + q) * 512 + (g * 4) * 64 + c;
#pragma unroll
            for (int dt = 0; dt < 4; ++dt)
#pragma unroll
                for (int i = 0; i < 4; ++i) dst[i * 64 + 16 * dt] = (bf16_t)f2bf(accw[dt][i]);
        }
        else { asm volatile("" :: "v"(accw[0]), "v"(accw[1]), "v"(accw[2]), "v"(accw[3])); }
        LDS_WAIT();
    }
    __syncthreads();
    if (vm != 0) return;
    for (int i = F.tid; i < 66560 / 16; i += 512) *(LAS f32x4*)(F.lds + i * 16) = z4;
    if (F.tid < 64) { CNT[F.tid] = 0; TURN[F.tid] = 0; }
    __syncthreads();
    { const int blk = SELB[F.tid];
      if (blk >= 0) { int rank = 0;
#pragma unroll
          for (int k = 0; k < 8; ++k) { const int ob = SELB[(F.tid & ~7) + k]; rank += (ob >= 0 && ob < blk) ? 1 : 0; }
          const int pos = __hip_atomic_fetch_add(CNT + blk, 1, __ATOMIC_RELAXED, __HIP_MEMORY_SCOPE_WORKGROUP); LIST[blk * 64 + pos] = (unsigned short)((F.tid >> 3) | (rank << 8)); } }
    __syncthreads();
    if (wave == 0) {
        const int uj = (CNT[lane] + 3) >> 2; int inc = uj;
#pragma unroll
        for (int o_ = 1; o_ < 64; o_ <<= 1) { const int v = __shfl_up(inc, o_); if (lane >= o_) inc += v; }
        const int offs = inc - uj;
        for (int u = 0; u < uj; ++u) UNIT[offs + u] = (unsigned short)(lane | (u << 8));
        if (lane == 63) NUNIT[0] = inc;
    }
    __syncthreads();
    {
        const int nu = NUNIT[0];
        const LAS float* trow = tbl + (c & 3) * LUTP;
        const bf16_t* KSb = (const bf16_t*)(ws + WS_KS) + (size_t)(b * 2 + g) * SEQ * 64; const bf16_t* VSb = (const bf16_t*)(ws + WS_VS) + (size_t)(b * 2 + g) * SEQ * 64;
        bf16x8 kA[4], kB[4]; u32x4 vA[4], vB[4]; bf16x8 qs[2], qn[2];
        const bf16x8 zq = {0, 0, 0, 0, 0, 0, 0, 0};
#define SEL_LOAD(K_, V_, jj, st) do { const bf16_t* kr0 = KSb + (size_t)(64 * (jj) + 32 * (st) + c) * 64 + 8 * q; K_[0] = *(const bf16x8*)kr0; K_[1] = *(const bf16x8*)(kr0 + 32); K_[2] = *(const bf16x8*)(kr0 + 1024); K_[3] = *(const bf16x8*)(kr0 + 1056); \
            const bf16_t* vr0 = VSb + (size_t)(64 * (jj) + 32 * (st) + (lane >> 3)) * 64 + (lane & 7) * 8; _Pragma("unroll") for (int m = 0; m < 4; ++m) V_[m] = *(const u32x4*)(vr0 + m * 512); } while (0)
#define SEL_LOADQ(Q_, jj, uu_) do { const int sl_ = 4 * (uu_) + (c >> 2); const int qr_ = sl_ < CNT[jj] ? (int)(LIST[(jj) * 64 + sl_] & 63) : -1; \
            const bf16_t* qp = prow0 + (size_t)(64 * tb + (qr_ < 0 ? 0 : qr_)) * PW + C_NQ + (g * 4 + (c & 3)) * 64 + 8 * q; const bf16x8 q0_ = *(const bf16x8*)qp, q1_ = *(const bf16x8*)(qp + 32); \
            Q_[0] = qr_ >= 0 ? q0_ : zq; Q_[1] = qr_ >= 0 ? q1_ : zq; } while (0)
#define SEL_STEP(K_, V_, st) do { \
                f32x4 s0 = z4, s1 = z4; \
                s0 = MFMA16(K_[0], qs[0], s0); s0 = MFMA16(K_[1], qs[1], s0); s1 = MFMA16(K_[2], qs[0], s1); s1 = MFMA16(K_[3], qs[1], s1); \
                const int d0 = 64 * (tb - j) + (qrow < 0 ? 0 : qrow) - 32 * (st) - 4 * q; float pv[8]; \
            _Pragma("unroll") \
                for (int i = 0; i < 4; ++i) { const int da = d0 - i, db = da - 16; \
                    const float ea = __builtin_amdgcn_exp2f(s0[i] + trow[da < 0 ? 0 : (da < 1023 ? da : 1023)]), eb = __builtin_amdgcn_exp2f(s1[i] + trow[db < 0 ? 0 : (db < 1023 ? db : 1023)]); \
                    pv[i] = (qrow >= 0 && da >= 0) ? ea : 0.f; pv[4 + i] = (qrow >= 0 && db >= 0) ? eb : 0.f; lsum += pv[i] + pv[4 + i]; } \
            _Pragma("unroll") \
                for (int m = 0; m < 4; ++m) *(LAS u32x4*)(vt2 + ((lane >> 3) + 8 * m) * 144 + (lane & 7) * 16) = V_[m]; \
                LDS_FENCE(); \
                const bf16x8 pa = __builtin_bit_cast(bf16x8, pack8(pv)); \
            _Pragma("unroll") \
                for (int dt = 0; dt < 4; ++dt) { \
                    const s16x4 lo = __builtin_amdgcn_ds_read_tr16_b64_v4i16((LAS s16x4*)(vt2 + (4 * q + (c >> 2)) * 144 + (16 * dt + 4 * (c & 3)) * 2)); \
                    const s16x4 hi = __builtin_amdgcn_ds_read_tr16_b64_v4i16((LAS s16x4*)(vt2 + (16 + 4 * q + (c >> 2)) * 144 + (16 * dt + 4 * (c & 3)) * 2)); \
                    o[dt] = MFMA16(pa, __builtin_shufflevector(lo, hi, 0, 1, 2, 3, 4, 5, 6, 7), o[dt]); \
                } \
                LDS_FENCE(); } while (0)
        { const int uu0 = UNIT[wave < nu ? wave : 0]; SEL_LOAD(kA, vA, uu0 & 63, 0); SEL_LOADQ(qs, uu0 & 63, (uu0 >> 8) & 15); }
        for (int ui = wave; ui < nu; ui += 8) {
            const int uu = UNIT[ui], j = uu & 255, u = uu >> 8, nj = CNT[j];
            const int slot = 4 * u + (c >> 2); const int qrow = slot < nj ? (int)(LIST[j * 64 + slot] & 255) : -1;
            f32x4 o[4] = {z4, z4, z4, z4}; float lsum = 0.f;
            SEL_LOAD(kB, vB, j, 1);
            SEL_STEP(kA, vA, 0);
            { const int uu2 = UNIT[ui + 8 < nu ? ui + 8 : ui]; SEL_LOAD(kA, vA, uu2 & 63, 0); SEL_LOADQ(qn, uu2 & 63, (uu2 >> 8) & 15); }
            SEL_STEP(kB, vB, 1);
            qs[0] = qn[0]; qs[1] = qn[1];
            lsum = x32_sum(x16_sum(lsum));
#pragma unroll 1
            for (int s = 0; s < 4; ++s) {
                if (4 * u + s >= nj) break;
                const int ent = LIST[j * 64 + 4 * u + s], qs_ = ent & 255, rk = ent >> 8;
                unsigned spins = 0;
                while (TURN[qs_] != rk) { __builtin_amdgcn_s_sleep(1); if (++spins > (1u << 22)) break; }
                if (q == s) {
#pragma unroll
                    for (int dt = 0; dt < 4; ++dt)
#pragma unroll
                        for (int i = 0; i < 4; ++i) OS[(qs_ * 4 + i) * 64 + 16 * dt + c] += o[dt][i];
                }
                if ((c >> 2) == s && q == 0) LS[qs_ * 4 + (c & 3)] += lsum;
                LDS_WAIT();
                if (lane == 0) TURN[qs_] = rk + 1;
                LDS_WAIT();
            }
        }
#undef SEL_LOAD
#undef SEL_LOADQ
#undef SEL_STEP
    }
    __syncthreads();
    for (int ii = 0; ii < 2; ++ii) {
        const int item = wave * 2 + ii, qq = item * 4 + q, t = 64 * tb + qq;
        const u32x2 gg = *(const u32x2*)(prow0 + (size_t)t * PW + C_NG + 8 + g * 4);
        const float g1[4] = {sigm(lo16(gg.x)), sigm(hi16(gg.x)), sigm(lo16(gg.y)), sigm(hi16(gg.y))};
        const f32x4 l4 = *(const LAS f32x4*)(LS + qq * 4);
        const float inv[4] = {l4.x > 0.f ? g1[0] / l4.x : 0.f, l4.y > 0.f ? g1[1] / l4.y : 0.f, l4.z > 0.f ? g1[2] / l4.z : 0.f, l4.w > 0.f ? g1[3] / l4.w : 0.f};
        bf16_t* dst = YB + (size_t)(b * SEQ + t) * 512 + (g * 4) * 64 + c;
#pragma unroll
        for (int dt = 0; dt < 4; ++dt)
#pragma unroll
            for (int i = 0; i < 4; ++i) dst[i * 64 + 16 * dt] = (bf16_t)f2bf(bf2f(dst[i * 64 + 16 * dt]) + inv[i] * OS[(qq * 4 + i) * 64 + 16 * dt + c]);
    }
    __syncthreads();
}

DI void dsa_group(const Params& p, int b, int t0, const Frame& F, const LAS unsigned char* buck, const LAS float* tbl, int parts = 7) {
    unsigned char* ws = p.ws; const int lane = F.lane, wave = F.wave, c = lane & 15, q = lane >> 4;
    LAS unsigned* SC = (LAS unsigned*)F.lds;
    LAS int* list = (LAS int*)(F.lds + 131072 + wave * 1024); LAS float* al = (LAS float*)(F.lds + 139264 + wave * 64);
    const bf16_t* prow0 = (const bf16_t*)(ws + WS_PROJ) + (size_t)(b * SEQ) * PW;
    bf16_t* YD = (bf16_t*)(ws + WS_Y) + (size_t)3 * T * 512;
    const bf16x8 zf = {0, 0, 0, 0, 0, 0, 0, 0};
    const int t = t0 + wave; const bf16_t* qrow = prow0 + (size_t)t * PW;
    const bf16_t* dki = (const bf16_t*)(ws + WS_DKI) + (size_t)(b * SEQ) * 64;
    const bool full = t0 >= 256;
    if (full && (parts & 1)) {
        bf16x8 qa[4][2]; float wv[4][4];
#pragma unroll
        for (int rt = 0; rt < 4; ++rt) { const bf16_t* qp = prow0 + (size_t)(t0 + 2 * rt + (c >> 3)) * PW + C_DQI + (c & 7) * 64 + 8 * q; qa[rt][0] = *(const bf16x8*)qp; qa[rt][1] = *(const bf16x8*)(qp + 32);
            const u32x2 w4 = *(const u32x2*)(prow0 + (size_t)(t0 + 2 * rt + (q >> 1)) * PW + C_DWI + (q & 1) * 4);
            wv[rt][0] = lo16(w4.x) * 0.35355339f; wv[rt][1] = hi16(w4.x) * 0.35355339f; wv[rt][2] = lo16(w4.y) * 0.35355339f; wv[rt][3] = hi16(w4.y) * 0.35355339f; }
        const int ntile = ((t0 + 7) >> 4) + 1, nk64 = ((t0 + 7) >> 6) + 1;
        bf16x8 kx0, kx1;
        { const bf16_t* kp = dki + (size_t)(16 * (wave < ntile ? wave : 0) + c) * 64 + 8 * q; kx0 = *(const bf16x8*)kp; kx1 = *(const bf16x8*)(kp + 32); }
        for (int tau = wave; tau < ntile; tau += 8) {
            const bf16x8 kb0 = kx0, kb1 = kx1;
            { const bf16_t* kp = dki + (size_t)(16 * (tau + 8 < ntile ? tau + 8 : tau) + c) * 64 + 8 * q; kx0 = *(const bf16x8*)kp; kx1 = *(const bf16x8*)(kp + 32); }
            const int key = 16 * tau + c;
#pragma unroll
            for (int rt = 0; rt < 4; ++rt) {
                f32x4 acc = {0.f, 0.f, 0.f, 0.f};
                acc = MFMA16(qa[rt][0], kb0, acc); acc = MFMA16(qa[rt][1], kb1, acc);
                float s = wv[rt][0] * fmaxf(acc[0], 0.f) + wv[rt][1] * fmaxf(acc[1], 0.f) + wv[rt][2] * fmaxf(acc[2], 0.f) + wv[rt][3] * fmaxf(acc[3], 0.f);
                s = x16_sum(s);
                const int qq = 2 * rt + (q >> 1);
                if ((q & 1) == 0) SC[qq * 4096 + key] = key <= t0 + qq ? ordf(s) : 0u;
            }
        }
        for (int i = F.tid; i < 8 * 64; i += 512) { const int key = ntile * 16 + (i & 63); if (key < nk64 * 64) SC[(i >> 6) * 4096 + key] = 0u; }
    }
    __syncthreads();
    int n;
    if (!full) { n = t + 1; for (int i = lane; i < 256; i += 64) list[i] = i <= t ? i : -1; }
    else if (parts & 2) {
        n = 256;
        const LAS unsigned* sc = SC + wave * 4096; const int nk64 = (t >> 6) + 1;
        unsigned u[64];
#pragma unroll
        for (int k = 0; k < 64; ++k) u[k] = k < nk64 ? sc[k * 64 + lane] : 0u;
#define WAVE_TOTAL(cl, tot) do { tot = __builtin_amdgcn_readfirstlane((int)wave_sum_u(cl)); } while (0)
        unsigned prefix = 0u;
        const int nk8 = __builtin_amdgcn_readfirstlane((nk64 + 7) >> 3);
#define CNT_GE(NK) _Pragma("unroll") for (int k = 0; k < NK; ++k) cl += (u[k] >= cand) ? 1u : 0u;
        for (int bit = 31; bit >= 0; --bit) {
            const unsigned cand = prefix | (1u << bit); unsigned cl = 0u; int cnt;
            switch (nk8) { case 1: CNT_GE(8) break; case 2: CNT_GE(16) break; case 3: CNT_GE(24) break; case 4: CNT_GE(32) break;
                           case 5: CNT_GE(40) break; case 6: CNT_GE(48) break; case 7: CNT_GE(56) break; default: CNT_GE(64) break; }
            WAVE_TOTAL(cl, cnt);
            if (cnt >= 256) { prefix = cand; if (cnt == 256) break; }
        }
        int cgt; { unsigned cl = 0u;
#pragma unroll
            for (int k = 0; k < 64; ++k) cl += (u[k] > prefix) ? 1u : 0u;
            WAVE_TOTAL(cl, cgt); }
#undef WAVE_TOTAL
#undef CNT_GE
        const int need_eq = 256 - cgt; int base = 0, eqbase = 0;
#pragma unroll
        for (int k = 0; k < 64; ++k) {
            if (k < nk64) {
                const bool gtp = u[k] > prefix, eq = u[k] == prefix;
                const unsigned long long meq = __ballot(eq);
                const int eqrank = eqbase + (int)__builtin_amdgcn_mbcnt_hi((unsigned)(meq >> 32), __builtin_amdgcn_mbcnt_lo((unsigned)meq, 0u));
                const bool take = gtp || (eq && eqrank < need_eq);
                const unsigned long long mt = __ballot(take);
                const int slot = base + (int)__builtin_amdgcn_mbcnt_hi((unsigned)(mt >> 32), __builtin_amdgcn_mbcnt_lo((unsigned)mt, 0u));
                if (take && slot < 256) list[slot] = k * 64 + lane;
                base += __popcll(mt); eqbase += __popcll(meq);
            }
        }
    }
    else n = 256;
    LDS_WAIT();
    if (!(parts & 4)) { __syncthreads(); return; }
    LAS unsigned char* vt = F.lds + wave * 16384;
    bf16x8 qd[2] = {zf, zf};
    if (c < 8) { qd[0] = *(const bf16x8*)(qrow + C_DQ + c * 64 + 8 * q); qd[1] = *(const bf16x8*)(qrow + C_DQ + c * 64 + 32 + 8 * q); }
    KsDsa ks{(const bf16_t*)(ws + WS_DK) + (size_t)(b * SEQ) * 64, (const bf16_t*)(ws + WS_DV) + (size_t)(b * SEQ) * 64, list, n, t};
    const f32x4 z4 = {0.f, 0.f, 0.f, 0.f};
    float m = -1e30f, lr = 0.f; f32x4 o[4] = {z4, z4, z4, z4};
    flash_run<0>(ks, (n + 31) & ~31, qd, o, m, lr, vt, al, (LAS float*)vt, buck, tbl, lane);
    if (q < 2) {
#pragma unroll
        for (int dt = 0; dt < 4; ++dt)
#pragma unroll
            for (int i = 0; i < 4; ++i) YD[(size_t)(b * SEQ + t) * 512 + (4 * q + i) * 64 + 16 * dt + c] = (bf16_t)f2bf(o[dt][i]);
    }
    __syncthreads();
}

DI void phase_attn(const Params& p, int l, const Frame& F, int mask = 3, int parts = 15) {
    const int gw = F.vb * 8 + F.wave, NGW = F.G * 8; const float* rel = p.in[I_REL];
#ifndef MK_ATTN
#define MK_ATTN 3
#endif
    if ((MK_ATTN & 1) && (mask & 1)) {
        LAS float* lut = (LAS float*)(F.lds + 130048);
        for (int i = F.tid; i < 8 * 1024; i += 512) { const int h = i >> 10, d = i & 1023; lut[h * LUTP + d] = rel[bucket_of(d) * 16 + h] * 1.44269504f; }
        __syncthreads();
        for (int it = F.vb; it < 8 * 2 * 64; it += F.G) { const int b = it >> 7, g = (it >> 6) & 1; int tb = it & 63; if ((it / F.G) & 1) tb = 63 - tb; nsa_tile(p, b, g, tb, F, lut, (parts >> 8) & 15); }
    }
    __syncthreads();
    LAS unsigned char* buck = F.lds + 139776; LAS float* tbl = (LAS float*)(F.lds + 140800);
    for (int i = F.tid; i < 1024; i += 512) buck[i] = (unsigned char)bucket_of(i);
    tbl[F.tid] = rel[F.tid] * 1.44269504f;
    __syncthreads();
    if ((MK_ATTN & 2) && (mask & 2)) for (int it = F.vb; it < 8 * 512; it += F.G) { const int b = it >> 9; int tg = it & 511; if (b & 1) tg = 511 - tg; dsa_group(p, b, tg * 8, F, buck, tbl, parts); }
}


#ifndef MK_PROBE
#define MK_PROBE 0
#endif

DI unsigned row16_maxu(unsigned m) { unsigned o;
    o = (unsigned)DPP_I((int)m, 0xB1); m = m > o ? m : o; o = (unsigned)DPP_I((int)m, 0x4E); m = m > o ? m : o;
    o = (unsigned)DPP_I((int)m, 0x141); m = m > o ? m : o; o = (unsigned)DPP_I((int)m, 0x140); m = m > o ? m : o; return m; }
DI void peer_route_tile(const Params& p, int t0, int lane) {
    unsigned char* ws = p.ws; const int c = lane & 15, q = lane >> 4;
    const bf16_t* QP = (const bf16_t*)(ws + WS_QP); const bf16_t* SK = (const bf16_t*)(ws + WS_SK); int* EIDX = (int*)(ws + WS_EIDX); float* EW = (float*)(ws + WS_EW);
    float* EU = (float*)(ws + WS_EU); const float* USr = (const float*)(ws + WS_PTV); const float* VSr = USr + 16384;
    int ca[4], cb[4]; bool cv[4];
    ca[0] = 0; cb[0] = c; cv[0] = true;
    ca[1] = c < 8 ? 1 : (c < 13 ? 2 : 3); cb[1] = c < 8 ? c : (c < 13 ? c - 8 : c - 13); cv[1] = true;
    { const int ci = 32 + c; int a_, b_;
      if (ci == 32) { a_ = 3; b_ = 3; } else if (ci < 36) { a_ = 4; b_ = ci - 33; } else if (ci < 42) { a_ = 5 + ((ci - 36) >> 1); b_ = (ci - 36) & 1; } else { a_ = 8 + (ci - 42); b_ = 0; }
      ca[2] = a_; cb[2] = b_; cv[2] = true; }
    ca[3] = c < 2 ? 14 + c : 0; cb[3] = 0; cv[3] = c < 2;
    for (int h = 0; h < 8; ++h) {
        unsigned top[2][4];
#pragma unroll
        for (int pp = 0; pp < 2; ++pp) {
            const int hp = h * 2 + pp;
            const bf16_t* ap = QP + (size_t)(t0 + c) * 1024 + hp * 64 + 8 * q;
            const bf16x8 a0 = *(const bf16x8*)ap, a1 = *(const bf16x8*)(ap + 32);
            unsigned v[4][8];
#pragma unroll
            for (int kt = 0; kt < 8; ++kt) { const bf16_t* bp = SK + ((size_t)hp * 128 + 16 * kt + c) * 64 + 8 * q;
                const bf16x8 b0 = *(const bf16x8*)bp, b1 = *(const bf16x8*)(bp + 32);
                f32x4 acc = {0.f, 0.f, 0.f, 0.f}; acc = MFMA16(a0, b0, acc); acc = MFMA16(a1, b1, acc);
#pragma unroll
                for (int i = 0; i < 4; ++i) v[i][kt] = (ordf(acc[i]) & 0xFFFFFF80u) | (unsigned)(127 - (16 * kt + c)); }
            { unsigned mine[4] = {0u, 0u, 0u, 0u};
#define CE_(a, b) { const unsigned hi_ = v[i][a] > v[i][b] ? v[i][a] : v[i][b], lo_ = v[i][a] > v[i][b] ? v[i][b] : v[i][a]; v[i][a] = hi_; v[i][b] = lo_; }
#pragma unroll
              for (int i = 0; i < 4; ++i) { CE_(0, 1) CE_(2, 3) CE_(4, 5) CE_(6, 7) CE_(0, 2) CE_(1, 3) CE_(4, 6) CE_(5, 7) CE_(1, 2) CE_(5, 6) CE_(0, 4) CE_(3, 7) CE_(1, 5) CE_(2, 6) CE_(1, 4) CE_(3, 6) CE_(2, 4) CE_(3, 5) CE_(3, 4) }
#undef CE_
              for (int r = 0; r < 16; ++r) {
#pragma unroll
                  for (int i = 0; i < 4; ++i) { const unsigned m = row16_maxu(v[i][0]); mine[i] = (c == r) ? m : mine[i];
                      const bool win = v[i][0] == m;
#pragma unroll
                      for (int kt = 0; kt < 7; ++kt) v[i][kt] = win ? v[i][kt + 1] : v[i][kt];
                      v[i][7] = win ? 0u : v[i][7]; } }
#pragma unroll
              for (int i = 0; i < 4; ++i) top[pp][i] = mine[i]; }
        }
        unsigned cd[4][4], mine2[4] = {0u, 0u, 0u, 0u}; int i0v[4], i1v[4];
#pragma unroll
        for (int i = 0; i < 4; ++i) {
            const float s0 = unordf(top[0][i] & 0xFFFFFF80u), s1 = unordf(top[1][i] & 0xFFFFFF80u);
            i0v[i] = 127 - (int)(top[0][i] & 127u); i1v[i] = 127 - (int)(top[1][i] & 127u);
#pragma unroll
            for (int k = 0; k < 4; ++k) { const float s0a = __shfl(s0, (lane & 48) | ca[k]), s1b = __shfl(s1, (lane & 48) | cb[k]);
                cd[i][k] = cv[k] ? ((ordf(s0a + s1b) & 0xFFFFFF00u) | (unsigned)(255 - (ca[k] * 16 + cb[k]))) : 0u; }
        }
#define CE_(a, b) { const unsigned hi_ = cd[i][a] > cd[i][b] ? cd[i][a] : cd[i][b], lo_ = cd[i][a] > cd[i][b] ? cd[i][b] : cd[i][a]; cd[i][a] = hi_; cd[i][b] = lo_; }
#pragma unroll
        for (int i = 0; i < 4; ++i) { CE_(0, 1) CE_(2, 3) CE_(0, 2) CE_(1, 3) CE_(1, 2) }
#undef CE_
        for (int r = 0; r < 16; ++r) {
#pragma unroll
            for (int i = 0; i < 4; ++i) { const unsigned m = row16_maxu(cd[i][0]); mine2[i] = (c == r) ? m : mine2[i];
                const bool win = cd[i][0] == m;
#pragma unroll
                for (int k = 0; k < 3; ++k) cd[i][k] = win ? cd[i][k + 1] : cd[i][k];
                cd[i][3] = win ? 0u : cd[i][3]; }
        }
#pragma unroll
        for (int i = 0; i < 4; ++i) {
            const unsigned mine = mine2[i];
            const int pr = 255 - (int)(mine & 255u); const int ea = __shfl(i0v[i], (lane & 48) | (pr >> 4)), eb = __shfl(i1v[i], (lane & 48) | (pr & 15));
            const float scv = unordf(mine & 0xFFFFFF00u);
            const float mx = row16_maxf(scv);
            const float e = __expf(scv - mx); const float sm = row16_sumf(e);
            const size_t o = (size_t)(t0 + 4 * q + i) * 128 + h * 16 + c;
            const int eid = ea * 128 + eb; EIDX[o] = eid; EW[o] = (e / sm) * VSr[eid]; EU[o] = USr[eid];
        }
    }
}
#define MFMA8(a, b, c) __builtin_amdgcn_mfma_f32_16x16x32_fp8_fp8((a), (b), (c), 0, 0, 0)
DI long lo64(const u32x4 v) { return (long)(((unsigned long long)v.y << 32) | v.x); }
DI long hi64(const u32x4 v) { return (long)(((unsigned long long)v.w << 32) | v.z); }
template <int OFF> DI void peer_dma_o(const unsigned char* src, LAS unsigned char* dst) { __builtin_amdgcn_global_load_lds((const unsigned*)src, (LAS unsigned*)(dst - OFF), 16, OFF, 0); }
#define PEER_RD(slot_) (*(const LAS u32x4*)(ring + 1024 * (slot_) + 16 * lane))
#define PEER_VMW(n_) asm volatile("s_waitcnt vmcnt(" #n_ ")" ::: "memory")
struct PeerStream { int u0, ustep, n, xfix; bool al; };
DI PeerStream peer_stream(const Frame& F) { PeerStream s; const int bx = blockIdx.x; s.al = (F.G & 7) == 0; s.u0 = s.al ? (bx >> 3) * 8 + F.wave : bx * 8 + F.wave; s.ustep = s.al ? F.G : F.G * 8;
    const int nu = s.al ? T : T * 8; s.n = (nu - s.u0 + s.ustep - 1) / s.ustep; s.xfix = bx & 7; return s; }
DI void peer_unit(const PeerStream& s, int k, int& t, int& x) { const int u = s.u0 + (k < s.n ? k : s.n - 1) * s.ustep; t = s.al ? u : u >> 3; x = s.al ? s.xfix : u & 7; }

DI void phase_peer_u(const Params& p, const Frame& F) {
    unsigned char* ws = p.ws; const int lane = F.lane, c = lane & 15, q = lane >> 4, c8 = lane & 7, r8 = lane >> 3;
    LAS unsigned char* wl = F.lds + F.wave * LDS_PERWAVE; LAS float* pdl = (LAS float*)wl; LAS unsigned char* ring = wl + 512; LAS unsigned char* meta = wl + 512 + 16384;
    const PeerStream S = peer_stream(F);
    const unsigned char* EIDX = ws + WS_EIDX; const unsigned char* H8 = ws + WS_H8; float* PD = (float*)(ws + WS_PD); const unsigned char* PTU = ws + WS_PTU;
    const int p0 = ((c >> 1) + q) & 7, p1 = (p0 + 4) & 7;
    const int rdo = 1024 * (c >> 3) + 128 * (c & 7);
    int t, x;
#define PU_META(k_, slot_) do { peer_unit(S, (k_), t, x); const unsigned char* s_ = lane < 32 ? EIDX + (size_t)t * 512 + 16 * lane : H8 + (size_t)t * 1024 + 128 * x + 16 * (lane & 7); peer_dma_o<0>(s_, meta + 1024 * (slot_)); } while (0)
#define PU_RD(g_, pc_) (*(const LAS u32x4*)(ring + 2048 * (g_) + rdo + 16 * (pc_)))
    PU_META(0, 0); PU_META(1, 1);
    asm volatile("s_waitcnt vmcnt(0)" ::: "memory");
    u32x4 in_[4], hc0, hc1, hn0, hn1;
    { u32x4 i0_[4];
#pragma unroll
      for (int v_ = 0; v_ < 4; ++v_) i0_[v_] = *(const LAS u32x4*)(meta + 64 * r8 + 16 * v_);
      hn0 = *(const LAS u32x4*)(meta + 512 + 16 * p0); hn1 = *(const LAS u32x4*)(meta + 512 + 16 * p1);
      peer_unit(S, 0, t, x); const unsigned char* tb = PTU + (size_t)x * PT_SLICE + 16 * c8;
#define PU_D0(j) peer_dma_o<0>(tb + (size_t)i0_[(j) >> 2][(j) & 3] * 128, ring + 1024 * (j))
      PU_D0(0); PU_D0(1); PU_D0(2); PU_D0(3); PU_D0(4); PU_D0(5); PU_D0(6); PU_D0(7); PU_D0(8); PU_D0(9); PU_D0(10); PU_D0(11); PU_D0(12); PU_D0(13); PU_D0(14); PU_D0(15);
#undef PU_D0
    }
    PEER_VMW(12);
    u32x4 ra[2], rb[2];
#pragma unroll
    for (int i = 0; i < 2; ++i) { ra[i] = PU_RD(i, p0); rb[i] = PU_RD(i, p1); }
    const f32x4 z4 = {0.f, 0.f, 0.f, 0.f};
    for (int k = 0; k < S.n; ++k) {
        int tc, xc; peer_unit(S, k, tc, xc);
        hc0 = hn0; hc1 = hn1;
        { LAS unsigned char* m1 = meta + 1024 * ((k + 1) & 1);
#pragma unroll
          for (int v_ = 0; v_ < 4; ++v_) in_[v_] = *(const LAS u32x4*)(m1 + 64 * r8 + 16 * v_);
          hn0 = *(const LAS u32x4*)(m1 + 512 + 16 * p0); hn1 = *(const LAS u32x4*)(m1 + 512 + 16 * p1); }
        LDS_WAIT(); PU_META(k + 2, k & 1);
        peer_unit(S, k + 1, t, x);
        const unsigned char* tbn = PTU + (size_t)x * PT_SLICE + 16 * c8;
#define PU_GRP(g) do { if ((g) < 6) PEER_VMW(11); else PEER_VMW(10); const u32x4 na = PU_RD(((g) + 2) & 7, p0), nb = PU_RD(((g) + 2) & 7, p1); \
            f32x4 acc = MFMA8(lo64(ra[(g) & 1]), lo64(hc0), z4); acc = MFMA8(hi64(ra[(g) & 1]), hi64(hc0), acc); acc = MFMA8(lo64(rb[(g) & 1]), lo64(hc1), acc); acc = MFMA8(hi64(rb[(g) & 1]), hi64(hc1), acc); \
            asm volatile("" :: "v"(ra[(g) & 1]), "v"(rb[(g) & 1])); \
            peer_dma_o<0>(tbn + (size_t)in_[(2 * (g)) >> 2][(2 * (g)) & 3] * 128, ring + 2048 * (g)); peer_dma_o<0>(tbn + (size_t)in_[(2 * (g) + 1) >> 2][(2 * (g) + 1) & 3] * 128, ring + 2048 * (g) + 1024); \
            ra[(g) & 1] = na; rb[(g) & 1] = nb; \
            { const float d01 = (c & 1) ? acc[1] : acc[0], d23 = (c & 1) ? acc[3] : acc[2], dg = (c & 2) ? d23 : d01; if (q == (c >> 2)) pdl[16 * (c & 7) + 2 * (g) + (c >> 3)] = dg; } } while (0)
        PU_GRP(0); PU_GRP(1); PU_GRP(2); PU_GRP(3); PU_GRP(4); PU_GRP(5); PU_GRP(6); PU_GRP(7);
#undef PU_GRP
        { const u32x2 pv = *(const LAS u32x2*)(pdl + 2 * lane); *(u32x2*)(PD + ((size_t)xc * T + tc) * 128 + 2 * lane) = pv; }
    }
#undef PU_META
#undef PU_RD
    asm volatile("s_waitcnt vmcnt(0) lgkmcnt(0)" ::: "memory");
}

DI void phase_peer_coef(const Params& p, const Frame& F) {
    unsigned char* ws = p.ws; const float* PD = (const float*)(ws + WS_PD); const float* EW = (const float*)(ws + WS_EW); const float* EU = (const float*)(ws + WS_EU);
    const float* HSI = (const float*)(ws + WS_HSI); float* COEF = (float*)(ws + WS_COEF);
    const size_t NT = (size_t)F.G * 512;
    for (size_t i0 = (size_t)F.vb * 512 + F.tid; i0 < (size_t)T * 128; i0 += 4 * NT) {
        float d[4][8], ew[4], eu[4], hs[4];
#pragma unroll
        for (int r = 0; r < 4; ++r) { size_t i = i0 + r * NT; if (i >= (size_t)T * 128) i = i0; const int t = (int)(i >> 7), pp = (int)(i & 127);
#pragma unroll
            for (int x = 0; x < 8; ++x) d[r][x] = PD[((size_t)x * T + t) * 128 + pp];
            ew[r] = EW[i]; eu[r] = EU[i]; hs[r] = HSI[t]; }
#pragma unroll
        for (int r = 0; r < 4; ++r) { const size_t i = i0 + r * NT; if (i >= (size_t)T * 128) break;
            const float dot = ((d[r][0] + d[r][1]) + (d[r][2] + d[r][3])) + ((d[r][4] + d[r][5]) + (d[r][6] + d[r][7]));
            COEF[i] = ew[r] * gelu_t(dot * eu[r] * hs[r]); }
    }
}

DI void phase_peer_v(const Params& p, const Frame& F, const float* xin, float* xout, const float* gple, bool fuse) {
    unsigned char* ws = p.ws; const int lane = F.lane, c8 = lane & 7, r8 = lane >> 3;
    LAS unsigned char* wl = F.lds + F.wave * LDS_PERWAVE; LAS unsigned char* ring = wl; LAS unsigned char* meta = wl + 16384; LAS unsigned char* xs = wl + 16384 + 2048;
    const PeerStream S = peer_stream(F);
    const unsigned char* EIDX = ws + WS_EIDX; const unsigned char* COEF = ws + WS_COEF; const unsigned char* PTV = ws + WS_PTU + 16 * MiB;
    typedef float f32x2_t __attribute__((ext_vector_type(2)));
    int colofs;
    { const auto ra = __builtin_amdgcn_permlane32_swap(0u, 8u, false, false); const unsigned ta = ra[0];
      const auto rb = __builtin_amdgcn_permlane16_swap(ta, ta + 4u, false, false); const unsigned tb = rb[0];
      colofs = (int)tb + ((lane & 8) ? 2 : 0); }
    LAS float* gl = (LAS float*)(F.lds + 8 * LDS_PERWAVE);
    for (int i = F.tid; i < 1024; i += 512) gl[i] = gple[i];
    __syncthreads();
    bf16_t* Hn = (bf16_t*)(ws + WS_H); float* SSQ = (float*)(ws + WS_SSQ);
    int t, x;
#define PV_META(k_, slot_) do { peer_unit(S, (k_), t, x); const unsigned char* s_ = (lane < 32 ? EIDX : COEF) + (size_t)t * 512 + 16 * (lane & 31); peer_dma_o<0>(s_, meta + 1024 * (slot_)); } while (0)
#define PV_XS(k_, slot_) do { peer_unit(S, (k_), t, x); if (lane < 32) peer_dma_o<0>((const unsigned char*)(xin + (size_t)t * 1024 + 128 * x) + 16 * lane, xs + 512 * (slot_)); } while (0)
    PV_META(0, 0); PV_META(1, 1); PV_XS(0, 0);
    asm volatile("s_waitcnt vmcnt(0)" ::: "memory");
    u32x4 in_[4]; f32x4 cf[4], cn[4];
    { u32x4 i0_[4];
#pragma unroll
      for (int v_ = 0; v_ < 4; ++v_) { i0_[v_] = *(const LAS u32x4*)(meta + 64 * r8 + 16 * v_); cn[v_] = *(const LAS f32x4*)(meta + 512 + 64 * r8 + 16 * v_); }
      peer_unit(S, 0, t, x); const unsigned char* tb = PTV + (size_t)x * PT_SLICE + 16 * c8;
#define PV_D0(j) peer_dma_o<0>(tb + (size_t)i0_[(j) >> 2][(j) & 3] * 128, ring + 1024 * (j))
      PV_D0(0); PV_D0(1); PV_D0(2); PV_D0(3); PV_D0(4); PV_D0(5); PV_D0(6); PV_D0(7); PV_D0(8); PV_D0(9); PV_D0(10); PV_D0(11); PV_D0(12); PV_D0(13); PV_D0(14); PV_D0(15);
#undef PV_D0
    }
    PEER_VMW(12);
    u32x4 rr[4];
#pragma unroll
    for (int i = 0; i < 4; ++i) rr[i] = PEER_RD(i);
    for (int k = 0; k < S.n; ++k) {
        int tc, xc; peer_unit(S, k, tc, xc);
#pragma unroll
        for (int v_ = 0; v_ < 4; ++v_) cf[v_] = cn[v_];
        { LAS unsigned char* m1 = meta + 1024 * ((k + 1) & 1);
#pragma unroll
          for (int v_ = 0; v_ < 4; ++v_) { in_[v_] = *(const LAS u32x4*)(m1 + 64 * r8 + 16 * v_); cn[v_] = *(const LAS f32x4*)(m1 + 512 + 64 * r8 + 16 * v_); } }
        LDS_WAIT(); PV_META(k + 2, k & 1);
        PV_XS(k + 1, (k + 1) & 1);
        peer_unit(S, k + 1, t, x);
        const unsigned char* tbn = PTV + (size_t)x * PT_SLICE + 16 * c8;
        f32x2_t out[8];
#pragma unroll
        for (int e = 0; e < 8; ++e) out[e] = (f32x2_t){0.f, 0.f};
#define PV_STEP(j) do { if ((j) < 12) PEER_VMW(13); else PEER_VMW(11); const u32x4 nw = PEER_RD(((j) + 4) & 15); \
            const u32x4 pv_ = rr[(j) & 3]; const float c1_ = cf[(j) >> 2][(j) & 3]; const f32x2_t cc = {c1_, c1_}; \
            out[0] += cc * __builtin_amdgcn_cvt_pk_f32_fp8((int)pv_.x, false); out[1] += cc * __builtin_amdgcn_cvt_pk_f32_fp8((int)pv_.x, true); \
            out[2] += cc * __builtin_amdgcn_cvt_pk_f32_fp8((int)pv_.y, false); out[3] += cc * __builtin_amdgcn_cvt_pk_f32_fp8((int)pv_.y, true); \
            out[4] += cc * __builtin_amdgcn_cvt_pk_f32_fp8((int)pv_.z, false); out[5] += cc * __builtin_amdgcn_cvt_pk_f32_fp8((int)pv_.z, true); \
            out[6] += cc * __builtin_amdgcn_cvt_pk_f32_fp8((int)pv_.w, false); out[7] += cc * __builtin_amdgcn_cvt_pk_f32_fp8((int)pv_.w, true); \
            asm volatile("" :: "v"(rr[(j) & 3])); \
            peer_dma_o<0>(tbn + (size_t)in_[(j) >> 2][(j) & 3] * 128, ring + 1024 * (j)); rr[(j) & 3] = nw; } while (0)
        PV_STEP(0); PV_STEP(1); PV_STEP(2); PV_STEP(3); PV_STEP(4); PV_STEP(5); PV_STEP(6); PV_STEP(7);
        PV_STEP(8); PV_STEP(9); PV_STEP(10); PV_STEP(11); PV_STEP(12); PV_STEP(13); PV_STEP(14); PV_STEP(15);
#undef PV_STEP
        float n8[8], n4[4], f2[2];
#pragma unroll
        for (int i = 0; i < 8; ++i) { const float a_ = (i & 1) ? out[i >> 1].y : out[i >> 1].x, b_ = (i & 1) ? out[4 + (i >> 1)].y : out[4 + (i >> 1)].x;
            const auto r_ = __builtin_amdgcn_permlane32_swap(__float_as_uint(a_), __float_as_uint(b_), false, false); n8[i] = __uint_as_float(r_[0]) + __uint_as_float(r_[1]); }
#pragma unroll
        for (int i = 0; i < 4; ++i) { const auto r_ = __builtin_amdgcn_permlane16_swap(__float_as_uint(n8[i]), __float_as_uint(n8[4 + i]), false, false); n4[i] = __uint_as_float(r_[0]) + __uint_as_float(r_[1]); }
#pragma unroll
        for (int i = 0; i < 2; ++i) { const bool hi8 = (lane & 8) != 0; const float keep = hi8 ? n4[2 + i] : n4[i], send = hi8 ? n4[i] : n4[2 + i];
            f2[i] = keep + __builtin_bit_cast(float, DPP_I(__builtin_bit_cast(int, send), 0x128)); }
        { const f32x2_t xv = *(const LAS f32x2_t*)(xs + 512 * (k & 1) + 4 * (16 * c8 + colofs));
          const f32x2_t o = {xv.x + f2[0], xv.y + f2[1]}; *(f32x2_t*)(xout + (size_t)tc * 1024 + 128 * xc + 16 * c8 + colofs) = o;
          if (fuse) { const f32x2_t gg = *(const LAS f32x2_t*)(gl + 128 * xc + 16 * c8 + colofs);
              *(unsigned*)(Hn + (size_t)tc * 1024 + 128 * xc + 16 * c8 + colofs) = pk2(o.x * gg.x, o.y * gg.y);
              const float ss = wave_sum(o.x * o.x + o.y * o.y); if (lane == 0) SSQ[(size_t)tc * 8 + xc] = ss; } }
    }
#undef PV_META
#undef PV_XS
    asm volatile("s_waitcnt vmcnt(0) lgkmcnt(0)" ::: "memory");
}
#undef PEER_RD
#undef PEER_VMW

#ifndef MK_MASK
#define MK_MASK 0xffff
#endif
__global__ void __launch_bounds__(512, 2) mega(Params p) {
    extern __shared__ __attribute__((aligned(16))) unsigned char lds_raw[];
#define MKFRAME() Frame F; { int t_ = threadIdx.x; asm volatile("" : "+v"(t_)); F.lds = (LAS unsigned char*)lds_raw; F.tid = t_; F.lane = t_ & 63; F.wave = __builtin_amdgcn_readfirstlane(t_ >> 6); \
        F.G = gridDim.x; const int bx = blockIdx.x; F.vb = (F.G % 8 == 0) ? (bx % 8) * (F.G / 8) + bx / 8 : bx; }
    if (threadIdx.x < 16) ((LAS unsigned*)((LAS unsigned char*)lds_raw + LDS_XB))[threadIdx.x] = 0u;
    __syncthreads();
    const int lo = p.ph_lo, hi = p.ph_hi;
    XcdBarrier bar; bar.bar = (unsigned*)(p.ws + WS_CTL) + 4096; bar.x = 0; bar.st = (volatile LAS unsigned*)((LAS unsigned char*)lds_raw + LDS_XB);
    if (hi - lo > 1) bar = xcd_barrier_post((unsigned*)(p.ws + WS_CTL) + 4096, (volatile LAS unsigned*)((LAS unsigned char*)lds_raw + LDS_XB));
#define WSP(ws) unsigned char* ws = p.ws; asm volatile("" : "+s"(ws))
    for (int l = 0; l < NLAYER; ++l) {
        const int pb = l * NPH;
#define IN(k) (((MK_MASK >> (k)) & 1) && lo <= pb + (k) && pb + (k) < hi)
#if MK_PROBE == 120
#define SEAM(k) do { if (((MK_MASK >> (k)) & 1) && lo <= pb + (k) && pb + (k) + 1 < hi) { xcd_barrier(bar); xcd_barrier(bar); xcd_barrier(bar); } } while (0)
#else
#define SEAM(k) do { if (((MK_MASK >> (k)) & 1) && lo <= pb + (k) && pb + (k) + 1 < hi) xcd_barrier(bar); } while (0)
#endif
        if (IN(0)) { MKFRAME(); phase_prep_w(p, l, F); }
        SEAM(0);
#if MK_PROBE == 100
        if (IN(0)) { MKFRAME(); phase_prep_w(p, l, F); } xcd_barrier(bar);
#endif
        if (IN(1)) { MKFRAME(); WSP(ws); pg8::Gemm g{(const bf16_t*)(ws + WS_H), (const bf16_t*)(ws + WS_WCAT), T, 9216, 1024}; XcdColOrder S{F.G, (int)blockIdx.x};
            Epi1 E{(bf16_t*)(ws + WS_PROJ), (bf16_t*)(ws + WS_GATES)};
            pg8::gemm_phase<Epi1, XcdColOrder, false>(F.lds, g, S, E, nullptr); }
        SEAM(1);
#if MK_PROBE == 104
        if (IN(1)) { for (int rr = 0; rr < 18; ++rr) { MKFRAME(); WSP(ws); pg8::Gemm g{(const bf16_t*)(ws + WS_H), (const bf16_t*)(ws + WS_WCAT), T, 9216, 1024}; RoundOrder S; S.base.init(T, 9216, F.G, (int)blockIdx.x); S.r = rr;
            Epi1 E{(bf16_t*)(ws + WS_PROJ), (bf16_t*)(ws + WS_GATES)};
            pg8::gemm_phase<Epi1, RoundOrder, false>(F.lds, g, S, E, nullptr); xcd_barrier(bar); } }
#endif
#if MK_PROBE == 101 || MK_PROBE == 102 || MK_PROBE == 103
        if (IN(1)) { MKFRAME(); WSP(ws); pg8::Gemm g{(const bf16_t*)(ws + WS_H), (const bf16_t*)(ws + WS_WCAT), T, 9216, 1024}; ColRangeOrder S{F.G, (int)blockIdx.x, MK_PROBE == 103 ? 20 : 0, MK_PROBE == 102 ? 20 : 36};
            Epi1 E{(bf16_t*)(ws + WS_PROJ), (bf16_t*)(ws + WS_GATES)};
            pg8::gemm_phase<Epi1, ColRangeOrder, false>(F.lds, g, S, E, nullptr); } xcd_barrier(bar);
#endif
        if (IN(2)) { MKFRAME(); phase_chunk(p, l, F); }
        SEAM(2);
#if MK_PROBE == 140
        if (IN(2)) { MKFRAME(); phase_chunk(p, l, F); xcd_barrier(bar); }
#endif
        if (IN(3)) { MKFRAME(); WSP(ws);
            { pg8::Gemm g{(const bf16_t*)(ws + WS_CMPA), (const bf16_t*)(ws + WS_W1C), 4096, 512, 1024}; pg8::StaticOrder S; S.init(4096, 512, F.G, (int)blockIdx.x); EpiF32P E{(float*)(ws + WS_CMPP), 512};
              pg8::gemm_phase<EpiF32P, pg8::StaticOrder, false>(F.lds, g, S, E, nullptr); }
        }
        if (IN(3)) { MKFRAME(); WSP(ws);
            { pg8::Gemm g{(const bf16_t*)(ws + WS_CMPA) + (size_t)4096 * 1024, (const bf16_t*)(ws + WS_W1C) + (size_t)512 * 1024, 4096, 512, 1024}; pg8::StaticOrder S; S.init(4096, 512, F.G, (int)((blockIdx.x + F.G / 2) % F.G));
              EpiF32P E{(float*)(ws + WS_CMPP) + (size_t)4096 * 512, 512};
              pg8::gemm_phase<EpiF32P, pg8::StaticOrder, false>(F.lds, g, S, E, nullptr); }
        }
        SEAM(3);
        if (IN(4)) { MKFRAME(); phase_cmp2(p, l, F); }
        SEAM(4);
#if MK_PROBE == 141
        if (IN(4)) { MKFRAME(); phase_cmp2(p, l, F); xcd_barrier(bar); }
#endif
        if (IN(5)) { MKFRAME(); phase_attn(p, l, F, 3, 15); }
        SEAM(5);
#if MK_PROBE == 5 || MK_PROBE == 50 || MK_PROBE == 51 || MK_PROBE == 52 || MK_PROBE == 53
        if (IN(5)) { MKFRAME(); phase_attn(p, l, F, MK_PROBE == 5 ? 3 : (MK_PROBE == 50 ? 1 : 2), MK_PROBE == 52 ? 1 : (MK_PROBE == 53 ? 3 : 15)); xcd_barrier(bar); }
#endif
#if MK_PROBE >= 60 && MK_PROBE < 76
        if (IN(5)) { MKFRAME(); phase_attn(p, l, F, 1, (MK_PROBE - 60) << 8); xcd_barrier(bar); }
#endif
        if (IN(6)) { MKFRAME(); WSP(ws); pg8::Gemm g{(const bf16_t*)(ws + WS_Y), (const bf16_t*)(ws + WS_WBR), 4 * T, 4096, 512}; BranchOrder S{F.G, (int)blockIdx.x};
            EpiBranch E{(const bf16_t*)(ws + WS_GATES), (bf16_t*)(ws + WS_MERGED)};
            pg8::gemm_phase<EpiBranch, BranchOrder, false>(F.lds, g, S, E, nullptr); }
        SEAM(6);
#if MK_PROBE == 106
        if (IN(6)) { MKFRAME(); WSP(ws); pg8::Gemm g{(const bf16_t*)(ws + WS_Y), (const bf16_t*)(ws + WS_WBR), 4 * T, 4096, 512}; BranchOrder S{F.G, (int)blockIdx.x};
            EpiBranch E{(const bf16_t*)(ws + WS_GATES), (bf16_t*)(ws + WS_MERGED)};
            pg8::gemm_phase<EpiBranch, BranchOrder, false>(F.lds, g, S, E, nullptr); } xcd_barrier(bar);
#endif
        if (IN(7)) { MKFRAME(); WSP(ws); pg8::Gemm g{(const bf16_t*)(ws + WS_MERGED), (const bf16_t*)(ws + WS_WOUT4), T, 1024, 1024}; pg8::StaticOrder S; S.init(T, 1024, F.G, (int)blockIdx.x);
            EpiRes E{l == 0 ? p.in[I_X] : p.out, p.out};
            pg8::gemm_phase<EpiRes, pg8::StaticOrder, false>(F.lds, g, S, E, nullptr); }
        SEAM(7);
        if (IN(8)) { MKFRAME(); WSP(ws); rmsnorm_rows(p.out, p.in[I_GFFN] + l * 1024, (bf16_t*)(ws + WS_H), F.vb * 8 + F.wave, F.G * 8, F.lane, ws + WS_H8, (float*)(ws + WS_HSI)); }
        SEAM(8);
#if MK_PROBE == 108
        if (IN(8)) { MKFRAME(); WSP(ws); rmsnorm_rows(p.out, p.in[I_GFFN] + l * 1024, (bf16_t*)(ws + WS_H), F.vb * 8 + F.wave, F.G * 8, F.lane); } xcd_barrier(bar);
#endif
        if (IN(9)) { MKFRAME(); WSP(ws);
            { pg8::Gemm g{(const bf16_t*)(ws + WS_H), (const bf16_t*)(ws + WS_WQ), T, 1024, 1024}; pg8::StaticOrder S; S.init(T, 1024, F.G, (int)blockIdx.x); EpiBf E{(bf16_t*)(ws + WS_QP), 1024};
              pg8::gemm_phase<EpiBf, pg8::StaticOrder, false>(F.lds, g, S, E, nullptr); }
        }
        if (IN(9)) { MKFRAME(); WSP(ws);
            { pg8::Gemm g{(const bf16_t*)(ws + WS_PB), (const bf16_t*)(ws + WS_WPP), T, 1024, 256}; pg8::StaticOrder S; S.init(T, 1024, F.G, (int)blockIdx.x); EpiBf E{(bf16_t*)(ws + WS_PP), 1024};
              pg8::gemm_phase<EpiBf, pg8::StaticOrder, false>(F.lds, g, S, E, nullptr); }
        }
        SEAM(9);
#if MK_PROBE == 110
        if (IN(9)) { for (int rep = 0; rep < 9; ++rep) { MKFRAME(); WSP(ws);
            { pg8::Gemm g{(const bf16_t*)(ws + WS_H), (const bf16_t*)(ws + WS_WQ), T, 1024, 1024}; pg8::StaticOrder S; S.init(T, 1024, F.G, (int)blockIdx.x); EpiBf E{(bf16_t*)(ws + WS_QP), 1024};
              pg8::gemm_phase<EpiBf, pg8::StaticOrder, false>(F.lds, g, S, E, nullptr); } } xcd_barrier(bar); }
#endif
#if MK_PROBE == 109
        if (IN(9)) { MKFRAME(); WSP(ws);
            { pg8::Gemm g{(const bf16_t*)(ws + WS_H), (const bf16_t*)(ws + WS_WQ), T, 1024, 1024}; pg8::StaticOrder S; S.init(T, 1024, F.G, (int)blockIdx.x); EpiBf E{(bf16_t*)(ws + WS_QP), 1024};
              pg8::gemm_phase<EpiBf, pg8::StaticOrder, false>(F.lds, g, S, E, nullptr); } }
        if (IN(9)) { MKFRAME(); WSP(ws);
            { pg8::Gemm g{(const bf16_t*)(ws + WS_PB), (const bf16_t*)(ws + WS_WPP), T, 1024, 256}; pg8::StaticOrder S; S.init(T, 1024, F.G, (int)blockIdx.x); EpiBf E{(bf16_t*)(ws + WS_PP), 1024};
              pg8::gemm_phase<EpiBf, pg8::StaticOrder, false>(F.lds, g, S, E, nullptr); } }
        xcd_barrier(bar);
#endif
        if (IN(10)) { MKFRAME(); for (int tile = F.vb * 8 + F.wave; tile < T / 16; tile += F.G * 8) peer_route_tile(p, tile * 16, F.lane); }
        SEAM(10);
        if (IN(11)) { MKFRAME(); phase_peer_u(p, F); }
        SEAM(11);
        if (IN(12)) { MKFRAME(); phase_peer_coef(p, F); }
        SEAM(12);
        if (IN(13)) { MKFRAME(); phase_peer_v(p, F, p.out, p.out, p.in[I_GPLE] + l * 1024, true); }
        SEAM(13);
#if MK_PROBE == 130
        if (IN(13)) { MKFRAME(); phase_peer_u(p, F); xcd_barrier(bar); }
#endif
#if MK_PROBE == 131
        if (IN(13)) { MKFRAME(); phase_peer_coef(p, F); xcd_barrier(bar); }
#endif
#if MK_PROBE == 132
        if (IN(13)) { MKFRAME(); phase_peer_v(p, F, p.out, (float*)(p.ws + WS_Y), p.in[I_GPLE] + l * 1024, false); xcd_barrier(bar); }
#endif
#if MK_PROBE == 133
        if (IN(13)) { MKFRAME(); for (int tile = F.vb * 8 + F.wave; tile < T / 16; tile += F.G * 8) peer_route_tile(p, tile * 16, F.lane); xcd_barrier(bar); }
#endif
        if (IN(15)) { MKFRAME(); WSP(ws); pg8::Gemm g{(const bf16_t*)(ws + WS_H), (const bf16_t*)(ws + WS_WPG), T, 1024, 1024}; pg8::StaticOrder S; S.init(T, 1024, F.G, (int)blockIdx.x);
            EpiPle E{p.out, (const bf16_t*)(ws + WS_PP), (const float*)(ws + WS_SSQ)};
            pg8::gemm_phase<EpiPle, pg8::StaticOrder, false>(F.lds, g, S, E, nullptr); }
        SEAM(15);
#undef IN
#undef SEAM
    }
}
}

#ifndef MK_LAUNCH_PER_PHASE
#define MK_LAUNCH_PER_PHASE 0
#endif
extern "C" void kernel_launch(void* const* d_in, const int* in_sizes, int n_in, void* d_out, int out_size, void* d_ws, size_t ws_size, hipStream_t stream) {
    static int grid = 0;
    if (grid == 0) {
        if (n_in != 27 || ws_size < mk::WS_END) { fprintf(stderr, "kernel_launch: need 27 inputs and >= %zu bytes of workspace (got %d, %zu)\n", (size_t)mk::WS_END, n_in, ws_size); grid = -1; return; }
        int dev = 0, cus = 0;
        if (hipGetDevice(&dev) != hipSuccess || hipDeviceGetAttribute(&cus, hipDeviceAttributeMultiprocessorCount, dev) != hipSuccess) { grid = -1; return; }
        if (hipFuncSetAttribute((const void*)mk::mega, hipFuncAttributeMaxDynamicSharedMemorySize, mk::LDS_BYTES) != hipSuccess) { fprintf(stderr, "kernel_launch: hipFuncSetAttribute failed\n"); grid = -1; return; }
        int per_cu = 0;
        if (hipOccupancyMaxActiveBlocksPerMultiprocessor(&per_cu, (const void*)mk::mega, 512, mk::LDS_BYTES) != hipSuccess || per_cu < 1) fprintf(stderr, "kernel_launch: occupancy query says %d\n", per_cu);
        (void)hipGetLastError();
        grid = cus;
    }
    if (grid < 0) return;
    (void)in_sizes; (void)out_size;
    hipMemsetAsync((char*)d_ws + mk::WS_CTL, 0, 1u << 20, stream);
    mk::Params prm{};
    for (int i = 0; i < 27; ++i) prm.in[i] = (const float*)d_in[i];
    prm.out = (float*)d_out; prm.ws = (unsigned char*)d_ws;
#if MK_LAUNCH_PER_PHASE
    for (int ph = 0; ph < mk::NLAYER * mk::NPH; ++ph) { prm.ph_lo = ph; prm.ph_hi = ph + 1; hipLaunchKernelGGL(mk::mega, dim3(grid), dim3(512), mk::LDS_BYTES, stream, prm); }
#else
    prm.ph_lo = 0; prm.ph_hi = mk::NLAYER * mk::NPH; hipLaunchKernelGGL(mk::mega, dim3(grid), dim3(512), mk::LDS_BYTES, stream, prm);
#endif
}
```

```cpp
#include <hip/hip_runtime.h>
#include <stdio.h>
#include <stdint.h>
namespace pg8 {
#define PG8_LAS __attribute__((address_space(3)))
typedef unsigned short bf16_t;
typedef short bf16x8 __attribute__((ext_vector_type(8)));
typedef float f32x4 __attribute__((ext_vector_type(4)));
typedef unsigned u32x4 __attribute__((ext_vector_type(4)));
constexpr int BM = 256, BK = 64, HALF = 128, HTB = HALF * BK * 2  , STAGE_BYTES = 8 * HTB, NXCD = 8, WGM = 8;

__host__ __device__ __forceinline__ int lds_byte(int r, int c) { const int st = (r >> 4) * 2 + (c >> 5), rr = r & 15, cc = c & 31, ob = rr * 64 + cc * 2; return st * 1024 + (ob ^ (((ob >> 9) & 1) << 5)); }
__host__ __device__ __forceinline__ void stage_rc(int b, int& R, int& C) { const int st = b / 1024, sb = b % 1024, swz = sb ^ (((sb >> 9) & 1) << 5); R = (st >> 1) * 16 + swz / 64; C = (st & 1) * 32 + (swz % 64) / 2; }
__host__ __device__ __forceinline__ int perm32(int rho) { const int n = rho >> 4, i = rho & 15; return 8 * (i >> 2) + 4 * n + (i & 3); }

struct Unit { int pm, pn; };
struct Gemm { const bf16_t* A; const bf16_t* Bt; int M, N, K; };

struct StaticOrder {
    int nM, nN, nwg, G, c;
    __host__ __device__ void init(int M, int N, int G_, int c_) { nM = M / BM; nN = N / BM; nwg = nM * nN; G = G_; c = c_; }
    __host__ __device__ bool next(int i, Unit& u) const {
        const long L = (long)i * G + c; if (L >= nwg) return false;
        int wgid = (int)L; { const int q = nwg / NXCD, r = nwg % NXCD, xcd = wgid % NXCD, off = wgid / NXCD; wgid = (xcd < r ? xcd * (q + 1) : r * (q + 1) + (xcd - r) * q) + off; }
        const int nig = WGM * nN, gid = wgid / nig, fm = gid * WGM, gsz = (nM - fm) < WGM ? (nM - fm) : WGM;
        u.pm = fm + ((wgid % nig) % gsz); u.pn = (wgid % nig) / gsz; return true;
    }
    __device__ __forceinline__ void a_ready(const Unit&) const {}
    __device__ __forceinline__ void done(const Unit&) const {}
};
__device__ __forceinline__ unsigned cvt_pk_bf16(float lo, float hi) { unsigned r; asm volatile("v_cvt_pk_bf16_f32 %0, %1, %2" : "=v"(r) : "v"(lo), "v"(hi)); return r; }
template <class Epi, class Sched, bool STAMP = false>
__device__ __forceinline__ void gemm_phase(PG8_LAS unsigned char* lds, const Gemm g, const Sched& S, const Epi& E, unsigned long long* stamps) {
    int tid_l = threadIdx.x; asm volatile("" : "+v"(tid_l));
    const int tid = tid_l, wid = __builtin_amdgcn_readfirstlane(tid >> 6), lane = tid & 63, wr = wid >> 2, wc = wid & 3, fr = lane & 15, fq = lane >> 4;
    const int K = g.K, nt = K / BK;
    int ts_lo = 0, ts_hi = 0, nts = 0; const unsigned long long rt_entry = STAMP ? (unsigned long long)wall_clock64() : 0ull;
#define PG8_STAMP() do { if (STAMP && wid == 0 && nts < 64) { const unsigned long long _c = (unsigned long long)clock64(); \
        ts_lo = (lane == nts) ? (int)(unsigned)_c : ts_lo; ts_hi = (lane == nts) ? (int)(unsigned)(_c >> 32) : ts_hi; ++nts; } } while (0)
    PG8_STAMP();
    unsigned voffA[2], voffB[2];
#pragma unroll
    for (int i = 0; i < 2; ++i) { int R, C; stage_rc(tid * 16 + i * 8192, R, C); const int Rb = Epi::PERM ? ((R & ~31) + perm32(R & 31)) : R;
        voffA[i] = (unsigned)(R * K + C) * 2u; voffB[i] = (unsigned)(Rb * K + C) * 2u; }
    const size_t kstep = (size_t)(BK * 2);
    const size_t hstep = (size_t)HALF * K * 2;
    const size_t tstep = 2 * hstep;
    const unsigned ldsw = (unsigned)wid * 1024u;
    const int aoff = lds_byte(wr * 64 + fr, fq * 8), boff = lds_byte(wc * 32 + fr, fq * 8);
#define PG8_SA(b, h) (((b) * 2 + (h)) * HTB)
#define PG8_SB(b, h) ((4 + (b) * 2 + (h)) * HTB)
#define PG8_STAGE(bufoff, gbase, voff) do { _Pragma("unroll") for (int _i = 0; _i < 2; ++_i) \
        __builtin_amdgcn_global_load_lds((const unsigned*)((const char*)(gbase) + (voff)[_i]), (PG8_LAS unsigned*)(lds + (bufoff) + ldsw + _i * 8192), 16, 0, 0); } while (0)
#define PG8_LDA(dst, b, h) do { _Pragma("unroll") for (int m = 0; m < 4; ++m) _Pragma("unroll") for (int k = 0; k < 2; ++k) dst[m][k] = *(const PG8_LAS bf16x8*)(lds + PG8_SA(b, h) + aoff + m * 2048 + k * 1024); } while (0)
#define PG8_LDB(dst, b, h) do { _Pragma("unroll") for (int n = 0; n < 2; ++n) _Pragma("unroll") for (int k = 0; k < 2; ++k) dst[n][k] = *(const PG8_LAS bf16x8*)(lds + PG8_SB(b, h) + boff + n * 2048 + k * 1024); } while (0)
#define PG8_MMA(ai, bj, At, Bt) do { __builtin_amdgcn_s_setprio(1); _Pragma("unroll") for (int m = 0; m < 4; ++m) _Pragma("unroll") for (int n = 0; n < 2; ++n) _Pragma("unroll") for (int k = 0; k < 2; ++k) \
        acc[ai][bj][m][n] = __builtin_amdgcn_mfma_f32_16x16x32_bf16(Bt[n][k], At[m][k], acc[ai][bj][m][n], 0, 0, 0); __builtin_amdgcn_s_setprio(0); } while (0)
#define PG8_WAIT_V(n) asm volatile("s_waitcnt vmcnt(" #n ")" ::: "memory")
#define PG8_WAIT_L(n) asm volatile("s_waitcnt lgkmcnt(" #n ")" ::: "memory")
#define PG8_BAR __builtin_amdgcn_s_barrier()
#define PG8_SCHED __builtin_amdgcn_sched_barrier(0)
    Unit cur, nxt; int ui = 0;
    if (!S.next(0, cur)) return;
    f32x4 acc[2][2][4][2];
#pragma unroll
    for (int a = 0; a < 2; ++a)
#pragma unroll
        for (int b = 0; b < 2; ++b)
#pragma unroll
            for (int m = 0; m < 4; ++m)
#pragma unroll
                for (int n = 0; n < 2; ++n) acc[a][b][m][n] = (f32x4){0.f, 0.f, 0.f, 0.f};
    bf16x8 At[4][2], B0[2][2], B1[2][2];
    const char* cA = (const char*)g.A + (size_t)cur.pm * tstep; const char* cB = (const char*)g.Bt + (size_t)cur.pn * tstep;
    S.a_ready(cur);
    PG8_STAGE(PG8_SB(0, 0), cB, voffB); PG8_STAGE(PG8_SA(0, 0), cA, voffA); PG8_STAGE(PG8_SB(0, 1), cB + hstep, voffB); PG8_STAGE(PG8_SA(0, 1), cA + hstep, voffA);
    if (wr == 1) PG8_BAR;
    PG8_WAIT_V(4); PG8_BAR;
    PG8_STAGE(PG8_SB(1, 0), cB + kstep, voffB); PG8_STAGE(PG8_SA(1, 0), cA + kstep, voffA); PG8_STAGE(PG8_SB(1, 1), cB + hstep + kstep, voffB);
    PG8_WAIT_V(6); PG8_BAR;
    PG8_STAMP();
    for (;;) {
        const bool has_next = S.next(ui + 1, nxt);
        const char* nA = has_next ? (const char*)g.A + (size_t)nxt.pm * tstep : cA; const char* nB = has_next ? (const char*)g.Bt + (size_t)nxt.pn * tstep : cB;
        for (int t = 0; t < nt; t += 2) {
            const bool last = (t == nt - 2);
            const char* a1 = cA + (size_t)(t + 1) * kstep;
            const char* a2 = last ? nA : cA + (size_t)(t + 2) * kstep; const char* b2 = last ? nB : cB + (size_t)(t + 2) * kstep;
            const char* a3 = a2 + kstep; const char* b3 = b2 + kstep;
            if (last && has_next) S.a_ready(nxt);
            PG8_LDB(B0, 0, 0); PG8_SCHED; PG8_LDA(At, 0, 0); PG8_STAGE(PG8_SA(1, 1), a1 + hstep, voffA);
            PG8_WAIT_L(8); PG8_BAR; PG8_WAIT_L(0); PG8_MMA(0, 0, At, B0); PG8_BAR; PG8_SCHED;
            PG8_LDB(B1, 0, 1); PG8_STAGE(PG8_SB(0, 0), b2, voffB);
            PG8_BAR; PG8_WAIT_L(0); PG8_MMA(0, 1, At, B1); PG8_BAR;
            PG8_LDA(At, 0, 1); PG8_STAGE(PG8_SA(0, 0), a2, voffA);
            PG8_BAR; PG8_WAIT_L(0); PG8_MMA(1, 0, At, B0); PG8_BAR; PG8_SCHED;
            PG8_STAGE(PG8_SB(0, 1), b2 + hstep, voffB);
            PG8_WAIT_V(6); PG8_BAR; PG8_MMA(1, 1, At, B1); PG8_BAR;
            PG8_LDB(B0, 1, 0); PG8_SCHED; PG8_LDA(At, 1, 0); PG8_STAGE(PG8_SA(0, 1), a2 + hstep, voffA);
            PG8_WAIT_L(8); PG8_BAR; PG8_WAIT_L(0); PG8_MMA(0, 0, At, B0); PG8_BAR; PG8_SCHED;
            PG8_LDB(B1, 1, 1); PG8_STAGE(PG8_SB(1, 0), b3, voffB);
            PG8_BAR; PG8_WAIT_L(0); PG8_MMA(0, 1, At, B1); PG8_BAR;
            PG8_LDA(At, 1, 1); PG8_STAGE(PG8_SA(1, 0), a3, voffA);
            PG8_BAR; PG8_WAIT_L(0); PG8_MMA(1, 0, At, B0); PG8_BAR; PG8_SCHED;
            PG8_STAGE(PG8_SB(1, 1), b3 + hstep, voffB);
            PG8_WAIT_V(6); PG8_BAR; PG8_MMA(1, 1, At, B1); PG8_BAR;
        }
        PG8_STAMP();
        if constexpr (!Epi::AFTER_DRAIN) { E(acc, cur, wr, wc, fr, fq); S.done(cur); }
        PG8_STAMP();
        if (!has_next) break;
#pragma unroll
        for (int a = 0; a < 2; ++a)
#pragma unroll
            for (int b = 0; b < 2; ++b)
#pragma unroll
                for (int m = 0; m < 4; ++m)
#pragma unroll
                    for (int n = 0; n < 2; ++n) acc[a][b][m][n] = (f32x4){0.f, 0.f, 0.f, 0.f};
        cur = nxt; cA = nA; cB = nB; ++ui;
    }
    PG8_WAIT_V(0);
    if (wr == 0) PG8_BAR;
    PG8_BAR;
    if constexpr (Epi::AFTER_DRAIN) { E.fused(acc, cur, wr, wc, fr, fq, lds, wid, lane); S.done(cur); }
    PG8_STAMP();
    if (STAMP && wid == 0) { stamps[lane] = lane < nts ? (((unsigned long long)(unsigned)ts_hi << 32) | (unsigned)ts_lo) : 0ull;
        if (lane == 62) stamps[62] = rt_entry; if (lane == 63) stamps[63] = (unsigned long long)wall_clock64(); }
#undef PG8_STAMP
#undef PG8_SA
#undef PG8_SB
#undef PG8_STAGE
#undef PG8_LDA
#undef PG8_LDB
#undef PG8_MMA
#undef PG8_WAIT_V
#undef PG8_WAIT_L
#undef PG8_BAR
#undef PG8_SCHED
}
}
#define XB_TMO      128
#define XB_XCNT(j)  (256  + 64 * (j))
#define XB_XSUB(j)  (1280 + 64 * (j))
#define XB_XGEN(j)  (2304 + 64 * (j))
#define XB_TOP      3328
#define XB_TOPGEN   3392
#define XCD_BAR_WORDS 3456
#define XB_SPIN_CAP (1u << 18)
#define LAS __attribute__((address_space(3)))

__device__ __forceinline__ unsigned xb_ld(unsigned* p)              { return __hip_atomic_load(p, __ATOMIC_RELAXED, __HIP_MEMORY_SCOPE_AGENT); }
__device__ __forceinline__ unsigned xb_add(unsigned* p, unsigned v) { return __hip_atomic_fetch_add(p, v, __ATOMIC_RELAXED, __HIP_MEMORY_SCOPE_AGENT); }
__device__ __forceinline__ unsigned xb_xcc_id() { return (unsigned)__builtin_amdgcn_s_getreg((3 << 11) | 20) & 0xFu; }
#define XB_SPIN(cond, bar) do { unsigned _sp = 0; while (cond) { __builtin_amdgcn_s_sleep(1); \
    if ((++_sp & 255u) == 0u) { if (xb_ld(&(bar)[XB_TMO])) break; if (_sp > XB_SPIN_CAP) { atomicAdd(&(bar)[XB_TMO], 1u); break; } } } } while (0)

struct XcdBarrier {
    unsigned* bar; unsigned x;
    volatile LAS unsigned* st;
};

__device__ __forceinline__ XcdBarrier xcd_barrier_post(unsigned* bar, volatile LAS unsigned* st) {
    XcdBarrier b; b.bar = bar; b.x = xb_xcc_id(); b.st = st;
    if (threadIdx.x == 0) (void)xb_add(&bar[XB_XCNT(b.x)], 1u);
    return b;
}
__device__ __forceinline__ void xcd_barrier_complete(unsigned* bar, unsigned x, unsigned& nloc, unsigned& nx) {
    const unsigned G = gridDim.x * gridDim.y * gridDim.z;
    unsigned sum, cnt, mine, sp = 0u;
    for (;;) {
        sum = 0u; cnt = 0u; mine = 0u;
#pragma unroll
        for (unsigned j = 0; j < 16; ++j) { const unsigned c = xb_ld(&bar[XB_XCNT(j)]); sum += c; cnt += (c > 0u) ? 1u : 0u; mine = (j == x) ? c : mine; }
        if (sum == G) break;
        __builtin_amdgcn_s_sleep(1);
        if ((++sp & 255u) == 0u) { if (xb_ld(&bar[XB_TMO])) break; if (sp > XB_SPIN_CAP) { atomicAdd(&bar[XB_TMO], 1u); break; } }
    }
    nloc = mine > 0u ? mine : 1u; nx = cnt > 0u ? cnt : 1u;
}

__device__ __forceinline__ void xcd_barrier(const XcdBarrier& b) {
    asm volatile("s_waitcnt vmcnt(0)" ::: "memory");
    __syncthreads();
    if (threadIdx.x == 0) {
        unsigned* bar = b.bar;
        __builtin_amdgcn_s_waitcnt(0);
        unsigned nloc = b.st[0], nx = b.st[1];
        if (nloc == 0u) { xcd_barrier_complete(bar, b.x, nloc, nx); b.st[0] = nloc; b.st[1] = nx; }
        const unsigned old = xb_add(&bar[XB_XSUB(b.x)], 1u);
        const unsigned gen = old / nloc;
        if (old + 1u == (gen + 1u) * nloc) {
            __builtin_amdgcn_fence(__ATOMIC_RELEASE, "agent");
            asm volatile("s_waitcnt vmcnt(0)" ::: "memory");
            const unsigned og = xb_add(&bar[XB_TOP], 1u);
            const unsigned tg = og / nx;
            if (og + 1u == (tg + 1u) * nx) xb_add(&bar[XB_TOPGEN], 1u);
            else XB_SPIN(xb_ld(&bar[XB_TOPGEN]) == tg, bar);
            __builtin_amdgcn_fence(__ATOMIC_ACQUIRE, "agent");
            xb_add(&bar[XB_XGEN(b.x)], 1u);
            asm volatile("s_waitcnt vmcnt(0)" ::: "memory");
        } else {
            XB_SPIN(xb_ld(&bar[XB_XGEN(b.x)]) == gen, bar);
            __builtin_amdgcn_fence(__ATOMIC_ACQUIRE, "agent");
            asm volatile("s_waitcnt vmcnt(0)" ::: "memory");
        }
    }
    __syncthreads();
}

namespace mk {
using pg8::bf16_t; using pg8::bf16x8; using pg8::f32x4; using pg8::u32x4;
typedef unsigned u32x2 __attribute__((ext_vector_type(2)));
typedef short s16x4 __attribute__((ext_vector_type(4)));
#define DI __device__ __forceinline__
#define LDS_WAIT() asm volatile("s_waitcnt lgkmcnt(0)" ::: "memory")
#define LDS_FENCE() asm volatile("" ::: "memory")
#define MFMA16(a, b, c) __builtin_amdgcn_mfma_f32_16x16x32_bf16((a), (b), (c), 0, 0, 0)

constexpr int T = 32768, SEQ = 4096, NLAYER = 4, NPH = 16;
constexpr int PW = 5120;
constexpr int C_AB = 0, C_AC = 512, C_AX = 1024, C_NQ = 1536, C_NKV = 2048, C_UV = 2816, C_DQ = 3840, C_DK = 4352, C_DV = 4416,
              C_DQI = 4480, C_DKI = 4992, C_NG = 5056, C_DWI = 5080;
constexpr size_t MiB = 1u << 20;
constexpr size_t WS_CTL = 0, WS_PEB = 1 * MiB, WS_CMPK = 2 * MiB, WS_CMPV = 3 * MiB, WS_SK = 4 * MiB, WS_SGUW = 5 * MiB, WS_CMPA = 8 * MiB,
                 WS_CMPP = 24 * MiB, WS_WCAT = 40 * MiB, WS_WBR = 58 * MiB, WS_WOUT4 = 62 * MiB, WS_WQ = 70 * MiB, WS_WPG = 72 * MiB,
                 WS_WPP = 74 * MiB, WS_W1C = 75 * MiB, WS_PB = 78 * MiB, WS_PTU = 96 * MiB, WS_PTV = 128 * MiB, WS_H = 160 * MiB,
                 WS_Y = 224 * MiB, WS_PROJ = 352 * MiB, WS_GATES = 672 * MiB,
                 WS_KS = 928 * MiB, WS_VS = 936 * MiB, WS_KW = 944 * MiB, WS_VW = 952 * MiB, WS_DK = 960 * MiB, WS_DV = 964 * MiB, WS_DKI = 968 * MiB, WS_END = 972 * MiB;
constexpr size_t WS_ACCF = WS_PROJ, WS_MERGED = WS_PROJ + 128 * MiB, WS_QP = WS_PROJ, WS_PP = WS_PROJ + 64 * MiB, WS_EIDX = WS_PROJ + 128 * MiB, WS_EW = WS_PROJ + 144 * MiB, WS_EU = WS_PROJ + 160 * MiB;
constexpr size_t WS_COEF = WS_PROJ + 176 * MiB, WS_H8 = WS_PROJ + 192 * MiB, WS_HSI = WS_PROJ + 224 * MiB, WS_SSQ = WS_PROJ + 225 * MiB, WS_PD = WS_GATES, PT_SLICE = 2 * MiB;
constexpr int LDS_BYTES = 163840, LDS_PERWAVE = 19456, LDS_BUCK = 8 * LDS_PERWAVE, LDS_TBL = LDS_BUCK + 4096, LDS_XB = LDS_BYTES - 64;

struct Params { const float* in[27]; float* out; unsigned char* ws; int ph_lo, ph_hi; };
enum { I_X = 0, I_P, I_REL, I_GMIX, I_WIN, I_CONVW, I_PE, I_CW1, I_CW2, I_NQG, I_NKG, I_LNG, I_SGUW, I_SGUB, I_DQG, I_DKG, I_WGATE, I_WBR, I_WOUT,
       I_GFFN, I_WQ, I_SUBK, I_PU, I_PV, I_GPLE, I_WPG, I_WPP };

struct Frame { LAS unsigned char* lds; int tid, lane, wave, vb, G; };

DI float bf2f(unsigned short b) { return __uint_as_float(((unsigned)b) << 16); }
DI unsigned f2bf(float f) { unsigned u = __float_as_uint(f); return (u + 0x7fffu + ((u >> 16) & 1u)) >> 16; }
DI unsigned pk2(float lo, float hi) { return pg8::cvt_pk_bf16(lo, hi); }
DI float lo16(unsigned w) { return __uint_as_float(w << 16); }
DI float hi16(unsigned w) { return __uint_as_float(w & 0xffff0000u); }
DI float sigm(float x) { return __builtin_amdgcn_rcpf(1.f + __builtin_amdgcn_exp2f(-1.44269504f * x)); }
DI float gelu_t(float x) { const float y = (-2.f * 0.7978845608f * 1.44269504f) * (x + 0.044715f * x * x * x); return x * __builtin_amdgcn_rcpf(1.f + __builtin_amdgcn_exp2f(y)); }
#define DPP_I(x, ctrl) __builtin_amdgcn_update_dpp(0, (x), (ctrl), 0xF, 0xF, false)
DI float dppf(float x, int) { return x; }
DI float row16_sumf(float v) { v += __builtin_bit_cast(float, DPP_I(__builtin_bit_cast(int, v), 0xB1)); v += __builtin_bit_cast(float, DPP_I(__builtin_bit_cast(int, v), 0x4E));
    v += __builtin_bit_cast(float, DPP_I(__builtin_bit_cast(int, v), 0x141)); v += __builtin_bit_cast(float, DPP_I(__builtin_bit_cast(int, v), 0x140)); return v; }
DI float row16_maxf(float v) { v = fmaxf(v, __builtin_bit_cast(float, DPP_I(__builtin_bit_cast(int, v), 0xB1))); v = fmaxf(v, __builtin_bit_cast(float, DPP_I(__builtin_bit_cast(int, v), 0x4E)));
    v = fmaxf(v, __builtin_bit_cast(float, DPP_I(__builtin_bit_cast(int, v), 0x141))); v = fmaxf(v, __builtin_bit_cast(float, DPP_I(__builtin_bit_cast(int, v), 0x140))); return v; }
DI float quad_sumf(float v) { v += __builtin_bit_cast(float, DPP_I(__builtin_bit_cast(int, v), 0xB1)); v += __builtin_bit_cast(float, DPP_I(__builtin_bit_cast(int, v), 0x4E)); return v; }
DI float oct_sumf(float v) { v = quad_sumf(v); v += __builtin_bit_cast(float, DPP_I(__builtin_bit_cast(int, v), 0x141)); return v; }
DI float x16_sum(float v) { const unsigned u = __float_as_uint(v); const auto r = __builtin_amdgcn_permlane16_swap(u, u, false, false); return __uint_as_float(r[0]) + __uint_as_float(r[1]); }
DI float x32_sum(float v) { const unsigned u = __float_as_uint(v); const auto r = __builtin_amdgcn_permlane32_swap(u, u, false, false); return __uint_as_float(r[0]) + __uint_as_float(r[1]); }
DI float x16_max(float v) { const unsigned u = __float_as_uint(v); const auto r = __builtin_amdgcn_permlane16_swap(u, u, false, false); return fmaxf(__uint_as_float(r[0]), __uint_as_float(r[1])); }
DI float x32_max(float v) { const unsigned u = __float_as_uint(v); const auto r = __builtin_amdgcn_permlane32_swap(u, u, false, false); return fmaxf(__uint_as_float(r[0]), __uint_as_float(r[1])); }
DI unsigned wave_sum_u(unsigned v) { v += (unsigned)DPP_I((int)v, 0xB1); v += (unsigned)DPP_I((int)v, 0x4E); v += (unsigned)DPP_I((int)v, 0x141); v += (unsigned)DPP_I((int)v, 0x140);
    { const auto r = __builtin_amdgcn_permlane16_swap(v, v, false, false); v = r[0] + r[1]; } { const auto r = __builtin_amdgcn_permlane32_swap(v, v, false, false); v = r[0] + r[1]; } return v; }
DI float wave_sum(float v) { return x32_sum(x16_sum(row16_sumf(v))); }
DI float wave_max(float v) { return x32_max(x16_max(row16_maxf(v))); }
DI unsigned ordf(float f) { const unsigned u = __float_as_uint(f); return (u & 0x80000000u) ? ~u : (u | 0x80000000u); }
DI float unordf(unsigned x) { return __uint_as_float((x & 0x80000000u) ? (x & 0x7fffffffu) : ~x); }
DI int bucket_of(int n) {
    if (n < 16) return n;
    int b = 16;
    b += (n >= 21); b += (n >= 27); b += (n >= 35); b += (n >= 46); b += (n >= 59); b += (n >= 77); b += (n >= 99); b += (n >= 128);
    b += (n >= 166); b += (n >= 216); b += (n >= 280); b += (n >= 363); b += (n >= 470); b += (n >= 609); b += (n >= 790);
    return b; }

DI int srccol(int n) { return n < 2816 ? n : (n < 5056 ? n + 24 : (n < 5080 ? n - 2240 : (n < 5088 ? n : -1))); }
DI void tr_item(const float* W, int ldw, bf16_t* WT, int ldwt, int k0, int n0, LAS float* scr, int lane, bool remap, int ncopy, int cstride) {
    float tv[32];
#pragma unroll
    for (int i = 0; i < 32; ++i) { const int kk = 2 * i + (lane >> 5), nl = lane & 31; const int n = n0 + nl; const int src = remap ? srccol(n) : n; tv[i] = src >= 0 ? W[(size_t)(k0 + kk) * ldw + src] : 0.f; }
#pragma unroll
    for (int i = 0; i < 32; ++i) { const int kk = 2 * i + (lane >> 5), nl = lane & 31; scr[kk * 33 + nl] = tv[i]; }
    LDS_WAIT();
    const int c = lane & 7;
#pragma unroll
    for (int j = 0; j < 4; ++j) { const int n = (lane >> 3) + 8 * j; const LAS float* s = scr + (8 * c) * 33 + n;
        u32x4 o; o.x = pk2(s[0], s[33]); o.y = pk2(s[66], s[99]); o.z = pk2(s[132], s[165]); o.w = pk2(s[198], s[231]);
        for (int cp = 0; cp < ncopy; ++cp) *(u32x4*)(WT + (size_t)(n0 + n) * ldwt + (size_t)cp * cstride + k0 + 8 * c) = o; }
    LDS_WAIT();
}
DI void cvt_rows(const float* src, bf16_t* dst, size_t ngroups8, int gw, int NGW, int lane) {
    const size_t st = (size_t)NGW * 64;
    for (size_t i0 = (size_t)gw * 64 + lane; i0 < ngroups8; i0 += 4 * st) {
        f32x4 a[4], b[4];
#pragma unroll
        for (int r = 0; r < 4; ++r) { const size_t i = i0 + r * st < ngroups8 ? i0 + r * st : i0; a[r] = ((const f32x4*)src)[2 * i]; b[r] = ((const f32x4*)src)[2 * i + 1]; }
#pragma unroll
        for (int r = 0; r < 4; ++r) { const size_t i = i0 + r * st; if (i >= ngroups8) break;
            u32x4 o; o.x = pk2(a[r].x, a[r].y); o.y = pk2(a[r].z, a[r].w); o.z = pk2(b[r].x, b[r].y); o.w = pk2(b[r].z, b[r].w); ((u32x4*)dst)[i] = o; }
    }
}
DI int pk4_fp8(float a, float b, float c, float d) { int w = 0; w = __builtin_amdgcn_cvt_pk_fp8_f32(a, b, w, false); w = __builtin_amdgcn_cvt_pk_fp8_f32(c, d, w, true); return w; }
DI void cvt_rows_fp8(const float* src, unsigned char* dst, float* scl, int nrows, int gw, int NGW, int lane) {
    for (int r0 = gw; r0 < nrows; r0 += 4 * NGW) {
        f32x4 a[4], b[4], c[4], d[4];
#pragma unroll
        for (int k = 0; k < 4; ++k) { const int r = r0 + k * NGW < nrows ? r0 + k * NGW : r0; const float* s = src + (size_t)r * 1024 + lane * 16;
            a[k] = *(const f32x4*)s; b[k] = *(const f32x4*)(s + 4); c[k] = *(const f32x4*)(s + 8); d[k] = *(const f32x4*)(s + 12); }
#pragma unroll
        for (int k = 0; k < 4; ++k) { const int r = r0 + k * NGW; if (r >= nrows) break;
            float mx = fmaxf(fmaxf(fmaxf(fabsf(a[k].x), fabsf(a[k].y)), fmaxf(fabsf(a[k].z), fabsf(a[k].w))), fmaxf(fmaxf(fabsf(b[k].x), fabsf(b[k].y)), fmaxf(fabsf(b[k].z), fabsf(b[k].w))));
            mx = fmaxf(mx, fmaxf(fmaxf(fmaxf(fabsf(c[k].x), fabsf(c[k].y)), fmaxf(fabsf(c[k].z), fabsf(c[k].w))), fmaxf(fmaxf(fabsf(d[k].x), fabsf(d[k].y)), fmaxf(fabsf(d[k].z), fabsf(d[k].w)))));
            mx = wave_max(mx);
            const float sc = mx > 0.f ? mx * (1.f / 448.f) : 1.f, inv = 1.f / sc;
            u32x4 o; o.x = (unsigned)pk4_fp8(a[k].x * inv, a[k].y * inv, a[k].z * inv, a[k].w * inv); o.y = (unsigned)pk4_fp8(b[k].x * inv, b[k].y * inv, b[k].z * inv, b[k].w * inv);
            o.z = (unsigned)pk4_fp8(c[k].x * inv, c[k].y * inv, c[k].z * inv, c[k].w * inv); o.w = (unsigned)pk4_fp8(d[k].x * inv, d[k].y * inv, d[k].z * inv, d[k].w * inv);
            *(u32x4*)(dst + (size_t)(lane >> 3) * PT_SLICE + (size_t)r * 128 + (lane & 7) * 16) = o;
            if (lane == 0) scl[r] = sc; }
    }
}
DI void rmsnorm_rows(const float* x, const float* g, bf16_t* H, int gw, int NGW, int lane, unsigned char* H8 = nullptr, float* HSI = nullptr) {
    const f32x4 g0 = *(const f32x4*)(g + lane * 8), g1 = *(const f32x4*)(g + lane * 8 + 4), g2 = *(const f32x4*)(g + 512 + lane * 8), g3 = *(const f32x4*)(g + 512 + lane * 8 + 4);
    for (int m0 = gw; m0 < T; m0 += 4 * NGW) {
        f32x4 a[4], b[4], c[4], d[4];
#pragma unroll
        for (int r = 0; r < 4; ++r) { const int m = m0 + r * NGW < T ? m0 + r * NGW : m0; const float* xr = x + (size_t)m * 1024 + lane * 8;
            a[r] = *(const f32x4*)xr; b[r] = *(const f32x4*)(xr + 4); c[r] = *(const f32x4*)(xr + 512); d[r] = *(const f32x4*)(xr + 516); }
#pragma unroll
        for (int r = 0; r < 4; ++r) { const int m = m0 + r * NGW; if (m >= T) break;
            float ss = a[r].x * a[r].x + a[r].y * a[r].y + a[r].z * a[r].z + a[r].w * a[r].w + b[r].x * b[r].x + b[r].y * b[r].y + b[r].z * b[r].z + b[r].w * b[r].w
                     + c[r].x * c[r].x + c[r].y * c[r].y + c[r].z * c[r].z + c[r].w * c[r].w + d[r].x * d[r].x + d[r].y * d[r].y + d[r].z * d[r].z + d[r].w * d[r].w;
            ss = wave_sum(ss);
            const float rr = rsqrtf(ss * (1.f / 1024.f) + 1e-6f);
            u32x4 o0, o1;
            o0.x = pk2(a[r].x * rr * g0.x, a[r].y * rr * g0.y); o0.y = pk2(a[r].z * rr * g0.z, a[r].w * rr * g0.w); o0.z = pk2(b[r].x * rr * g1.x, b[r].y * rr * g1.y); o0.w = pk2(b[r].z * rr * g1.z, b[r].w * rr * g1.w);
            o1.x = pk2(c[r].x * rr * g2.x, c[r].y * rr * g2.y); o1.y = pk2(c[r].z * rr * g2.z, c[r].w * rr * g2.w); o1.z = pk2(d[r].x * rr * g3.x, d[r].y * rr * g3.y); o1.w = pk2(d[r].z * rr * g3.z, d[r].w * rr * g3.w);
            bf16_t* hr = H + (size_t)m * 1024 + lane * 8; *(u32x4*)hr = o0; *(u32x4*)(hr + 512) = o1;
            if (H8) {
                float v[16] = {a[r].x * rr * g0.x, a[r].y * rr * g0.y, a[r].z * rr * g0.z, a[r].w * rr * g0.w, b[r].x * rr * g1.x, b[r].y * rr * g1.y, b[r].z * rr * g1.z, b[r].w * rr * g1.w,
                               c[r].x * rr * g2.x, c[r].y * rr * g2.y, c[r].z * rr * g2.z, c[r].w * rr * g2.w, d[r].x * rr * g3.x, d[r].y * rr * g3.y, d[r].z * rr * g3.z, d[r].w * rr * g3.w};
                float am = 0.f;
#pragma unroll
                for (int e = 0; e < 16; ++e) am = fmaxf(am, fabsf(v[e]));
                am = wave_max(am);
                const float hs = am > 0.f ? 224.f / am : 1.f;
                u32x2 q0, q1; q0.x = (unsigned)pk4_fp8(v[0] * hs, v[1] * hs, v[2] * hs, v[3] * hs); q0.y = (unsigned)pk4_fp8(v[4] * hs, v[5] * hs, v[6] * hs, v[7] * hs);
                q1.x = (unsigned)pk4_fp8(v[8] * hs, v[9] * hs, v[10] * hs, v[11] * hs); q1.y = (unsigned)pk4_fp8(v[12] * hs, v[13] * hs, v[14] * hs, v[15] * hs);
                unsigned char* h8 = H8 + (size_t)m * 1024 + lane * 8; *(u32x2*)h8 = q0; *(u32x2*)(h8 + 512) = q1;
                if (lane == 0) HSI[m] = 1.f / hs; } }
    }
}
DI void phase_prep_w(const Params& p, int l, const Frame& F) {
    LAS float* scr = (LAS float*)(F.lds + F.wave * 8448);
    const int gw = F.vb * 8 + F.wave, NGW = F.G * 8, lane = F.lane;
    unsigned char* ws = p.ws;
    bf16_t* WCAT = (bf16_t*)(ws + WS_WCAT); bf16_t* WBR = (bf16_t*)(ws + WS_WBR); bf16_t* WOUT4 = (bf16_t*)(ws + WS_WOUT4); bf16_t* WQ = (bf16_t*)(ws + WS_WQ);
    bf16_t* WPG = (bf16_t*)(ws + WS_WPG); bf16_t* WPP = (bf16_t*)(ws + WS_WPP); bf16_t* W1C = (bf16_t*)(ws + WS_W1C);
    constexpr int I0 = 2560, I1 = 2048, I2 = 1024, I3 = 512, I4 = 512, I5 = 512, I6 = 128, I7 = 512, NIT = I0 + I1 + I2 + I3 + I4 + I5 + I6 + I7;
    for (int it = gw; it < NIT; it += NGW) {
        int r = it;
        if (r < I0) { tr_item(p.in[I_WIN] + (size_t)l * 1024 * 5088, 5088, WCAT, 1024, (r / 160) * 64, (r % 160) * 32, scr, lane, true, 1, 0); continue; } r -= I0;
        if (r < I1) { tr_item(p.in[I_WGATE] + (size_t)l * 1024 * 4096, 4096, WCAT + (size_t)5120 * 1024, 1024, (r / 128) * 64, (r % 128) * 32, scr, lane, false, 1, 0); continue; } r -= I1;
        if (r < I2) { const int m = r >> 8, rr = r & 255; tr_item(p.in[I_WBR] + ((size_t)l * 2048 + m * 512) * 1024, 1024, WBR + (size_t)m * 1024 * 512, 512, (rr / 32) * 64, (rr % 32) * 32, scr, lane, false, 1, 0); continue; } r -= I2;
        if (r < I3) { tr_item(p.in[I_WOUT] + (size_t)l * 1024 * 1024, 1024, WOUT4, 1024, (r / 32) * 64, (r % 32) * 32, scr, lane, false, 1, 0); continue; } r -= I3;
        if (r < I4) { tr_item(p.in[I_WQ] + (size_t)l * 1024 * 1024, 1024, WQ, 1024, (r / 32) * 64, (r % 32) * 32, scr, lane, false, 1, 0); continue; } r -= I4;
        if (r < I5) { tr_item(p.in[I_WPG] + (size_t)l * 1024 * 1024, 1024, WPG, 1024, (r / 32) * 64, (r % 32) * 32, scr, lane, false, 1, 0); continue; } r -= I5;
        if (r < I6) { tr_item(p.in[I_WPP] + (size_t)l * 256 * 1024, 1024, WPP, 256, (r / 32) * 64, (r % 32) * 32, scr, lane, false, 1, 0); continue; } r -= I6;
        { const int jh = r >> 7, rr = r & 127, j = jh >> 1, half = jh & 1;
          tr_item(p.in[I_CW1] + (((size_t)l * 2 + j) * 2048 + half * 1024) * 256, 256, W1C + ((size_t)j * 512 + half * 256) * 1024, 1024, (rr / 8) * 64, (rr % 8) * 32, scr, lane, false, 1, 0); }
    }
    cvt_rows_fp8(p.in[I_PU] + (size_t)l * 16384 * 1024, ws + WS_PTU, (float*)(ws + WS_PTV), 16384, gw, NGW, lane);
    cvt_rows_fp8(p.in[I_PV] + (size_t)l * 16384 * 1024, ws + WS_PTU + 16 * MiB, (float*)(ws + WS_PTV) + 16384, 16384, gw, NGW, lane);
    cvt_rows(p.in[I_SUBK] + (size_t)l * 131072, (bf16_t*)(ws + WS_SK), 131072 / 8, gw, NGW, lane);
    cvt_rows(p.in[I_P] + (size_t)l * T * 256, (bf16_t*)(ws + WS_PB), (size_t)T * 256 / 8, gw, NGW, lane);
    { const float* sw = p.in[I_SGUW] + (size_t)l * 131072; bf16_t* dst = (bf16_t*)(ws + WS_SGUW);
      for (int i = gw * 64 + lane; i < 131072 / 8; i += NGW * 64) { const int e = i * 8, t = (e >> 7) & 127, s0 = e & 127; float v[8];
#pragma unroll
          for (int k = 0; k < 8; ++k) v[k] = (s0 + k <= t) ? sw[e + k] : 0.f;
          u32x4 o; o.x = pk2(v[0], v[1]); o.y = pk2(v[2], v[3]); o.z = pk2(v[4], v[5]); o.w = pk2(v[6], v[7]); ((u32x4*)dst)[i] = o; } }
    { float* peb = (float*)(ws + WS_PEB);
      for (int o = gw; o < 512; o += NGW) { const int j = o >> 8, n = o & 255; const float* pe = p.in[I_PE] + ((size_t)l * 2 + j) * 2048; const float* w1 = p.in[I_CW1] + ((size_t)l * 2 + j) * 2048 * 256;
          float s = 0.f; for (int k = lane; k < 2048; k += 64) s += pe[k] * w1[(size_t)k * 256 + n];
          s = wave_sum(s); if (lane == 0) peb[o] = s; } }
    rmsnorm_rows(l == 0 ? p.in[I_X] : p.out, p.in[I_GMIX] + l * 1024, (bf16_t*)(ws + WS_H), gw, NGW, lane);
}

struct Epi1 {
    static constexpr bool PERM = true, AFTER_DRAIN = false;
    bf16_t* proj; bf16_t* gates;
    DI void operator()(const f32x4 (&acc)[2][2][4][2], const pg8::Unit& u, int wr, int wc, int fr, int fq) const {
        const int row0 = u.pm * 256 + wr * 64 + fr; const bool isg = u.pn >= 20;
        const int col0 = (isg ? (u.pn - 20) * 256 : u.pn * 256) + wc * 32 + 8 * fq; bf16_t* base = isg ? gates : proj; const int ldc = isg ? 4096 : PW;
#pragma unroll
        for (int ai = 0; ai < 2; ++ai)
#pragma unroll
            for (int m = 0; m < 4; ++m) { bf16_t* rowp = base + (size_t)(row0 + ai * 128 + m * 16) * ldc + col0;
#pragma unroll
                for (int bj = 0; bj < 2; ++bj) { f32x4 v0 = acc[ai][bj][m][0], v1 = acc[ai][bj][m][1];
                    if (isg) { v0.x = sigm(v0.x); v0.y = sigm(v0.y); v0.z = sigm(v0.z); v0.w = sigm(v0.w); v1.x = sigm(v1.x); v1.y = sigm(v1.y); v1.z = sigm(v1.z); v1.w = sigm(v1.w); }
                    u32x4 w; w.x = pk2(v0.x, v0.y); w.y = pk2(v0.z, v0.w); w.z = pk2(v1.x, v1.y); w.w = pk2(v1.z, v1.w);
                    __builtin_nontemporal_store(w, (u32x4*)(rowp + bj * 128)); } }
    }
};
struct EpiBf {
    static constexpr bool PERM = true, AFTER_DRAIN = false;
    bf16_t* O; int ldc;
    DI void operator()(const f32x4 (&acc)[2][2][4][2], const pg8::Unit& u, int wr, int wc, int fr, int fq) const {
        const int row0 = u.pm * 256 + wr * 64 + fr, col0 = u.pn * 256 + wc * 32 + 8 * fq;
#pragma unroll
        for (int ai = 0; ai < 2; ++ai)
#pragma unroll
            for (int m = 0; m < 4; ++m) { bf16_t* rowp = O + (size_t)(row0 + ai * 128 + m * 16) * ldc + col0;
#pragma unroll
                for (int bj = 0; bj < 2; ++bj) { const f32x4 v0 = acc[ai][bj][m][0], v1 = acc[ai][bj][m][1];
                    u32x4 w; w.x = pk2(v0.x, v0.y); w.y = pk2(v0.z, v0.w); w.z = pk2(v1.x, v1.y); w.w = pk2(v1.z, v1.w);
                    *(u32x4*)(rowp + bj * 128) = w; } }
    }
};
struct EpiF32P {
    static constexpr bool PERM = true, AFTER_DRAIN = false;
    float* C; int ldc;
    DI void operator()(const f32x4 (&acc)[2][2][4][2], const pg8::Unit& u, int wr, int wc, int fr, int fq) const {
        const int row0 = u.pm * 256 + wr * 64 + fr, col0 = u.pn * 256 + wc * 32 + 8 * fq;
#pragma unroll
        for (int ai = 0; ai < 2; ++ai)
#pragma unroll
            for (int m = 0; m < 4; ++m) { float* rowp = C + (size_t)(row0 + ai * 128 + m * 16) * ldc + col0;
#pragma unroll
                for (int bj = 0; bj < 2; ++bj) { *(f32x4*)(rowp + bj * 128) = acc[ai][bj][m][0]; *(f32x4*)(rowp + bj * 128 + 4) = acc[ai][bj][m][1]; } }
    }
};
struct XcdColOrder {
    int G, c;
    DI bool next(int i, pg8::Unit& u) const {
        if (G != 256) { const int Lx = i * G + c; if (Lx >= 128 * 36) return false; u.pm = Lx / 36; u.pn = Lx % 36; return true; }
        if (i >= 18) return false;
        const int x = c & 7, w = c >> 3;
        if (i < 16) { u.pm = 8 * i + (w & 7); u.pn = 4 * x + (w >> 3); }
        else { u.pm = 16 * x + 8 * (i - 16) + (w & 7); u.pn = 32 + (w >> 3); }
        return true; }
    DI void a_ready(const pg8::Unit&) const {}
    DI void done(const pg8::Unit&) const {}
};
struct RoundOrder {
    pg8::StaticOrder base; int r;
    DI bool next(int i, pg8::Unit& u) const { return i == 0 && base.next(r, u); }
    DI void a_ready(const pg8::Unit&) const {}
    DI void done(const pg8::Unit&) const {}
};
struct ColRangeOrder {
    int G, c, c0, c1;
    DI bool next(int i, pg8::Unit& u) const { const int nc = c1 - c0; const int Lx = i * G + c; if (Lx >= 128 * nc) return false; u.pm = Lx / nc; u.pn = c0 + Lx % nc; return true; }
    DI void a_ready(const pg8::Unit&) const {}
    DI void done(const pg8::Unit&) const {}
};
struct BranchOrder {
    int G, c;
    DI bool next(int i, pg8::Unit& u) const { const int tile = c + G * (i >> 2), m = i & 3; if (tile >= 512) return false; u.pm = m * 128 + (tile >> 2); u.pn = m * 4 + (tile & 3); return true; }
    DI void a_ready(const pg8::Unit&) const {}
    DI void done(const pg8::Unit&) const {}
};
struct EpiBranch {
    static constexpr bool PERM = true, AFTER_DRAIN = false;
    const bf16_t* gates; bf16_t* merged;
    DI void operator()(const f32x4 (&acc)[2][2][4][2], const pg8::Unit& u, int wr, int wc, int fr, int fq) const {
        const int m4 = u.pn >> 2; const int row0 = (u.pm & 127) * 256 + wr * 64 + fr, gcol0 = u.pn * 256 + wc * 32 + 8 * fq, dcol0 = (u.pn & 3) * 256 + wc * 32 + 8 * fq;
#pragma unroll
        for (int ai = 0; ai < 2; ++ai) {
            u32x4 g[4][2], pr[4][2];
#pragma unroll
            for (int m = 0; m < 4; ++m)
#pragma unroll
                for (int bj = 0; bj < 2; ++bj) { g[m][bj] = *(const u32x4*)(gates + (size_t)(row0 + ai * 128 + m * 16) * 4096 + gcol0 + bj * 128);
                    if (m4 > 0) pr[m][bj] = *(const u32x4*)(merged + (size_t)(row0 + ai * 128 + m * 16) * 1024 + dcol0 + bj * 128); }
#pragma unroll
            for (int m = 0; m < 4; ++m)
#pragma unroll
                for (int bj = 0; bj < 2; ++bj) { const f32x4 v0 = acc[ai][bj][m][0], v1 = acc[ai][bj][m][1]; const u32x4 gg = g[m][bj];
                    f32x4 r0 = {v0.x * lo16(gg.x), v0.y * hi16(gg.x), v0.z * lo16(gg.y), v0.w * hi16(gg.y)}, r1 = {v1.x * lo16(gg.z), v1.y * hi16(gg.z), v1.z * lo16(gg.w), v1.w * hi16(gg.w)};
                    if (m4 > 0) { const u32x4 pp_ = pr[m][bj];
                        r0.x += lo16(pp_.x); r0.y += hi16(pp_.x); r0.z += lo16(pp_.y); r0.w += hi16(pp_.y); r1.x += lo16(pp_.z); r1.y += hi16(pp_.z); r1.z += lo16(pp_.w); r1.w += hi16(pp_.w); }
                    u32x4 w; w.x = pk2(r0.x, r0.y); w.y = pk2(r0.z, r0.w); w.z = pk2(r1.x, r1.y); w.w = pk2(r1.z, r1.w);
                    *(u32x4*)(merged + (size_t)(row0 + ai * 128 + m * 16) * 1024 + dcol0 + bj * 128) = w; }
        }
    }
};
struct EpiRes {
    static constexpr bool PERM = true, AFTER_DRAIN = false;
    const float* xin; float* out;
    DI void operator()(const f32x4 (&acc)[2][2][4][2], const pg8::Unit& u, int wr, int wc, int fr, int fq) const {
        const int row0 = u.pm * 256 + wr * 64 + fr, col0 = u.pn * 256 + wc * 32 + 8 * fq;
#pragma unroll
        for (int ai = 0; ai < 2; ++ai)
#pragma unroll
            for (int mh = 0; mh < 2; ++mh) {
                f32x4 xa[2][2][2];
#pragma unroll
                for (int m2 = 0; m2 < 2; ++m2)
#pragma unroll
                    for (int bj = 0; bj < 2; ++bj) { const size_t off = (size_t)(row0 + ai * 128 + (mh * 2 + m2) * 16) * 1024 + col0 + bj * 128; xa[m2][bj][0] = *(const f32x4*)(xin + off); xa[m2][bj][1] = *(const f32x4*)(xin + off + 4); }
#pragma unroll
                for (int m2 = 0; m2 < 2; ++m2)
#pragma unroll
                    for (int bj = 0; bj < 2; ++bj) { const size_t off = (size_t)(row0 + ai * 128 + (mh * 2 + m2) * 16) * 1024 + col0 + bj * 128;
                        *(f32x4*)(out + off) = xa[m2][bj][0] + acc[ai][bj][mh * 2 + m2][0]; *(f32x4*)(out + off + 4) = xa[m2][bj][1] + acc[ai][bj][mh * 2 + m2][1]; }
            }
    }
};
struct EpiPle {
    static constexpr bool PERM = true, AFTER_DRAIN = false;
    float* x; const bf16_t* pp; const float* ssq;
    DI void operator()(const f32x4 (&acc)[2][2][4][2], const pg8::Unit& u, int wr, int wc, int fr, int fq) const {
        const int row0 = u.pm * 256 + wr * 64 + fr, col0 = u.pn * 256 + wc * 32 + 8 * fq;
#pragma unroll
        for (int ai = 0; ai < 2; ++ai)
#pragma unroll
            for (int mh = 0; mh < 2; ++mh) {
                f32x4 xa[2][2][2]; u32x4 ga[2][2]; f32x4 sq[2][2];
#pragma unroll
                for (int m2 = 0; m2 < 2; ++m2) { const float* sp = ssq + (size_t)(row0 + ai * 128 + (mh * 2 + m2) * 16) * 8; sq[m2][0] = *(const f32x4*)sp; sq[m2][1] = *(const f32x4*)(sp + 4);
#pragma unroll
                    for (int bj = 0; bj < 2; ++bj) { const size_t off = (size_t)(row0 + ai * 128 + (mh * 2 + m2) * 16) * 1024 + col0 + bj * 128;
                        xa[m2][bj][0] = *(const f32x4*)(x + off); xa[m2][bj][1] = *(const f32x4*)(x + off + 4); ga[m2][bj] = *(const u32x4*)(pp + off); } }
#pragma unroll
                for (int m2 = 0; m2 < 2; ++m2) {
                    const float rr = rsqrtf((((sq[m2][0].x + sq[m2][0].y) + (sq[m2][0].z + sq[m2][0].w)) + ((sq[m2][1].x + sq[m2][1].y) + (sq[m2][1].z + sq[m2][1].w))) * (1.f / 1024.f) + 1e-6f);
#pragma unroll
                    for (int bj = 0; bj < 2; ++bj) { const size_t off = (size_t)(row0 + ai * 128 + (mh * 2 + m2) * 16) * 1024 + col0 + bj * 128;
                        const f32x4 v0 = acc[ai][bj][mh * 2 + m2][0] * rr, v1 = acc[ai][bj][mh * 2 + m2][1] * rr; const u32x4 g = ga[m2][bj]; f32x4 x0 = xa[m2][bj][0], x1 = xa[m2][bj][1];
                        x0.x += sigm(v0.x) * lo16(g.x); x0.y += sigm(v0.y) * hi16(g.x); x0.z += sigm(v0.z) * lo16(g.y); x0.w += sigm(v0.w) * hi16(g.y);
                        x1.x += sigm(v1.x) * lo16(g.z); x1.y += sigm(v1.y) * hi16(g.z); x1.z += sigm(v1.z) * lo16(g.w); x1.w += sigm(v1.w) * hi16(g.w);
                        *(f32x4*)(x + off) = x0; *(f32x4*)(x + off + 4) = x1; } }
            }
    }
};


DI void unpack8(const u32x4 w, float (&f)[8]) { f[0] = lo16(w.x); f[1] = hi16(w.x); f[2] = lo16(w.y); f[3] = hi16(w.y); f[4] = lo16(w.z); f[5] = hi16(w.z); f[6] = lo16(w.w); f[7] = hi16(w.w); }
DI u32x4 pack8(const float (&f)[8]) { u32x4 o; o.x = pk2(f[0], f[1]); o.y = pk2(f[2], f[3]); o.z = pk2(f[4], f[5]); o.w = pk2(f[6], f[7]); return o; }
DI void load8f(const float* p, float (&f)[8]) { const f32x4 a = *(const f32x4*)p, b = *(const f32x4*)(p + 4); f[0] = a.x; f[1] = a.y; f[2] = a.z; f[3] = a.w; f[4] = b.x; f[5] = b.y; f[6] = b.z; f[7] = b.w; }

DI void phase_chunk(const Params& p, int l, const Frame& F) {
    unsigned char* ws = p.ws; const int lane = F.lane, wave = F.wave;
    bf16_t* PROJ = (bf16_t*)(ws + WS_PROJ); bf16_t* YA = (bf16_t*)(ws + WS_Y); bf16_t* YC = YA + (size_t)2 * T * 512; bf16_t* CMPA = (bf16_t*)(ws + WS_CMPA);
    const bf16_t* SGUW = (const bf16_t*)(ws + WS_SGUW);
    LAS unsigned char* vnT = F.lds;
    const float* convw = p.in[I_CONVW] + (size_t)l * 3 * 512; const float* lng = p.in[I_LNG] + (size_t)l * 512; const float* sgub = p.in[I_SGUB] + (size_t)l * 8 * 128;
    float cw0[8], cw1[8], cw2[8], lgn[8];
    load8f(convw + lane * 8, cw0); load8f(convw + 512 + lane * 8, cw1); load8f(convw + 1024 + lane * 8, cw2); load8f(lng + lane * 8, lgn);
    for (int chunk = F.vb; chunk < T / 128; chunk += F.G) {
        const int t0 = chunk * 128;
        for (int tt = wave; tt < 128; tt += 8) {
            const int t = t0 + tt, s = t & (SEQ - 1), b = t >> 12;
            bf16_t* row = PROJ + (size_t)t * PW;
            const int c0 = lane * 8;
            const u32x4 z = {0u, 0u, 0u, 0u};
            const u32x4 rab = *(const u32x4*)(row + C_AB + c0), rc0 = *(const u32x4*)(row + C_AC + c0), rx0 = *(const u32x4*)(row + C_AX + c0);
            u32x4 r1c = z, r1x = z, r2c = z, r2x = z;
            if (s >= 1) { r1c = *(const u32x4*)(row - PW + C_AC + c0); r1x = *(const u32x4*)(row - PW + C_AX + c0); }
            if (s >= 2) { r2c = *(const u32x4*)(row - 2 * PW + C_AC + c0); r2x = *(const u32x4*)(row - 2 * PW + C_AX + c0); }
            u32x4 segv[3]; int segcol[3]; const float* seggp[3]; float segsc[3];
#pragma unroll
            for (int pass = 0; pass < 3; ++pass) {
                const int seg = pass * 8 + (lane >> 3), sg = seg < 20 ? seg : 20; int col; const float* gp; float sc = 1.f;
                if (sg < 8) { col = C_NQ + 64 * sg; gp = p.in[I_NQG] + l * 64; sc = 0.125f * 1.44269504f; }
                else if (sg < 10) { col = C_NKV + 2 * 128 + (sg - 8) * 64; gp = p.in[I_NKG] + (l * 3 + 1) * 64; }
                else if (sg < 12) { col = C_NKV + 4 * 128 + (sg - 10) * 64; gp = p.in[I_NKG] + (l * 3 + 2) * 64; }
                else if (sg < 20) { col = C_DQ + 64 * (sg - 12); gp = p.in[I_DQG] + l * 64; sc = 0.125f * 1.44269504f; }
                else { col = C_DK; gp = p.in[I_DKG] + l * 64; }
                segcol[pass] = col; seggp[pass] = gp; segsc[pass] = sc; segv[pass] = *(const u32x4*)(row + col + (lane & 7) * 8);
            }
            u32x4 rawc = z; const bf16_t* rawsrc = row; bf16_t* rawdst = nullptr;
            if (lane < 48) { const int sgc = lane >> 3;
                if (sgc < 2) { rawsrc = row + C_NKV + 3 * 128 + sgc * 64; rawdst = (bf16_t*)(ws + WS_VS) + ((size_t)((b * 2 + sgc) * SEQ + s)) * 64; }
                else if (sgc < 4) { rawsrc = row + C_NKV + 5 * 128 + (sgc - 2) * 64; rawdst = (bf16_t*)(ws + WS_VW) + ((size_t)((b * 2 + (sgc - 2)) * SEQ + s)) * 64; }
                else if (sgc == 4) { rawsrc = row + C_DV; rawdst = (bf16_t*)(ws + WS_DV) + (size_t)t * 64; }
                else { rawsrc = row + C_DKI; rawdst = (bf16_t*)(ws + WS_DKI) + (size_t)t * 64; }
                rawc = *(const u32x4*)(rawsrc + (lane & 7) * 8); }
            u32x4 cmpc = z;
            if (lane < 32) { const int jg = lane >> 3; cmpc = *(const u32x4*)(row + C_NKV + (jg >> 1) * 128 + (jg & 1) * 64 + (lane & 7) * 8); }
            const u32x4 ruv = *(const u32x4*)(row + C_UV + 512 + lane * 8);
            {
                float ab[8], c0v[8], x0v[8], c1v[8], x1v[8], c2v[8], x2v[8], y[8];
                unpack8(rab, ab); unpack8(rc0, c0v); unpack8(rx0, x0v); unpack8(r1c, c1v); unpack8(r1x, x1v); unpack8(r2c, c2v); unpack8(r2x, x2v);
#pragma unroll
                for (int e = 0; e < 8; ++e) y[e] = ab[e] * (cw2[e] * c0v[e] * x0v[e] + cw1[e] * c1v[e] * x1v[e] + cw0[e] * c2v[e] * x2v[e]);
                *(u32x4*)(YA + (size_t)t * 512 + c0) = pack8(y);
            }
#pragma unroll
            for (int pass = 0; pass < 3; ++pass) {
                const int seg = pass * 8 + (lane >> 3), part = lane & 7, sg = seg < 20 ? seg : 20;
                float v[8], g[8]; unpack8(segv[pass], v); load8f(seggp[pass] + part * 8, g);
                float ss = 0.f;
#pragma unroll
                for (int e = 0; e < 8; ++e) ss += v[e] * v[e];
                ss = oct_sumf(ss);
                const float r = rsqrtf(ss * (1.f / 64.f) + 1e-6f) * segsc[pass];
#pragma unroll
                for (int e = 0; e < 8; ++e) v[e] = v[e] * r * g[e];
                bf16_t* dstp = row + segcol[pass] + part * 8;
                if (sg >= 8 && sg < 10) dstp = (bf16_t*)(ws + WS_KS) + ((size_t)((b * 2 + (sg - 8)) * SEQ + s)) * 64 + part * 8;
                else if (sg >= 10 && sg < 12) dstp = (bf16_t*)(ws + WS_KW) + ((size_t)((b * 2 + (sg - 10)) * SEQ + s)) * 64 + part * 8;
                else if (sg == 20) dstp = (bf16_t*)(ws + WS_DK) + (size_t)t * 64 + part * 8;
                if (seg < 21) *(u32x4*)dstp = pack8(v);
            }
            if (lane < 48) *(u32x4*)(rawdst + (lane & 7) * 8) = rawc;
            if (lane < 32) { const int jg = lane >> 3, j = jg >> 1, g = jg & 1, part = lane & 7;
                *(u32x4*)(CMPA + ((size_t)j * 4096 + ((size_t)(b * 256 + (s >> 4)) * 2 + g)) * 1024 + (s & 15) * 64 + part * 8) = cmpc; }
            {
                float v[8]; unpack8(ruv, v);
                float sm = 0.f;
#pragma unroll
                for (int e = 0; e < 8; ++e) { v[e] = gelu_t(v[e]); sm += v[e]; }
                const float mean = wave_sum(sm) * (1.f / 512.f); float sq = 0.f;
#pragma unroll
                for (int e = 0; e < 8; ++e) { v[e] -= mean; sq += v[e] * v[e]; }
                const float r = rsqrtf(wave_sum(sq) * (1.f / 512.f) + 1e-6f);
#pragma unroll
                for (int e = 0; e < 8; ++e) *(LAS unsigned short*)(vnT + (lane * 8 + e) * 272 + tt * 2) = (unsigned short)f2bf(v[e] * r * lgn[e]);
            }
        }
        __syncthreads();
        {
            const int g = wave, c = lane & 15, q = lane >> 4; const bf16_t* Wg = SGUW + (size_t)g * 128 * 128;
            for (int tt16 = 0; tt16 < 8; ++tt16) {
                const int nk = (tt16 >> 1) + 1;
                bf16x8 bw[4];
#pragma unroll
                for (int kk = 0; kk < 4; ++kk) bw[kk] = *(const bf16x8*)(Wg + (size_t)(16 * tt16 + c) * 128 + 32 * (kk < nk ? kk : 0) + 8 * q);
                const int t = t0 + 16 * tt16 + c; const float bias = sgub[g * 128 + 16 * tt16 + c];
#pragma unroll
                for (int dt = 0; dt < 4; ++dt) {
                    f32x4 acc = {0.f, 0.f, 0.f, 0.f};
#pragma unroll
                    for (int kk = 0; kk < 4; ++kk) if (kk < nk) { const bf16x8 a = *(const LAS bf16x8*)(vnT + (g * 64 + 16 * dt + c) * 272 + (32 * kk + 8 * q) * 2); acc = MFMA16(a, bw[kk], acc); }
                    const int ch = g * 64 + 16 * dt + 4 * q;
                    const u32x2 uu = *(const u32x2*)(PROJ + (size_t)t * PW + C_UV + ch);
                    u32x2 o; o.x = pk2(gelu_t(lo16(uu.x)) * (acc[0] + bias), gelu_t(hi16(uu.x)) * (acc[1] + bias)); o.y = pk2(gelu_t(lo16(uu.y)) * (acc[2] + bias), gelu_t(hi16(uu.y)) * (acc[3] + bias));
                    *(u32x2*)(YC + (size_t)t * 512 + ch) = o;
                }
            }
        }
        __syncthreads();
    }
}

DI void phase_cmp2(const Params& p, int l, const Frame& F) {
    unsigned char* ws = p.ws; const int lane = F.lane; const int gw = F.vb * 8 + F.wave, NGW = F.G * 8;
    LAS float* hid = (LAS float*)(F.lds + 131072 + F.wave * 1024);
    LAS float* w2s = (LAS float*)F.lds;
    { const float* w2g = p.in[I_CW2] + (size_t)l * 2 * 256 * 64;
      for (int i = F.tid; i < 2 * 256 * 64 / 4; i += 512) *(LAS f32x4*)(w2s + i * 4) = *(const f32x4*)(w2g + i * 4); }
    __syncthreads();
    const float* CMPP = (const float*)(ws + WS_CMPP); const float* peb = (const float*)(ws + WS_PEB);
    bf16_t* CMPK = (bf16_t*)(ws + WS_CMPK); bf16_t* CMPV = (bf16_t*)(ws + WS_CMPV);
    const float* kg = p.in[I_NKG] + (l * 3 + 0) * 64;
    for (int it = gw; it < 8 * 256 * 2 * 2; it += NGW) {
        const int j = it & 1, g = (it >> 1) & 1, n = (it >> 2) & 255, b = it >> 10;
        bf16_t* dst = (j ? CMPV : CMPK) + ((size_t)(b * 2 + g) * 256 + n) * 64;
        if (n == 255) { dst[lane] = 0; continue; }
        const float* Pa = CMPP + ((size_t)j * 4096 + (size_t)(b * 256 + n) * 2 + g) * 512; const float* Pb = CMPP + ((size_t)j * 4096 + (size_t)(b * 256 + n + 1) * 2 + g) * 512 + 256;
        const f32x4 a = *(const f32x4*)(Pa + lane * 4), bq = *(const f32x4*)(Pb + lane * 4), pe = *(const f32x4*)(peb + j * 256 + lane * 4);
        f32x4 h; h.x = gelu_t(a.x + bq.x + pe.x); h.y = gelu_t(a.y + bq.y + pe.y); h.z = gelu_t(a.z + bq.z + pe.z); h.w = gelu_t(a.w + bq.w + pe.w);
        *(LAS f32x4*)(hid + lane * 4) = h;
        LDS_WAIT();
        const LAS float* w2 = w2s + j * 256 * 64;
        float o = 0.f;
#pragma unroll 16
        for (int k = 0; k < 256; ++k) o += hid[k] * w2[k * 64 + lane];
        if (j == 0) { const float ss = wave_sum(o * o); o = o * rsqrtf(ss * (1.f / 64.f) + 1e-6f) * kg[lane]; }
        dst[lane] = (bf16_t)f2bf(o);
        LDS_WAIT();
    }
}

constexpr int LUTP = 1040;
DI int bucket_fast(int n) { const int big = 16 + (int)((__log2f((float)n) - 4.f) * 2.6666667f + 2e-4f); return n < 16 ? n : (big < 31 ? big : 31); }
struct KsCmp { static constexpr bool CONTIG = true; static constexpr int DSTEP = 16, DMAX = 1 << 30; const bf16_t* kb; const bf16_t* vb; int t0, hb;
    DI void base(int k0, const bf16_t*& k, const bf16_t*& v) const { k = kb + (size_t)k0 * 64; v = vb + (size_t)k0 * 64; }
    DI int dist0(int k0, int c) const { return t0 + (c >> 2) - (16 * k0 + 31); } };
struct KsSel { static constexpr bool CONTIG = true; static constexpr int DSTEP = 1, DMAX = 1 << 30; const bf16_t* kb; const bf16_t* vb; const LAS int* selb; int t, hb;
    DI int p0(int k0) const { return __builtin_amdgcn_readfirstlane(selb[k0 >> 6]) * 64 + (k0 & 63); }
    DI void base(int k0, const bf16_t*& k, const bf16_t*& v) const { const int ps = p0(k0); k = kb + (size_t)ps * 64; v = vb + (size_t)ps * 64; }
    DI int dist0(int k0, int c) const { return t - p0(k0); } };
struct KsWin { static constexpr bool CONTIG = true; static constexpr int DSTEP = 1, DMAX = 512; const bf16_t* kb; const bf16_t* vb; int pstart, t0, hb;
    DI void base(int k0, const bf16_t*& k, const bf16_t*& v) const { k = kb + (size_t)(pstart + k0) * 64; v = vb + (size_t)(pstart + k0) * 64; }
    DI int dist0(int k0, int c) const { return t0 + (c >> 2) - (pstart + k0); } };
struct KsDsa { static constexpr bool CONTIG = false; static constexpr int DSTEP = 1, DMAX = 1 << 30; const bf16_t* kb; const bf16_t* vb; const LAS int* list; int n, t;
    DI int pos(int idx) const { return idx < n ? list[idx] : -1; }
    DI const bf16_t* krow(int idx) const { const int ps = pos(idx); return kb + (size_t)(ps < 0 ? 0 : ps) * 64; }
    DI const bf16_t* vrow(int idx) const { const int ps = pos(idx); return vb + (size_t)(ps < 0 ? 0 : ps) * 64; }
    DI float adjust(int idx, int c, float s, bool& ok, const LAS unsigned char* buck, const LAS float* tbl) const {
        const int ps = pos(idx); ok = ps >= 0 && ps <= t; const int dd = t - ps; const int dc = ok ? (dd < 1023 ? dd : 1023) : 0; return s + tbl[buck[dc] * 16 + 8 + (c & 7)]; } };

template <int MODE, class KS>
DI void flash_run(const KS& ks, int nkeys, const bf16x8 (&qb)[2], f32x4 (&o)[4], float& m_run, float& l_run, LAS unsigned char* vt, LAS float* al, LAS float* pn,
                  const LAS unsigned char* buck, const LAS float* tbl, int lane) {
    const int c = lane & 15, q = lane >> 4;
    bf16x8 A00, A01, A10, A11, B00, B01, B10, B11; u32x4 Av[4], Bv[4];
#define FL_LOAD(B_, kk0) do { if constexpr (KS::CONTIG) { const bf16_t* kbp_; const bf16_t* vbp_; ks.base((kk0), kbp_, vbp_); const bf16_t* kr0 = kbp_ + c * 64 + 8 * q; \
            B_##00 = *(const bf16x8*)kr0; B_##01 = *(const bf16x8*)(kr0 + 32); B_##10 = *(const bf16x8*)(kr0 + 1024); B_##11 = *(const bf16x8*)(kr0 + 1056); \
            if (MODE != 1) { const bf16_t* vr0 = vbp_ + (lane >> 3) * 64 + (lane & 7) * 8; _Pragma("unroll") for (int m = 0; m < 4; ++m) B_##v[m] = *(const u32x4*)(vr0 + m * 512); } } \
        else { const bf16_t* kr0 = ks.krow((kk0) + c); const bf16_t* kr1 = ks.krow((kk0) + 16 + c); \
            B_##00 = *(const bf16x8*)(kr0 + 8 * q); B_##01 = *(const bf16x8*)(kr0 + 32 + 8 * q); B_##10 = *(const bf16x8*)(kr1 + 8 * q); B_##11 = *(const bf16x8*)(kr1 + 32 + 8 * q); \
            if (MODE != 1) { _Pragma("unroll") for (int m = 0; m < 4; ++m) B_##v[m] = *(const u32x4*)(ks.vrow((kk0) + (lane >> 3) + 8 * m) + (lane & 7) * 8); } } } while (0)
#define FL_STEP(B_, K0_) do { \
        f32x4 s0 = {0.f, 0.f, 0.f, 0.f}, s1 = {0.f, 0.f, 0.f, 0.f}; \
        s0 = MFMA16(B_##00, qb[0], s0); s0 = MFMA16(B_##01, qb[1], s0); s1 = MFMA16(B_##10, qb[0], s1); s1 = MFMA16(B_##11, qb[1], s1); \
        float sv[8], pv[8]; bool ok[8]; \
        if constexpr (KS::CONTIG) { \
            const LAS float* trow = tbl + (c & 3) * LUTP; const int d0 = ks.dist0((K0_), c) - KS::DSTEP * 4 * q; \
        _Pragma("unroll") \
            for (int i = 0; i < 4; ++i) { const int da = d0 - KS::DSTEP * i, db = da - KS::DSTEP * 16; \
                ok[i] = da >= 0 && da < KS::DMAX; ok[4 + i] = db >= 0 && db < KS::DMAX; \
                sv[i] = s0[i] + trow[da < 0 ? 0 : (da < 1023 ? da : 1023)]; sv[4 + i] = s1[i] + trow[db < 0 ? 0 : (db < 1023 ? db : 1023)]; } \
        } else { \
        _Pragma("unroll") \
            for (int i = 0; i < 4; ++i) { sv[i] = ks.adjust((K0_) + 4 * q + i, c, s0[i], ok[i], buck, tbl); sv[4 + i] = ks.adjust((K0_) + 16 + 4 * q + i, c, s1[i], ok[4 + i], buck, tbl); } \
        } \
        if (MODE == 2) { \
        _Pragma("unroll") \
            for (int e = 0; e < 8; ++e) { pv[e] = ok[e] ? __builtin_amdgcn_exp2f(sv[e]) * l_run : 0.f; \
                const float x = quad_sumf(pv[e]); \
                if ((c & 3) == 0) pn[(c >> 2) * 256 + (K0_) + (e < 4 ? 4 * q + e : 16 + 4 * q + (e - 4))] = x; } \
        } else { \
            float ps = 0.f; \
        _Pragma("unroll") \
            for (int e = 0; e < 8; ++e) { pv[e] = ok[e] ? __builtin_amdgcn_exp2f(sv[e]) : 0.f; ps += pv[e]; } \
            l_run += ps; \
        } \
        if (MODE != 1) { \
        _Pragma("unroll") \
            for (int m = 0; m < 4; ++m) *(LAS u32x4*)(vt + ((lane >> 3) + 8 * m) * 144 + (lane & 7) * 16) = B_##v[m]; \
            LDS_FENCE(); \
            const bf16x8 pa = __builtin_bit_cast(bf16x8, pack8(pv)); \
        _Pragma("unroll") \
            for (int dt = 0; dt < 4; ++dt) { \
                const s16x4 lo = __builtin_amdgcn_ds_read_tr16_b64_v4i16((LAS s16x4*)(vt + (4 * q + (c >> 2)) * 144 + (16 * dt + 4 * (c & 3)) * 2)); \
                const s16x4 hi = __builtin_amdgcn_ds_read_tr16_b64_v4i16((LAS s16x4*)(vt + (16 + 4 * q + (c >> 2)) * 144 + (16 * dt + 4 * (c & 3)) * 2)); \
                const bf16x8 vb8 = __builtin_shufflevector(lo, hi, 0, 1, 2, 3, 4, 5, 6, 7); \
                o[dt] = MFMA16(pa, vb8, o[dt]); \
            } \
            LDS_FENCE(); \
        } \
    } while (0)
    FL_LOAD(A, 0);
    for (int k0 = 0; k0 < nkeys; k0 += 64) {
        { const int kn = k0 + 32 < nkeys ? k0 + 32 : k0; FL_LOAD(B, kn); }
        FL_STEP(A, k0);
        if (k0 + 32 >= nkeys) break;
        { const int kn = k0 + 64 < nkeys ? k0 + 64 : k0; FL_LOAD(A, kn); }
        FL_STEP(B, k0 + 32);
    }
#undef FL_STEP
#undef FL_LOAD
    if (MODE == 0) {
        float lt = x32_sum(x16_sum(l_run));
        const float inv = lt > 0.f ? __builtin_amdgcn_rcpf(lt) : 0.f;
        if (q == 0) al[c] = inv;
        LDS_WAIT();
        const f32x4 a4 = *(const LAS f32x4*)(al + 4 * q);
#pragma unroll
        for (int dt = 0; dt < 4; ++dt) o[dt] = o[dt] * a4;
        LDS_WAIT();
    }
}

DI void nsa_tile(const Params& p, int b, int g, int tb, const Frame& F, const LAS float* lut, int vm = 0) {
    unsigned char* ws = p.ws; const int lane = F.lane, wave = F.wave, c = lane & 15, q = lane >> 4;
    const LAS float* tbl = lut + g * 4 * LUTP;
    LAS unsigned char* wl = F.lds + wave * 9216; LAS unsigned char* vt = wl; LAS float* al = (LAS float*)(wl + 4608); LAS float* pn = (LAS float*)(wl + 4736);
    LAS float* OS = (LAS float*)F.lds; LAS float* LS = (LAS float*)(F.lds + 65536);
    LAS int* SELB = (LAS int*)(F.lds + 73728); LAS int* CNT = (LAS int*)(F.lds + 75776); LAS unsigned short* UNIT = (LAS unsigned short*)(F.lds + 76032); LAS int* NUNIT = (LAS int*)(F.lds + 76416);
    volatile LAS int* TURN = (volatile LAS int*)(F.lds + 76544); LAS unsigned short* LIST = (LAS unsigned short*)(F.lds + 76800);
    LAS unsigned char* vt2 = F.lds + 84992 + wave * 4608;
    const bf16_t* prow0 = (const bf16_t*)(ws + WS_PROJ) + (size_t)(b * SEQ) * PW;
    bf16_t* YB = (bf16_t*)(ws + WS_Y) + (size_t)T * 512;
    const f32x4 z4 = {0.f, 0.f, 0.f, 0.f};
    for (int ii = 0; ii < 2; ++ii) {
        f32x4 accw[4];
        const int item = wave * 2 + ii, t0 = 64 * tb + 4 * item;
#pragma unroll
        for (int k = 0; k < 4; ++k) *(LAS f32x4*)(pn + lane * 4 + 256 * k) = z4;
        bf16x8 qb[2];
        { const bf16_t* qp = prow0 + (size_t)(t0 + (c >> 2)) * PW + C_NQ + (g * 4 + (c & 3)) * 64 + 8 * q; qb[0] = *(const bf16x8*)qp; qb[1] = *(const bf16x8*)(qp + 32); }
        float g0[4], g2[4];
        { const u32x2 ga = *(const u32x2*)(prow0 + (size_t)(t0 + q) * PW + C_NG + 0 * 8 + g * 4), gc = *(const u32x2*)(prow0 + (size_t)(t0 + q) * PW + C_NG + 2 * 8 + g * 4);
          g0[0] = sigm(lo16(ga.x)); g0[1] = sigm(hi16(ga.x)); g0[2] = sigm(lo16(ga.y)); g0[3] = sigm(hi16(ga.y));
          g2[0] = sigm(lo16(gc.x)); g2[1] = sigm(hi16(gc.x)); g2[2] = sigm(lo16(gc.y)); g2[3] = sigm(hi16(gc.y)); }
#pragma unroll
        for (int dt = 0; dt < 4; ++dt) accw[dt] = z4;
        LDS_WAIT();
        const int tl = t0 + 3, nv = tl >= 31 ? ((tl - 31) >> 4) + 1 : 0;
        if (nv > 0 && (vm == 0 || (vm & 1))) {
            const int nk = (nv + 31) & ~31;
            KsCmp ks{(const bf16_t*)(ws + WS_CMPK) + (size_t)(b * 2 + g) * 256 * 64, (const bf16_t*)(ws + WS_CMPV) + (size_t)(b * 2 + g) * 256 * 64, t0, g * 4};
            float m = 0.f, lr = 0.f; f32x4 o[4] = {z4, z4, z4, z4};
            flash_run<1>(ks, nk, qb, o, m, lr, vt, al, pn, (const LAS unsigned char*)vt, tbl, lane);
            lr = x32_sum(x16_sum(lr)); lr = lr > 0.f ? __builtin_amdgcn_rcpf(lr) : 0.f;
            flash_run<2>(ks, nk, qb, o, m, lr, vt, al, pn, (const LAS unsigned char*)vt, tbl, lane);
#pragma unroll
            for (int dt = 0; dt < 4; ++dt) { accw[dt][0] = g0[0] * o[dt][0]; accw[dt][1] = g0[1] * o[dt][1]; accw[dt][2] = g0[2] * o[dt][2]; accw[dt][3] = g0[3] * o[dt][3]; }
        }
        LDS_WAIT();
        {
            const int j = lane; float val[4];
#pragma unroll
            for (int qi = 0; qi < 4; ++qi) {
                if (j == 0 || j == tb) val[qi] = 1e4f;
                else if (j < tb) { const LAS float* pq = pn + qi * 256 + 4 * j; val[qi] = pq[-1] + pq[0] + pq[1] + pq[2] + pq[3]; }
                else val[qi] = -1e30f;
            }
            for (int k = 0; k < 8; ++k) {
#pragma unroll
                for (int qi = 0; qi < 4; ++qi) {
                    const float mx = wave_max(val[qi]); const unsigned long long who = __ballot(val[qi] == mx); const int w = __builtin_ctzll(who);
                    if (lane == 0) SELB[(item * 4 + qi) * 8 + k] = mx > -1e29f ? w : -1;
                    if (lane == w) val[qi] = -3e38f;
                }
            }
        }
        {
            const int pstart = t0 >= 511 ? t0 - 511 : 0, nk = (t0 + 3 - pstart + 1 + 31) & ~31;
            KsWin ks{(const bf16_t*)(ws + WS_KW) + (size_t)(b * 2 + g) * SEQ * 64, (const bf16_t*)(ws + WS_VW) + (size_t)(b * 2 + g) * SEQ * 64, pstart, t0, g * 4};
            float m = 0.f, lr = 0.f; f32x4 o[4] = {z4, z4, z4, z4};
            if (vm == 0 || (vm & 2)) flash_run<0>(ks, nk, qb, o, m, lr, vt, al, pn, (const LAS unsigned char*)vt, tbl, lane);
            if (vm & 4) { flash_run<1>(ks, nk, qb, o, m, lr, vt, al, pn, (const LAS unsigned char*)vt, tbl, lane); o[0][0] += lr; }
#pragma unroll
            for (int dt = 0; dt < 4; ++dt) { accw[dt][0] += g2[0] * o[dt][0]; accw[dt][1] += g2[1] * o[dt][1]; accw[dt][2] += g2[2] * o[dt][2]; accw[dt][3] += g2[3] * o[dt][3]; }
        }
        if (vm == 0) {
            bf16_t* dst = YB + (size_t)(b * SEQ + t0 + q) * 512 + (g * 4) * 64 + c;
#pragma unroll
            for (int dt = 0; dt < 4; ++dt)
#pragma unroll
                for (int i = 0; i < 4; ++i) dst[i * 64 + 16 * dt] = (bf16_t)f2bf(accw[dt][i]);
        }
        else { asm volatile("" :: "v"(accw[0]), "v"(accw[1]), "v"(accw[2]), "v"(accw[3])); }
        LDS_WAIT();
    }
    __syncthreads();
    if (vm != 0) return;
    for (int i = F.tid; i < 66560 / 16; i += 512) *(LAS f32x4*)(F.lds + i * 16) = z4;
    if (F.tid < 64) { CNT[F.tid] = 0; TURN[F.tid] = 0; }
    __syncthreads();
    { const int blk = SELB[F.tid];
      if (blk >= 0) { int rank = 0;
#pragma unroll
          for (int k = 0; k < 8; ++k) { const int ob = SELB[(F.tid & ~7) + k]; rank += (ob >= 0 && ob < blk) ? 1 : 0; }
          const int pos = __hip_atomic_fetch_add(CNT + blk, 1, __ATOMIC_RELAXED, __HIP_MEMORY_SCOPE_WORKGROUP); LIST[blk * 64 + pos] = (unsigned short)((F.tid >> 3) | (rank << 8)); } }
    __syncthreads();
    if (wave == 0) {
        const int uj = (CNT[lane] + 3) >> 2; int inc = uj;
#pragma unroll
        for (int o_ = 1; o_ < 64; o_ <<= 1) { const int v = __shfl_up(inc, o_); if (lane >= o_) inc += v; }
        const int offs = inc - uj;
        for (int u = 0; u < uj; ++u) UNIT[offs + u] = (unsigned short)(lane | (u << 8));
        if (lane == 63) NUNIT[0] = inc;
    }
    __syncthreads();
    {
        const int nu = NUNIT[0];
        const LAS float* trow = tbl + (c & 3) * LUTP;
        const bf16_t* KSb = (const bf16_t*)(ws + WS_KS) + (size_t)(b * 2 + g) * SEQ * 64; const bf16_t* VSb = (const bf16_t*)(ws + WS_VS) + (size_t)(b * 2 + g) * SEQ * 64;
        bf16x8 kA[4], kB[4]; u32x4 vA[4], vB[4]; bf16x8 qs[2], qn[2];
        const bf16x8 zq = {0, 0, 0, 0, 0, 0, 0, 0};
#define SEL_LOAD(K_, V_, jj, st) do { const bf16_t* kr0 = KSb + (size_t)(64 * (jj) + 32 * (st) + c) * 64 + 8 * q; K_[0] = *(const bf16x8*)kr0; K_[1] = *(const bf16x8*)(kr0 + 32); K_[2] = *(const bf16x8*)(kr0 + 1024); K_[3] = *(const bf16x8*)(kr0 + 1056); \
            const bf16_t* vr0 = VSb + (size_t)(64 * (jj) + 32 * (st) + (lane >> 3)) * 64 + (lane & 7) * 8; _Pragma("unroll") for (int m = 0; m < 4; ++m) V_[m] = *(const u32x4*)(vr0 + m * 512); } while (0)
#define SEL_LOADQ(Q_, jj, uu_) do { const int sl_ = 4 * (uu_) + (c >> 2); const int qr_ = sl_ < CNT[jj] ? (int)(LIST[(jj) * 64 + sl_] & 63) : -1; \
            const bf16_t* qp = prow0 + (size_t)(64 * tb + (qr_ < 0 ? 0 : qr_)) * PW + C_NQ + (g * 4 + (c & 3)) * 64 + 8 * q; const bf16x8 q0_ = *(const bf16x8*)qp, q1_ = *(const bf16x8*)(qp + 32); \
            Q_[0] = qr_ >= 0 ? q0_ : zq; Q_[1] = qr_ >= 0 ? q1_ : zq; } while (0)
#define SEL_STEP(K_, V_, st) do { \
                f32x4 s0 = z4, s1 = z4; \
                s0 = MFMA16(K_[0], qs[0], s0); s0 = MFMA16(K_[1], qs[1], s0); s1 = MFMA16(K_[2], qs[0], s1); s1 = MFMA16(K_[3], qs[1], s1); \
                const int d0 = 64 * (tb - j) + (qrow < 0 ? 0 : qrow) - 32 * (st) - 4 * q; float pv[8]; \
            _Pragma("unroll") \
                for (int i = 0; i < 4; ++i) { const int da = d0 - i, db = da - 16; \
                    const float ea = __builtin_amdgcn_exp2f(s0[i] + trow[da < 0 ? 0 : (da < 1023 ? da : 1023)]), eb = __builtin_amdgcn_exp2f(s1[i] + trow[db < 0 ? 0 : (db < 1023 ? db : 1023)]); \
                    pv[i] = (qrow >= 0 && da >= 0) ? ea : 0.f; pv[4 + i] = (qrow >= 0 && db >= 0) ? eb : 0.f; lsum += pv[i] + pv[4 + i]; } \
            _Pragma("unroll") \
                for (int m = 0; m < 4; ++m) *(LAS u32x4*)(vt2 + ((lane >> 3) + 8 * m) * 144 + (lane & 7) * 16) = V_[m]; \
                LDS_FENCE(); \
                const bf16x8 pa = __builtin_bit_cast(bf16x8, pack8(pv)); \
            _Pragma("unroll") \
                for (int dt = 0; dt < 4; ++dt) { \
                    const s16x4 lo = __builtin_amdgcn_ds_read_tr16_b64_v4i16((LAS s16x4*)(vt2 + (4 * q + (c >> 2)) * 144 + (16 * dt + 4 * (c & 3)) * 2)); \
                    const s16x4 hi = __builtin_amdgcn_ds_read_tr16_b64_v4i16((LAS s16x4*)(vt2 + (16 + 4 * q + (c >> 2)) * 144 + (16 * dt + 4 * (c & 3)) * 2)); \
                    o[dt] = MFMA16(pa, __builtin_shufflevector(lo, hi, 0, 1, 2, 3, 4, 5, 6, 7), o[dt]); \
                } \
                LDS_FENCE(); } while (0)
        { const int uu0 = UNIT[wave < nu ? wave : 0]; SEL_LOAD(kA, vA, uu0 & 63, 0); SEL_LOADQ(qs, uu0 & 63, (uu0 >> 8) & 15); }
        for (int ui = wave; ui < nu; ui += 8) {
            const int uu = UNIT[ui], j = uu & 255, u = uu >> 8, nj = CNT[j];
            const int slot = 4 * u + (c >> 2); const int qrow = slot < nj ? (int)(LIST[j * 64 + slot] & 255) : -1;
            f32x4 o[4] = {z4, z4, z4, z4}; float lsum = 0.f;
            SEL_LOAD(kB, vB, j, 1);
            SEL_STEP(kA, vA, 0);
            { const int uu2 = UNIT[ui + 8 < nu ? ui + 8 : ui]; SEL_LOAD(kA, vA, uu2 & 63, 0); SEL_LOADQ(qn, uu2 & 63, (uu2 >> 8) & 15); }
            SEL_STEP(kB, vB, 1);
            qs[0] = qn[0]; qs[1] = qn[1];
            lsum = x32_sum(x16_sum(lsum));
#pragma unroll 1
            for (int s = 0; s < 4; ++s) {
                if (4 * u + s >= nj) break;
                const int ent = LIST[j * 64 + 4 * u + s], qs_ = ent & 255, rk = ent >> 8;
                unsigned spins = 0;
                while (TURN[qs_] != rk) { __builtin_amdgcn_s_sleep(1); if (++spins > (1u << 22)) break; }
            }
            if (4 * u + q < nj) { const int qo = (int)(LIST[j * 64 + 4 * u + q] & 255);
#pragma unroll
                for (int dt = 0; dt < 4; ++dt)
#pragma unroll
                    for (int i = 0; i < 4; ++i) OS[(qo * 4 + i) * 64 + 16 * dt + c] += o[dt][i];
            }
            if (q == 0 && qrow >= 0) LS[qrow * 4 + (c & 3)] += lsum;
            LDS_WAIT();
            if (lane < 4 && 4 * u + lane < nj) { const int ent = LIST[j * 64 + 4 * u + lane]; TURN[ent & 255] = (ent >> 8) + 1; }
            LDS_WAIT();
        }
#undef SEL_LOAD
#undef SEL_LOADQ
#undef SEL_STEP
    }
    __syncthreads();
    for (int ii = 0; ii < 2; ++ii) {
        const int item = wave * 2 + ii, qq = item * 4 + q, t = 64 * tb + qq;
        const u32x2 gg = *(const u32x2*)(prow0 + (size_t)t * PW + C_NG + 8 + g * 4);
        const float g1[4] = {sigm(lo16(gg.x)), sigm(hi16(gg.x)), sigm(lo16(gg.y)), sigm(hi16(gg.y))};
        const f32x4 l4 = *(const LAS f32x4*)(LS + qq * 4);
        const float inv[4] = {l4.x > 0.f ? g1[0] / l4.x : 0.f, l4.y > 0.f ? g1[1] / l4.y : 0.f, l4.z > 0.f ? g1[2] / l4.z : 0.f, l4.w > 0.f ? g1[3] / l4.w : 0.f};
        bf16_t* dst = YB + (size_t)(b * SEQ + t) * 512 + (g * 4) * 64 + c;
#pragma unroll
        for (int dt = 0; dt < 4; ++dt)
#pragma unroll
            for (int i = 0; i < 4; ++i) dst[i * 64 + 16 * dt] = (bf16_t)f2bf(bf2f(dst[i * 64 + 16 * dt]) + inv[i] * OS[(qq * 4 + i) * 64 + 16 * dt + c]);
    }
    __syncthreads();
}

DI void dsa_group(const Params& p, int b, int t0, const Frame& F, const LAS unsigned char* buck, const LAS float* tbl, int parts = 7) {
    unsigned char* ws = p.ws; const int lane = F.lane, wave = F.wave, c = lane & 15, q = lane >> 4;
    LAS unsigned* SC = (LAS unsigned*)F.lds;
    LAS int* list = (LAS int*)(F.lds + 131072 + wave * 1024); LAS float* al = (LAS float*)(F.lds + 139264 + wave * 64);
    const bf16_t* prow0 = (const bf16_t*)(ws + WS_PROJ) + (size_t)(b * SEQ) * PW;
    bf16_t* YD = (bf16_t*)(ws + WS_Y) + (size_t)3 * T * 512;
    const bf16x8 zf = {0, 0, 0, 0, 0, 0, 0, 0};
    const int t = t0 + wave; const bf16_t* qrow = prow0 + (size_t)t * PW;
    const bf16_t* dki = (const bf16_t*)(ws + WS_DKI) + (size_t)(b * SEQ) * 64;
    const bool full = t0 >= 256;
    if (full && (parts & 1)) {
        bf16x8 qa[4][2]; float wv[4][4];
#pragma unroll
        for (int rt = 0; rt < 4; ++rt) { const bf16_t* qp = prow0 + (size_t)(t0 + 2 * rt + (c >> 3)) * PW + C_DQI + (c & 7) * 64 + 8 * q; qa[rt][0] = *(const bf16x8*)qp; qa[rt][1] = *(const bf16x8*)(qp + 32);
            const u32x2 w4 = *(const u32x2*)(prow0 + (size_t)(t0 + 2 * rt + (q >> 1)) * PW + C_DWI + (q & 1) * 4);
            wv[rt][0] = lo16(w4.x) * 0.35355339f; wv[rt][1] = hi16(w4.x) * 0.35355339f; wv[rt][2] = lo16(w4.y) * 0.35355339f; wv[rt][3] = hi16(w4.y) * 0.35355339f; }
        const int ntile = ((t0 + 7) >> 4) + 1, nk64 = ((t0 + 7) >> 6) + 1;
        bf16x8 kx0, kx1;
        { const bf16_t* kp = dki + (size_t)(16 * (wave < ntile ? wave : 0) + c) * 64 + 8 * q; kx0 = *(const bf16x8*)kp; kx1 = *(const bf16x8*)(kp + 32); }
        for (int tau = wave; tau < ntile; tau += 8) {
            const bf16x8 kb0 = kx0, kb1 = kx1;
            { const bf16_t* kp = dki + (size_t)(16 * (tau + 8 < ntile ? tau + 8 : tau) + c) * 64 + 8 * q; kx0 = *(const bf16x8*)kp; kx1 = *(const bf16x8*)(kp + 32); }
            const int key = 16 * tau + c;
#pragma unroll
            for (int rt = 0; rt < 4; ++rt) {
                f32x4 acc = {0.f, 0.f, 0.f, 0.f};
                acc = MFMA16(qa[rt][0], kb0, acc); acc = MFMA16(qa[rt][1], kb1, acc);
                float s = wv[rt][0] * fmaxf(acc[0], 0.f) + wv[rt][1] * fmaxf(acc[1], 0.f) + wv[rt][2] * fmaxf(acc[2], 0.f) + wv[rt][3] * fmaxf(acc[3], 0.f);
                s = x16_sum(s);
                const int qq = 2 * rt + (q >> 1);
                if ((q & 1) == 0) SC[qq * 4096 + key] = key <= t0 + qq ? ordf(s) : 0u;
            }
        }
        for (int i = F.tid; i < 8 * 64; i += 512) { const int key = ntile * 16 + (i & 63); if (key < nk64 * 64) SC[(i >> 6) * 4096 + key] = 0u; }
    }
    __syncthreads();
    int n;
    if (!full) { n = t + 1; for (int i = lane; i < 256; i += 64) list[i] = i <= t ? i : -1; }
    else if (parts & 2) {
        n = 256;
        const LAS unsigned* sc = SC + wave * 4096; const int nk64 = (t >> 6) + 1;
        unsigned u[64];
#pragma unroll
        for (int k = 0; k < 64; ++k) u[k] = k < nk64 ? sc[k * 64 + lane] : 0u;
#define WAVE_TOTAL(cl, tot) do { tot = __builtin_amdgcn_readfirstlane((int)wave_sum_u(cl)); } while (0)
        unsigned prefix = 0u;
        const int nk8 = __builtin_amdgcn_readfirstlane((nk64 + 7) >> 3);
#define CNT_GE(NK) _Pragma("unroll") for (int k = 0; k < NK; ++k) cl += (u[k] >= cand) ? 1u : 0u;
        for (int bit = 31; bit >= 0; --bit) {
            const unsigned cand = prefix | (1u << bit); unsigned cl = 0u; int cnt;
            switch (nk8) { case 1: CNT_GE(8) break; case 2: CNT_GE(16) break; case 3: CNT_GE(24) break; case 4: CNT_GE(32) break;
                           case 5: CNT_GE(40) break; case 6: CNT_GE(48) break; case 7: CNT_GE(56) break; default: CNT_GE(64) break; }
            WAVE_TOTAL(cl, cnt);
            if (cnt >= 256) { prefix = cand; if (cnt == 256) break; }
        }
        int cgt; { unsigned cl = 0u;
#pragma unroll
            for (int k = 0; k < 64; ++k) cl += (u[k] > prefix) ? 1u : 0u;
            WAVE_TOTAL(cl, cgt); }
#undef WAVE_TOTAL
#undef CNT_GE
        const int need_eq = 256 - cgt; int base = 0, eqbase = 0;
#pragma unroll
        for (int k = 0; k < 64; ++k) {
            if (k < nk64) {
                const bool gtp = u[k] > prefix, eq = u[k] == prefix;
                const unsigned long long meq = __ballot(eq);
                const int eqrank = eqbase + (int)__builtin_amdgcn_mbcnt_hi((unsigned)(meq >> 32), __builtin_amdgcn_mbcnt_lo((unsigned)meq, 0u));
                const bool take = gtp || (eq && eqrank < need_eq);
                const unsigned long long mt = __ballot(take);
                const int slot = base + (int)__builtin_amdgcn_mbcnt_hi((unsigned)(mt >> 32), __builtin_amdgcn_mbcnt_lo((unsigned)mt, 0u));
                if (take && slot < 256) list[slot] = k * 64 + lane;
                base += __popcll(mt); eqbase += __popcll(meq);
            }
        }
    }
    else n = 256;
    LDS_WAIT();
    if (!(parts & 4)) { __syncthreads(); return; }
    LAS unsigned char* vt = F.lds + wave * 16384;
    bf16x8 qd[2] = {zf, zf};
    if (c < 8) { qd[0] = *(const bf16x8*)(qrow + C_DQ + c * 64 + 8 * q); qd[1] = *(const bf16x8*)(qrow + C_DQ + c * 64 + 32 + 8 * q); }
    KsDsa ks{(const bf16_t*)(ws + WS_DK) + (size_t)(b * SEQ) * 64, (const bf16_t*)(ws + WS_DV) + (size_t)(b * SEQ) * 64, list, n, t};
    const f32x4 z4 = {0.f, 0.f, 0.f, 0.f};
    float m = -1e30f, lr = 0.f; f32x4 o[4] = {z4, z4, z4, z4};
    flash_run<0>(ks, (n + 31) & ~31, qd, o, m, lr, vt, al, (LAS float*)vt, buck, tbl, lane);
    if (q < 2) {
#pragma unroll
        for (int dt = 0; dt < 4; ++dt)
#pragma unroll
            for (int i = 0; i < 4; ++i) YD[(size_t)(b * SEQ + t) * 512 + (4 * q + i) * 64 + 16 * dt + c] = (bf16_t)f2bf(o[dt][i]);
    }
    __syncthreads();
}

DI void phase_attn(const Params& p, int l, const Frame& F, int mask = 3, int parts = 15) {
    const int gw = F.vb * 8 + F.wave, NGW = F.G * 8; const float* rel = p.in[I_REL];
#ifndef MK_ATTN
#define MK_ATTN 3
#endif
    if ((MK_ATTN & 1) && (mask & 1)) {
        LAS float* lut = (LAS float*)(F.lds + 130048);
        for (int i = F.tid; i < 8 * 1024; i += 512) { const int h = i >> 10, d = i & 1023; lut[h * LUTP + d] = rel[bucket_of(d) * 16 + h] * 1.44269504f; }
        __syncthreads();
        for (int it = F.vb; it < 8 * 2 * 64; it += F.G) { const int b = it >> 7, g = (it >> 6) & 1; int tb = it & 63; if ((it / F.G) & 1) tb = 63 - tb; nsa_tile(p, b, g, tb, F, lut, (parts >> 8) & 15); }
    }
    __syncthreads();
    LAS unsigned char* buck = F.lds + 139776; LAS float* tbl = (LAS float*)(F.lds + 140800);
    for (int i = F.tid; i < 1024; i += 512) buck[i] = (unsigned char)bucket_of(i);
    tbl[F.tid] = rel[F.tid] * 1.44269504f;
    __syncthreads();
    if ((MK_ATTN & 2) && (mask & 2)) for (int it = F.vb; it < 8 * 512; it += F.G) { const int b = it >> 9; int tg = it & 511; if (b & 1) tg = 511 - tg; dsa_group(p, b, tg * 8, F, buck, tbl, parts); }
}


#ifndef MK_PROBE
#define MK_PROBE 0
#endif

DI unsigned row16_maxu(unsigned m) { unsigned o;
    o = (unsigned)DPP_I((int)m, 0xB1); m = m > o ? m : o; o = (unsigned)DPP_I((int)m, 0x4E); m = m > o ? m : o;
    o = (unsigned)DPP_I((int)m, 0x141); m = m > o ? m : o; o = (unsigned)DPP_I((int)m, 0x140); m = m > o ? m : o; return m; }
DI void peer_route_tile(const Params& p, int t0, int lane) {
    unsigned char* ws = p.ws; const int c = lane & 15, q = lane >> 4;
    const bf16_t* QP = (const bf16_t*)(ws + WS_QP); const bf16_t* SK = (const bf16_t*)(ws + WS_SK); int* EIDX = (int*)(ws + WS_EIDX); float* EW = (float*)(ws + WS_EW);
    float* EU = (float*)(ws + WS_EU); const float* USr = (const float*)(ws + WS_PTV); const float* VSr = USr + 16384;
    int ca[4], cb[4]; bool cv[4];
    ca[0] = 0; cb[0] = c; cv[0] = true;
    ca[1] = c < 8 ? 1 : (c < 13 ? 2 : 3); cb[1] = c < 8 ? c : (c < 13 ? c - 8 : c - 13); cv[1] = true;
    { const int ci = 32 + c; int a_, b_;
      if (ci == 32) { a_ = 3; b_ = 3; } else if (ci < 36) { a_ = 4; b_ = ci - 33; } else if (ci < 42) { a_ = 5 + ((ci - 36) >> 1); b_ = (ci - 36) & 1; } else { a_ = 8 + (ci - 42); b_ = 0; }
      ca[2] = a_; cb[2] = b_; cv[2] = true; }
    ca[3] = c < 2 ? 14 + c : 0; cb[3] = 0; cv[3] = c < 2;
    for (int h = 0; h < 8; ++h) {
        unsigned top[2][4];
#pragma unroll
        for (int pp = 0; pp < 2; ++pp) {
            const int hp = h * 2 + pp;
            const bf16_t* ap = QP + (size_t)(t0 + c) * 1024 + hp * 64 + 8 * q;
            const bf16x8 a0 = *(const bf16x8*)ap, a1 = *(const bf16x8*)(ap + 32);
            unsigned v[4][8];
#pragma unroll
            for (int kt = 0; kt < 8; ++kt) { const bf16_t* bp = SK + ((size_t)hp * 128 + 16 * kt + c) * 64 + 8 * q;
                const bf16x8 b0 = *(const bf16x8*)bp, b1 = *(const bf16x8*)(bp + 32);
                f32x4 acc = {0.f, 0.f, 0.f, 0.f}; acc = MFMA16(a0, b0, acc); acc = MFMA16(a1, b1, acc);
#pragma unroll
                for (int i = 0; i < 4; ++i) v[i][kt] = (ordf(acc[i]) & 0xFFFFFF80u) | (unsigned)(127 - (16 * kt + c)); }
            { unsigned mine[4] = {0u, 0u, 0u, 0u};
#define CE_(a, b) { const unsigned hi_ = v[i][a] > v[i][b] ? v[i][a] : v[i][b], lo_ = v[i][a] > v[i][b] ? v[i][b] : v[i][a]; v[i][a] = hi_; v[i][b] = lo_; }
#pragma unroll
              for (int i = 0; i < 4; ++i) { CE_(0, 1) CE_(2, 3) CE_(4, 5) CE_(6, 7) CE_(0, 2) CE_(1, 3) CE_(4, 6) CE_(5, 7) CE_(1, 2) CE_(5, 6) CE_(0, 4) CE_(3, 7) CE_(1, 5) CE_(2, 6) CE_(1, 4) CE_(3, 6) CE_(2, 4) CE_(3, 5) CE_(3, 4) }
#undef CE_
              for (int r = 0; r < 16; ++r) {
#pragma unroll
                  for (int i = 0; i < 4; ++i) { const unsigned m = row16_maxu(v[i][0]); mine[i] = (c == r) ? m : mine[i];
                      const bool win = v[i][0] == m;
#pragma unroll
                      for (int kt = 0; kt < 7; ++kt) v[i][kt] = win ? v[i][kt + 1] : v[i][kt];
                      v[i][7] = win ? 0u : v[i][7]; } }
#pragma unroll
              for (int i = 0; i < 4; ++i) top[pp][i] = mine[i]; }
        }
        unsigned cd[4][4], mine2[4] = {0u, 0u, 0u, 0u}; int i0v[4], i1v[4];
#pragma unroll
        for (int i = 0; i < 4; ++i) {
            const float s0 = unordf(top[0][i] & 0xFFFFFF80u), s1 = unordf(top[1][i] & 0xFFFFFF80u);
            i0v[i] = 127 - (int)(top[0][i] & 127u); i1v[i] = 127 - (int)(top[1][i] & 127u);
#pragma unroll
            for (int k = 0; k < 4; ++k) { const float s0a = __shfl(s0, (lane & 48) | ca[k]), s1b = __shfl(s1, (lane & 48) | cb[k]);
                cd[i][k] = cv[k] ? ((ordf(s0a + s1b) & 0xFFFFFF00u) | (unsigned)(255 - (ca[k] * 16 + cb[k]))) : 0u; }
        }
#define CE_(a, b) { const unsigned hi_ = cd[i][a] > cd[i][b] ? cd[i][a] : cd[i][b], lo_ = cd[i][a] > cd[i][b] ? cd[i][b] : cd[i][a]; cd[i][a] = hi_; cd[i][b] = lo_; }
#pragma unroll
        for (int i = 0; i < 4; ++i) { CE_(0, 1) CE_(2, 3) CE_(0, 2) CE_(1, 3) CE_(1, 2) }
#undef CE_
        for (int r = 0; r < 16; ++r) {
#pragma unroll
            for (int i = 0; i < 4; ++i) { const unsigned m = row16_maxu(cd[i][0]); mine2[i] = (c == r) ? m : mine2[i];
                const bool win = cd[i][0] == m;
#pragma unroll
                for (int k = 0; k < 3; ++k) cd[i][k] = win ? cd[i][k + 1] : cd[i][k];
                cd[i][3] = win ? 0u : cd[i][3]; }
        }
#pragma unroll
        for (int i = 0; i < 4; ++i) {
            const unsigned mine = mine2[i];
            const int pr = 255 - (int)(mine & 255u); const int ea = __shfl(i0v[i], (lane & 48) | (pr >> 4)), eb = __shfl(i1v[i], (lane & 48) | (pr & 15));
            const float scv = unordf(mine & 0xFFFFFF00u);
            const float mx = row16_maxf(scv);
            const float e = __expf(scv - mx); const float sm = row16_sumf(e);
            const size_t o = (size_t)(t0 + 4 * q + i) * 128 + h * 16 + c;
            const int eid = ea * 128 + eb; EIDX[o] = eid; EW[o] = (e / sm) * VSr[eid]; EU[o] = USr[eid];
        }
    }
}
#define MFMA8(a, b, c) __builtin_amdgcn_mfma_f32_16x16x32_fp8_fp8((a), (b), (c), 0, 0, 0)
DI long lo64(const u32x4 v) { return (long)(((unsigned long long)v.y << 32) | v.x); }
DI long hi64(const u32x4 v) { return (long)(((unsigned long long)v.w << 32) | v.z); }
template <int OFF> DI void peer_dma_o(const unsigned char* src, LAS unsigned char* dst) { __builtin_amdgcn_global_load_lds((const unsigned*)src, (LAS unsigned*)(dst - OFF), 16, OFF, 0); }
#define PEER_RD(slot_) (*(const LAS u32x4*)(ring + 1024 * (slot_) + 16 * lane))
#define PEER_VMW(n_) asm volatile("s_waitcnt vmcnt(" #n_ ")" ::: "memory")
struct PeerStream { int u0, ustep, n, xfix; bool al; };
DI PeerStream peer_stream(const Frame& F) { PeerStream s; const int bx = blockIdx.x; s.al = (F.G & 7) == 0; s.u0 = s.al ? (bx >> 3) * 8 + F.wave : bx * 8 + F.wave; s.ustep = s.al ? F.G : F.G * 8;
    const int nu = s.al ? T : T * 8; s.n = (nu - s.u0 + s.ustep - 1) / s.ustep; s.xfix = bx & 7; return s; }
DI void peer_unit(const PeerStream& s, int k, int& t, int& x) { const int u = s.u0 + (k < s.n ? k : s.n - 1) * s.ustep; t = s.al ? u : u >> 3; x = s.al ? s.xfix : u & 7; }

DI void phase_peer_u(const Params& p, const Frame& F) {
    unsigned char* ws = p.ws; const int lane = F.lane, c = lane & 15, q = lane >> 4, c8 = lane & 7, r8 = lane >> 3;
    LAS unsigned char* wl = F.lds + F.wave * LDS_PERWAVE; LAS float* pdl = (LAS float*)wl; LAS unsigned char* ring = wl + 512; LAS unsigned char* meta = wl + 512 + 16384;
    const PeerStream S = peer_stream(F);
    const unsigned char* EIDX = ws + WS_EIDX; const unsigned char* H8 = ws + WS_H8; float* PD = (float*)(ws + WS_PD); const unsigned char* PTU = ws + WS_PTU;
    const int p0 = ((c >> 1) + q) & 7, p1 = (p0 + 4) & 7;
    const int rdo = 1024 * (c >> 3) + 128 * (c & 7);
    int t, x;
#define PU_META(k_, slot_) do { peer_unit(S, (k_), t, x); const unsigned char* s_ = lane < 32 ? EIDX + (size_t)t * 512 + 16 * lane : H8 + (size_t)t * 1024 + 128 * x + 16 * (lane & 7); peer_dma_o<0>(s_, meta + 1024 * (slot_)); } while (0)
#define PU_RD(g_, pc_) (*(const LAS u32x4*)(ring + 2048 * (g_) + rdo + 16 * (pc_)))
    PU_META(0, 0); PU_META(1, 1);
    asm volatile("s_waitcnt vmcnt(0)" ::: "memory");
    u32x4 in_[4], hc0, hc1, hn0, hn1;
    { u32x4 i0_[4];
#pragma unroll
      for (int v_ = 0; v_ < 4; ++v_) i0_[v_] = *(const LAS u32x4*)(meta + 64 * r8 + 16 * v_);
      hn0 = *(const LAS u32x4*)(meta + 512 + 16 * p0); hn1 = *(const LAS u32x4*)(meta + 512 + 16 * p1);
      peer_unit(S, 0, t, x); const unsigned char* tb = PTU + (size_t)x * PT_SLICE + 16 * c8;
#define PU_D0(j) peer_dma_o<0>(tb + (size_t)i0_[(j) >> 2][(j) & 3] * 128, ring + 1024 * (j))
      PU_D0(0); PU_D0(1); PU_D0(2); PU_D0(3); PU_D0(4); PU_D0(5); PU_D0(6); PU_D0(7); PU_D0(8); PU_D0(9); PU_D0(10); PU_D0(11); PU_D0(12); PU_D0(13); PU_D0(14); PU_D0(15);
#undef PU_D0
    }
    PEER_VMW(12);
    u32x4 ra[2], rb[2];
#pragma unroll
    for (int i = 0; i < 2; ++i) { ra[i] = PU_RD(i, p0); rb[i] = PU_RD(i, p1); }
    const f32x4 z4 = {0.f, 0.f, 0.f, 0.f};
    for (int k = 0; k < S.n; ++k) {
        int tc, xc; peer_unit(S, k, tc, xc);
        hc0 = hn0; hc1 = hn1;
        { LAS unsigned char* m1 = meta + 1024 * ((k + 1) & 1);
#pragma unroll
          for (int v_ = 0; v_ < 4; ++v_) in_[v_] = *(const LAS u32x4*)(m1 + 64 * r8 + 16 * v_);
          hn0 = *(const LAS u32x4*)(m1 + 512 + 16 * p0); hn1 = *(const LAS u32x4*)(m1 + 512 + 16 * p1); }
        LDS_WAIT(); PU_META(k + 2, k & 1);
        peer_unit(S, k + 1, t, x);
        const unsigned char* tbn = PTU + (size_t)x * PT_SLICE + 16 * c8;
#define PU_GRP(g) do { if ((g) < 6) PEER_VMW(11); else PEER_VMW(10); const u32x4 na = PU_RD(((g) + 2) & 7, p0), nb = PU_RD(((g) + 2) & 7, p1); \
            f32x4 acc = MFMA8(lo64(ra[(g) & 1]), lo64(hc0), z4); acc = MFMA8(hi64(ra[(g) & 1]), hi64(hc0), acc); acc = MFMA8(lo64(rb[(g) & 1]), lo64(hc1), acc); acc = MFMA8(hi64(rb[(g) & 1]), hi64(hc1), acc); \
            asm volatile("" :: "v"(ra[(g) & 1]), "v"(rb[(g) & 1])); \
            peer_dma_o<0>(tbn + (size_t)in_[(2 * (g)) >> 2][(2 * (g)) & 3] * 128, ring + 2048 * (g)); peer_dma_o<0>(tbn + (size_t)in_[(2 * (g) + 1) >> 2][(2 * (g) + 1) & 3] * 128, ring + 2048 * (g) + 1024); \
            ra[(g) & 1] = na; rb[(g) & 1] = nb; \
            { const float d01 = (c & 1) ? acc[1] : acc[0], d23 = (c & 1) ? acc[3] : acc[2], dg = (c & 2) ? d23 : d01; if (q == (c >> 2)) pdl[16 * (c & 7) + 2 * (g) + (c >> 3)] = dg; } } while (0)
        PU_GRP(0); PU_GRP(1); PU_GRP(2); PU_GRP(3); PU_GRP(4); PU_GRP(5); PU_GRP(6); PU_GRP(7);
#undef PU_GRP
        { const u32x2 pv = *(const LAS u32x2*)(pdl + 2 * lane); *(u32x2*)(PD + ((size_t)xc * T + tc) * 128 + 2 * lane) = pv; }
    }
#undef PU_META
#undef PU_RD
    asm volatile("s_waitcnt vmcnt(0) lgkmcnt(0)" ::: "memory");
}

DI void phase_peer_coef(const Params& p, const Frame& F) {
    unsigned char* ws = p.ws; const float* PD = (const float*)(ws + WS_PD); const float* EW = (const float*)(ws + WS_EW); const float* EU = (const float*)(ws + WS_EU);
    const float* HSI = (const float*)(ws + WS_HSI); float* COEF = (float*)(ws + WS_COEF);
    const size_t NT = (size_t)F.G * 512;
    for (size_t i0 = (size_t)F.vb * 512 + F.tid; i0 < (size_t)T * 128; i0 += 4 * NT) {
        float d[4][8], ew[4], eu[4], hs[4];
#pragma unroll
        for (int r = 0; r < 4; ++r) { size_t i = i0 + r * NT; if (i >= (size_t)T * 128) i = i0; const int t = (int)(i >> 7), pp = (int)(i & 127);
#pragma unroll
            for (int x = 0; x < 8; ++x) d[r][x] = PD[((size_t)x * T + t) * 128 + pp];
            ew[r] = EW[i]; eu[r] = EU[i]; hs[r] = HSI[t]; }
#pragma unroll
        for (int r = 0; r < 4; ++r) { const size_t i = i0 + r * NT; if (i >= (size_t)T * 128) break;
            const float dot = ((d[r][0] + d[r][1]) + (d[r][2] + d[r][3])) + ((d[r][4] + d[r][5]) + (d[r][6] + d[r][7]));
            COEF[i] = ew[r] * gelu_t(dot * eu[r] * hs[r]); }
    }
}

DI void phase_peer_v(const Params& p, const Frame& F, const float* xin, float* xout, const float* gple, bool fuse) {
    unsigned char* ws = p.ws; const int lane = F.lane, c8 = lane & 7, r8 = lane >> 3;
    LAS unsigned char* wl = F.lds + F.wave * LDS_PERWAVE; LAS unsigned char* ring = wl; LAS unsigned char* meta = wl + 16384; LAS unsigned char* xs = wl + 16384 + 2048;
    const PeerStream S = peer_stream(F);
    const unsigned char* EIDX = ws + WS_EIDX; const unsigned char* COEF = ws + WS_COEF; const unsigned char* PTV = ws + WS_PTU + 16 * MiB;
    typedef float f32x2_t __attribute__((ext_vector_type(2)));
    int colofs;
    { const auto ra = __builtin_amdgcn_permlane32_swap(0u, 8u, false, false); const unsigned ta = ra[0];
      const auto rb = __builtin_amdgcn_permlane16_swap(ta, ta + 4u, false, false); const unsigned tb = rb[0];
      colofs = (int)tb + ((lane & 8) ? 2 : 0); }
    LAS float* gl = (LAS float*)(F.lds + 8 * LDS_PERWAVE);
    for (int i = F.tid; i < 1024; i += 512) gl[i] = gple[i];
    __syncthreads();
    bf16_t* Hn = (bf16_t*)(ws + WS_H); float* SSQ = (float*)(ws + WS_SSQ);
    int t, x;
#define PV_META(k_, slot_) do { peer_unit(S, (k_), t, x); const unsigned char* s_ = (lane < 32 ? EIDX : COEF) + (size_t)t * 512 + 16 * (lane & 31); peer_dma_o<0>(s_, meta + 1024 * (slot_)); } while (0)
#define PV_XS(k_, slot_) do { peer_unit(S, (k_), t, x); if (lane < 32) peer_dma_o<0>((const unsigned char*)(xin + (size_t)t * 1024 + 128 * x) + 16 * lane, xs + 512 * (slot_)); } while (0)
    PV_META(0, 0); PV_META(1, 1); PV_XS(0, 0);
    asm volatile("s_waitcnt vmcnt(0)" ::: "memory");
    u32x4 in_[4]; f32x4 cf[4], cn[4];
    { u32x4 i0_[4];
#pragma unroll
      for (int v_ = 0; v_ < 4; ++v_) { i0_[v_] = *(const LAS u32x4*)(meta + 64 * r8 + 16 * v_); cn[v_] = *(const LAS f32x4*)(meta + 512 + 64 * r8 + 16 * v_); }
      peer_unit(S, 0, t, x); const unsigned char* tb = PTV + (size_t)x * PT_SLICE + 16 * c8;
#define PV_D0(j) peer_dma_o<0>(tb + (size_t)i0_[(j) >> 2][(j) & 3] * 128, ring + 1024 * (j))
      PV_D0(0); PV_D0(1); PV_D0(2); PV_D0(3); PV_D0(4); PV_D0(5); PV_D0(6); PV_D0(7); PV_D0(8); PV_D0(9); PV_D0(10); PV_D0(11); PV_D0(12); PV_D0(13); PV_D0(14); PV_D0(15);
#undef PV_D0
    }
    PEER_VMW(12);
    u32x4 rr[4];
#pragma unroll
    for (int i = 0; i < 4; ++i) rr[i] = PEER_RD(i);
    for (int k = 0; k < S.n; ++k) {
        int tc, xc; peer_unit(S, k, tc, xc);
#pragma unroll
        for (int v_ = 0; v_ < 4; ++v_) cf[v_] = cn[v_];
        { LAS unsigned char* m1 = meta + 1024 * ((k + 1) & 1);
#pragma unroll
          for (int v_ = 0; v_ < 4; ++v_) { in_[v_] = *(const LAS u32x4*)(m1 + 64 * r8 + 16 * v_); cn[v_] = *(const LAS f32x4*)(m1 + 512 + 64 * r8 + 16 * v_); } }
        LDS_WAIT(); PV_META(k + 2, k & 1);
        PV_XS(k + 1, (k + 1) & 1);
        peer_unit(S, k + 1, t, x);
        const unsigned char* tbn = PTV + (size_t)x * PT_SLICE + 16 * c8;
        f32x2_t out[8];
#pragma unroll
        for (int e = 0; e < 8; ++e) out[e] = (f32x2_t){0.f, 0.f};
#define PV_STEP(j) do { if ((j) < 12) PEER_VMW(13); else PEER_VMW(11); const u32x4 nw = PEER_RD(((j) + 4) & 15); \
            const u32x4 pv_ = rr[(j) & 3]; const float c1_ = cf[(j) >> 2][(j) & 3]; const f32x2_t cc = {c1_, c1_}; \
            out[0] += cc * __builtin_amdgcn_cvt_pk_f32_fp8((int)pv_.x, false); out[1] += cc * __builtin_amdgcn_cvt_pk_f32_fp8((int)pv_.x, true); \
            out[2] += cc * __builtin_amdgcn_cvt_pk_f32_fp8((int)pv_.y, false); out[3] += cc * __builtin_amdgcn_cvt_pk_f32_fp8((int)pv_.y, true); \
            out[4] += cc * __builtin_amdgcn_cvt_pk_f32_fp8((int)pv_.z, false); out[5] += cc * __builtin_amdgcn_cvt_pk_f32_fp8((int)pv_.z, true); \
            out[6] += cc * __builtin_amdgcn_cvt_pk_f32_fp8((int)pv_.w, false); out[7] += cc * __builtin_amdgcn_cvt_pk_f32_fp8((int)pv_.w, true); \
            asm volatile("" :: "v"(rr[(j) & 3])); \
            peer_dma_o<0>(tbn + (size_t)in_[(j) >> 2][(j) & 3] * 128, ring + 1024 * (j)); rr[(j) & 3] = nw; } while (0)
        PV_STEP(0); PV_STEP(1); PV_STEP(2); PV_STEP(3); PV_STEP(4); PV_STEP(5); PV_STEP(6); PV_STEP(7);
        PV_STEP(8); PV_STEP(9); PV_STEP(10); PV_STEP(11); PV_STEP(12); PV_STEP(13); PV_STEP(14); PV_STEP(15);
#undef PV_STEP
        float n8[8], n4[4], f2[2];
#pragma unroll
        for (int i = 0; i < 8; ++i) { const float a_ = (i & 1) ? out[i >> 1].y : out[i >> 1].x, b_ = (i & 1) ? out[4 + (i >> 1)].y : out[4 + (i >> 1)].x;
            const auto r_ = __builtin_amdgcn_permlane32_swap(__float_as_uint(a_), __float_as_uint(b_), false, false); n8[i] = __uint_as_float(r_[0]) + __uint_as_float(r_[1]); }
#pragma unroll
        for (int i = 0; i < 4; ++i) { const auto r_ = __builtin_amdgcn_permlane16_swap(__float_as_uint(n8[i]), __float_as_uint(n8[4 + i]), false, false); n4[i] = __uint_as_float(r_[0]) + __uint_as_float(r_[1]); }
#pragma unroll
        for (int i = 0; i < 2; ++i) { const bool hi8 = (lane & 8) != 0; const float keep = hi8 ? n4[2 + i] : n4[i], send = hi8 ? n4[i] : n4[2 + i];
            f2[i] = keep + __builtin_bit_cast(float, DPP_I(__builtin_bit_cast(int, send), 0x128)); }
        { const f32x2_t xv = *(const LAS f32x2_t*)(xs + 512 * (k & 1) + 4 * (16 * c8 + colofs));
          const f32x2_t o = {xv.x + f2[0], xv.y + f2[1]}; *(f32x2_t*)(xout + (size_t)tc * 1024 + 128 * xc + 16 * c8 + colofs) = o;
          if (fuse) { const f32x2_t gg = *(const LAS f32x2_t*)(gl + 128 * xc + 16 * c8 + colofs);
              *(unsigned*)(Hn + (size_t)tc * 1024 + 128 * xc + 16 * c8 + colofs) = pk2(o.x * gg.x, o.y * gg.y);
              const float ss = wave_sum(o.x * o.x + o.y * o.y); if (lane == 0) SSQ[(size_t)tc * 8 + xc] = ss; } }
    }
#undef PV_META
#undef PV_XS
    asm volatile("s_waitcnt vmcnt(0) lgkmcnt(0)" ::: "memory");
}
#undef PEER_RD
#undef PEER_VMW

#ifndef MK_MASK
#define MK_MASK 0xffff
#endif
__global__ void __launch_bounds__(512, 2) mega(Params p) {
    extern __shared__ __attribute__((aligned(16))) unsigned char lds_raw[];
#define MKFRAME() Frame F; { int t_ = threadIdx.x; asm volatile("" : "+v"(t_)); F.lds = (LAS unsigned char*)lds_raw; F.tid = t_; F.lane = t_ & 63; F.wave = __builtin_amdgcn_readfirstlane(t_ >> 6); \
        F.G = gridDim.x; const int bx = blockIdx.x; F.vb = (F.G % 8 == 0) ? (bx % 8) * (F.G / 8) + bx / 8 : bx; }
    if (threadIdx.x < 16) ((LAS unsigned*)((LAS unsigned char*)lds_raw + LDS_XB))[threadIdx.x] = 0u;
    __syncthreads();
    const int lo = p.ph_lo, hi = p.ph_hi;
    XcdBarrier bar; bar.bar = (unsigned*)(p.ws + WS_CTL) + 4096; bar.x = 0; bar.st = (volatile LAS unsigned*)((LAS unsigned char*)lds_raw + LDS_XB);
    if (hi - lo > 1) bar = xcd_barrier_post((unsigned*)(p.ws + WS_CTL) + 4096, (volatile LAS unsigned*)((LAS unsigned char*)lds_raw + LDS_XB));
#define WSP(ws) unsigned char* ws = p.ws; asm volatile("" : "+s"(ws))
    for (int l = 0; l < NLAYER; ++l) {
        const int pb = l * NPH;
#define IN(k) (((MK_MASK >> (k)) & 1) && lo <= pb + (k) && pb + (k) < hi)
#if MK_PROBE == 120
#define SEAM(k) do { if (((MK_MASK >> (k)) & 1) && lo <= pb + (k) && pb + (k) + 1 < hi) { xcd_barrier(bar); xcd_barrier(bar); xcd_barrier(bar); } } while (0)
#else
#define SEAM(k) do { if (((MK_MASK >> (k)) & 1) && lo <= pb + (k) && pb + (k) + 1 < hi) xcd_barrier(bar); } while (0)
#endif
        if (IN(0)) { MKFRAME(); phase_prep_w(p, l, F); }
        SEAM(0);
#if MK_PROBE == 100
        if (IN(0)) { MKFRAME(); phase_prep_w(p, l, F); } xcd_barrier(bar);
#endif
        if (IN(1)) { MKFRAME(); WSP(ws); pg8::Gemm g{(const bf16_t*)(ws + WS_H), (const bf16_t*)(ws + WS_WCAT), T, 9216, 1024}; XcdColOrder S{F.G, (int)blockIdx.x};
            Epi1 E{(bf16_t*)(ws + WS_PROJ), (bf16_t*)(ws + WS_GATES)};
            pg8::gemm_phase<Epi1, XcdColOrder, false>(F.lds, g, S, E, nullptr); }
        SEAM(1);
#if MK_PROBE == 104
        if (IN(1)) { for (int rr = 0; rr < 18; ++rr) { MKFRAME(); WSP(ws); pg8::Gemm g{(const bf16_t*)(ws + WS_H), (const bf16_t*)(ws + WS_WCAT), T, 9216, 1024}; RoundOrder S; S.base.init(T, 9216, F.G, (int)blockIdx.x); S.r = rr;
            Epi1 E{(bf16_t*)(ws + WS_PROJ), (bf16_t*)(ws + WS_GATES)};
            pg8::gemm_phase<Epi1, RoundOrder, false>(F.lds, g, S, E, nullptr); xcd_barrier(bar); } }
#endif
#if MK_PROBE == 101 || MK_PROBE == 102 || MK_PROBE == 103
        if (IN(1)) { MKFRAME(); WSP(ws); pg8::Gemm g{(const bf16_t*)(ws + WS_H), (const bf16_t*)(ws + WS_WCAT), T, 9216, 1024}; ColRangeOrder S{F.G, (int)blockIdx.x, MK_PROBE == 103 ? 20 : 0, MK_PROBE == 102 ? 20 : 36};
            Epi1 E{(bf16_t*)(ws + WS_PROJ), (bf16_t*)(ws + WS_GATES)};
            pg8::gemm_phase<Epi1, ColRangeOrder, false>(F.lds, g, S, E, nullptr); } xcd_barrier(bar);
#endif
        if (IN(2)) { MKFRAME(); phase_chunk(p, l, F); }
        SEAM(2);
#if MK_PROBE == 140
        if (IN(2)) { MKFRAME(); phase_chunk(p, l, F); xcd_barrier(bar); }
#endif
        if (IN(3)) { MKFRAME(); WSP(ws);
            { pg8::Gemm g{(const bf16_t*)(ws + WS_CMPA), (const bf16_t*)(ws + WS_W1C), 4096, 512, 1024}; pg8::StaticOrder S; S.init(4096, 512, F.G, (int)blockIdx.x); EpiF32P E{(float*)(ws + WS_CMPP), 512};
              pg8::gemm_phase<EpiF32P, pg8::StaticOrder, false>(F.lds, g, S, E, nullptr); }
        }
        if (IN(3)) { MKFRAME(); WSP(ws);
            { pg8::Gemm g{(const bf16_t*)(ws + WS_CMPA) + (size_t)4096 * 1024, (const bf16_t*)(ws + WS_W1C) + (size_t)512 * 1024, 4096, 512, 1024}; pg8::StaticOrder S; S.init(4096, 512, F.G, (int)((blockIdx.x + F.G / 2) % F.G));
              EpiF32P E{(float*)(ws + WS_CMPP) + (size_t)4096 * 512, 512};
              pg8::gemm_phase<EpiF32P, pg8::StaticOrder, false>(F.lds, g, S, E, nullptr); }
        }
        SEAM(3);
        if (IN(4)) { MKFRAME(); phase_cmp2(p, l, F); }
        SEAM(4);
#if MK_PROBE == 141
        if (IN(4)) { MKFRAME(); phase_cmp2(p, l, F); xcd_barrier(bar); }
#endif
        if (IN(5)) { MKFRAME(); phase_attn(p, l, F, 3, 15); }
        SEAM(5);
#if MK_PROBE == 5 || MK_PROBE == 50 || MK_PROBE == 51 || MK_PROBE == 52 || MK_PROBE == 53
        if (IN(5)) { MKFRAME(); phase_attn(p, l, F, MK_PROBE == 5 ? 3 : (MK_PROBE == 50 ? 1 : 2), MK_PROBE == 52 ? 1 : (MK_PROBE == 53 ? 3 : 15)); xcd_barrier(bar); }
#endif
#if MK_PROBE >= 60 && MK_PROBE < 76
        if (IN(5)) { MKFRAME(); phase_attn(p, l, F, 1, (MK_PROBE - 60) << 8); xcd_barrier(bar); }
#endif
        if (IN(6)) { MKFRAME(); WSP(ws); pg8::Gemm g{(const bf16_t*)(ws + WS_Y), (const bf16_t*)(ws + WS_WBR), 4 * T, 4096, 512}; BranchOrder S{F.G, (int)blockIdx.x};
            EpiBranch E{(const bf16_t*)(ws + WS_GATES), (bf16_t*)(ws + WS_MERGED)};
            pg8::gemm_phase<EpiBranch, BranchOrder, false>(F.lds, g, S, E, nullptr); }
        SEAM(6);
#if MK_PROBE == 106
        if (IN(6)) { MKFRAME(); WSP(ws); pg8::Gemm g{(const bf16_t*)(ws + WS_Y), (const bf16_t*)(ws + WS_WBR), 4 * T, 4096, 512}; BranchOrder S{F.G, (int)blockIdx.x};
            EpiBranch E{(const bf16_t*)(ws + WS_GATES), (bf16_t*)(ws + WS_MERGED)};
            pg8::gemm_phase<EpiBranch, BranchOrder, false>(F.lds, g, S, E, nullptr); } xcd_barrier(bar);
#endif
        if (IN(7)) { MKFRAME(); WSP(ws); pg8::Gemm g{(const bf16_t*)(ws + WS_MERGED), (const bf16_t*)(ws + WS_WOUT4), T, 1024, 1024}; pg8::StaticOrder S; S.init(T, 1024, F.G, (int)blockIdx.x);
            EpiRes E{l == 0 ? p.in[I_X] : p.out, p.out};
            pg8::gemm_phase<EpiRes, pg8::StaticOrder, false>(F.lds, g, S, E, nullptr); }
        SEAM(7);
        if (IN(8)) { MKFRAME(); WSP(ws); rmsnorm_rows(p.out, p.in[I_GFFN] + l * 1024, (bf16_t*)(ws + WS_H), F.vb * 8 + F.wave, F.G * 8, F.lane, ws + WS_H8, (float*)(ws + WS_HSI)); }
        SEAM(8);
#if MK_PROBE == 108
        if (IN(8)) { MKFRAME(); WSP(ws); rmsnorm_rows(p.out, p.in[I_GFFN] + l * 1024, (bf16_t*)(ws + WS_H), F.vb * 8 + F.wave, F.G * 8, F.lane); } xcd_barrier(bar);
#endif
        if (IN(9)) { MKFRAME(); WSP(ws);
            { pg8::Gemm g{(const bf16_t*)(ws + WS_H), (const bf16_t*)(ws + WS_WQ), T, 1024, 1024}; pg8::StaticOrder S; S.init(T, 1024, F.G, (int)blockIdx.x); EpiBf E{(bf16_t*)(ws + WS_QP), 1024};
              pg8::gemm_phase<EpiBf, pg8::StaticOrder, false>(F.lds, g, S, E, nullptr); }
        }
        if (IN(9)) { MKFRAME(); WSP(ws);
            { pg8::Gemm g{(const bf16_t*)(ws + WS_PB), (const bf16_t*)(ws + WS_WPP), T, 1024, 256}; pg8::StaticOrder S; S.init(T, 1024, F.G, (int)blockIdx.x); EpiBf E{(bf16_t*)(ws + WS_PP), 1024};
              pg8::gemm_phase<EpiBf, pg8::StaticOrder, false>(F.lds, g, S, E, nullptr); }
        }
        SEAM(9);
#if MK_PROBE == 110
        if (IN(9)) { for (int rep = 0; rep < 9; ++rep) { MKFRAME(); WSP(ws);
            { pg8::Gemm g{(const bf16_t*)(ws + WS_H), (const bf16_t*)(ws + WS_WQ), T, 1024, 1024}; pg8::StaticOrder S; S.init(T, 1024, F.G, (int)blockIdx.x); EpiBf E{(bf16_t*)(ws + WS_QP), 1024};
              pg8::gemm_phase<EpiBf, pg8::StaticOrder, false>(F.lds, g, S, E, nullptr); } } xcd_barrier(bar); }
#endif
#if MK_PROBE == 109
        if (IN(9)) { MKFRAME(); WSP(ws);
            { pg8::Gemm g{(const bf16_t*)(ws + WS_H), (const bf16_t*)(ws + WS_WQ), T, 1024, 1024}; pg8::StaticOrder S; S.init(T, 1024, F.G, (int)blockIdx.x); EpiBf E{(bf16_t*)(ws + WS_QP), 1024};
              pg8::gemm_phase<EpiBf, pg8::StaticOrder, false>(F.lds, g, S, E, nullptr); } }
        if (IN(9)) { MKFRAME(); WSP(ws);
            { pg8::Gemm g{(const bf16_t*)(ws + WS_PB), (const bf16_t*)(ws + WS_WPP), T, 1024, 256}; pg8::StaticOrder S; S.init(T, 1024, F.G, (int)blockIdx.x); EpiBf E{(bf16_t*)(ws + WS_PP), 1024};
              pg8::gemm_phase<EpiBf, pg8::StaticOrder, false>(F.lds, g, S, E, nullptr); } }
        xcd_barrier(bar);
#endif
        if (IN(10)) { MKFRAME(); for (int tile = F.vb * 8 + F.wave; tile < T / 16; tile += F.G * 8) peer_route_tile(p, tile * 16, F.lane); }
        SEAM(10);
        if (IN(11)) { MKFRAME(); phase_peer_u(p, F); }
        SEAM(11);
        if (IN(12)) { MKFRAME(); phase_peer_coef(p, F); }
        SEAM(12);
        if (IN(13)) { MKFRAME(); phase_peer_v(p, F, p.out, p.out, p.in[I_GPLE] + l * 1024, true); }
        SEAM(13);
#if MK_PROBE == 130
        if (IN(13)) { MKFRAME(); phase_peer_u(p, F); xcd_barrier(bar); }
#endif
#if MK_PROBE == 131
        if (IN(13)) { MKFRAME(); phase_peer_coef(p, F); xcd_barrier(bar); }
#endif
#if MK_PROBE == 132
        if (IN(13)) { MKFRAME(); phase_peer_v(p, F, p.out, (float*)(p.ws + WS_Y), p.in[I_GPLE] + l * 1024, false); xcd_barrier(bar); }
#endif
#if MK_PROBE == 133
        if (IN(13)) { MKFRAME(); for (int tile = F.vb * 8 + F.wave; tile < T / 16; tile += F.G * 8) peer_route_tile(p, tile * 16, F.lane); xcd_barrier(bar); }
#endif
        if (IN(15)) { MKFRAME(); WSP(ws); pg8::Gemm g{(const bf16_t*)(ws + WS_H), (const bf16_t*)(ws + WS_WPG), T, 1024, 1024}; pg8::StaticOrder S; S.init(T, 1024, F.G, (int)blockIdx.x);
            EpiPle E{p.out, (const bf16_t*)(ws + WS_PP), (const float*)(ws + WS_SSQ)};
            pg8::gemm_phase<EpiPle, pg8::StaticOrder, false>(F.lds, g, S, E, nullptr); }
        SEAM(15);
#undef IN
#undef SEAM
    }
}
}

#ifndef MK_LAUNCH_PER_PHASE
#define MK_LAUNCH_PER_PHASE 0
#endif
extern "C" void kernel_launch(void* const* d_in, const int* in_sizes, int n_in, void* d_out, int out_size, void* d_ws, size_t ws_size, hipStream_t stream) {
    static int grid = 0;
    if (grid == 0) {
        if (n_in != 27 || ws_size < mk::WS_END) { fprintf(stderr, "kernel_launch: need 27 inputs and >= %zu bytes of workspace (got %d, %zu)\n", (size_t)mk::WS_END, n_in, ws_size); grid = -1; return; }
        int dev = 0, cus = 0;
        if (hipGetDevice(&dev) != hipSuccess || hipDeviceGetAttribute(&cus, hipDeviceAttributeMultiprocessorCount, dev) != hipSuccess) { grid = -1; return; }
        if (hipFuncSetAttribute((const void*)mk::mega, hipFuncAttributeMaxDynamicSharedMemorySize, mk::LDS_BYTES) != hipSuccess) { fprintf(stderr, "kernel_launch: hipFuncSetAttribute failed\n"); grid = -1; return; }
        int per_cu = 0;
        if (hipOccupancyMaxActiveBlocksPerMultiprocessor(&per_cu, (const void*)mk::mega, 512, mk::LDS_BYTES) != hipSuccess || per_cu < 1) fprintf(stderr, "kernel_launch: occupancy query says %d\n", per_cu);
        (void)hipGetLastError();
        grid = cus;
    }
    if (grid < 0) return;
    (void)in_sizes; (void)out_size;
    hipMemsetAsync((char*)d_ws + mk::WS_CTL, 0, 1u << 20, stream);
    mk::Params prm{};
    for (int i = 0; i < 27; ++i) prm.in[i] = (const float*)d_in[i];
    prm.out = (float*)d_out; prm.ws = (unsigned char*)d_ws;
#if MK_LAUNCH_PER_PHASE
    for (int ph = 0; ph < mk::NLAYER * mk::NPH; ++ph) { prm.ph_lo = ph; prm.ph_hi = ph + 1; hipLaunchKernelGGL(mk::mega, dim3(grid), dim3(512), mk::LDS_BYTES, stream, prm); }
#else
    prm.ph_lo = 0; prm.ph_hi = mk::NLAYER * mk::NPH; hipLaunchKernelGGL(mk::mega, dim3(grid), dim3(512), mk::LDS_BYTES, stream, prm);
#endif
}
```

```cpp
#include <hip/hip_runtime.h>
#include <stdio.h>
#include <stdint.h>
namespace pg8 {
#define PG8_LAS __attribute__((address_space(3)))
typedef unsigned short bf16_t;
typedef short bf16x8 __attribute__((ext_vector_type(8)));
typedef float f32x4 __attribute__((ext_vector_type(4)));
typedef unsigned u32x4 __attribute__((ext_vector_type(4)));
constexpr int BM = 256, BK = 64, HALF = 128, HTB = HALF * BK * 2  , STAGE_BYTES = 8 * HTB, NXCD = 8, WGM = 8;

__host__ __device__ __forceinline__ int lds_byte(int r, int c) { const int st = (r >> 4) * 2 + (c >> 5), rr = r & 15, cc = c & 31, ob = rr * 64 + cc * 2; return st * 1024 + (ob ^ (((ob >> 9) & 1) << 5)); }
__host__ __device__ __forceinline__ void stage_rc(int b, int& R, int& C) { const int st = b / 1024, sb = b % 1024, swz = sb ^ (((sb >> 9) & 1) << 5); R = (st >> 1) * 16 + swz / 64; C = (st & 1) * 32 + (swz % 64) / 2; }
__host__ __device__ __forceinline__ int perm32(int rho) { const int n = rho >> 4, i = rho & 15; return 8 * (i >> 2) + 4 * n + (i & 3); }

struct Unit { int pm, pn; };
struct Gemm { const bf16_t* A; const bf16_t* Bt; int M, N, K; };

struct StaticOrder {
    int nM, nN, nwg, G, c;
    __host__ __device__ void init(int M, int N, int G_, int c_) { nM = M / BM; nN = N / BM; nwg = nM * nN; G = G_; c = c_; }
    __host__ __device__ bool next(int i, Unit& u) const {
        const long L = (long)i * G + c; if (L >= nwg) return false;
        int wgid = (int)L; { const int q = nwg / NXCD, r = nwg % NXCD, xcd = wgid % NXCD, off = wgid / NXCD; wgid = (xcd < r ? xcd * (q + 1) : r * (q + 1) + (xcd - r) * q) + off; }
        const int nig = WGM * nN, gid = wgid / nig, fm = gid * WGM, gsz = (nM - fm) < WGM ? (nM - fm) : WGM;
        u.pm = fm + ((wgid % nig) % gsz); u.pn = (wgid % nig) / gsz; return true;
    }
    __device__ __forceinline__ void a_ready(const Unit&) const {}
    __device__ __forceinline__ void done(const Unit&) const {}
};
__device__ __forceinline__ unsigned cvt_pk_bf16(float lo, float hi) { unsigned r; asm volatile("v_cvt_pk_bf16_f32 %0, %1, %2" : "=v"(r) : "v"(lo), "v"(hi)); return r; }
template <class Epi, class Sched, bool STAMP = false>
__device__ __forceinline__ void gemm_phase(PG8_LAS unsigned char* lds, const Gemm g, const Sched& S, const Epi& E, unsigned long long* stamps) {
    int tid_l = threadIdx.x; asm volatile("" : "+v"(tid_l));
    const int tid = tid_l, wid = __builtin_amdgcn_readfirstlane(tid >> 6), lane = tid & 63, wr = wid >> 2, wc = wid & 3, fr = lane & 15, fq = lane >> 4;
    const int K = g.K, nt = K / BK;
    int ts_lo = 0, ts_hi = 0, nts = 0; const unsigned long long rt_entry = STAMP ? (unsigned long long)wall_clock64() : 0ull;
#define PG8_STAMP() do { if (STAMP && wid == 0 && nts < 64) { const unsigned long long _c = (unsigned long long)clock64(); \
        ts_lo = (lane == nts) ? (int)(unsigned)_c : ts_lo; ts_hi = (lane == nts) ? (int)(unsigned)(_c >> 32) : ts_hi; ++nts; } } while (0)
    PG8_STAMP();
    unsigned voffA[2], voffB[2];
#pragma unroll
    for (int i = 0; i < 2; ++i) { int R, C; stage_rc(tid * 16 + i * 8192, R, C); const int Rb = Epi::PERM ? ((R & ~31) + perm32(R & 31)) : R;
        voffA[i] = (unsigned)(R * K + C) * 2u; voffB[i] = (unsigned)(Rb * K + C) * 2u; }
    const size_t kstep = (size_t)(BK * 2);
    const size_t hstep = (size_t)HALF * K * 2;
    const size_t tstep = 2 * hstep;
    const unsigned ldsw = (unsigned)wid * 1024u;
    const int aoff = lds_byte(wr * 64 + fr, fq * 8), boff = lds_byte(wc * 32 + fr, fq * 8);
#define PG8_SA(b, h) (((b) * 2 + (h)) * HTB)
#define PG8_SB(b, h) ((4 + (b) * 2 + (h)) * HTB)
#define PG8_STAGE(bufoff, gbase, voff) do { _Pragma("unroll") for (int _i = 0; _i < 2; ++_i) \
        __builtin_amdgcn_global_load_lds((const unsigned*)((const char*)(gbase) + (voff)[_i]), (PG8_LAS unsigned*)(lds + (bufoff) + ldsw + _i * 8192), 16, 0, 0); } while (0)
#define PG8_LDA(dst, b, h) do { _Pragma("unroll") for (int m = 0; m < 4; ++m) _Pragma("unroll") for (int k = 0; k < 2; ++k) dst[m][k] = *(const PG8_LAS bf16x8*)(lds + PG8_SA(b, h) + aoff + m * 2048 + k * 1024); } while (0)
#define PG8_LDB(dst, b, h) do { _Pragma("unroll") for (int n = 0; n < 2; ++n) _Pragma("unroll") for (int k = 0; k < 2; ++k) dst[n][k] = *(const PG8_LAS bf16x8*)(lds + PG8_SB(b, h) + boff + n * 2048 + k * 1024); } while (0)
#define PG8_MMA(ai, bj, At, Bt) do { __builtin_amdgcn_s_setprio(1); _Pragma("unroll") for (int m = 0; m < 4; ++m) _Pragma("unroll") for (int n = 0; n < 2; ++n) _Pragma("unroll") for (int k = 0; k < 2; ++k) \
        acc[ai][bj][m][n] = __builtin_amdgcn_mfma_f32_16x16x32_bf16(Bt[n][k], At[m][k], acc[ai][bj][m][n], 0, 0, 0); __builtin_amdgcn_s_setprio(0); } while (0)
#define PG8_WAIT_V(n) asm volatile("s_waitcnt vmcnt(" #n ")" ::: "memory")
#define PG8_WAIT_L(n) asm volatile("s_waitcnt lgkmcnt(" #n ")" ::: "memory")
#define PG8_BAR __builtin_amdgcn_s_barrier()
#define PG8_SCHED __builtin_amdgcn_sched_barrier(0)
    Unit cur, nxt; int ui = 0;
    if (!S.next(0, cur)) return;
    f32x4 acc[2][2][4][2];
#pragma unroll
    for (int a = 0; a < 2; ++a)
#pragma unroll
        for (int b = 0; b < 2; ++b)
#pragma unroll
            for (int m = 0; m < 4; ++m)
#pragma unroll
                for (int n = 0; n < 2; ++n) acc[a][b][m][n] = (f32x4){0.f, 0.f, 0.f, 0.f};
    bf16x8 At[4][2], B0[2][2], B1[2][2];
    const char* cA = (const char*)g.A + (size_t)cur.pm * tstep; const char* cB = (const char*)g.Bt + (size_t)cur.pn * tstep;
    S.a_ready(cur);
    PG8_STAGE(PG8_SB(0, 0), cB, voffB); PG8_STAGE(PG8_SA(0, 0), cA, voffA); PG8_STAGE(PG8_SB(0, 1), cB + hstep, voffB); PG8_STAGE(PG8_SA(0, 1), cA + hstep, voffA);
    if (wr == 1) PG8_BAR;
    PG8_WAIT_V(4); PG8_BAR;
    PG8_STAGE(PG8_SB(1, 0), cB + kstep, voffB); PG8_STAGE(PG8_SA(1, 0), cA + kstep, voffA); PG8_STAGE(PG8_SB(1, 1), cB + hstep + kstep, voffB);
    PG8_WAIT_V(6); PG8_BAR;
    PG8_STAMP();
    for (;;) {
        const bool has_next = S.next(ui + 1, nxt);
        const char* nA = has_next ? (const char*)g.A + (size_t)nxt.pm * tstep : cA; const char* nB = has_next ? (const char*)g.Bt + (size_t)nxt.pn * tstep : cB;
        for (int t = 0; t < nt; t += 2) {
            const bool last = (t == nt - 2);
            const char* a1 = cA + (size_t)(t + 1) * kstep;
            const char* a2 = last ? nA : cA + (size_t)(t + 2) * kstep; const char* b2 = last ? nB : cB + (size_t)(t + 2) * kstep;
            const char* a3 = a2 + kstep; const char* b3 = b2 + kstep;
            if (last && has_next) S.a_ready(nxt);
            PG8_LDB(B0, 0, 0); PG8_SCHED; PG8_LDA(At, 0, 0); PG8_STAGE(PG8_SA(1, 1), a1 + hstep, voffA);
            PG8_WAIT_L(8); PG8_BAR; PG8_WAIT_L(0); PG8_MMA(0, 0, At, B0); PG8_BAR; PG8_SCHED;
            PG8_LDB(B1, 0, 1); PG8_STAGE(PG8_SB(0, 0), b2, voffB);
            PG8_BAR; PG8_WAIT_L(0); PG8_MMA(0, 1, At, B1); PG8_BAR;
            PG8_LDA(At, 0, 1); PG8_STAGE(PG8_SA(0, 0), a2, voffA);
            PG8_BAR; PG8_WAIT_L(0); PG8_MMA(1, 0, At, B0); PG8_BAR; PG8_SCHED;
            PG8_STAGE(PG8_SB(0, 1), b2 + hstep, voffB);
            PG8_WAIT_V(6); PG8_BAR; PG8_MMA(1, 1, At, B1); PG8_BAR;
            PG8_LDB(B0, 1, 0); PG8_SCHED; PG8_LDA(At, 1, 0); PG8_STAGE(PG8_SA(0, 1), a2 + hstep, voffA);
            PG8_WAIT_L(8); PG8_BAR; PG8_WAIT_L(0); PG8_MMA(0, 0, At, B0); PG8_BAR; PG8_SCHED;
            PG8_LDB(B1, 1, 1); PG8_STAGE(PG8_SB(1, 0), b3, voffB);
            PG8_BAR; PG8_WAIT_L(0); PG8_MMA(0, 1, At, B1); PG8_BAR;
            PG8_LDA(At, 1, 1); PG8_STAGE(PG8_SA(1, 0), a3, voffA);
            PG8_BAR; PG8_WAIT_L(0); PG8_MMA(1, 0, At, B0); PG8_BAR; PG8_SCHED;
            PG8_STAGE(PG8_SB(1, 1), b3 + hstep, voffB);
            PG8_WAIT_V(6); PG8_BAR; PG8_MMA(1, 1, At, B1); PG8_BAR;
        }
        PG8_STAMP();
        if constexpr (!Epi::AFTER_DRAIN) { E(acc, cur, wr, wc, fr, fq); S.done(cur); }
        PG8_STAMP();
        if (!has_next) break;
#pragma unroll
        for (int a = 0; a < 2; ++a)
#pragma unroll
            for (int b = 0; b < 2; ++b)
#pragma unroll
                for (int m = 0; m < 4; ++m)
#pragma unroll
                    for (int n = 0; n < 2; ++n) acc[a][b][m][n] = (f32x4){0.f, 0.f, 0.f, 0.f};
        cur = nxt; cA = nA; cB = nB; ++ui;
    }
    PG8_WAIT_V(0);
    if (wr == 0) PG8_BAR;
    PG8_BAR;
    if constexpr (Epi::AFTER_DRAIN) { E.fused(acc, cur, wr, wc, fr, fq, lds, wid, lane); S.done(cur); }
    PG8_STAMP();
    if (STAMP && wid == 0) { stamps[lane] = lane < nts ? (((unsigned long long)(unsigned)ts_hi << 32) | (unsigned)ts_lo) : 0ull;
        if (lane == 62) stamps[62] = rt_entry; if (lane == 63) stamps[63] = (unsigned long long)wall_clock64(); }
#undef PG8_STAMP
#undef PG8_SA
#undef PG8_SB
#undef PG8_STAGE
#undef PG8_LDA
#undef PG8_LDB
#undef PG8_MMA
#undef PG8_WAIT_V
#undef PG8_WAIT_L
#undef PG8_BAR
#undef PG8_SCHED
}
}
#define XB_TMO      128
#define XB_XCNT(j)  (256  + 64 * (j))
#define XB_XSUB(j)  (1280 + 64 * (j))
#define XB_XGEN(j)  (2304 + 64 * (j))
#define XB_TOP      3328
#define XB_TOPGEN   3392
#define XCD_BAR_WORDS 3456
#define XB_SPIN_CAP (1u << 18)
#define LAS __attribute__((address_space(3)))

__device__ __forceinline__ unsigned xb_ld(unsigned* p)              { return __hip_atomic_load(p, __ATOMIC_RELAXED, __HIP_MEMORY_SCOPE_AGENT); }
__device__ __forceinline__ unsigned xb_add(unsigned* p, unsigned v) { return __hip_atomic_fetch_add(p, v, __ATOMIC_RELAXED, __HIP_MEMORY_SCOPE_AGENT); }
__device__ __forceinline__ unsigned xb_xcc_id() { return (unsigned)__builtin_amdgcn_s_getreg((3 << 11) | 20) & 0xFu; }
#define XB_SPIN(cond, bar) do { unsigned _sp = 0; while (cond) { __builtin_amdgcn_s_sleep(1); \
    if ((++_sp & 255u) == 0u) { if (xb_ld(&(bar)[XB_TMO])) break; if (_sp > XB_SPIN_CAP) { atomicAdd(&(bar)[XB_TMO], 1u); break; } } } } while (0)

struct XcdBarrier {
    unsigned* bar; unsigned x;
    volatile LAS unsigned* st;
};

__device__ __forceinline__ XcdBarrier xcd_barrier_post(unsigned* bar, volatile LAS unsigned* st) {
    XcdBarrier b; b.bar = bar; b.x = xb_xcc_id(); b.st = st;
    if (threadIdx.x == 0) (void)xb_add(&bar[XB_XCNT(b.x)], 1u);
    return b;
}
__device__ __forceinline__ void xcd_barrier_complete(unsigned* bar, unsigned x, unsigned& nloc, unsigned& nx) {
    const unsigned G = gridDim.x * gridDim.y * gridDim.z;
    unsigned sum, cnt, mine, sp = 0u;
    for (;;) {
        sum = 0u; cnt = 0u; mine = 0u;
#pragma unroll
        for (unsigned j = 0; j < 16; ++j) { const unsigned c = xb_ld(&bar[XB_XCNT(j)]); sum += c; cnt += (c > 0u) ? 1u : 0u; mine = (j == x) ? c : mine; }
        if (sum == G) break;
        __builtin_amdgcn_s_sleep(1);
        if ((++sp & 255u) == 0u) { if (xb_ld(&bar[XB_TMO])) break; if (sp > XB_SPIN_CAP) { atomicAdd(&bar[XB_TMO], 1u); break; } }
    }
    nloc = mine > 0u ? mine : 1u; nx = cnt > 0u ? cnt : 1u;
}

__device__ __forceinline__ void xcd_barrier(const XcdBarrier& b) {
    asm volatile("s_waitcnt vmcnt(0)" ::: "memory");
    __syncthreads();
    if (threadIdx.x == 0) {
        unsigned* bar = b.bar;
        __builtin_amdgcn_s_waitcnt(0);
        unsigned nloc = b.st[0], nx = b.st[1];
        if (nloc == 0u) { xcd_barrier_complete(bar, b.x, nloc, nx); b.st[0] = nloc; b.st[1] = nx; }
        const unsigned old = xb_add(&bar[XB_XSUB(b.x)], 1u);
        const unsigned gen = old / nloc;
        if (old + 1u == (gen + 1u) * nloc) {
            __builtin_amdgcn_fence(__ATOMIC_RELEASE, "agent");
            asm volatile("s_waitcnt vmcnt(0)" ::: "memory");
            const unsigned og = xb_add(&bar[XB_TOP], 1u);
            const unsigned tg = og / nx;
            if (og + 1u == (tg + 1u) * nx) xb_add(&bar[XB_TOPGEN], 1u);
            else XB_SPIN(xb_ld(&bar[XB_TOPGEN]) == tg, bar);
            __builtin_amdgcn_fence(__ATOMIC_ACQUIRE, "agent");
            xb_add(&bar[XB_XGEN(b.x)], 1u);
            asm volatile("s_waitcnt vmcnt(0)" ::: "memory");
        } else {
            XB_SPIN(xb_ld(&bar[XB_XGEN(b.x)]) == gen, bar);
            __builtin_amdgcn_fence(__ATOMIC_ACQUIRE, "agent");
            asm volatile("s_waitcnt vmcnt(0)" ::: "memory");
        }
    }
    __syncthreads();
}

namespace mk {
using pg8::bf16_t; using pg8::bf16x8; using pg8::f32x4; using pg8::u32x4;
typedef unsigned u32x2 __attribute__((ext_vector_type(2)));
typedef short s16x4 __attribute__((ext_vector_type(4)));
#define DI __device__ __forceinline__
#define LDS_WAIT() asm volatile("s_waitcnt lgkmcnt(0)" ::: "memory")
#define LDS_FENCE() asm volatile("" ::: "memory")
#define MFMA16(a, b, c) __builtin_amdgcn_mfma_f32_16x16x32_bf16((a), (b), (c), 0, 0, 0)

constexpr int T = 32768, SEQ = 4096, NLAYER = 4, NPH = 16;
constexpr int PW = 5120;
constexpr int C_AB = 0, C_AC = 512, C_AX = 1024, C_NQ = 1536, C_NKV = 2048, C_UV = 2816, C_DQ = 3840, C_DK = 4352, C_DV = 4416,
              C_DQI = 4480, C_DKI = 4992, C_NG = 5056, C_DWI = 5080;
constexpr size_t MiB = 1u << 20;
constexpr size_t WS_CTL = 0, WS_PEB = 1 * MiB, WS_CMPK = 2 * MiB, WS_CMPV = 3 * MiB, WS_SK = 4 * MiB, WS_SGUW = 5 * MiB, WS_CMPA = 8 * MiB,
                 WS_CMPP = 24 * MiB, WS_WCAT = 40 * MiB, WS_WBR = 58 * MiB, WS_WOUT4 = 62 * MiB, WS_WQ = 70 * MiB, WS_WPG = 72 * MiB,
                 WS_WPP = 74 * MiB, WS_W1C = 75 * MiB, WS_PB = 78 * MiB, WS_PTU = 96 * MiB, WS_PTV = 128 * MiB, WS_H = 160 * MiB,
                 WS_Y = 224 * MiB, WS_PROJ = 352 * MiB, WS_GATES = 672 * MiB,
                 WS_KS = 928 * MiB, WS_VS = 936 * MiB, WS_KW = 944 * MiB, WS_VW = 952 * MiB, WS_DK = 960 * MiB, WS_DV = 964 * MiB, WS_DKI = 968 * MiB, WS_END = 972 * MiB;
constexpr size_t WS_ACCF = WS_PROJ, WS_MERGED = WS_PROJ + 128 * MiB, WS_QP = WS_PROJ, WS_PP = WS_PROJ + 64 * MiB, WS_EIDX = WS_PROJ + 128 * MiB, WS_EW = WS_PROJ + 144 * MiB, WS_EU = WS_PROJ + 160 * MiB;
constexpr size_t WS_COEF = WS_PROJ + 176 * MiB, WS_H8 = WS_PROJ + 192 * MiB, WS_HSI = WS_PROJ + 224 * MiB, WS_SSQ = WS_PROJ + 225 * MiB, WS_PD = WS_GATES, PT_SLICE = 2 * MiB;
constexpr int LDS_BYTES = 163840, LDS_PERWAVE = 19456, LDS_BUCK = 8 * LDS_PERWAVE, LDS_TBL = LDS_BUCK + 4096, LDS_XB = LDS_BYTES - 64;

struct Params { const float* in[27]; float* out; unsigned char* ws; int ph_lo, ph_hi; };
enum { I_X = 0, I_P, I_REL, I_GMIX, I_WIN, I_CONVW, I_PE, I_CW1, I_CW2, I_NQG, I_NKG, I_LNG, I_SGUW, I_SGUB, I_DQG, I_DKG, I_WGATE, I_WBR, I_WOUT,
       I_GFFN, I_WQ, I_SUBK, I_PU, I_PV, I_GPLE, I_WPG, I_WPP };

struct Frame { LAS unsigned char* lds; int tid, lane, wave, vb, G; };

DI float bf2f(unsigned short b) { return __uint_as_float(((unsigned)b) << 16); }
DI unsigned f2bf(float f) { unsigned u = __float_as_uint(f); return (u + 0x7fffu + ((u >> 16) & 1u)) >> 16; }
DI unsigned pk2(float lo, float hi) { return pg8::cvt_pk_bf16(lo, hi); }
DI float lo16(unsigned w) { return __uint_as_float(w << 16); }
DI float hi16(unsigned w) { return __uint_as_float(w & 0xffff0000u); }
DI float sigm(float x) { return __builtin_amdgcn_rcpf(1.f + __builtin_amdgcn_exp2f(-1.44269504f * x)); }
DI float gelu_t(float x) { const float y = (-2.f * 0.7978845608f * 1.44269504f) * (x + 0.044715f * x * x * x); return x * __builtin_amdgcn_rcpf(1.f + __builtin_amdgcn_exp2f(y)); }
#define DPP_I(x, ctrl) __builtin_amdgcn_update_dpp(0, (x), (ctrl), 0xF, 0xF, false)
DI float dppf(float x, int) { return x; }
DI float row16_sumf(float v) { v += __builtin_bit_cast(float, DPP_I(__builtin_bit_cast(int, v), 0xB1)); v += __builtin_bit_cast(float, DPP_I(__builtin_bit_cast(int, v), 0x4E));
    v += __builtin_bit_cast(float, DPP_I(__builtin_bit_cast(int, v), 0x141)); v += __builtin_bit_cast(float, DPP_I(__builtin_bit_cast(int, v), 0x140)); return v; }
DI float row16_maxf(float v) { v = fmaxf(v, __builtin_bit_cast(float, DPP_I(__builtin_bit_cast(int, v), 0xB1))); v = fmaxf(v, __builtin_bit_cast(float, DPP_I(__builtin_bit_cast(int, v), 0x4E)));
    v = fmaxf(v, __builtin_bit_cast(float, DPP_I(__builtin_bit_cast(int, v), 0x141))); v = fmaxf(v, __builtin_bit_cast(float, DPP_I(__builtin_bit_cast(int, v), 0x140))); return v; }
DI float quad_sumf(float v) { v += __builtin_bit_cast(float, DPP_I(__builtin_bit_cast(int, v), 0xB1)); v += __builtin_bit_cast(float, DPP_I(__builtin_bit_cast(int, v), 0x4E)); return v; }
DI float oct_sumf(float v) { v = quad_sumf(v); v += __builtin_bit_cast(float, DPP_I(__builtin_bit_cast(int, v), 0x141)); return v; }
DI float x16_sum(float v) { const unsigned u = __float_as_uint(v); const auto r = __builtin_amdgcn_permlane16_swap(u, u, false, false); return __uint_as_float(r[0]) + __uint_as_float(r[1]); }
DI float x32_sum(float v) { const unsigned u = __float_as_uint(v); const auto r = __builtin_amdgcn_permlane32_swap(u, u, false, false); return __uint_as_float(r[0]) + __uint_as_float(r[1]); }
DI float x16_max(float v) { const unsigned u = __float_as_uint(v); const auto r = __builtin_amdgcn_permlane16_swap(u, u, false, false); return fmaxf(__uint_as_float(r[0]), __uint_as_float(r[1])); }
DI float x32_max(float v) { const unsigned u = __float_as_uint(v); const auto r = __builtin_amdgcn_permlane32_swap(u, u, false, false); return fmaxf(__uint_as_float(r[0]), __uint_as_float(r[1])); }
DI unsigned wave_sum_u(unsigned v) { v += (unsigned)DPP_I((int)v, 0xB1); v += (unsigned)DPP_I((int)v, 0x4E); v += (unsigned)DPP_I((int)v, 0x141); v += (unsigned)DPP_I((int)v, 0x140);
    { const auto r = __builtin_amdgcn_permlane16_swap(v, v, false, false); v = r[0] + r[1]; } { const auto r = __builtin_amdgcn_permlane32_swap(v, v, false, false); v = r[0] + r[1]; } return v; }
DI float wave_sum(float v) { return x32_sum(x16_sum(row16_sumf(v))); }
DI float wave_max(float v) { return x32_max(x16_max(row16_maxf(v))); }
DI unsigned ordf(float f) { const unsigned u = __float_as_uint(f); return (u & 0x80000000u) ? ~u : (u | 0x80000000u); }
DI float unordf(unsigned x) { return __uint_as_float((x & 0x80000000u) ? (x & 0x7fffffffu) : ~x); }
DI int bucket_of(int n) {
    if (n < 16) return n;
    int b = 16;
    b += (n >= 21); b += (n >= 27); b += (n >= 35); b += (n >= 46); b += (n >= 59); b += (n >= 77); b += (n >= 99); b += (n >= 128);
    b += (n >= 166); b += (n >= 216); b += (n >= 280); b += (n >= 363); b += (n >= 470); b += (n >= 609); b += (n >= 790);
    return b; }

DI int srccol(int n) { return n < 2816 ? n : (n < 5056 ? n + 24 : (n < 5080 ? n - 2240 : (n < 5088 ? n : -1))); }
DI void tr_item(const float* W, int ldw, bf16_t* WT, int ldwt, int k0, int n0, LAS float* scr, int lane, bool remap, int ncopy, int cstride) {
    float tv[32];
#pragma unroll
    for (int i = 0; i < 32; ++i) { const int kk = 2 * i + (lane >> 5), nl = lane & 31; const int n = n0 + nl; const int src = remap ? srccol(n) : n; tv[i] = src >= 0 ? W[(size_t)(k0 + kk) * ldw + src] : 0.f; }
#pragma unroll
    for (int i = 0; i < 32; ++i) { const int kk = 2 * i + (lane >> 5), nl = lane & 31; scr[kk * 33 + nl] = tv[i]; }
    LDS_WAIT();
    const int c = lane & 7;
#pragma unroll
    for (int j = 0; j < 4; ++j) { const int n = (lane >> 3) + 8 * j; const LAS float* s = scr + (8 * c) * 33 + n;
        u32x4 o; o.x = pk2(s[0], s[33]); o.y = pk2(s[66], s[99]); o.z = pk2(s[132], s[165]); o.w = pk2(s[198], s[231]);
        for (int cp = 0; cp < ncopy; ++cp) *(u32x4*)(WT + (size_t)(n0 + n) * ldwt + (size_t)cp * cstride + k0 + 8 * c) = o; }
    LDS_WAIT();
}
DI void cvt_rows(const float* src, bf16_t* dst, size_t ngroups8, int gw, int NGW, int lane) {
    const size_t st = (size_t)NGW * 64;
    for (size_t i0 = (size_t)gw * 64 + lane; i0 < ngroups8; i0 += 4 * st) {
        f32x4 a[4], b[4];
#pragma unroll
        for (int r = 0; r < 4; ++r) { const size_t i = i0 + r * st < ngroups8 ? i0 + r * st : i0; a[r] = ((const f32x4*)src)[2 * i]; b[r] = ((const f32x4*)src)[2 * i + 1]; }
#pragma unroll
        for (int r = 0; r < 4; ++r) { const size_t i = i0 + r * st; if (i >= ngroups8) break;
            u32x4 o; o.x = pk2(a[r].x, a[r].y); o.y = pk2(a[r].z, a[r].w); o.z = pk2(b[r].x, b[r].y); o.w = pk2(b[r].z, b[r].w); ((u32x4*)dst)[i] = o; }
    }
}
DI int pk4_fp8(float a, float b, float c, float d) { int w = 0; w = __builtin_amdgcn_cvt_pk_fp8_f32(a, b, w, false); w = __builtin_amdgcn_cvt_pk_fp8_f32(c, d, w, true); return w; }
DI void cvt_rows_fp8(const float* src, unsigned char* dst, float* scl, int nrows, int gw, int NGW, int lane) {
    for (int r0 = gw; r0 < nrows; r0 += 4 * NGW) {
        f32x4 a[4], b[4], c[4], d[4];
#pragma unroll
        for (int k = 0; k < 4; ++k) { const int r = r0 + k * NGW < nrows ? r0 + k * NGW : r0; const float* s = src + (size_t)r * 1024 + lane * 16;
            a[k] = *(const f32x4*)s; b[k] = *(const f32x4*)(s + 4); c[k] = *(const f32x4*)(s + 8); d[k] = *(const f32x4*)(s + 12); }
#pragma unroll
        for (int k = 0; k < 4; ++k) { const int r = r0 + k * NGW; if (r >= nrows) break;
            float mx = fmaxf(fmaxf(fmaxf(fabsf(a[k].x), fabsf(a[k].y)), fmaxf(fabsf(a[k].z), fabsf(a[k].w))), fmaxf(fmaxf(fabsf(b[k].x), fabsf(b[k].y)), fmaxf(fabsf(b[k].z), fabsf(b[k].w))));
            mx = fmaxf(mx, fmaxf(fmaxf(fmaxf(fabsf(c[k].x), fabsf(c[k].y)), fmaxf(fabsf(c[k].z), fabsf(c[k].w))), fmaxf(fmaxf(fabsf(d[k].x), fabsf(d[k].y)), fmaxf(fabsf(d[k].z), fabsf(d[k].w)))));
            mx = wave_max(mx);
            const float sc = mx > 0.f ? mx * (1.f / 448.f) : 1.f, inv = 1.f / sc;
            u32x4 o; o.x = (unsigned)pk4_fp8(a[k].x * inv, a[k].y * inv, a[k].z * inv, a[k].w * inv); o.y = (unsigned)pk4_fp8(b[k].x * inv, b[k].y * inv, b[k].z * inv, b[k].w * inv);
            o.z = (unsigned)pk4_fp8(c[k].x * inv, c[k].y * inv, c[k].z * inv, c[k].w * inv); o.w = (unsigned)pk4_fp8(d[k].x * inv, d[k].y * inv, d[k].z * inv, d[k].w * inv);
            *(u32x4*)(dst + (size_t)(lane >> 3) * PT_SLICE + (size_t)r * 128 + (lane & 7) * 16) = o;
            if (lane == 0) scl[r] = sc; }
    }
}
DI void rmsnorm_rows(const float* x, const float* g, bf16_t* H, int gw, int NGW, int lane, unsigned char* H8 = nullptr, float* HSI = nullptr) {
    const f32x4 g0 = *(const f32x4*)(g + lane * 8), g1 = *(const f32x4*)(g + lane * 8 + 4), g2 = *(const f32x4*)(g + 512 + lane * 8), g3 = *(const f32x4*)(g + 512 + lane * 8 + 4);
    for (int m0 = gw; m0 < T; m0 += 4 * NGW) {
        f32x4 a[4], b[4], c[4], d[4];
#pragma unroll
        for (int r = 0; r < 4; ++r) { const int m = m0 + r * NGW < T ? m0 + r * NGW : m0; const float* xr = x + (size_t)m * 1024 + lane * 8;
            a[r] = *(const f32x4*)xr; b[r] = *(const f32x4*)(xr + 4); c[r] = *(const f32x4*)(xr + 512); d[r] = *(const f32x4*)(xr + 516); }
#pragma unroll
        for (int r = 0; r < 4; ++r) { const int m = m0 + r * NGW; if (m >= T) break;
            float ss = a[r].x * a[r].x + a[r].y * a[r].y + a[r].z * a[r].z + a[r].w * a[r].w + b[r].x * b[r].x + b[r].y * b[r].y + b[r].z * b[r].z + b[r].w * b[r].w
                     + c[r].x * c[r].x + c[r].y * c[r].y + c[r].z * c[r].z + c[r].w * c[r].w + d[r].x * d[r].x + d[r].y * d[r].y + d[r].z * d[r].z + d[r].w * d[r].w;
            ss = wave_sum(ss);
            const float rr = rsqrtf(ss * (1.f / 1024.f) + 1e-6f);
            u32x4 o0, o1;
            o0.x = pk2(a[r].x * rr * g0.x, a[r].y * rr * g0.y); o0.y = pk2(a[r].z * rr * g0.z, a[r].w * rr * g0.w); o0.z = pk2(b[r].x * rr * g1.x, b[r].y * rr * g1.y); o0.w = pk2(b[r].z * rr * g1.z, b[r].w * rr * g1.w);
            o1.x = pk2(c[r].x * rr * g2.x, c[r].y * rr * g2.y); o1.y = pk2(c[r].z * rr * g2.z, c[r].w * rr * g2.w); o1.z = pk2(d[r].x * rr * g3.x, d[r].y * rr * g3.y); o1.w = pk2(d[r].z * rr * g3.z, d[r].w * rr * g3.w);
            bf16_t* hr = H + (size_t)m * 1024 + lane * 8; *(u32x4*)hr = o0; *(u32x4*)(hr + 512) = o1;
            if (H8) {
                float v[16] = {a[r].x * rr * g0.x, a[r].y * rr * g0.y, a[r].z * rr * g0.z, a[r].w * rr * g0.w, b[r].x * rr * g1.x, b[r].y * rr * g1.y, b[r].z * rr * g1.z, b[r].w * rr * g1.w,
                               c[r].x * rr * g2.x, c[r].y * rr * g2.y, c[r].z * rr * g2.z, c[r].w * rr * g2.w, d[r].x * rr * g3.x, d[r].y * rr * g3.y, d[r].z * rr * g3.z, d[r].w * rr * g3.w};
                float am = 0.f;
#pragma unroll
                for (int e = 0; e < 16; ++e) am = fmaxf(am, fabsf(v[e]));
                am = wave_max(am);
                const float hs = am > 0.f ? 224.f / am : 1.f;
                u32x2 q0, q1; q0.x = (unsigned)pk4_fp8(v[0] * hs, v[1] * hs, v[2] * hs, v[3] * hs); q0.y = (unsigned)pk4_fp8(v[4] * hs, v[5] * hs, v[6] * hs, v[7] * hs);
                q1.x = (unsigned)pk4_fp8(v[8] * hs, v[9] * hs, v[10] * hs, v[11] * hs); q1.y = (unsigned)pk4_fp8(v[12] * hs, v[13] * hs, v[14] * hs, v[15] * hs);
                unsigned char* h8 = H8 + (size_t)m * 1024 + lane * 8; *(u32x2*)h8 = q0; *(u32x2*)(h8 + 512) = q1;
                if (lane == 0) HSI[m] = 1.f / hs; } }
    }
}
DI void phase_prep_w(const Params& p, int l, const Frame& F) {
    LAS float* scr = (LAS float*)(F.lds + F.wave * 8448);
    const int gw = F.vb * 8 + F.wave, NGW = F.G * 8, lane = F.lane;
    unsigned char* ws = p.ws;
    bf16_t* WCAT = (bf16_t*)(ws + WS_WCAT); bf16_t* WBR = (bf16_t*)(ws + WS_WBR); bf16_t* WOUT4 = (bf16_t*)(ws + WS_WOUT4); bf16_t* WQ = (bf16_t*)(ws + WS_WQ);
    bf16_t* WPG = (bf16_t*)(ws + WS_WPG); bf16_t* WPP = (bf16_t*)(ws + WS_WPP); bf16_t* W1C = (bf16_t*)(ws + WS_W1C);
    constexpr int I0 = 2560, I1 = 2048, I2 = 1024, I3 = 512, I4 = 512, I5 = 512, I6 = 128, I7 = 512, NIT = I0 + I1 + I2 + I3 + I4 + I5 + I6 + I7;
    for (int it = gw; it < NIT; it += NGW) {
        int r = it;
        if (r < I0) { tr_item(p.in[I_WIN] + (size_t)l * 1024 * 5088, 5088, WCAT, 1024, (r / 160) * 64, (r % 160) * 32, scr, lane, true, 1, 0); continue; } r -= I0;
        if (r < I1) { tr_item(p.in[I_WGATE] + (size_t)l * 1024 * 4096, 4096, WCAT + (size_t)5120 * 1024, 1024, (r / 128) * 64, (r % 128) * 32, scr, lane, false, 1, 0); continue; } r -= I1;
        if (r < I2) { const int m = r >> 8, rr = r & 255; tr_item(p.in[I_WBR] + ((size_t)l * 2048 + m * 512) * 1024, 1024, WBR + (size_t)m * 1024 * 512, 512, (rr / 32) * 64, (rr % 32) * 32, scr, lane, false, 1, 0); continue; } r -= I2;
        if (r < I3) { tr_item(p.in[I_WOUT] + (size_t)l * 1024 * 1024, 1024, WOUT4, 1024, (r / 32) * 64, (r % 32) * 32, scr, lane, false, 1, 0); continue; } r -= I3;
        if (r < I4) { tr_item(p.in[I_WQ] + (size_t)l * 1024 * 1024, 1024, WQ, 1024, (r / 32) * 64, (r % 32) * 32, scr, lane, false, 1, 0); continue; } r -= I4;
        if (r < I5) { tr_item(p.in[I_WPG] + (size_t)l * 1024 * 1024, 1024, WPG, 1024, (r / 32) * 64, (r % 32) * 32, scr, lane, false, 1, 0); continue; } r -= I5;
        if (r < I6) { tr_item(p.in[I_WPP] + (size_t)l * 256 * 1024, 1024, WPP, 256, (r / 32) * 64, (r % 32) * 32, scr, lane, false, 1, 0); continue; } r -= I6;
        { const int jh = r >> 7, rr = r & 127, j = jh >> 1, half = jh & 1;
          tr_item(p.in[I_CW1] + (((size_t)l * 2 + j) * 2048 + half * 1024) * 256, 256, W1C + ((size_t)j * 512 + half * 256) * 1024, 1024, (rr / 8) * 64, (rr % 8) * 32, scr, lane, false, 1, 0); }
    }
    cvt_rows_fp8(p.in[I_PU] + (size_t)l * 16384 * 1024, ws + WS_PTU, (float*)(ws + WS_PTV), 16384, gw, NGW, lane);
    cvt_rows_fp8(p.in[I_PV] + (size_t)l * 16384 * 1024, ws + WS_PTU + 16 * MiB, (float*)(ws + WS_PTV) + 16384, 16384, gw, NGW, lane);
    cvt_rows(p.in[I_SUBK] + (size_t)l * 131072, (bf16_t*)(ws + WS_SK), 131072 / 8, gw, NGW, lane);
    cvt_rows(p.in[I_P] + (size_t)l * T * 256, (bf16_t*)(ws + WS_PB), (size_t)T * 256 / 8, gw, NGW, lane);
    { const float* sw = p.in[I_SGUW] + (size_t)l * 131072; bf16_t* dst = (bf16_t*)(ws + WS_SGUW);
      for (int i = gw * 64 + lane; i < 131072 / 8; i += NGW * 64) { const int e = i * 8, t = (e >> 7) & 127, s0 = e & 127; float v[8];
#pragma unroll
          for (int k = 0; k < 8; ++k) v[k] = (s0 + k <= t) ? sw[e + k] : 0.f;
          u32x4 o; o.x = pk2(v[0], v[1]); o.y = pk2(v[2], v[3]); o.z = pk2(v[4], v[5]); o.w = pk2(v[6], v[7]); ((u32x4*)dst)[i] = o; } }
    { float* peb = (float*)(ws + WS_PEB);
      for (int o = gw; o < 512; o += NGW) { const int j = o >> 8, n = o & 255; const float* pe = p.in[I_PE] + ((size_t)l * 2 + j) * 2048; const float* w1 = p.in[I_CW1] + ((size_t)l * 2 + j) * 2048 * 256;
          float s = 0.f; for (int k = lane; k < 2048; k += 64) s += pe[k] * w1[(size_t)k * 256 + n];
          s = wave_sum(s); if (lane == 0) peb[o] = s; } }
    rmsnorm_rows(l == 0 ? p.in[I_X] : p.out, p.in[I_GMIX] + l * 1024, (bf16_t*)(ws + WS_H), gw, NGW, lane);
}

struct Epi1 {
    static constexpr bool PERM = true, AFTER_DRAIN = false;
    bf16_t* proj; bf16_t* gates;
    DI void operator()(const f32x4 (&acc)[2][2][4][2], const pg8::Unit& u, int wr, int wc, int fr, int fq) const {
        const int row0 = u.pm * 256 + wr * 64 + fr; const bool isg = u.pn >= 20;
        const int col0 = (isg ? (u.pn - 20) * 256 : u.pn * 256) + wc * 32 + 8 * fq; bf16_t* base = isg ? gates : proj; const int ldc = isg ? 4096 : PW;
#pragma unroll
        for (int ai = 0; ai < 2; ++ai)
#pragma unroll
            for (int m = 0; m < 4; ++m) { bf16_t* rowp = base + (size_t)(row0 + ai * 128 + m * 16) * ldc + col0;
#pragma unroll
                for (int bj = 0; bj < 2; ++bj) { f32x4 v0 = acc[ai][bj][m][0], v1 = acc[ai][bj][m][1];
                    if (isg) { v0.x = sigm(v0.x); v0.y = sigm(v0.y); v0.z = sigm(v0.z); v0.w = sigm(v0.w); v1.x = sigm(v1.x); v1.y = sigm(v1.y); v1.z = sigm(v1.z); v1.w = sigm(v1.w); }
                    u32x4 w; w.x = pk2(v0.x, v0.y); w.y = pk2(v0.z, v0.w); w.z = pk2(v1.x, v1.y); w.w = pk2(v1.z, v1.w);
                    __builtin_nontemporal_store(w, (u32x4*)(rowp + bj * 128)); } }
    }
};
struct EpiBf {
    static constexpr bool PERM = true, AFTER_DRAIN = false;
    bf16_t* O; int ldc;
    DI void operator()(const f32x4 (&acc)[2][2][4][2], const pg8::Unit& u, int wr, int wc, int fr, int fq) const {
        const int row0 = u.pm * 256 + wr * 64 + fr, col0 = u.pn * 256 + wc * 32 + 8 * fq;
#pragma unroll
        for (int ai = 0; ai < 2; ++ai)
#pragma unroll
            for (int m = 0; m < 4; ++m) { bf16_t* rowp = O + (size_t)(row0 + ai * 128 + m * 16) * ldc + col0;
#pragma unroll
                for (int bj = 0; bj < 2; ++bj) { const f32x4 v0 = acc[ai][bj][m][0], v1 = acc[ai][bj][m][1];
                    u32x4 w; w.x = pk2(v0.x, v0.y); w.y = pk2(v0.z, v0.w); w.z = pk2(v1.x, v1.y); w.w = pk2(v1.z, v1.w);
                    *(u32x4*)(rowp + bj * 128) = w; } }
    }
};
struct EpiF32P {
    static constexpr bool PERM = true, AFTER_DRAIN = false;
    float* C; int ldc;
    DI void operator()(const f32x4 (&acc)[2][2][4][2], const pg8::Unit& u, int wr, int wc, int fr, int fq) const {
        const int row0 = u.pm * 256 + wr * 64 + fr, col0 = u.pn * 256 + wc * 32 + 8 * fq;
#pragma unroll
        for (int ai = 0; ai < 2; ++ai)
#pragma unroll
            for (int m = 0; m < 4; ++m) { float* rowp = C + (size_t)(row0 + ai * 128 + m * 16) * ldc + col0;
#pragma unroll
                for (int bj = 0; bj < 2; ++bj) { *(f32x4*)(rowp + bj * 128) = acc[ai][bj][m][0]; *(f32x4*)(rowp + bj * 128 + 4) = acc[ai][bj][m][1]; } }
    }
};
struct XcdColOrder {
    int G, c;
    DI bool next(int i, pg8::Unit& u) const {
        if (G != 256) { const int Lx = i * G + c; if (Lx >= 128 * 36) return false; u.pm = Lx / 36; u.pn = Lx % 36; return true; }
        if (i >= 18) return false;
        const int x = c & 7, w = c >> 3;
        if (i < 16) { u.pm = 8 * i + (w & 7); u.pn = 4 * x + (w >> 3); }
        else { u.pm = 16 * x + 8 * (i - 16) + (w & 7); u.pn = 32 + (w >> 3); }
        return true; }
    DI void a_ready(const pg8::Unit&) const {}
    DI void done(const pg8::Unit&) const {}
};
struct RoundOrder {
    pg8::StaticOrder base; int r;
    DI bool next(int i, pg8::Unit& u) const { return i == 0 && base.next(r, u); }
    DI void a_ready(const pg8::Unit&) const {}
    DI void done(const pg8::Unit&) const {}
};
struct ColRangeOrder {
    int G, c, c0, c1;
    DI bool next(int i, pg8::Unit& u) const { const int nc = c1 - c0; const int Lx = i * G + c; if (Lx >= 128 * nc) return false; u.pm = Lx / nc; u.pn = c0 + Lx % nc; return true; }
    DI void a_ready(const pg8::Unit&) const {}
    DI void done(const pg8::Unit&) const {}
};
struct BranchOrder {
    int G, c;
    DI bool next(int i, pg8::Unit& u) const { const int tile = c + G * (i >> 2), m = i & 3; if (tile >= 512) return false; u.pm = m * 128 + (tile >> 2); u.pn = m * 4 + (tile & 3); return true; }
    DI void a_ready(const pg8::Unit&) const {}
    DI void done(const pg8::Unit&) const {}
};
struct EpiBranch {
    static constexpr bool PERM = true, AFTER_DRAIN = false;
    const bf16_t* gates; bf16_t* merged;
    DI void operator()(const f32x4 (&acc)[2][2][4][2], const pg8::Unit& u, int wr, int wc, int fr, int fq) const {
        const int m4 = u.pn >> 2; const int row0 = (u.pm & 127) * 256 + wr * 64 + fr, gcol0 = u.pn * 256 + wc * 32 + 8 * fq, dcol0 = (u.pn & 3) * 256 + wc * 32 + 8 * fq;
#pragma unroll
        for (int ai = 0; ai < 2; ++ai) {
            u32x4 g[4][2], pr[4][2];
#pragma unroll
            for (int m = 0; m < 4; ++m)
#pragma unroll
                for (int bj = 0; bj < 2; ++bj) { g[m][bj] = *(const u32x4*)(gates + (size_t)(row0 + ai * 128 + m * 16) * 4096 + gcol0 + bj * 128);
                    if (m4 > 0) pr[m][bj] = *(const u32x4*)(merged + (size_t)(row0 + ai * 128 + m * 16) * 1024 + dcol0 + bj * 128); }
#pragma unroll
            for (int m = 0; m < 4; ++m)
#pragma unroll
                for (int bj = 0; bj < 2; ++bj) { const f32x4 v0 = acc[ai][bj][m][0], v1 = acc[ai][bj][m][1]; const u32x4 gg = g[m][bj];
                    f32x4 r0 = {v0.x * lo16(gg.x), v0.y * hi16(gg.x), v0.z * lo16(gg.y), v0.w * hi16(gg.y)}, r1 = {v1.x * lo16(gg.z), v1.y * hi16(gg.z), v1.z * lo16(gg.w), v1.w * hi16(gg.w)};
                    if (m4 > 0) { const u32x4 pp_ = pr[m][bj];
                        r0.x += lo16(pp_.x); r0.y += hi16(pp_.x); r0.z += lo16(pp_.y); r0.w += hi16(pp_.y); r1.x += lo16(pp_.z); r1.y += hi16(pp_.z); r1.z += lo16(pp_.w); r1.w += hi16(pp_.w); }
                    u32x4 w; w.x = pk2(r0.x, r0.y); w.y = pk2(r0.z, r0.w); w.z = pk2(r1.x, r1.y); w.w = pk2(r1.z, r1.w);
                    *(u32x4*)(merged + (size_t)(row0 + ai * 128 + m * 16) * 1024 + dcol0 + bj * 128) = w; }
        }
    }
};
struct EpiRes {
    static constexpr bool PERM = true, AFTER_DRAIN = false;
    const float* xin; float* out;
    DI void operator()(const f32x4 (&acc)[2][2][4][2], const pg8::Unit& u, int wr, int wc, int fr, int fq) const {
        const int row0 = u.pm * 256 + wr * 64 + fr, col0 = u.pn * 256 + wc * 32 + 8 * fq;
#pragma unroll
        for (int ai = 0; ai < 2; ++ai)
#pragma unroll
            for (int mh = 0; mh < 2; ++mh) {
                f32x4 xa[2][2][2];
#pragma unroll
                for (int m2 = 0; m2 < 2; ++m2)
#pragma unroll
                    for (int bj = 0; bj < 2; ++bj) { const size_t off = (size_t)(row0 + ai * 128 + (mh * 2 + m2) * 16) * 1024 + col0 + bj * 128; xa[m2][bj][0] = *(const f32x4*)(xin + off); xa[m2][bj][1] = *(const f32x4*)(xin + off + 4); }
#pragma unroll
                for (int m2 = 0; m2 < 2; ++m2)
#pragma unroll
                    for (int bj = 0; bj < 2; ++bj) { const size_t off = (size_t)(row0 + ai * 128 + (mh * 2 + m2) * 16) * 1024 + col0 + bj * 128;
                        *(f32x4*)(out + off) = xa[m2][bj][0] + acc[ai][bj][mh * 2 + m2][0]; *(f32x4*)(out + off + 4) = xa[m2][bj][1] + acc[ai][bj][mh * 2 + m2][1]; }
            }
    }
};
struct EpiPle {
    static constexpr bool PERM = true, AFTER_DRAIN = false;
    float* x; const bf16_t* pp; const float* ssq;
    DI void operator()(const f32x4 (&acc)[2][2][4][2], const pg8::Unit& u, int wr, int wc, int fr, int fq) const {
        const int row0 = u.pm * 256 + wr * 64 + fr, col0 = u.pn * 256 + wc * 32 + 8 * fq;
#pragma unroll
        for (int ai = 0; ai < 2; ++ai)
#pragma unroll
            for (int mh = 0; mh < 2; ++mh) {
                f32x4 xa[2][2][2]; u32x4 ga[2][2]; f32x4 sq[2][2];
#pragma unroll
                for (int m2 = 0; m2 < 2; ++m2) { const float* sp = ssq + (size_t)(row0 + ai * 128 + (mh * 2 + m2) * 16) * 8; sq[m2][0] = *(const f32x4*)sp; sq[m2][1] = *(const f32x4*)(sp + 4);
#pragma unroll
                    for (int bj = 0; bj < 2; ++bj) { const size_t off = (size_t)(row0 + ai * 128 + (mh * 2 + m2) * 16) * 1024 + col0 + bj * 128;
                        xa[m2][bj][0] = *(const f32x4*)(x + off); xa[m2][bj][1] = *(const f32x4*)(x + off + 4); ga[m2][bj] = *(const u32x4*)(pp + off); } }
#pragma unroll
                for (int m2 = 0; m2 < 2; ++m2) {
                    const float rr = rsqrtf((((sq[m2][0].x + sq[m2][0].y) + (sq[m2][0].z + sq[m2][0].w)) + ((sq[m2][1].x + sq[m2][1].y) + (sq[m2][1].z + sq[m2][1].w))) * (1.f / 1024.f) + 1e-6f);
#pragma unroll
                    for (int bj = 0; bj < 2; ++bj) { const size_t off = (size_t)(row0 + ai * 128 + (mh * 2 + m2) * 16) * 1024 + col0 + bj * 128;
                        const f32x4 v0 = acc[ai][bj][mh * 2 + m2][0] * rr, v1 = acc[ai][bj][mh * 2 + m2][1] * rr; const u32x4 g = ga[m2][bj]; f32x4 x0 = xa[m2][bj][0], x1 = xa[m2][bj][1];
                        x0.x += sigm(v0.x) * lo16(g.x); x0.y += sigm(v0.y) * hi16(g.x); x0.z += sigm(v0.z) * lo16(g.y); x0.w += sigm(v0.w) * hi16(g.y);
                        x1.x += sigm(v1.x) * lo16(g.z); x1.y += sigm(v1.y) * hi16(g.z); x1.z += sigm(v1.z) * lo16(g.w); x1.w += sigm(v1.w) * hi16(g.w);
                        *(f32x4*)(x + off) = x0; *(f32x4*)(x + off + 4) = x1; } }
            }
    }
};


DI void unpack8(const u32x4 w, float (&f)[8]) { f[0] = lo16(w.x); f[1] = hi16(w.x); f[2] = lo16(w.y); f[3] = hi16(w.y); f[4] = lo16(w.z); f[5] = hi16(w.z); f[6] = lo16(w.w); f[7] = hi16(w.w); }
DI u32x4 pack8(const float (&f)[8]) { u32x4 o; o.x = pk2(f[0], f[1]); o.y = pk2(f[2], f[3]); o.z = pk2(f[4], f[5]); o.w = pk2(f[6], f[7]); return o; }
DI void load8f(const float* p, float (&f)[8]) { const f32x4 a = *(const f32x4*)p, b = *(const f32x4*)(p + 4); f[0] = a.x; f[1] = a.y; f[2] = a.z; f[3] = a.w; f[4] = b.x; f[5] = b.y; f[6] = b.z; f[7] = b.w; }

DI void phase_chunk(const Params& p, int l, const Frame& F) {
    unsigned char* ws = p.ws; const int lane = F.lane, wave = F.wave;
    bf16_t* PROJ = (bf16_t*)(ws + WS_PROJ); bf16_t* YA = (bf16_t*)(ws + WS_Y); bf16_t* YC = YA + (size_t)2 * T * 512; bf16_t* CMPA = (bf16_t*)(ws + WS_CMPA);
    const bf16_t* SGUW = (const bf16_t*)(ws + WS_SGUW);
    LAS unsigned char* vnT = F.lds;
    const float* convw = p.in[I_CONVW] + (size_t)l * 3 * 512; const float* lng = p.in[I_LNG] + (size_t)l * 512; const float* sgub = p.in[I_SGUB] + (size_t)l * 8 * 128;
    float cw0[8], cw1[8], cw2[8], lgn[8];
    load8f(convw + lane * 8, cw0); load8f(convw + 512 + lane * 8, cw1); load8f(convw + 1024 + lane * 8, cw2); load8f(lng + lane * 8, lgn);
    for (int chunk = F.vb; chunk < T / 128; chunk += F.G) {
        const int t0 = chunk * 128;
        for (int tt = wave; tt < 128; tt += 8) {
            const int t = t0 + tt, s = t & (SEQ - 1), b = t >> 12;
            bf16_t* row = PROJ + (size_t)t * PW;
            const int c0 = lane * 8;
            const u32x4 z = {0u, 0u, 0u, 0u};
            const u32x4 rab = *(const u32x4*)(row + C_AB + c0), rc0 = *(const u32x4*)(row + C_AC + c0), rx0 = *(const u32x4*)(row + C_AX + c0);
            u32x4 r1c = z, r1x = z, r2c = z, r2x = z;
            if (s >= 1) { r1c = *(const u32x4*)(row - PW + C_AC + c0); r1x = *(const u32x4*)(row - PW + C_AX + c0); }
            if (s >= 2) { r2c = *(const u32x4*)(row - 2 * PW + C_AC + c0); r2x = *(const u32x4*)(row - 2 * PW + C_AX + c0); }
            u32x4 segv[3]; int segcol[3]; const float* seggp[3]; float segsc[3];
#pragma unroll
            for (int pass = 0; pass < 3; ++pass) {
                const int seg = pass * 8 + (lane >> 3), sg = seg < 20 ? seg : 20; int col; const float* gp; float sc = 1.f;
                if (sg < 8) { col = C_NQ + 64 * sg; gp = p.in[I_NQG] + l * 64; sc = 0.125f * 1.44269504f; }
                else if (sg < 10) { col = C_NKV + 2 * 128 + (sg - 8) * 64; gp = p.in[I_NKG] + (l * 3 + 1) * 64; }
                else if (sg < 12) { col = C_NKV + 4 * 128 + (sg - 10) * 64; gp = p.in[I_NKG] + (l * 3 + 2) * 64; }
                else if (sg < 20) { col = C_DQ + 64 * (sg - 12); gp = p.in[I_DQG] + l * 64; sc = 0.125f * 1.44269504f; }
                else { col = C_DK; gp = p.in[I_DKG] + l * 64; }
                segcol[pass] = col; seggp[pass] = gp; segsc[pass] = sc; segv[pass] = *(const u32x4*)(row + col + (lane & 7) * 8);
            }
            u32x4 rawc = z; const bf16_t* rawsrc = row; bf16_t* rawdst = nullptr;
            if (lane < 48) { const int sgc = lane >> 3;
                if (sgc < 2) { rawsrc = row + C_NKV + 3 * 128 + sgc * 64; rawdst = (bf16_t*)(ws + WS_VS) + ((size_t)((b * 2 + sgc) * SEQ + s)) * 64; }
                else if (sgc < 4) { rawsrc = row + C_NKV + 5 * 128 + (sgc - 2) * 64; rawdst = (bf16_t*)(ws + WS_VW) + ((size_t)((b * 2 + (sgc - 2)) * SEQ + s)) * 64; }
                else if (sgc == 4) { rawsrc = row + C_DV; rawdst = (bf16_t*)(ws + WS_DV) + (size_t)t * 64; }
                else { rawsrc = row + C_DKI; rawdst = (bf16_t*)(ws + WS_DKI) + (size_t)t * 64; }
                rawc = *(const u32x4*)(rawsrc + (lane & 7) * 8); }
            u32x4 cmpc = z;
            if (lane < 32) { const int jg = lane >> 3; cmpc = *(const u32x4*)(row + C_NKV + (jg >> 1) * 128 + (jg & 1) * 64 + (lane & 7) * 8); }
            const u32x4 ruv = *(const u32x4*)(row + C_UV + 512 + lane * 8);
            {
                float ab[8], c0v[8], x0v[8], c1v[8], x1v[8], c2v[8], x2v[8], y[8];
                unpack8(rab, ab); unpack8(rc0, c0v); unpack8(rx0, x0v); unpack8(r1c, c1v); unpack8(r1x, x1v); unpack8(r2c, c2v); unpack8(r2x, x2v);
#pragma unroll
                for (int e = 0; e < 8; ++e) y[e] = ab[e] * (cw2[e] * c0v[e] * x0v[e] + cw1[e] * c1v[e] * x1v[e] + cw0[e] * c2v[e] * x2v[e]);
                *(u32x4*)(YA + (size_t)t * 512 + c0) = pack8(y);
            }
#pragma unroll
            for (int pass = 0; pass < 3; ++pass) {
                const int seg = pass * 8 + (lane >> 3), part = lane & 7, sg = seg < 20 ? seg : 20;
                float v[8], g[8]; unpack8(segv[pass], v); load8f(seggp[pass] + part * 8, g);
                float ss = 0.f;
#pragma unroll
                for (int e = 0; e < 8; ++e) ss += v[e] * v[e];
                ss = oct_sumf(ss);
                const float r = rsqrtf(ss * (1.f / 64.f) + 1e-6f) * segsc[pass];
#pragma unroll
                for (int e = 0; e < 8; ++e) v[e] = v[e] * r * g[e];
                bf16_t* dstp = row + segcol[pass] + part * 8;
                if (sg >= 8 && sg < 10) dstp = (bf16_t*)(ws + WS_KS) + ((size_t)((b * 2 + (sg - 8)) * SEQ + s)) * 64 + part * 8;
                else if (sg >= 10 && sg < 12) dstp = (bf16_t*)(ws + WS_KW) + ((size_t)((b * 2 + (sg - 10)) * SEQ + s)) * 64 + part * 8;
                else if (sg == 20) dstp = (bf16_t*)(ws + WS_DK) + (size_t)t * 64 + part * 8;
                if (seg < 21) *(u32x4*)dstp = pack8(v);
            }
            if (lane < 48) *(u32x4*)(rawdst + (lane & 7) * 8) = rawc;
            if (lane < 32) { const int jg = lane >> 3, j = jg >> 1, g = jg & 1, part = lane & 7;
                *(u32x4*)(CMPA + ((size_t)j * 4096 + ((size_t)(b * 256 + (s >> 4)) * 2 + g)) * 1024 + (s & 15) * 64 + part * 8) = cmpc; }
            {
                float v[8]; unpack8(ruv, v);
                float sm = 0.f;
#pragma unroll
                for (int e = 0; e < 8; ++e) { v[e] = gelu_t(v[e]); sm += v[e]; }
                const float mean = wave_sum(sm) * (1.f / 512.f); float sq = 0.f;
#pragma unroll
                for (int e = 0; e < 8; ++e) { v[e] -= mean; sq += v[e] * v[e]; }
                const float r = rsqrtf(wave_sum(sq) * (1.f / 512.f) + 1e-6f);
#pragma unroll
                for (int e = 0; e < 8; ++e) *(LAS unsigned short*)(vnT + (lane * 8 + e) * 272 + tt * 2) = (unsigned short)f2bf(v[e] * r * lgn[e]);
            }
        }
        __syncthreads();
        {
            const int g = wave, c = lane & 15, q = lane >> 4; const bf16_t* Wg = SGUW + (size_t)g * 128 * 128;
            for (int tt16 = 0; tt16 < 8; ++tt16) {
                const int nk = (tt16 >> 1) + 1;
                bf16x8 bw[4];
#pragma unroll
                for (int kk = 0; kk < 4; ++kk) bw[kk] = *(const bf16x8*)(Wg + (size_t)(16 * tt16 + c) * 128 + 32 * (kk < nk ? kk : 0) + 8 * q);
                const int t = t0 + 16 * tt16 + c; const float bias = sgub[g * 128 + 16 * tt16 + c];
#pragma unroll
                for (int dt = 0; dt < 4; ++dt) {
                    f32x4 acc = {0.f, 0.f, 0.f, 0.f};
#pragma unroll
                    for (int kk = 0; kk < 4; ++kk) if (kk < nk) { const bf16x8 a = *(const LAS bf16x8*)(vnT + (g * 64 + 16 * dt + c) * 272 + (32 * kk + 8 * q) * 2); acc = MFMA16(a, bw[kk], acc); }
                    const int ch = g * 64 + 16 * dt + 4 * q;
                    const u32x2 uu = *(const u32x2*)(PROJ + (size_t)t * PW + C_UV + ch);
                    u32x2 o; o.x = pk2(gelu_t(lo16(uu.x)) * (acc[0] + bias), gelu_t(hi16(uu.x)) * (acc[1] + bias)); o.y = pk2(gelu_t(lo16(uu.y)) * (acc[2] + bias), gelu_t(hi16(uu.y)) * (acc[3] + bias));
                    *(u32x2*)(YC + (size_t)t * 512 + ch) = o;
                }
            }
        }
        __syncthreads();
    }
}

DI void phase_cmp2(const Params& p, int l, const Frame& F) {
    unsigned char* ws = p.ws; const int lane = F.lane; const int gw = F.vb * 8 + F.wave, NGW = F.G * 8;
    LAS float* hid = (LAS float*)(F.lds + 131072 + F.wave * 1024);
    LAS float* w2s = (LAS float*)F.lds;
    { const float* w2g = p.in[I_CW2] + (size_t)l * 2 * 256 * 64;
      for (int i = F.tid; i < 2 * 256 * 64 / 4; i += 512) *(LAS f32x4*)(w2s + i * 4) = *(const f32x4*)(w2g + i * 4); }
    __syncthreads();
    const float* CMPP = (const float*)(ws + WS_CMPP); const float* peb = (const float*)(ws + WS_PEB);
    bf16_t* CMPK = (bf16_t*)(ws + WS_CMPK); bf16_t* CMPV = (bf16_t*)(ws + WS_CMPV);
    const float* kg = p.in[I_NKG] + (l * 3 + 0) * 64;
    for (int it = gw; it < 8 * 256 * 2 * 2; it += NGW) {
        const int j = it & 1, g = (it >> 1) & 1, n = (it >> 2) & 255, b = it >> 10;
        bf16_t* dst = (j ? CMPV : CMPK) + ((size_t)(b * 2 + g) * 256 + n) * 64;
        if (n == 255) { dst[lane] = 0; continue; }
        const float* Pa = CMPP + ((size_t)j * 4096 + (size_t)(b * 256 + n) * 2 + g) * 512; const float* Pb = CMPP + ((size_t)j * 4096 + (size_t)(b * 256 + n + 1) * 2 + g) * 512 + 256;
        const f32x4 a = *(const f32x4*)(Pa + lane * 4), bq = *(const f32x4*)(Pb + lane * 4), pe = *(const f32x4*)(peb + j * 256 + lane * 4);
        f32x4 h; h.x = gelu_t(a.x + bq.x + pe.x); h.y = gelu_t(a.y + bq.y + pe.y); h.z = gelu_t(a.z + bq.z + pe.z); h.w = gelu_t(a.w + bq.w + pe.w);
        *(LAS f32x4*)(hid + lane * 4) = h;
        LDS_WAIT();
        const LAS float* w2 = w2s + j * 256 * 64;
        float o = 0.f;
#pragma unroll 16
        for (int k = 0; k < 256; ++k) o += hid[k] * w2[k * 64 + lane];
        if (j == 0) { const float ss = wave_sum(o * o); o = o * rsqrtf(ss * (1.f / 64.f) + 1e-6f) * kg[lane]; }
        dst[lane] = (bf16_t)f2bf(o);
        LDS_WAIT();
    }
}

constexpr int LUTP = 1040;
DI int bucket_fast(int n) { const int big = 16 + (int)((__log2f((float)n) - 4.f) * 2.6666667f + 2e-4f); return n < 16 ? n : (big < 31 ? big : 31); }
struct KsCmp { static constexpr bool CONTIG = true; static constexpr int DSTEP = 16, DMAX = 1 << 30; const bf16_t* kb; const bf16_t* vb; int t0, hb;
    DI void base(int k0, const bf16_t*& k, const bf16_t*& v) const { k = kb + (size_t)k0 * 64; v = vb + (size_t)k0 * 64; }
    DI int dist0(int k0, int c) const { return t0 + (c >> 2) - (16 * k0 + 31); } };
struct KsSel { static constexpr bool CONTIG = true; static constexpr int DSTEP = 1, DMAX = 1 << 30; const bf16_t* kb; const bf16_t* vb; const LAS int* selb; int t, hb;
    DI int p0(int k0) const { return __builtin_amdgcn_readfirstlane(selb[k0 >> 6]) * 64 + (k0 & 63); }
    DI void base(int k0, const bf16_t*& k, const bf16_t*& v) const { const int ps = p0(k0); k = kb + (size_t)ps * 64; v = vb + (size_t)ps * 64; }
    DI int dist0(int k0, int c) const { return t - p0(k0); } };
struct KsWin { static constexpr bool CONTIG = true; static constexpr int DSTEP = 1, DMAX = 512; const bf16_t* kb; const bf16_t* vb; int pstart, t0, hb;
    DI void base(int k0, const bf16_t*& k, const bf16_t*& v) const { k = kb + (size_t)(pstart + k0) * 64; v = vb + (size_t)(pstart + k0) * 64; }
    DI int dist0(int k0, int c) const { return t0 + (c >> 2) - (pstart + k0); } };
struct KsDsa { static constexpr bool CONTIG = false; static constexpr int DSTEP = 1, DMAX = 1 << 30; const bf16_t* kb; const bf16_t* vb; const LAS int* list; int n, t;
    DI int pos(int idx) const { return idx < n ? list[idx] : -1; }
    DI const bf16_t* krow(int idx) const { const int ps = pos(idx); return kb + (size_t)(ps < 0 ? 0 : ps) * 64; }
    DI const bf16_t* vrow(int idx) const { const int ps = pos(idx); return vb + (size_t)(ps < 0 ? 0 : ps) * 64; }
    DI float adjust(int idx, int c, float s, bool& ok, const LAS unsigned char* buck, const LAS float* tbl) const {
        const int ps = pos(idx); ok = ps >= 0 && ps <= t; const int dd = t - ps; const int dc = ok ? (dd < 1023 ? dd : 1023) : 0; return s + tbl[buck[dc] * 16 + 8 + (c & 7)]; } };

template <int MODE, class KS>
DI void flash_run(const KS& ks, int nkeys, const bf16x8 (&qb)[2], f32x4 (&o)[4], float& m_run, float& l_run, LAS unsigned char* vt, LAS float* al, LAS float* pn,
                  const LAS unsigned char* buck, const LAS float* tbl, int lane) {
    const int c = lane & 15, q = lane >> 4;
    bf16x8 A00, A01, A10, A11, B00, B01, B10, B11; u32x4 Av[4], Bv[4];
#define FL_LOAD(B_, kk0) do { if constexpr (KS::CONTIG) { const bf16_t* kbp_; const bf16_t* vbp_; ks.base((kk0), kbp_, vbp_); const bf16_t* kr0 = kbp_ + c * 64 + 8 * q; \
            B_##00 = *(const bf16x8*)kr0; B_##01 = *(const bf16x8*)(kr0 + 32); B_##10 = *(const bf16x8*)(kr0 + 1024); B_##11 = *(const bf16x8*)(kr0 + 1056); \
            if (MODE != 1) { const bf16_t* vr0 = vbp_ + (lane >> 3) * 64 + (lane & 7) * 8; _Pragma("unroll") for (int m = 0; m < 4; ++m) B_##v[m] = *(const u32x4*)(vr0 + m * 512); } } \
        else { const bf16_t* kr0 = ks.krow((kk0) + c); const bf16_t* kr1 = ks.krow((kk0) + 16 + c); \
            B_##00 = *(const bf16x8*)(kr0 + 8 * q); B_##01 = *(const bf16x8*)(kr0 + 32 + 8 * q); B_##10 = *(const bf16x8*)(kr1 + 8 * q); B_##11 = *(const bf16x8*)(kr1 + 32 + 8 * q); \
            if (MODE != 1) { _Pragma("unroll") for (int m = 0; m < 4; ++m) B_##v[m] = *(const u32x4*)(ks.vrow((kk0) + (lane >> 3) + 8 * m) + (lane & 7) * 8); } } } while (0)
#define FL_STEP(B_, K0_) do { \
        f32x4 s0 = {0.f, 0.f, 0.f, 0.f}, s1 = {0.f, 0.f, 0.f, 0.f}; \
        s0 = MFMA16(B_##00, qb[0], s0); s0 = MFMA16(B_##01, qb[1], s0); s1 = MFMA16(B_##10, qb[0], s1); s1 = MFMA16(B_##11, qb[1], s1); \
        float sv[8], pv[8]; bool ok[8]; \
        if constexpr (KS::CONTIG) { \
            const LAS float* trow = tbl + (c & 3) * LUTP; const int d0 = ks.dist0((K0_), c) - KS::DSTEP * 4 * q; \
        _Pragma("unroll") \
            for (int i = 0; i < 4; ++i) { const int da = d0 - KS::DSTEP * i, db = da - KS::DSTEP * 16; \
                ok[i] = da >= 0 && da < KS::DMAX; ok[4 + i] = db >= 0 && db < KS::DMAX; \
                sv[i] = s0[i] + trow[da < 0 ? 0 : (da < 1023 ? da : 1023)]; sv[4 + i] = s1[i] + trow[db < 0 ? 0 : (db < 1023 ? db : 1023)]; } \
        } else { \
        _Pragma("unroll") \
            for (int i = 0; i < 4; ++i) { sv[i] = ks.adjust((K0_) + 4 * q + i, c, s0[i], ok[i], buck, tbl); sv[4 + i] = ks.adjust((K0_) + 16 + 4 * q + i, c, s1[i], ok[4 + i], buck, tbl); } \
        } \
        if (MODE == 2) { \
        _Pragma("unroll") \
            for (int e = 0; e < 8; ++e) { pv[e] = ok[e] ? __builtin_amdgcn_exp2f(sv[e]) * l_run : 0.f; \
                const float x = quad_sumf(pv[e]); \
                if ((c & 3) == 0) pn[(c >> 2) * 256 + (K0_) + (e < 4 ? 4 * q + e : 16 + 4 * q + (e - 4))] = x; } \
        } else { \
            float ps = 0.f; \
        _Pragma("unroll") \
            for (int e = 0; e < 8; ++e) { pv[e] = ok[e] ? __builtin_amdgcn_exp2f(sv[e]) : 0.f; ps += pv[e]; } \
            l_run += ps; \
        } \
        if (MODE != 1) { \
        _Pragma("unroll") \
            for (int m = 0; m < 4; ++m) *(LAS u32x4*)(vt + ((lane >> 3) + 8 * m) * 144 + (lane & 7) * 16) = B_##v[m]; \
            LDS_FENCE(); \
            const bf16x8 pa = __builtin_bit_cast(bf16x8, pack8(pv)); \
        _Pragma("unroll") \
            for (int dt = 0; dt < 4; ++dt) { \
                const s16x4 lo = __builtin_amdgcn_ds_read_tr16_b64_v4i16((LAS s16x4*)(vt + (4 * q + (c >> 2)) * 144 + (16 * dt + 4 * (c & 3)) * 2)); \
                const s16x4 hi = __builtin_amdgcn_ds_read_tr16_b64_v4i16((LAS s16x4*)(vt + (16 + 4 * q + (c >> 2)) * 144 + (16 * dt + 4 * (c & 3)) * 2)); \
                const bf16x8 vb8 = __builtin_shufflevector(lo, hi, 0, 1, 2, 3, 4, 5, 6, 7); \
                o[dt] = MFMA16(pa, vb8, o[dt]); \
            } \
            LDS_FENCE(); \
        } \
    } while (0)
    FL_LOAD(A, 0);
    for (int k0 = 0; k0 < nkeys; k0 += 64) {
        { const int kn = k0 + 32 < nkeys ? k0 + 32 : k0; FL_LOAD(B, kn); }
        FL_STEP(A, k0);
        if (k0 + 32 >= nkeys) break;
        { const int kn = k0 + 64 < nkeys ? k0 + 64 : k0; FL_LOAD(A, kn); }
        FL_STEP(B, k0 + 32);
    }
#undef FL_STEP
#undef FL_LOAD
    if (MODE == 0) {
        float lt = x32_sum(x16_sum(l_run));
        const float inv = lt > 0.f ? __builtin_amdgcn_rcpf(lt) : 0.f;
        if (q == 0) al[c] = inv;
        LDS_WAIT();
        const f32x4 a4 = *(const LAS f32x4*)(al + 4 * q);
#pragma unroll
        for (int dt = 0; dt < 4; ++dt) o[dt] = o[dt] * a4;
        LDS_WAIT();
    }
}

DI void nsa_tile(const Params& p, int b, int g, int tb, const Frame& F, const LAS float* lut, int vm = 0) {
    unsigned char* ws = p.ws; const int lane = F.lane, wave = F.wave, c = lane & 15, q = lane >> 4;
    const LAS float* tbl = lut + g * 4 * LUTP;
    LAS unsigned char* wl = F.lds + wave * 9216; LAS unsigned char* vt = wl; LAS float* al = (LAS float*)(wl + 4608); LAS float* pn = (LAS float*)(wl + 4736);
    LAS float* OS = (LAS float*)F.lds; LAS float* LS = (LAS float*)(F.lds + 65536);
    LAS int* SELB = (LAS int*)(F.lds + 73728); LAS int* CNT = (LAS int*)(F.lds + 75776); LAS unsigned short* UNIT = (LAS unsigned short*)(F.lds + 76032); LAS int* NUNIT = (LAS int*)(F.lds + 76416);
    volatile LAS int* TURN = (volatile LAS int*)(F.lds + 76544); LAS unsigned short* LIST = (LAS unsigned short*)(F.lds + 76800);
    LAS unsigned char* vt2 = F.lds + 84992 + wave * 4608;
    const bf16_t* prow0 = (const bf16_t*)(ws + WS_PROJ) + (size_t)(b * SEQ) * PW;
    bf16_t* YB = (bf16_t*)(ws + WS_Y) + (size_t)T * 512;
    const f32x4 z4 = {0.f, 0.f, 0.f, 0.f};
    for (int ii = 0; ii < 2; ++ii) {
        f32x4 accw[4];
        const int item = wave * 2 + ii, t0 = 64 * tb + 4 * item;
#pragma unroll
        for (int k = 0; k < 4; ++k) *(LAS f32x4*)(pn + lane * 4 + 256 * k) = z4;
        bf16x8 qb[2];
        { const bf16_t* qp = prow0 + (size_t)(t0 + (c >> 2)) * PW + C_NQ + (g * 4 + (c & 3)) * 64 + 8 * q; qb[0] = *(const bf16x8*)qp; qb[1] = *(const bf16x8*)(qp + 32); }
        float g0[4], g2[4];
        { const u32x2 ga = *(const u32x2*)(prow0 + (size_t)(t0 + q) * PW + C_NG + 0 * 8 + g * 4), gc = *(const u32x2*)(prow0 + (size_t)(t0 + q) * PW + C_NG + 2 * 8 + g * 4);
          g0[0] = sigm(lo16(ga.x)); g0[1] = sigm(hi16(ga.x)); g0[2] = sigm(lo16(ga.y)); g0[3] = sigm(hi16(ga.y));
          g2[0] = sigm(lo16(gc.x)); g2[1] = sigm(hi16(gc.x)); g2[2] = sigm(lo16(gc.y)); g2[3] = sigm(hi16(gc.y)); }
#pragma unroll
        for (int dt = 0; dt < 4; ++dt) accw[dt] = z4;
        LDS_WAIT();
        const int tl = t0 + 3, nv = tl >= 31 ? ((tl - 31) >> 4) + 1 : 0;
        if (nv > 0 && (vm == 0 || (vm & 1))) {
            const int nk = (nv + 31) & ~31;
            KsCmp ks{(const bf16_t*)(ws + WS_CMPK) + (size_t)(b * 2 + g) * 256 * 64, (const bf16_t*)(ws + WS_CMPV) + (size_t)(b * 2 + g) * 256 * 64, t0, g * 4};
            float m = 0.f, lr = 0.f; f32x4 o[4] = {z4, z4, z4, z4};
            flash_run<1>(ks, nk, qb, o, m, lr, vt, al, pn, (const LAS unsigned char*)vt, tbl, lane);
            lr = x32_sum(x16_sum(lr)); lr = lr > 0.f ? __builtin_amdgcn_rcpf(lr) : 0.f;
            flash_run<2>(ks, nk, qb, o, m, lr, vt, al, pn, (const LAS unsigned char*)vt, tbl, lane);
#pragma unroll
            for (int dt = 0; dt < 4; ++dt) { accw[dt][0] = g0[0] * o[dt][0]; accw[dt][1] = g0[1] * o[dt][1]; accw[dt][2] = g0[2] * o[dt][2]; accw[dt][3] = g0[3] * o[dt][3]; }
        }
        LDS_WAIT();
        {
            const int j = lane; float val[4];
#pragma unroll
            for (int qi = 0; qi < 4; ++qi) {
                if (j == 0 || j == tb) val[qi] = 1e4f;
                else if (j < tb) { const LAS float* pq = pn + qi * 256 + 4 * j; val[qi] = pq[-1] + pq[0] + pq[1] + pq[2] + pq[3]; }
                else val[qi] = -1e30f;
            }
            for (int k = 0; k < 8; ++k) {
#pragma unroll
                for (int qi = 0; qi < 4; ++qi) {
                    const float mx = wave_max(val[qi]); const unsigned long long who = __ballot(val[qi] == mx); const int w = __builtin_ctzll(who);
                    if (lane == 0) SELB[(item * 4 + qi) * 8 + k] = mx > -1e29f ? w : -1;
                    if (lane == w) val[qi] = -3e38f;
                }
            }
        }
        {
            const int pstart = t0 >= 511 ? t0 - 511 : 0, nk = (t0 + 3 - pstart + 1 + 31) & ~31;
            KsWin ks{(const bf16_t*)(ws + WS_KW) + (size_t)(b * 2 + g) * SEQ * 64, (const bf16_t*)(ws + WS_VW) + (size_t)(b * 2 + g) * SEQ * 64, pstart, t0, g * 4};
            float m = 0.f, lr = 0.f; f32x4 o[4] = {z4, z4, z4, z4};
            if (vm == 0 || (vm & 2)) flash_run<0>(ks, nk, qb, o, m, lr, vt, al, pn, (const LAS unsigned char*)vt, tbl, lane);
            if (vm & 4) { flash_run<1>(ks, nk, qb, o, m, lr, vt, al, pn, (const LAS unsigned char*)vt, tbl, lane); o[0][0] += lr; }
#pragma unroll
            for (int dt = 0; dt < 4; ++dt) { accw[dt][0] += g2[0] * o[dt][0]; accw[dt][1] += g2[1] * o[dt][1]; accw[dt][2] += g2[2] * o[dt][2]; accw[dt][3] += g2[3] * o[dt][3]; }
        }
        if (vm == 0) {
            bf16_t* dst = YB + (size_t)(b * SEQ + t0 + q) * 512 + (g * 4) * 64 + c;
#pragma unroll
            for (int dt = 0; dt < 4; ++dt)
#pragma unroll
                for (int i = 0; i < 4; ++i) dst[i * 64 + 16 * dt] = (bf16_t)f2bf(accw[dt][i]);
        }
        else { asm volatile("" :: "v"(accw[0]), "v"(accw[1]), "v"(accw[2]), "v"(accw[3])); }
        LDS_WAIT();
    }
    __syncthreads();
    if (vm != 0) return;
    for (int i = F.tid; i < 66560 / 16; i += 512) *(LAS f32x4*)(F.lds + i * 16) = z4;
    if (F.tid < 64) { CNT[F.tid] = 0; TURN[F.tid] = 0; }
    __syncthreads();
    { const int blk = SELB[F.tid];
      if (blk >= 0) { int rank = 0;
#pragma unroll
          for (int k = 0; k < 8; ++k) { const int ob = SELB[(F.tid & ~7) + k]; rank += (ob >= 0 && ob < blk) ? 1 : 0; }
          const int pos = __hip_atomic_fetch_add(CNT + blk, 1, __ATOMIC_RELAXED, __HIP_MEMORY_SCOPE_WORKGROUP); LIST[blk * 64 + pos] = (unsigned short)((F.tid >> 3) | (rank << 8)); } }
    __syncthreads();
    if (wave == 0) {
        const int uj = (CNT[lane] + 3) >> 2; int inc = uj;
#pragma unroll
        for (int o_ = 1; o_ < 64; o_ <<= 1) { const int v = __shfl_up(inc, o_); if (lane >= o_) inc += v; }
        const int offs = inc - uj;
        for (int u = 0; u < uj; ++u) UNIT[offs + u] = (unsigned short)(lane | (u << 8));
        if (lane == 63) NUNIT[0] = inc;
    }
    __syncthreads();
    {
        const int nu = NUNIT[0];
        const LAS float* trow = tbl + (c & 3) * LUTP;
        const bf16_t* KSb = (const bf16_t*)(ws + WS_KS) + (size_t)(b * 2 + g) * SEQ * 64; const bf16_t* VSb = (const bf16_t*)(ws + WS_VS) + (size_t)(b * 2 + g) * SEQ * 64;
        bf16x8 kA[4], kB[4]; u32x4 vA[4], vB[4]; bf16x8 qs[2], qn[2];
        const bf16x8 zq = {0, 0, 0, 0, 0, 0, 0, 0};
#define SEL_LOAD(K_, V_, jj, st) do { const bf16_t* kr0 = KSb + (size_t)(64 * (jj) + 32 * (st) + c) * 64 + 8 * q; K_[0] = *(const bf16x8*)kr0; K_[1] = *(const bf16x8*)(kr0 + 32); K_[2] = *(const bf16x8*)(kr0 + 1024); K_[3] = *(const bf16x8*)(kr0 + 1056); \
            const bf16_t* vr0 = VSb + (size_t)(64 * (jj) + 32 * (st) + (lane >> 3)) * 64 + (lane & 7) * 8; _Pragma("unroll") for (int m = 0; m < 4; ++m) V_[m] = *(const u32x4*)(vr0 + m * 512); } while (0)
#define SEL_LOADQ(Q_, jj, uu_) do { const int sl_ = 4 * (uu_) + (c >> 2); const int qr_ = sl_ < CNT[jj] ? (int)(LIST[(jj) * 64 + sl_] & 63) : -1; \
            const bf16_t* qp = prow0 + (size_t)(64 * tb + (qr_ < 0 ? 0 : qr_)) * PW + C_NQ + (g * 4 + (c & 3)) * 64 + 8 * q; const bf16x8 q0_ = *(const bf16x8*)qp, q1_ = *(const bf16x8*)(qp + 32); \
            Q_[0] = qr_ >= 0 ? q0_ : zq; Q_[1] = qr_ >= 0 ? q1_ : zq; } while (0)
#define SEL_STEP(K_, V_, st) do { \
                f32x4 s0 = z4, s1 = z4; \
                s0 = MFMA16(K_[0], qs[0], s0); s0 = MFMA16(K_[1], qs[1], s0); s1 = MFMA16(K_[2], qs[0], s1); s1 = MFMA16(K_[3], qs[1], s1); \
                const int d0 = 64 * (tb - j) + (qrow < 0 ? 0 : qrow) - 32 * (st) - 4 * q; float pv[8]; \
            _Pragma("unroll") \
                for (int i = 0; i < 4; ++i) { const int da = d0 - i, db = da - 16; \
                    const float ea = __builtin_amdgcn_exp2f(s0[i] + trow[da < 0 ? 0 : (da < 1023 ? da : 1023)]), eb = __builtin_amdgcn_exp2f(s1[i] + trow[db < 0 ? 0 : (db < 1023 ? db : 1023)]); \
                    pv[i] = (qrow >= 0 && da >= 0) ? ea : 0.f; pv[4 + i] = (qrow >= 0 && db >= 0) ? eb : 0.f; lsum += pv[i] + pv[4 + i]; } \
            _Pragma("unroll") \
                for (int m = 0; m < 4; ++m) *(LAS u32x4*)(vt2 + ((lane >> 3) + 8 * m) * 144 + (lane & 7) * 16) = V_[m]; \
                LDS_FENCE(); \
                const bf16x8 pa = __builtin_bit_cast(bf16x8, pack8(pv)); \
            _Pragma("unroll") \
                for (int dt = 0; dt < 4; ++dt) { \
                    const s16x4 lo = __builtin_amdgcn_ds_read_tr16_b64_v4i16((LAS s16x4*)(vt2 + (4 * q + (c >> 2)) * 144 + (16 * dt + 4 * (c & 3)) * 2)); \
                    const s16x4 hi = __builtin_amdgcn_ds_read_tr16_b64_v4i16((LAS s16x4*)(vt2 + (16 + 4 * q + (c >> 2)) * 144 + (16 * dt + 4 * (c & 3)) * 2)); \
                    o[dt] = MFMA16(pa, __builtin_shufflevector(lo, hi, 0, 1, 2, 3, 4, 5, 6, 7), o[dt]); \
                } \
                LDS_FENCE(); } while (0)
        { const int uu0 = UNIT[wave < nu ? wave : 0]; SEL_LOAD(kA, vA, uu0 & 63, 0); SEL_LOADQ(qs, uu0 & 63, (uu0 >> 8) & 15); }
        for (int ui = wave; ui < nu; ui += 8) {
            const int uu = UNIT[ui], j = uu & 255, u = uu >> 8, nj = CNT[j];
            const int slot = 4 * u + (c >> 2); const int qrow = slot < nj ? (int)(LIST[j * 64 + slot] & 255) : -1;
            f32x4 o[4] = {z4, z4, z4, z4}; float lsum = 0.f;
            SEL_LOAD(kB, vB, j, 1);
            SEL_STEP(kA, vA, 0);
            { const int uu2 = UNIT[ui + 8 < nu ? ui + 8 : ui]; SEL_LOAD(kA, vA, uu2 & 63, 0); SEL_LOADQ(qn, uu2 & 63, (uu2 >> 8) & 15); }
            SEL_STEP(kB, vB, 1);
            qs[0] = qn[0]; qs[1] = qn[1];
            lsum = x32_sum(x16_sum(lsum));
#pragma unroll 1
            for (int s = 0; s < 4; ++s) {
                if (4 * u + s >= nj) break;
                const int ent = LIST[j * 64 + 4 * u + s], qs_ = ent & 255, rk = ent >> 8;
                unsigned spins = 0;
                while (TURN[qs_] != rk) { __builtin_amdgcn_s_sleep(1); if (++spins > (1u << 22)) break; }
            }
            if (4 * u + q < nj) { const int qo = (int)(LIST[j * 64 + 4 * u + q] & 255);
#pragma unroll
                for (int dt = 0; dt < 4; ++dt)
#pragma unroll
                    for (int i = 0; i < 4; ++i) OS[(qo * 4 + i) * 64 + 16 * dt + c] += o[dt][i];
            }
            if (q == 0 && qrow >= 0) LS[qrow * 4 + (c & 3)] += lsum;
            LDS_WAIT();
            if (lane < 4 && 4 * u + lane < nj) { const int ent = LIST[j * 64 + 4 * u + lane]; TURN[ent & 255] = (ent >> 8) + 1; }
            LDS_WAIT();
        }
#undef SEL_LOAD
#undef SEL_LOADQ
#undef SEL_STEP
    }
    __syncthreads();
    for (int ii = 0; ii < 2; ++ii) {
        const int item = wave * 2 + ii, qq = item * 4 + q, t = 64 * tb + qq;
        const u32x2 gg = *(const u32x2*)(prow0 + (size_t)t * PW + C_NG + 8 + g * 4);
        const float g1[4] = {sigm(lo16(gg.x)), sigm(hi16(gg.x)), sigm(lo16(gg.y)), sigm(hi16(gg.y))};
        const f32x4 l4 = *(const LAS f32x4*)(LS + qq * 4);
        const float inv[4] = {l4.x > 0.f ? g1[0] / l4.x : 0.f, l4.y > 0.f ? g1[1] / l4.y : 0.f, l4.z > 0.f ? g1[2] / l4.z : 0.f, l4.w > 0.f ? g1[3] / l4.w : 0.f};
        bf16_t* dst = YB + (size_t)(b * SEQ + t) * 512 + (g * 4) * 64 + c;
#pragma unroll
        for (int dt = 0; dt < 4; ++dt)
#pragma unroll
            for (int i = 0; i < 4; ++i) dst[i * 64 + 16 * dt] = (bf16_t)f2bf(bf2f(dst[i * 64 + 16 * dt]) + inv[i] * OS[(qq * 4 + i) * 64 + 16 * dt + c]);
    }
    __syncthreads();
}

struct DsaPre { bf16x8 qa[4][2]; u32x2 w4[4]; bf16x8 kx0, kx1; };
DI void dsa_preload(const Params& p, int b, int t0, const Frame& F, DsaPre& d) {
    const int lane = F.lane, c = lane & 15, q = lane >> 4;
    const bf16_t* prow0 = (const bf16_t*)(p.ws + WS_PROJ) + (size_t)(b * SEQ) * PW; const bf16_t* dki = (const bf16_t*)(p.ws + WS_DKI) + (size_t)(b * SEQ) * 64;
#pragma unroll
    for (int rt = 0; rt < 4; ++rt) { const bf16_t* qp = prow0 + (size_t)(t0 + 2 * rt + (c >> 3)) * PW + C_DQI + (c & 7) * 64 + 8 * q; d.qa[rt][0] = *(const bf16x8*)qp; d.qa[rt][1] = *(const bf16x8*)(qp + 32);
        d.w4[rt] = *(const u32x2*)(prow0 + (size_t)(t0 + 2 * rt + (q >> 1)) * PW + C_DWI + (q & 1) * 4); }
    const int ntile = ((t0 + 7) >> 4) + 1;
    const bf16_t* kp = dki + (size_t)(16 * (F.wave < ntile ? F.wave : 0) + c) * 64 + 8 * q; d.kx0 = *(const bf16x8*)kp; d.kx1 = *(const bf16x8*)(kp + 32);
}
DI void dsa_group(const Params& p, int b, int t0, const Frame& F, const LAS unsigned char* buck, const LAS float* tbl, int parts, const DsaPre& cur, DsaPre& nxt, int nb, int nt0) {
    unsigned char* ws = p.ws; const int lane = F.lane, wave = F.wave, c = lane & 15, q = lane >> 4;
    LAS unsigned* SC = (LAS unsigned*)F.lds;
    LAS int* list = (LAS int*)(F.lds + 131072 + wave * 1024); LAS float* al = (LAS float*)(F.lds + 139264 + wave * 64);
    const bf16_t* prow0 = (const bf16_t*)(ws + WS_PROJ) + (size_t)(b * SEQ) * PW;
    bf16_t* YD = (bf16_t*)(ws + WS_Y) + (size_t)3 * T * 512;
    const bf16x8 zf = {0, 0, 0, 0, 0, 0, 0, 0};
    const int t = t0 + wave; const bf16_t* qrow = prow0 + (size_t)t * PW;
    const bf16_t* dki = (const bf16_t*)(ws + WS_DKI) + (size_t)(b * SEQ) * 64;
    const bool full = t0 >= 256;
    bf16x8 qd[2] = {zf, zf};
    if (c < 8) { qd[0] = *(const bf16x8*)(qrow + C_DQ + c * 64 + 8 * q); qd[1] = *(const bf16x8*)(qrow + C_DQ + c * 64 + 32 + 8 * q); }
    if (full && (parts & 1)) {
        bf16x8 qa[4][2]; float wv[4][4];
#pragma unroll
        for (int rt = 0; rt < 4; ++rt) { qa[rt][0] = cur.qa[rt][0]; qa[rt][1] = cur.qa[rt][1]; const u32x2 w4 = cur.w4[rt];
            wv[rt][0] = lo16(w4.x) * 0.35355339f; wv[rt][1] = hi16(w4.x) * 0.35355339f; wv[rt][2] = lo16(w4.y) * 0.35355339f; wv[rt][3] = hi16(w4.y) * 0.35355339f; }
        const int ntile = ((t0 + 7) >> 4) + 1, nk64 = ((t0 + 7) >> 6) + 1;
        bf16x8 kx0 = cur.kx0, kx1 = cur.kx1;
        for (int tau = wave; tau < ntile; tau += 8) {
            const bf16x8 kb0 = kx0, kb1 = kx1;
            { const bf16_t* kp = dki + (size_t)(16 * (tau + 8 < ntile ? tau + 8 : tau) + c) * 64 + 8 * q; kx0 = *(const bf16x8*)kp; kx1 = *(const bf16x8*)(kp + 32); }
            const int key = 16 * tau + c;
#pragma unroll
            for (int rt = 0; rt < 4; ++rt) {
                f32x4 acc = {0.f, 0.f, 0.f, 0.f};
                acc = MFMA16(qa[rt][0], kb0, acc); acc = MFMA16(qa[rt][1], kb1, acc);
                float s = wv[rt][0] * fmaxf(acc[0], 0.f) + wv[rt][1] * fmaxf(acc[1], 0.f) + wv[rt][2] * fmaxf(acc[2], 0.f) + wv[rt][3] * fmaxf(acc[3], 0.f);
                s = x16_sum(s);
                const int qq = 2 * rt + (q >> 1);
                if ((q & 1) == 0) SC[qq * 4096 + key] = key <= t0 + qq ? ordf(s) : 0u;
            }
        }
        for (int i = F.tid; i < 8 * 64; i += 512) { const int key = ntile * 16 + (i & 63); if (key < nk64 * 64) SC[(i >> 6) * 4096 + key] = 0u; }
    }
    dsa_preload(p, nb, nt0, F, nxt);
    __syncthreads();
    int n;
    if (!full) { n = t + 1; for (int i = lane; i < 256; i += 64) list[i] = i <= t ? i : -1; }
    else if (parts & 2) {
        n = 256;
        const LAS unsigned* sc = SC + wave * 4096; const int nk64 = (t >> 6) + 1;
        unsigned u[64];
#pragma unroll
        for (int k = 0; k < 64; ++k) u[k] = k < nk64 ? sc[k * 64 + lane] : 0u;
#define WAVE_TOTAL(cl, tot) do { tot = __builtin_amdgcn_readfirstlane((int)wave_sum_u(cl)); } while (0)
        unsigned prefix = 0u;
        const int nk8 = __builtin_amdgcn_readfirstlane((nk64 + 7) >> 3);
#define CNT_GE(NK) _Pragma("unroll") for (int k = 0; k < NK; ++k) cl += (u[k] >= cand) ? 1u : 0u;
        for (int bit = 31; bit >= 0; --bit) {
            const unsigned cand = prefix | (1u << bit); unsigned cl = 0u; int cnt;
            switch (nk8) { case 1: CNT_GE(8) break; case 2: CNT_GE(16) break; case 3: CNT_GE(24) break; case 4: CNT_GE(32) break;
                           case 5: CNT_GE(40) break; case 6: CNT_GE(48) break; case 7: CNT_GE(56) break; default: CNT_GE(64) break; }
            WAVE_TOTAL(cl, cnt);
            if (cnt >= 256) { prefix = cand; if (cnt == 256) break; }
        }
        int cgt; { unsigned cl = 0u;
#pragma unroll
            for (int k = 0; k < 64; ++k) cl += (u[k] > prefix) ? 1u : 0u;
            WAVE_TOTAL(cl, cgt); }
#undef WAVE_TOTAL
#undef CNT_GE
        const int need_eq = 256 - cgt; int base = 0, eqbase = 0;
#pragma unroll
        for (int k = 0; k < 64; ++k) {
            if (k < nk64) {
                const bool gtp = u[k] > prefix, eq = u[k] == prefix;
                const unsigned long long meq = __ballot(eq);
                const int eqrank = eqbase + (int)__builtin_amdgcn_mbcnt_hi((unsigned)(meq >> 32), __builtin_amdgcn_mbcnt_lo((unsigned)meq, 0u));
                const bool take = gtp || (eq && eqrank < need_eq);
                const unsigned long long mt = __ballot(take);
                const int slot = base + (int)__builtin_amdgcn_mbcnt_hi((unsigned)(mt >> 32), __builtin_amdgcn_mbcnt_lo((unsigned)mt, 0u));
                if (take && slot < 256) list[slot] = k * 64 + lane;
                base += __popcll(mt); eqbase += __popcll(meq);
            }
        }
    }
    else n = 256;
    LDS_WAIT();
    if (!(parts & 4)) { __syncthreads(); return; }
    LAS unsigned char* vt = F.lds + wave * 16384;
    KsDsa ks{(const bf16_t*)(ws + WS_DK) + (size_t)(b * SEQ) * 64, (const bf16_t*)(ws + WS_DV) + (size_t)(b * SEQ) * 64, list, n, t};
    const f32x4 z4 = {0.f, 0.f, 0.f, 0.f};
    float m = -1e30f, lr = 0.f; f32x4 o[4] = {z4, z4, z4, z4};
    flash_run<0>(ks, (n + 31) & ~31, qd, o, m, lr, vt, al, (LAS float*)vt, buck, tbl, lane);
    if (q < 2) {
#pragma unroll
        for (int dt = 0; dt < 4; ++dt)
#pragma unroll
            for (int i = 0; i < 4; ++i) YD[(size_t)(b * SEQ + t) * 512 + (4 * q + i) * 64 + 16 * dt + c] = (bf16_t)f2bf(o[dt][i]);
    }
    __syncthreads();
}

DI void phase_attn(const Params& p, int l, const Frame& F, int mask = 3, int parts = 15) {
    const int gw = F.vb * 8 + F.wave, NGW = F.G * 8; const float* rel = p.in[I_REL];
#ifndef MK_ATTN
#define MK_ATTN 3
#endif
    if ((MK_ATTN & 1) && (mask & 1)) {
        LAS float* lut = (LAS float*)(F.lds + 130048);
        for (int i = F.tid; i < 8 * 1024; i += 512) { const int h = i >> 10, d = i & 1023; lut[h * LUTP + d] = rel[bucket_of(d) * 16 + h] * 1.44269504f; }
        __syncthreads();
        for (int it = F.vb; it < 8 * 2 * 64; it += F.G) { const int b = it >> 7, g = (it >> 6) & 1; int tb = it & 63; if ((it / F.G) & 1) tb = 63 - tb; nsa_tile(p, b, g, tb, F, lut, (parts >> 8) & 15); }
    }
    __syncthreads();
    LAS unsigned char* buck = F.lds + 139776; LAS float* tbl = (LAS float*)(F.lds + 140800);
    for (int i = F.tid; i < 1024; i += 512) buck[i] = (unsigned char)bucket_of(i);
    tbl[F.tid] = rel[F.tid] * 1.44269504f;
    __syncthreads();
    if ((MK_ATTN & 2) && (mask & 2)) {
        DsaPre pa, pb;
        { const int it = F.vb < 8 * 512 ? F.vb : 0; const int b = it >> 9; int tg = it & 511; if (b & 1) tg = 511 - tg; dsa_preload(p, b, tg * 8, F, pa); }
        for (int it = F.vb; it < 8 * 512; it += F.G) { const int b = it >> 9; int tg = it & 511; if (b & 1) tg = 511 - tg;
            const int it2 = it + F.G < 8 * 512 ? it + F.G : it; const int b2 = it2 >> 9; int tg2 = it2 & 511; if (b2 & 1) tg2 = 511 - tg2;
            dsa_group(p, b, tg * 8, F, buck, tbl, parts, pa, pb, b2, tg2 * 8); pa = pb; }
    }
}


#ifndef MK_PROBE
#define MK_PROBE 0
#endif

DI unsigned row16_maxu(unsigned m) { unsigned o;
    o = (unsigned)DPP_I((int)m, 0xB1); m = m > o ? m : o; o = (unsigned)DPP_I((int)m, 0x4E); m = m > o ? m : o;
    o = (unsigned)DPP_I((int)m, 0x141); m = m > o ? m : o; o = (unsigned)DPP_I((int)m, 0x140); m = m > o ? m : o; return m; }
DI void peer_route_tile(const Params& p, int t0, int lane) {
    unsigned char* ws = p.ws; const int c = lane & 15, q = lane >> 4;
    const bf16_t* QP = (const bf16_t*)(ws + WS_QP); const bf16_t* SK = (const bf16_t*)(ws + WS_SK); int* EIDX = (int*)(ws + WS_EIDX); float* EW = (float*)(ws + WS_EW);
    float* EU = (float*)(ws + WS_EU); const float* USr = (const float*)(ws + WS_PTV); const float* VSr = USr + 16384;
    int ca[4], cb[4]; bool cv[4];
    ca[0] = 0; cb[0] = c; cv[0] = true;
    ca[1] = c < 8 ? 1 : (c < 13 ? 2 : 3); cb[1] = c < 8 ? c : (c < 13 ? c - 8 : c - 13); cv[1] = true;
    { const int ci = 32 + c; int a_, b_;
      if (ci == 32) { a_ = 3; b_ = 3; } else if (ci < 36) { a_ = 4; b_ = ci - 33; } else if (ci < 42) { a_ = 5 + ((ci - 36) >> 1); b_ = (ci - 36) & 1; } else { a_ = 8 + (ci - 42); b_ = 0; }
      ca[2] = a_; cb[2] = b_; cv[2] = true; }
    ca[3] = c < 2 ? 14 + c : 0; cb[3] = 0; cv[3] = c < 2;
    for (int h = 0; h < 8; ++h) {
        unsigned top[2][4];
#pragma unroll
        for (int pp = 0; pp < 2; ++pp) {
            const int hp = h * 2 + pp;
            const bf16_t* ap = QP + (size_t)(t0 + c) * 1024 + hp * 64 + 8 * q;
            const bf16x8 a0 = *(const bf16x8*)ap, a1 = *(const bf16x8*)(ap + 32);
            unsigned v[4][8];
#pragma unroll
            for (int kt = 0; kt < 8; ++kt) { const bf16_t* bp = SK + ((size_t)hp * 128 + 16 * kt + c) * 64 + 8 * q;
                const bf16x8 b0 = *(const bf16x8*)bp, b1 = *(const bf16x8*)(bp + 32);
                f32x4 acc = {0.f, 0.f, 0.f, 0.f}; acc = MFMA16(a0, b0, acc); acc = MFMA16(a1, b1, acc);
#pragma unroll
                for (int i = 0; i < 4; ++i) v[i][kt] = (ordf(acc[i]) & 0xFFFFFF80u) | (unsigned)(127 - (16 * kt + c)); }
            { unsigned mine[4] = {0u, 0u, 0u, 0u};
#define CE_(a, b) { const unsigned hi_ = v[i][a] > v[i][b] ? v[i][a] : v[i][b], lo_ = v[i][a] > v[i][b] ? v[i][b] : v[i][a]; v[i][a] = hi_; v[i][b] = lo_; }
#pragma unroll
              for (int i = 0; i < 4; ++i) { CE_(0, 1) CE_(2, 3) CE_(4, 5) CE_(6, 7) CE_(0, 2) CE_(1, 3) CE_(4, 6) CE_(5, 7) CE_(1, 2) CE_(5, 6) CE_(0, 4) CE_(3, 7) CE_(1, 5) CE_(2, 6) CE_(1, 4) CE_(3, 6) CE_(2, 4) CE_(3, 5) CE_(3, 4) }
#undef CE_
              for (int r = 0; r < 16; ++r) {
#pragma unroll
                  for (int i = 0; i < 4; ++i) { const unsigned m = row16_maxu(v[i][0]); mine[i] = (c == r) ? m : mine[i];
                      const bool win = v[i][0] == m;
#pragma unroll
                      for (int kt = 0; kt < 7; ++kt) v[i][kt] = win ? v[i][kt + 1] : v[i][kt];
                      v[i][7] = win ? 0u : v[i][7]; } }
#pragma unroll
              for (int i = 0; i < 4; ++i) top[pp][i] = mine[i]; }
        }
        unsigned cd[4][4], mine2[4] = {0u, 0u, 0u, 0u}; int i0v[4], i1v[4];
#pragma unroll
        for (int i = 0; i < 4; ++i) {
            const float s0 = unordf(top[0][i] & 0xFFFFFF80u), s1 = unordf(top[1][i] & 0xFFFFFF80u);
            i0v[i] = 127 - (int)(top[0][i] & 127u); i1v[i] = 127 - (int)(top[1][i] & 127u);
#pragma unroll
            for (int k = 0; k < 4; ++k) { const float s0a = __shfl(s0, (lane & 48) | ca[k]), s1b = __shfl(s1, (lane & 48) | cb[k]);
                cd[i][k] = cv[k] ? ((ordf(s0a + s1b) & 0xFFFFFF00u) | (unsigned)(255 - (ca[k] * 16 + cb[k]))) : 0u; }
        }
#define CE_(a, b) { const unsigned hi_ = cd[i][a] > cd[i][b] ? cd[i][a] : cd[i][b], lo_ = cd[i][a] > cd[i][b] ? cd[i][b] : cd[i][a]; cd[i][a] = hi_; cd[i][b] = lo_; }
#pragma unroll
        for (int i = 0; i < 4; ++i) { CE_(0, 1) CE_(2, 3) CE_(0, 2) CE_(1, 3) CE_(1, 2) }
#undef CE_
        for (int r = 0; r < 16; ++r) {
#pragma unroll
            for (int i = 0; i < 4; ++i) { const unsigned m = row16_maxu(cd[i][0]); mine2[i] = (c == r) ? m : mine2[i];
                const bool win = cd[i][0] == m;
#pragma unroll
                for (int k = 0; k < 3; ++k) cd[i][k] = win ? cd[i][k + 1] : cd[i][k];
                cd[i][3] = win ? 0u : cd[i][3]; }
        }
#pragma unroll
        for (int i = 0; i < 4; ++i) {
            const unsigned mine = mine2[i];
            const int pr = 255 - (int)(mine & 255u); const int ea = __shfl(i0v[i], (lane & 48) | (pr >> 4)), eb = __shfl(i1v[i], (lane & 48) | (pr & 15));
            const float scv = unordf(mine & 0xFFFFFF00u);
            const float mx = row16_maxf(scv);
            const float e = __expf(scv - mx); const float sm = row16_sumf(e);
            const size_t o = (size_t)(t0 + 4 * q + i) * 128 + h * 16 + c;
            const int eid = ea * 128 + eb; EIDX[o] = eid; EW[o] = (e / sm) * VSr[eid]; EU[o] = USr[eid];
        }
    }
}
#define MFMA8(a, b, c) __builtin_amdgcn_mfma_f32_16x16x32_fp8_fp8((a), (b), (c), 0, 0, 0)
DI long lo64(const u32x4 v) { return (long)(((unsigned long long)v.y << 32) | v.x); }
DI long hi64(const u32x4 v) { return (long)(((unsigned long long)v.w << 32) | v.z); }
template <int OFF> DI void peer_dma_o(const unsigned char* src, LAS unsigned char* dst) { __builtin_amdgcn_global_load_lds((const unsigned*)src, (LAS unsigned*)(dst - OFF), 16, OFF, 0); }
#define PEER_RD(slot_) (*(const LAS u32x4*)(ring + 1024 * (slot_) + 16 * lane))
#define PEER_VMW(n_) asm volatile("s_waitcnt vmcnt(" #n_ ")" ::: "memory")
struct PeerStream { int u0, ustep, n, xfix; bool al; };
DI PeerStream peer_stream(const Frame& F) { PeerStream s; const int bx = blockIdx.x; s.al = (F.G & 7) == 0; s.u0 = s.al ? (bx >> 3) * 8 + F.wave : bx * 8 + F.wave; s.ustep = s.al ? F.G : F.G * 8;
    const int nu = s.al ? T : T * 8; s.n = (nu - s.u0 + s.ustep - 1) / s.ustep; s.xfix = bx & 7; return s; }
DI void peer_unit(const PeerStream& s, int k, int& t, int& x) { const int u = s.u0 + (k < s.n ? k : s.n - 1) * s.ustep; t = s.al ? u : u >> 3; x = s.al ? s.xfix : u & 7; }

DI void phase_peer_u(const Params& p, const Frame& F) {
    unsigned char* ws = p.ws; const int lane = F.lane, c = lane & 15, q = lane >> 4, c8 = lane & 7, r8 = lane >> 3;
    LAS unsigned char* wl = F.lds + F.wave * LDS_PERWAVE; LAS float* pdl = (LAS float*)wl; LAS unsigned char* ring = wl + 512; LAS unsigned char* meta = wl + 512 + 16384;
    const PeerStream S = peer_stream(F);
    const unsigned char* EIDX = ws + WS_EIDX; const unsigned char* H8 = ws + WS_H8; float* PD = (float*)(ws + WS_PD); const unsigned char* PTU = ws + WS_PTU;
    const int p0 = ((c >> 1) + q) & 7, p1 = (p0 + 4) & 7;
    const int rdo = 1024 * (c >> 3) + 128 * (c & 7);
    int t, x;
#define PU_META(k_, slot_) do { peer_unit(S, (k_), t, x); const unsigned char* s_ = lane < 32 ? EIDX + (size_t)t * 512 + 16 * lane : H8 + (size_t)t * 1024 + 128 * x + 16 * (lane & 7); peer_dma_o<0>(s_, meta + 1024 * (slot_)); } while (0)
#define PU_RD(g_, pc_) (*(const LAS u32x4*)(ring + 2048 * (g_) + rdo + 16 * (pc_)))
    PU_META(0, 0); PU_META(1, 1);
    asm volatile("s_waitcnt vmcnt(0)" ::: "memory");
    u32x4 in_[4], hc0, hc1, hn0, hn1;
    { u32x4 i0_[4];
#pragma unroll
      for (int v_ = 0; v_ < 4; ++v_) i0_[v_] = *(const LAS u32x4*)(meta + 64 * r8 + 16 * v_);
      hn0 = *(const LAS u32x4*)(meta + 512 + 16 * p0); hn1 = *(const LAS u32x4*)(meta + 512 + 16 * p1);
      peer_unit(S, 0, t, x); const unsigned char* tb = PTU + (size_t)x * PT_SLICE + 16 * c8;
#define PU_D0(j) peer_dma_o<0>(tb + (size_t)i0_[(j) >> 2][(j) & 3] * 128, ring + 1024 * (j))
      PU_D0(0); PU_D0(1); PU_D0(2); PU_D0(3); PU_D0(4); PU_D0(5); PU_D0(6); PU_D0(7); PU_D0(8); PU_D0(9); PU_D0(10); PU_D0(11); PU_D0(12); PU_D0(13); PU_D0(14); PU_D0(15);
#undef PU_D0
    }
    PEER_VMW(12);
    u32x4 ra[2], rb[2];
#pragma unroll
    for (int i = 0; i < 2; ++i) { ra[i] = PU_RD(i, p0); rb[i] = PU_RD(i, p1); }
    const f32x4 z4 = {0.f, 0.f, 0.f, 0.f};
    for (int k = 0; k < S.n; ++k) {
        int tc, xc; peer_unit(S, k, tc, xc);
        hc0 = hn0; hc1 = hn1;
        { LAS unsigned char* m1 = meta + 1024 * ((k + 1) & 1);
#pragma unroll
          for (int v_ = 0; v_ < 4; ++v_) in_[v_] = *(const LAS u32x4*)(m1 + 64 * r8 + 16 * v_);
          hn0 = *(const LAS u32x4*)(m1 + 512 + 16 * p0); hn1 = *(const LAS u32x4*)(m1 + 512 + 16 * p1); }
        LDS_WAIT(); PU_META(k + 2, k & 1);
        peer_unit(S, k + 1, t, x);
        const unsigned char* tbn = PTU + (size_t)x * PT_SLICE + 16 * c8;
#define PU_GRP(g) do { if ((g) < 6) PEER_VMW(11); else PEER_VMW(10); const u32x4 na = PU_RD(((g) + 2) & 7, p0), nb = PU_RD(((g) + 2) & 7, p1); \
            f32x4 acc = MFMA8(lo64(ra[(g) & 1]), lo64(hc0), z4); acc = MFMA8(hi64(ra[(g) & 1]), hi64(hc0), acc); acc = MFMA8(lo64(rb[(g) & 1]), lo64(hc1), acc); acc = MFMA8(hi64(rb[(g) & 1]), hi64(hc1), acc); \
            asm volatile("" :: "v"(ra[(g) & 1]), "v"(rb[(g) & 1])); \
            peer_dma_o<0>(tbn + (size_t)in_[(2 * (g)) >> 2][(2 * (g)) & 3] * 128, ring + 2048 * (g)); peer_dma_o<0>(tbn + (size_t)in_[(2 * (g) + 1) >> 2][(2 * (g) + 1) & 3] * 128, ring + 2048 * (g) + 1024); \
            ra[(g) & 1] = na; rb[(g) & 1] = nb; \
            { const float d01 = (c & 1) ? acc[1] : acc[0], d23 = (c & 1) ? acc[3] : acc[2], dg = (c & 2) ? d23 : d01; if (q == (c >> 2)) pdl[16 * (c & 7) + 2 * (g) + (c >> 3)] = dg; } } while (0)
        PU_GRP(0); PU_GRP(1); PU_GRP(2); PU_GRP(3); PU_GRP(4); PU_GRP(5); PU_GRP(6); PU_GRP(7);
#undef PU_GRP
        { const u32x2 pv = *(const LAS u32x2*)(pdl + 2 * lane); *(u32x2*)(PD + ((size_t)xc * T + tc) * 128 + 2 * lane) = pv; }
    }
#undef PU_META
#undef PU_RD
    asm volatile("s_waitcnt vmcnt(0) lgkmcnt(0)" ::: "memory");
}

DI void phase_peer_coef(const Params& p, const Frame& F) {
    unsigned char* ws = p.ws; const float* PD = (const float*)(ws + WS_PD); const float* EW = (const float*)(ws + WS_EW); const float* EU = (const float*)(ws + WS_EU);
    const float* HSI = (const float*)(ws + WS_HSI); float* COEF = (float*)(ws + WS_COEF);
    const size_t NT = (size_t)F.G * 512;
    for (size_t i0 = (size_t)F.vb * 512 + F.tid; i0 < (size_t)T * 128; i0 += 4 * NT) {
        float d[4][8], ew[4], eu[4], hs[4];
#pragma unroll
        for (int r = 0; r < 4; ++r) { size_t i = i0 + r * NT; if (i >= (size_t)T * 128) i = i0; const int t = (int)(i >> 7), pp = (int)(i & 127);
#pragma unroll
            for (int x = 0; x < 8; ++x) d[r][x] = PD[((size_t)x * T + t) * 128 + pp];
            ew[r] = EW[i]; eu[r] = EU[i]; hs[r] = HSI[t]; }
#pragma unroll
        for (int r = 0; r < 4; ++r) { const size_t i = i0 + r * NT; if (i >= (size_t)T * 128) break;
            const float dot = ((d[r][0] + d[r][1]) + (d[r][2] + d[r][3])) + ((d[r][4] + d[r][5]) + (d[r][6] + d[r][7]));
            COEF[i] = ew[r] * gelu_t(dot * eu[r] * hs[r]); }
    }
}

DI void phase_peer_v(const Params& p, const Frame& F, const float* xin, float* xout, const float* gple, bool fuse) {
    unsigned char* ws = p.ws; const int lane = F.lane, c8 = lane & 7, r8 = lane >> 3;
    LAS unsigned char* wl = F.lds + F.wave * LDS_PERWAVE; LAS unsigned char* ring = wl; LAS unsigned char* meta = wl + 16384; LAS unsigned char* xs = wl + 16384 + 2048;
    const PeerStream S = peer_stream(F);
    const unsigned char* EIDX = ws + WS_EIDX; const unsigned char* COEF = ws + WS_COEF; const unsigned char* PTV = ws + WS_PTU + 16 * MiB;
    typedef float f32x2_t __attribute__((ext_vector_type(2)));
    int colofs;
    { const auto ra = __builtin_amdgcn_permlane32_swap(0u, 8u, false, false); const unsigned ta = ra[0];
      const auto rb = __builtin_amdgcn_permlane16_swap(ta, ta + 4u, false, false); const unsigned tb = rb[0];
      colofs = (int)tb + ((lane & 8) ? 2 : 0); }
    LAS float* gl = (LAS float*)(F.lds + 8 * LDS_PERWAVE);
    for (int i = F.tid; i < 1024; i += 512) gl[i] = gple[i];
    __syncthreads();
    bf16_t* Hn = (bf16_t*)(ws + WS_H); float* SSQ = (float*)(ws + WS_SSQ);
    int t, x;
#define PV_META(k_, slot_) do { peer_unit(S, (k_), t, x); const unsigned char* s_ = (lane < 32 ? EIDX : COEF) + (size_t)t * 512 + 16 * (lane & 31); peer_dma_o<0>(s_, meta + 1024 * (slot_)); } while (0)
#define PV_XS(k_, slot_) do { peer_unit(S, (k_), t, x); if (lane < 32) peer_dma_o<0>((const unsigned char*)(xin + (size_t)t * 1024 + 128 * x) + 16 * lane, xs + 512 * (slot_)); } while (0)
    PV_META(0, 0); PV_META(1, 1); PV_XS(0, 0);
    asm volatile("s_waitcnt vmcnt(0)" ::: "memory");
    u32x4 in_[4]; f32x4 cf[4], cn[4];
    { u32x4 i0_[4];
#pragma unroll
      for (int v_ = 0; v_ < 4; ++v_) { i0_[v_] = *(const LAS u32x4*)(meta + 64 * r8 + 16 * v_); cn[v_] = *(const LAS f32x4*)(meta + 512 + 64 * r8 + 16 * v_); }
      peer_unit(S, 0, t, x); const unsigned char* tb = PTV + (size_t)x * PT_SLICE + 16 * c8;
#define PV_D0(j) peer_dma_o<0>(tb + (size_t)i0_[(j) >> 2][(j) & 3] * 128, ring + 1024 * (j))
      PV_D0(0); PV_D0(1); PV_D0(2); PV_D0(3); PV_D0(4); PV_D0(5); PV_D0(6); PV_D0(7); PV_D0(8); PV_D0(9); PV_D0(10); PV_D0(11); PV_D0(12); PV_D0(13); PV_D0(14); PV_D0(15);
#undef PV_D0
    }
    PEER_VMW(12);
    u32x4 rr[4];
#pragma unroll
    for (int i = 0; i < 4; ++i) rr[i] = PEER_RD(i);
    for (int k = 0; k < S.n; ++k) {
        int tc, xc; peer_unit(S, k, tc, xc);
#pragma unroll
        for (int v_ = 0; v_ < 4; ++v_) cf[v_] = cn[v_];
        { LAS unsigned char* m1 = meta + 1024 * ((k + 1) & 1);
#pragma unroll
          for (int v_ = 0; v_ < 4; ++v_) { in_[v_] = *(const LAS u32x4*)(m1 + 64 * r8 + 16 * v_); cn[v_] = *(const LAS f32x4*)(m1 + 512 + 64 * r8 + 16 * v_); } }
        LDS_WAIT(); PV_META(k + 2, k & 1);
        PV_XS(k + 1, (k + 1) & 1);
        peer_unit(S, k + 1, t, x);
        const unsigned char* tbn = PTV + (size_t)x * PT_SLICE + 16 * c8;
        f32x2_t out[8];
#pragma unroll
        for (int e = 0; e < 8; ++e) out[e] = (f32x2_t){0.f, 0.f};
#define PV_STEP(j) do { if ((j) < 12) PEER_VMW(13); else PEER_VMW(11); const u32x4 nw = PEER_RD(((j) + 4) & 15); \
            const u32x4 pv_ = rr[(j) & 3]; const float c1_ = cf[(j) >> 2][(j) & 3]; const f32x2_t cc = {c1_, c1_}; \
            out[0] += cc * __builtin_amdgcn_cvt_pk_f32_fp8((int)pv_.x, false); out[1] += cc * __builtin_amdgcn_cvt_pk_f32_fp8((int)pv_.x, true); \
            out[2] += cc * __builtin_amdgcn_cvt_pk_f32_fp8((int)pv_.y, false); out[3] += cc * __builtin_amdgcn_cvt_pk_f32_fp8((int)pv_.y, true); \
            out[4] += cc * __builtin_amdgcn_cvt_pk_f32_fp8((int)pv_.z, false); out[5] += cc * __builtin_amdgcn_cvt_pk_f32_fp8((int)pv_.z, true); \
            out[6] += cc * __builtin_amdgcn_cvt_pk_f32_fp8((int)pv_.w, false); out[7] += cc * __builtin_amdgcn_cvt_pk_f32_fp8((int)pv_.w, true); \
            asm volatile("" :: "v"(rr[(j) & 3])); \
            peer_dma_o<0>(tbn + (size_t)in_[(j) >> 2][(j) & 3] * 128, ring + 1024 * (j)); rr[(j) & 3] = nw; } while (0)
        PV_STEP(0); PV_STEP(1); PV_STEP(2); PV_STEP(3); PV_STEP(4); PV_STEP(5); PV_STEP(6); PV_STEP(7);
        PV_STEP(8); PV_STEP(9); PV_STEP(10); PV_STEP(11); PV_STEP(12); PV_STEP(13); PV_STEP(14); PV_STEP(15);
#undef PV_STEP
        float n8[8], n4[4], f2[2];
#pragma unroll
        for (int i = 0; i < 8; ++i) { const float a_ = (i & 1) ? out[i >> 1].y : out[i >> 1].x, b_ = (i & 1) ? out[4 + (i >> 1)].y : out[4 + (i >> 1)].x;
            const auto r_ = __builtin_amdgcn_permlane32_swap(__float_as_uint(a_), __float_as_uint(b_), false, false); n8[i] = __uint_as_float(r_[0]) + __uint_as_float(r_[1]); }
#pragma unroll
        for (int i = 0; i < 4; ++i) { const auto r_ = __builtin_amdgcn_permlane16_swap(__float_as_uint(n8[i]), __float_as_uint(n8[4 + i]), false, false); n4[i] = __uint_as_float(r_[0]) + __uint_as_float(r_[1]); }
#pragma unroll
        for (int i = 0; i < 2; ++i) { const bool hi8 = (lane & 8) != 0; const float keep = hi8 ? n4[2 + i] : n4[i], send = hi8 ? n4[i] : n4[2 + i];
            f2[i] = keep + __builtin_bit_cast(float, DPP_I(__builtin_bit_cast(int, send), 0x128)); }
        { const f32x2_t xv = *(const LAS f32x2_t*)(xs + 512 * (k & 1) + 4 * (16 * c8 + colofs));
          const f32x2_t o = {xv.x + f2[0], xv.y + f2[1]}; *(f32x2_t*)(xout + (size_t)tc * 1024 + 128 * xc + 16 * c8 + colofs) = o;
          if (fuse) { const f32x2_t gg = *(const LAS f32x2_t*)(gl + 128 * xc + 16 * c8 + colofs);
              *(unsigned*)(Hn + (size_t)tc * 1024 + 128 * xc + 16 * c8 + colofs) = pk2(o.x * gg.x, o.y * gg.y);
              const float ss = wave_sum(o.x * o.x + o.y * o.y); if (lane == 0) SSQ[(size_t)tc * 8 + xc] = ss; } }
    }
#undef PV_META
#undef PV_XS
    asm volatile("s_waitcnt vmcnt(0) lgkmcnt(0)" ::: "memory");
}
#undef PEER_RD
#undef PEER_VMW

#ifndef MK_MASK
#define MK_MASK 0xffff
#endif
__global__ void __launch_bounds__(512, 2) mega(Params p) {
    extern __shared__ __attribute__((aligned(16))) unsigned char lds_raw[];
#define MKFRAME() Frame F; { int t_ = threadIdx.x; asm volatile("" : "+v"(t_)); F.lds = (LAS unsigned char*)lds_raw; F.tid = t_; F.lane = t_ & 63; F.wave = __builtin_amdgcn_readfirstlane(t_ >> 6); \
        F.G = gridDim.x; const int bx = blockIdx.x; F.vb = (F.G % 8 == 0) ? (bx % 8) * (F.G / 8) + bx / 8 : bx; }
    if (threadIdx.x < 16) ((LAS unsigned*)((LAS unsigned char*)lds_raw + LDS_XB))[threadIdx.x] = 0u;
    __syncthreads();
    const int lo = p.ph_lo, hi = p.ph_hi;
    XcdBarrier bar; bar.bar = (unsigned*)(p.ws + WS_CTL) + 4096; bar.x = 0; bar.st = (volatile LAS unsigned*)((LAS unsigned char*)lds_raw + LDS_XB);
    if (hi - lo > 1) bar = xcd_barrier_post((unsigned*)(p.ws + WS_CTL) + 4096, (volatile LAS unsigned*)((LAS unsigned char*)lds_raw + LDS_XB));
#define WSP(ws) unsigned char* ws = p.ws; asm volatile("" : "+s"(ws))
    for (int l = 0; l < NLAYER; ++l) {
        const int pb = l * NPH;
#define IN(k) (((MK_MASK >> (k)) & 1) && lo <= pb + (k) && pb + (k) < hi)
#if MK_PROBE == 120
#define SEAM(k) do { if (((MK_MASK >> (k)) & 1) && lo <= pb + (k) && pb + (k) + 1 < hi) { xcd_barrier(bar); xcd_barrier(bar); xcd_barrier(bar); } } while (0)
#else
#define SEAM(k) do { if (((MK_MASK >> (k)) & 1) && lo <= pb + (k) && pb + (k) + 1 < hi) xcd_barrier(bar); } while (0)
#endif
        if (IN(0)) { MKFRAME(); phase_prep_w(p, l, F); }
        SEAM(0);
#if MK_PROBE == 100
        if (IN(0)) { MKFRAME(); phase_prep_w(p, l, F); } xcd_barrier(bar);
#endif
        if (IN(1)) { MKFRAME(); WSP(ws); pg8::Gemm g{(const bf16_t*)(ws + WS_H), (const bf16_t*)(ws + WS_WCAT), T, 9216, 1024}; XcdColOrder S{F.G, (int)blockIdx.x};
            Epi1 E{(bf16_t*)(ws + WS_PROJ), (bf16_t*)(ws + WS_GATES)};
            pg8::gemm_phase<Epi1, XcdColOrder, false>(F.lds, g, S, E, nullptr); }
        SEAM(1);
#if MK_PROBE == 104
        if (IN(1)) { for (int rr = 0; rr < 18; ++rr) { MKFRAME(); WSP(ws); pg8::Gemm g{(const bf16_t*)(ws + WS_H), (const bf16_t*)(ws + WS_WCAT), T, 9216, 1024}; RoundOrder S; S.base.init(T, 9216, F.G, (int)blockIdx.x); S.r = rr;
            Epi1 E{(bf16_t*)(ws + WS_PROJ), (bf16_t*)(ws + WS_GATES)};
            pg8::gemm_phase<Epi1, RoundOrder, false>(F.lds, g, S, E, nullptr); xcd_barrier(bar); } }
#endif
#if MK_PROBE == 101 || MK_PROBE == 102 || MK_PROBE == 103
        if (IN(1)) { MKFRAME(); WSP(ws); pg8::Gemm g{(const bf16_t*)(ws + WS_H), (const bf16_t*)(ws + WS_WCAT), T, 9216, 1024}; ColRangeOrder S{F.G, (int)blockIdx.x, MK_PROBE == 103 ? 20 : 0, MK_PROBE == 102 ? 20 : 36};
            Epi1 E{(bf16_t*)(ws + WS_PROJ), (bf16_t*)(ws + WS_GATES)};
            pg8::gemm_phase<Epi1, ColRangeOrder, false>(F.lds, g, S, E, nullptr); } xcd_barrier(bar);
#endif
        if (IN(2)) { MKFRAME(); phase_chunk(p, l, F); }
        SEAM(2);
#if MK_PROBE == 140
        if (IN(2)) { MKFRAME(); phase_chunk(p, l, F); xcd_barrier(bar); }
#endif
        if (IN(3)) { MKFRAME(); WSP(ws);
            { pg8::Gemm g{(const bf16_t*)(ws + WS_CMPA), (const bf16_t*)(ws + WS_W1C), 4096, 512, 1024}; pg8::StaticOrder S; S.init(4096, 512, F.G, (int)blockIdx.x); EpiF32P E{(float*)(ws + WS_CMPP), 512};
              pg8::gemm_phase<EpiF32P, pg8::StaticOrder, false>(F.lds, g, S, E, nullptr); }
        }
        if (IN(3)) { MKFRAME(); WSP(ws);
            { pg8::Gemm g{(const bf16_t*)(ws + WS_CMPA) + (size_t)4096 * 1024, (const bf16_t*)(ws + WS_W1C) + (size_t)512 * 1024, 4096, 512, 1024}; pg8::StaticOrder S; S.init(4096, 512, F.G, (int)((blockIdx.x + F.G / 2) % F.G));
              EpiF32P E{(float*)(ws + WS_CMPP) + (size_t)4096 * 512, 512};
              pg8::gemm_phase<EpiF32P, pg8::StaticOrder, false>(F.lds, g, S, E, nullptr); }
        }
        SEAM(3);
        if (IN(4)) { MKFRAME(); phase_cmp2(p, l, F); }
        SEAM(4);
#if MK_PROBE == 141
        if (IN(4)) { MKFRAME(); phase_cmp2(p, l, F); xcd_barrier(bar); }
#endif
        if (IN(5)) { MKFRAME(); phase_attn(p, l, F, 3, 15); }
        SEAM(5);
#if MK_PROBE == 5 || MK_PROBE == 50 || MK_PROBE == 51 || MK_PROBE == 52 || MK_PROBE == 53
        if (IN(5)) { MKFRAME(); phase_attn(p, l, F, MK_PROBE == 5 ? 3 : (MK_PROBE == 50 ? 1 : 2), MK_PROBE == 52 ? 1 : (MK_PROBE == 53 ? 3 : 15)); xcd_barrier(bar); }
#endif
#if MK_PROBE >= 60 && MK_PROBE < 76
        if (IN(5)) { MKFRAME(); phase_attn(p, l, F, 1, (MK_PROBE - 60) << 8); xcd_barrier(bar); }
#endif
        if (IN(6)) { MKFRAME(); WSP(ws); pg8::Gemm g{(const bf16_t*)(ws + WS_Y), (const bf16_t*)(ws + WS_WBR), 4 * T, 4096, 512}; BranchOrder S{F.G, (int)blockIdx.x};
            EpiBranch E{(const bf16_t*)(ws + WS_GATES), (bf16_t*)(ws + WS_MERGED)};
            pg8::gemm_phase<EpiBranch, BranchOrder, false>(F.lds, g, S, E, nullptr); }
        SEAM(6);
#if MK_PROBE == 106
        if (IN(6)) { MKFRAME(); WSP(ws); pg8::Gemm g{(const bf16_t*)(ws + WS_Y), (const bf16_t*)(ws + WS_WBR), 4 * T, 4096, 512}; BranchOrder S{F.G, (int)blockIdx.x};
            EpiBranch E{(const bf16_t*)(ws + WS_GATES), (bf16_t*)(ws + WS_MERGED)};
            pg8::gemm_phase<EpiBranch, BranchOrder, false>(F.lds, g, S, E, nullptr); } xcd_barrier(bar);
#endif
        if (IN(7)) { MKFRAME(); WSP(ws); pg8::Gemm g{(const bf16_t*)(ws + WS_MERGED), (const bf16_t*)(ws + WS_WOUT4), T, 1024, 1024}; pg8::StaticOrder S; S.init(T, 1024, F.G, (int)blockIdx.x);
            EpiRes E{l == 0 ? p.in[I_X] : p.out, p.out};
            pg8::gemm_phase<EpiRes, pg8::StaticOrder, false>(F.lds, g, S, E, nullptr); }
        SEAM(7);
        if (IN(8)) { MKFRAME(); WSP(ws); rmsnorm_rows(p.out, p.in[I_GFFN] + l * 1024, (bf16_t*)(ws + WS_H), F.vb * 8 + F.wave, F.G * 8, F.lane, ws + WS_H8, (float*)(ws + WS_HSI)); }
        SEAM(8);
#if MK_PROBE == 108
        if (IN(8)) { MKFRAME(); WSP(ws); rmsnorm_rows(p.out, p.in[I_GFFN] + l * 1024, (bf16_t*)(ws + WS_H), F.vb * 8 + F.wave, F.G * 8, F.lane); } xcd_barrier(bar);
#endif
        if (IN(9)) { MKFRAME(); WSP(ws);
            { pg8::Gemm g{(const bf16_t*)(ws + WS_H), (const bf16_t*)(ws + WS_WQ), T, 1024, 1024}; pg8::StaticOrder S; S.init(T, 1024, F.G, (int)blockIdx.x); EpiBf E{(bf16_t*)(ws + WS_QP), 1024};
              pg8::gemm_phase<EpiBf, pg8::StaticOrder, false>(F.lds, g, S, E, nullptr); }
        }
        if (IN(9)) { MKFRAME(); WSP(ws);
            { pg8::Gemm g{(const bf16_t*)(ws + WS_PB), (const bf16_t*)(ws + WS_WPP), T, 1024, 256}; pg8::StaticOrder S; S.init(T, 1024, F.G, (int)blockIdx.x); EpiBf E{(bf16_t*)(ws + WS_PP), 1024};
              pg8::gemm_phase<EpiBf, pg8::StaticOrder, false>(F.lds, g, S, E, nullptr); }
        }
        SEAM(9);
#if MK_PROBE == 110
        if (IN(9)) { for (int rep = 0; rep < 9; ++rep) { MKFRAME(); WSP(ws);
            { pg8::Gemm g{(const bf16_t*)(ws + WS_H), (const bf16_t*)(ws + WS_WQ), T, 1024, 1024}; pg8::StaticOrder S; S.init(T, 1024, F.G, (int)blockIdx.x); EpiBf E{(bf16_t*)(ws + WS_QP), 1024};
              pg8::gemm_phase<EpiBf, pg8::StaticOrder, false>(F.lds, g, S, E, nullptr); } } xcd_barrier(bar); }
#endif
#if MK_PROBE == 109
        if (IN(9)) { MKFRAME(); WSP(ws);
            { pg8::Gemm g{(const bf16_t*)(ws + WS_H), (const bf16_t*)(ws + WS_WQ), T, 1024, 1024}; pg8::StaticOrder S; S.init(T, 1024, F.G, (int)blockIdx.x); EpiBf E{(bf16_t*)(ws + WS_QP), 1024};
              pg8::gemm_phase<EpiBf, pg8::StaticOrder, false>(F.lds, g, S, E, nullptr); } }
        if (IN(9)) { MKFRAME(); WSP(ws);
            { pg8::Gemm g{(const bf16_t*)(ws + WS_PB), (const bf16_t*)(ws + WS_WPP), T, 1024, 256}; pg8::StaticOrder S; S.init(T, 1024, F.G, (int)blockIdx.x); EpiBf E{(bf16_t*)(ws + WS_PP), 1024};
              pg8::gemm_phase<EpiBf, pg8::StaticOrder, false>(F.lds, g, S, E, nullptr); } }
        xcd_barrier(bar);
#endif
        if (IN(10)) { MKFRAME(); for (int tile = F.vb * 8 + F.wave; tile < T / 16; tile += F.G * 8) peer_route_tile(p, tile * 16, F.lane); }
        SEAM(10);
        if (IN(11)) { MKFRAME(); phase_peer_u(p, F); }
        SEAM(11);
        if (IN(12)) { MKFRAME(); phase_peer_coef(p, F); }
        SEAM(12);
        if (IN(13)) { MKFRAME(); phase_peer_v(p, F, p.out, p.out, p.in[I_GPLE] + l * 1024, true); }
        SEAM(13);
#if MK_PROBE == 130
        if (IN(13)) { MKFRAME(); phase_peer_u(p, F); xcd_barrier(bar); }
#endif
#if MK_PROBE == 131
        if (IN(13)) { MKFRAME(); phase_peer_coef(p, F); xcd_barrier(bar); }
#endif
#if MK_PROBE == 132
        if (IN(13)) { MKFRAME(); phase_peer_v(p, F, p.out, (float*)(p.ws + WS_Y), p.in[I_GPLE] + l * 1024, false); xcd_barrier(bar); }
#endif
#if MK_PROBE == 133
        if (IN(13)) { MKFRAME(); for (int tile = F.vb * 8 + F.wave; tile < T / 16; tile += F.G * 8) peer_route_tile(p, tile * 16, F.lane); xcd_barrier(bar); }
#endif
        if (IN(15)) { MKFRAME(); WSP(ws); pg8::Gemm g{(const bf16_t*)(ws + WS_H), (const bf16_t*)(ws + WS_WPG), T, 1024, 1024}; pg8::StaticOrder S; S.init(T, 1024, F.G, (int)blockIdx.x);
            EpiPle E{p.out, (const bf16_t*)(ws + WS_PP), (const float*)(ws + WS_SSQ)};
            pg8::gemm_phase<EpiPle, pg8::StaticOrder, false>(F.lds, g, S, E, nullptr); }
        SEAM(15);
#undef IN
#undef SEAM
    }
}
}

#ifndef MK_LAUNCH_PER_PHASE
#define MK_LAUNCH_PER_PHASE 0
#endif
extern "C" void kernel_launch(void* const* d_in, const int* in_sizes, int n_in, void* d_out, int out_size, void* d_ws, size_t ws_size, hipStream_t stream) {
    static int grid = 0;
    if (grid == 0) {
        if (n_in != 27 || ws_size < mk::WS_END) { fprintf(stderr, "kernel_launch: need 27 inputs and >= %zu bytes of workspace (got %d, %zu)\n", (size_t)mk::WS_END, n_in, ws_size); grid = -1; return; }
        int dev = 0, cus = 0;
        if (hipGetDevice(&dev) != hipSuccess || hipDeviceGetAttribute(&cus, hipDeviceAttributeMultiprocessorCount, dev) != hipSuccess) { grid = -1; return; }
        if (hipFuncSetAttribute((const void*)mk::mega, hipFuncAttributeMaxDynamicSharedMemorySize, mk::LDS_BYTES) != hipSuccess) { fprintf(stderr, "kernel_launch: hipFuncSetAttribute failed\n"); grid = -1; return; }
        int per_cu = 0;
        if (hipOccupancyMaxActiveBlocksPerMultiprocessor(&per_cu, (const void*)mk::mega, 512, mk::LDS_BYTES) != hipSuccess || per_cu < 1) fprintf(stderr, "kernel_launch: occupancy query says %d\n", per_cu);
        (void)hipGetLastError();
        grid = cus;
    }
    if (grid < 0) return;
    (void)in_sizes; (void)out_size;
    hipMemsetAsync((char*)d_ws + mk::WS_CTL, 0, 1u << 20, stream);
    mk::Params prm{};
    for (int i = 0; i < 27; ++i) prm.in[i] = (const float*)d_in[i];
    prm.out = (float*)d_out; prm.ws = (unsigned char*)d_ws;
#if MK_LAUNCH_PER_PHASE
    for (int ph = 0; ph < mk::NLAYER * mk::NPH; ++ph) { prm.ph_lo = ph; prm.ph_hi = ph + 1; hipLaunchKernelGGL(mk::mega, dim3(grid), dim3(512), mk::LDS_BYTES, stream, prm); }
#else
    prm.ph_lo = 0; prm.ph_hi = mk::NLAYER * mk::NPH; hipLaunchKernelGGL(mk::mega, dim3(grid), dim3(512), mk::LDS_BYTES, stream, prm);
#endif
}
```
